# Optimizing an MI355X kernel written in HIP

```python
import math
import jax
import jax.numpy as jnp
from jax import lax
import numpy as np

D_MODEL = 1024
BATCH = 32
SEQ = 256
DEPTH = 2
DEC_BATCH = 4
DEC_SEQ = 1024
PAST_LEN = 512

F32 = jnp.float32
GRID_W = 64
EPS = 1e-6
GN_EPS = 1e-5
S5_WIDTH = D_MODEL // 2
S5_GROUP_CH = 16
S5_GROUPS = S5_WIDTH // S5_GROUP_CH
S5_STATE = 64
RET_WIDTH = D_MODEL // 2
RET_HEADS = 4
RET_DK = RET_WIDTH // RET_HEADS
RET_DV = RET_WIDTH // RET_HEADS
RET_CHUNK = 128
ROPE_BASE = 10000.0
HY_WIDTH = D_MODEL // 2
HY_ORDER = 2
HY_BANDS = 16
HY_EMB = 1 + 2 * HY_BANDS
HY_HIDDEN = 64
HY_DECAY_MIN = -math.log(1e-2) / 1.5
HY_DECAY_MAX = -math.log(1e-2) / 0.3
N_BRANCH = 3
IN_COLS = S5_WIDTH + 4 * RET_WIDTH + 3 * HY_WIDTH + N_BRANCH * D_MODEL
D_FF = 256 * (-(-8 * D_MODEL // (3 * 256)))

kernel_name = 'hybrid_s5_retnet_hyena_diffusion_step'


def _rms_norm(x, g):
    xf = x.astype(F32)
    y = xf * lax.rsqrt(jnp.mean(xf * xf, axis=-1, keepdims=True) + EPS)
    return (y * g.astype(F32)).astype(x.dtype)


def _head_norm(x):
    xc = x - jnp.mean(x, axis=-1, keepdims=True)
    return xc * lax.rsqrt(jnp.mean(xc * xc, axis=-1, keepdims=True) + GN_EPS)


def _diag_scan(lam_bar, bu, h0):
    if h0 is not None:
        bu = bu.at[:, 0].add(lam_bar * h0)
    a = jnp.broadcast_to(lam_bar, bu.shape)

    def combine(left, right):
        a_l, b_l = left
        a_r, b_r = right
        return a_l * a_r, a_r * b_l + b_r

    _, h = lax.associative_scan(combine, (a, bu), axis=1)
    return h


def _s5(u, lp, h0):
    bsz, L, _ = u.shape
    uf = u.astype(F32).reshape(bsz, L, S5_GROUPS, S5_GROUP_CH)
    lam = lax.complex(lp['s5_lam_re'].astype(F32), lp['s5_lam_im'].astype(F32))
    dt = jnp.exp(lp['s5_log_dt'].astype(F32))[..., None]
    lam_bar = jnp.exp(lam * dt)
    b = lax.complex(lp['s5_b_re'].astype(F32), lp['s5_b_im'].astype(F32))
    b_bar = ((lam_bar - 1.0) / lam)[..., None] * b
    c = lax.complex(lp['s5_c_re'].astype(F32), lp['s5_c_im'].astype(F32))
    bu = jnp.einsum('blgc,rgpc->rblgp', uf, b_bar)
    h_f = _diag_scan(lam_bar[0], bu[0], None if h0 is None else h0[:, 0])
    h_b = jnp.flip(_diag_scan(lam_bar[1], jnp.flip(bu[1], axis=1), None if h0 is None else h0[:, 1]), axis=1)
    y = jnp.real(jnp.einsum('blgp,gcp->blgc', h_f, c[0]) + jnp.einsum('blgp,gcp->blgc', h_b, c[1]))
    y = y.reshape(bsz, L, S5_WIDTH) + lp['s5_d'].astype(F32) * u.astype(F32)
    final = jnp.stack([h_f[:, -1], h_b[:, 0]], axis=1)
    return y.astype(u.dtype), final


def _rope_2d(x):
    L, dk = x.shape[1], x.shape[-1]
    n_rows = L // GRID_W
    rows = jnp.repeat(jnp.arange(n_rows, dtype=F32), GRID_W)
    cols = jnp.tile(jnp.arange(GRID_W, dtype=F32), n_rows)
    half = dk // 2
    n_freq = half // 2
    inv = ROPE_BASE ** (-jnp.arange(n_freq, dtype=F32) / n_freq)
    ang = jnp.concatenate([rows[:, None] * inv, cols[:, None] * inv], axis=-1)
    cos = jnp.cos(ang)[None, :, None, :]
    sin = jnp.sin(ang)[None, :, None, :]
    x1, x2 = x[..., :half], x[..., half:]
    return jnp.concatenate([x1 * cos - x2 * sin, x1 * sin + x2 * cos], axis=-1)


def _retention_dir(q, k, v, log_g, inclusive, s0=None, q0=None):
    bsz, L, H, dk = q.shape
    dv = v.shape[-1]
    n = L // RET_CHUNK
    qc = q.reshape(bsz, n, RET_CHUNK, H, dk)
    kc = k.reshape(bsz, n, RET_CHUNK, H, dk)
    vc = v.reshape(bsz, n, RET_CHUNK, H, dv)
    pos = jnp.arange(RET_CHUNK, dtype=F32)
    diff = pos[:, None] - pos[None, :]
    mask = (diff >= 0) if inclusive else (diff > 0)
    decay = jnp.where(mask[None], jnp.exp(log_g[:, None, None] * jnp.maximum(diff, 0.0)[None]), 0.0)
    scores = jnp.einsum('bnihd,bnjhd->bnhij', qc, kc) * decay
    intra = jnp.einsum('bnhij,bnjhe->bnihe', scores, vc)
    k_decay = jnp.exp(log_g[:, None] * (RET_CHUNK - 1.0 - pos)[None])
    kv = jnp.einsum('bnjhd,hj,bnjhe->nbhde', kc, k_decay, vc)
    chunk_decay = jnp.exp(log_g * RET_CHUNK)[:, None, None]

    def step(s, kv_n):
        return chunk_decay * s + kv_n, s

    s_final, s_prev = lax.scan(step, jnp.zeros((bsz, H, dk, dv), F32), kv)
    q_decay = jnp.exp(log_g[:, None] * (pos + 1.0)[None])
    cross = jnp.einsum('bnihd,nbhde,hi->bnihe', qc, s_prev, q_decay)
    out = (intra + cross).reshape(bsz, L, H, dv)
    if s0 is not None:
        t = jnp.arange(L, dtype=F32) + (1.0 if inclusive else 0.0)
        out = out + jnp.einsum('blhd,bhde,hl->blhe', q0, s0, jnp.exp(log_g[:, None] * t[None]))
    return out, s_final


def _flip_seq(a):
    return jnp.flip(a, axis=1)


def _retention_bidir(q, k, v, log_g, q_ctx=None, s0=None):
    fwd, s_f = _retention_dir(q, k, v, log_g[0], True,
                              None if s0 is None else s0[:, 0], q_ctx)
    bwd, s_b = _retention_dir(_flip_seq(q), _flip_seq(k), _flip_seq(v), log_g[1], False,
                              None if s0 is None else s0[:, 1],
                              None if q_ctx is None else _flip_seq(q_ctx))
    return fwd + _flip_seq(bwd), jnp.stack([s_f, s_b], axis=1)


def _short_conv(x, w, b):
    L = x.shape[1]
    xp = jnp.pad(x, ((0, 0), (1, 1), (0, 0)))
    return xp[:, :L] * w[0] + xp[:, 1:L + 1] * w[1] + xp[:, 2:] * w[2] + b


def _hyena_filter_spectra(L, lp):
    t = jnp.arange(L, dtype=F32)
    t_norm = t / L
    bands = jnp.linspace(1e-4, HY_BANDS - 1, HY_BANDS, dtype=F32)
    ang = (2.0 * math.pi / L) * t[:, None] * bands[None, :]
    z = jnp.concatenate([t_norm[:, None], jnp.cos(ang), -jnp.sin(ang)], axis=-1)
    freq = lp['hy_freq'].astype(F32)
    hid = jnp.sin(freq[0] * (z @ lp['hy_w1'].astype(F32) + lp['hy_b1'].astype(F32)))
    hid = jnp.sin(freq[1] * (hid @ lp['hy_w2'].astype(F32) + lp['hy_b2'].astype(F32)))
    filt = (hid @ lp['hy_w3'].astype(F32)).reshape(L, 2, HY_ORDER, HY_WIDTH)
    rate = jnp.linspace(HY_DECAY_MIN, HY_DECAY_MAX, HY_WIDTH, dtype=F32)
    filt = filt * jnp.exp(-t_norm[:, None, None, None] * rate)
    fwd, bwd = filt[:, 0], filt[:, 1]
    kern = jnp.concatenate([fwd, jnp.zeros((1, HY_ORDER, HY_WIDTH), F32), bwd[:0:-1]], axis=0)
    kern = kern * lax.rsqrt(jnp.sum(kern * kern, axis=0, keepdims=True) + EPS)
    return jnp.fft.rfft(kern, axis=0)


def _hyena(hy, lp):
    L = hy.shape[1]
    z = _short_conv(hy.astype(F32), lp['hy_conv_w'].astype(F32), lp['hy_conv_b'].astype(F32))
    x1, x2, v = jnp.split(z, 3, axis=-1)
    spec = _hyena_filter_spectra(L, lp)
    bias = lp['hy_bias'].astype(F32)
    out = v
    for o, gate in enumerate((x1, x2)):
        conv = jnp.fft.irfft(jnp.fft.rfft(out, n=2 * L, axis=1) * spec[None, :, o], n=2 * L, axis=1)[:, :L]
        out = gate * (conv + bias[o] * out)
    return out.astype(hy.dtype)


def _mixer(h, lp, latent, s5_h0, ret_s0):
    bsz, L, _ = h.shape
    widths = [S5_WIDTH, RET_WIDTH, RET_WIDTH, RET_WIDTH, RET_WIDTH, 3 * HY_WIDTH]
    cuts = [int(cv) for cv in np.cumsum(widths)]
    u, q, k, v, g, hy, gate_logits = jnp.split(h @ lp['w_in'], cuts, axis=-1)
    y_s5, s5_state = _s5(u, lp, s5_h0)
    a, b = jnp.split(jax.nn.gelu(y_s5) @ lp['w_s5_glu'], 2, axis=-1)
    br_s5 = a * jax.nn.sigmoid(b)
    q = q.astype(F32).reshape(bsz, L, RET_HEADS, RET_DK)
    k = k.astype(F32).reshape(bsz, L, RET_HEADS, RET_DK) * (RET_DK ** -0.5)
    v = v.astype(F32).reshape(bsz, L, RET_HEADS, RET_DV)
    log_g = jnp.log1p(-jnp.exp(lp['ret_decay'].astype(F32)))
    if latent:
        ret, ret_state = _retention_bidir(_rope_2d(q), _rope_2d(k), v, log_g, q, ret_s0)
    else:
        ret, ret_state = _retention_bidir(q, k, v, log_g)
    ret = _head_norm(ret).reshape(bsz, L, RET_WIDTH) * jax.nn.silu(g.astype(F32))
    br_ret = ret.astype(h.dtype) @ lp['w_ret_o']
    br_hy = _hyena(hy, lp) @ lp['w_hy_o']
    gates = jax.nn.sigmoid(gate_logits.astype(F32)).astype(h.dtype).reshape(bsz, L, N_BRANCH, D_MODEL)
    merged = gates[:, :, 0] * br_s5 + gates[:, :, 1] * br_ret + gates[:, :, 2] * br_hy
    return merged @ lp['w_out'], s5_state, ret_state


def _swiglu(h, w_in, w_out):
    a, b = jnp.split(h @ w_in, 2, axis=-1)
    return (jax.nn.silu(a) * b) @ w_out


def _layer(x, cond, lp, latent, s5_h0, ret_s0):
    mod = (cond @ lp['w_mod'] + lp['b_mod'])[:, None, :]
    sh1, sc1, g1, sh2, sc2, g2 = jnp.split(mod, 6, axis=-1)
    h = _rms_norm(x, lp['norm1']) * (1.0 + sc1) + sh1
    mix, s5_state, ret_state = _mixer(h, lp, latent, s5_h0, ret_s0)
    x = x + g1 * mix
    h = _rms_norm(x, lp['norm2']) * (1.0 + sc2) + sh2
    x = x + g2 * _swiglu(h, lp['w_ffn_in'], lp['w_ffn_out'])
    return x, s5_state, ret_state


def setup_inputs(seed: int = 0) -> dict:
    key = jax.random.key(seed)
    ks = jax.random.split(key, 36)

    def nrm(i, shape, scale):
        return scale * jax.random.normal(ks[i], shape, F32)

    s5_shape = (DEPTH, 2, S5_GROUPS, S5_STATE)
    lam_im = jnp.pi * jnp.arange(S5_STATE, dtype=F32) + nrm(12, s5_shape, 0.01)
    ret_decay = -(5.0 + jnp.arange(RET_HEADS, dtype=F32)) * math.log(2.0) + nrm(20, (DEPTH, 2, RET_HEADS), 0.05)
    return {
        'x_prompt': nrm(0, (BATCH, SEQ, D_MODEL), 1.0),
        'x_sample': nrm(1, (DEC_BATCH, DEC_SEQ, D_MODEL), 1.0),
        'state_s5': nrm(2, (DEC_BATCH, DEPTH, 2, S5_GROUPS, S5_STATE, 2), 0.1),
        'state_ret': nrm(3, (DEC_BATCH, DEPTH, 2, RET_HEADS, RET_DK, RET_DV), 0.5),
        'c': nrm(4, (DEC_BATCH, D_MODEL), 1.0),
        'c_ctx': nrm(5, (D_MODEL,), 1.0),
        'w_mod': nrm(6, (DEPTH, D_MODEL, 6 * D_MODEL), 0.5 * D_MODEL ** -0.5),
        'b_mod': nrm(7, (DEPTH, 6 * D_MODEL), 0.02),
        'norm1': 1.0 + nrm(8, (DEPTH, D_MODEL), 0.02),
        'norm2': 1.0 + nrm(9, (DEPTH, D_MODEL), 0.02),
        'w_in': nrm(10, (DEPTH, D_MODEL, IN_COLS), D_MODEL ** -0.5),
        's5_lam_re': -0.5 + nrm(11, s5_shape, 0.01),
        's5_lam_im': lam_im,
        's5_log_dt': jax.random.uniform(ks[13], (DEPTH, 2, S5_GROUPS), F32, math.log(1e-3), math.log(1e-1)),
        's5_b_re': nrm(14, (DEPTH, 2, S5_GROUPS, S5_STATE, S5_GROUP_CH), (2.0 * S5_GROUP_CH) ** -0.5),
        's5_b_im': nrm(15, (DEPTH, 2, S5_GROUPS, S5_STATE, S5_GROUP_CH), (2.0 * S5_GROUP_CH) ** -0.5),
        's5_c_re': nrm(16, (DEPTH, 2, S5_GROUPS, S5_GROUP_CH, S5_STATE), S5_STATE ** -0.5),
        's5_c_im': nrm(17, (DEPTH, 2, S5_GROUPS, S5_GROUP_CH, S5_STATE), S5_STATE ** -0.5),
        's5_d': nrm(18, (DEPTH, S5_WIDTH), 1.0),
        'w_s5_glu': nrm(19, (DEPTH, S5_WIDTH, 2 * D_MODEL), S5_WIDTH ** -0.5),
        'ret_decay': ret_decay,
        'w_ret_o': nrm(21, (DEPTH, RET_WIDTH, D_MODEL), RET_WIDTH ** -0.5),
        'hy_conv_w': nrm(22, (DEPTH, 3, 3 * HY_WIDTH), 3.0 ** -0.5),
        'hy_conv_b': nrm(23, (DEPTH, 3 * HY_WIDTH), 0.02),
        'hy_w1': nrm(24, (DEPTH, HY_EMB, HY_HIDDEN), HY_EMB ** -0.5),
        'hy_b1': nrm(25, (DEPTH, HY_HIDDEN), 0.1),
        'hy_w2': nrm(26, (DEPTH, HY_HIDDEN, HY_HIDDEN), HY_HIDDEN ** -0.5),
        'hy_b2': nrm(27, (DEPTH, HY_HIDDEN), 0.1),
        'hy_freq': 1.0 + nrm(28, (DEPTH, 2, HY_HIDDEN), 0.02),
        'hy_w3': nrm(29, (DEPTH, HY_HIDDEN, 2 * HY_ORDER * HY_WIDTH), HY_HIDDEN ** -0.5),
        'hy_bias': nrm(30, (DEPTH, HY_ORDER, HY_WIDTH), 1.0),
        'w_hy_o': nrm(31, (DEPTH, HY_WIDTH, D_MODEL), HY_WIDTH ** -0.5),
        'w_out': nrm(32, (DEPTH, D_MODEL, D_MODEL), D_MODEL ** -0.5),
        'w_ffn_in': nrm(33, (DEPTH, D_MODEL, 2 * D_FF), D_MODEL ** -0.5),
        'w_ffn_out': nrm(34, (DEPTH, D_FF, D_MODEL), D_FF ** -0.5),
        'norm_f': 1.0 + nrm(35, (D_MODEL,), 0.02),
    }


def reference(x_prompt, x_sample, state_s5, state_ret, c, c_ctx, w_mod, b_mod, norm1, norm2, w_in,
              s5_lam_re, s5_lam_im, s5_log_dt, s5_b_re, s5_b_im, s5_c_re, s5_c_im, s5_d, w_s5_glu,
              ret_decay, w_ret_o, hy_conv_w, hy_conv_b, hy_w1, hy_b1, hy_w2, hy_b2, hy_freq, hy_w3, hy_bias,
              w_hy_o, w_out, w_ffn_in, w_ffn_out, norm_f):
    cond_ctx = jax.nn.silu(c_ctx)[None, :]
    cond_lat = jax.nn.silu(c)
    s5_cache = lax.complex(state_s5[..., 0].astype(F32), state_s5[..., 1].astype(F32))
    ret_cache = state_ret.astype(F32)
    xp, xs = x_prompt, x_sample
    s5_states, ret_states = [], []
    for l in range(DEPTH):
        lp = {
            'w_mod': w_mod[l], 'b_mod': b_mod[l], 'norm1': norm1[l], 'norm2': norm2[l], 'w_in': w_in[l],
            's5_lam_re': s5_lam_re[l], 's5_lam_im': s5_lam_im[l], 's5_log_dt': s5_log_dt[l],
            's5_b_re': s5_b_re[l], 's5_b_im': s5_b_im[l], 's5_c_re': s5_c_re[l], 's5_c_im': s5_c_im[l],
            's5_d': s5_d[l], 'w_s5_glu': w_s5_glu[l], 'ret_decay': ret_decay[l], 'w_ret_o': w_ret_o[l],
            'hy_conv_w': hy_conv_w[l], 'hy_conv_b': hy_conv_b[l], 'hy_w1': hy_w1[l], 'hy_b1': hy_b1[l],
            'hy_w2': hy_w2[l], 'hy_b2': hy_b2[l], 'hy_freq': hy_freq[l], 'hy_w3': hy_w3[l],
            'hy_bias': hy_bias[l], 'w_hy_o': w_hy_o[l], 'w_out': w_out[l],
            'w_ffn_in': w_ffn_in[l], 'w_ffn_out': w_ffn_out[l],
        }
        xp, s5_st, ret_st = _layer(xp, cond_ctx, lp, False, None, None)
        s5_states.append(s5_st)
        ret_states.append(ret_st)
        xs, _, _ = _layer(xs, cond_lat, lp, True, s5_cache[:, l], ret_cache[:, l])
    y_prompt = _rms_norm(xp, norm_f)
    y_sample = _rms_norm(xs, norm_f)
    s5_new = jnp.stack(s5_states, axis=1)
    new_state_s5 = jnp.stack([jnp.real(s5_new), jnp.imag(s5_new)], axis=-1).astype(x_prompt.dtype)
    new_state_ret = jnp.stack(ret_states, axis=1).astype(x_prompt.dtype)
    return (y_prompt, y_sample, new_state_s5, new_state_ret)
```

```cpp
#include <hip/hip_runtime.h>
#include <hip/hip_cooperative_groups.h>
#include <cstdio>
namespace cg = cooperative_groups;

#ifndef MULTI
#define MULTI 0
#endif

typedef unsigned short u16;
using bf16x8 = __attribute__((ext_vector_type(8))) short;
using f32x4 = __attribute__((ext_vector_type(4))) float;
using u32x4 = __attribute__((ext_vector_type(4))) unsigned;
using u32x2 = __attribute__((ext_vector_type(2))) unsigned;
#define DEV __device__ __forceinline__

constexpr int MT = 12288;
constexpr size_t OFF_WT = 0;
constexpr int WIN_O = 0, WGLU_O = 7340032, WRETO_O = 8388608, WHYO_O = 8912896, WOUT_O = 9437184, WFIN_O = 10485760, WFOUT_O = 16252928;
constexpr size_t OFF_G = 38273024;
constexpr size_t OFF_H = 48758784;
constexpr size_t OFF_ZA = 73924608;
constexpr size_t OFF_HYZ = 124256256;
constexpr size_t OFF_VT = 162004992;
constexpr size_t OFF_KT = 174587904;
constexpr size_t OFF_QR = 182976512;
constexpr size_t OFF_YP = 187170816;
constexpr size_t OFF_OUT1 = 212336640;
constexpr size_t OFF_MOD = 237502464;
constexpr size_t OFF_SUMSQ = OFF_MOD + 245760;
constexpr size_t OFF_BAR = OFF_SUMSQ + 16384;
constexpr size_t ZERO_BYTES = 245760 + 16384 + 16384;
constexpr size_t OFF_LAMBAR = OFF_BAR + 16384;
constexpr size_t OFF_BBAR = OFF_LAMBAR + 65536;
constexpr size_t OFF_CM = OFF_BBAR + 524288;
constexpr size_t OFF_ROPE = OFF_CM + 524288;
constexpr size_t OFF_S0T = OFF_ROPE + 524288;
constexpr size_t WS_END = OFF_S0T + 2097152;

struct Params {
  const float* in[36];
  float* out;
  char* ws;
};


DEV int TID() { int t = threadIdx.x; asm volatile("" : "+v"(t)); return t; }
DEV int BID() { int t = blockIdx.x; asm volatile("" : "+s"(t)); return t; }
DEV char* WS(const Params& p) { char* w = p.ws; asm volatile("" : "+s"(w)); return w; }
DEV float* OUTP(const Params& p) { float* w = p.out; asm volatile("" : "+s"(w)); return w; }
DEV const float* INP(const Params& p, int i) { const float* w = p.in[i]; asm volatile("" : "+s"(w)); return w; }

DEV u16 f2bf(float f) { unsigned u = __float_as_uint(f); u += 0x7fffu + ((u >> 16) & 1u); return (u16)(u >> 16); }
DEV float bf2f(u16 h) { return __uint_as_float(((unsigned)h) << 16); }
DEV float sigm(float x) { return 1.f / (1.f + __expf(-x)); }
DEV float silu_(float x) { return x / (1.f + __expf(-x)); }
DEV float gelu_(float x) { float u = 0.7978845608028654f * (x + 0.044715f * x * x * x); return 0.5f * x * (1.f + tanhf(u)); }
DEV unsigned pack2(float a, float b) { return (unsigned)f2bf(a) | ((unsigned)f2bf(b) << 16); }

DEV const float* xin_row(const Params& p, int row) { return row < 8192 ? INP(p, 0) + (size_t)row * 1024 : INP(p, 1) + (size_t)(row - 8192) * 1024; }
DEV int modidx(int row) { return row < 8192 ? 0 : 1 + ((row - 8192) >> 10); }

template <int NF>
DEV void gemm_loop(const u16* __restrict__ A, int lda, const u16* __restrict__ B, int ldb, int K, f32x4 (&acc)[4][NF], u16* sA, u16* sB) {
  const int tid = TID(), lane = tid & 63, wid = tid >> 6, wr = wid >> 1, wc = wid & 1, fr = lane & 15, fq = lane >> 4;
  constexpr int NB = NF;
  u32x4 ra[4], rb[NB];
  const int crow = tid >> 3, ccol = (tid & 7) * 8;
  const u16* Ap = A + (size_t)crow * lda + ccol;
  const u16* Bp = B + (size_t)crow * ldb + ccol;
#pragma unroll
  for (int i = 0; i < 4; i++) ra[i] = *(const u32x4*)(Ap + (size_t)(i * 32) * lda);
#pragma unroll
  for (int i = 0; i < NB; i++) rb[i] = *(const u32x4*)(Bp + (size_t)(i * 32) * ldb);
  for (int k0 = 0; k0 < K; k0 += 64) {
    __syncthreads();
#pragma unroll
    for (int i = 0; i < 4; i++) *(u32x4*)(sA + (crow + i * 32) * 72 + ccol) = ra[i];
#pragma unroll
    for (int i = 0; i < NB; i++) *(u32x4*)(sB + (crow + i * 32) * 72 + ccol) = rb[i];
    __syncthreads();
    if (k0 + 64 < K) {
#pragma unroll
      for (int i = 0; i < 4; i++) ra[i] = *(const u32x4*)(Ap + (size_t)(i * 32) * lda + k0 + 64);
#pragma unroll
      for (int i = 0; i < NB; i++) rb[i] = *(const u32x4*)(Bp + (size_t)(i * 32) * ldb + k0 + 64);
    }
#pragma unroll
    for (int ks = 0; ks < 2; ks++) {
      bf16x8 af[4], bv[NF];
#pragma unroll
      for (int m = 0; m < 4; m++) af[m] = *(const bf16x8*)(sA + (wr * 64 + m * 16 + fr) * 72 + ks * 32 + fq * 8);
#pragma unroll
      for (int n = 0; n < NF; n++) bv[n] = *(const bf16x8*)(sB + (wc * (NF * 16) + n * 16 + fr) * 72 + ks * 32 + fq * 8);
#pragma unroll
      for (int m = 0; m < 4; m++)
#pragma unroll
        for (int n = 0; n < NF; n++) acc[m][n] = __builtin_amdgcn_mfma_f32_16x16x32_bf16(af[m], bv[n], acc[m][n], 0, 0, 0);
    }
  }
}

template <int NF>
DEV void zero_acc(f32x4 (&acc)[4][NF]) {
#pragma unroll
  for (int m = 0; m < 4; m++)
#pragma unroll
    for (int n = 0; n < NF; n++) acc[m][n] = f32x4{0.f, 0.f, 0.f, 0.f};
}

template <int NF, int TS>
DEV void acc_to_lds(const f32x4 (&acc)[4][NF], u16* T) {
  const int tid = TID(), lane = tid & 63, wid = tid >> 6, wr = wid >> 1, wc = wid & 1, fr = lane & 15, fq = lane >> 4;
#pragma unroll
  for (int m = 0; m < 4; m++)
#pragma unroll
    for (int n = 0; n < NF; n++)
#pragma unroll
      for (int j = 0; j < 4; j++) T[(wr * 64 + m * 16 + fq * 4 + j) * TS + wc * (NF * 16) + n * 16 + fr] = f2bf(acc[m][n][j]);
}
DEV void acc_to_lds_T(const f32x4 (&acc)[4][4], u16* T) {
  const int tid = TID(), lane = tid & 63, wid = tid >> 6, wr = wid >> 1, wc = wid & 1, fr = lane & 15, fq = lane >> 4;
#pragma unroll
  for (int m = 0; m < 4; m++)
#pragma unroll
    for (int n = 0; n < 4; n++) {
      u32x2 v; v.x = pack2(acc[m][n][0], acc[m][n][1]); v.y = pack2(acc[m][n][2], acc[m][n][3]);
      *(u32x2*)(T + (wc * 64 + n * 16 + fr) * 136 + wr * 64 + m * 16 + fq * 4) = v;
    }
}
template <int COLS, int TS>
DEV void copy_tile(const u16* T, u16* dst, int ld) {
  constexpr int CPR = COLS / 8;
  constexpr int NIT = 128 * CPR / 256;
#pragma unroll
  for (int i = 0; i < NIT; i++) {
    int id = TID() + i * 256; int r = id / CPR, ch = id % CPR;
    *(u32x4*)(dst + (size_t)r * ld + ch * 8) = *(const u32x4*)(T + r * TS + ch * 8);
  }
}

DEV void transpose_tile(const float* __restrict__ src, int K, int N, u16* __restrict__ dst, int tile, float* sm) {
  int nk = K >> 6; int tk = tile % nk, tn = tile / nk; int k0 = tk * 64, n0 = tn * 64;
  int tx = TID() & 63, ty = TID() >> 6;
  __syncthreads();
#pragma unroll
  for (int i = 0; i < 16; i++) { int k = ty + i * 4; sm[k * 65 + tx] = src[(size_t)(k0 + k) * N + n0 + tx]; }
  __syncthreads();
#pragma unroll
  for (int i = 0; i < 16; i++) { int n = ty + i * 4; dst[(size_t)(n0 + n) * K + k0 + tx] = f2bf(sm[tx * 65 + n]); }
}

DEV void wt_task(const Params& p, int l, int t, float* sm) {
  u16* WT = (u16*)(WS(p) + OFF_WT);
  const float* src; int K, N, off, tt;
  if (t < 1792) { src = INP(p, 10) + (size_t)l * 1024 * 7168; K = 1024; N = 7168; off = WIN_O; tt = t; }
  else if (t < 2048) { src = INP(p, 19) + (size_t)l * 512 * 2048; K = 512; N = 2048; off = WGLU_O; tt = t - 1792; }
  else if (t < 2176) { src = INP(p, 21) + (size_t)l * 512 * 1024; K = 512; N = 1024; off = WRETO_O; tt = t - 2048; }
  else if (t < 2304) { src = INP(p, 31) + (size_t)l * 512 * 1024; K = 512; N = 1024; off = WHYO_O; tt = t - 2176; }
  else if (t < 2560) { src = INP(p, 32) + (size_t)l * 1024 * 1024; K = 1024; N = 1024; off = WOUT_O; tt = t - 2304; }
  else if (t < 3968) { src = INP(p, 33) + (size_t)l * 1024 * 5632; K = 1024; N = 5632; off = WFIN_O; tt = t - 2560; }
  else { src = INP(p, 34) + (size_t)l * 2816 * 1024; K = 2816; N = 1024; off = WFOUT_O; tt = t - 3968; }
  transpose_tile(src, K, N, WT + off, tt, sm);
}

DEV void mod_task(const Params& p, int task, float* sm) {
  int kc = task & 7; int cb = (task >> 3) % 24; int l = task / 192;
  int tid = TID();
  __syncthreads();
  for (int i = tid; i < 640; i += 256) {
    int j = i >> 7, k = kc * 128 + (i & 127);
    float c = (j == 0) ? INP(p, 5)[k] : INP(p, 4)[(j - 1) * 1024 + k];
    sm[i] = silu_(c);
  }
  __syncthreads();
  int col = cb * 256 + tid;
  const float* w = INP(p, 6) + (size_t)l * 1024 * 6144 + (size_t)(kc * 128) * 6144 + col;
  float a0 = 0, a1 = 0, a2 = 0, a3 = 0, a4 = 0;
#pragma unroll 8
  for (int k = 0; k < 128; k++) {
    float wv = w[(size_t)k * 6144];
    a0 += sm[k] * wv; a1 += sm[128 + k] * wv; a2 += sm[256 + k] * wv; a3 += sm[384 + k] * wv; a4 += sm[512 + k] * wv;
  }
  float* MOD = (float*)(WS(p) + OFF_MOD);
  atomicAdd(&MOD[(l * 5 + 0) * 6144 + col], a0);
  atomicAdd(&MOD[(l * 5 + 1) * 6144 + col], a1);
  atomicAdd(&MOD[(l * 5 + 2) * 6144 + col], a2);
  atomicAdd(&MOD[(l * 5 + 3) * 6144 + col], a3);
  atomicAdd(&MOD[(l * 5 + 4) * 6144 + col], a4);
}

DEV void filt_task(const Params& p, int l, int task, float* sm) {
  int Lsel = task >= 32; int tb = Lsel ? task - 32 : task; int L = Lsel ? 1024 : 256; int t0 = tb * 8;
  int tid = TID();
  float* z = sm; float* h1 = sm + 264; float* h2 = sm + 264 + 512;
  const float* w1 = INP(p, 24) + l * 33 * 64; const float* b1 = INP(p, 25) + l * 64;
  const float* w2 = INP(p, 26) + l * 64 * 64; const float* b2 = INP(p, 27) + l * 64;
  const float* fr0 = INP(p, 28) + l * 128; const float* fr1 = fr0 + 64;
  const float* w3 = INP(p, 29) + (size_t)l * 64 * 2048;
  __syncthreads();
  for (int i = tid; i < 264; i += 256) {
    int tt = i / 33, e = i % 33; float t = (float)(t0 + tt); float v;
    if (e == 0) v = t / (float)L;
    else {
      int b = (e - 1) & 15; float band = 1e-4f + (float)b * ((15.f - 1e-4f) / 15.f);
      float ang = (6.283185307179586f / (float)L) * t * band;
      v = (e <= 16) ? cosf(ang) : -sinf(ang);
    }
    z[i] = v;
  }
  __syncthreads();
  for (int i = tid; i < 512; i += 256) {
    int tt = i >> 6, j = i & 63; float s = b1[j];
    for (int e = 0; e < 33; e++) s += z[tt * 33 + e] * w1[e * 64 + j];
    h1[i] = sinf(fr0[j] * s);
  }
  __syncthreads();
  for (int i = tid; i < 512; i += 256) {
    int tt = i >> 6, j = i & 63; float s = b2[j];
    for (int e = 0; e < 64; e++) s += h1[tt * 64 + e] * w2[e * 64 + j];
    h2[i] = sinf(fr1[j] * s);
  }
  __syncthreads();
  float* G = (float*)(WS(p) + OFF_G) + (Lsel ? 524288 : 0);
  float* SUMSQ = (float*)(WS(p) + OFF_SUMSQ);
  for (int m = 0; m < 8; m++) {
    int col = tid + m * 256;
    float acc[8];
#pragma unroll
    for (int tt = 0; tt < 8; tt++) acc[tt] = 0.f;
    for (int j = 0; j < 64; j++) {
      float w = w3[j * 2048 + col];
#pragma unroll
      for (int tt = 0; tt < 8; tt++) acc[tt] += h2[tt * 64 + j] * w;
    }
    int dir = col >> 10, o = (col >> 9) & 1, c = col & 511;
    float rate = 3.0701134573253944f + (float)c * ((15.350567286626972f - 3.0701134573253944f) / 511.f);
    float ss = 0.f;
    float* Go = G + (size_t)o * (2 * L) * 512 + c;
#pragma unroll
    for (int tt = 0; tt < 8; tt++) {
      int t = t0 + tt;
      float val = acc[tt] * expf(-((float)t / (float)L) * rate);
      if (dir == 0) { Go[(size_t)(L + t) * 512] = val; ss += val * val; }
      else if (t > 0) { Go[(size_t)(L - t) * 512] = val; ss += val * val; }
      else { Go[0] = 0.f; }
    }
    atomicAdd(&SUMSQ[((l * 2 + Lsel) * 2 + o) * 512 + c], ss);
  }
}

DEV void s5prep_task(const Params& p, int task) {
  int idx = task * 256 + TID();
  int pp = idx & 63; int lrg = idx >> 6;
  float lre = INP(p, 11)[idx], lim = INP(p, 12)[idx];
  float dt = expf(INP(p, 13)[lrg]);
  float mag = expf(lre * dt);
  float lbr = mag * cosf(lim * dt), lbi = mag * sinf(lim * dt);
  float nr = lbr - 1.f, ni = lbi; float den = lre * lre + lim * lim;
  float cr = (nr * lre + ni * lim) / den, ci = (ni * lre - nr * lim) / den;
  u16* BBAR = (u16*)(WS(p) + OFF_BBAR); u16* CM = (u16*)(WS(p) + OFF_CM); float* LB = (float*)(WS(p) + OFF_LAMBAR);
  LB[idx * 2] = lbr; LB[idx * 2 + 1] = lbi;
  for (int c = 0; c < 16; c++) {
    float br = INP(p, 14)[(size_t)idx * 16 + c], bi = INP(p, 15)[(size_t)idx * 16 + c];
    BBAR[(size_t)lrg * 2048 + pp * 16 + c] = f2bf(cr * br - ci * bi);
    BBAR[(size_t)lrg * 2048 + (64 + pp) * 16 + c] = f2bf(cr * bi + ci * br);
    CM[(size_t)lrg * 2048 + c * 128 + pp] = f2bf(INP(p, 16)[(size_t)lrg * 1024 + c * 64 + pp]);
    CM[(size_t)lrg * 2048 + c * 128 + 64 + pp] = f2bf(-INP(p, 17)[(size_t)lrg * 1024 + c * 64 + pp]);
  }
}

DEV void rope_task(const Params& p, int task) {
  int idx = task * 256 + TID(); int t = idx >> 6, d = idx & 63; int f = d & 31;
  float inv = powf(10000.f, -(float)f / 32.f);
  float pos = (d < 32) ? (float)(t >> 6) : (float)(t & 63);
  float ang = pos * inv;
  float* R = (float*)(WS(p) + OFF_ROPE);
  R[idx * 2] = cosf(ang); R[idx * 2 + 1] = sinf(ang);
}

DEV void layer_prep(const Params& p, int l, char* smem) {
  for (int t = BID(); t < 4672 + 160; t += gridDim.x) {
    if (t < 4672) wt_task(p, l, t, (float*)smem);
    else filt_task(p, l, t - 4672, (float*)smem);
  }
}
DEV void phaseA(const Params& p, char* smem) {
  for (int t = BID(); t < 384 + 32 + 256 + 256; t += gridDim.x) {
    if (t < 384) mod_task(p, t, (float*)smem);
    else if (t < 416) s5prep_task(p, t - 384);
    else if (t < 672) rope_task(p, t - 416);
    else { int tt = t - 672; int mi = tt >> 2; transpose_tile(INP(p, 3) + (size_t)mi * 16384, 128, 128, (u16*)(WS(p) + OFF_S0T) + (size_t)mi * 16384, tt & 3, (float*)smem); }
  }
  layer_prep(p, 0, smem);
}

DEV void norm_phase(const Params& p, int l, int which) {
  const int lane = TID() & 63;
  const int wave = (BID() * blockDim.x + TID()) >> 6, nw = (gridDim.x * blockDim.x) >> 6;
  u16* H = (u16*)(WS(p) + OFF_H);
  const float* MOD = (const float*)(WS(p) + OFF_MOD);
  for (int row = wave; row < MT; row += nw) {
    const float* x = (l == 0 && which == 0) ? xin_row(p, row) : OUTP(p) + (size_t)row * 1024;
    float4 v[4]; float ss = 0.f;
#pragma unroll
    for (int i = 0; i < 4; i++) { v[i] = *(const float4*)(x + i * 256 + lane * 4); ss += v[i].x * v[i].x + v[i].y * v[i].y + v[i].z * v[i].z + v[i].w * v[i].w; }
#pragma unroll
    for (int o = 32; o > 0; o >>= 1) ss += __shfl_xor(ss, o, 64);
    float rinv = rsqrtf(ss * (1.f / 1024.f) + 1e-6f);
    if (which == 2) {
      const float* nf = INP(p, 35);
#pragma unroll
      for (int i = 0; i < 4; i++) {
        float4 g = *(const float4*)(nf + i * 256 + lane * 4);
        float4 o; o.x = v[i].x * rinv * g.x; o.y = v[i].y * rinv * g.y; o.z = v[i].z * rinv * g.z; o.w = v[i].w * rinv * g.w;
        *(float4*)(OUTP(p) + (size_t)row * 1024 + i * 256 + lane * 4) = o;
      }
    } else {
      int j = modidx(row);
      const float* nwt = (which == 0 ? INP(p, 8) : INP(p, 9)) + l * 1024;
      const float* msh = MOD + (l * 5 + j) * 6144 + (which ? 3 : 0) * 1024;
      const float* msc = msh + 1024;
      const float* bsh = INP(p, 7) + l * 6144 + (which ? 3 : 0) * 1024;
      const float* bsc = bsh + 1024;
#pragma unroll
      for (int i = 0; i < 4; i++) {
        int k = i * 256 + lane * 4;
        float4 g = *(const float4*)(nwt + k);
        float4 sh = *(const float4*)(msh + k), sc = *(const float4*)(msc + k);
        float4 bh = *(const float4*)(bsh + k), bc = *(const float4*)(bsc + k);
        float o0 = v[i].x * rinv * g.x * (1.f + sc.x + bc.x) + sh.x + bh.x;
        float o1 = v[i].y * rinv * g.y * (1.f + sc.y + bc.y) + sh.y + bh.y;
        float o2 = v[i].z * rinv * g.z * (1.f + sc.z + bc.z) + sh.z + bh.z;
        float o3 = v[i].w * rinv * g.w * (1.f + sc.w + bc.w) + sh.w + bh.w;
        u32x2 pk; pk.x = pack2(o0, o1); pk.y = pack2(o2, o3);
        *(u32x2*)(H + (size_t)row * 1024 + k) = pk;
      }
    }
  }
}

DEV void phaseC(const Params& p, int l, char* smem) {
  u16* sA = (u16*)smem; u16* sB = sA + 128 * 72; u16* T = (u16*)smem;
  const u16* H = (const u16*)(WS(p) + OFF_H);
  const u16* WIN = (const u16*)(WS(p) + OFF_WT) + WIN_O;
  u16* ZA = (u16*)(WS(p) + OFF_ZA); u16* HYZ = (u16*)(WS(p) + OFF_HYZ); u16* VT = (u16*)(WS(p) + OFF_VT);
  u16* KT = (u16*)(WS(p) + OFF_KT); u16* QR = (u16*)(WS(p) + OFF_QR);
  const float* ROPE = (const float*)(WS(p) + OFF_ROPE);
  const int tid = TID();
  for (int tile = BID(); tile < 96 * 32; tile += gridDim.x) {
    int tm = tile >> 5, tn = tile & 31;
    f32x4 acc[4][4]; zero_acc<4>(acc);
    gemm_loop<4>(H + (size_t)tm * 128 * 1024, 1024, WIN + (size_t)tn * 128 * 1024, 1024, 1024, acc, sA, sB);
    __syncthreads();
    int row0 = tm * 128; bool lat = row0 >= 8192;
    int kind = tn >> 2, hd = tn & 3;
    int seq, t0, L;
    if (!lat) { seq = row0 >> 8; t0 = row0 & 255; L = 256; } else { seq = (row0 - 8192) >> 10; t0 = (row0 - 8192) & 1023; L = 1024; }
    if (kind == 2) {
#pragma unroll
      for (int m = 0; m < 4; m++)
#pragma unroll
        for (int n = 0; n < 4; n++) acc[m][n] *= 0.08838834764831845f;
    } else if (kind == 4) {
#pragma unroll
      for (int m = 0; m < 4; m++)
#pragma unroll
        for (int n = 0; n < 4; n++)
#pragma unroll
          for (int j = 0; j < 4; j++) acc[m][n][j] = silu_(acc[m][n][j]);
    }
    if (kind == 3) {
      acc_to_lds_T(acc, T);
      __syncthreads();
      u16* dst = lat ? VT + (size_t)8192 * 512 + (size_t)((seq * 4 + hd) * 128) * 1024 + t0 : VT + (size_t)((seq * 4 + hd) * 128) * 256 + t0;
      copy_tile<128, 136>(T, dst, L);
    } else {
      acc_to_lds<4, 136>(acc, T);
      __syncthreads();
      bool roped = lat && (kind == 1 || kind == 2);
      if (!(lat && kind == 2)) {
        u16* dst;
        if (kind == 0) dst = ZA + (size_t)row0 * 2048 + hd * 128;
        else if (kind == 1) dst = ZA + (size_t)row0 * 2048 + 512 + hd * 128;
        else if (kind == 2) dst = ZA + (size_t)row0 * 2048 + 1024 + hd * 128;
        else if (kind == 4) dst = ZA + (size_t)row0 * 2048 + 1536 + hd * 128;
        else dst = HYZ + (size_t)row0 * 1536 + (tn - 20) * 128;
        copy_tile<128, 136>(T, dst, kind >= 5 ? 1536 : 2048);
      }
      if (roped) {
        u16* dst; int ld;
        if (kind == 1) { dst = QR + (size_t)(row0 - 8192) * 512 + hd * 128; ld = 512; }
        else { dst = ZA + (size_t)row0 * 2048 + 1024 + hd * 128; ld = 2048; }
#pragma unroll
        for (int i = 0; i < 4; i++) {
          int id = tid + i * 256; int r = id >> 3, ch = id & 7;
          u32x4 a = *(const u32x4*)(T + r * 136 + ch * 8);
          u32x4 b = *(const u32x4*)(T + r * 136 + 64 + ch * 8);
          const float4* cs = (const float4*)(ROPE + ((size_t)(t0 + r) * 64 + ch * 8) * 2);
          u32x4 o1, o2;
#pragma unroll
          for (int q = 0; q < 4; q++) {
            float4 c4 = cs[q];
            float x1a = __uint_as_float(a[q] << 16), x1b = __uint_as_float(a[q] & 0xffff0000u);
            float x2a = __uint_as_float(b[q] << 16), x2b = __uint_as_float(b[q] & 0xffff0000u);
            o1[q] = pack2(x1a * c4.x - x2a * c4.y, x1b * c4.z - x2b * c4.w);
            o2[q] = pack2(x1a * c4.y + x2a * c4.x, x1b * c4.w + x2b * c4.z);
          }
          *(u32x4*)(dst + (size_t)r * ld + ch * 8) = o1;
          *(u32x4*)(dst + (size_t)r * ld + 64 + ch * 8) = o2;
        }
      }
      if (kind == 2 && !lat) {
        __syncthreads();
        acc_to_lds_T(acc, T);
        __syncthreads();
        copy_tile<128, 136>(T, KT + (size_t)((seq * 4 + hd) * 128) * 256 + t0, 256);
      }
    }
  }
}

DEV void s5_task(const Params& p, int l, int task, char* smem) {
  const int tid = TID(), lane = tid & 63, wid = tid >> 6, fr = lane & 15, fq = lane >> 4;
  int seq, gp;
  if (task < 64) { seq = 32 + (task >> 4); gp = task & 15; } else { int t2 = task - 64; seq = t2 >> 4; gp = t2 & 15; }
  const bool lat = seq >= 32;
  const int L = lat ? 1024 : 256;
  const int row0 = lat ? 8192 + (seq - 32) * 1024 : seq * 256;
  const int grp = gp * 2 + (wid >> 1), dir = wid & 1;
  const int lrg = (l * 2 + dir) * 32 + grp;
  float* BU = (float*)(smem + wid * 12544);
  u16* HB = (u16*)(smem + wid * 12544 + 8192);
  u16* ZA = (u16*)(WS(p) + OFF_ZA);
  float* YP = (float*)(WS(p) + OFF_YP);
  const u16* BBAR = (const u16*)(WS(p) + OFF_BBAR) + (size_t)lrg * 2048;
  const u16* CM = (const u16*)(WS(p) + OFF_CM) + (size_t)lrg * 2048;
  const float* LB = (const float*)(WS(p) + OFF_LAMBAR) + ((size_t)lrg * 64 + lane) * 2;
  const float lr = LB[0], li = LB[1];
  bf16x8 bfrag[8], cfrag[4];
  const bf16x8 zero8 = {0, 0, 0, 0, 0, 0, 0, 0};
#pragma unroll
  for (int nt = 0; nt < 8; nt++) bfrag[nt] = (fq < 2) ? *(const bf16x8*)(BBAR + (nt * 16 + fr) * 16 + fq * 8) : zero8;
#pragma unroll
  for (int ks = 0; ks < 4; ks++) cfrag[ks] = *(const bf16x8*)(CM + fr * 128 + ks * 32 + fq * 8);
  float hr = 0.f, hi = 0.f;
  if (lat) {
    const float* s0 = INP(p, 2) + ((((size_t)(seq - 32) * 2 + l) * 2 + dir) * 32 + grp) * 128 + lane * 2;
    hr = s0[0]; hi = s0[1];
  }
  const float dcoef = INP(p, 18)[l * 512 + grp * 16 + fr];
  const int nch = L >> 4;
  __syncthreads();
  for (int i = 0; i < nch; i++) {
    const int ci = dir ? nch - 1 - i : i; const int t0 = ci * 16;
    if (i == (nch >> 1)) { __threadfence(); __syncthreads(); }
    bf16x8 ua = (fq < 2) ? *(const bf16x8*)(ZA + (size_t)(row0 + t0 + fr) * 2048 + grp * 16 + fq * 8) : zero8;
#pragma unroll
    for (int nt = 0; nt < 8; nt++) {
      f32x4 r = __builtin_amdgcn_mfma_f32_16x16x32_bf16(ua, bfrag[nt], f32x4{0.f, 0.f, 0.f, 0.f}, 0, 0, 0);
#pragma unroll
      for (int j = 0; j < 4; j++) BU[(fq * 4 + j) * 128 + nt * 16 + fr] = r[j];
    }
    asm volatile("s_waitcnt lgkmcnt(0)" ::: "memory");
#pragma unroll
    for (int tt = 0; tt < 16; tt++) {
      const int t = dir ? 15 - tt : tt;
      float re = BU[t * 128 + lane], im = BU[t * 128 + 64 + lane];
      float nr = lr * hr - li * hi + re; float ni = lr * hi + li * hr + im;
      hr = nr; hi = ni;
      HB[t * 136 + lane] = f2bf(hr); HB[t * 136 + 64 + lane] = f2bf(hi);
    }
    asm volatile("s_waitcnt lgkmcnt(0)" ::: "memory");
    f32x4 y = {0.f, 0.f, 0.f, 0.f};
#pragma unroll
    for (int ks = 0; ks < 4; ks++) {
      bf16x8 a = *(const bf16x8*)(HB + fr * 136 + ks * 32 + fq * 8);
      y = __builtin_amdgcn_mfma_f32_16x16x32_bf16(a, cfrag[ks], y, 0, 0, 0);
    }
    asm volatile("s_waitcnt lgkmcnt(0)" ::: "memory");
    if (i < (nch >> 1)) {
#pragma unroll
      for (int j = 0; j < 4; j++) YP[(size_t)(row0 + t0 + fq * 4 + j) * 512 + grp * 16 + fr] = y[j];
    } else {
#pragma unroll
      for (int j = 0; j < 4; j++) {
        size_t row = (size_t)(row0 + t0 + fq * 4 + j);
        float other = __hip_atomic_load(&YP[row * 512 + grp * 16 + fr], __ATOMIC_RELAXED, __HIP_MEMORY_SCOPE_AGENT);
        u16* up = ZA + row * 2048 + grp * 16 + fr;
        float u = bf2f(*up);
        float v = y[j] + other + dcoef * u;
        *up = f2bf(gelu_(v));
      }
    }
  }
  if (!lat) {
    float* o = OUTP(p) + 12582912 + ((((size_t)seq * 2 + l) * 2 + dir) * 32 + grp) * 128 + lane * 2;
    o[0] = hr; o[1] = hi;
  }
}

DEV void ret_task(const Params& p, int l, int task, char* smem) {
  const int tid = TID(), lane = tid & 63, wid = tid >> 6, fr = lane & 15, fq = lane >> 4;
  int seq, h, qt; bool lat;
  if (task < 256) { lat = true; seq = task >> 6; h = (task >> 4) & 3; qt = task & 15; }
  else { int t2 = task - 256; lat = false; seq = t2 >> 4; h = (t2 >> 2) & 3; qt = t2 & 3; }
  const int L = lat ? 1024 : 256;
  const int row0 = lat ? 8192 + seq * 1024 : seq * 256;
  u16* sK = (u16*)smem; u16* sV = sK + 64 * 136; u16* sP = sV + 128 * 72 + wid * 16 * 72;
  u16* ZA = (u16*)(WS(p) + OFF_ZA);
  const u16* QR = (const u16*)(WS(p) + OFF_QR);
  const u16* VT = (const u16*)(WS(p) + OFF_VT);
  const float lgf = log1pf(-expf(INP(p, 20)[(l * 2 + 0) * 4 + h])), lgb = log1pf(-expf(INP(p, 20)[(l * 2 + 1) * 4 + h]));
  const int qrow = qt * 64 + wid * 16;
  const u16* qsrc = lat ? QR + (size_t)(row0 - 8192 + qrow + fr) * 512 + h * 128 : ZA + (size_t)(row0 + qrow + fr) * 2048 + 512 + h * 128;
  bf16x8 qa[4];
#pragma unroll
  for (int ks = 0; ks < 4; ks++) qa[ks] = *(const bf16x8*)(qsrc + ks * 32 + fq * 8);
  f32x4 o[8];
#pragma unroll
  for (int n = 0; n < 8; n++) o[n] = f32x4{0.f, 0.f, 0.f, 0.f};
  const u16* Kbase = ZA + (size_t)row0 * 2048 + 1024 + h * 128;
  const u16* Vbase = lat ? VT + (size_t)8192 * 512 + (size_t)((seq * 4 + h) * 128) * 1024 : VT + (size_t)((seq * 4 + h) * 128) * 256;
  const int nkt = L >> 6;
  for (int jt = 0; jt < nkt; jt++) {
    __syncthreads();
#pragma unroll
    for (int i = 0; i < 4; i++) {
      int id = tid + i * 256; int r = id >> 4, ch = id & 15;
      *(u32x4*)(sK + r * 136 + ch * 8) = *(const u32x4*)(Kbase + (size_t)(jt * 64 + r) * 2048 + ch * 8);
    }
#pragma unroll
    for (int i = 0; i < 4; i++) {
      int id = tid + i * 256; int e = id >> 3, ch = id & 7;
      *(u32x4*)(sV + e * 72 + ch * 8) = *(const u32x4*)(Vbase + (size_t)e * L + jt * 64 + ch * 8);
    }
    __syncthreads();
    f32x4 s[4];
#pragma unroll
    for (int nt = 0; nt < 4; nt++) {
      s[nt] = f32x4{0.f, 0.f, 0.f, 0.f};
#pragma unroll
      for (int ks = 0; ks < 4; ks++) {
        bf16x8 b = *(const bf16x8*)(sK + (nt * 16 + fr) * 136 + ks * 32 + fq * 8);
        s[nt] = __builtin_amdgcn_mfma_f32_16x16x32_bf16(qa[ks], b, s[nt], 0, 0, 0);
      }
      asm volatile("" ::: "memory");
    }
#pragma unroll
    for (int nt = 0; nt < 4; nt++)
#pragma unroll
      for (int j = 0; j < 4; j++) {
        int d = (qrow + fq * 4 + j) - (jt * 64 + nt * 16 + fr);
        float w = d >= 0 ? __expf(lgf * (float)d) : __expf(lgb * (float)(-d));
        sP[(fq * 4 + j) * 72 + nt * 16 + fr] = f2bf(s[nt][j] * w);
      }
    asm volatile("s_waitcnt lgkmcnt(0)" ::: "memory");
#pragma unroll
    for (int k2 = 0; k2 < 2; k2++) {
      bf16x8 a = *(const bf16x8*)(sP + fr * 72 + k2 * 32 + fq * 8);
#pragma unroll
      for (int n2 = 0; n2 < 8; n2++) {
        bf16x8 b = *(const bf16x8*)(sV + (n2 * 16 + fr) * 72 + k2 * 32 + fq * 8);
        o[n2] = __builtin_amdgcn_mfma_f32_16x16x32_bf16(a, b, o[n2], 0, 0, 0);
        if (n2 == 3) asm volatile("" ::: "memory");
      }
      asm volatile("" ::: "memory");
    }
    asm volatile("s_waitcnt lgkmcnt(0)" ::: "memory");
  }
  if (lat) {
    const u16* q0src = ZA + (size_t)(row0 + qrow + fr) * 2048 + 512 + h * 128;
    bf16x8 q0[4];
#pragma unroll
    for (int ks = 0; ks < 4; ks++) q0[ks] = *(const bf16x8*)(q0src + ks * 32 + fq * 8);
#pragma unroll 1
    for (int dir = 0; dir < 2; dir++) {
      const u16* S0 = (const u16*)(WS(p) + OFF_S0T) + (size_t)((((seq * 2 + l) * 2 + dir) * 4 + h)) * 16384;
      float wj[4];
#pragma unroll
      for (int j = 0; j < 4; j++) { int gi = qrow + fq * 4 + j; wj[j] = dir == 0 ? __expf(lgf * (float)(gi + 1)) : __expf(lgb * (float)(L - 1 - gi)); }
#pragma unroll
      for (int n2 = 0; n2 < 8; n2++) {
        f32x4 tmp = {0.f, 0.f, 0.f, 0.f};
#pragma unroll
        for (int ks = 0; ks < 4; ks++) {
          bf16x8 b = *(const bf16x8*)(S0 + (size_t)(n2 * 16 + fr) * 128 + ks * 32 + fq * 8);
          tmp = __builtin_amdgcn_mfma_f32_16x16x32_bf16(q0[ks], b, tmp, 0, 0, 0);
        }
#pragma unroll
        for (int j = 0; j < 4; j++) o[n2][j] += wj[j] * tmp[j];
        asm volatile("" ::: "memory");
      }
    }
  }
#pragma unroll
  for (int j = 0; j < 4; j++) {
    float s = 0.f;
#pragma unroll
    for (int n2 = 0; n2 < 8; n2++) s += o[n2][j];
    s += __shfl_xor(s, 1, 64); s += __shfl_xor(s, 2, 64); s += __shfl_xor(s, 4, 64); s += __shfl_xor(s, 8, 64);
    float mean = s * (1.f / 128.f);
    float v = 0.f;
#pragma unroll
    for (int n2 = 0; n2 < 8; n2++) { float dd = o[n2][j] - mean; v += dd * dd; }
    v += __shfl_xor(v, 1, 64); v += __shfl_xor(v, 2, 64); v += __shfl_xor(v, 4, 64); v += __shfl_xor(v, 8, 64);
    float rstd = rsqrtf(v * (1.f / 128.f) + 1e-5f);
    size_t rbase = (size_t)(row0 + qrow + fq * 4 + j) * 2048;
#pragma unroll
    for (int n2 = 0; n2 < 8; n2++) {
      int e = n2 * 16 + fr;
      float gv = bf2f(ZA[rbase + 1536 + h * 128 + e]);
      ZA[rbase + 512 + h * 128 + e] = f2bf((o[n2][j] - mean) * rstd * gv);
    }
  }
}

DEV bf16x8 scale8(u32x4 raw, const float (&w)[8]) {
  union { u32x4 u; bf16x8 v; } r;
#pragma unroll
  for (int q = 0; q < 4; q++) {
    float a = __uint_as_float(raw[q] << 16) * w[q * 2], b = __uint_as_float(raw[q] & 0xffff0000u) * w[q * 2 + 1];
    r.u[q] = pack2(a, b);
  }
  return r.v;
}

DEV void retstate_task(const Params& p, int l, int task) {
  const int tid = TID(), lane = tid & 63, wid = tid >> 6, fr = lane & 15, fq = lane >> 4;
  int seq = task >> 3, h = (task >> 1) & 3, dir = task & 1;
  const u16* KT = (const u16*)(WS(p) + OFF_KT) + (size_t)((seq * 4 + h) * 128) * 256;
  const u16* VT = (const u16*)(WS(p) + OFF_VT) + (size_t)((seq * 4 + h) * 128) * 256;
  const float lg = log1pf(-expf(INP(p, 20)[(l * 2 + dir) * 4 + h]));
  f32x4 acc[2][8];
#pragma unroll
  for (int m = 0; m < 2; m++)
#pragma unroll
    for (int n = 0; n < 8; n++) acc[m][n] = f32x4{0.f, 0.f, 0.f, 0.f};
#pragma unroll 1
  for (int ks = 0; ks < 8; ks++) {
    float w[8];
#pragma unroll
    for (int jj = 0; jj < 8; jj++) { int j = ks * 32 + fq * 8 + jj; w[jj] = __expf(lg * (float)(dir == 0 ? 255 - j : j)); }
    bf16x8 a[2];
#pragma unroll
    for (int m = 0; m < 2; m++) a[m] = scale8(*(const u32x4*)(KT + (size_t)(wid * 32 + m * 16 + fr) * 256 + ks * 32 + fq * 8), w);
#pragma unroll
    for (int n = 0; n < 8; n++) {
      bf16x8 b = *(const bf16x8*)(VT + (size_t)(n * 16 + fr) * 256 + ks * 32 + fq * 8);
#pragma unroll
      for (int m = 0; m < 2; m++) acc[m][n] = __builtin_amdgcn_mfma_f32_16x16x32_bf16(a[m], b, acc[m][n], 0, 0, 0);
    }
  }
  float* o = OUTP(p) + 13107200 + ((((size_t)seq * 2 + l) * 2 + dir) * 4 + h) * 16384;
#pragma unroll
  for (int m = 0; m < 2; m++)
#pragma unroll
    for (int n = 0; n < 8; n++)
#pragma unroll
      for (int j = 0; j < 4; j++) o[(size_t)(wid * 32 + m * 16 + fq * 4 + j) * 128 + n * 16 + fr] = acc[m][n][j];
}

DEV float hsc(const u16* HZ, int col, int t, int L, float w0, float w1, float w2, float b) {
  float hm = t > 0 ? bf2f(HZ[(size_t)(t - 1) * 1536 + col]) : 0.f;
  float hc = bf2f(HZ[(size_t)t * 1536 + col]);
  float hp = t + 1 < L ? bf2f(HZ[(size_t)(t + 1) * 1536 + col]) : 0.f;
  return w0 * hm + w1 * hc + w2 * hp + b;
}

template <int ORDER>
DEV void hyena_task(const Params& p, int l, int task) {
  const int tid = TID(), lane = tid & 63, wid = tid >> 6;
  int seq, cgi, t64, L, row0, Lsel;
  if (task < 512) { seq = task >> 7; cgi = (task >> 4) & 7; t64 = task & 15; L = 1024; Lsel = 1; row0 = 8192 + seq * 1024; }
  else { int t2 = task - 512; seq = t2 >> 5; cgi = (t2 >> 2) & 7; t64 = t2 & 3; L = 256; Lsel = 0; row0 = seq * 256; }
  const int c = cgi * 64 + lane; const int t0 = t64 * 64 + wid * 16;
  const float* Gp = (const float*)(WS(p) + OFF_G) + (Lsel ? 524288 : 0) + (size_t)(ORDER - 1) * (2 * L) * 512 + c;
  u16* HZ = (u16*)(WS(p) + OFF_HYZ) + (size_t)row0 * 1536;
  float* OUT1 = (float*)(WS(p) + OFF_OUT1) + (size_t)row0 * 512;
  const float* cw = INP(p, 22) + (size_t)l * 3 * 1536; const float* cb = INP(p, 23) + l * 1536;
  float acc[16], Whi[15];
#pragma unroll
  for (int i = 0; i < 16; i++) acc[i] = 0.f;
#pragma unroll
  for (int m = 0; m < 15; m++) Whi[m] = Gp[(size_t)(L + t0 + 1 + m) * 512];
  const float v0 = cw[1024 + c], v1 = cw[1536 + 1024 + c], v2 = cw[3072 + 1024 + c], vb = cb[1024 + c];
  float hprev = 0.f, hcur = 0.f;
  if (ORDER == 1) hcur = bf2f(HZ[1024 + c]);
  for (int sb = 0; sb < L; sb += 16) {
    float Wlo[16], x[16];
#pragma unroll
    for (int m = 0; m < 16; m++) Wlo[m] = Gp[(size_t)(L + t0 - sb - 15 + m) * 512];
    if (ORDER == 1) {
      float hn[16];
#pragma unroll
      for (int ss = 0; ss < 16; ss++) { int s = sb + ss + 1; hn[ss] = s < L ? bf2f(HZ[(size_t)s * 1536 + 1024 + c]) : 0.f; }
      x[0] = v0 * hprev + v1 * hcur + v2 * hn[0] + vb;
      x[1] = v0 * hcur + v1 * hn[0] + v2 * hn[1] + vb;
#pragma unroll
      for (int ss = 2; ss < 16; ss++) x[ss] = v0 * hn[ss - 2] + v1 * hn[ss - 1] + v2 * hn[ss] + vb;
      hprev = hn[14]; hcur = hn[15];
    } else {
#pragma unroll
      for (int ss = 0; ss < 16; ss++) x[ss] = OUT1[(size_t)(sb + ss) * 512 + c];
    }
#pragma unroll
    for (int ss = 0; ss < 16; ss++)
#pragma unroll
      for (int i = 0; i < 16; i++) {
        const int m = 15 + i - ss;
        const float w = m < 16 ? Wlo[m < 16 ? m : 0] : Whi[m >= 16 ? m - 16 : 0];
        acc[i] += w * x[ss];
      }
#pragma unroll
    for (int m = 0; m < 15; m++) Whi[m] = Wlo[m];
  }
  const float rn = rsqrtf(((const float*)(WS(p) + OFF_SUMSQ))[((l * 2 + Lsel) * 2 + (ORDER - 1)) * 512 + c] + 1e-6f);
  const float bias = INP(p, 30)[(l * 2 + (ORDER - 1)) * 512 + c];
  if (ORDER == 1) {
    const float a0 = cw[c], a1 = cw[1536 + c], a2 = cw[3072 + c], ab = cb[c];
#pragma unroll
    for (int i = 0; i < 16; i++) {
      int t = t0 + i;
      float vs = hsc(HZ, 1024 + c, t, L, v0, v1, v2, vb);
      float x1 = hsc(HZ, c, t, L, a0, a1, a2, ab);
      OUT1[(size_t)t * 512 + c] = x1 * (acc[i] * rn + bias * vs);
    }
  } else {
    const float a0 = cw[512 + c], a1 = cw[1536 + 512 + c], a2 = cw[3072 + 512 + c], ab = cb[512 + c];
#pragma unroll
    for (int i = 0; i < 16; i++) {
      int t = t0 + i;
      float x2 = hsc(HZ, 512 + c, t, L, a0, a1, a2, ab);
      float o1 = OUT1[(size_t)t * 512 + c];
      HZ[(size_t)t * 1536 + 1024 + c] = f2bf(x2 * (acc[i] * rn + bias * o1));
    }
  }
}

DEV void phaseD(const Params& p, int l, char* smem) {
  const int nb = gridDim.x, b = BID();
#pragma unroll 1
  for (int t = b; t < 1536; t += nb) hyena_task<1>(p, l, t);
#pragma unroll 1
  for (int t = (b + nb - (1536 % nb)) % nb; t < 768; t += nb) ret_task(p, l, t, smem);
#pragma unroll 1
  for (int t = (b + 2 * nb - ((1536 + 768) % nb)) % nb; t < 576; t += nb) s5_task(p, l, t, smem);
#pragma unroll 1
  for (int t = (b + 3 * nb - ((1536 + 768 + 576) % nb)) % nb; t < 256; t += nb) retstate_task(p, l, t);
}
DEV void phaseE(const Params& p, int l) {
  for (int t = BID(); t < 1536; t += gridDim.x) hyena_task<2>(p, l, t);
}

DEV void phaseF(const Params& p, int l, char* smem) {
  u16* sA = (u16*)smem; u16* sB = sA + 128 * 72; u16* T = (u16*)smem;
  const u16* H = (const u16*)(WS(p) + OFF_H);
  const u16* WT = (const u16*)(WS(p) + OFF_WT);
  const u16* ZA = (const u16*)(WS(p) + OFF_ZA); const u16* HYZ = (const u16*)(WS(p) + OFF_HYZ);
  u16* MG = (u16*)(WS(p) + OFF_YP);
  for (int tile = BID(); tile < 96 * 16; tile += gridDim.x) {
    int tm = tile >> 4, tn = tile & 15; int row0 = tm * 128, n0 = tn * 64;
    f32x4 a1[4][2], a2[4][2], tt[4][2];
    const u16* Hrow = H + (size_t)row0 * 1024;
    zero_acc<2>(a1); zero_acc<2>(tt);
#pragma unroll 1
    for (int ps = 0; ps < 7; ps++) {
      const u16* Ap; const u16* Bp; int lda, K;
      switch (ps) {
        case 0: Ap = ZA + (size_t)row0 * 2048; lda = 2048; Bp = WT + WGLU_O + (size_t)n0 * 512; K = 512; break;
        case 1: Ap = ZA + (size_t)row0 * 2048; lda = 2048; Bp = WT + WGLU_O + (size_t)(1024 + n0) * 512; K = 512; break;
        case 3: Ap = ZA + (size_t)row0 * 2048 + 512; lda = 2048; Bp = WT + WRETO_O + (size_t)n0 * 512; K = 512; break;
        case 5: Ap = HYZ + (size_t)row0 * 1536 + 1024; lda = 1536; Bp = WT + WHYO_O + (size_t)n0 * 512; K = 512; break;
        default: Ap = Hrow; lda = 1024; Bp = WT + WIN_O + (size_t)(4096 + ((ps - 2) >> 1) * 1024 + n0) * 1024; K = 1024; break;
      }
      zero_acc<2>(a2);
      gemm_loop<2>(Ap, lda, Bp, K, K, a2, sA, sB);
      if (ps == 0 || ps == 3 || ps == 5) {
#pragma unroll
        for (int m = 0; m < 4; m++)
#pragma unroll
          for (int n = 0; n < 2; n++) a1[m][n] = a2[m][n];
      } else if (ps == 1) {
#pragma unroll
        for (int m = 0; m < 4; m++)
#pragma unroll
          for (int n = 0; n < 2; n++)
#pragma unroll
            for (int j = 0; j < 4; j++) a1[m][n][j] *= sigm(a2[m][n][j]);
      } else {
#pragma unroll
        for (int m = 0; m < 4; m++)
#pragma unroll
          for (int n = 0; n < 2; n++)
#pragma unroll
            for (int j = 0; j < 4; j++) tt[m][n][j] += a1[m][n][j] * sigm(a2[m][n][j]);
      }
    }
    __syncthreads();
    acc_to_lds<2, 72>(tt, T);
    __syncthreads();
    copy_tile<64, 72>(T, MG + (size_t)row0 * 1024 + n0, 1024);
  }
}

template <int NF>
DEV void resid_store(const Params& p, const f32x4 (&acc)[4][NF], int l, int chunk, int row0, int col0, bool from_input) {
  const int tid = TID(), lane = tid & 63, wid = tid >> 6, wr = wid >> 1, wc = wid & 1, fr = lane & 15, fq = lane >> 4;
  const int j = modidx(row0);
  const float* MOD = (const float*)(WS(p) + OFF_MOD) + (l * 5 + j) * 6144 + chunk * 1024;
  const float* BM = INP(p, 7) + l * 6144 + chunk * 1024;
#pragma unroll
  for (int n = 0; n < NF; n++) {
    int col = col0 + wc * (NF * 16) + n * 16 + fr;
    float g = MOD[col] + BM[col];
#pragma unroll
    for (int m = 0; m < 4; m++)
#pragma unroll
      for (int jj = 0; jj < 4; jj++) {
        int row = row0 + wr * 64 + m * 16 + fq * 4 + jj;
        float xo = from_input ? xin_row(p, row)[col] : OUTP(p)[(size_t)row * 1024 + col];
        OUTP(p)[(size_t)row * 1024 + col] = xo + g * acc[m][n][jj];
      }
  }
}

DEV void phaseG(const Params& p, int l, char* smem) {
  u16* sA = (u16*)smem; u16* sB = sA + 128 * 72;
  const u16* MG = (const u16*)(WS(p) + OFF_YP);
  const u16* W = (const u16*)(WS(p) + OFF_WT) + WOUT_O;
  for (int tile = BID(); tile < 96 * 16; tile += gridDim.x) {
    int tm = tile >> 4, tn = tile & 15;
    f32x4 acc[4][2]; zero_acc<2>(acc);
    gemm_loop<2>(MG + (size_t)tm * 128 * 1024, 1024, W + (size_t)tn * 64 * 1024, 1024, 1024, acc, sA, sB);
    resid_store<2>(p, acc, l, 2, tm * 128, tn * 64, l == 0);
  }
}

DEV void phaseI(const Params& p, int l, char* smem) {
  u16* sA = (u16*)smem; u16* sB = sA + 128 * 72; u16* T = (u16*)smem;
  const u16* H = (const u16*)(WS(p) + OFF_H);
  const u16* W = (const u16*)(WS(p) + OFF_WT) + WFIN_O;
  u16* ACT = (u16*)(WS(p) + OFF_ZA);
  for (int tile = BID(); tile < 96 * 22; tile += gridDim.x) {
    int tm = tile / 22, tn = tile % 22;
    f32x4 a1[4][4], a2[4][4];
    zero_acc<4>(a1); gemm_loop<4>(H + (size_t)tm * 128 * 1024, 1024, W + (size_t)tn * 128 * 1024, 1024, 1024, a1, sA, sB);
    zero_acc<4>(a2); gemm_loop<4>(H + (size_t)tm * 128 * 1024, 1024, W + (size_t)(2816 + tn * 128) * 1024, 1024, 1024, a2, sA, sB);
#pragma unroll
    for (int m = 0; m < 4; m++)
#pragma unroll
      for (int n = 0; n < 4; n++)
#pragma unroll
        for (int j = 0; j < 4; j++) a1[m][n][j] = silu_(a1[m][n][j]) * a2[m][n][j];
    __syncthreads();
    acc_to_lds<4, 136>(a1, T);
    __syncthreads();
    copy_tile<128, 136>(T, ACT + (size_t)tm * 128 * 2816 + tn * 128, 2816);
  }
}

DEV void phaseJ(const Params& p, int l, char* smem) {
  u16* sA = (u16*)smem; u16* sB = sA + 128 * 72;
  const u16* ACT = (const u16*)(WS(p) + OFF_ZA);
  const u16* W = (const u16*)(WS(p) + OFF_WT) + WFOUT_O;
  for (int tile = BID(); tile < 96 * 16; tile += gridDim.x) {
    int tm = tile >> 4, tn = tile & 15;
    f32x4 acc[4][2]; zero_acc<2>(acc);
    gemm_loop<2>(ACT + (size_t)tm * 128 * 2816, 2816, W + (size_t)tn * 64 * 2816, 2816, 2816, acc, sA, sB);
    resid_store<2>(p, acc, l, 5, tm * 128, tn * 64, false);
  }
}

constexpr int SMEM_BYTES = 50176;

DEV void run_phase(const Params& p, int ph, int l, char* smem) {
  switch (ph) {
    case 0: phaseA(p, smem); break;
    case 1: norm_phase(p, l, 0); if (l == 1) layer_prep(p, 1, smem); break;
    case 2: phaseC(p, l, smem); break;
    case 3: phaseD(p, l, smem); break;
    case 4: phaseE(p, l); break;
    case 5: phaseF(p, l, smem); break;
    case 6: phaseG(p, l, smem); break;
    case 7: norm_phase(p, l, 1); break;
    case 8: phaseI(p, l, smem); break;
    case 9: phaseJ(p, l, smem); break;
    case 10: norm_phase(p, 0, 2); break;
  }
}

#if MULTI
__global__ void __launch_bounds__(256, 2) kphase(Params p, int ph, int l) {
  __shared__ __attribute__((aligned(16))) char smem[SMEM_BYTES];
  run_phase(p, ph, l, smem);
}
#else
__global__ void __launch_bounds__(256, 2) mega(Params p) {
  __shared__ __attribute__((aligned(16))) char smem[SMEM_BYTES];
  cg::grid_group grid = cg::this_grid();
  run_phase(p, 0, 0, smem);
  grid.sync();
  for (int l = 0; l < 2; l++) {
    for (int ph = 1; ph <= 9; ph++) {
      run_phase(p, ph, l, smem);
      grid.sync();
    }
  }
  run_phase(p, 10, 0, smem);
}
#endif

extern "C" void kernel_launch(void* const* d_in, const int* in_sizes, int n_in, void* d_out, int out_size, void* d_ws, size_t ws_size, hipStream_t stream) {
  Params p{};
  for (int i = 0; i < 36; i++) p.in[i] = (const float*)d_in[i];
  p.out = (float*)d_out;
  p.ws = (char*)d_ws;
  hipMemsetAsync((char*)d_ws + OFF_MOD, 0, ZERO_BYTES, stream);
  static int grid_blocks = 0;
#if MULTI
  if (!grid_blocks) {
    int dev = 0, cus = 0, per_cu = 0;
    hipGetDevice(&dev);
    hipDeviceGetAttribute(&cus, hipDeviceAttributeMultiprocessorCount, dev);
    hipOccupancyMaxActiveBlocksPerMultiprocessor(&per_cu, kphase, 256, 0);
    if (per_cu > 2) per_cu = 2;
    if (per_cu < 1) per_cu = 1;
    grid_blocks = cus * per_cu;
  }
  kphase<<<grid_blocks, 256, 0, stream>>>(p, 0, 0);
  for (int l = 0; l < 2; l++)
    for (int ph = 1; ph <= 9; ph++) kphase<<<grid_blocks, 256, 0, stream>>>(p, ph, l);
  kphase<<<grid_blocks, 256, 0, stream>>>(p, 10, 0);
#else
  if (!grid_blocks) {
    int dev = 0, cus = 0, per_cu = 0;
    hipGetDevice(&dev);
    hipDeviceGetAttribute(&cus, hipDeviceAttributeMultiprocessorCount, dev);
    hipOccupancyMaxActiveBlocksPerMultiprocessor(&per_cu, mega, 256, 0);
    if (per_cu > 2) per_cu = 2;
    if (per_cu < 1) per_cu = 1;
    grid_blocks = cus * per_cu;
  }
  void* args[] = {&p};
  hipError_t e = hipLaunchCooperativeKernel((void*)mega, dim3(grid_blocks), dim3(256), args, 0, stream);
  if (e != hipSuccess) fprintf(stderr, "cooperative launch failed: %s (grid %d)\n", hipGetErrorString(e), grid_blocks);
#endif
}
```

```cpp
#include <hip/hip_runtime.h>
#include <hip/hip_cooperative_groups.h>
#include <cstdio>
namespace cg = cooperative_groups;

#ifndef MULTI
#define MULTI 0
#endif

typedef unsigned short u16;
using bf16x8 = __attribute__((ext_vector_type(8))) short;
using f32x4 = __attribute__((ext_vector_type(4))) float;
using u32x4 = __attribute__((ext_vector_type(4))) unsigned;
using u32x2 = __attribute__((ext_vector_type(2))) unsigned;
#define DEV __device__ __forceinline__

constexpr int MT = 12288;
constexpr size_t OFF_WT = 0;
constexpr int WIN_O = 0, WGLU_O = 7340032, WRETO_O = 8388608, WHYO_O = 8912896, WOUT_O = 9437184, WFIN_O = 10485760, WFOUT_O = 16252928;
constexpr size_t OFF_G = 38273024;
constexpr size_t OFF_H = 48758784;
constexpr size_t OFF_ZA = 73924608;
constexpr size_t OFF_HYZ = 124256256;
constexpr size_t OFF_VT = 162004992;
constexpr size_t OFF_KT = 174587904;
constexpr size_t OFF_QR = 182976512;
constexpr size_t OFF_YP = 187170816;
constexpr size_t OFF_OUT1 = 212336640;
constexpr size_t OFF_MOD = 237502464;
constexpr size_t OFF_SUMSQ = OFF_MOD + 245760;
constexpr size_t OFF_BAR = OFF_SUMSQ + 16384;
constexpr size_t ZERO_BYTES = 245760 + 16384 + 16384;
constexpr size_t OFF_LAMBAR = OFF_BAR + 16384;
constexpr size_t OFF_BBAR = OFF_LAMBAR + 65536;
constexpr size_t OFF_CM = OFF_BBAR + 524288;
constexpr size_t OFF_ROPE = OFF_CM + 524288;
constexpr size_t OFF_S0T = OFF_ROPE + 524288;
constexpr size_t WS_END = OFF_S0T + 2097152;

struct Params {
  const float* in[36];
  float* out;
  char* ws;
};


DEV int TID() { int t = threadIdx.x; asm volatile("" : "+v"(t)); return t; }
DEV int BID() { int t = blockIdx.x; asm volatile("" : "+s"(t)); return t; }
DEV char* WS(const Params& p) { char* w = p.ws; asm volatile("" : "+s"(w)); return w; }
DEV float* OUTP(const Params& p) { float* w = p.out; asm volatile("" : "+s"(w)); return w; }
DEV const float* INP(const Params& p, int i) { const float* w = p.in[i]; asm volatile("" : "+s"(w)); return w; }

DEV u16 f2bf(float f) { unsigned u = __float_as_uint(f); u += 0x7fffu + ((u >> 16) & 1u); return (u16)(u >> 16); }
DEV float bf2f(u16 h) { return __uint_as_float(((unsigned)h) << 16); }
DEV float sigm(float x) { return 1.f / (1.f + __expf(-x)); }
DEV float silu_(float x) { return x / (1.f + __expf(-x)); }
DEV float gelu_(float x) { float u = 0.7978845608028654f * (x + 0.044715f * x * x * x); return 0.5f * x * (1.f + tanhf(u)); }
DEV unsigned pack2(float a, float b) { return (unsigned)f2bf(a) | ((unsigned)f2bf(b) << 16); }

DEV const float* xin_row(const Params& p, int row) { return row < 8192 ? INP(p, 0) + (size_t)row * 1024 : INP(p, 1) + (size_t)(row - 8192) * 1024; }
DEV int modidx(int row) { return row < 8192 ? 0 : 1 + ((row - 8192) >> 10); }

template <int MF, int NF>
DEV void gemm_loop(const u16* __restrict__ A, int lda, const u16* __restrict__ B, int ldb, int K, f32x4 (&acc)[MF][NF], u16* sA) {
  const int tid = TID(), lane = tid & 63, wid = tid >> 6, wr = wid >> 1, wc = wid & 1, fr = lane & 15, fq = lane >> 4;
  u16* sB = sA + MF * 32 * 72;
  u32x4 ra[MF], rb[NF];
  const int crow = tid >> 3, ccol = (tid & 7) * 8;
  const u16* Ap = A + (size_t)crow * lda + ccol;
  const u16* Bp = B + (size_t)crow * ldb + ccol;
#pragma unroll
  for (int i = 0; i < MF; i++) ra[i] = *(const u32x4*)(Ap + (size_t)(i * 32) * lda);
#pragma unroll
  for (int i = 0; i < NF; i++) rb[i] = *(const u32x4*)(Bp + (size_t)(i * 32) * ldb);
  for (int k0 = 0; k0 < K; k0 += 64) {
    __syncthreads();
#pragma unroll
    for (int i = 0; i < MF; i++) *(u32x4*)(sA + (crow + i * 32) * 72 + ccol) = ra[i];
#pragma unroll
    for (int i = 0; i < NF; i++) *(u32x4*)(sB + (crow + i * 32) * 72 + ccol) = rb[i];
    __syncthreads();
    if (k0 + 64 < K) {
#pragma unroll
      for (int i = 0; i < MF; i++) ra[i] = *(const u32x4*)(Ap + (size_t)(i * 32) * lda + k0 + 64);
#pragma unroll
      for (int i = 0; i < NF; i++) rb[i] = *(const u32x4*)(Bp + (size_t)(i * 32) * ldb + k0 + 64);
    }
#pragma unroll
    for (int ks = 0; ks < 2; ks++) {
      bf16x8 bv[NF];
#pragma unroll
      for (int n = 0; n < NF; n++) bv[n] = *(const bf16x8*)(sB + (wc * (NF * 16) + n * 16 + fr) * 72 + ks * 32 + fq * 8);
#pragma unroll
      for (int m = 0; m < MF; m++) {
        bf16x8 af = *(const bf16x8*)(sA + (m * 32 + wr * 16 + fr) * 72 + ks * 32 + fq * 8);
#pragma unroll
        for (int n = 0; n < NF; n++) acc[m][n] = __builtin_amdgcn_mfma_f32_16x16x32_bf16(af, bv[n], acc[m][n], 0, 0, 0);
      }
    }
  }
}

template <int MF, int NF>
DEV void zero_acc(f32x4 (&acc)[MF][NF]) {
#pragma unroll
  for (int m = 0; m < MF; m++)
#pragma unroll
    for (int n = 0; n < NF; n++) acc[m][n] = f32x4{0.f, 0.f, 0.f, 0.f};
}

DEV float epi_op(float v, int op) { return op == 1 ? v * 0.08838834764831845f : (op == 2 ? silu_(v) : v); }
template <int MF, int NF, int TS>
DEV void acc_to_lds(const f32x4 (&acc)[MF][NF], u16* T, int m0, int op = 0) {
  const int tid = TID(), lane = tid & 63, wid = tid >> 6, wr = wid >> 1, wc = wid & 1, fr = lane & 15, fq = lane >> 4;
#pragma unroll
  for (int m = 0; m < 4; m++)
#pragma unroll
    for (int n = 0; n < NF; n++)
#pragma unroll
      for (int j = 0; j < 4; j++) T[(m * 32 + wr * 16 + fq * 4 + j) * TS + wc * (NF * 16) + n * 16 + fr] = f2bf(epi_op(acc[m0 + m][n][j], op));
}
template <int MF>
DEV void acc_to_lds_T(const f32x4 (&acc)[MF][4], u16* T, int m0, int op = 0) {
  const int tid = TID(), lane = tid & 63, wid = tid >> 6, wr = wid >> 1, wc = wid & 1, fr = lane & 15, fq = lane >> 4;
#pragma unroll
  for (int m = 0; m < 4; m++)
#pragma unroll
    for (int n = 0; n < 4; n++) {
      u32x2 v; v.x = pack2(epi_op(acc[m0 + m][n][0], op), epi_op(acc[m0 + m][n][1], op)); v.y = pack2(epi_op(acc[m0 + m][n][2], op), epi_op(acc[m0 + m][n][3], op));
      *(u32x2*)(T + (wc * 64 + n * 16 + fr) * 136 + m * 32 + wr * 16 + fq * 4) = v;
    }
}
template <int COLS, int TS>
DEV void copy_tile(const u16* T, u16* dst, int ld) {
  constexpr int CPR = COLS / 8;
  constexpr int NIT = 128 * CPR / 256;
#pragma unroll
  for (int i = 0; i < NIT; i++) {
    int id = TID() + i * 256; int r = id / CPR, ch = id % CPR;
    *(u32x4*)(dst + (size_t)r * ld + ch * 8) = *(const u32x4*)(T + r * TS + ch * 8);
  }
}

DEV void transpose_tile(const float* __restrict__ src, int K, int N, u16* __restrict__ dst, int tile, float* sm, int perm = 0) {
  int nk = K >> 6; int tk = tile % nk, tn = tile / nk; int k0 = tk * 64, n0 = tn * 64;
  int tx = TID() & 63, ty = TID() >> 6;
  __syncthreads();
#pragma unroll
  for (int i = 0; i < 16; i++) { int k = ty + i * 4; sm[k * 65 + tx] = src[(size_t)(k0 + k) * N + n0 + tx]; }
  __syncthreads();
#pragma unroll
  for (int i = 0; i < 16; i++) {
    int n = n0 + ty + i * 4;
    if (perm) { int half = N >> 1; int j = n < half ? n : n - half; n = (j >> 4) * 32 + (n < half ? 0 : 16) + (j & 15); }
    dst[(size_t)n * K + k0 + tx] = f2bf(sm[tx * 65 + (ty + i * 4)]);
  }
}

DEV void wt_task(const Params& p, int l, int t, float* sm) {
  u16* WT = (u16*)(WS(p) + OFF_WT);
  const float* src; int K, N, off, tt, perm = 0;
  if (t < 1792) { src = INP(p, 10) + (size_t)l * 1024 * 7168; K = 1024; N = 7168; off = WIN_O; tt = t; }
  else if (t < 2048) { src = INP(p, 19) + (size_t)l * 512 * 2048; K = 512; N = 2048; off = WGLU_O; tt = t - 1792; }
  else if (t < 2176) { src = INP(p, 21) + (size_t)l * 512 * 1024; K = 512; N = 1024; off = WRETO_O; tt = t - 2048; }
  else if (t < 2304) { src = INP(p, 31) + (size_t)l * 512 * 1024; K = 512; N = 1024; off = WHYO_O; tt = t - 2176; }
  else if (t < 2560) { src = INP(p, 32) + (size_t)l * 1024 * 1024; K = 1024; N = 1024; off = WOUT_O; tt = t - 2304; }
  else if (t < 3968) { src = INP(p, 33) + (size_t)l * 1024 * 5632; K = 1024; N = 5632; off = WFIN_O; tt = t - 2560; perm = 1; }
  else { src = INP(p, 34) + (size_t)l * 2816 * 1024; K = 2816; N = 1024; off = WFOUT_O; tt = t - 3968; }
  transpose_tile(src, K, N, WT + off, tt, sm, perm);
}

DEV void mod_task(const Params& p, int task, float* sm) {
  int kc = task & 7; int cb = (task >> 3) % 24; int l = task / 192;
  int tid = TID();
  __syncthreads();
  for (int i = tid; i < 640; i += 256) {
    int j = i >> 7, k = kc * 128 + (i & 127);
    float c = (j == 0) ? INP(p, 5)[k] : INP(p, 4)[(j - 1) * 1024 + k];
    sm[i] = silu_(c);
  }
  __syncthreads();
  int col = cb * 256 + tid;
  const float* w = INP(p, 6) + (size_t)l * 1024 * 6144 + (size_t)(kc * 128) * 6144 + col;
  float a0 = 0, a1 = 0, a2 = 0, a3 = 0, a4 = 0;
#pragma unroll 8
  for (int k = 0; k < 128; k++) {
    float wv = w[(size_t)k * 6144];
    a0 += sm[k] * wv; a1 += sm[128 + k] * wv; a2 += sm[256 + k] * wv; a3 += sm[384 + k] * wv; a4 += sm[512 + k] * wv;
  }
  float* MOD = (float*)(WS(p) + OFF_MOD);
  atomicAdd(&MOD[(l * 5 + 0) * 6144 + col], a0);
  atomicAdd(&MOD[(l * 5 + 1) * 6144 + col], a1);
  atomicAdd(&MOD[(l * 5 + 2) * 6144 + col], a2);
  atomicAdd(&MOD[(l * 5 + 3) * 6144 + col], a3);
  atomicAdd(&MOD[(l * 5 + 4) * 6144 + col], a4);
}

DEV void filt_task(const Params& p, int l, int task, float* sm) {
  int Lsel = task >= 32; int tb = Lsel ? task - 32 : task; int L = Lsel ? 1024 : 256; int t0 = tb * 8;
  int tid = TID();
  float* z = sm; float* h1 = sm + 264; float* h2 = sm + 264 + 512;
  const float* w1 = INP(p, 24) + l * 33 * 64; const float* b1 = INP(p, 25) + l * 64;
  const float* w2 = INP(p, 26) + l * 64 * 64; const float* b2 = INP(p, 27) + l * 64;
  const float* fr0 = INP(p, 28) + l * 128; const float* fr1 = fr0 + 64;
  const float* w3 = INP(p, 29) + (size_t)l * 64 * 2048;
  __syncthreads();
  for (int i = tid; i < 264; i += 256) {
    int tt = i / 33, e = i % 33; float t = (float)(t0 + tt); float v;
    if (e == 0) v = t / (float)L;
    else {
      int b = (e - 1) & 15; float band = 1e-4f + (float)b * ((15.f - 1e-4f) / 15.f);
      float ang = (6.283185307179586f / (float)L) * t * band;
      v = (e <= 16) ? cosf(ang) : -sinf(ang);
    }
    z[i] = v;
  }
  __syncthreads();
  for (int i = tid; i < 512; i += 256) {
    int tt = i >> 6, j = i & 63; float s = b1[j];
    for (int e = 0; e < 33; e++) s += z[tt * 33 + e] * w1[e * 64 + j];
    h1[i] = sinf(fr0[j] * s);
  }
  __syncthreads();
  for (int i = tid; i < 512; i += 256) {
    int tt = i >> 6, j = i & 63; float s = b2[j];
    for (int e = 0; e < 64; e++) s += h1[tt * 64 + e] * w2[e * 64 + j];
    h2[i] = sinf(fr1[j] * s);
  }
  __syncthreads();
  float* G = (float*)(WS(p) + OFF_G) + (Lsel ? 524288 : 0);
  float* SUMSQ = (float*)(WS(p) + OFF_SUMSQ);
  for (int m = 0; m < 8; m++) {
    int col = tid + m * 256;
    float acc[8];
#pragma unroll
    for (int tt = 0; tt < 8; tt++) acc[tt] = 0.f;
    for (int j = 0; j < 64; j++) {
      float w = w3[j * 2048 + col];
#pragma unroll
      for (int tt = 0; tt < 8; tt++) acc[tt] += h2[tt * 64 + j] * w;
    }
    int dir = col >> 10, o = (col >> 9) & 1, c = col & 511;
    float rate = 3.0701134573253944f + (float)c * ((15.350567286626972f - 3.0701134573253944f) / 511.f);
    float ss = 0.f;
    float* Go = G + (size_t)o * (2 * L) * 512 + c;
#pragma unroll
    for (int tt = 0; tt < 8; tt++) {
      int t = t0 + tt;
      float val = acc[tt] * expf(-((float)t / (float)L) * rate);
      if (dir == 0) { Go[(size_t)(L + t) * 512] = val; ss += val * val; }
      else if (t > 0) { Go[(size_t)(L - t) * 512] = val; ss += val * val; }
      else { Go[0] = 0.f; }
    }
    atomicAdd(&SUMSQ[((l * 2 + Lsel) * 2 + o) * 512 + c], ss);
  }
}

DEV void s5prep_task(const Params& p, int task) {
  int idx = task * 256 + TID();
  int pp = idx & 63; int lrg = idx >> 6;
  float lre = INP(p, 11)[idx], lim = INP(p, 12)[idx];
  float dt = expf(INP(p, 13)[lrg]);
  float mag = expf(lre * dt);
  float lbr = mag * cosf(lim * dt), lbi = mag * sinf(lim * dt);
  float nr = lbr - 1.f, ni = lbi; float den = lre * lre + lim * lim;
  float cr = (nr * lre + ni * lim) / den, ci = (ni * lre - nr * lim) / den;
  u16* BBAR = (u16*)(WS(p) + OFF_BBAR); u16* CM = (u16*)(WS(p) + OFF_CM); float* LB = (float*)(WS(p) + OFF_LAMBAR);
  LB[idx * 2] = lbr; LB[idx * 2 + 1] = lbi;
  for (int c = 0; c < 16; c++) {
    float br = INP(p, 14)[(size_t)idx * 16 + c], bi = INP(p, 15)[(size_t)idx * 16 + c];
    BBAR[(size_t)lrg * 2048 + pp * 16 + c] = f2bf(cr * br - ci * bi);
    BBAR[(size_t)lrg * 2048 + (64 + pp) * 16 + c] = f2bf(cr * bi + ci * br);
    CM[(size_t)lrg * 2048 + c * 128 + pp] = f2bf(INP(p, 16)[(size_t)lrg * 1024 + c * 64 + pp]);
    CM[(size_t)lrg * 2048 + c * 128 + 64 + pp] = f2bf(-INP(p, 17)[(size_t)lrg * 1024 + c * 64 + pp]);
  }
}

DEV void rope_task(const Params& p, int task) {
  int idx = task * 256 + TID(); int t = idx >> 6, d = idx & 63; int f = d & 31;
  float inv = powf(10000.f, -(float)f / 32.f);
  float pos = (d < 32) ? (float)(t >> 6) : (float)(t & 63);
  float ang = pos * inv;
  float* R = (float*)(WS(p) + OFF_ROPE);
  R[idx * 2] = cosf(ang); R[idx * 2 + 1] = sinf(ang);
}

DEV void layer_prep(const Params& p, int l, char* smem) {
  for (int t = BID(); t < 4672 + 160; t += gridDim.x) {
    if (t < 4672) wt_task(p, l, t, (float*)smem);
    else filt_task(p, l, t - 4672, (float*)smem);
  }
}
DEV void phaseA(const Params& p, char* smem) {
  for (int t = BID(); t < 384 + 32 + 256 + 256; t += gridDim.x) {
    if (t < 384) mod_task(p, t, (float*)smem);
    else if (t < 416) s5prep_task(p, t - 384);
    else if (t < 672) rope_task(p, t - 416);
    else { int tt = t - 672; int mi = tt >> 2; transpose_tile(INP(p, 3) + (size_t)mi * 16384, 128, 128, (u16*)(WS(p) + OFF_S0T) + (size_t)mi * 16384, tt & 3, (float*)smem); }
  }
  layer_prep(p, 0, smem);
}

DEV void norm_phase(const Params& p, int l, int which) {
  const int lane = TID() & 63;
  const int wave = (BID() * blockDim.x + TID()) >> 6, nw = (gridDim.x * blockDim.x) >> 6;
  u16* H = (u16*)(WS(p) + OFF_H);
  const float* MOD = (const float*)(WS(p) + OFF_MOD);
  for (int row = wave; row < MT; row += nw) {
    const float* x = (l == 0 && which == 0) ? xin_row(p, row) : OUTP(p) + (size_t)row * 1024;
    float4 v[4]; float ss = 0.f;
#pragma unroll
    for (int i = 0; i < 4; i++) { v[i] = *(const float4*)(x + i * 256 + lane * 4); ss += v[i].x * v[i].x + v[i].y * v[i].y + v[i].z * v[i].z + v[i].w * v[i].w; }
#pragma unroll
    for (int o = 32; o > 0; o >>= 1) ss += __shfl_xor(ss, o, 64);
    float rinv = rsqrtf(ss * (1.f / 1024.f) + 1e-6f);
    if (which == 2) {
      const float* nf = INP(p, 35);
#pragma unroll
      for (int i = 0; i < 4; i++) {
        float4 g = *(const float4*)(nf + i * 256 + lane * 4);
        float4 o; o.x = v[i].x * rinv * g.x; o.y = v[i].y * rinv * g.y; o.z = v[i].z * rinv * g.z; o.w = v[i].w * rinv * g.w;
        *(float4*)(OUTP(p) + (size_t)row * 1024 + i * 256 + lane * 4) = o;
      }
    } else {
      int j = modidx(row);
      const float* nwt = (which == 0 ? INP(p, 8) : INP(p, 9)) + l * 1024;
      const float* msh = MOD + (l * 5 + j) * 6144 + (which ? 3 : 0) * 1024;
      const float* msc = msh + 1024;
      const float* bsh = INP(p, 7) + l * 6144 + (which ? 3 : 0) * 1024;
      const float* bsc = bsh + 1024;
#pragma unroll
      for (int i = 0; i < 4; i++) {
        int k = i * 256 + lane * 4;
        float4 g = *(const float4*)(nwt + k);
        float4 sh = *(const float4*)(msh + k), sc = *(const float4*)(msc + k);
        float4 bh = *(const float4*)(bsh + k), bc = *(const float4*)(bsc + k);
        float o0 = v[i].x * rinv * g.x * (1.f + sc.x + bc.x) + sh.x + bh.x;
        float o1 = v[i].y * rinv * g.y * (1.f + sc.y + bc.y) + sh.y + bh.y;
        float o2 = v[i].z * rinv * g.z * (1.f + sc.z + bc.z) + sh.z + bh.z;
        float o3 = v[i].w * rinv * g.w * (1.f + sc.w + bc.w) + sh.w + bh.w;
        u32x2 pk; pk.x = pack2(o0, o1); pk.y = pack2(o2, o3);
        *(u32x2*)(H + (size_t)row * 1024 + k) = pk;
      }
    }
  }
}

DEV void phaseC(const Params& p, int l, char* smem) {
  u16* sA = (u16*)smem; u16* T = (u16*)smem;
  const u16* H = (const u16*)(WS(p) + OFF_H);
  const u16* WIN = (const u16*)(WS(p) + OFF_WT) + WIN_O;
  u16* ZA = (u16*)(WS(p) + OFF_ZA); u16* HYZ = (u16*)(WS(p) + OFF_HYZ); u16* VT = (u16*)(WS(p) + OFF_VT);
  u16* KT = (u16*)(WS(p) + OFF_KT); u16* QR = (u16*)(WS(p) + OFF_QR);
  const float* ROPE = (const float*)(WS(p) + OFF_ROPE);
  const int tid = TID();
  for (int tile = BID(); tile < 48 * 32; tile += gridDim.x) {
    int tm = tile >> 5, tn = tile & 31;
    f32x4 acc[8][4]; zero_acc<8, 4>(acc);
    gemm_loop<8, 4>(H + (size_t)tm * 256 * 1024, 1024, WIN + (size_t)tn * 128 * 1024, 1024, 1024, acc, sA);
    int kind = tn >> 2, hd = tn & 3;
    const int op = kind == 2 ? 1 : (kind == 4 ? 2 : 0);
#pragma unroll
    for (int hh = 0; hh < 2; hh++) {
      int row0 = tm * 256 + hh * 128; bool lat = row0 >= 8192;
      int seq, t0, L;
      if (!lat) { seq = row0 >> 8; t0 = row0 & 255; L = 256; } else { seq = (row0 - 8192) >> 10; t0 = (row0 - 8192) & 1023; L = 1024; }
      __syncthreads();
      if (kind == 3) {
        acc_to_lds_T<8>(acc, T, hh * 4, 0);
        __syncthreads();
        u16* dst = lat ? VT + (size_t)8192 * 512 + (size_t)((seq * 4 + hd) * 128) * 1024 + t0 : VT + (size_t)((seq * 4 + hd) * 128) * 256 + t0;
        copy_tile<128, 136>(T, dst, L);
      } else {
        acc_to_lds<8, 4, 136>(acc, T, hh * 4, op);
        __syncthreads();
        bool roped = lat && (kind == 1 || kind == 2);
        if (!(lat && kind == 2)) {
          u16* dst;
          if (kind == 0) dst = ZA + (size_t)row0 * 2048 + hd * 128;
          else if (kind == 1) dst = ZA + (size_t)row0 * 2048 + 512 + hd * 128;
          else if (kind == 2) dst = ZA + (size_t)row0 * 2048 + 1024 + hd * 128;
          else if (kind == 4) dst = ZA + (size_t)row0 * 2048 + 1536 + hd * 128;
          else dst = HYZ + (size_t)row0 * 1536 + (tn - 20) * 128;
          copy_tile<128, 136>(T, dst, kind >= 5 ? 1536 : 2048);
        }
        if (roped) {
          u16* dst; int ld;
          if (kind == 1) { dst = QR + (size_t)(row0 - 8192) * 512 + hd * 128; ld = 512; }
          else { dst = ZA + (size_t)row0 * 2048 + 1024 + hd * 128; ld = 2048; }
#pragma unroll 1
          for (int i = 0; i < 4; i++) {
            int id = tid + i * 256; int r = id >> 3, ch = id & 7;
            u32x4 a = *(const u32x4*)(T + r * 136 + ch * 8);
            u32x4 b = *(const u32x4*)(T + r * 136 + 64 + ch * 8);
            const float4* cs = (const float4*)(ROPE + ((size_t)(t0 + r) * 64 + ch * 8) * 2);
            u32x4 o1, o2;
#pragma unroll
            for (int q = 0; q < 4; q++) {
              float4 c4 = cs[q];
              float x1a = __uint_as_float(a[q] << 16), x1b = __uint_as_float(a[q] & 0xffff0000u);
              float x2a = __uint_as_float(b[q] << 16), x2b = __uint_as_float(b[q] & 0xffff0000u);
              o1[q] = pack2(x1a * c4.x - x2a * c4.y, x1b * c4.z - x2b * c4.w);
              o2[q] = pack2(x1a * c4.y + x2a * c4.x, x1b * c4.w + x2b * c4.z);
            }
            *(u32x4*)(dst + (size_t)r * ld + ch * 8) = o1;
            *(u32x4*)(dst + (size_t)r * ld + 64 + ch * 8) = o2;
          }
        }
        if (kind == 2 && !lat) {
          __syncthreads();
          acc_to_lds_T<8>(acc, T, hh * 4, op);
          __syncthreads();
          copy_tile<128, 136>(T, KT + (size_t)((seq * 4 + hd) * 128) * 256 + t0, 256);
        }
      }
    }
  }
}

DEV void s5_task(const Params& p, int l, int task, char* smem) {
  const int tid = TID(), lane = tid & 63, wid = tid >> 6, fr = lane & 15, fq = lane >> 4;
  int seq, gp;
  if (task < 64) { seq = 32 + (task >> 4); gp = task & 15; } else { int t2 = task - 64; seq = t2 >> 4; gp = t2 & 15; }
  const bool lat = seq >= 32;
  const int L = lat ? 1024 : 256;
  const int row0 = lat ? 8192 + (seq - 32) * 1024 : seq * 256;
  const int grp = gp * 2 + (wid >> 1), dir = wid & 1;
  const int lrg = (l * 2 + dir) * 32 + grp;
  float* BU = (float*)(smem + wid * 12544);
  u16* HB = (u16*)(smem + wid * 12544 + 8192);
  u16* ZA = (u16*)(WS(p) + OFF_ZA);
  float* YP = (float*)(WS(p) + OFF_YP);
  const u16* BBAR = (const u16*)(WS(p) + OFF_BBAR) + (size_t)lrg * 2048;
  const u16* CM = (const u16*)(WS(p) + OFF_CM) + (size_t)lrg * 2048;
  const float* LB = (const float*)(WS(p) + OFF_LAMBAR) + ((size_t)lrg * 64 + lane) * 2;
  const float lr = LB[0], li = LB[1];
  bf16x8 bfrag[8], cfrag[4];
  const bf16x8 zero8 = {0, 0, 0, 0, 0, 0, 0, 0};
#pragma unroll
  for (int nt = 0; nt < 8; nt++) bfrag[nt] = (fq < 2) ? *(const bf16x8*)(BBAR + (nt * 16 + fr) * 16 + fq * 8) : zero8;
#pragma unroll
  for (int ks = 0; ks < 4; ks++) cfrag[ks] = *(const bf16x8*)(CM + fr * 128 + ks * 32 + fq * 8);
  float hr = 0.f, hi = 0.f;
  if (lat) {
    const float* s0 = INP(p, 2) + ((((size_t)(seq - 32) * 2 + l) * 2 + dir) * 32 + grp) * 128 + lane * 2;
    hr = s0[0]; hi = s0[1];
  }
  const float dcoef = INP(p, 18)[l * 512 + grp * 16 + fr];
  const int nch = L >> 4;
  __syncthreads();
  for (int i = 0; i < nch; i++) {
    const int ci = dir ? nch - 1 - i : i; const int t0 = ci * 16;
    if (i == (nch >> 1)) { __threadfence(); __syncthreads(); }
    bf16x8 ua = (fq < 2) ? *(const bf16x8*)(ZA + (size_t)(row0 + t0 + fr) * 2048 + grp * 16 + fq * 8) : zero8;
#pragma unroll
    for (int nt = 0; nt < 8; nt++) {
      f32x4 r = __builtin_amdgcn_mfma_f32_16x16x32_bf16(ua, bfrag[nt], f32x4{0.f, 0.f, 0.f, 0.f}, 0, 0, 0);
#pragma unroll
      for (int j = 0; j < 4; j++) BU[(fq * 4 + j) * 128 + nt * 16 + fr] = r[j];
    }
    asm volatile("s_waitcnt lgkmcnt(0)" ::: "memory");
#pragma unroll
    for (int tt = 0; tt < 16; tt++) {
      const int t = dir ? 15 - tt : tt;
      float re = BU[t * 128 + lane], im = BU[t * 128 + 64 + lane];
      float nr = lr * hr - li * hi + re; float ni = lr * hi + li * hr + im;
      hr = nr; hi = ni;
      HB[t * 136 + lane] = f2bf(hr); HB[t * 136 + 64 + lane] = f2bf(hi);
    }
    asm volatile("s_waitcnt lgkmcnt(0)" ::: "memory");
    f32x4 y = {0.f, 0.f, 0.f, 0.f};
#pragma unroll
    for (int ks = 0; ks < 4; ks++) {
      bf16x8 a = *(const bf16x8*)(HB + fr * 136 + ks * 32 + fq * 8);
      y = __builtin_amdgcn_mfma_f32_16x16x32_bf16(a, cfrag[ks], y, 0, 0, 0);
    }
    asm volatile("s_waitcnt lgkmcnt(0)" ::: "memory");
    if (i < (nch >> 1)) {
#pragma unroll
      for (int j = 0; j < 4; j++) YP[(size_t)(row0 + t0 + fq * 4 + j) * 512 + grp * 16 + fr] = y[j];
    } else {
#pragma unroll
      for (int j = 0; j < 4; j++) {
        size_t row = (size_t)(row0 + t0 + fq * 4 + j);
        float other = __hip_atomic_load(&YP[row * 512 + grp * 16 + fr], __ATOMIC_RELAXED, __HIP_MEMORY_SCOPE_AGENT);
        u16* up = ZA + row * 2048 + grp * 16 + fr;
        float u = bf2f(*up);
        float v = y[j] + other + dcoef * u;
        *up = f2bf(gelu_(v));
      }
    }
  }
  if (!lat) {
    float* o = OUTP(p) + 12582912 + ((((size_t)seq * 2 + l) * 2 + dir) * 32 + grp) * 128 + lane * 2;
    o[0] = hr; o[1] = hi;
  }
}

DEV void ret_task(const Params& p, int l, int task, char* smem) {
  const int tid = TID(), lane = tid & 63, wid = tid >> 6, fr = lane & 15, fq = lane >> 4;
  int seq, h, qt; bool lat;
  if (task < 256) { lat = true; seq = task >> 6; h = (task >> 4) & 3; qt = task & 15; }
  else { int t2 = task - 256; lat = false; seq = t2 >> 4; h = (t2 >> 2) & 3; qt = t2 & 3; }
  const int L = lat ? 1024 : 256;
  const int row0 = lat ? 8192 + seq * 1024 : seq * 256;
  u16* sK = (u16*)smem; u16* sV = sK + 64 * 136; u16* sP = sV + 128 * 72 + wid * 16 * 72;
  u16* ZA = (u16*)(WS(p) + OFF_ZA);
  const u16* QR = (const u16*)(WS(p) + OFF_QR);
  const u16* VT = (const u16*)(WS(p) + OFF_VT);
  const float lgf = log1pf(-expf(INP(p, 20)[(l * 2 + 0) * 4 + h])), lgb = log1pf(-expf(INP(p, 20)[(l * 2 + 1) * 4 + h]));
  const int qrow = qt * 64 + wid * 16;
  const u16* qsrc = lat ? QR + (size_t)(row0 - 8192 + qrow + fr) * 512 + h * 128 : ZA + (size_t)(row0 + qrow + fr) * 2048 + 512 + h * 128;
  bf16x8 qa[4];
#pragma unroll
  for (int ks = 0; ks < 4; ks++) qa[ks] = *(const bf16x8*)(qsrc + ks * 32 + fq * 8);
  f32x4 o[8];
#pragma unroll
  for (int n = 0; n < 8; n++) o[n] = f32x4{0.f, 0.f, 0.f, 0.f};
  const u16* Kbase = ZA + (size_t)row0 * 2048 + 1024 + h * 128;
  const u16* Vbase = lat ? VT + (size_t)8192 * 512 + (size_t)((seq * 4 + h) * 128) * 1024 : VT + (size_t)((seq * 4 + h) * 128) * 256;
  const int nkt = L >> 6;
  for (int jt = 0; jt < nkt; jt++) {
    __syncthreads();
#pragma unroll
    for (int i = 0; i < 4; i++) {
      int id = tid + i * 256; int r = id >> 4, ch = id & 15;
      *(u32x4*)(sK + r * 136 + ch * 8) = *(const u32x4*)(Kbase + (size_t)(jt * 64 + r) * 2048 + ch * 8);
    }
#pragma unroll
    for (int i = 0; i < 4; i++) {
      int id = tid + i * 256; int e = id >> 3, ch = id & 7;
      *(u32x4*)(sV + e * 72 + ch * 8) = *(const u32x4*)(Vbase + (size_t)e * L + jt * 64 + ch * 8);
    }
    __syncthreads();
    f32x4 s[4];
#pragma unroll
    for (int nt = 0; nt < 4; nt++) {
      s[nt] = f32x4{0.f, 0.f, 0.f, 0.f};
#pragma unroll
      for (int ks = 0; ks < 4; ks++) {
        bf16x8 b = *(const bf16x8*)(sK + (nt * 16 + fr) * 136 + ks * 32 + fq * 8);
        s[nt] = __builtin_amdgcn_mfma_f32_16x16x32_bf16(qa[ks], b, s[nt], 0, 0, 0);
      }
      asm volatile("" ::: "memory");
    }
#pragma unroll
    for (int nt = 0; nt < 4; nt++)
#pragma unroll
      for (int j = 0; j < 4; j++) {
        int d = (qrow + fq * 4 + j) - (jt * 64 + nt * 16 + fr);
        float w = d >= 0 ? __expf(lgf * (float)d) : __expf(lgb * (float)(-d));
        sP[(fq * 4 + j) * 72 + nt * 16 + fr] = f2bf(s[nt][j] * w);
      }
    asm volatile("s_waitcnt lgkmcnt(0)" ::: "memory");
#pragma unroll
    for (int k2 = 0; k2 < 2; k2++) {
      bf16x8 a = *(const bf16x8*)(sP + fr * 72 + k2 * 32 + fq * 8);
#pragma unroll
      for (int n2 = 0; n2 < 8; n2++) {
        bf16x8 b = *(const bf16x8*)(sV + (n2 * 16 + fr) * 72 + k2 * 32 + fq * 8);
        o[n2] = __builtin_amdgcn_mfma_f32_16x16x32_bf16(a, b, o[n2], 0, 0, 0);
        if (n2 == 3) asm volatile("" ::: "memory");
      }
      asm volatile("" ::: "memory");
    }
    asm volatile("s_waitcnt lgkmcnt(0)" ::: "memory");
  }
  if (lat) {
    const u16* q0src = ZA + (size_t)(row0 + qrow + fr) * 2048 + 512 + h * 128;
    bf16x8 q0[4];
#pragma unroll
    for (int ks = 0; ks < 4; ks++) q0[ks] = *(const bf16x8*)(q0src + ks * 32 + fq * 8);
#pragma unroll 1
    for (int dir = 0; dir < 2; dir++) {
      const u16* S0 = (const u16*)(WS(p) + OFF_S0T) + (size_t)((((seq * 2 + l) * 2 + dir) * 4 + h)) * 16384;
      float wj[4];
#pragma unroll
      for (int j = 0; j < 4; j++) { int gi = qrow + fq * 4 + j; wj[j] = dir == 0 ? __expf(lgf * (float)(gi + 1)) : __expf(lgb * (float)(L - 1 - gi)); }
#pragma unroll
      for (int n2 = 0; n2 < 8; n2++) {
        f32x4 tmp = {0.f, 0.f, 0.f, 0.f};
#pragma unroll
        for (int ks = 0; ks < 4; ks++) {
          bf16x8 b = *(const bf16x8*)(S0 + (size_t)(n2 * 16 + fr) * 128 + ks * 32 + fq * 8);
          tmp = __builtin_amdgcn_mfma_f32_16x16x32_bf16(q0[ks], b, tmp, 0, 0, 0);
        }
#pragma unroll
        for (int j = 0; j < 4; j++) o[n2][j] += wj[j] * tmp[j];
        asm volatile("" ::: "memory");
      }
    }
  }
#pragma unroll
  for (int j = 0; j < 4; j++) {
    float s = 0.f;
#pragma unroll
    for (int n2 = 0; n2 < 8; n2++) s += o[n2][j];
    s += __shfl_xor(s, 1, 64); s += __shfl_xor(s, 2, 64); s += __shfl_xor(s, 4, 64); s += __shfl_xor(s, 8, 64);
    float mean = s * (1.f / 128.f);
    float v = 0.f;
#pragma unroll
    for (int n2 = 0; n2 < 8; n2++) { float dd = o[n2][j] - mean; v += dd * dd; }
    v += __shfl_xor(v, 1, 64); v += __shfl_xor(v, 2, 64); v += __shfl_xor(v, 4, 64); v += __shfl_xor(v, 8, 64);
    float rstd = rsqrtf(v * (1.f / 128.f) + 1e-5f);
    size_t rbase = (size_t)(row0 + qrow + fq * 4 + j) * 2048;
#pragma unroll
    for (int n2 = 0; n2 < 8; n2++) {
      int e = n2 * 16 + fr;
      float gv = bf2f(ZA[rbase + 1536 + h * 128 + e]);
      ZA[rbase + 512 + h * 128 + e] = f2bf((o[n2][j] - mean) * rstd * gv);
    }
  }
}

DEV bf16x8 scale8(u32x4 raw, const float (&w)[8]) {
  union { u32x4 u; bf16x8 v; } r;
#pragma unroll
  for (int q = 0; q < 4; q++) {
    float a = __uint_as_float(raw[q] << 16) * w[q * 2], b = __uint_as_float(raw[q] & 0xffff0000u) * w[q * 2 + 1];
    r.u[q] = pack2(a, b);
  }
  return r.v;
}

DEV void retstate_task(const Params& p, int l, int task) {
  const int tid = TID(), lane = tid & 63, wid = tid >> 6, fr = lane & 15, fq = lane >> 4;
  int seq = task >> 3, h = (task >> 1) & 3, dir = task & 1;
  const u16* KT = (const u16*)(WS(p) + OFF_KT) + (size_t)((seq * 4 + h) * 128) * 256;
  const u16* VT = (const u16*)(WS(p) + OFF_VT) + (size_t)((seq * 4 + h) * 128) * 256;
  const float lg = log1pf(-expf(INP(p, 20)[(l * 2 + dir) * 4 + h]));
  f32x4 acc[2][8];
#pragma unroll
  for (int m = 0; m < 2; m++)
#pragma unroll
    for (int n = 0; n < 8; n++) acc[m][n] = f32x4{0.f, 0.f, 0.f, 0.f};
#pragma unroll 1
  for (int ks = 0; ks < 8; ks++) {
    float w[8];
#pragma unroll
    for (int jj = 0; jj < 8; jj++) { int j = ks * 32 + fq * 8 + jj; w[jj] = __expf(lg * (float)(dir == 0 ? 255 - j : j)); }
    bf16x8 a[2];
#pragma unroll
    for (int m = 0; m < 2; m++) a[m] = scale8(*(const u32x4*)(KT + (size_t)(wid * 32 + m * 16 + fr) * 256 + ks * 32 + fq * 8), w);
#pragma unroll
    for (int n = 0; n < 8; n++) {
      bf16x8 b = *(const bf16x8*)(VT + (size_t)(n * 16 + fr) * 256 + ks * 32 + fq * 8);
#pragma unroll
      for (int m = 0; m < 2; m++) acc[m][n] = __builtin_amdgcn_mfma_f32_16x16x32_bf16(a[m], b, acc[m][n], 0, 0, 0);
    }
  }
  float* o = OUTP(p) + 13107200 + ((((size_t)seq * 2 + l) * 2 + dir) * 4 + h) * 16384;
#pragma unroll
  for (int m = 0; m < 2; m++)
#pragma unroll
    for (int n = 0; n < 8; n++)
#pragma unroll
      for (int j = 0; j < 4; j++) o[(size_t)(wid * 32 + m * 16 + fq * 4 + j) * 128 + n * 16 + fr] = acc[m][n][j];
}

DEV float hsc(const u16* HZ, int col, int t, int L, float w0, float w1, float w2, float b) {
  float hm = t > 0 ? bf2f(HZ[(size_t)(t - 1) * 1536 + col]) : 0.f;
  float hc = bf2f(HZ[(size_t)t * 1536 + col]);
  float hp = t + 1 < L ? bf2f(HZ[(size_t)(t + 1) * 1536 + col]) : 0.f;
  return w0 * hm + w1 * hc + w2 * hp + b;
}

template <int ORDER>
DEV void hyena_task(const Params& p, int l, int task) {
  const int tid = TID(), lane = tid & 63, wid = tid >> 6;
  int seq, cgi, t64, L, row0, Lsel;
  if (task < 512) { seq = task >> 7; cgi = (task >> 4) & 7; t64 = task & 15; L = 1024; Lsel = 1; row0 = 8192 + seq * 1024; }
  else { int t2 = task - 512; seq = t2 >> 5; cgi = (t2 >> 2) & 7; t64 = t2 & 3; L = 256; Lsel = 0; row0 = seq * 256; }
  const int c = cgi * 64 + lane; const int t0 = t64 * 64 + wid * 16;
  const float* Gp = (const float*)(WS(p) + OFF_G) + (Lsel ? 524288 : 0) + (size_t)(ORDER - 1) * (2 * L) * 512 + c;
  u16* HZ = (u16*)(WS(p) + OFF_HYZ) + (size_t)row0 * 1536;
  float* OUT1 = (float*)(WS(p) + OFF_OUT1) + (size_t)row0 * 512;
  const float* cw = INP(p, 22) + (size_t)l * 3 * 1536; const float* cb = INP(p, 23) + l * 1536;
  float acc[16], Whi[15];
#pragma unroll
  for (int i = 0; i < 16; i++) acc[i] = 0.f;
#pragma unroll
  for (int m = 0; m < 15; m++) Whi[m] = Gp[(size_t)(L + t0 + 1 + m) * 512];
  const float v0 = cw[1024 + c], v1 = cw[1536 + 1024 + c], v2 = cw[3072 + 1024 + c], vb = cb[1024 + c];
  float hprev = 0.f, hcur = 0.f;
  if (ORDER == 1) hcur = bf2f(HZ[1024 + c]);
  for (int sb = 0; sb < L; sb += 16) {
    float Wlo[16], x[16];
#pragma unroll
    for (int m = 0; m < 16; m++) Wlo[m] = Gp[(size_t)(L + t0 - sb - 15 + m) * 512];
    if (ORDER == 1) {
      float hn[16];
#pragma unroll
      for (int ss = 0; ss < 16; ss++) { int s = sb + ss + 1; hn[ss] = s < L ? bf2f(HZ[(size_t)s * 1536 + 1024 + c]) : 0.f; }
      x[0] = v0 * hprev + v1 * hcur + v2 * hn[0] + vb;
      x[1] = v0 * hcur + v1 * hn[0] + v2 * hn[1] + vb;
#pragma unroll
      for (int ss = 2; ss < 16; ss++) x[ss] = v0 * hn[ss - 2] + v1 * hn[ss - 1] + v2 * hn[ss] + vb;
      hprev = hn[14]; hcur = hn[15];
    } else {
#pragma unroll
      for (int ss = 0; ss < 16; ss++) x[ss] = OUT1[(size_t)(sb + ss) * 512 + c];
    }
#pragma unroll
    for (int ss = 0; ss < 16; ss++)
#pragma unroll
      for (int i = 0; i < 16; i++) {
        const int m = 15 + i - ss;
        const float w = m < 16 ? Wlo[m < 16 ? m : 0] : Whi[m >= 16 ? m - 16 : 0];
        acc[i] += w * x[ss];
      }
#pragma unroll
    for (int m = 0; m < 15; m++) Whi[m] = Wlo[m];
  }
  const float rn = rsqrtf(((const float*)(WS(p) + OFF_SUMSQ))[((l * 2 + Lsel) * 2 + (ORDER - 1)) * 512 + c] + 1e-6f);
  const float bias = INP(p, 30)[(l * 2 + (ORDER - 1)) * 512 + c];
  if (ORDER == 1) {
    const float a0 = cw[c], a1 = cw[1536 + c], a2 = cw[3072 + c], ab = cb[c];
#pragma unroll
    for (int i = 0; i < 16; i++) {
      int t = t0 + i;
      float vs = hsc(HZ, 1024 + c, t, L, v0, v1, v2, vb);
      float x1 = hsc(HZ, c, t, L, a0, a1, a2, ab);
      OUT1[(size_t)t * 512 + c] = x1 * (acc[i] * rn + bias * vs);
    }
  } else {
    const float a0 = cw[512 + c], a1 = cw[1536 + 512 + c], a2 = cw[3072 + 512 + c], ab = cb[512 + c];
#pragma unroll
    for (int i = 0; i < 16; i++) {
      int t = t0 + i;
      float x2 = hsc(HZ, 512 + c, t, L, a0, a1, a2, ab);
      float o1 = OUT1[(size_t)t * 512 + c];
      HZ[(size_t)t * 1536 + 1024 + c] = f2bf(x2 * (acc[i] * rn + bias * o1));
    }
  }
}

DEV void phaseD(const Params& p, int l, char* smem) {
  const int nb = gridDim.x, b = BID();
#pragma unroll 1
  for (int t = b; t < 1536; t += nb) hyena_task<1>(p, l, t);
#pragma unroll 1
  for (int t = (b + nb - (1536 % nb)) % nb; t < 768; t += nb) ret_task(p, l, t, smem);
#pragma unroll 1
  for (int t = (b + 2 * nb - ((1536 + 768) % nb)) % nb; t < 576; t += nb) s5_task(p, l, t, smem);
#pragma unroll 1
  for (int t = (b + 3 * nb - ((1536 + 768 + 576) % nb)) % nb; t < 256; t += nb) retstate_task(p, l, t);
}
DEV void phaseE(const Params& p, int l) {
  for (int t = BID(); t < 1536; t += gridDim.x) hyena_task<2>(p, l, t);
}

DEV void phaseF(const Params& p, int l, char* smem) {
  u16* sA = (u16*)smem; u16* T = (u16*)smem;
  const u16* H = (const u16*)(WS(p) + OFF_H);
  const u16* WT = (const u16*)(WS(p) + OFF_WT);
  const u16* ZA = (const u16*)(WS(p) + OFF_ZA); const u16* HYZ = (const u16*)(WS(p) + OFF_HYZ);
  u16* MG = (u16*)(WS(p) + OFF_YP);
  for (int tile = BID(); tile < 96 * 16; tile += gridDim.x) {
    int tm = tile >> 4, tn = tile & 15; int row0 = tm * 128, n0 = tn * 64;
    f32x4 a1[4][2], a2[4][2], tt[4][2];
    const u16* Hrow = H + (size_t)row0 * 1024;
    zero_acc<4, 2>(a1); zero_acc<4, 2>(tt);
#pragma unroll 1
    for (int ps = 0; ps < 7; ps++) {
      const u16* Ap; const u16* Bp; int lda, K;
      switch (ps) {
        case 0: Ap = ZA + (size_t)row0 * 2048; lda = 2048; Bp = WT + WGLU_O + (size_t)n0 * 512; K = 512; break;
        case 1: Ap = ZA + (size_t)row0 * 2048; lda = 2048; Bp = WT + WGLU_O + (size_t)(1024 + n0) * 512; K = 512; break;
        case 3: Ap = ZA + (size_t)row0 * 2048 + 512; lda = 2048; Bp = WT + WRETO_O + (size_t)n0 * 512; K = 512; break;
        case 5: Ap = HYZ + (size_t)row0 * 1536 + 1024; lda = 1536; Bp = WT + WHYO_O + (size_t)n0 * 512; K = 512; break;
        default: Ap = Hrow; lda = 1024; Bp = WT + WIN_O + (size_t)(4096 + ((ps - 2) >> 1) * 1024 + n0) * 1024; K = 1024; break;
      }
      zero_acc<4, 2>(a2);
      gemm_loop<4, 2>(Ap, lda, Bp, K, K, a2, sA);
      if (ps == 0 || ps == 3 || ps == 5) {
#pragma unroll
        for (int m = 0; m < 4; m++)
#pragma unroll
          for (int n = 0; n < 2; n++) a1[m][n] = a2[m][n];
      } else if (ps == 1) {
#pragma unroll
        for (int m = 0; m < 4; m++)
#pragma unroll
          for (int n = 0; n < 2; n++)
#pragma unroll
            for (int j = 0; j < 4; j++) a1[m][n][j] *= sigm(a2[m][n][j]);
      } else {
#pragma unroll
        for (int m = 0; m < 4; m++)
#pragma unroll
          for (int n = 0; n < 2; n++)
#pragma unroll
            for (int j = 0; j < 4; j++) tt[m][n][j] += a1[m][n][j] * sigm(a2[m][n][j]);
      }
    }
    __syncthreads();
    acc_to_lds<4, 2, 72>(tt, T, 0);
    __syncthreads();
    copy_tile<64, 72>(T, MG + (size_t)row0 * 1024 + n0, 1024);
  }
}

template <int MF, int NF>
DEV void resid_store(const Params& p, const f32x4 (&acc)[MF][NF], int l, int chunk, int row0, int col0, bool from_input) {
  const int tid = TID(), lane = tid & 63, wid = tid >> 6, wr = wid >> 1, wc = wid & 1, fr = lane & 15, fq = lane >> 4;
  float* out = OUTP(p);
#pragma unroll
  for (int m = 0; m < MF; m++) {
    const int rb = row0 + m * 32 + wr * 16 + fq * 4;
    const int j = modidx(rb);
    const float* MOD = (const float*)(WS(p) + OFF_MOD) + (l * 5 + j) * 6144 + chunk * 1024;
    const float* BM = INP(p, 7) + l * 6144 + chunk * 1024;
#pragma unroll
    for (int n = 0; n < NF; n++) {
      int col = col0 + wc * (NF * 16) + n * 16 + fr;
      float g = MOD[col] + BM[col];
#pragma unroll
      for (int jj = 0; jj < 4; jj++) {
        int row = rb + jj;
        float xo = from_input ? xin_row(p, row)[col] : out[(size_t)row * 1024 + col];
        out[(size_t)row * 1024 + col] = xo + g * acc[m][n][jj];
      }
    }
  }
}

DEV void phaseG(const Params& p, int l, char* smem) {
  u16* sA = (u16*)smem;
  const u16* MG = (const u16*)(WS(p) + OFF_YP);
  const u16* W = (const u16*)(WS(p) + OFF_WT) + WOUT_O;
  for (int tile = BID(); tile < 48 * 8; tile += gridDim.x) {
    int tm = tile >> 3, tn = tile & 7;
    f32x4 acc[8][4]; zero_acc<8, 4>(acc);
    gemm_loop<8, 4>(MG + (size_t)tm * 256 * 1024, 1024, W + (size_t)tn * 128 * 1024, 1024, 1024, acc, sA);
    resid_store<8, 4>(p, acc, l, 2, tm * 256, tn * 128, l == 0);
  }
}

DEV void phaseI(const Params& p, int l, char* smem) {
  u16* sA = (u16*)smem; u16* T = (u16*)smem;
  const u16* H = (const u16*)(WS(p) + OFF_H);
  const u16* W = (const u16*)(WS(p) + OFF_WT) + WFIN_O;
  u16* ACT = (u16*)(WS(p) + OFF_ZA);
  for (int tile = BID(); tile < 48 * 44; tile += gridDim.x) {
    int tm = tile / 44, tn = tile % 44;
    f32x4 acc[8][4]; zero_acc<8, 4>(acc);
    gemm_loop<8, 4>(H + (size_t)tm * 256 * 1024, 1024, W + (size_t)tn * 128 * 1024, 1024, 1024, acc, sA);
    const int tid = TID(), lane = tid & 63, wid = tid >> 6, wr = wid >> 1, wc = wid & 1, fr = lane & 15, fq = lane >> 4;
#pragma unroll
    for (int hh = 0; hh < 2; hh++) {
      __syncthreads();
#pragma unroll
      for (int m = 0; m < 4; m++)
#pragma unroll
        for (int n = 0; n < 2; n++)
#pragma unroll
          for (int j = 0; j < 4; j++)
            T[(m * 32 + wr * 16 + fq * 4 + j) * 72 + wc * 32 + n * 16 + fr] = f2bf(silu_(acc[hh * 4 + m][2 * n][j]) * acc[hh * 4 + m][2 * n + 1][j]);
      __syncthreads();
      copy_tile<64, 72>(T, ACT + (size_t)(tm * 256 + hh * 128) * 2816 + tn * 64, 2816);
    }
  }
}

DEV void phaseJ(const Params& p, int l, char* smem) {
  u16* sA = (u16*)smem;
  const u16* ACT = (const u16*)(WS(p) + OFF_ZA);
  const u16* W = (const u16*)(WS(p) + OFF_WT) + WFOUT_O;
  for (int tile = BID(); tile < 48 * 8; tile += gridDim.x) {
    int tm = tile >> 3, tn = tile & 7;
    f32x4 acc[8][4]; zero_acc<8, 4>(acc);
    gemm_loop<8, 4>(ACT + (size_t)tm * 256 * 2816, 2816, W + (size_t)tn * 128 * 2816, 2816, 2816, acc, sA);
    resid_store<8, 4>(p, acc, l, 5, tm * 256, tn * 128, false);
  }
}


#define XB_TMO      128
#define XB_XCNT(j)  (256  + 64 * (j))
#define XB_XSUB(j)  (1280 + 64 * (j))
#define XB_XGEN(j)  (2304 + 64 * (j))
#define XB_TOP      3328
#define XB_TOPGEN   3392
#define XB_SPIN_CAP (1u << 22)
#define LAS __attribute__((address_space(3)))
DEV unsigned xb_ld(unsigned* p) { return __hip_atomic_load(p, __ATOMIC_RELAXED, __HIP_MEMORY_SCOPE_AGENT); }
DEV unsigned xb_add(unsigned* p, unsigned v) { return __hip_atomic_fetch_add(p, v, __ATOMIC_RELAXED, __HIP_MEMORY_SCOPE_AGENT); }
DEV unsigned xb_xcc_id() { return (unsigned)__builtin_amdgcn_s_getreg((3 << 11) | 20) & 0xFu; }
#define XB_SPIN(cond, bar) do { unsigned _sp = 0; while (cond) { __builtin_amdgcn_s_sleep(1); \
    if ((++_sp & 255u) == 0u) { if (xb_ld(&(bar)[XB_TMO])) break; if (_sp > XB_SPIN_CAP) { atomicAdd(&(bar)[XB_TMO], 1u); break; } } } } while (0)
struct XcdBarrier { unsigned* bar; unsigned x; volatile LAS unsigned* st; };
DEV XcdBarrier xcd_barrier_post(unsigned* bar, volatile LAS unsigned* st) {
  XcdBarrier b; b.bar = bar; b.x = xb_xcc_id(); b.st = st;
  if (threadIdx.x == 0) (void)xb_add(&bar[XB_XCNT(b.x)], 1u);
  return b;
}
DEV void xcd_barrier_complete(unsigned* bar, unsigned x, unsigned& nloc, unsigned& nx) {
  const unsigned G = gridDim.x * gridDim.y * gridDim.z;
  unsigned sum, cnt, mine, sp = 0u;
  for (;;) {
    sum = 0u; cnt = 0u; mine = 0u;
#pragma unroll
    for (unsigned j = 0; j < 16; ++j) { const unsigned c = xb_ld(&bar[XB_XCNT(j)]); sum += c; cnt += (c > 0u) ? 1u : 0u; mine = (j == x) ? c : mine; }
    if (sum == G) break;
    __builtin_amdgcn_s_sleep(1);
    if ((++sp & 255u) == 0u) { if (xb_ld(&bar[XB_TMO])) break; if (sp > XB_SPIN_CAP) { atomicAdd(&bar[XB_TMO], 1u); break; } }
  }
  nloc = mine > 0u ? mine : 1u; nx = cnt > 0u ? cnt : 1u;
}
DEV void xcd_barrier(const XcdBarrier& b) {
  asm volatile("s_waitcnt vmcnt(0)" ::: "memory");
  __syncthreads();
  if (threadIdx.x == 0) {
    unsigned* bar = b.bar;
    __builtin_amdgcn_s_waitcnt(0);
    unsigned nloc = b.st[0], nx = b.st[1];
    if (nloc == 0u) { xcd_barrier_complete(bar, b.x, nloc, nx); b.st[0] = nloc; b.st[1] = nx; }
    const unsigned old = xb_add(&bar[XB_XSUB(b.x)], 1u);
    const unsigned gen = old / nloc;
    if (old + 1u == (gen + 1u) * nloc) {
      __builtin_amdgcn_fence(__ATOMIC_RELEASE, "agent");
      asm volatile("s_waitcnt vmcnt(0)" ::: "memory");
      const unsigned og = xb_add(&bar[XB_TOP], 1u);
      const unsigned tg = og / nx;
      if (og + 1u == (tg + 1u) * nx) xb_add(&bar[XB_TOPGEN], 1u);
      else XB_SPIN(xb_ld(&bar[XB_TOPGEN]) == tg, bar);
      __builtin_amdgcn_fence(__ATOMIC_ACQUIRE, "agent");
      xb_add(&bar[XB_XGEN(b.x)], 1u);
      asm volatile("s_waitcnt vmcnt(0)" ::: "memory");
    } else {
      XB_SPIN(xb_ld(&bar[XB_XGEN(b.x)]) == gen, bar);
      __builtin_amdgcn_fence(__ATOMIC_ACQUIRE, "agent");
      asm volatile("s_waitcnt vmcnt(0)" ::: "memory");
    }
  }
  __syncthreads();
}

constexpr int SMEM_BYTES = 55296;

DEV void run_phase(const Params& p, int ph, int l, char* smem) {
  switch (ph) {
    case 0: phaseA(p, smem); break;
    case 1: norm_phase(p, l, 0); if (l == 1) layer_prep(p, 1, smem); break;
    case 2: phaseC(p, l, smem); break;
    case 3: phaseD(p, l, smem); break;
    case 4: phaseE(p, l); break;
    case 5: phaseF(p, l, smem); break;
    case 6: phaseG(p, l, smem); break;
    case 7: norm_phase(p, l, 1); break;
    case 8: phaseI(p, l, smem); break;
    case 9: phaseJ(p, l, smem); break;
    case 10: norm_phase(p, 0, 2); break;
  }
}

#if MULTI
__global__ void __launch_bounds__(256, 2) kphase(Params p, int ph, int l) {
  __shared__ __attribute__((aligned(16))) char smem[SMEM_BYTES];
  run_phase(p, ph, l, smem);
}
#else
__global__ void __launch_bounds__(256, 2) mega(Params p) {
  __shared__ __attribute__((aligned(16))) char smem[SMEM_BYTES];
  __shared__ uint4 xb_words;
  cg::grid_group grid = cg::this_grid();
  if (threadIdx.x == 0) xb_words = make_uint4(0u, 0u, 0u, 0u);
  __syncthreads();
  XcdBarrier xb = xcd_barrier_post((unsigned*)(p.ws + OFF_BAR), (volatile LAS unsigned*)&xb_words);
  run_phase(p, 0, 0, smem);
  grid.sync();
  for (int l = 0; l < 2; l++) {
    for (int ph = 1; ph <= 9; ph++) {
      run_phase(p, ph, l, smem);
      xcd_barrier(xb);
    }
  }
  run_phase(p, 10, 0, smem);
}
#endif

extern "C" void kernel_launch(void* const* d_in, const int* in_sizes, int n_in, void* d_out, int out_size, void* d_ws, size_t ws_size, hipStream_t stream) {
  Params p{};
  for (int i = 0; i < 36; i++) p.in[i] = (const float*)d_in[i];
  p.out = (float*)d_out;
  p.ws = (char*)d_ws;
  hipMemsetAsync((char*)d_ws + OFF_MOD, 0, ZERO_BYTES, stream);
  static int grid_blocks = 0;
#if MULTI
  if (!grid_blocks) {
    int dev = 0, cus = 0, per_cu = 0;
    hipGetDevice(&dev);
    hipDeviceGetAttribute(&cus, hipDeviceAttributeMultiprocessorCount, dev);
    hipOccupancyMaxActiveBlocksPerMultiprocessor(&per_cu, kphase, 256, 0);
    if (per_cu > 2) per_cu = 2;
    if (per_cu < 1) per_cu = 1;
    grid_blocks = cus * per_cu;
  }
  kphase<<<grid_blocks, 256, 0, stream>>>(p, 0, 0);
  for (int l = 0; l < 2; l++)
    for (int ph = 1; ph <= 9; ph++) kphase<<<grid_blocks, 256, 0, stream>>>(p, ph, l);
  kphase<<<grid_blocks, 256, 0, stream>>>(p, 10, 0);
#else
  if (!grid_blocks) {
    int dev = 0, cus = 0, per_cu = 0;
    hipGetDevice(&dev);
    hipDeviceGetAttribute(&cus, hipDeviceAttributeMultiprocessorCount, dev);
    hipOccupancyMaxActiveBlocksPerMultiprocessor(&per_cu, mega, 256, 0);
    if (per_cu > 2) per_cu = 2;
    if (per_cu < 1) per_cu = 1;
    grid_blocks = cus * per_cu;
  }
  void* args[] = {&p};
  hipError_t e = hipLaunchCooperativeKernel((void*)mega, dim3(grid_blocks), dim3(256), args, 0, stream);
  if (e != hipSuccess) fprintf(stderr, "cooperative launch failed: %s (grid %d)\n", hipGetErrorString(e), grid_blocks);
#endif
}
```

```cpp
#include <hip/hip_runtime.h>
#include <hip/hip_cooperative_groups.h>
#include <cstdio>
namespace cg = cooperative_groups;

#ifndef MULTI
#define MULTI 0
#endif

typedef unsigned short u16;
using bf16x8 = __attribute__((ext_vector_type(8))) short;
using f32x4 = __attribute__((ext_vector_type(4))) float;
using u32x4 = __attribute__((ext_vector_type(4))) unsigned;
using u32x2 = __attribute__((ext_vector_type(2))) unsigned;
#define DEV __device__ __forceinline__

constexpr int MT = 12288;
constexpr size_t OFF_WT = 0;
constexpr int WIN_O = 0, WGLU_O = 7340032, WRETO_O = 8388608, WHYO_O = 8912896, WOUT_O = 9437184, WFIN_O = 10485760, WFOUT_O = 16252928;
constexpr size_t OFF_G = 38273024;
constexpr size_t OFF_H = 48758784;
constexpr size_t OFF_ZA = 73924608;
constexpr size_t OFF_HYZ = 124256256;
constexpr size_t OFF_VT = 162004992;
constexpr size_t OFF_KT = 174587904;
constexpr size_t OFF_QR = 182976512;
constexpr size_t OFF_YP = 187170816;
constexpr size_t OFF_OUT1 = 212336640;
constexpr size_t OFF_MOD = 237502464;
constexpr size_t OFF_SUMSQ = OFF_MOD + 245760;
constexpr size_t OFF_BAR = OFF_SUMSQ + 16384;
constexpr size_t ZERO_BYTES = 245760 + 16384 + 16384;
constexpr size_t OFF_LAMBAR = OFF_BAR + 16384;
constexpr size_t OFF_BBAR = OFF_LAMBAR + 65536;
constexpr size_t OFF_CM = OFF_BBAR + 524288;
constexpr size_t OFF_ROPE = OFF_CM + 524288;
constexpr size_t OFF_S0T = OFF_ROPE + 524288;
constexpr size_t WS_END = OFF_S0T + 2097152;

struct Params {
  const float* in[36];
  float* out;
  char* ws;
};


DEV int TID() { int t = threadIdx.x; asm volatile("" : "+v"(t)); return t; }
DEV int BID() { int t = blockIdx.x; asm volatile("" : "+s"(t)); return t; }
DEV char* WS(const Params& p) { char* w = p.ws; asm volatile("" : "+s"(w)); return w; }
DEV float* OUTP(const Params& p) { float* w = p.out; asm volatile("" : "+s"(w)); return w; }
DEV const float* INP(const Params& p, int i) { const float* w = p.in[i]; asm volatile("" : "+s"(w)); return w; }

DEV u16 f2bf(float f) { unsigned u = __float_as_uint(f); u += 0x7fffu + ((u >> 16) & 1u); return (u16)(u >> 16); }
DEV float bf2f(u16 h) { return __uint_as_float(((unsigned)h) << 16); }
DEV float sigm(float x) { return 1.f / (1.f + __expf(-x)); }
DEV float silu_(float x) { return x / (1.f + __expf(-x)); }
DEV float gelu_(float x) { float u = 0.7978845608028654f * (x + 0.044715f * x * x * x); return 0.5f * x * (1.f + tanhf(u)); }
DEV unsigned pack2(float a, float b) { return (unsigned)f2bf(a) | ((unsigned)f2bf(b) << 16); }

DEV const float* xin_row(const Params& p, int row) { return row < 8192 ? INP(p, 0) + (size_t)row * 1024 : INP(p, 1) + (size_t)(row - 8192) * 1024; }
DEV int modidx(int row) { return row < 8192 ? 0 : 1 + ((row - 8192) >> 10); }

template <int MF, int NF>
DEV void gemm_loop(const u16* __restrict__ A, int lda, const u16* __restrict__ B, int ldb, int K, f32x4 (&acc)[MF][NF], u16* sA) {
  const int tid = TID(), lane = tid & 63, wid = tid >> 6, wr = wid >> 1, wc = wid & 1, fr = lane & 15, fq = lane >> 4;
  u16* sB = sA + MF * 32 * 72;
  u32x4 ra[MF], rb[NF];
  const int crow = tid >> 3, ccol = (tid & 7) * 8;
  const u16* Ap = A + (size_t)crow * lda + ccol;
  const u16* Bp = B + (size_t)crow * ldb + ccol;
#pragma unroll
  for (int i = 0; i < MF; i++) ra[i] = *(const u32x4*)(Ap + (size_t)(i * 32) * lda);
#pragma unroll
  for (int i = 0; i < NF; i++) rb[i] = *(const u32x4*)(Bp + (size_t)(i * 32) * ldb);
  for (int k0 = 0; k0 < K; k0 += 64) {
    __syncthreads();
#pragma unroll
    for (int i = 0; i < MF; i++) *(u32x4*)(sA + (crow + i * 32) * 72 + ccol) = ra[i];
#pragma unroll
    for (int i = 0; i < NF; i++) *(u32x4*)(sB + (crow + i * 32) * 72 + ccol) = rb[i];
    __syncthreads();
    if (k0 + 64 < K) {
#pragma unroll
      for (int i = 0; i < MF; i++) ra[i] = *(const u32x4*)(Ap + (size_t)(i * 32) * lda + k0 + 64);
#pragma unroll
      for (int i = 0; i < NF; i++) rb[i] = *(const u32x4*)(Bp + (size_t)(i * 32) * ldb + k0 + 64);
    }
#pragma unroll
    for (int ks = 0; ks < 2; ks++) {
      bf16x8 bv[NF];
#pragma unroll
      for (int n = 0; n < NF; n++) bv[n] = *(const bf16x8*)(sB + (wc * (NF * 16) + n * 16 + fr) * 72 + ks * 32 + fq * 8);
#pragma unroll
      for (int m = 0; m < MF; m++) {
        bf16x8 af = *(const bf16x8*)(sA + (m * 32 + wr * 16 + fr) * 72 + ks * 32 + fq * 8);
#pragma unroll
        for (int n = 0; n < NF; n++) acc[m][n] = __builtin_amdgcn_mfma_f32_16x16x32_bf16(af, bv[n], acc[m][n], 0, 0, 0);
      }
    }
  }
}

template <int MF, int NF>
DEV void zero_acc(f32x4 (&acc)[MF][NF]) {
#pragma unroll
  for (int m = 0; m < MF; m++)
#pragma unroll
    for (int n = 0; n < NF; n++) acc[m][n] = f32x4{0.f, 0.f, 0.f, 0.f};
}

DEV float epi_op(float v, int op) { return op == 1 ? v * 0.08838834764831845f : (op == 2 ? silu_(v) : v); }
template <int MF, int NF, int TS>
DEV void acc_to_lds(const f32x4 (&acc)[MF][NF], u16* T, int m0, int op = 0) {
  const int tid = TID(), lane = tid & 63, wid = tid >> 6, wr = wid >> 1, wc = wid & 1, fr = lane & 15, fq = lane >> 4;
#pragma unroll
  for (int m = 0; m < 4; m++)
#pragma unroll
    for (int n = 0; n < NF; n++)
#pragma unroll
      for (int j = 0; j < 4; j++) T[(m * 32 + wr * 16 + fq * 4 + j) * TS + wc * (NF * 16) + n * 16 + fr] = f2bf(epi_op(acc[m0 + m][n][j], op));
}
template <int MF>
DEV void acc_to_lds_T(const f32x4 (&acc)[MF][4], u16* T, int m0, int op = 0) {
  const int tid = TID(), lane = tid & 63, wid = tid >> 6, wr = wid >> 1, wc = wid & 1, fr = lane & 15, fq = lane >> 4;
#pragma unroll
  for (int m = 0; m < 4; m++)
#pragma unroll
    for (int n = 0; n < 4; n++) {
      u32x2 v; v.x = pack2(epi_op(acc[m0 + m][n][0], op), epi_op(acc[m0 + m][n][1], op)); v.y = pack2(epi_op(acc[m0 + m][n][2], op), epi_op(acc[m0 + m][n][3], op));
      *(u32x2*)(T + (wc * 64 + n * 16 + fr) * 136 + m * 32 + wr * 16 + fq * 4) = v;
    }
}
template <int COLS, int TS>
DEV void copy_tile(const u16* T, u16* dst, int ld) {
  constexpr int CPR = COLS / 8;
  constexpr int NIT = 128 * CPR / 256;
#pragma unroll
  for (int i = 0; i < NIT; i++) {
    int id = TID() + i * 256; int r = id / CPR, ch = id % CPR;
    *(u32x4*)(dst + (size_t)r * ld + ch * 8) = *(const u32x4*)(T + r * TS + ch * 8);
  }
}

DEV void transpose_tile(const float* __restrict__ src, int K, int N, u16* __restrict__ dst, int tile, float* sm, int perm = 0) {
  int nk = K >> 6; int tk = tile % nk, tn = tile / nk; int k0 = tk * 64, n0 = tn * 64;
  int tx = TID() & 63, ty = TID() >> 6;
  __syncthreads();
#pragma unroll
  for (int i = 0; i < 16; i++) { int k = ty + i * 4; sm[k * 65 + tx] = src[(size_t)(k0 + k) * N + n0 + tx]; }
  __syncthreads();
#pragma unroll
  for (int i = 0; i < 16; i++) {
    int n = n0 + ty + i * 4;
    if (perm) { int half = N >> 1; int j = n < half ? n : n - half; n = (j >> 4) * 32 + (n < half ? 0 : 16) + (j & 15); }
    dst[(size_t)n * K + k0 + tx] = f2bf(sm[tx * 65 + (ty + i * 4)]);
  }
}

DEV void wt_task(const Params& p, int l, int t, float* sm) {
  u16* WT = (u16*)(WS(p) + OFF_WT);
  const float* src; int K, N, off, tt, perm = 0;
  if (t < 1792) { src = INP(p, 10) + (size_t)l * 1024 * 7168; K = 1024; N = 7168; off = WIN_O; tt = t; }
  else if (t < 2048) { src = INP(p, 19) + (size_t)l * 512 * 2048; K = 512; N = 2048; off = WGLU_O; tt = t - 1792; }
  else if (t < 2176) { src = INP(p, 21) + (size_t)l * 512 * 1024; K = 512; N = 1024; off = WRETO_O; tt = t - 2048; }
  else if (t < 2304) { src = INP(p, 31) + (size_t)l * 512 * 1024; K = 512; N = 1024; off = WHYO_O; tt = t - 2176; }
  else if (t < 2560) { src = INP(p, 32) + (size_t)l * 1024 * 1024; K = 1024; N = 1024; off = WOUT_O; tt = t - 2304; }
  else if (t < 3968) { src = INP(p, 33) + (size_t)l * 1024 * 5632; K = 1024; N = 5632; off = WFIN_O; tt = t - 2560; perm = 1; }
  else { src = INP(p, 34) + (size_t)l * 2816 * 1024; K = 2816; N = 1024; off = WFOUT_O; tt = t - 3968; }
  transpose_tile(src, K, N, WT + off, tt, sm, perm);
}

DEV void mod_task(const Params& p, int task, float* sm) {
  int cb = task % 24; int l = task / 24;
  int tid = TID();
  __syncthreads();
  for (int i = tid; i < 5120; i += 256) {
    int j = i >> 10, k = i & 1023;
    float c = (j == 0) ? INP(p, 5)[k] : INP(p, 4)[(j - 1) * 1024 + k];
    sm[i] = silu_(c);
  }
  __syncthreads();
  int col = cb * 256 + tid;
  const float* w = INP(p, 6) + (size_t)l * 1024 * 6144 + col;
  float a0 = 0, a1 = 0, a2 = 0, a3 = 0, a4 = 0;
#pragma unroll 8
  for (int k = 0; k < 1024; k++) {
    float wv = w[(size_t)k * 6144];
    a0 += sm[k] * wv; a1 += sm[1024 + k] * wv; a2 += sm[2048 + k] * wv; a3 += sm[3072 + k] * wv; a4 += sm[4096 + k] * wv;
  }
  float* MOD = (float*)(WS(p) + OFF_MOD);
  MOD[(l * 5 + 0) * 6144 + col] = a0;
  MOD[(l * 5 + 1) * 6144 + col] = a1;
  MOD[(l * 5 + 2) * 6144 + col] = a2;
  MOD[(l * 5 + 3) * 6144 + col] = a3;
  MOD[(l * 5 + 4) * 6144 + col] = a4;
}

DEV void filt_task(const Params& p, int l, int task, float* sm) {
  int Lsel = task >= 32; int tb = Lsel ? task - 32 : task; int L = Lsel ? 1024 : 256; int t0 = tb * 8;
  int tid = TID();
  float* z = sm; float* h1 = sm + 264; float* h2 = sm + 264 + 512;
  const float* w1 = INP(p, 24) + l * 33 * 64; const float* b1 = INP(p, 25) + l * 64;
  const float* w2 = INP(p, 26) + l * 64 * 64; const float* b2 = INP(p, 27) + l * 64;
  const float* fr0 = INP(p, 28) + l * 128; const float* fr1 = fr0 + 64;
  const float* w3 = INP(p, 29) + (size_t)l * 64 * 2048;
  __syncthreads();
  for (int i = tid; i < 264; i += 256) {
    int tt = i / 33, e = i % 33; float t = (float)(t0 + tt); float v;
    if (e == 0) v = t / (float)L;
    else {
      int b = (e - 1) & 15; float band = 1e-4f + (float)b * ((15.f - 1e-4f) / 15.f);
      float ang = (6.283185307179586f / (float)L) * t * band;
      v = (e <= 16) ? cosf(ang) : -sinf(ang);
    }
    z[i] = v;
  }
  __syncthreads();
  for (int i = tid; i < 512; i += 256) {
    int tt = i >> 6, j = i & 63; float s = b1[j];
    for (int e = 0; e < 33; e++) s += z[tt * 33 + e] * w1[e * 64 + j];
    h1[i] = sinf(fr0[j] * s);
  }
  __syncthreads();
  for (int i = tid; i < 512; i += 256) {
    int tt = i >> 6, j = i & 63; float s = b2[j];
    for (int e = 0; e < 64; e++) s += h1[tt * 64 + e] * w2[e * 64 + j];
    h2[i] = sinf(fr1[j] * s);
  }
  __syncthreads();
  float* FB = (float*)(WS(p) + OFF_G) + (Lsel ? 524288 : 0);
  float* SUMSQ = (float*)(WS(p) + WS_END);
  for (int m = 0; m < 8; m++) {
    int col = tid + m * 256;
    float acc[8];
#pragma unroll
    for (int tt = 0; tt < 8; tt++) acc[tt] = 0.f;
    for (int j = 0; j < 64; j++) {
      float w = w3[j * 2048 + col];
#pragma unroll
      for (int tt = 0; tt < 8; tt++) acc[tt] += h2[tt * 64 + j] * w;
    }
    int dir = col >> 10, o = (col >> 9) & 1, c = col & 511;
    float rate = 3.0701134573253944f + (float)c * ((15.350567286626972f - 3.0701134573253944f) / 511.f);
    float ss = 0.f;
    float* Fo = FB + (size_t)o * (2 * L) * 512 + c;
#pragma unroll
    for (int tt = 0; tt < 8; tt++) {
      int t = t0 + tt;
      float val = acc[tt] * expf(-((float)t / (float)L) * rate);
      if (dir == 0) { Fo[(size_t)(L + t) * 512] = val; ss += val * val; }
      else if (t > 0) { Fo[(size_t)(L - t) * 512] = val; ss += val * val; }
      else { Fo[0] = 0.f; }
    }
    SUMSQ[((size_t)l * 160 + task) * 2048 + col] = ss;
  }
}

DEV void s5prep_task(const Params& p, int task) {
  int idx = task * 256 + TID();
  int pp = idx & 63; int lrg = idx >> 6;
  float lre = INP(p, 11)[idx], lim = INP(p, 12)[idx];
  float dt = expf(INP(p, 13)[lrg]);
  float mag = expf(lre * dt);
  float lbr = mag * cosf(lim * dt), lbi = mag * sinf(lim * dt);
  float nr = lbr - 1.f, ni = lbi; float den = lre * lre + lim * lim;
  float cr = (nr * lre + ni * lim) / den, ci = (ni * lre - nr * lim) / den;
  u16* BBAR = (u16*)(WS(p) + OFF_BBAR); u16* CM = (u16*)(WS(p) + OFF_CM); float* LB = (float*)(WS(p) + OFF_LAMBAR);
  LB[idx * 2] = lbr; LB[idx * 2 + 1] = lbi;
  for (int c = 0; c < 16; c++) {
    float br = INP(p, 14)[(size_t)idx * 16 + c], bi = INP(p, 15)[(size_t)idx * 16 + c];
    BBAR[(size_t)lrg * 2048 + pp * 16 + c] = f2bf(cr * br - ci * bi);
    BBAR[(size_t)lrg * 2048 + (64 + pp) * 16 + c] = f2bf(cr * bi + ci * br);
    CM[(size_t)lrg * 2048 + c * 128 + pp] = f2bf(INP(p, 16)[(size_t)lrg * 1024 + c * 64 + pp]);
    CM[(size_t)lrg * 2048 + c * 128 + 64 + pp] = f2bf(-INP(p, 17)[(size_t)lrg * 1024 + c * 64 + pp]);
  }
}

DEV void rope_task(const Params& p, int task) {
  int idx = task * 256 + TID(); int t = idx >> 6, d = idx & 63; int f = d & 31;
  float inv = powf(10000.f, -(float)f / 32.f);
  float pos = (d < 32) ? (float)(t >> 6) : (float)(t & 63);
  float ang = pos * inv;
  float* R = (float*)(WS(p) + OFF_ROPE);
  R[idx * 2] = cosf(ang); R[idx * 2 + 1] = sinf(ang);
}

DEV void layer_prep(const Params& p, int l, char* smem) {
  for (int t = BID(); t < 4672 + 160; t += gridDim.x) {
    if (t < 4672) wt_task(p, l, t, (float*)smem);
    else filt_task(p, l, t - 4672, (float*)smem);
  }
}
DEV void phaseA(const Params& p, char* smem) {
  for (int t = BID(); t < 48 + 32 + 256 + 256; t += gridDim.x) {
    if (t < 48) mod_task(p, t, (float*)smem);
    else if (t < 80) s5prep_task(p, t - 48);
    else if (t < 336) rope_task(p, t - 80);
    else { int tt = t - 336; int mi = tt >> 2; transpose_tile(INP(p, 3) + (size_t)mi * 16384, 128, 128, (u16*)(WS(p) + OFF_S0T) + (size_t)mi * 16384, tt & 3, (float*)smem); }
  }
  layer_prep(p, 0, smem);
}

DEV void norm_phase(const Params& p, int l, int which) {
  const int lane = TID() & 63;
  const int wave = (BID() * blockDim.x + TID()) >> 6, nw = (gridDim.x * blockDim.x) >> 6;
  u16* H = (u16*)(WS(p) + OFF_H);
  const float* MOD = (const float*)(WS(p) + OFF_MOD);
  for (int row = wave; row < MT; row += nw) {
    const float* x = (l == 0 && which == 0) ? xin_row(p, row) : OUTP(p) + (size_t)row * 1024;
    float4 v[4]; float ss = 0.f;
#pragma unroll
    for (int i = 0; i < 4; i++) { v[i] = *(const float4*)(x + i * 256 + lane * 4); ss += v[i].x * v[i].x + v[i].y * v[i].y + v[i].z * v[i].z + v[i].w * v[i].w; }
#pragma unroll
    for (int o = 32; o > 0; o >>= 1) ss += __shfl_xor(ss, o, 64);
    float rinv = rsqrtf(ss * (1.f / 1024.f) + 1e-6f);
    if (which == 2) {
      const float* nf = INP(p, 35);
#pragma unroll
      for (int i = 0; i < 4; i++) {
        float4 g = *(const float4*)(nf + i * 256 + lane * 4);
        float4 o; o.x = v[i].x * rinv * g.x; o.y = v[i].y * rinv * g.y; o.z = v[i].z * rinv * g.z; o.w = v[i].w * rinv * g.w;
        *(float4*)(OUTP(p) + (size_t)row * 1024 + i * 256 + lane * 4) = o;
      }
    } else {
      int j = modidx(row);
      const float* nwt = (which == 0 ? INP(p, 8) : INP(p, 9)) + l * 1024;
      const float* msh = MOD + (l * 5 + j) * 6144 + (which ? 3 : 0) * 1024;
      const float* msc = msh + 1024;
      const float* bsh = INP(p, 7) + l * 6144 + (which ? 3 : 0) * 1024;
      const float* bsc = bsh + 1024;
#pragma unroll
      for (int i = 0; i < 4; i++) {
        int k = i * 256 + lane * 4;
        float4 g = *(const float4*)(nwt + k);
        float4 sh = *(const float4*)(msh + k), sc = *(const float4*)(msc + k);
        float4 bh = *(const float4*)(bsh + k), bc = *(const float4*)(bsc + k);
        float o0 = v[i].x * rinv * g.x * (1.f + sc.x + bc.x) + sh.x + bh.x;
        float o1 = v[i].y * rinv * g.y * (1.f + sc.y + bc.y) + sh.y + bh.y;
        float o2 = v[i].z * rinv * g.z * (1.f + sc.z + bc.z) + sh.z + bh.z;
        float o3 = v[i].w * rinv * g.w * (1.f + sc.w + bc.w) + sh.w + bh.w;
        u32x2 pk; pk.x = pack2(o0, o1); pk.y = pack2(o2, o3);
        *(u32x2*)(H + (size_t)row * 1024 + k) = pk;
      }
    }
  }
}

DEV void phaseC(const Params& p, int l, char* smem) {
  u16* sA = (u16*)smem; u16* T = (u16*)smem;
  const u16* H = (const u16*)(WS(p) + OFF_H);
  const u16* WIN = (const u16*)(WS(p) + OFF_WT) + WIN_O;
  u16* ZA = (u16*)(WS(p) + OFF_ZA); u16* HYT = (u16*)(WS(p) + OFF_HYZ); u16* VT = (u16*)(WS(p) + OFF_VT);
  u16* KT = (u16*)(WS(p) + OFF_KT); u16* QR = (u16*)(WS(p) + OFF_QR);
  const float* ROPE = (const float*)(WS(p) + OFF_ROPE);
  const int tid = TID();
  for (int tile = BID(); tile < 48 * 32; tile += gridDim.x) {
    int tm = tile >> 5, tn = tile & 31;
    f32x4 acc[8][4]; zero_acc<8, 4>(acc);
    gemm_loop<8, 4>(H + (size_t)tm * 256 * 1024, 1024, WIN + (size_t)tn * 128 * 1024, 1024, 1024, acc, sA);
    int kind = tn >> 2, hd = tn & 3;
    const int op = kind == 2 ? 1 : (kind == 4 ? 2 : 0);
#pragma unroll
    for (int hh = 0; hh < 2; hh++) {
      int row0 = tm * 256 + hh * 128; bool lat = row0 >= 8192;
      int seq, t0, L;
      if (!lat) { seq = row0 >> 8; t0 = row0 & 255; L = 256; } else { seq = (row0 - 8192) >> 10; t0 = (row0 - 8192) & 1023; L = 1024; }
      __syncthreads();
      if (kind == 3 || kind >= 5) {
        acc_to_lds_T<8>(acc, T, hh * 4, 0);
        __syncthreads();
        u16* dst;
        if (kind == 3) dst = lat ? VT + (size_t)8192 * 512 + (size_t)((seq * 4 + hd) * 128) * 1024 + t0 : VT + (size_t)((seq * 4 + hd) * 128) * 256 + t0;
        else dst = lat ? HYT + (size_t)8192 * 1536 + ((size_t)seq * 1536 + (tn - 20) * 128) * 1024 + t0 : HYT + ((size_t)seq * 1536 + (tn - 20) * 128) * 256 + t0;
        copy_tile<128, 136>(T, dst, L);
      } else {
        acc_to_lds<8, 4, 136>(acc, T, hh * 4, op);
        __syncthreads();
        bool roped = lat && (kind == 1 || kind == 2);
        if (!(lat && kind == 2)) {
          u16* dst;
          if (kind == 0) dst = ZA + (size_t)row0 * 2048 + hd * 128;
          else if (kind == 1) dst = ZA + (size_t)row0 * 2048 + 512 + hd * 128;
          else if (kind == 2) dst = ZA + (size_t)row0 * 2048 + 1024 + hd * 128;
          else dst = ZA + (size_t)row0 * 2048 + 1536 + hd * 128;
          copy_tile<128, 136>(T, dst, 2048);
        }
        if (roped) {
          u16* dst; int ld;
          if (kind == 1) { dst = QR + (size_t)(row0 - 8192) * 512 + hd * 128; ld = 512; }
          else { dst = ZA + (size_t)row0 * 2048 + 1024 + hd * 128; ld = 2048; }
#pragma unroll 1
          for (int i = 0; i < 4; i++) {
            int id = tid + i * 256; int r = id >> 3, ch = id & 7;
            u32x4 a = *(const u32x4*)(T + r * 136 + ch * 8);
            u32x4 b = *(const u32x4*)(T + r * 136 + 64 + ch * 8);
            const float4* cs = (const float4*)(ROPE + ((size_t)(t0 + r) * 64 + ch * 8) * 2);
            u32x4 o1, o2;
#pragma unroll
            for (int q = 0; q < 4; q++) {
              float4 c4 = cs[q];
              float x1a = __uint_as_float(a[q] << 16), x1b = __uint_as_float(a[q] & 0xffff0000u);
              float x2a = __uint_as_float(b[q] << 16), x2b = __uint_as_float(b[q] & 0xffff0000u);
              o1[q] = pack2(x1a * c4.x - x2a * c4.y, x1b * c4.z - x2b * c4.w);
              o2[q] = pack2(x1a * c4.y + x2a * c4.x, x1b * c4.w + x2b * c4.z);
            }
            *(u32x4*)(dst + (size_t)r * ld + ch * 8) = o1;
            *(u32x4*)(dst + (size_t)r * ld + 64 + ch * 8) = o2;
          }
        }
        if (kind == 2 && !lat) {
          __syncthreads();
          acc_to_lds_T<8>(acc, T, hh * 4, op);
          __syncthreads();
          copy_tile<128, 136>(T, KT + (size_t)((seq * 4 + hd) * 128) * 256 + t0, 256);
        }
      }
    }
  }
}

DEV void s5_task(const Params& p, int l, int task, char* smem) {
  const int tid = TID(), lane = tid & 63, wid = tid >> 6, fr = lane & 15, fq = lane >> 4;
  int seq, gp;
  if (task < 64) { seq = 32 + (task >> 4); gp = task & 15; } else { int t2 = task - 64; seq = t2 >> 4; gp = t2 & 15; }
  const bool lat = seq >= 32;
  const int L = lat ? 1024 : 256;
  const int row0 = lat ? 8192 + (seq - 32) * 1024 : seq * 256;
  const int grp = gp * 2 + (wid >> 1), dir = wid & 1;
  const int lrg = (l * 2 + dir) * 32 + grp;
  float* BU = (float*)(smem + wid * 12544);
  u16* HB = (u16*)(smem + wid * 12544 + 8192);
  u16* ZA = (u16*)(WS(p) + OFF_ZA);
  float* YP = (float*)(WS(p) + OFF_YP);
  const u16* BBAR = (const u16*)(WS(p) + OFF_BBAR) + (size_t)lrg * 2048;
  const u16* CM = (const u16*)(WS(p) + OFF_CM) + (size_t)lrg * 2048;
  const float* LB = (const float*)(WS(p) + OFF_LAMBAR) + ((size_t)lrg * 64 + lane) * 2;
  const float lr = LB[0], li = LB[1];
  bf16x8 bfrag[8], cfrag[4];
  const bf16x8 zero8 = {0, 0, 0, 0, 0, 0, 0, 0};
#pragma unroll
  for (int nt = 0; nt < 8; nt++) bfrag[nt] = (fq < 2) ? *(const bf16x8*)(BBAR + (nt * 16 + fr) * 16 + fq * 8) : zero8;
#pragma unroll
  for (int ks = 0; ks < 4; ks++) cfrag[ks] = *(const bf16x8*)(CM + fr * 128 + ks * 32 + fq * 8);
  float hr = 0.f, hi = 0.f;
  if (lat) {
    const float* s0 = INP(p, 2) + ((((size_t)(seq - 32) * 2 + l) * 2 + dir) * 32 + grp) * 128 + lane * 2;
    hr = s0[0]; hi = s0[1];
  }
  const float dcoef = INP(p, 18)[l * 512 + grp * 16 + fr];
  const int nch = L >> 4;
  __syncthreads();
  for (int i = 0; i < nch; i++) {
    const int ci = dir ? nch - 1 - i : i; const int t0 = ci * 16;
    if (i == (nch >> 1)) { __threadfence(); __syncthreads(); }
    bf16x8 ua = (fq < 2) ? *(const bf16x8*)(ZA + (size_t)(row0 + t0 + fr) * 2048 + grp * 16 + fq * 8) : zero8;
#pragma unroll
    for (int nt = 0; nt < 8; nt++) {
      f32x4 r = __builtin_amdgcn_mfma_f32_16x16x32_bf16(ua, bfrag[nt], f32x4{0.f, 0.f, 0.f, 0.f}, 0, 0, 0);
#pragma unroll
      for (int j = 0; j < 4; j++) BU[(fq * 4 + j) * 128 + nt * 16 + fr] = r[j];
    }
    asm volatile("s_waitcnt lgkmcnt(0)" ::: "memory");
#pragma unroll
    for (int tt = 0; tt < 16; tt++) {
      const int t = dir ? 15 - tt : tt;
      float re = BU[t * 128 + lane], im = BU[t * 128 + 64 + lane];
      float nr = lr * hr - li * hi + re; float ni = lr * hi + li * hr + im;
      hr = nr; hi = ni;
      HB[t * 136 + lane] = f2bf(hr); HB[t * 136 + 64 + lane] = f2bf(hi);
    }
    asm volatile("s_waitcnt lgkmcnt(0)" ::: "memory");
    f32x4 y = {0.f, 0.f, 0.f, 0.f};
#pragma unroll
    for (int ks = 0; ks < 4; ks++) {
      bf16x8 a = *(const bf16x8*)(HB + fr * 136 + ks * 32 + fq * 8);
      y = __builtin_amdgcn_mfma_f32_16x16x32_bf16(a, cfrag[ks], y, 0, 0, 0);
    }
    asm volatile("s_waitcnt lgkmcnt(0)" ::: "memory");
    if (i < (nch >> 1)) {
#pragma unroll
      for (int j = 0; j < 4; j++) YP[(size_t)(row0 + t0 + fq * 4 + j) * 512 + grp * 16 + fr] = y[j];
    } else {
#pragma unroll
      for (int j = 0; j < 4; j++) {
        size_t row = (size_t)(row0 + t0 + fq * 4 + j);
        float other = __hip_atomic_load(&YP[row * 512 + grp * 16 + fr], __ATOMIC_RELAXED, __HIP_MEMORY_SCOPE_AGENT);
        u16* up = ZA + row * 2048 + grp * 16 + fr;
        float u = bf2f(*up);
        float v = y[j] + other + dcoef * u;
        *up = f2bf(gelu_(v));
      }
    }
  }
  if (!lat) {
    float* o = OUTP(p) + 12582912 + ((((size_t)seq * 2 + l) * 2 + dir) * 32 + grp) * 128 + lane * 2;
    o[0] = hr; o[1] = hi;
  }
}

DEV void ret_task(const Params& p, int l, int task, char* smem) {
  const int tid = TID(), lane = tid & 63, wid = tid >> 6, fr = lane & 15, fq = lane >> 4;
  int seq, h, qt; bool lat;
  if (task < 256) { lat = true; seq = task >> 6; h = (task >> 4) & 3; qt = task & 15; }
  else { int t2 = task - 256; lat = false; seq = t2 >> 4; h = (t2 >> 2) & 3; qt = t2 & 3; }
  const int L = lat ? 1024 : 256;
  const int row0 = lat ? 8192 + seq * 1024 : seq * 256;
  u16* sK = (u16*)smem; u16* sV = sK + 64 * 136; u16* sP = sV + 128 * 72 + wid * 16 * 72;
  u16* ZA = (u16*)(WS(p) + OFF_ZA);
  const u16* QR = (const u16*)(WS(p) + OFF_QR);
  const u16* VT = (const u16*)(WS(p) + OFF_VT);
  const float lgf = log1pf(-expf(INP(p, 20)[(l * 2 + 0) * 4 + h])), lgb = log1pf(-expf(INP(p, 20)[(l * 2 + 1) * 4 + h]));
  const int qrow = qt * 64 + wid * 16;
  const u16* qsrc = lat ? QR + (size_t)(row0 - 8192 + qrow + fr) * 512 + h * 128 : ZA + (size_t)(row0 + qrow + fr) * 2048 + 512 + h * 128;
  bf16x8 qa[4];
#pragma unroll
  for (int ks = 0; ks < 4; ks++) qa[ks] = *(const bf16x8*)(qsrc + ks * 32 + fq * 8);
  f32x4 o[8];
#pragma unroll
  for (int n = 0; n < 8; n++) o[n] = f32x4{0.f, 0.f, 0.f, 0.f};
  const u16* Kbase = ZA + (size_t)row0 * 2048 + 1024 + h * 128;
  const u16* Vbase = lat ? VT + (size_t)8192 * 512 + (size_t)((seq * 4 + h) * 128) * 1024 : VT + (size_t)((seq * 4 + h) * 128) * 256;
  const int nkt = L >> 6;
  for (int jt = 0; jt < nkt; jt++) {
    __syncthreads();
#pragma unroll
    for (int i = 0; i < 4; i++) {
      int id = tid + i * 256; int r = id >> 4, ch = id & 15;
      *(u32x4*)(sK + r * 136 + ch * 8) = *(const u32x4*)(Kbase + (size_t)(jt * 64 + r) * 2048 + ch * 8);
    }
#pragma unroll
    for (int i = 0; i < 4; i++) {
      int id = tid + i * 256; int e = id >> 3, ch = id & 7;
      *(u32x4*)(sV + e * 72 + ch * 8) = *(const u32x4*)(Vbase + (size_t)e * L + jt * 64 + ch * 8);
    }
    __syncthreads();
    f32x4 s[4];
#pragma unroll
    for (int nt = 0; nt < 4; nt++) {
      s[nt] = f32x4{0.f, 0.f, 0.f, 0.f};
#pragma unroll
      for (int ks = 0; ks < 4; ks++) {
        bf16x8 b = *(const bf16x8*)(sK + (nt * 16 + fr) * 136 + ks * 32 + fq * 8);
        s[nt] = __builtin_amdgcn_mfma_f32_16x16x32_bf16(qa[ks], b, s[nt], 0, 0, 0);
      }
      asm volatile("" ::: "memory");
    }
#pragma unroll
    for (int nt = 0; nt < 4; nt++)
#pragma unroll
      for (int j = 0; j < 4; j++) {
        int d = (qrow + fq * 4 + j) - (jt * 64 + nt * 16 + fr);
        float w = d >= 0 ? __expf(lgf * (float)d) : __expf(lgb * (float)(-d));
        sP[(fq * 4 + j) * 72 + nt * 16 + fr] = f2bf(s[nt][j] * w);
      }
    asm volatile("s_waitcnt lgkmcnt(0)" ::: "memory");
#pragma unroll
    for (int k2 = 0; k2 < 2; k2++) {
      bf16x8 a = *(const bf16x8*)(sP + fr * 72 + k2 * 32 + fq * 8);
#pragma unroll
      for (int n2 = 0; n2 < 8; n2++) {
        bf16x8 b = *(const bf16x8*)(sV + (n2 * 16 + fr) * 72 + k2 * 32 + fq * 8);
        o[n2] = __builtin_amdgcn_mfma_f32_16x16x32_bf16(a, b, o[n2], 0, 0, 0);
        if (n2 == 3) asm volatile("" ::: "memory");
      }
      asm volatile("" ::: "memory");
    }
    asm volatile("s_waitcnt lgkmcnt(0)" ::: "memory");
  }
  if (lat) {
    const u16* q0src = ZA + (size_t)(row0 + qrow + fr) * 2048 + 512 + h * 128;
    bf16x8 q0[4];
#pragma unroll
    for (int ks = 0; ks < 4; ks++) q0[ks] = *(const bf16x8*)(q0src + ks * 32 + fq * 8);
#pragma unroll 1
    for (int dir = 0; dir < 2; dir++) {
      const u16* S0 = (const u16*)(WS(p) + OFF_S0T) + (size_t)((((seq * 2 + l) * 2 + dir) * 4 + h)) * 16384;
      float wj[4];
#pragma unroll
      for (int j = 0; j < 4; j++) { int gi = qrow + fq * 4 + j; wj[j] = dir == 0 ? __expf(lgf * (float)(gi + 1)) : __expf(lgb * (float)(L - 1 - gi)); }
#pragma unroll
      for (int n2 = 0; n2 < 8; n2++) {
        f32x4 tmp = {0.f, 0.f, 0.f, 0.f};
#pragma unroll
        for (int ks = 0; ks < 4; ks++) {
          bf16x8 b = *(const bf16x8*)(S0 + (size_t)(n2 * 16 + fr) * 128 + ks * 32 + fq * 8);
          tmp = __builtin_amdgcn_mfma_f32_16x16x32_bf16(q0[ks], b, tmp, 0, 0, 0);
        }
#pragma unroll
        for (int j = 0; j < 4; j++) o[n2][j] += wj[j] * tmp[j];
        asm volatile("" ::: "memory");
      }
    }
  }
#pragma unroll
  for (int j = 0; j < 4; j++) {
    float s = 0.f;
#pragma unroll
    for (int n2 = 0; n2 < 8; n2++) s += o[n2][j];
    s += __shfl_xor(s, 1, 64); s += __shfl_xor(s, 2, 64); s += __shfl_xor(s, 4, 64); s += __shfl_xor(s, 8, 64);
    float mean = s * (1.f / 128.f);
    float v = 0.f;
#pragma unroll
    for (int n2 = 0; n2 < 8; n2++) { float dd = o[n2][j] - mean; v += dd * dd; }
    v += __shfl_xor(v, 1, 64); v += __shfl_xor(v, 2, 64); v += __shfl_xor(v, 4, 64); v += __shfl_xor(v, 8, 64);
    float rstd = rsqrtf(v * (1.f / 128.f) + 1e-5f);
    size_t rbase = (size_t)(row0 + qrow + fq * 4 + j) * 2048;
#pragma unroll
    for (int n2 = 0; n2 < 8; n2++) {
      int e = n2 * 16 + fr;
      float gv = bf2f(ZA[rbase + 1536 + h * 128 + e]);
      ZA[rbase + 512 + h * 128 + e] = f2bf((o[n2][j] - mean) * rstd * gv);
    }
  }
}

DEV bf16x8 scale8(u32x4 raw, const float (&w)[8]) {
  union { u32x4 u; bf16x8 v; } r;
#pragma unroll
  for (int q = 0; q < 4; q++) {
    float a = __uint_as_float(raw[q] << 16) * w[q * 2], b = __uint_as_float(raw[q] & 0xffff0000u) * w[q * 2 + 1];
    r.u[q] = pack2(a, b);
  }
  return r.v;
}

DEV void retstate_task(const Params& p, int l, int task) {
  const int tid = TID(), lane = tid & 63, wid = tid >> 6, fr = lane & 15, fq = lane >> 4;
  int seq = task >> 3, h = (task >> 1) & 3, dir = task & 1;
  const u16* KT = (const u16*)(WS(p) + OFF_KT) + (size_t)((seq * 4 + h) * 128) * 256;
  const u16* VT = (const u16*)(WS(p) + OFF_VT) + (size_t)((seq * 4 + h) * 128) * 256;
  const float lg = log1pf(-expf(INP(p, 20)[(l * 2 + dir) * 4 + h]));
  f32x4 acc[2][8];
#pragma unroll
  for (int m = 0; m < 2; m++)
#pragma unroll
    for (int n = 0; n < 8; n++) acc[m][n] = f32x4{0.f, 0.f, 0.f, 0.f};
#pragma unroll 1
  for (int ks = 0; ks < 8; ks++) {
    float w[8];
#pragma unroll
    for (int jj = 0; jj < 8; jj++) { int j = ks * 32 + fq * 8 + jj; w[jj] = __expf(lg * (float)(dir == 0 ? 255 - j : j)); }
    bf16x8 a[2];
#pragma unroll
    for (int m = 0; m < 2; m++) a[m] = scale8(*(const u32x4*)(KT + (size_t)(wid * 32 + m * 16 + fr) * 256 + ks * 32 + fq * 8), w);
#pragma unroll
    for (int n = 0; n < 8; n++) {
      bf16x8 b = *(const bf16x8*)(VT + (size_t)(n * 16 + fr) * 256 + ks * 32 + fq * 8);
#pragma unroll
      for (int m = 0; m < 2; m++) acc[m][n] = __builtin_amdgcn_mfma_f32_16x16x32_bf16(a[m], b, acc[m][n], 0, 0, 0);
    }
  }
  float* o = OUTP(p) + 13107200 + ((((size_t)seq * 2 + l) * 2 + dir) * 4 + h) * 16384;
#pragma unroll
  for (int m = 0; m < 2; m++)
#pragma unroll
    for (int n = 0; n < 8; n++)
#pragma unroll
      for (int j = 0; j < 4; j++) o[(size_t)(wid * 32 + m * 16 + fq * 4 + j) * 128 + n * 16 + fr] = acc[m][n][j];
}

template <bool LAT>
DEV void hyena_mfma(const Params& p, int l, int task, char* smem) {
  constexpr int L = LAT ? 1024 : 256;
  constexpr int NV = LAT ? 4 : 16;
  constexpr int RS = L + 8, CS = 2 * L + 16;
  constexpr int MPW = L / 64, NKS = L / 32, NCH = L / 8, Lsel = LAT ? 1 : 0;
  const int tid = TID(), lane = tid & 63, wid = tid >> 6, fr = lane & 15, fq = lane >> 4;
  const int c = LAT ? task : (task >> 1);
  const int sg = LAT ? 0 : (task & 1);
  u16* CP = (u16*)smem; u16* XV = CP + 8 * CS; u16* GS = XV + NV * RS; u16* O1 = GS + NV * RS;
  const u16* HYT = (const u16*)(WS(p) + OFF_HYZ);
  u16* HYOT = (u16*)(WS(p) + OFF_OUT1) + (size_t)MT * 512;
  const float* cw = INP(p, 22) + (size_t)l * 3 * 1536; const float* cb = INP(p, 23) + l * 1536;
  auto sconv = [&](int arr, u16* dstA) {
    const int ch = arr * 512 + c;
    const float w0 = cw[ch], w1 = cw[1536 + ch], w2 = cw[3072 + ch], bb = cb[ch];
#pragma unroll
    for (int i = 0; i < (NV * NCH) / 256; i++) {
      int id = tid + i * 256; int n = id / NCH, t8 = (id % NCH) * 8;
      const u16* src = LAT ? HYT + (size_t)8192 * 1536 + ((size_t)n * 1536 + ch) * 1024 + t8 : HYT + ((size_t)(sg * 16 + n) * 1536 + ch) * 256 + t8;
      u32x4 raw = *(const u32x4*)src;
      float h[10];
      h[0] = t8 > 0 ? bf2f(src[-1]) : 0.f;
      h[9] = t8 + 8 < L ? bf2f(src[8]) : 0.f;
#pragma unroll
      for (int q = 0; q < 4; q++) { h[1 + 2 * q] = __uint_as_float(raw[q] << 16); h[2 + 2 * q] = __uint_as_float(raw[q] & 0xffff0000u); }
      u32x4 o;
#pragma unroll
      for (int q = 0; q < 4; q++) o[q] = pack2(w0 * h[2 * q] + w1 * h[2 * q + 1] + w2 * h[2 * q + 2] + bb, w0 * h[2 * q + 1] + w1 * h[2 * q + 2] + w2 * h[2 * q + 3] + bb);
      *(u32x4*)(dstA + n * RS + t8) = o;
    }
  };
  __syncthreads();
  sconv(0, GS);
  sconv(2, XV);
  const int rr = (-fr) & 7;
  const u16* cpl = CP + rr * CS + (L + 8 * fq - fr - rr);
#pragma unroll 1
  for (int o = 0; o < 2; o++) {
    if (o == 1) sconv(1, GS);
    u16* FL = o == 0 ? O1 : XV;
    const float* Gp = (const float*)(WS(p) + OFF_G) + (Lsel ? 524288 : 0) + (size_t)o * (2 * L) * 512 + c;
    if (tid < 2 * L / 8) {
      float f[8];
#pragma unroll
      for (int j = 0; j < 8; j++) { int u = tid * 8 + j; f[j] = u > 0 ? Gp[(size_t)(2 * L - u) * 512] : 0.f; }
      u32x4 v; v[0] = pack2(f[0], f[1]); v[1] = pack2(f[2], f[3]); v[2] = pack2(f[4], f[5]); v[3] = pack2(f[6], f[7]);
      *(u32x4*)(FL + tid * 8) = v;
    }
    if (tid < 2) *(u32x4*)(FL + 2 * L + tid * 8) = u32x4{0u, 0u, 0u, 0u};
    __syncthreads();
    if (tid < 2 * L / 8) {
      u32x4 a = *(const u32x4*)(FL + tid * 8), b = *(const u32x4*)(FL + tid * 8 + 8);
      unsigned d[8] = {a[0], a[1], a[2], a[3], b[0], b[1], b[2], b[3]};
#pragma unroll
      for (int r = 0; r < 8; r++) {
        u32x4 ov;
#pragma unroll
        for (int q = 0; q < 4; q++) ov[q] = (r & 1) ? ((d[q + (r >> 1)] >> 16) | (d[q + (r >> 1) + 1] << 16)) : d[q + (r >> 1)];
        *(u32x4*)(CP + r * CS + tid * 8) = ov;
      }
    }
    __syncthreads();
    float rn;
    {
      constexpr int NTB = LAT ? 128 : 32;
      const float* SP = (const float*)(WS(p) + WS_END) + ((size_t)l * 160 + (LAT ? 32 : 0)) * 2048 + o * 512 + c;
      float ssum = 0.f;
      for (int tb = lane; tb < NTB; tb += 64) ssum += SP[(size_t)tb * 2048] + SP[(size_t)tb * 2048 + 1024];
#pragma unroll
      for (int off = 32; off > 0; off >>= 1) ssum += __shfl_xor(ssum, off, 64);
      rn = rsqrtf(ssum + 1e-6f);
    }
    const float bias = INP(p, 30)[(l * 2 + o) * 512 + c];
    const u16* Xs = o == 0 ? XV : O1;
    f32x4 acc[MPW];
#pragma unroll
    for (int mi = 0; mi < MPW; mi++) acc[mi] = f32x4{0.f, 0.f, 0.f, 0.f};
    const bf16x8 zero8 = {0, 0, 0, 0, 0, 0, 0, 0};
#pragma unroll 2
    for (int ks = 0; ks < NKS; ks++) {
      bf16x8 b = (fr < NV) ? *(const bf16x8*)(Xs + fr * RS + ks * 32 + fq * 8) : zero8;
#pragma unroll
      for (int mi = 0; mi < MPW; mi++) {
        bf16x8 a = *(const bf16x8*)(cpl - 16 * (wid * MPW + mi) + 32 * ks);
        acc[mi] = __builtin_amdgcn_mfma_f32_16x16x32_bf16(a, b, acc[mi], 0, 0, 0);
      }
    }
    if (fr < NV) {
      const u16* gate = GS;
      const u16* vin = o == 0 ? XV : O1;
#pragma unroll
      for (int mi = 0; mi < MPW; mi++) {
        const int t0 = (wid * MPW + mi) * 16 + fq * 4;
        u32x2 gq = *(const u32x2*)(gate + fr * RS + t0), vq = *(const u32x2*)(vin + fr * RS + t0);
        float g4[4] = {__uint_as_float(gq[0] << 16), __uint_as_float(gq[0] & 0xffff0000u), __uint_as_float(gq[1] << 16), __uint_as_float(gq[1] & 0xffff0000u)};
        float v4[4] = {__uint_as_float(vq[0] << 16), __uint_as_float(vq[0] & 0xffff0000u), __uint_as_float(vq[1] << 16), __uint_as_float(vq[1] & 0xffff0000u)};
        float r4[4];
#pragma unroll
        for (int j = 0; j < 4; j++) r4[j] = g4[j] * (acc[mi][j] * rn + bias * v4[j]);
        if (o == 0) {
          u32x2 ov; ov[0] = pack2(r4[0], r4[1]); ov[1] = pack2(r4[2], r4[3]);
          *(u32x2*)(O1 + fr * RS + t0) = ov;
        } else {
          u16* dst = LAT ? HYOT + (size_t)8192 * 512 + ((size_t)fr * 512 + c) * 1024 + t0 : HYOT + ((size_t)(sg * 16 + fr) * 512 + c) * 256 + t0;
          u32x2 ov; ov[0] = pack2(r4[0], r4[1]); ov[1] = pack2(r4[2], r4[3]);
          *(u32x2*)dst = ov;
        }
      }
    }
    __syncthreads();
  }
}

DEV void phaseD(const Params& p, int l, char* smem) {
  const int nb = gridDim.x, b = BID();
#pragma unroll 1
  for (int t = b; t < 512; t += nb) hyena_mfma<true>(p, l, t, smem);
#pragma unroll 1
  for (int t = (b + nb - (512 % nb)) % nb; t < 768; t += nb) ret_task(p, l, t, smem);
#pragma unroll 1
  for (int t = (b + 2 * nb - ((512 + 768) % nb)) % nb; t < 576; t += nb) s5_task(p, l, t, smem);
#pragma unroll 1
  for (int t = (b + 3 * nb - ((512 + 768 + 576) % nb)) % nb; t < 1024; t += nb) hyena_mfma<false>(p, l, t, smem);
#pragma unroll 1
  for (int t = (b + 4 * nb - ((512 + 768 + 576 + 1024) % nb)) % nb; t < 256; t += nb) retstate_task(p, l, t);
}

DEV void phaseE(const Params& p, char* smem) {
  const u16* HYOT = (const u16*)(WS(p) + OFF_OUT1) + (size_t)MT * 512;
  u16* HYO = (u16*)(WS(p) + OFF_OUT1);
  u16* sm = (u16*)smem;
  const int tx = TID() & 63, ty = TID() >> 6;
  for (int tile = BID(); tile < 192 * 8; tile += gridDim.x) {
    int rt = tile >> 3, c0 = (tile & 7) * 64; int row0 = rt * 64;
    const u16* src = row0 < 8192 ? HYOT + ((size_t)(row0 >> 8) * 512 + c0) * 256 + (row0 & 255)
                                 : HYOT + (size_t)8192 * 512 + ((size_t)((row0 - 8192) >> 10) * 512 + c0) * 1024 + ((row0 - 8192) & 1023);
    const int L = row0 < 8192 ? 256 : 1024;
    __syncthreads();
#pragma unroll
    for (int i = 0; i < 16; i++) { int cc = ty + i * 4; sm[cc * 66 + tx] = src[(size_t)cc * L + tx]; }
    __syncthreads();
#pragma unroll
    for (int i = 0; i < 16; i++) { int tt = ty + i * 4; HYO[(size_t)(row0 + tt) * 512 + c0 + tx] = sm[tx * 66 + tt]; }
  }
}

DEV void phaseF(const Params& p, int l, char* smem) {
  u16* sA = (u16*)smem; u16* T = (u16*)smem;
  const u16* H = (const u16*)(WS(p) + OFF_H);
  const u16* WT = (const u16*)(WS(p) + OFF_WT);
  const u16* ZA = (const u16*)(WS(p) + OFF_ZA); const u16* HYO = (const u16*)(WS(p) + OFF_OUT1);
  u16* MG = (u16*)(WS(p) + OFF_YP);
  for (int tile = BID(); tile < 96 * 16; tile += gridDim.x) {
    int tm = tile >> 4, tn = tile & 15; int row0 = tm * 128, n0 = tn * 64;
    f32x4 a1[4][2], a2[4][2], tt[4][2];
    const u16* Hrow = H + (size_t)row0 * 1024;
    zero_acc<4, 2>(a1); zero_acc<4, 2>(tt);
#pragma unroll 1
    for (int ps = 0; ps < 7; ps++) {
      const u16* Ap; const u16* Bp; int lda, K;
      switch (ps) {
        case 0: Ap = ZA + (size_t)row0 * 2048; lda = 2048; Bp = WT + WGLU_O + (size_t)n0 * 512; K = 512; break;
        case 1: Ap = ZA + (size_t)row0 * 2048; lda = 2048; Bp = WT + WGLU_O + (size_t)(1024 + n0) * 512; K = 512; break;
        case 3: Ap = ZA + (size_t)row0 * 2048 + 512; lda = 2048; Bp = WT + WRETO_O + (size_t)n0 * 512; K = 512; break;
        case 5: Ap = HYO + (size_t)row0 * 512; lda = 512; Bp = WT + WHYO_O + (size_t)n0 * 512; K = 512; break;
        default: Ap = Hrow; lda = 1024; Bp = WT + WIN_O + (size_t)(4096 + ((ps - 2) >> 1) * 1024 + n0) * 1024; K = 1024; break;
      }
      zero_acc<4, 2>(a2);
      gemm_loop<4, 2>(Ap, lda, Bp, K, K, a2, sA);
      if (ps == 0 || ps == 3 || ps == 5) {
#pragma unroll
        for (int m = 0; m < 4; m++)
#pragma unroll
          for (int n = 0; n < 2; n++) a1[m][n] = a2[m][n];
      } else if (ps == 1) {
#pragma unroll
        for (int m = 0; m < 4; m++)
#pragma unroll
          for (int n = 0; n < 2; n++)
#pragma unroll
            for (int j = 0; j < 4; j++) a1[m][n][j] *= sigm(a2[m][n][j]);
      } else {
#pragma unroll
        for (int m = 0; m < 4; m++)
#pragma unroll
          for (int n = 0; n < 2; n++)
#pragma unroll
            for (int j = 0; j < 4; j++) tt[m][n][j] += a1[m][n][j] * sigm(a2[m][n][j]);
      }
    }
    __syncthreads();
    acc_to_lds<4, 2, 72>(tt, T, 0);
    __syncthreads();
    copy_tile<64, 72>(T, MG + (size_t)row0 * 1024 + n0, 1024);
  }
}

template <int MF, int NF>
DEV void resid_store(const Params& p, const f32x4 (&acc)[MF][NF], int l, int chunk, int row0, int col0, bool from_input) {
  const int tid = TID(), lane = tid & 63, wid = tid >> 6, wr = wid >> 1, wc = wid & 1, fr = lane & 15, fq = lane >> 4;
  float* out = OUTP(p);
#pragma unroll
  for (int m = 0; m < MF; m++) {
    const int rb = row0 + m * 32 + wr * 16 + fq * 4;
    const int j = modidx(rb);
    const float* MOD = (const float*)(WS(p) + OFF_MOD) + (l * 5 + j) * 6144 + chunk * 1024;
    const float* BM = INP(p, 7) + l * 6144 + chunk * 1024;
#pragma unroll
    for (int n = 0; n < NF; n++) {
      int col = col0 + wc * (NF * 16) + n * 16 + fr;
      float g = MOD[col] + BM[col];
#pragma unroll
      for (int jj = 0; jj < 4; jj++) {
        int row = rb + jj;
        float xo = from_input ? xin_row(p, row)[col] : out[(size_t)row * 1024 + col];
        out[(size_t)row * 1024 + col] = xo + g * acc[m][n][jj];
      }
    }
  }
}

DEV void phaseG(const Params& p, int l, char* smem) {
  u16* sA = (u16*)smem;
  const u16* MG = (const u16*)(WS(p) + OFF_YP);
  const u16* W = (const u16*)(WS(p) + OFF_WT) + WOUT_O;
  for (int tile = BID(); tile < 48 * 8; tile += gridDim.x) {
    int tm = tile >> 3, tn = tile & 7;
    f32x4 acc[8][4]; zero_acc<8, 4>(acc);
    gemm_loop<8, 4>(MG + (size_t)tm * 256 * 1024, 1024, W + (size_t)tn * 128 * 1024, 1024, 1024, acc, sA);
    resid_store<8, 4>(p, acc, l, 2, tm * 256, tn * 128, l == 0);
  }
}

DEV void phaseI(const Params& p, int l, char* smem) {
  u16* sA = (u16*)smem; u16* T = (u16*)smem;
  const u16* H = (const u16*)(WS(p) + OFF_H);
  const u16* W = (const u16*)(WS(p) + OFF_WT) + WFIN_O;
  u16* ACT = (u16*)(WS(p) + OFF_ZA);
  for (int tile = BID(); tile < 48 * 44; tile += gridDim.x) {
    int tm = tile / 44, tn = tile % 44;
    f32x4 acc[8][4]; zero_acc<8, 4>(acc);
    gemm_loop<8, 4>(H + (size_t)tm * 256 * 1024, 1024, W + (size_t)tn * 128 * 1024, 1024, 1024, acc, sA);
    const int tid = TID(), lane = tid & 63, wid = tid >> 6, wr = wid >> 1, wc = wid & 1, fr = lane & 15, fq = lane >> 4;
#pragma unroll
    for (int hh = 0; hh < 2; hh++) {
      __syncthreads();
#pragma unroll
      for (int m = 0; m < 4; m++)
#pragma unroll
        for (int n = 0; n < 2; n++)
#pragma unroll
          for (int j = 0; j < 4; j++)
            T[(m * 32 + wr * 16 + fq * 4 + j) * 72 + wc * 32 + n * 16 + fr] = f2bf(silu_(acc[hh * 4 + m][2 * n][j]) * acc[hh * 4 + m][2 * n + 1][j]);
      __syncthreads();
      copy_tile<64, 72>(T, ACT + (size_t)(tm * 256 + hh * 128) * 2816 + tn * 64, 2816);
    }
  }
}

DEV void phaseJ(const Params& p, int l, char* smem) {
  u16* sA = (u16*)smem;
  const u16* ACT = (const u16*)(WS(p) + OFF_ZA);
  const u16* W = (const u16*)(WS(p) + OFF_WT) + WFOUT_O;
  for (int tile = BID(); tile < 48 * 8; tile += gridDim.x) {
    int tm = tile >> 3, tn = tile & 7;
    f32x4 acc[8][4]; zero_acc<8, 4>(acc);
    gemm_loop<8, 4>(ACT + (size_t)tm * 256 * 2816, 2816, W + (size_t)tn * 128 * 2816, 2816, 2816, acc, sA);
    resid_store<8, 4>(p, acc, l, 5, tm * 256, tn * 128, false);
  }
}


#define XB_TMO      128
#define XB_XCNT(j)  (256  + 64 * (j))
#define XB_XSUB(j)  (1280 + 64 * (j))
#define XB_XGEN(j)  (2304 + 64 * (j))
#define XB_TOP      3328
#define XB_TOPGEN   3392
#define XB_SPIN_CAP (1u << 22)
#define LAS __attribute__((address_space(3)))
DEV unsigned xb_ld(unsigned* p) { return __hip_atomic_load(p, __ATOMIC_RELAXED, __HIP_MEMORY_SCOPE_AGENT); }
DEV unsigned xb_add(unsigned* p, unsigned v) { return __hip_atomic_fetch_add(p, v, __ATOMIC_RELAXED, __HIP_MEMORY_SCOPE_AGENT); }
DEV unsigned xb_xcc_id() { return (unsigned)__builtin_amdgcn_s_getreg((3 << 11) | 20) & 0xFu; }
#define XB_SPIN(cond, bar) do { unsigned _sp = 0; while (cond) { __builtin_amdgcn_s_sleep(1); \
    if ((++_sp & 255u) == 0u) { if (xb_ld(&(bar)[XB_TMO])) break; if (_sp > XB_SPIN_CAP) { atomicAdd(&(bar)[XB_TMO], 1u); break; } } } } while (0)
struct XcdBarrier { unsigned* bar; unsigned x; volatile LAS unsigned* st; };
DEV XcdBarrier xcd_barrier_post(unsigned* bar, volatile LAS unsigned* st) {
  XcdBarrier b; b.bar = bar; b.x = xb_xcc_id(); b.st = st;
  if (threadIdx.x == 0) (void)xb_add(&bar[XB_XCNT(b.x)], 1u);
  return b;
}
DEV void xcd_barrier_complete(unsigned* bar, unsigned x, unsigned& nloc, unsigned& nx) {
  const unsigned G = gridDim.x * gridDim.y * gridDim.z;
  unsigned sum, cnt, mine, sp = 0u;
  for (;;) {
    sum = 0u; cnt = 0u; mine = 0u;
#pragma unroll
    for (unsigned j = 0; j < 16; ++j) { const unsigned c = xb_ld(&bar[XB_XCNT(j)]); sum += c; cnt += (c > 0u) ? 1u : 0u; mine = (j == x) ? c : mine; }
    if (sum == G) break;
    __builtin_amdgcn_s_sleep(1);
    if ((++sp & 255u) == 0u) { if (xb_ld(&bar[XB_TMO])) break; if (sp > XB_SPIN_CAP) { atomicAdd(&bar[XB_TMO], 1u); break; } }
  }
  nloc = mine > 0u ? mine : 1u; nx = cnt > 0u ? cnt : 1u;
}
DEV void xcd_barrier(const XcdBarrier& b) {
  asm volatile("s_waitcnt vmcnt(0)" ::: "memory");
  __syncthreads();
  if (threadIdx.x == 0) {
    unsigned* bar = b.bar;
    __builtin_amdgcn_s_waitcnt(0);
    unsigned nloc = b.st[0], nx = b.st[1];
    if (nloc == 0u) { xcd_barrier_complete(bar, b.x, nloc, nx); b.st[0] = nloc; b.st[1] = nx; }
    const unsigned old = xb_add(&bar[XB_XSUB(b.x)], 1u);
    const unsigned gen = old / nloc;
    if (old + 1u == (gen + 1u) * nloc) {
      __builtin_amdgcn_fence(__ATOMIC_RELEASE, "agent");
      asm volatile("s_waitcnt vmcnt(0)" ::: "memory");
      const unsigned og = xb_add(&bar[XB_TOP], 1u);
      const unsigned tg = og / nx;
      if (og + 1u == (tg + 1u) * nx) xb_add(&bar[XB_TOPGEN], 1u);
      else XB_SPIN(xb_ld(&bar[XB_TOPGEN]) == tg, bar);
      __builtin_amdgcn_fence(__ATOMIC_ACQUIRE, "agent");
      xb_add(&bar[XB_XGEN(b.x)], 1u);
      asm volatile("s_waitcnt vmcnt(0)" ::: "memory");
    } else {
      XB_SPIN(xb_ld(&bar[XB_XGEN(b.x)]) == gen, bar);
      __builtin_amdgcn_fence(__ATOMIC_ACQUIRE, "agent");
      asm volatile("s_waitcnt vmcnt(0)" ::: "memory");
    }
  }
  __syncthreads();
}

constexpr int SMEM_BYTES = 57792;

DEV void run_phase(const Params& p, int ph, int l, char* smem) {
  switch (ph) {
    case 0: phaseA(p, smem); break;
    case 1: norm_phase(p, l, 0); if (l == 1) layer_prep(p, 1, smem); break;
    case 2: phaseC(p, l, smem); break;
    case 3: phaseD(p, l, smem); break;
    case 4: phaseE(p, smem); break;
    case 5: phaseF(p, l, smem); break;
    case 6: phaseG(p, l, smem); break;
    case 7: norm_phase(p, l, 1); break;
    case 8: phaseI(p, l, smem); break;
    case 9: phaseJ(p, l, smem); break;
    case 10: norm_phase(p, 0, 2); break;
  }
}

#if MULTI
__global__ void __launch_bounds__(256, 2) kphase(Params p, int ph, int l) {
  __shared__ __attribute__((aligned(16))) char smem[SMEM_BYTES];
  run_phase(p, ph, l, smem);
}
#else
__global__ void __launch_bounds__(256, 2) mega(Params p) {
  __shared__ __attribute__((aligned(16))) char smem[SMEM_BYTES];
  __shared__ uint4 xb_words;
  cg::grid_group grid = cg::this_grid();
  if (threadIdx.x == 0) xb_words = make_uint4(0u, 0u, 0u, 0u);
  __syncthreads();
  XcdBarrier xb = xcd_barrier_post((unsigned*)(p.ws + OFF_BAR), (volatile LAS unsigned*)&xb_words);
  run_phase(p, 0, 0, smem);
  grid.sync();
  for (int l = 0; l < 2; l++) {
    for (int ph = 1; ph <= 9; ph++) {
      run_phase(p, ph, l, smem);
      xcd_barrier(xb);
    }
  }
  run_phase(p, 10, 0, smem);
}
#endif

extern "C" void kernel_launch(void* const* d_in, const int* in_sizes, int n_in, void* d_out, int out_size, void* d_ws, size_t ws_size, hipStream_t stream) {
  Params p{};
  for (int i = 0; i < 36; i++) p.in[i] = (const float*)d_in[i];
  p.out = (float*)d_out;
  p.ws = (char*)d_ws;
  hipMemsetAsync((char*)d_ws + OFF_MOD, 0, ZERO_BYTES, stream);
  static int grid_blocks = 0;
#if MULTI
  if (!grid_blocks) {
    int dev = 0, cus = 0, per_cu = 0;
    hipGetDevice(&dev);
    hipDeviceGetAttribute(&cus, hipDeviceAttributeMultiprocessorCount, dev);
    hipOccupancyMaxActiveBlocksPerMultiprocessor(&per_cu, kphase, 256, 0);
    if (per_cu > 2) per_cu = 2;
    if (per_cu < 1) per_cu = 1;
    grid_blocks = cus * per_cu;
  }
  kphase<<<grid_blocks, 256, 0, stream>>>(p, 0, 0);
  for (int l = 0; l < 2; l++)
    for (int ph = 1; ph <= 9; ph++) kphase<<<grid_blocks, 256, 0, stream>>>(p, ph, l);
  kphase<<<grid_blocks, 256, 0, stream>>>(p, 10, 0);
#else
  if (!grid_blocks) {
    int dev = 0, cus = 0, per_cu = 0;
    hipGetDevice(&dev);
    hipDeviceGetAttribute(&cus, hipDeviceAttributeMultiprocessorCount, dev);
    hipOccupancyMaxActiveBlocksPerMultiprocessor(&per_cu, mega, 256, 0);
    if (per_cu > 2) per_cu = 2;
    if (per_cu < 1) per_cu = 1;
    grid_blocks = cus * per_cu;
  }
  void* args[] = {&p};
  hipError_t e = hipLaunchCooperativeKernel((void*)mega, dim3(grid_blocks), dim3(256), args, 0, stream);
  if (e != hipSuccess) fprintf(stderr, "cooperative launch failed: %s (grid %d)\n", hipGetErrorString(e), grid_blocks);
#endif
}
```

```cpp
#include <hip/hip_runtime.h>
#include <hip/hip_cooperative_groups.h>
#include <cstdio>
namespace cg = cooperative_groups;

#ifndef MULTI
#define MULTI 0
#endif

typedef unsigned short u16;
using bf16x8 = __attribute__((ext_vector_type(8))) short;
using f32x4 = __attribute__((ext_vector_type(4))) float;
using u32x4 = __attribute__((ext_vector_type(4))) unsigned;
using u32x2 = __attribute__((ext_vector_type(2))) unsigned;
#define DEV __device__ __forceinline__

constexpr int MT = 12288;
constexpr size_t OFF_WT = 0;
constexpr int WIN_O = 0, WGLU_O = 7340032, WRETO_O = 8388608, WHYO_O = 8912896, WOUT_O = 9437184, WFIN_O = 10485760, WFOUT_O = 16252928;
constexpr size_t OFF_G = 38273024;
constexpr size_t OFF_H = 48758784;
constexpr size_t OFF_ZA = 73924608;
constexpr size_t OFF_HYZ = 124256256;
constexpr size_t OFF_VT = 162004992;
constexpr size_t OFF_KT = 174587904;
constexpr size_t OFF_QR = 182976512;
constexpr size_t OFF_YP = 187170816;
constexpr size_t OFF_OUT1 = 212336640;
constexpr size_t OFF_MOD = 237502464;
constexpr size_t OFF_SUMSQ = OFF_MOD + 245760;
constexpr size_t OFF_BAR = OFF_SUMSQ + 16384;
constexpr size_t ZERO_BYTES = 245760 + 16384 + 16384;
constexpr size_t OFF_LAMBAR = OFF_BAR + 16384;
constexpr size_t OFF_BBAR = OFF_LAMBAR + 65536;
constexpr size_t OFF_CM = OFF_BBAR + 524288;
constexpr size_t OFF_ROPE = OFF_CM + 524288;
constexpr size_t OFF_S0T = OFF_ROPE + 524288;
constexpr size_t WS_END = OFF_S0T + 2097152;

struct Params {
  const float* in[36];
  float* out;
  char* ws;
};


DEV int TID() { int t = threadIdx.x; asm volatile("" : "+v"(t)); return t; }
DEV int BID() { int t = blockIdx.x; asm volatile("" : "+s"(t)); return t; }
DEV char* WS(const Params& p) { char* w = p.ws; asm volatile("" : "+s"(w)); return w; }
DEV float* OUTP(const Params& p) { float* w = p.out; asm volatile("" : "+s"(w)); return w; }
DEV const float* INP(const Params& p, int i) { const float* w = p.in[i]; asm volatile("" : "+s"(w)); return w; }

DEV u16 f2bf(float f) { unsigned u = __float_as_uint(f); u += 0x7fffu + ((u >> 16) & 1u); return (u16)(u >> 16); }
DEV float bf2f(u16 h) { return __uint_as_float(((unsigned)h) << 16); }
DEV float sigm(float x) { return 1.f / (1.f + __expf(-x)); }
DEV float silu_(float x) { return x / (1.f + __expf(-x)); }
DEV float gelu_(float x) { float u = 0.7978845608028654f * (x + 0.044715f * x * x * x); return 0.5f * x * (1.f + tanhf(u)); }
DEV unsigned pack2(float a, float b) { return (unsigned)f2bf(a) | ((unsigned)f2bf(b) << 16); }

DEV const float* xin_row(const Params& p, int row) { return row < 8192 ? INP(p, 0) + (size_t)row * 1024 : INP(p, 1) + (size_t)(row - 8192) * 1024; }
DEV int modidx(int row) { return row < 8192 ? 0 : 1 + ((row - 8192) >> 10); }

template <int MF, int NF>
DEV void gemm_loop(const u16* __restrict__ A, int lda, const u16* __restrict__ B, int ldb, int K, f32x4 (&acc)[MF][NF], u16* sA) {
  const int tid = TID(), lane = tid & 63, wid = tid >> 6, wr = wid >> 1, wc = wid & 1, fr = lane & 15, fq = lane >> 4;
  u16* sB = sA + MF * 32 * 72;
  u32x4 ra[MF], rb[NF];
  const int crow = tid >> 3, ccol = (tid & 7) * 8;
  const u16* Ap = A + (size_t)crow * lda + ccol;
  const u16* Bp = B + (size_t)crow * ldb + ccol;
#pragma unroll
  for (int i = 0; i < MF; i++) ra[i] = *(const u32x4*)(Ap + (size_t)(i * 32) * lda);
#pragma unroll
  for (int i = 0; i < NF; i++) rb[i] = *(const u32x4*)(Bp + (size_t)(i * 32) * ldb);
  for (int k0 = 0; k0 < K; k0 += 64) {
    __syncthreads();
#pragma unroll
    for (int i = 0; i < MF; i++) *(u32x4*)(sA + (crow + i * 32) * 72 + ccol) = ra[i];
#pragma unroll
    for (int i = 0; i < NF; i++) *(u32x4*)(sB + (crow + i * 32) * 72 + ccol) = rb[i];
    __syncthreads();
    if (k0 + 64 < K) {
#pragma unroll
      for (int i = 0; i < MF; i++) ra[i] = *(const u32x4*)(Ap + (size_t)(i * 32) * lda + k0 + 64);
#pragma unroll
      for (int i = 0; i < NF; i++) rb[i] = *(const u32x4*)(Bp + (size_t)(i * 32) * ldb + k0 + 64);
    }
#pragma unroll
    for (int ks = 0; ks < 2; ks++) {
      bf16x8 bv[NF];
#pragma unroll
      for (int n = 0; n < NF; n++) bv[n] = *(const bf16x8*)(sB + (wc * (NF * 16) + n * 16 + fr) * 72 + ks * 32 + fq * 8);
#pragma unroll
      for (int m = 0; m < MF; m++) {
        bf16x8 af = *(const bf16x8*)(sA + (m * 32 + wr * 16 + fr) * 72 + ks * 32 + fq * 8);
#pragma unroll
        for (int n = 0; n < NF; n++) acc[m][n] = __builtin_amdgcn_mfma_f32_16x16x32_bf16(af, bv[n], acc[m][n], 0, 0, 0);
      }
    }
  }
}

template <int MF, int NF>
DEV void zero_acc(f32x4 (&acc)[MF][NF]) {
#pragma unroll
  for (int m = 0; m < MF; m++)
#pragma unroll
    for (int n = 0; n < NF; n++) acc[m][n] = f32x4{0.f, 0.f, 0.f, 0.f};
}

DEV float epi_op(float v, int op) { return op == 1 ? v * 0.08838834764831845f : (op == 2 ? silu_(v) : v); }
template <int MF, int NF, int TS>
DEV void acc_to_lds(const f32x4 (&acc)[MF][NF], u16* T, int m0, int op = 0) {
  const int tid = TID(), lane = tid & 63, wid = tid >> 6, wr = wid >> 1, wc = wid & 1, fr = lane & 15, fq = lane >> 4;
#pragma unroll
  for (int m = 0; m < 4; m++)
#pragma unroll
    for (int n = 0; n < NF; n++)
#pragma unroll
      for (int j = 0; j < 4; j++) T[(m * 32 + wr * 16 + fq * 4 + j) * TS + wc * (NF * 16) + n * 16 + fr] = f2bf(epi_op(acc[m0 + m][n][j], op));
}
template <int MF>
DEV void acc_to_lds_T(const f32x4 (&acc)[MF][4], u16* T, int m0, int op = 0) {
  const int tid = TID(), lane = tid & 63, wid = tid >> 6, wr = wid >> 1, wc = wid & 1, fr = lane & 15, fq = lane >> 4;
#pragma unroll
  for (int m = 0; m < 4; m++)
#pragma unroll
    for (int n = 0; n < 4; n++) {
      u32x2 v; v.x = pack2(epi_op(acc[m0 + m][n][0], op), epi_op(acc[m0 + m][n][1], op)); v.y = pack2(epi_op(acc[m0 + m][n][2], op), epi_op(acc[m0 + m][n][3], op));
      *(u32x2*)(T + (wc * 64 + n * 16 + fr) * 136 + m * 32 + wr * 16 + fq * 4) = v;
    }
}
template <int COLS, int TS>
DEV void copy_tile(const u16* T, u16* dst, int ld) {
  constexpr int CPR = COLS / 8;
  constexpr int NIT = 128 * CPR / 256;
#pragma unroll
  for (int i = 0; i < NIT; i++) {
    int id = TID() + i * 256; int r = id / CPR, ch = id % CPR;
    *(u32x4*)(dst + (size_t)r * ld + ch * 8) = *(const u32x4*)(T + r * TS + ch * 8);
  }
}

DEV void transpose_tile(const float* __restrict__ src, int K, int N, u16* __restrict__ dst, int tile, float* sm, int perm = 0) {
  int nk = K >> 6; int tk = tile % nk, tn = tile / nk; int k0 = tk * 64, n0 = tn * 64;
  int tx = TID() & 63, ty = TID() >> 6;
  __syncthreads();
#pragma unroll
  for (int i = 0; i < 16; i++) { int k = ty + i * 4; sm[k * 65 + tx] = src[(size_t)(k0 + k) * N + n0 + tx]; }
  __syncthreads();
#pragma unroll
  for (int i = 0; i < 16; i++) {
    int n = n0 + ty + i * 4;
    if (perm) { int half = N >> 1; int j = n < half ? n : n - half; n = (j >> 4) * 32 + (n < half ? 0 : 16) + (j & 15); }
    dst[(size_t)n * K + k0 + tx] = f2bf(sm[tx * 65 + (ty + i * 4)]);
  }
}

DEV void wt_task(const Params& p, int l, int t, float* sm) {
  u16* WT = (u16*)(WS(p) + OFF_WT);
  const float* src; int K, N, off, tt, perm = 0;
  if (t < 1792) { src = INP(p, 10) + (size_t)l * 1024 * 7168; K = 1024; N = 7168; off = WIN_O; tt = t; }
  else if (t < 2048) { src = INP(p, 19) + (size_t)l * 512 * 2048; K = 512; N = 2048; off = WGLU_O; tt = t - 1792; }
  else if (t < 2176) { src = INP(p, 21) + (size_t)l * 512 * 1024; K = 512; N = 1024; off = WRETO_O; tt = t - 2048; }
  else if (t < 2304) { src = INP(p, 31) + (size_t)l * 512 * 1024; K = 512; N = 1024; off = WHYO_O; tt = t - 2176; }
  else if (t < 2560) { src = INP(p, 32) + (size_t)l * 1024 * 1024; K = 1024; N = 1024; off = WOUT_O; tt = t - 2304; }
  else if (t < 3968) { src = INP(p, 33) + (size_t)l * 1024 * 5632; K = 1024; N = 5632; off = WFIN_O; tt = t - 2560; perm = 1; }
  else { src = INP(p, 34) + (size_t)l * 2816 * 1024; K = 2816; N = 1024; off = WFOUT_O; tt = t - 3968; }
  transpose_tile(src, K, N, WT + off, tt, sm, perm);
}

DEV void mod_task(const Params& p, int task, float* sm) {
  int cb = task % 96; int l = task / 96;
  int tid = TID(), lane = tid & 63, kq = tid >> 6;
  __syncthreads();
  for (int i = tid; i < 5120; i += 256) {
    int j = i >> 10, k = i & 1023;
    float c = (j == 0) ? INP(p, 5)[k] : INP(p, 4)[(j - 1) * 1024 + k];
    sm[i] = silu_(c);
  }
  __syncthreads();
  int col = cb * 64 + lane;
  const float* w = INP(p, 6) + (size_t)l * 1024 * 6144 + col;
  float a0 = 0, a1 = 0, a2 = 0, a3 = 0, a4 = 0;
#pragma unroll 8
  for (int kk = 0; kk < 256; kk++) {
    int k = kk * 4 + kq;
    float wv = w[(size_t)k * 6144];
    a0 += sm[k] * wv; a1 += sm[1024 + k] * wv; a2 += sm[2048 + k] * wv; a3 += sm[3072 + k] * wv; a4 += sm[4096 + k] * wv;
  }
  float* red = sm + 5120;
  red[(kq * 5 + 0) * 64 + lane] = a0; red[(kq * 5 + 1) * 64 + lane] = a1; red[(kq * 5 + 2) * 64 + lane] = a2;
  red[(kq * 5 + 3) * 64 + lane] = a3; red[(kq * 5 + 4) * 64 + lane] = a4;
  __syncthreads();
  float* MOD = (float*)(WS(p) + OFF_MOD);
  for (int i = tid; i < 320; i += 256) {
    int j = i >> 6, cc = i & 63;
    float v = ((red[(0 * 5 + j) * 64 + cc] + red[(1 * 5 + j) * 64 + cc]) + red[(2 * 5 + j) * 64 + cc]) + red[(3 * 5 + j) * 64 + cc];
    MOD[(l * 5 + j) * 6144 + cb * 64 + cc] = v;
  }
}

DEV void filt_task(const Params& p, int l, int task, float* sm) {
  int Lsel = task >= 32; int tb = Lsel ? task - 32 : task; int L = Lsel ? 1024 : 256; int t0 = tb * 8;
  int tid = TID();
  float* z = sm; float* h1 = sm + 264; float* h2 = sm + 264 + 512;
  const float* w1 = INP(p, 24) + l * 33 * 64; const float* b1 = INP(p, 25) + l * 64;
  const float* w2 = INP(p, 26) + l * 64 * 64; const float* b2 = INP(p, 27) + l * 64;
  const float* fr0 = INP(p, 28) + l * 128; const float* fr1 = fr0 + 64;
  const float* w3 = INP(p, 29) + (size_t)l * 64 * 2048;
  __syncthreads();
  for (int i = tid; i < 264; i += 256) {
    int tt = i / 33, e = i % 33; float t = (float)(t0 + tt); float v;
    if (e == 0) v = t / (float)L;
    else {
      int b = (e - 1) & 15; float band = 1e-4f + (float)b * ((15.f - 1e-4f) / 15.f);
      float ang = (6.283185307179586f / (float)L) * t * band;
      v = (e <= 16) ? cosf(ang) : -sinf(ang);
    }
    z[i] = v;
  }
  __syncthreads();
  for (int i = tid; i < 512; i += 256) {
    int tt = i >> 6, j = i & 63; float s = b1[j];
    for (int e = 0; e < 33; e++) s += z[tt * 33 + e] * w1[e * 64 + j];
    h1[i] = sinf(fr0[j] * s);
  }
  __syncthreads();
  for (int i = tid; i < 512; i += 256) {
    int tt = i >> 6, j = i & 63; float s = b2[j];
    for (int e = 0; e < 64; e++) s += h1[tt * 64 + e] * w2[e * 64 + j];
    h2[i] = sinf(fr1[j] * s);
  }
  __syncthreads();
  float* FB = (float*)(WS(p) + OFF_G) + (Lsel ? 524288 : 0);
  float* SUMSQ = (float*)(WS(p) + WS_END);
  for (int m = 0; m < 8; m++) {
    int col = tid + m * 256;
    float acc[8];
#pragma unroll
    for (int tt = 0; tt < 8; tt++) acc[tt] = 0.f;
    for (int j = 0; j < 64; j++) {
      float w = w3[j * 2048 + col];
#pragma unroll
      for (int tt = 0; tt < 8; tt++) acc[tt] += h2[tt * 64 + j] * w;
    }
    int dir = col >> 10, o = (col >> 9) & 1, c = col & 511;
    float rate = 3.0701134573253944f + (float)c * ((15.350567286626972f - 3.0701134573253944f) / 511.f);
    float ss = 0.f;
    float* Fo = FB + (size_t)o * (2 * L) * 512 + c;
#pragma unroll
    for (int tt = 0; tt < 8; tt++) {
      int t = t0 + tt;
      float val = acc[tt] * expf(-((float)t / (float)L) * rate);
      if (dir == 0) { Fo[(size_t)(L + t) * 512] = val; ss += val * val; }
      else if (t > 0) { Fo[(size_t)(L - t) * 512] = val; ss += val * val; }
      else { Fo[0] = 0.f; }
    }
    SUMSQ[((size_t)l * 160 + task) * 2048 + col] = ss;
  }
}

DEV void s5prep_task(const Params& p, int task) {
  int idx = task * 256 + TID();
  int pp = idx & 63; int lrg = idx >> 6;
  float lre = INP(p, 11)[idx], lim = INP(p, 12)[idx];
  float dt = expf(INP(p, 13)[lrg]);
  float mag = expf(lre * dt);
  float lbr = mag * cosf(lim * dt), lbi = mag * sinf(lim * dt);
  float nr = lbr - 1.f, ni = lbi; float den = lre * lre + lim * lim;
  float cr = (nr * lre + ni * lim) / den, ci = (ni * lre - nr * lim) / den;
  u16* BBAR = (u16*)(WS(p) + OFF_BBAR); u16* CM = (u16*)(WS(p) + OFF_CM); float* LB = (float*)(WS(p) + OFF_LAMBAR);
  LB[idx * 2] = lbr; LB[idx * 2 + 1] = lbi;
  for (int c = 0; c < 16; c++) {
    float br = INP(p, 14)[(size_t)idx * 16 + c], bi = INP(p, 15)[(size_t)idx * 16 + c];
    BBAR[(size_t)lrg * 2048 + pp * 16 + c] = f2bf(cr * br - ci * bi);
    BBAR[(size_t)lrg * 2048 + (64 + pp) * 16 + c] = f2bf(cr * bi + ci * br);
    CM[(size_t)lrg * 2048 + c * 128 + pp] = f2bf(INP(p, 16)[(size_t)lrg * 1024 + c * 64 + pp]);
    CM[(size_t)lrg * 2048 + c * 128 + 64 + pp] = f2bf(-INP(p, 17)[(size_t)lrg * 1024 + c * 64 + pp]);
  }
}

DEV void rope_task(const Params& p, int task) {
  int idx = task * 256 + TID(); int t = idx >> 6, d = idx & 63; int f = d & 31;
  float inv = powf(10000.f, -(float)f / 32.f);
  float pos = (d < 32) ? (float)(t >> 6) : (float)(t & 63);
  float ang = pos * inv;
  float* R = (float*)(WS(p) + OFF_ROPE);
  R[idx * 2] = cosf(ang); R[idx * 2 + 1] = sinf(ang);
}

DEV void layer_prep(const Params& p, int l, char* smem) {
  for (int t = BID(); t < 4672 + 160; t += gridDim.x) {
    if (t < 4672) wt_task(p, l, t, (float*)smem);
    else filt_task(p, l, t - 4672, (float*)smem);
  }
}
DEV void phaseA(const Params& p, char* smem) {
  for (int t = BID(); t < 192 + 32 + 256 + 256; t += gridDim.x) {
    if (t < 192) mod_task(p, t, (float*)smem);
    else if (t < 224) s5prep_task(p, t - 192);
    else if (t < 480) rope_task(p, t - 224);
    else { int tt = t - 480; int mi = tt >> 2; transpose_tile(INP(p, 3) + (size_t)mi * 16384, 128, 128, (u16*)(WS(p) + OFF_S0T) + (size_t)mi * 16384, tt & 3, (float*)smem); }
  }
  layer_prep(p, 0, smem);
}

DEV void norm_phase(const Params& p, int l, int which) {
  const int lane = TID() & 63;
  const int wave = (BID() * blockDim.x + TID()) >> 6, nw = (gridDim.x * blockDim.x) >> 6;
  u16* H = (u16*)(WS(p) + OFF_H);
  const float* MOD = (const float*)(WS(p) + OFF_MOD);
  for (int row = wave; row < MT; row += nw) {
    const float* x = (l == 0 && which == 0) ? xin_row(p, row) : OUTP(p) + (size_t)row * 1024;
    float4 v[4]; float ss = 0.f;
#pragma unroll
    for (int i = 0; i < 4; i++) { v[i] = *(const float4*)(x + i * 256 + lane * 4); ss += v[i].x * v[i].x + v[i].y * v[i].y + v[i].z * v[i].z + v[i].w * v[i].w; }
#pragma unroll
    for (int o = 32; o > 0; o >>= 1) ss += __shfl_xor(ss, o, 64);
    float rinv = rsqrtf(ss * (1.f / 1024.f) + 1e-6f);
    if (which == 2) {
      const float* nf = INP(p, 35);
#pragma unroll
      for (int i = 0; i < 4; i++) {
        float4 g = *(const float4*)(nf + i * 256 + lane * 4);
        float4 o; o.x = v[i].x * rinv * g.x; o.y = v[i].y * rinv * g.y; o.z = v[i].z * rinv * g.z; o.w = v[i].w * rinv * g.w;
        *(float4*)(OUTP(p) + (size_t)row * 1024 + i * 256 + lane * 4) = o;
      }
    } else {
      int j = modidx(row);
      const float* nwt = (which == 0 ? INP(p, 8) : INP(p, 9)) + l * 1024;
      const float* msh = MOD + (l * 5 + j) * 6144 + (which ? 3 : 0) * 1024;
      const float* msc = msh + 1024;
      const float* bsh = INP(p, 7) + l * 6144 + (which ? 3 : 0) * 1024;
      const float* bsc = bsh + 1024;
#pragma unroll
      for (int i = 0; i < 4; i++) {
        int k = i * 256 + lane * 4;
        float4 g = *(const float4*)(nwt + k);
        float4 sh = *(const float4*)(msh + k), sc = *(const float4*)(msc + k);
        float4 bh = *(const float4*)(bsh + k), bc = *(const float4*)(bsc + k);
        float o0 = v[i].x * rinv * g.x * (1.f + sc.x + bc.x) + sh.x + bh.x;
        float o1 = v[i].y * rinv * g.y * (1.f + sc.y + bc.y) + sh.y + bh.y;
        float o2 = v[i].z * rinv * g.z * (1.f + sc.z + bc.z) + sh.z + bh.z;
        float o3 = v[i].w * rinv * g.w * (1.f + sc.w + bc.w) + sh.w + bh.w;
        u32x2 pk; pk.x = pack2(o0, o1); pk.y = pack2(o2, o3);
        *(u32x2*)(H + (size_t)row * 1024 + k) = pk;
      }
    }
  }
}

DEV void phaseC(const Params& p, int l, char* smem) {
  u16* sA = (u16*)smem; u16* T = (u16*)smem;
  const u16* H = (const u16*)(WS(p) + OFF_H);
  const u16* WIN = (const u16*)(WS(p) + OFF_WT) + WIN_O;
  u16* ZA = (u16*)(WS(p) + OFF_ZA); u16* HYT = (u16*)(WS(p) + OFF_HYZ); u16* VT = (u16*)(WS(p) + OFF_VT);
  u16* KT = (u16*)(WS(p) + OFF_KT); u16* QR = (u16*)(WS(p) + OFF_QR);
  const float* ROPE = (const float*)(WS(p) + OFF_ROPE);
  const int tid = TID();
  for (int tile = BID(); tile < 48 * 32; tile += gridDim.x) {
    int tm = tile >> 5, tn = tile & 31;
    f32x4 acc[8][4]; zero_acc<8, 4>(acc);
    gemm_loop<8, 4>(H + (size_t)tm * 256 * 1024, 1024, WIN + (size_t)tn * 128 * 1024, 1024, 1024, acc, sA);
    int kind = tn >> 2, hd = tn & 3;
    const int op = kind == 2 ? 1 : (kind == 4 ? 2 : 0);
#pragma unroll
    for (int hh = 0; hh < 2; hh++) {
      int row0 = tm * 256 + hh * 128; bool lat = row0 >= 8192;
      int seq, t0, L;
      if (!lat) { seq = row0 >> 8; t0 = row0 & 255; L = 256; } else { seq = (row0 - 8192) >> 10; t0 = (row0 - 8192) & 1023; L = 1024; }
      __syncthreads();
      if (kind == 3 || kind >= 5) {
        acc_to_lds_T<8>(acc, T, hh * 4, 0);
        __syncthreads();
        u16* dst;
        if (kind == 3) dst = lat ? VT + (size_t)8192 * 512 + (size_t)((seq * 4 + hd) * 128) * 1024 + t0 : VT + (size_t)((seq * 4 + hd) * 128) * 256 + t0;
        else dst = lat ? HYT + (size_t)8192 * 1536 + ((size_t)seq * 1536 + (tn - 20) * 128) * 1024 + t0 : HYT + ((size_t)seq * 1536 + (tn - 20) * 128) * 256 + t0;
        copy_tile<128, 136>(T, dst, L);
      } else {
        acc_to_lds<8, 4, 136>(acc, T, hh * 4, op);
        __syncthreads();
        bool roped = lat && (kind == 1 || kind == 2);
        if (!(lat && kind == 2)) {
          u16* dst;
          if (kind == 0) dst = ZA + (size_t)row0 * 2048 + hd * 128;
          else if (kind == 1) dst = ZA + (size_t)row0 * 2048 + 512 + hd * 128;
          else if (kind == 2) dst = ZA + (size_t)row0 * 2048 + 1024 + hd * 128;
          else dst = ZA + (size_t)row0 * 2048 + 1536 + hd * 128;
          copy_tile<128, 136>(T, dst, 2048);
        }
        if (roped) {
          u16* dst; int ld;
          if (kind == 1) { dst = QR + (size_t)(row0 - 8192) * 512 + hd * 128; ld = 512; }
          else { dst = ZA + (size_t)row0 * 2048 + 1024 + hd * 128; ld = 2048; }
#pragma unroll 1
          for (int i = 0; i < 4; i++) {
            int id = tid + i * 256; int r = id >> 3, ch = id & 7;
            u32x4 a = *(const u32x4*)(T + r * 136 + ch * 8);
            u32x4 b = *(const u32x4*)(T + r * 136 + 64 + ch * 8);
            const float4* cs = (const float4*)(ROPE + ((size_t)(t0 + r) * 64 + ch * 8) * 2);
            u32x4 o1, o2;
#pragma unroll
            for (int q = 0; q < 4; q++) {
              float4 c4 = cs[q];
              float x1a = __uint_as_float(a[q] << 16), x1b = __uint_as_float(a[q] & 0xffff0000u);
              float x2a = __uint_as_float(b[q] << 16), x2b = __uint_as_float(b[q] & 0xffff0000u);
              o1[q] = pack2(x1a * c4.x - x2a * c4.y, x1b * c4.z - x2b * c4.w);
              o2[q] = pack2(x1a * c4.y + x2a * c4.x, x1b * c4.w + x2b * c4.z);
            }
            *(u32x4*)(dst + (size_t)r * ld + ch * 8) = o1;
            *(u32x4*)(dst + (size_t)r * ld + 64 + ch * 8) = o2;
          }
        }
        if (kind == 2 && !lat) {
          __syncthreads();
          acc_to_lds_T<8>(acc, T, hh * 4, op);
          __syncthreads();
          copy_tile<128, 136>(T, KT + (size_t)((seq * 4 + hd) * 128) * 256 + t0, 256);
        }
      }
    }
  }
}

DEV void s5_task(const Params& p, int l, int task, char* smem) {
  const int tid = TID(), lane = tid & 63, wid = tid >> 6, fr = lane & 15, fq = lane >> 4;
  int seq, gp;
  if (task < 64) { seq = 32 + (task >> 4); gp = task & 15; } else { int t2 = task - 64; seq = t2 >> 4; gp = t2 & 15; }
  const bool lat = seq >= 32;
  const int L = lat ? 1024 : 256;
  const int row0 = lat ? 8192 + (seq - 32) * 1024 : seq * 256;
  const int grp = gp * 2 + (wid >> 1), dir = wid & 1;
  const int lrg = (l * 2 + dir) * 32 + grp;
  float* BU = (float*)(smem + wid * 12544);
  u16* HB = (u16*)(smem + wid * 12544 + 8192);
  u16* ZA = (u16*)(WS(p) + OFF_ZA);
  float* YP = (float*)(WS(p) + OFF_YP);
  const u16* BBAR = (const u16*)(WS(p) + OFF_BBAR) + (size_t)lrg * 2048;
  const u16* CM = (const u16*)(WS(p) + OFF_CM) + (size_t)lrg * 2048;
  const float* LB = (const float*)(WS(p) + OFF_LAMBAR) + ((size_t)lrg * 64 + lane) * 2;
  const float lr = LB[0], li = LB[1];
  bf16x8 bfrag[8], cfrag[4];
  const bf16x8 zero8 = {0, 0, 0, 0, 0, 0, 0, 0};
#pragma unroll
  for (int nt = 0; nt < 8; nt++) bfrag[nt] = (fq < 2) ? *(const bf16x8*)(BBAR + (nt * 16 + fr) * 16 + fq * 8) : zero8;
#pragma unroll
  for (int ks = 0; ks < 4; ks++) cfrag[ks] = *(const bf16x8*)(CM + fr * 128 + ks * 32 + fq * 8);
  float hr = 0.f, hi = 0.f;
  if (lat) {
    const float* s0 = INP(p, 2) + ((((size_t)(seq - 32) * 2 + l) * 2 + dir) * 32 + grp) * 128 + lane * 2;
    hr = s0[0]; hi = s0[1];
  }
  const float dcoef = INP(p, 18)[l * 512 + grp * 16 + fr];
  const int nch = L >> 4;
  __syncthreads();
  for (int i = 0; i < nch; i++) {
    const int ci = dir ? nch - 1 - i : i; const int t0 = ci * 16;
    if (i == (nch >> 1)) { __threadfence(); __syncthreads(); }
    bf16x8 ua = (fq < 2) ? *(const bf16x8*)(ZA + (size_t)(row0 + t0 + fr) * 2048 + grp * 16 + fq * 8) : zero8;
#pragma unroll
    for (int nt = 0; nt < 8; nt++) {
      f32x4 r = __builtin_amdgcn_mfma_f32_16x16x32_bf16(ua, bfrag[nt], f32x4{0.f, 0.f, 0.f, 0.f}, 0, 0, 0);
#pragma unroll
      for (int j = 0; j < 4; j++) BU[(fq * 4 + j) * 128 + nt * 16 + fr] = r[j];
    }
    asm volatile("s_waitcnt lgkmcnt(0)" ::: "memory");
#pragma unroll
    for (int tt = 0; tt < 16; tt++) {
      const int t = dir ? 15 - tt : tt;
      float re = BU[t * 128 + lane], im = BU[t * 128 + 64 + lane];
      float nr = lr * hr - li * hi + re; float ni = lr * hi + li * hr + im;
      hr = nr; hi = ni;
      HB[t * 136 + lane] = f2bf(hr); HB[t * 136 + 64 + lane] = f2bf(hi);
    }
    asm volatile("s_waitcnt lgkmcnt(0)" ::: "memory");
    f32x4 y = {0.f, 0.f, 0.f, 0.f};
#pragma unroll
    for (int ks = 0; ks < 4; ks++) {
      bf16x8 a = *(const bf16x8*)(HB + fr * 136 + ks * 32 + fq * 8);
      y = __builtin_amdgcn_mfma_f32_16x16x32_bf16(a, cfrag[ks], y, 0, 0, 0);
    }
    asm volatile("s_waitcnt lgkmcnt(0)" ::: "memory");
    if (i < (nch >> 1)) {
#pragma unroll
      for (int j = 0; j < 4; j++) YP[(size_t)(row0 + t0 + fq * 4 + j) * 512 + grp * 16 + fr] = y[j];
    } else {
#pragma unroll
      for (int j = 0; j < 4; j++) {
        size_t row = (size_t)(row0 + t0 + fq * 4 + j);
        float other = __hip_atomic_load(&YP[row * 512 + grp * 16 + fr], __ATOMIC_RELAXED, __HIP_MEMORY_SCOPE_AGENT);
        u16* up = ZA + row * 2048 + grp * 16 + fr;
        float u = bf2f(*up);
        float v = y[j] + other + dcoef * u;
        *up = f2bf(gelu_(v));
      }
    }
  }
  if (!lat) {
    float* o = OUTP(p) + 12582912 + ((((size_t)seq * 2 + l) * 2 + dir) * 32 + grp) * 128 + lane * 2;
    o[0] = hr; o[1] = hi;
  }
}

DEV void ret_task(const Params& p, int l, int task, char* smem) {
  const int tid = TID(), lane = tid & 63, wid = tid >> 6, fr = lane & 15, fq = lane >> 4;
  int seq, h, qt; bool lat;
  if (task < 256) { lat = true; seq = task >> 6; h = (task >> 4) & 3; qt = task & 15; }
  else { int t2 = task - 256; lat = false; seq = t2 >> 4; h = (t2 >> 2) & 3; qt = t2 & 3; }
  const int L = lat ? 1024 : 256;
  const int row0 = lat ? 8192 + seq * 1024 : seq * 256;
  u16* sK = (u16*)smem; u16* sV = sK + 64 * 136; u16* sP = sV + 128 * 72 + wid * 16 * 72;
  u16* ZA = (u16*)(WS(p) + OFF_ZA);
  const u16* QR = (const u16*)(WS(p) + OFF_QR);
  const u16* VT = (const u16*)(WS(p) + OFF_VT);
  const float lgf = log1pf(-expf(INP(p, 20)[(l * 2 + 0) * 4 + h])), lgb = log1pf(-expf(INP(p, 20)[(l * 2 + 1) * 4 + h]));
  const int qrow = qt * 64 + wid * 16;
  const u16* qsrc = lat ? QR + (size_t)(row0 - 8192 + qrow + fr) * 512 + h * 128 : ZA + (size_t)(row0 + qrow + fr) * 2048 + 512 + h * 128;
  bf16x8 qa[4];
#pragma unroll
  for (int ks = 0; ks < 4; ks++) qa[ks] = *(const bf16x8*)(qsrc + ks * 32 + fq * 8);
  f32x4 o[8];
#pragma unroll
  for (int n = 0; n < 8; n++) o[n] = f32x4{0.f, 0.f, 0.f, 0.f};
  const u16* Kbase = ZA + (size_t)row0 * 2048 + 1024 + h * 128;
  const u16* Vbase = lat ? VT + (size_t)8192 * 512 + (size_t)((seq * 4 + h) * 128) * 1024 : VT + (size_t)((seq * 4 + h) * 128) * 256;
  const int nkt = L >> 6;
  for (int jt = 0; jt < nkt; jt++) {
    __syncthreads();
#pragma unroll
    for (int i = 0; i < 4; i++) {
      int id = tid + i * 256; int r = id >> 4, ch = id & 15;
      *(u32x4*)(sK + r * 136 + ch * 8) = *(const u32x4*)(Kbase + (size_t)(jt * 64 + r) * 2048 + ch * 8);
    }
#pragma unroll
    for (int i = 0; i < 4; i++) {
      int id = tid + i * 256; int e = id >> 3, ch = id & 7;
      *(u32x4*)(sV + e * 72 + ch * 8) = *(const u32x4*)(Vbase + (size_t)e * L + jt * 64 + ch * 8);
    }
    __syncthreads();
    f32x4 s[4];
#pragma unroll
    for (int nt = 0; nt < 4; nt++) {
      s[nt] = f32x4{0.f, 0.f, 0.f, 0.f};
#pragma unroll
      for (int ks = 0; ks < 4; ks++) {
        bf16x8 b = *(const bf16x8*)(sK + (nt * 16 + fr) * 136 + ks * 32 + fq * 8);
        s[nt] = __builtin_amdgcn_mfma_f32_16x16x32_bf16(qa[ks], b, s[nt], 0, 0, 0);
      }
      asm volatile("" ::: "memory");
    }
#pragma unroll
    for (int nt = 0; nt < 4; nt++)
#pragma unroll
      for (int j = 0; j < 4; j++) {
        int d = (qrow + fq * 4 + j) - (jt * 64 + nt * 16 + fr);
        float w = d >= 0 ? __expf(lgf * (float)d) : __expf(lgb * (float)(-d));
        sP[(fq * 4 + j) * 72 + nt * 16 + fr] = f2bf(s[nt][j] * w);
      }
    asm volatile("s_waitcnt lgkmcnt(0)" ::: "memory");
#pragma unroll
    for (int k2 = 0; k2 < 2; k2++) {
      bf16x8 a = *(const bf16x8*)(sP + fr * 72 + k2 * 32 + fq * 8);
#pragma unroll
      for (int n2 = 0; n2 < 8; n2++) {
        bf16x8 b = *(const bf16x8*)(sV + (n2 * 16 + fr) * 72 + k2 * 32 + fq * 8);
        o[n2] = __builtin_amdgcn_mfma_f32_16x16x32_bf16(a, b, o[n2], 0, 0, 0);
        if (n2 == 3) asm volatile("" ::: "memory");
      }
      asm volatile("" ::: "memory");
    }
    asm volatile("s_waitcnt lgkmcnt(0)" ::: "memory");
  }
  if (lat) {
    const u16* q0src = ZA + (size_t)(row0 + qrow + fr) * 2048 + 512 + h * 128;
    bf16x8 q0[4];
#pragma unroll
    for (int ks = 0; ks < 4; ks++) q0[ks] = *(const bf16x8*)(q0src + ks * 32 + fq * 8);
#pragma unroll 1
    for (int dir = 0; dir < 2; dir++) {
      const u16* S0 = (const u16*)(WS(p) + OFF_S0T) + (size_t)((((seq * 2 + l) * 2 + dir) * 4 + h)) * 16384;
      float wj[4];
#pragma unroll
      for (int j = 0; j < 4; j++) { int gi = qrow + fq * 4 + j; wj[j] = dir == 0 ? __expf(lgf * (float)(gi + 1)) : __expf(lgb * (float)(L - 1 - gi)); }
#pragma unroll
      for (int n2 = 0; n2 < 8; n2++) {
        f32x4 tmp = {0.f, 0.f, 0.f, 0.f};
#pragma unroll
        for (int ks = 0; ks < 4; ks++) {
          bf16x8 b = *(const bf16x8*)(S0 + (size_t)(n2 * 16 + fr) * 128 + ks * 32 + fq * 8);
          tmp = __builtin_amdgcn_mfma_f32_16x16x32_bf16(q0[ks], b, tmp, 0, 0, 0);
        }
#pragma unroll
        for (int j = 0; j < 4; j++) o[n2][j] += wj[j] * tmp[j];
        asm volatile("" ::: "memory");
      }
    }
  }
#pragma unroll
  for (int j = 0; j < 4; j++) {
    float s = 0.f;
#pragma unroll
    for (int n2 = 0; n2 < 8; n2++) s += o[n2][j];
    s += __shfl_xor(s, 1, 64); s += __shfl_xor(s, 2, 64); s += __shfl_xor(s, 4, 64); s += __shfl_xor(s, 8, 64);
    float mean = s * (1.f / 128.f);
    float v = 0.f;
#pragma unroll
    for (int n2 = 0; n2 < 8; n2++) { float dd = o[n2][j] - mean; v += dd * dd; }
    v += __shfl_xor(v, 1, 64); v += __shfl_xor(v, 2, 64); v += __shfl_xor(v, 4, 64); v += __shfl_xor(v, 8, 64);
    float rstd = rsqrtf(v * (1.f / 128.f) + 1e-5f);
    size_t rbase = (size_t)(row0 + qrow + fq * 4 + j) * 2048;
#pragma unroll
    for (int n2 = 0; n2 < 8; n2++) {
      int e = n2 * 16 + fr;
      float gv = bf2f(ZA[rbase + 1536 + h * 128 + e]);
      ZA[rbase + 512 + h * 128 + e] = f2bf((o[n2][j] - mean) * rstd * gv);
    }
  }
}

DEV bf16x8 scale8(u32x4 raw, const float (&w)[8]) {
  union { u32x4 u; bf16x8 v; } r;
#pragma unroll
  for (int q = 0; q < 4; q++) {
    float a = __uint_as_float(raw[q] << 16) * w[q * 2], b = __uint_as_float(raw[q] & 0xffff0000u) * w[q * 2 + 1];
    r.u[q] = pack2(a, b);
  }
  return r.v;
}

DEV void retstate_task(const Params& p, int l, int task) {
  const int tid = TID(), lane = tid & 63, wid = tid >> 6, fr = lane & 15, fq = lane >> 4;
  int seq = task >> 3, h = (task >> 1) & 3, dir = task & 1;
  const u16* KT = (const u16*)(WS(p) + OFF_KT) + (size_t)((seq * 4 + h) * 128) * 256;
  const u16* VT = (const u16*)(WS(p) + OFF_VT) + (size_t)((seq * 4 + h) * 128) * 256;
  const float lg = log1pf(-expf(INP(p, 20)[(l * 2 + dir) * 4 + h]));
  f32x4 acc[2][8];
#pragma unroll
  for (int m = 0; m < 2; m++)
#pragma unroll
    for (int n = 0; n < 8; n++) acc[m][n] = f32x4{0.f, 0.f, 0.f, 0.f};
#pragma unroll 1
  for (int ks = 0; ks < 8; ks++) {
    float w[8];
#pragma unroll
    for (int jj = 0; jj < 8; jj++) { int j = ks * 32 + fq * 8 + jj; w[jj] = __expf(lg * (float)(dir == 0 ? 255 - j : j)); }
    bf16x8 a[2];
#pragma unroll
    for (int m = 0; m < 2; m++) a[m] = scale8(*(const u32x4*)(KT + (size_t)(wid * 32 + m * 16 + fr) * 256 + ks * 32 + fq * 8), w);
#pragma unroll
    for (int n = 0; n < 8; n++) {
      bf16x8 b = *(const bf16x8*)(VT + (size_t)(n * 16 + fr) * 256 + ks * 32 + fq * 8);
#pragma unroll
      for (int m = 0; m < 2; m++) acc[m][n] = __builtin_amdgcn_mfma_f32_16x16x32_bf16(a[m], b, acc[m][n], 0, 0, 0);
    }
  }
  float* o = OUTP(p) + 13107200 + ((((size_t)seq * 2 + l) * 2 + dir) * 4 + h) * 16384;
#pragma unroll
  for (int m = 0; m < 2; m++)
#pragma unroll
    for (int n = 0; n < 8; n++)
#pragma unroll
      for (int j = 0; j < 4; j++) o[(size_t)(wid * 32 + m * 16 + fq * 4 + j) * 128 + n * 16 + fr] = acc[m][n][j];
}

template <bool LAT>
DEV void hyena_mfma(const Params& p, int l, int task, char* smem) {
  constexpr int L = LAT ? 1024 : 256;
  constexpr int NV = LAT ? 4 : 16;
  constexpr int RS = L + 8, CS = 2 * L + 16;
  constexpr int MPW = L / 64, NKS = L / 32, NCH = L / 8, Lsel = LAT ? 1 : 0;
  const int tid = TID(), lane = tid & 63, wid = tid >> 6, fr = lane & 15, fq = lane >> 4;
  const int c = LAT ? task : (task >> 1);
  const int sg = LAT ? 0 : (task & 1);
  u16* CP = (u16*)smem; u16* XV = CP + 8 * CS; u16* GS = XV + NV * RS; u16* O1 = GS + NV * RS;
  const u16* HYT = (const u16*)(WS(p) + OFF_HYZ);
  u16* HYOT = (u16*)(WS(p) + OFF_OUT1) + (size_t)MT * 512;
  const float* cw = INP(p, 22) + (size_t)l * 3 * 1536; const float* cb = INP(p, 23) + l * 1536;
  auto sconv = [&](int arr, u16* dstA) {
    const int ch = arr * 512 + c;
    const float w0 = cw[ch], w1 = cw[1536 + ch], w2 = cw[3072 + ch], bb = cb[ch];
#pragma unroll
    for (int i = 0; i < (NV * NCH) / 256; i++) {
      int id = tid + i * 256; int n = id / NCH, t8 = (id % NCH) * 8;
      const u16* src = LAT ? HYT + (size_t)8192 * 1536 + ((size_t)n * 1536 + ch) * 1024 + t8 : HYT + ((size_t)(sg * 16 + n) * 1536 + ch) * 256 + t8;
      u32x4 raw = *(const u32x4*)src;
      float h[10];
      h[0] = t8 > 0 ? bf2f(src[-1]) : 0.f;
      h[9] = t8 + 8 < L ? bf2f(src[8]) : 0.f;
#pragma unroll
      for (int q = 0; q < 4; q++) { h[1 + 2 * q] = __uint_as_float(raw[q] << 16); h[2 + 2 * q] = __uint_as_float(raw[q] & 0xffff0000u); }
      u32x4 o;
#pragma unroll
      for (int q = 0; q < 4; q++) o[q] = pack2(w0 * h[2 * q] + w1 * h[2 * q + 1] + w2 * h[2 * q + 2] + bb, w0 * h[2 * q + 1] + w1 * h[2 * q + 2] + w2 * h[2 * q + 3] + bb);
      *(u32x4*)(dstA + n * RS + t8) = o;
    }
  };
  __syncthreads();
  sconv(0, GS);
  sconv(2, XV);
  const int rr = (-fr) & 7;
  const u16* cpl = CP + rr * CS + (L + 8 * fq - fr - rr);
#pragma unroll 1
  for (int o = 0; o < 2; o++) {
    if (o == 1) sconv(1, GS);
    u16* FL = o == 0 ? O1 : XV;
    const float* Gp = (const float*)(WS(p) + OFF_G) + (Lsel ? 524288 : 0) + (size_t)o * (2 * L) * 512 + c;
    if (tid < 2 * L / 8) {
      float f[8];
#pragma unroll
      for (int j = 0; j < 8; j++) { int u = tid * 8 + j; f[j] = u > 0 ? Gp[(size_t)(2 * L - u) * 512] : 0.f; }
      u32x4 v; v[0] = pack2(f[0], f[1]); v[1] = pack2(f[2], f[3]); v[2] = pack2(f[4], f[5]); v[3] = pack2(f[6], f[7]);
      *(u32x4*)(FL + tid * 8) = v;
    }
    if (tid < 2) *(u32x4*)(FL + 2 * L + tid * 8) = u32x4{0u, 0u, 0u, 0u};
    __syncthreads();
    if (tid < 2 * L / 8) {
      u32x4 a = *(const u32x4*)(FL + tid * 8), b = *(const u32x4*)(FL + tid * 8 + 8);
      unsigned d[8] = {a[0], a[1], a[2], a[3], b[0], b[1], b[2], b[3]};
#pragma unroll
      for (int r = 0; r < 8; r++) {
        u32x4 ov;
#pragma unroll
        for (int q = 0; q < 4; q++) ov[q] = (r & 1) ? ((d[q + (r >> 1)] >> 16) | (d[q + (r >> 1) + 1] << 16)) : d[q + (r >> 1)];
        *(u32x4*)(CP + r * CS + tid * 8) = ov;
      }
    }
    __syncthreads();
    float rn;
    {
      constexpr int NTB = LAT ? 128 : 32;
      const float* SP = (const float*)(WS(p) + WS_END) + ((size_t)l * 160 + (LAT ? 32 : 0)) * 2048 + o * 512 + c;
      float ssum = 0.f;
      for (int tb = lane; tb < NTB; tb += 64) ssum += SP[(size_t)tb * 2048] + SP[(size_t)tb * 2048 + 1024];
#pragma unroll
      for (int off = 32; off > 0; off >>= 1) ssum += __shfl_xor(ssum, off, 64);
      rn = rsqrtf(ssum + 1e-6f);
    }
    const float bias = INP(p, 30)[(l * 2 + o) * 512 + c];
    const u16* Xs = o == 0 ? XV : O1;
    f32x4 acc[MPW];
#pragma unroll
    for (int mi = 0; mi < MPW; mi++) acc[mi] = f32x4{0.f, 0.f, 0.f, 0.f};
    const bf16x8 zero8 = {0, 0, 0, 0, 0, 0, 0, 0};
#pragma unroll 2
    for (int ks = 0; ks < NKS; ks++) {
      bf16x8 b = (fr < NV) ? *(const bf16x8*)(Xs + fr * RS + ks * 32 + fq * 8) : zero8;
#pragma unroll
      for (int mi = 0; mi < MPW; mi++) {
        bf16x8 a = *(const bf16x8*)(cpl - 16 * (wid * MPW + mi) + 32 * ks);
        acc[mi] = __builtin_amdgcn_mfma_f32_16x16x32_bf16(a, b, acc[mi], 0, 0, 0);
      }
    }
    if (fr < NV) {
      const u16* gate = GS;
      const u16* vin = o == 0 ? XV : O1;
#pragma unroll
      for (int mi = 0; mi < MPW; mi++) {
        const int t0 = (wid * MPW + mi) * 16 + fq * 4;
        u32x2 gq = *(const u32x2*)(gate + fr * RS + t0), vq = *(const u32x2*)(vin + fr * RS + t0);
        float g4[4] = {__uint_as_float(gq[0] << 16), __uint_as_float(gq[0] & 0xffff0000u), __uint_as_float(gq[1] << 16), __uint_as_float(gq[1] & 0xffff0000u)};
        float v4[4] = {__uint_as_float(vq[0] << 16), __uint_as_float(vq[0] & 0xffff0000u), __uint_as_float(vq[1] << 16), __uint_as_float(vq[1] & 0xffff0000u)};
        float r4[4];
#pragma unroll
        for (int j = 0; j < 4; j++) r4[j] = g4[j] * (acc[mi][j] * rn + bias * v4[j]);
        if (o == 0) {
          u32x2 ov; ov[0] = pack2(r4[0], r4[1]); ov[1] = pack2(r4[2], r4[3]);
          *(u32x2*)(O1 + fr * RS + t0) = ov;
        } else {
          u16* dst = LAT ? HYOT + (size_t)8192 * 512 + ((size_t)fr * 512 + c) * 1024 + t0 : HYOT + ((size_t)(sg * 16 + fr) * 512 + c) * 256 + t0;
          u32x2 ov; ov[0] = pack2(r4[0], r4[1]); ov[1] = pack2(r4[2], r4[3]);
          *(u32x2*)dst = ov;
        }
      }
    }
    __syncthreads();
  }
}

DEV void phaseD(const Params& p, int l, char* smem) {
  const int nb = gridDim.x, b = BID();
#pragma unroll 1
  for (int t = b; t < 512; t += nb) hyena_mfma<true>(p, l, t, smem);
#pragma unroll 1
  for (int t = (b + nb - (512 % nb)) % nb; t < 768; t += nb) ret_task(p, l, t, smem);
#pragma unroll 1
  for (int t = (b + 2 * nb - ((512 + 768) % nb)) % nb; t < 576; t += nb) s5_task(p, l, t, smem);
#pragma unroll 1
  for (int t = (b + 3 * nb - ((512 + 768 + 576) % nb)) % nb; t < 1024; t += nb) hyena_mfma<false>(p, l, t, smem);
#pragma unroll 1
  for (int t = (b + 4 * nb - ((512 + 768 + 576 + 1024) % nb)) % nb; t < 256; t += nb) retstate_task(p, l, t);
}

DEV void phaseE(const Params& p, char* smem) {
  const u16* HYOT = (const u16*)(WS(p) + OFF_OUT1) + (size_t)MT * 512;
  u16* HYO = (u16*)(WS(p) + OFF_OUT1);
  u16* sm = (u16*)smem;
  const int tx = TID() & 63, ty = TID() >> 6;
  for (int tile = BID(); tile < 192 * 8; tile += gridDim.x) {
    int rt = tile >> 3, c0 = (tile & 7) * 64; int row0 = rt * 64;
    const u16* src = row0 < 8192 ? HYOT + ((size_t)(row0 >> 8) * 512 + c0) * 256 + (row0 & 255)
                                 : HYOT + (size_t)8192 * 512 + ((size_t)((row0 - 8192) >> 10) * 512 + c0) * 1024 + ((row0 - 8192) & 1023);
    const int L = row0 < 8192 ? 256 : 1024;
    __syncthreads();
#pragma unroll
    for (int i = 0; i < 16; i++) { int cc = ty + i * 4; sm[cc * 66 + tx] = src[(size_t)cc * L + tx]; }
    __syncthreads();
#pragma unroll
    for (int i = 0; i < 16; i++) { int tt = ty + i * 4; HYO[(size_t)(row0 + tt) * 512 + c0 + tx] = sm[tx * 66 + tt]; }
  }
}

DEV void phaseF(const Params& p, int l, char* smem) {
  u16* sA = (u16*)smem; u16* T = (u16*)smem;
  const u16* H = (const u16*)(WS(p) + OFF_H);
  const u16* WT = (const u16*)(WS(p) + OFF_WT);
  const u16* ZA = (const u16*)(WS(p) + OFF_ZA); const u16* HYO = (const u16*)(WS(p) + OFF_OUT1);
  u16* MG = (u16*)(WS(p) + OFF_YP);
  for (int tile = BID(); tile < 96 * 16; tile += gridDim.x) {
    int tm = tile >> 4, tn = tile & 15; int row0 = tm * 128, n0 = tn * 64;
    f32x4 a1[4][2], a2[4][2], tt[4][2];
    const u16* Hrow = H + (size_t)row0 * 1024;
    zero_acc<4, 2>(a1); zero_acc<4, 2>(tt);
#pragma unroll 1
    for (int ps = 0; ps < 7; ps++) {
      const u16* Ap; const u16* Bp; int lda, K;
      switch (ps) {
        case 0: Ap = ZA + (size_t)row0 * 2048; lda = 2048; Bp = WT + WGLU_O + (size_t)n0 * 512; K = 512; break;
        case 1: Ap = ZA + (size_t)row0 * 2048; lda = 2048; Bp = WT + WGLU_O + (size_t)(1024 + n0) * 512; K = 512; break;
        case 3: Ap = ZA + (size_t)row0 * 2048 + 512; lda = 2048; Bp = WT + WRETO_O + (size_t)n0 * 512; K = 512; break;
        case 5: Ap = HYO + (size_t)row0 * 512; lda = 512; Bp = WT + WHYO_O + (size_t)n0 * 512; K = 512; break;
        default: Ap = Hrow; lda = 1024; Bp = WT + WIN_O + (size_t)(4096 + ((ps - 2) >> 1) * 1024 + n0) * 1024; K = 1024; break;
      }
      zero_acc<4, 2>(a2);
      gemm_loop<4, 2>(Ap, lda, Bp, K, K, a2, sA);
      if (ps == 0 || ps == 3 || ps == 5) {
#pragma unroll
        for (int m = 0; m < 4; m++)
#pragma unroll
          for (int n = 0; n < 2; n++) a1[m][n] = a2[m][n];
      } else if (ps == 1) {
#pragma unroll
        for (int m = 0; m < 4; m++)
#pragma unroll
          for (int n = 0; n < 2; n++)
#pragma unroll
            for (int j = 0; j < 4; j++) a1[m][n][j] *= sigm(a2[m][n][j]);
      } else {
#pragma unroll
        for (int m = 0; m < 4; m++)
#pragma unroll
          for (int n = 0; n < 2; n++)
#pragma unroll
            for (int j = 0; j < 4; j++) tt[m][n][j] += a1[m][n][j] * sigm(a2[m][n][j]);
      }
    }
    __syncthreads();
    acc_to_lds<4, 2, 72>(tt, T, 0);
    __syncthreads();
    copy_tile<64, 72>(T, MG + (size_t)row0 * 1024 + n0, 1024);
  }
}

template <int MF, int NF>
DEV void resid_store(const Params& p, const f32x4 (&acc)[MF][NF], int l, int chunk, int row0, int col0, bool from_input) {
  const int tid = TID(), lane = tid & 63, wid = tid >> 6, wr = wid >> 1, wc = wid & 1, fr = lane & 15, fq = lane >> 4;
  float* out = OUTP(p);
#pragma unroll
  for (int m = 0; m < MF; m++) {
    const int rb = row0 + m * 32 + wr * 16 + fq * 4;
    const int j = modidx(rb);
    const float* MOD = (const float*)(WS(p) + OFF_MOD) + (l * 5 + j) * 6144 + chunk * 1024;
    const float* BM = INP(p, 7) + l * 6144 + chunk * 1024;
#pragma unroll
    for (int n = 0; n < NF; n++) {
      int col = col0 + wc * (NF * 16) + n * 16 + fr;
      float g = MOD[col] + BM[col];
#pragma unroll
      for (int jj = 0; jj < 4; jj++) {
        int row = rb + jj;
        float xo = from_input ? xin_row(p, row)[col] : out[(size_t)row * 1024 + col];
        out[(size_t)row * 1024 + col] = xo + g * acc[m][n][jj];
      }
    }
  }
}

DEV void phaseG(const Params& p, int l, char* smem) {
  u16* sA = (u16*)smem;
  const u16* MG = (const u16*)(WS(p) + OFF_YP);
  const u16* W = (const u16*)(WS(p) + OFF_WT) + WOUT_O;
  for (int tile = BID(); tile < 48 * 8; tile += gridDim.x) {
    int tm = tile >> 3, tn = tile & 7;
    f32x4 acc[8][4]; zero_acc<8, 4>(acc);
    gemm_loop<8, 4>(MG + (size_t)tm * 256 * 1024, 1024, W + (size_t)tn * 128 * 1024, 1024, 1024, acc, sA);
    resid_store<8, 4>(p, acc, l, 2, tm * 256, tn * 128, l == 0);
  }
}

DEV void phaseI(const Params& p, int l, char* smem) {
  u16* sA = (u16*)smem; u16* T = (u16*)smem;
  const u16* H = (const u16*)(WS(p) + OFF_H);
  const u16* W = (const u16*)(WS(p) + OFF_WT) + WFIN_O;
  u16* ACT = (u16*)(WS(p) + OFF_ZA);
  for (int tile = BID(); tile < 48 * 44; tile += gridDim.x) {
    int tm = tile / 44, tn = tile % 44;
    f32x4 acc[8][4]; zero_acc<8, 4>(acc);
    gemm_loop<8, 4>(H + (size_t)tm * 256 * 1024, 1024, W + (size_t)tn * 128 * 1024, 1024, 1024, acc, sA);
    const int tid = TID(), lane = tid & 63, wid = tid >> 6, wr = wid >> 1, wc = wid & 1, fr = lane & 15, fq = lane >> 4;
#pragma unroll
    for (int hh = 0; hh < 2; hh++) {
      __syncthreads();
#pragma unroll
      for (int m = 0; m < 4; m++)
#pragma unroll
        for (int n = 0; n < 2; n++)
#pragma unroll
          for (int j = 0; j < 4; j++)
            T[(m * 32 + wr * 16 + fq * 4 + j) * 72 + wc * 32 + n * 16 + fr] = f2bf(silu_(acc[hh * 4 + m][2 * n][j]) * acc[hh * 4 + m][2 * n + 1][j]);
      __syncthreads();
      copy_tile<64, 72>(T, ACT + (size_t)(tm * 256 + hh * 128) * 2816 + tn * 64, 2816);
    }
  }
}

DEV void phaseJ(const Params& p, int l, char* smem) {
  u16* sA = (u16*)smem;
  const u16* ACT = (const u16*)(WS(p) + OFF_ZA);
  const u16* W = (const u16*)(WS(p) + OFF_WT) + WFOUT_O;
  for (int tile = BID(); tile < 48 * 8; tile += gridDim.x) {
    int tm = tile >> 3, tn = tile & 7;
    f32x4 acc[8][4]; zero_acc<8, 4>(acc);
    gemm_loop<8, 4>(ACT + (size_t)tm * 256 * 2816, 2816, W + (size_t)tn * 128 * 2816, 2816, 2816, acc, sA);
    resid_store<8, 4>(p, acc, l, 5, tm * 256, tn * 128, false);
  }
}


#define XB_TMO      128
#define XB_XCNT(j)  (256  + 64 * (j))
#define XB_XSUB(j)  (1280 + 64 * (j))
#define XB_XGEN(j)  (2304 + 64 * (j))
#define XB_TOP      3328
#define XB_TOPGEN   3392
#define XB_SPIN_CAP (1u << 22)
#define LAS __attribute__((address_space(3)))
DEV unsigned xb_ld(unsigned* p) { return __hip_atomic_load(p, __ATOMIC_RELAXED, __HIP_MEMORY_SCOPE_AGENT); }
DEV unsigned xb_add(unsigned* p, unsigned v) { return __hip_atomic_fetch_add(p, v, __ATOMIC_RELAXED, __HIP_MEMORY_SCOPE_AGENT); }
DEV unsigned xb_xcc_id() { return (unsigned)__builtin_amdgcn_s_getreg((3 << 11) | 20) & 0xFu; }
#define XB_SPIN(cond, bar) do { unsigned _sp = 0; while (cond) { __builtin_amdgcn_s_sleep(1); \
    if ((++_sp & 255u) == 0u) { if (xb_ld(&(bar)[XB_TMO])) break; if (_sp > XB_SPIN_CAP) { atomicAdd(&(bar)[XB_TMO], 1u); break; } } } } while (0)
struct XcdBarrier { unsigned* bar; unsigned x; volatile LAS unsigned* st; };
DEV XcdBarrier xcd_barrier_post(unsigned* bar, volatile LAS unsigned* st) {
  XcdBarrier b; b.bar = bar; b.x = xb_xcc_id(); b.st = st;
  if (threadIdx.x == 0) (void)xb_add(&bar[XB_XCNT(b.x)], 1u);
  return b;
}
DEV void xcd_barrier_complete(unsigned* bar, unsigned x, unsigned& nloc, unsigned& nx) {
  const unsigned G = gridDim.x * gridDim.y * gridDim.z;
  unsigned sum, cnt, mine, sp = 0u;
  for (;;) {
    sum = 0u; cnt = 0u; mine = 0u;
#pragma unroll
    for (unsigned j = 0; j < 16; ++j) { const unsigned c = xb_ld(&bar[XB_XCNT(j)]); sum += c; cnt += (c > 0u) ? 1u : 0u; mine = (j == x) ? c : mine; }
    if (sum == G) break;
    __builtin_amdgcn_s_sleep(1);
    if ((++sp & 255u) == 0u) { if (xb_ld(&bar[XB_TMO])) break; if (sp > XB_SPIN_CAP) { atomicAdd(&bar[XB_TMO], 1u); break; } }
  }
  nloc = mine > 0u ? mine : 1u; nx = cnt > 0u ? cnt : 1u;
}
DEV void xcd_barrier(const XcdBarrier& b) {
  asm volatile("s_waitcnt vmcnt(0)" ::: "memory");
  __syncthreads();
  if (threadIdx.x == 0) {
    unsigned* bar = b.bar;
    __builtin_amdgcn_s_waitcnt(0);
    unsigned nloc = b.st[0], nx = b.st[1];
    if (nloc == 0u) { xcd_barrier_complete(bar, b.x, nloc, nx); b.st[0] = nloc; b.st[1] = nx; }
    const unsigned old = xb_add(&bar[XB_XSUB(b.x)], 1u);
    const unsigned gen = old / nloc;
    if (old + 1u == (gen + 1u) * nloc) {
      __builtin_amdgcn_fence(__ATOMIC_RELEASE, "agent");
      asm volatile("s_waitcnt vmcnt(0)" ::: "memory");
      const unsigned og = xb_add(&bar[XB_TOP], 1u);
      const unsigned tg = og / nx;
      if (og + 1u == (tg + 1u) * nx) xb_add(&bar[XB_TOPGEN], 1u);
      else XB_SPIN(xb_ld(&bar[XB_TOPGEN]) == tg, bar);
      __builtin_amdgcn_fence(__ATOMIC_ACQUIRE, "agent");
      xb_add(&bar[XB_XGEN(b.x)], 1u);
      asm volatile("s_waitcnt vmcnt(0)" ::: "memory");
    } else {
      XB_SPIN(xb_ld(&bar[XB_XGEN(b.x)]) == gen, bar);
      __builtin_amdgcn_fence(__ATOMIC_ACQUIRE, "agent");
      asm volatile("s_waitcnt vmcnt(0)" ::: "memory");
    }
  }
  __syncthreads();
}

constexpr int SMEM_BYTES = 57792;

DEV void run_phase(const Params& p, int ph, int l, char* smem) {
  switch (ph) {
    case 0: phaseA(p, smem); break;
    case 1: norm_phase(p, l, 0); if (l == 1) layer_prep(p, 1, smem); break;
    case 2: phaseC(p, l, smem); break;
    case 3: phaseD(p, l, smem); break;
    case 4: phaseE(p, smem); break;
    case 5: phaseF(p, l, smem); break;
    case 6: phaseG(p, l, smem); break;
    case 7: norm_phase(p, l, 1); break;
    case 8: phaseI(p, l, smem); break;
    case 9: phaseJ(p, l, smem); break;
    case 10: norm_phase(p, 0, 2); break;
  }
}

#if MULTI
__global__ void __launch_bounds__(256, 2) kphase(Params p, int ph, int l) {
  __shared__ __attribute__((aligned(16))) char smem[SMEM_BYTES];
  run_phase(p, ph, l, smem);
}
#else
__global__ void __launch_bounds__(256, 2) mega(Params p) {
  __shared__ __attribute__((aligned(16))) char smem[SMEM_BYTES];
  __shared__ uint4 xb_words;
  cg::grid_group grid = cg::this_grid();
  if (threadIdx.x == 0) xb_words = make_uint4(0u, 0u, 0u, 0u);
  __syncthreads();
  XcdBarrier xb = xcd_barrier_post((unsigned*)(p.ws + OFF_BAR), (volatile LAS unsigned*)&xb_words);
  run_phase(p, 0, 0, smem);
  grid.sync();
  for (int l = 0; l < 2; l++) {
    for (int ph = 1; ph <= 9; ph++) {
      run_phase(p, ph, l, smem);
      xcd_barrier(xb);
    }
  }
  run_phase(p, 10, 0, smem);
}
#endif

extern "C" void kernel_launch(void* const* d_in, const int* in_sizes, int n_in, void* d_out, int out_size, void* d_ws, size_t ws_size, hipStream_t stream) {
  Params p{};
  for (int i = 0; i < 36; i++) p.in[i] = (const float*)d_in[i];
  p.out = (float*)d_out;
  p.ws = (char*)d_ws;
  hipMemsetAsync((char*)d_ws + OFF_MOD, 0, ZERO_BYTES, stream);
  static int grid_blocks = 0;
#if MULTI
  if (!grid_blocks) {
    int dev = 0, cus = 0, per_cu = 0;
    hipGetDevice(&dev);
    hipDeviceGetAttribute(&cus, hipDeviceAttributeMultiprocessorCount, dev);
    hipOccupancyMaxActiveBlocksPerMultiprocessor(&per_cu, kphase, 256, 0);
    if (per_cu > 2) per_cu = 2;
    if (per_cu < 1) per_cu = 1;
    grid_blocks = cus * per_cu;
  }
  kphase<<<grid_blocks, 256, 0, stream>>>(p, 0, 0);
  for (int l = 0; l < 2; l++)
    for (int ph = 1; ph <= 9; ph++) kphase<<<grid_blocks, 256, 0, stream>>>(p, ph, l);
  kphase<<<grid_blocks, 256, 0, stream>>>(p, 10, 0);
#else
  if (!grid_blocks) {
    int dev = 0, cus = 0, per_cu = 0;
    hipGetDevice(&dev);
    hipDeviceGetAttribute(&cus, hipDeviceAttributeMultiprocessorCount, dev);
    hipOccupancyMaxActiveBlocksPerMultiprocessor(&per_cu, mega, 256, 0);
    if (per_cu > 2) per_cu = 2;
    if (per_cu < 1) per_cu = 1;
    grid_blocks = cus * per_cu;
  }
  void* args[] = {&p};
  hipError_t e = hipLaunchCooperativeKernel((void*)mega, dim3(grid_blocks), dim3(256), args, 0, stream);
  if (e != hipSuccess) fprintf(stderr, "cooperative launch failed: %s (grid %d)\n", hipGetErrorString(e), grid_blocks);
#endif
}
```

```cpp
#include <hip/hip_runtime.h>
#include <hip/hip_cooperative_groups.h>
#include <cstdio>
namespace cg = cooperative_groups;

#ifndef MULTI
#define MULTI 0
#endif

typedef unsigned short u16;
using bf16x8 = __attribute__((ext_vector_type(8))) short;
using f32x4 = __attribute__((ext_vector_type(4))) float;
using u32x4 = __attribute__((ext_vector_type(4))) unsigned;
using u32x2 = __attribute__((ext_vector_type(2))) unsigned;
#define DEV __device__ __forceinline__

constexpr int MT = 12288;
constexpr size_t OFF_WT = 0;
constexpr int WIN_O = 0, WGLU_O = 7340032, WRETO_O = 8388608, WHYO_O = 8912896, WOUT_O = 9437184, WFIN_O = 10485760, WFOUT_O = 16252928;
constexpr size_t OFF_G = 38273024;
constexpr size_t OFF_H = 48758784;
constexpr size_t OFF_ZA = 73924608;
constexpr size_t OFF_HYZ = 124256256;
constexpr size_t OFF_VT = 162004992;
constexpr size_t OFF_KT = 174587904;
constexpr size_t OFF_QR = 182976512;
constexpr size_t OFF_YP = 187170816;
constexpr size_t OFF_OUT1 = 212336640;
constexpr size_t OFF_MOD = 237502464;
constexpr size_t OFF_SUMSQ = OFF_MOD + 245760;
constexpr size_t OFF_BAR = OFF_SUMSQ + 16384;
constexpr size_t ZERO_BYTES = 245760 + 16384 + 16384;
constexpr size_t OFF_LAMBAR = OFF_BAR + 16384;
constexpr size_t OFF_BBAR = OFF_LAMBAR + 65536;
constexpr size_t OFF_CM = OFF_BBAR + 524288;
constexpr size_t OFF_ROPE = OFF_CM + 524288;
constexpr size_t OFF_S0T = OFF_ROPE + 524288;
constexpr size_t WS_END = OFF_S0T + 2097152;

struct Params {
  const float* in[36];
  float* out;
  char* ws;
};


DEV int TID() { int t = threadIdx.x; asm volatile("" : "+v"(t)); return t; }
DEV int BID() { int t = blockIdx.x; asm volatile("" : "+s"(t)); return t; }
DEV char* WS(const Params& p) { char* w = p.ws; asm volatile("" : "+s"(w)); return w; }
DEV float* OUTP(const Params& p) { float* w = p.out; asm volatile("" : "+s"(w)); return w; }
DEV const float* INP(const Params& p, int i) { const float* w = p.in[i]; asm volatile("" : "+s"(w)); return w; }

DEV u16 f2bf(float f) { unsigned u = __float_as_uint(f); u += 0x7fffu + ((u >> 16) & 1u); return (u16)(u >> 16); }
DEV float bf2f(u16 h) { return __uint_as_float(((unsigned)h) << 16); }
DEV float sigm(float x) { return 1.f / (1.f + __expf(-x)); }
DEV float silu_(float x) { return x / (1.f + __expf(-x)); }
DEV float gelu_(float x) { float u = 0.7978845608028654f * (x + 0.044715f * x * x * x); return 0.5f * x * (1.f + tanhf(u)); }
DEV unsigned pack2(float a, float b) { return (unsigned)f2bf(a) | ((unsigned)f2bf(b) << 16); }

DEV const float* xin_row(const Params& p, int row) { return row < 8192 ? INP(p, 0) + (size_t)row * 1024 : INP(p, 1) + (size_t)(row - 8192) * 1024; }
DEV int modidx(int row) { return row < 8192 ? 0 : 1 + ((row - 8192) >> 10); }

template <int MF, int NF>
DEV void gemm_loop(const u16* __restrict__ A, int lda, const u16* __restrict__ B, int ldb, int K, f32x4 (&acc)[MF][NF], u16* sA) {
  const int tid = TID(), lane = tid & 63, wid = tid >> 6, wr = wid >> 1, wc = wid & 1, fr = lane & 15, fq = lane >> 4;
  u16* sB = sA + MF * 32 * 72;
  u32x4 ra[MF], rb[NF];
  const int crow = tid >> 3, ccol = (tid & 7) * 8;
  const u16* Ap = A + (size_t)crow * lda + ccol;
  const u16* Bp = B + (size_t)crow * ldb + ccol;
#pragma unroll
  for (int i = 0; i < MF; i++) ra[i] = *(const u32x4*)(Ap + (size_t)(i * 32) * lda);
#pragma unroll
  for (int i = 0; i < NF; i++) rb[i] = *(const u32x4*)(Bp + (size_t)(i * 32) * ldb);
  for (int k0 = 0; k0 < K; k0 += 64) {
    __syncthreads();
#pragma unroll
    for (int i = 0; i < MF; i++) *(u32x4*)(sA + (crow + i * 32) * 72 + ccol) = ra[i];
#pragma unroll
    for (int i = 0; i < NF; i++) *(u32x4*)(sB + (crow + i * 32) * 72 + ccol) = rb[i];
    __syncthreads();
    if (k0 + 64 < K) {
#pragma unroll
      for (int i = 0; i < MF; i++) ra[i] = *(const u32x4*)(Ap + (size_t)(i * 32) * lda + k0 + 64);
#pragma unroll
      for (int i = 0; i < NF; i++) rb[i] = *(const u32x4*)(Bp + (size_t)(i * 32) * ldb + k0 + 64);
    }
#pragma unroll
    for (int ks = 0; ks < 2; ks++) {
      bf16x8 bv[NF];
#pragma unroll
      for (int n = 0; n < NF; n++) bv[n] = *(const bf16x8*)(sB + (wc * (NF * 16) + n * 16 + fr) * 72 + ks * 32 + fq * 8);
#pragma unroll
      for (int m = 0; m < MF; m++) {
        bf16x8 af = *(const bf16x8*)(sA + (m * 32 + wr * 16 + fr) * 72 + ks * 32 + fq * 8);
#pragma unroll
        for (int n = 0; n < NF; n++) acc[m][n] = __builtin_amdgcn_mfma_f32_16x16x32_bf16(af, bv[n], acc[m][n], 0, 0, 0);
      }
    }
  }
}

template <int MF, int NF>
DEV void zero_acc(f32x4 (&acc)[MF][NF]) {
#pragma unroll
  for (int m = 0; m < MF; m++)
#pragma unroll
    for (int n = 0; n < NF; n++) acc[m][n] = f32x4{0.f, 0.f, 0.f, 0.f};
}

DEV float epi_op(float v, int op) { return op == 1 ? v * 0.08838834764831845f : (op == 2 ? silu_(v) : v); }
template <int MF, int NF, int TS>
DEV void acc_to_lds(const f32x4 (&acc)[MF][NF], u16* T, int m0, int op = 0) {
  const int tid = TID(), lane = tid & 63, wid = tid >> 6, wr = wid >> 1, wc = wid & 1, fr = lane & 15, fq = lane >> 4;
#pragma unroll
  for (int m = 0; m < 4; m++)
#pragma unroll
    for (int n = 0; n < NF; n++)
#pragma unroll
      for (int j = 0; j < 4; j++) T[(m * 32 + wr * 16 + fq * 4 + j) * TS + wc * (NF * 16) + n * 16 + fr] = f2bf(epi_op(acc[m0 + m][n][j], op));
}
template <int MF>
DEV void acc_to_lds_T(const f32x4 (&acc)[MF][4], u16* T, int m0, int op = 0) {
  const int tid = TID(), lane = tid & 63, wid = tid >> 6, wr = wid >> 1, wc = wid & 1, fr = lane & 15, fq = lane >> 4;
#pragma unroll
  for (int m = 0; m < 4; m++)
#pragma unroll
    for (int n = 0; n < 4; n++) {
      u32x2 v; v.x = pack2(epi_op(acc[m0 + m][n][0], op), epi_op(acc[m0 + m][n][1], op)); v.y = pack2(epi_op(acc[m0 + m][n][2], op), epi_op(acc[m0 + m][n][3], op));
      *(u32x2*)(T + (wc * 64 + n * 16 + fr) * 136 + m * 32 + wr * 16 + fq * 4) = v;
    }
}
template <int COLS, int TS>
DEV void copy_tile(const u16* T, u16* dst, int ld) {
  constexpr int CPR = COLS / 8;
  constexpr int NIT = 128 * CPR / 256;
#pragma unroll
  for (int i = 0; i < NIT; i++) {
    int id = TID() + i * 256; int r = id / CPR, ch = id % CPR;
    *(u32x4*)(dst + (size_t)r * ld + ch * 8) = *(const u32x4*)(T + r * TS + ch * 8);
  }
}

DEV void transpose_tile(const float* __restrict__ src, int K, int N, u16* __restrict__ dst, int tile, float* sm, int perm = 0) {
  int nk = K >> 6; int tk = tile % nk, tn = tile / nk; int k0 = tk * 64, n0 = tn * 64;
  int tx = TID() & 63, ty = TID() >> 6;
  __syncthreads();
#pragma unroll
  for (int i = 0; i < 16; i++) { int k = ty + i * 4; sm[k * 65 + tx] = src[(size_t)(k0 + k) * N + n0 + tx]; }
  __syncthreads();
#pragma unroll
  for (int i = 0; i < 16; i++) {
    int n = n0 + ty + i * 4;
    if (perm) { int half = N >> 1; int j = n < half ? n : n - half; n = (j >> 4) * 32 + (n < half ? 0 : 16) + (j & 15); }
    dst[(size_t)n * K + k0 + tx] = f2bf(sm[tx * 65 + (ty + i * 4)]);
  }
}

DEV void wt_task(const Params& p, int l, int t, float* sm) {
  u16* WT = (u16*)(WS(p) + OFF_WT);
  const float* src; int K, N, off, tt, perm = 0;
  if (t < 1792) { src = INP(p, 10) + (size_t)l * 1024 * 7168; K = 1024; N = 7168; off = WIN_O; tt = t; }
  else if (t < 2048) { src = INP(p, 19) + (size_t)l * 512 * 2048; K = 512; N = 2048; off = WGLU_O; tt = t - 1792; }
  else if (t < 2176) { src = INP(p, 21) + (size_t)l * 512 * 1024; K = 512; N = 1024; off = WRETO_O; tt = t - 2048; }
  else if (t < 2304) { src = INP(p, 31) + (size_t)l * 512 * 1024; K = 512; N = 1024; off = WHYO_O; tt = t - 2176; }
  else if (t < 2560) { src = INP(p, 32) + (size_t)l * 1024 * 1024; K = 1024; N = 1024; off = WOUT_O; tt = t - 2304; }
  else if (t < 3968) { src = INP(p, 33) + (size_t)l * 1024 * 5632; K = 1024; N = 5632; off = WFIN_O; tt = t - 2560; perm = 1; }
  else { src = INP(p, 34) + (size_t)l * 2816 * 1024; K = 2816; N = 1024; off = WFOUT_O; tt = t - 3968; }
  transpose_tile(src, K, N, WT + off, tt, sm, perm);
}

DEV void mod_task(const Params& p, int task, float* sm) {
  int cb = task % 96; int l = task / 96;
  int tid = TID(), lane = tid & 63, kq = tid >> 6;
  __syncthreads();
  for (int i = tid; i < 5120; i += 256) {
    int j = i >> 10, k = i & 1023;
    float c = (j == 0) ? INP(p, 5)[k] : INP(p, 4)[(j - 1) * 1024 + k];
    sm[i] = silu_(c);
  }
  __syncthreads();
  int col = cb * 64 + lane;
  const float* w = INP(p, 6) + (size_t)l * 1024 * 6144 + col;
  float a0 = 0, a1 = 0, a2 = 0, a3 = 0, a4 = 0;
#pragma unroll 8
  for (int kk = 0; kk < 256; kk++) {
    int k = kk * 4 + kq;
    float wv = w[(size_t)k * 6144];
    a0 += sm[k] * wv; a1 += sm[1024 + k] * wv; a2 += sm[2048 + k] * wv; a3 += sm[3072 + k] * wv; a4 += sm[4096 + k] * wv;
  }
  float* red = sm + 5120;
  red[(kq * 5 + 0) * 64 + lane] = a0; red[(kq * 5 + 1) * 64 + lane] = a1; red[(kq * 5 + 2) * 64 + lane] = a2;
  red[(kq * 5 + 3) * 64 + lane] = a3; red[(kq * 5 + 4) * 64 + lane] = a4;
  __syncthreads();
  float* MOD = (float*)(WS(p) + OFF_MOD);
  for (int i = tid; i < 320; i += 256) {
    int j = i >> 6, cc = i & 63;
    float v = ((red[(0 * 5 + j) * 64 + cc] + red[(1 * 5 + j) * 64 + cc]) + red[(2 * 5 + j) * 64 + cc]) + red[(3 * 5 + j) * 64 + cc];
    MOD[(l * 5 + j) * 6144 + cb * 64 + cc] = v;
  }
}

DEV void filt_task(const Params& p, int l, int task, float* sm) {
  int Lsel = task >= 32; int tb = Lsel ? task - 32 : task; int L = Lsel ? 1024 : 256; int t0 = tb * 8;
  int tid = TID();
  float* z = sm; float* h1 = sm + 264; float* h2 = sm + 264 + 512;
  const float* w1 = INP(p, 24) + l * 33 * 64; const float* b1 = INP(p, 25) + l * 64;
  const float* w2 = INP(p, 26) + l * 64 * 64; const float* b2 = INP(p, 27) + l * 64;
  const float* fr0 = INP(p, 28) + l * 128; const float* fr1 = fr0 + 64;
  const float* w3 = INP(p, 29) + (size_t)l * 64 * 2048;
  __syncthreads();
  for (int i = tid; i < 264; i += 256) {
    int tt = i / 33, e = i % 33; float t = (float)(t0 + tt); float v;
    if (e == 0) v = t / (float)L;
    else {
      int b = (e - 1) & 15; float band = 1e-4f + (float)b * ((15.f - 1e-4f) / 15.f);
      float ang = (6.283185307179586f / (float)L) * t * band;
      v = (e <= 16) ? cosf(ang) : -sinf(ang);
    }
    z[i] = v;
  }
  __syncthreads();
  for (int i = tid; i < 512; i += 256) {
    int tt = i >> 6, j = i & 63; float s = b1[j];
    for (int e = 0; e < 33; e++) s += z[tt * 33 + e] * w1[e * 64 + j];
    h1[i] = sinf(fr0[j] * s);
  }
  __syncthreads();
  for (int i = tid; i < 512; i += 256) {
    int tt = i >> 6, j = i & 63; float s = b2[j];
    for (int e = 0; e < 64; e++) s += h1[tt * 64 + e] * w2[e * 64 + j];
    h2[i] = sinf(fr1[j] * s);
  }
  __syncthreads();
  float* FB = (float*)(WS(p) + OFF_G) + (Lsel ? 524288 : 0);
  float* SUMSQ = (float*)(WS(p) + WS_END);
  for (int m = 0; m < 8; m++) {
    int col = tid + m * 256;
    float acc[8];
#pragma unroll
    for (int tt = 0; tt < 8; tt++) acc[tt] = 0.f;
    for (int j = 0; j < 64; j++) {
      float w = w3[j * 2048 + col];
#pragma unroll
      for (int tt = 0; tt < 8; tt++) acc[tt] += h2[tt * 64 + j] * w;
    }
    int dir = col >> 10, o = (col >> 9) & 1, c = col & 511;
    float rate = 3.0701134573253944f + (float)c * ((15.350567286626972f - 3.0701134573253944f) / 511.f);
    float ss = 0.f;
    float* Fo = FB + (size_t)o * (2 * L) * 512 + c;
#pragma unroll
    for (int tt = 0; tt < 8; tt++) {
      int t = t0 + tt;
      float val = acc[tt] * expf(-((float)t / (float)L) * rate);
      if (dir == 0) { Fo[(size_t)(L + t) * 512] = val; ss += val * val; }
      else if (t > 0) { Fo[(size_t)(L - t) * 512] = val; ss += val * val; }
      else { Fo[0] = 0.f; }
    }
    SUMSQ[((size_t)l * 160 + task) * 2048 + col] = ss;
  }
}

DEV void s5prep_task(const Params& p, int task) {
  int idx = task * 256 + TID();
  int pp = idx & 63; int lrg = idx >> 6;
  float lre = INP(p, 11)[idx], lim = INP(p, 12)[idx];
  float dt = expf(INP(p, 13)[lrg]);
  float mag = expf(lre * dt);
  float lbr = mag * cosf(lim * dt), lbi = mag * sinf(lim * dt);
  float nr = lbr - 1.f, ni = lbi; float den = lre * lre + lim * lim;
  float cr = (nr * lre + ni * lim) / den, ci = (ni * lre - nr * lim) / den;
  u16* BBAR = (u16*)(WS(p) + OFF_BBAR); u16* CM = (u16*)(WS(p) + OFF_CM); float* LB = (float*)(WS(p) + OFF_LAMBAR);
  LB[idx * 2] = lbr; LB[idx * 2 + 1] = lbi;
  for (int c = 0; c < 16; c++) {
    float br = INP(p, 14)[(size_t)idx * 16 + c], bi = INP(p, 15)[(size_t)idx * 16 + c];
    BBAR[(size_t)lrg * 2048 + pp * 16 + c] = f2bf(cr * br - ci * bi);
    BBAR[(size_t)lrg * 2048 + (64 + pp) * 16 + c] = f2bf(cr * bi + ci * br);
    CM[(size_t)lrg * 2048 + c * 128 + pp] = f2bf(INP(p, 16)[(size_t)lrg * 1024 + c * 64 + pp]);
    CM[(size_t)lrg * 2048 + c * 128 + 64 + pp] = f2bf(-INP(p, 17)[(size_t)lrg * 1024 + c * 64 + pp]);
  }
}

DEV void rope_task(const Params& p, int task) {
  int idx = task * 256 + TID(); int t = idx >> 6, d = idx & 63; int f = d & 31;
  float inv = powf(10000.f, -(float)f / 32.f);
  float pos = (d < 32) ? (float)(t >> 6) : (float)(t & 63);
  float ang = pos * inv;
  float* R = (float*)(WS(p) + OFF_ROPE);
  R[idx * 2] = cosf(ang); R[idx * 2 + 1] = sinf(ang);
}

DEV void layer_prep(const Params& p, int l, char* smem) {
  for (int t = BID(); t < 4672 + 160; t += gridDim.x) {
    if (t < 4672) wt_task(p, l, t, (float*)smem);
    else filt_task(p, l, t - 4672, (float*)smem);
  }
}
DEV void phaseA(const Params& p, char* smem) {
  for (int t = BID(); t < 192 + 32 + 256 + 256; t += gridDim.x) {
    if (t < 192) mod_task(p, t, (float*)smem);
    else if (t < 224) s5prep_task(p, t - 192);
    else if (t < 480) rope_task(p, t - 224);
    else { int tt = t - 480; int mi = tt >> 2; transpose_tile(INP(p, 3) + (size_t)mi * 16384, 128, 128, (u16*)(WS(p) + OFF_S0T) + (size_t)mi * 16384, tt & 3, (float*)smem); }
  }
  layer_prep(p, 0, smem);
}

DEV void norm_phase(const Params& p, int l, int which) {
  const int lane = TID() & 63;
  const int wave = (BID() * blockDim.x + TID()) >> 6, nw = (gridDim.x * blockDim.x) >> 6;
  u16* H = (u16*)(WS(p) + OFF_H);
  const float* MOD = (const float*)(WS(p) + OFF_MOD);
  for (int row = wave; row < MT; row += nw) {
    const float* x = (l == 0 && which == 0) ? xin_row(p, row) : OUTP(p) + (size_t)row * 1024;
    float4 v[4]; float ss = 0.f;
#pragma unroll
    for (int i = 0; i < 4; i++) { v[i] = *(const float4*)(x + i * 256 + lane * 4); ss += v[i].x * v[i].x + v[i].y * v[i].y + v[i].z * v[i].z + v[i].w * v[i].w; }
#pragma unroll
    for (int o = 32; o > 0; o >>= 1) ss += __shfl_xor(ss, o, 64);
    float rinv = rsqrtf(ss * (1.f / 1024.f) + 1e-6f);
    if (which == 2) {
      const float* nf = INP(p, 35);
#pragma unroll
      for (int i = 0; i < 4; i++) {
        float4 g = *(const float4*)(nf + i * 256 + lane * 4);
        float4 o; o.x = v[i].x * rinv * g.x; o.y = v[i].y * rinv * g.y; o.z = v[i].z * rinv * g.z; o.w = v[i].w * rinv * g.w;
        *(float4*)(OUTP(p) + (size_t)row * 1024 + i * 256 + lane * 4) = o;
      }
    } else {
      int j = modidx(row);
      const float* nwt = (which == 0 ? INP(p, 8) : INP(p, 9)) + l * 1024;
      const float* msh = MOD + (l * 5 + j) * 6144 + (which ? 3 : 0) * 1024;
      const float* msc = msh + 1024;
      const float* bsh = INP(p, 7) + l * 6144 + (which ? 3 : 0) * 1024;
      const float* bsc = bsh + 1024;
#pragma unroll
      for (int i = 0; i < 4; i++) {
        int k = i * 256 + lane * 4;
        float4 g = *(const float4*)(nwt + k);
        float4 sh = *(const float4*)(msh + k), sc = *(const float4*)(msc + k);
        float4 bh = *(const float4*)(bsh + k), bc = *(const float4*)(bsc + k);
        float o0 = v[i].x * rinv * g.x * (1.f + sc.x + bc.x) + sh.x + bh.x;
        float o1 = v[i].y * rinv * g.y * (1.f + sc.y + bc.y) + sh.y + bh.y;
        float o2 = v[i].z * rinv * g.z * (1.f + sc.z + bc.z) + sh.z + bh.z;
        float o3 = v[i].w * rinv * g.w * (1.f + sc.w + bc.w) + sh.w + bh.w;
        u32x2 pk; pk.x = pack2(o0, o1); pk.y = pack2(o2, o3);
        *(u32x2*)(H + (size_t)row * 1024 + k) = pk;
      }
    }
  }
}

DEV void phaseC(const Params& p, int l, char* smem) {
  u16* sA = (u16*)smem; u16* T = (u16*)smem;
  const u16* H = (const u16*)(WS(p) + OFF_H);
  const u16* WIN = (const u16*)(WS(p) + OFF_WT) + WIN_O;
  u16* ZA = (u16*)(WS(p) + OFF_ZA); u16* HYT = (u16*)(WS(p) + OFF_HYZ); u16* VT = (u16*)(WS(p) + OFF_VT);
  u16* KT = (u16*)(WS(p) + OFF_KT); u16* QR = (u16*)(WS(p) + OFF_QR);
  const float* ROPE = (const float*)(WS(p) + OFF_ROPE);
  const int tid = TID();
  for (int tile = BID(); tile < 48 * 32; tile += gridDim.x) {
    int tm = tile >> 5, tn = tile & 31;
    f32x4 acc[8][4]; zero_acc<8, 4>(acc);
    gemm_loop<8, 4>(H + (size_t)tm * 256 * 1024, 1024, WIN + (size_t)tn * 128 * 1024, 1024, 1024, acc, sA);
    int kind = tn >> 2, hd = tn & 3;
    const int op = kind == 2 ? 1 : (kind == 4 ? 2 : 0);
#pragma unroll
    for (int hh = 0; hh < 2; hh++) {
      int row0 = tm * 256 + hh * 128; bool lat = row0 >= 8192;
      int seq, t0, L;
      if (!lat) { seq = row0 >> 8; t0 = row0 & 255; L = 256; } else { seq = (row0 - 8192) >> 10; t0 = (row0 - 8192) & 1023; L = 1024; }
      __syncthreads();
      if (kind == 3 || kind >= 5) {
        acc_to_lds_T<8>(acc, T, hh * 4, 0);
        __syncthreads();
        u16* dst;
        if (kind == 3) dst = lat ? VT + (size_t)8192 * 512 + (size_t)((seq * 4 + hd) * 128) * 1024 + t0 : VT + (size_t)((seq * 4 + hd) * 128) * 256 + t0;
        else dst = lat ? HYT + (size_t)8192 * 1536 + ((size_t)seq * 1536 + (tn - 20) * 128) * 1024 + t0 : HYT + ((size_t)seq * 1536 + (tn - 20) * 128) * 256 + t0;
        copy_tile<128, 136>(T, dst, L);
      } else {
        acc_to_lds<8, 4, 136>(acc, T, hh * 4, op);
        __syncthreads();
        bool roped = lat && (kind == 1 || kind == 2);
        if (!(lat && kind == 2)) {
          u16* dst;
          if (kind == 0) dst = ZA + (size_t)row0 * 2048 + hd * 128;
          else if (kind == 1) dst = ZA + (size_t)row0 * 2048 + 512 + hd * 128;
          else if (kind == 2) dst = ZA + (size_t)row0 * 2048 + 1024 + hd * 128;
          else dst = ZA + (size_t)row0 * 2048 + 1536 + hd * 128;
          copy_tile<128, 136>(T, dst, 2048);
        }
        if (roped) {
          u16* dst; int ld;
          if (kind == 1) { dst = QR + (size_t)(row0 - 8192) * 512 + hd * 128; ld = 512; }
          else { dst = ZA + (size_t)row0 * 2048 + 1024 + hd * 128; ld = 2048; }
#pragma unroll 1
          for (int i = 0; i < 4; i++) {
            int id = tid + i * 256; int r = id >> 3, ch = id & 7;
            u32x4 a = *(const u32x4*)(T + r * 136 + ch * 8);
            u32x4 b = *(const u32x4*)(T + r * 136 + 64 + ch * 8);
            const float4* cs = (const float4*)(ROPE + ((size_t)(t0 + r) * 64 + ch * 8) * 2);
            u32x4 o1, o2;
#pragma unroll
            for (int q = 0; q < 4; q++) {
              float4 c4 = cs[q];
              float x1a = __uint_as_float(a[q] << 16), x1b = __uint_as_float(a[q] & 0xffff0000u);
              float x2a = __uint_as_float(b[q] << 16), x2b = __uint_as_float(b[q] & 0xffff0000u);
              o1[q] = pack2(x1a * c4.x - x2a * c4.y, x1b * c4.z - x2b * c4.w);
              o2[q] = pack2(x1a * c4.y + x2a * c4.x, x1b * c4.w + x2b * c4.z);
            }
            *(u32x4*)(dst + (size_t)r * ld + ch * 8) = o1;
            *(u32x4*)(dst + (size_t)r * ld + 64 + ch * 8) = o2;
          }
        }
        if (kind == 2 && !lat) {
          __syncthreads();
          acc_to_lds_T<8>(acc, T, hh * 4, op);
          __syncthreads();
          copy_tile<128, 136>(T, KT + (size_t)((seq * 4 + hd) * 128) * 256 + t0, 256);
        }
      }
    }
  }
}

DEV void s5_task(const Params& p, int l, int task, char* smem) {
  const int tid = TID(), lane = tid & 63, wid = tid >> 6, fr = lane & 15, fq = lane >> 4;
  int seq, gp;
  if (task < 64) { seq = 32 + (task >> 4); gp = task & 15; } else { int t2 = task - 64; seq = t2 >> 4; gp = t2 & 15; }
  const bool lat = seq >= 32;
  const int L = lat ? 1024 : 256;
  const int row0 = lat ? 8192 + (seq - 32) * 1024 : seq * 256;
  const int grp = gp * 2 + (wid >> 1), dir = wid & 1;
  const int lrg = (l * 2 + dir) * 32 + grp;
  float* BU = (float*)(smem + wid * 12544);
  u16* HB = (u16*)(smem + wid * 12544 + 8192);
  u16* ZA = (u16*)(WS(p) + OFF_ZA);
  float* YP = (float*)(WS(p) + OFF_YP);
  const u16* BBAR = (const u16*)(WS(p) + OFF_BBAR) + (size_t)lrg * 2048;
  const u16* CM = (const u16*)(WS(p) + OFF_CM) + (size_t)lrg * 2048;
  const float* LB = (const float*)(WS(p) + OFF_LAMBAR) + ((size_t)lrg * 64 + lane) * 2;
  const float lr = LB[0], li = LB[1];
  bf16x8 bfrag[8], cfrag[4];
  const bf16x8 zero8 = {0, 0, 0, 0, 0, 0, 0, 0};
#pragma unroll
  for (int nt = 0; nt < 8; nt++) bfrag[nt] = (fq < 2) ? *(const bf16x8*)(BBAR + (nt * 16 + fr) * 16 + fq * 8) : zero8;
#pragma unroll
  for (int ks = 0; ks < 4; ks++) cfrag[ks] = *(const bf16x8*)(CM + fr * 128 + ks * 32 + fq * 8);
  float hr = 0.f, hi = 0.f;
  if (lat) {
    const float* s0 = INP(p, 2) + ((((size_t)(seq - 32) * 2 + l) * 2 + dir) * 32 + grp) * 128 + lane * 2;
    hr = s0[0]; hi = s0[1];
  }
  const float dcoef = INP(p, 18)[l * 512 + grp * 16 + fr];
  const int nch = L >> 4;
  __syncthreads();
  for (int i = 0; i < nch; i++) {
    const int ci = dir ? nch - 1 - i : i; const int t0 = ci * 16;
    if (i == (nch >> 1)) { __threadfence(); __syncthreads(); }
    bf16x8 ua = (fq < 2) ? *(const bf16x8*)(ZA + (size_t)(row0 + t0 + fr) * 2048 + grp * 16 + fq * 8) : zero8;
#pragma unroll
    for (int nt = 0; nt < 8; nt++) {
      f32x4 r = __builtin_amdgcn_mfma_f32_16x16x32_bf16(ua, bfrag[nt], f32x4{0.f, 0.f, 0.f, 0.f}, 0, 0, 0);
#pragma unroll
      for (int j = 0; j < 4; j++) BU[(fq * 4 + j) * 128 + nt * 16 + fr] = r[j];
    }
    asm volatile("s_waitcnt lgkmcnt(0)" ::: "memory");
#pragma unroll
    for (int tt = 0; tt < 16; tt++) {
      const int t = dir ? 15 - tt : tt;
      float re = BU[t * 128 + lane], im = BU[t * 128 + 64 + lane];
      float nr = lr * hr - li * hi + re; float ni = lr * hi + li * hr + im;
      hr = nr; hi = ni;
      HB[t * 136 + lane] = f2bf(hr); HB[t * 136 + 64 + lane] = f2bf(hi);
    }
    asm volatile("s_waitcnt lgkmcnt(0)" ::: "memory");
    f32x4 y = {0.f, 0.f, 0.f, 0.f};
#pragma unroll
    for (int ks = 0; ks < 4; ks++) {
      bf16x8 a = *(const bf16x8*)(HB + fr * 136 + ks * 32 + fq * 8);
      y = __builtin_amdgcn_mfma_f32_16x16x32_bf16(a, cfrag[ks], y, 0, 0, 0);
    }
    asm volatile("s_waitcnt lgkmcnt(0)" ::: "memory");
    if (i < (nch >> 1)) {
#pragma unroll
      for (int j = 0; j < 4; j++) YP[(size_t)(row0 + t0 + fq * 4 + j) * 512 + grp * 16 + fr] = y[j];
    } else {
#pragma unroll
      for (int j = 0; j < 4; j++) {
        size_t row = (size_t)(row0 + t0 + fq * 4 + j);
        float other = __hip_atomic_load(&YP[row * 512 + grp * 16 + fr], __ATOMIC_RELAXED, __HIP_MEMORY_SCOPE_AGENT);
        u16* up = ZA + row * 2048 + grp * 16 + fr;
        float u = bf2f(*up);
        float v = y[j] + other + dcoef * u;
        *up = f2bf(gelu_(v));
      }
    }
  }
  if (!lat) {
    float* o = OUTP(p) + 12582912 + ((((size_t)seq * 2 + l) * 2 + dir) * 32 + grp) * 128 + lane * 2;
    o[0] = hr; o[1] = hi;
  }
}

DEV void ret_task(const Params& p, int l, int task, char* smem) {
  const int tid = TID(), lane = tid & 63, wid = tid >> 6, fr = lane & 15, fq = lane >> 4;
  int seq, h, qt; bool lat;
  if (task < 256) { lat = true; seq = task >> 6; h = (task >> 4) & 3; qt = task & 15; }
  else { int t2 = task - 256; lat = false; seq = t2 >> 4; h = (t2 >> 2) & 3; qt = t2 & 3; }
  const int L = lat ? 1024 : 256;
  const int row0 = lat ? 8192 + seq * 1024 : seq * 256;
  u16* sK = (u16*)smem; u16* sV = sK + 64 * 136; u16* sP = sV + 128 * 72 + wid * 16 * 72;
  u16* ZA = (u16*)(WS(p) + OFF_ZA);
  const u16* QR = (const u16*)(WS(p) + OFF_QR);
  const u16* VT = (const u16*)(WS(p) + OFF_VT);
  const float lgf = log1pf(-expf(INP(p, 20)[(l * 2 + 0) * 4 + h])), lgb = log1pf(-expf(INP(p, 20)[(l * 2 + 1) * 4 + h]));
  const int qrow = qt * 64 + wid * 16;
  const u16* qsrc = lat ? QR + (size_t)(row0 - 8192 + qrow + fr) * 512 + h * 128 : ZA + (size_t)(row0 + qrow + fr) * 2048 + 512 + h * 128;
  bf16x8 qa[4];
#pragma unroll
  for (int ks = 0; ks < 4; ks++) qa[ks] = *(const bf16x8*)(qsrc + ks * 32 + fq * 8);
  f32x4 o[8];
#pragma unroll
  for (int n = 0; n < 8; n++) o[n] = f32x4{0.f, 0.f, 0.f, 0.f};
  const u16* Kbase = ZA + (size_t)row0 * 2048 + 1024 + h * 128;
  const u16* Vbase = lat ? VT + (size_t)8192 * 512 + (size_t)((seq * 4 + h) * 128) * 1024 : VT + (size_t)((seq * 4 + h) * 128) * 256;
  const int nkt = L >> 6;
  for (int jt = 0; jt < nkt; jt++) {
    __syncthreads();
#pragma unroll
    for (int i = 0; i < 4; i++) {
      int id = tid + i * 256; int r = id >> 4, ch = id & 15;
      *(u32x4*)(sK + r * 136 + ch * 8) = *(const u32x4*)(Kbase + (size_t)(jt * 64 + r) * 2048 + ch * 8);
    }
#pragma unroll
    for (int i = 0; i < 4; i++) {
      int id = tid + i * 256; int e = id >> 3, ch = id & 7;
      *(u32x4*)(sV + e * 72 + ch * 8) = *(const u32x4*)(Vbase + (size_t)e * L + jt * 64 + ch * 8);
    }
    __syncthreads();
    f32x4 s[4];
#pragma unroll
    for (int nt = 0; nt < 4; nt++) {
      s[nt] = f32x4{0.f, 0.f, 0.f, 0.f};
#pragma unroll
      for (int ks = 0; ks < 4; ks++) {
        bf16x8 b = *(const bf16x8*)(sK + (nt * 16 + fr) * 136 + ks * 32 + fq * 8);
        s[nt] = __builtin_amdgcn_mfma_f32_16x16x32_bf16(qa[ks], b, s[nt], 0, 0, 0);
      }
      asm volatile("" ::: "memory");
    }
#pragma unroll
    for (int nt = 0; nt < 4; nt++)
#pragma unroll
      for (int j = 0; j < 4; j++) {
        int d = (qrow + fq * 4 + j) - (jt * 64 + nt * 16 + fr);
        float w = d >= 0 ? __expf(lgf * (float)d) : __expf(lgb * (float)(-d));
        sP[(fq * 4 + j) * 72 + nt * 16 + fr] = f2bf(s[nt][j] * w);
      }
    asm volatile("s_waitcnt lgkmcnt(0)" ::: "memory");
#pragma unroll
    for (int k2 = 0; k2 < 2; k2++) {
      bf16x8 a = *(const bf16x8*)(sP + fr * 72 + k2 * 32 + fq * 8);
#pragma unroll
      for (int n2 = 0; n2 < 8; n2++) {
        bf16x8 b = *(const bf16x8*)(sV + (n2 * 16 + fr) * 72 + k2 * 32 + fq * 8);
        o[n2] = __builtin_amdgcn_mfma_f32_16x16x32_bf16(a, b, o[n2], 0, 0, 0);
        if (n2 == 3) asm volatile("" ::: "memory");
      }
      asm volatile("" ::: "memory");
    }
    asm volatile("s_waitcnt lgkmcnt(0)" ::: "memory");
  }
  if (lat) {
    const u16* q0src = ZA + (size_t)(row0 + qrow + fr) * 2048 + 512 + h * 128;
    bf16x8 q0[4];
#pragma unroll
    for (int ks = 0; ks < 4; ks++) q0[ks] = *(const bf16x8*)(q0src + ks * 32 + fq * 8);
#pragma unroll 1
    for (int dir = 0; dir < 2; dir++) {
      const u16* S0 = (const u16*)(WS(p) + OFF_S0T) + (size_t)((((seq * 2 + l) * 2 + dir) * 4 + h)) * 16384;
      float wj[4];
#pragma unroll
      for (int j = 0; j < 4; j++) { int gi = qrow + fq * 4 + j; wj[j] = dir == 0 ? __expf(lgf * (float)(gi + 1)) : __expf(lgb * (float)(L - 1 - gi)); }
#pragma unroll
      for (int n2 = 0; n2 < 8; n2++) {
        f32x4 tmp = {0.f, 0.f, 0.f, 0.f};
#pragma unroll
        for (int ks = 0; ks < 4; ks++) {
          bf16x8 b = *(const bf16x8*)(S0 + (size_t)(n2 * 16 + fr) * 128 + ks * 32 + fq * 8);
          tmp = __builtin_amdgcn_mfma_f32_16x16x32_bf16(q0[ks], b, tmp, 0, 0, 0);
        }
#pragma unroll
        for (int j = 0; j < 4; j++) o[n2][j] += wj[j] * tmp[j];
        asm volatile("" ::: "memory");
      }
    }
  }
#pragma unroll
  for (int j = 0; j < 4; j++) {
    float s = 0.f;
#pragma unroll
    for (int n2 = 0; n2 < 8; n2++) s += o[n2][j];
    s += __shfl_xor(s, 1, 64); s += __shfl_xor(s, 2, 64); s += __shfl_xor(s, 4, 64); s += __shfl_xor(s, 8, 64);
    float mean = s * (1.f / 128.f);
    float v = 0.f;
#pragma unroll
    for (int n2 = 0; n2 < 8; n2++) { float dd = o[n2][j] - mean; v += dd * dd; }
    v += __shfl_xor(v, 1, 64); v += __shfl_xor(v, 2, 64); v += __shfl_xor(v, 4, 64); v += __shfl_xor(v, 8, 64);
    float rstd = rsqrtf(v * (1.f / 128.f) + 1e-5f);
    size_t rbase = (size_t)(row0 + qrow + fq * 4 + j) * 2048;
#pragma unroll
    for (int n2 = 0; n2 < 8; n2++) {
      int e = n2 * 16 + fr;
      float gv = bf2f(ZA[rbase + 1536 + h * 128 + e]);
      ZA[rbase + 512 + h * 128 + e] = f2bf((o[n2][j] - mean) * rstd * gv);
    }
  }
}

DEV bf16x8 scale8(u32x4 raw, const float (&w)[8]) {
  union { u32x4 u; bf16x8 v; } r;
#pragma unroll
  for (int q = 0; q < 4; q++) {
    float a = __uint_as_float(raw[q] << 16) * w[q * 2], b = __uint_as_float(raw[q] & 0xffff0000u) * w[q * 2 + 1];
    r.u[q] = pack2(a, b);
  }
  return r.v;
}

DEV void retstate_task(const Params& p, int l, int task) {
  const int tid = TID(), lane = tid & 63, wid = tid >> 6, fr = lane & 15, fq = lane >> 4;
  int seq = task >> 3, h = (task >> 1) & 3, dir = task & 1;
  const u16* KT = (const u16*)(WS(p) + OFF_KT) + (size_t)((seq * 4 + h) * 128) * 256;
  const u16* VT = (const u16*)(WS(p) + OFF_VT) + (size_t)((seq * 4 + h) * 128) * 256;
  const float lg = log1pf(-expf(INP(p, 20)[(l * 2 + dir) * 4 + h]));
  f32x4 acc[2][8];
#pragma unroll
  for (int m = 0; m < 2; m++)
#pragma unroll
    for (int n = 0; n < 8; n++) acc[m][n] = f32x4{0.f, 0.f, 0.f, 0.f};
#pragma unroll 1
  for (int ks = 0; ks < 8; ks++) {
    float w[8];
#pragma unroll
    for (int jj = 0; jj < 8; jj++) { int j = ks * 32 + fq * 8 + jj; w[jj] = __expf(lg * (float)(dir == 0 ? 255 - j : j)); }
    bf16x8 a[2];
#pragma unroll
    for (int m = 0; m < 2; m++) a[m] = scale8(*(const u32x4*)(KT + (size_t)(wid * 32 + m * 16 + fr) * 256 + ks * 32 + fq * 8), w);
#pragma unroll
    for (int n = 0; n < 8; n++) {
      bf16x8 b = *(const bf16x8*)(VT + (size_t)(n * 16 + fr) * 256 + ks * 32 + fq * 8);
#pragma unroll
      for (int m = 0; m < 2; m++) acc[m][n] = __builtin_amdgcn_mfma_f32_16x16x32_bf16(a[m], b, acc[m][n], 0, 0, 0);
    }
  }
  float* o = OUTP(p) + 13107200 + ((((size_t)seq * 2 + l) * 2 + dir) * 4 + h) * 16384;
#pragma unroll
  for (int m = 0; m < 2; m++)
#pragma unroll
    for (int n = 0; n < 8; n++)
#pragma unroll
      for (int j = 0; j < 4; j++) o[(size_t)(wid * 32 + m * 16 + fq * 4 + j) * 128 + n * 16 + fr] = acc[m][n][j];
}

template <bool LAT>
DEV void hyena_mfma(const Params& p, int l, int task, char* smem) {
  constexpr int L = LAT ? 1024 : 256;
  constexpr int NV = LAT ? 4 : 16;
  constexpr int RS = L + 8, CS = 2 * L + 16;
  constexpr int MPW = L / 64, NKS = L / 32, NCH = L / 8, Lsel = LAT ? 1 : 0;
  const int tid = TID(), lane = tid & 63, wid = tid >> 6, fr = lane & 15, fq = lane >> 4;
  const int c = LAT ? task : (task >> 1);
  const int sg = LAT ? 0 : (task & 1);
  u16* CP = (u16*)smem; u16* XV = CP + 8 * CS; u16* GS = XV + NV * RS; u16* O1 = GS + NV * RS;
  const u16* HYT = (const u16*)(WS(p) + OFF_HYZ);
  u16* HYOT = (u16*)(WS(p) + OFF_OUT1) + (size_t)MT * 512;
  const float* cw = INP(p, 22) + (size_t)l * 3 * 1536; const float* cb = INP(p, 23) + l * 1536;
  auto sconv = [&](int arr, u16* dstA) {
    const int ch = arr * 512 + c;
    const float w0 = cw[ch], w1 = cw[1536 + ch], w2 = cw[3072 + ch], bb = cb[ch];
#pragma unroll
    for (int i = 0; i < (NV * NCH) / 256; i++) {
      int id = tid + i * 256; int n = id / NCH, t8 = (id % NCH) * 8;
      const u16* src = LAT ? HYT + (size_t)8192 * 1536 + ((size_t)n * 1536 + ch) * 1024 + t8 : HYT + ((size_t)(sg * 16 + n) * 1536 + ch) * 256 + t8;
      u32x4 raw = *(const u32x4*)src;
      float h[10];
      h[0] = t8 > 0 ? bf2f(src[-1]) : 0.f;
      h[9] = t8 + 8 < L ? bf2f(src[8]) : 0.f;
#pragma unroll
      for (int q = 0; q < 4; q++) { h[1 + 2 * q] = __uint_as_float(raw[q] << 16); h[2 + 2 * q] = __uint_as_float(raw[q] & 0xffff0000u); }
      u32x4 o;
#pragma unroll
      for (int q = 0; q < 4; q++) o[q] = pack2(w0 * h[2 * q] + w1 * h[2 * q + 1] + w2 * h[2 * q + 2] + bb, w0 * h[2 * q + 1] + w1 * h[2 * q + 2] + w2 * h[2 * q + 3] + bb);
      *(u32x4*)(dstA + n * RS + t8) = o;
    }
  };
  __syncthreads();
  sconv(0, GS);
  sconv(2, XV);
  const int rr = (-fr) & 7;
  const u16* cpl = CP + rr * CS + (L + 8 * fq - fr - rr);
#pragma unroll 1
  for (int o = 0; o < 2; o++) {
    if (o == 1) sconv(1, GS);
    u16* FL = o == 0 ? O1 : XV;
    const float* Gp = (const float*)(WS(p) + OFF_G) + (Lsel ? 524288 : 0) + (size_t)o * (2 * L) * 512 + c;
    if (tid < 2 * L / 8) {
      float f[8];
#pragma unroll
      for (int j = 0; j < 8; j++) { int u = tid * 8 + j; f[j] = u > 0 ? Gp[(size_t)(2 * L - u) * 512] : 0.f; }
      u32x4 v; v[0] = pack2(f[0], f[1]); v[1] = pack2(f[2], f[3]); v[2] = pack2(f[4], f[5]); v[3] = pack2(f[6], f[7]);
      *(u32x4*)(FL + tid * 8) = v;
    }
    if (tid < 2) *(u32x4*)(FL + 2 * L + tid * 8) = u32x4{0u, 0u, 0u, 0u};
    __syncthreads();
    if (tid < 2 * L / 8) {
      u32x4 a = *(const u32x4*)(FL + tid * 8), b = *(const u32x4*)(FL + tid * 8 + 8);
      unsigned d[8] = {a[0], a[1], a[2], a[3], b[0], b[1], b[2], b[3]};
#pragma unroll
      for (int r = 0; r < 8; r++) {
        u32x4 ov;
#pragma unroll
        for (int q = 0; q < 4; q++) ov[q] = (r & 1) ? ((d[q + (r >> 1)] >> 16) | (d[q + (r >> 1) + 1] << 16)) : d[q + (r >> 1)];
        *(u32x4*)(CP + r * CS + tid * 8) = ov;
      }
    }
    __syncthreads();
    float rn;
    {
      constexpr int NTB = LAT ? 128 : 32;
      const float* SP = (const float*)(WS(p) + WS_END) + ((size_t)l * 160 + (LAT ? 32 : 0)) * 2048 + o * 512 + c;
      float ssum = 0.f;
      for (int tb = lane; tb < NTB; tb += 64) ssum += SP[(size_t)tb * 2048] + SP[(size_t)tb * 2048 + 1024];
#pragma unroll
      for (int off = 32; off > 0; off >>= 1) ssum += __shfl_xor(ssum, off, 64);
      rn = rsqrtf(ssum + 1e-6f);
    }
    const float bias = INP(p, 30)[(l * 2 + o) * 512 + c];
    const u16* Xs = o == 0 ? XV : O1;
    f32x4 acc[MPW];
#pragma unroll
    for (int mi = 0; mi < MPW; mi++) acc[mi] = f32x4{0.f, 0.f, 0.f, 0.f};
    const bf16x8 zero8 = {0, 0, 0, 0, 0, 0, 0, 0};
#pragma unroll 2
    for (int ks = 0; ks < NKS; ks++) {
      bf16x8 b = (fr < NV) ? *(const bf16x8*)(Xs + fr * RS + ks * 32 + fq * 8) : zero8;
#pragma unroll
      for (int mi = 0; mi < MPW; mi++) {
        bf16x8 a = *(const bf16x8*)(cpl - 16 * (wid * MPW + mi) + 32 * ks);
        acc[mi] = __builtin_amdgcn_mfma_f32_16x16x32_bf16(a, b, acc[mi], 0, 0, 0);
      }
    }
    if (fr < NV) {
      const u16* gate = GS;
      const u16* vin = o == 0 ? XV : O1;
#pragma unroll
      for (int mi = 0; mi < MPW; mi++) {
        const int t0 = (wid * MPW + mi) * 16 + fq * 4;
        u32x2 gq = *(const u32x2*)(gate + fr * RS + t0), vq = *(const u32x2*)(vin + fr * RS + t0);
        float g4[4] = {__uint_as_float(gq[0] << 16), __uint_as_float(gq[0] & 0xffff0000u), __uint_as_float(gq[1] << 16), __uint_as_float(gq[1] & 0xffff0000u)};
        float v4[4] = {__uint_as_float(vq[0] << 16), __uint_as_float(vq[0] & 0xffff0000u), __uint_as_float(vq[1] << 16), __uint_as_float(vq[1] & 0xffff0000u)};
        float r4[4];
#pragma unroll
        for (int j = 0; j < 4; j++) r4[j] = g4[j] * (acc[mi][j] * rn + bias * v4[j]);
        if (o == 0) {
          u32x2 ov; ov[0] = pack2(r4[0], r4[1]); ov[1] = pack2(r4[2], r4[3]);
          *(u32x2*)(O1 + fr * RS + t0) = ov;
        } else {
          u16* dst = LAT ? HYOT + (size_t)8192 * 512 + ((size_t)fr * 512 + c) * 1024 + t0 : HYOT + ((size_t)(sg * 16 + fr) * 512 + c) * 256 + t0;
          u32x2 ov; ov[0] = pack2(r4[0], r4[1]); ov[1] = pack2(r4[2], r4[3]);
          *(u32x2*)dst = ov;
        }
      }
    }
    __syncthreads();
  }
}

DEV void phaseD(const Params& p, int l, char* smem) {
  const int nb = gridDim.x, b = BID();
#pragma unroll 1
  for (int t = b; t < 512; t += nb) hyena_mfma<true>(p, l, t, smem);
#pragma unroll 1
  for (int t = (b + nb - (512 % nb)) % nb; t < 768; t += nb) ret_task(p, l, t, smem);
#pragma unroll 1
  for (int t = (b + 2 * nb - ((512 + 768) % nb)) % nb; t < 576; t += nb) s5_task(p, l, t, smem);
#pragma unroll 1
  for (int t = (b + 3 * nb - ((512 + 768 + 576) % nb)) % nb; t < 1024; t += nb) hyena_mfma<false>(p, l, t, smem);
#pragma unroll 1
  for (int t = (b + 4 * nb - ((512 + 768 + 576 + 1024) % nb)) % nb; t < 256; t += nb) retstate_task(p, l, t);
}

DEV void phaseE(const Params& p, char* smem) {
  const u16* HYOT = (const u16*)(WS(p) + OFF_OUT1) + (size_t)MT * 512;
  u16* HYO = (u16*)(WS(p) + OFF_OUT1);
  u16* sm = (u16*)smem;
  const int tx = TID() & 63, ty = TID() >> 6;
  for (int tile = BID(); tile < 192 * 8; tile += gridDim.x) {
    int rt = tile >> 3, c0 = (tile & 7) * 64; int row0 = rt * 64;
    const u16* src = row0 < 8192 ? HYOT + ((size_t)(row0 >> 8) * 512 + c0) * 256 + (row0 & 255)
                                 : HYOT + (size_t)8192 * 512 + ((size_t)((row0 - 8192) >> 10) * 512 + c0) * 1024 + ((row0 - 8192) & 1023);
    const int L = row0 < 8192 ? 256 : 1024;
    __syncthreads();
#pragma unroll
    for (int i = 0; i < 16; i++) { int cc = ty + i * 4; sm[cc * 66 + tx] = src[(size_t)cc * L + tx]; }
    __syncthreads();
#pragma unroll
    for (int i = 0; i < 16; i++) { int tt = ty + i * 4; HYO[(size_t)(row0 + tt) * 512 + c0 + tx] = sm[tx * 66 + tt]; }
  }
}

DEV void phaseF(const Params& p, int l, char* smem) {
  u16* sA = (u16*)smem; u16* T = (u16*)smem;
  const u16* H = (const u16*)(WS(p) + OFF_H);
  const u16* WT = (const u16*)(WS(p) + OFF_WT);
  const u16* ZA = (const u16*)(WS(p) + OFF_ZA); const u16* HYO = (const u16*)(WS(p) + OFF_OUT1);
  u16* MG = (u16*)(WS(p) + OFF_YP);
  for (int tile = BID(); tile < 96 * 16; tile += gridDim.x) {
    int tm = tile >> 4, tn = tile & 15; int row0 = tm * 128, n0 = tn * 64;
    f32x4 a1[4][2], a2[4][2], tt[4][2];
    const u16* Hrow = H + (size_t)row0 * 1024;
    zero_acc<4, 2>(a1); zero_acc<4, 2>(tt);
#pragma unroll 1
    for (int ps = 0; ps < 7; ps++) {
      const u16* Ap; const u16* Bp; int lda, K;
      switch (ps) {
        case 0: Ap = ZA + (size_t)row0 * 2048; lda = 2048; Bp = WT + WGLU_O + (size_t)n0 * 512; K = 512; break;
        case 1: Ap = ZA + (size_t)row0 * 2048; lda = 2048; Bp = WT + WGLU_O + (size_t)(1024 + n0) * 512; K = 512; break;
        case 3: Ap = ZA + (size_t)row0 * 2048 + 512; lda = 2048; Bp = WT + WRETO_O + (size_t)n0 * 512; K = 512; break;
        case 5: Ap = HYO + (size_t)row0 * 512; lda = 512; Bp = WT + WHYO_O + (size_t)n0 * 512; K = 512; break;
        default: Ap = Hrow; lda = 1024; Bp = WT + WIN_O + (size_t)(4096 + ((ps - 2) >> 1) * 1024 + n0) * 1024; K = 1024; break;
      }
      zero_acc<4, 2>(a2);
      gemm_loop<4, 2>(Ap, lda, Bp, K, K, a2, sA);
      if (ps == 0 || ps == 3 || ps == 5) {
#pragma unroll
        for (int m = 0; m < 4; m++)
#pragma unroll
          for (int n = 0; n < 2; n++) a1[m][n] = a2[m][n];
      } else if (ps == 1) {
#pragma unroll
        for (int m = 0; m < 4; m++)
#pragma unroll
          for (int n = 0; n < 2; n++)
#pragma unroll
            for (int j = 0; j < 4; j++) a1[m][n][j] *= sigm(a2[m][n][j]);
      } else {
#pragma unroll
        for (int m = 0; m < 4; m++)
#pragma unroll
          for (int n = 0; n < 2; n++)
#pragma unroll
            for (int j = 0; j < 4; j++) tt[m][n][j] += a1[m][n][j] * sigm(a2[m][n][j]);
      }
    }
    __syncthreads();
    acc_to_lds<4, 2, 72>(tt, T, 0);
    __syncthreads();
    copy_tile<64, 72>(T, MG + (size_t)row0 * 1024 + n0, 1024);
  }
}

template <int MF, int NF>
DEV void resid_store(const Params& p, const f32x4 (&acc)[MF][NF], int l, int chunk, int row0, int col0, bool from_input) {
  const int tid = TID(), lane = tid & 63, wid = tid >> 6, wr = wid >> 1, wc = wid & 1, fr = lane & 15, fq = lane >> 4;
  float* out = OUTP(p);
#pragma unroll
  for (int m = 0; m < MF; m++) {
    const int rb = row0 + m * 32 + wr * 16 + fq * 4;
    const int j = modidx(rb);
    const float* MOD = (const float*)(WS(p) + OFF_MOD) + (l * 5 + j) * 6144 + chunk * 1024;
    const float* BM = INP(p, 7) + l * 6144 + chunk * 1024;
#pragma unroll
    for (int n = 0; n < NF; n++) {
      int col = col0 + wc * (NF * 16) + n * 16 + fr;
      float g = MOD[col] + BM[col];
#pragma unroll
      for (int jj = 0; jj < 4; jj++) {
        int row = rb + jj;
        float xo = from_input ? xin_row(p, row)[col] : out[(size_t)row * 1024 + col];
        out[(size_t)row * 1024 + col] = xo + g * acc[m][n][jj];
      }
    }
  }
}

DEV void phaseG(const Params& p, int l, char* smem) {
  u16* sA = (u16*)smem;
  const u16* MG = (const u16*)(WS(p) + OFF_YP);
  const u16* W = (const u16*)(WS(p) + OFF_WT) + WOUT_O;
  for (int tile = BID(); tile < 64 * 8; tile += gridDim.x) {
    int tm = tile >> 3, tn = tile & 7;
    f32x4 acc[6][4]; zero_acc<6, 4>(acc);
    gemm_loop<6, 4>(MG + (size_t)tm * 192 * 1024, 1024, W + (size_t)tn * 128 * 1024, 1024, 1024, acc, sA);
    resid_store<6, 4>(p, acc, l, 2, tm * 192, tn * 128, l == 0);
  }
}

DEV void phaseI(const Params& p, int l, char* smem) {
  u16* sA = (u16*)smem; u16* T = (u16*)smem;
  const u16* H = (const u16*)(WS(p) + OFF_H);
  const u16* W = (const u16*)(WS(p) + OFF_WT) + WFIN_O;
  u16* ACT = (u16*)(WS(p) + OFF_ZA);
  for (int tile = BID(); tile < 48 * 44; tile += gridDim.x) {
    int tm = tile / 44, tn = tile % 44;
    f32x4 acc[8][4]; zero_acc<8, 4>(acc);
    gemm_loop<8, 4>(H + (size_t)tm * 256 * 1024, 1024, W + (size_t)tn * 128 * 1024, 1024, 1024, acc, sA);
    const int tid = TID(), lane = tid & 63, wid = tid >> 6, wr = wid >> 1, wc = wid & 1, fr = lane & 15, fq = lane >> 4;
#pragma unroll
    for (int hh = 0; hh < 2; hh++) {
      __syncthreads();
#pragma unroll
      for (int m = 0; m < 4; m++)
#pragma unroll
        for (int n = 0; n < 2; n++)
#pragma unroll
          for (int j = 0; j < 4; j++)
            T[(m * 32 + wr * 16 + fq * 4 + j) * 72 + wc * 32 + n * 16 + fr] = f2bf(silu_(acc[hh * 4 + m][2 * n][j]) * acc[hh * 4 + m][2 * n + 1][j]);
      __syncthreads();
      copy_tile<64, 72>(T, ACT + (size_t)(tm * 256 + hh * 128) * 2816 + tn * 64, 2816);
    }
  }
}

DEV void phaseJ(const Params& p, int l, char* smem) {
  u16* sA = (u16*)smem;
  const u16* ACT = (const u16*)(WS(p) + OFF_ZA);
  const u16* W = (const u16*)(WS(p) + OFF_WT) + WFOUT_O;
  for (int tile = BID(); tile < 64 * 8; tile += gridDim.x) {
    int tm = tile >> 3, tn = tile & 7;
    f32x4 acc[6][4]; zero_acc<6, 4>(acc);
    gemm_loop<6, 4>(ACT + (size_t)tm * 192 * 2816, 2816, W + (size_t)tn * 128 * 2816, 2816, 2816, acc, sA);
    resid_store<6, 4>(p, acc, l, 5, tm * 192, tn * 128, false);
  }
}


#define XB_TMO      128
#define XB_XCNT(j)  (256  + 64 * (j))
#define XB_XSUB(j)  (1280 + 64 * (j))
#define XB_XGEN(j)  (2304 + 64 * (j))
#define XB_TOP      3328
#define XB_TOPGEN   3392
#define XB_SPIN_CAP (1u << 22)
#define LAS __attribute__((address_space(3)))
DEV unsigned xb_ld(unsigned* p) { return __hip_atomic_load(p, __ATOMIC_RELAXED, __HIP_MEMORY_SCOPE_AGENT); }
DEV unsigned xb_add(unsigned* p, unsigned v) { return __hip_atomic_fetch_add(p, v, __ATOMIC_RELAXED, __HIP_MEMORY_SCOPE_AGENT); }
DEV unsigned xb_xcc_id() { return (unsigned)__builtin_amdgcn_s_getreg((3 << 11) | 20) & 0xFu; }
#define XB_SPIN(cond, bar) do { unsigned _sp = 0; while (cond) { __builtin_amdgcn_s_sleep(1); \
    if ((++_sp & 255u) == 0u) { if (xb_ld(&(bar)[XB_TMO])) break; if (_sp > XB_SPIN_CAP) { atomicAdd(&(bar)[XB_TMO], 1u); break; } } } } while (0)
struct XcdBarrier { unsigned* bar; unsigned x; volatile LAS unsigned* st; };
DEV XcdBarrier xcd_barrier_post(unsigned* bar, volatile LAS unsigned* st) {
  XcdBarrier b; b.bar = bar; b.x = xb_xcc_id(); b.st = st;
  if (threadIdx.x == 0) (void)xb_add(&bar[XB_XCNT(b.x)], 1u);
  return b;
}
DEV void xcd_barrier_complete(unsigned* bar, unsigned x, unsigned& nloc, unsigned& nx) {
  const unsigned G = gridDim.x * gridDim.y * gridDim.z;
  unsigned sum, cnt, mine, sp = 0u;
  for (;;) {
    sum = 0u; cnt = 0u; mine = 0u;
#pragma unroll
    for (unsigned j = 0; j < 16; ++j) { const unsigned c = xb_ld(&bar[XB_XCNT(j)]); sum += c; cnt += (c > 0u) ? 1u : 0u; mine = (j == x) ? c : mine; }
    if (sum == G) break;
    __builtin_amdgcn_s_sleep(1);
    if ((++sp & 255u) == 0u) { if (xb_ld(&bar[XB_TMO])) break; if (sp > XB_SPIN_CAP) { atomicAdd(&bar[XB_TMO], 1u); break; } }
  }
  nloc = mine > 0u ? mine : 1u; nx = cnt > 0u ? cnt : 1u;
}
DEV void xcd_barrier(const XcdBarrier& b) {
  asm volatile("s_waitcnt vmcnt(0)" ::: "memory");
  __syncthreads();
  if (threadIdx.x == 0) {
    unsigned* bar = b.bar;
    __builtin_amdgcn_s_waitcnt(0);
    unsigned nloc = b.st[0], nx = b.st[1];
    if (nloc == 0u) { xcd_barrier_complete(bar, b.x, nloc, nx); b.st[0] = nloc; b.st[1] = nx; }
    const unsigned old = xb_add(&bar[XB_XSUB(b.x)], 1u);
    const unsigned gen = old / nloc;
    if (old + 1u == (gen + 1u) * nloc) {
      __builtin_amdgcn_fence(__ATOMIC_RELEASE, "agent");
      asm volatile("s_waitcnt vmcnt(0)" ::: "memory");
      const unsigned og = xb_add(&bar[XB_TOP], 1u);
      const unsigned tg = og / nx;
      if (og + 1u == (tg + 1u) * nx) xb_add(&bar[XB_TOPGEN], 1u);
      else XB_SPIN(xb_ld(&bar[XB_TOPGEN]) == tg, bar);
      __builtin_amdgcn_fence(__ATOMIC_ACQUIRE, "agent");
      xb_add(&bar[XB_XGEN(b.x)], 1u);
      asm volatile("s_waitcnt vmcnt(0)" ::: "memory");
    } else {
      XB_SPIN(xb_ld(&bar[XB_XGEN(b.x)]) == gen, bar);
      __builtin_amdgcn_fence(__ATOMIC_ACQUIRE, "agent");
      asm volatile("s_waitcnt vmcnt(0)" ::: "memory");
    }
  }
  __syncthreads();
}

constexpr int SMEM_BYTES = 57792;

DEV void run_phase(const Params& p, int ph, int l, char* smem) {
  switch (ph) {
    case 0: phaseA(p, smem); break;
    case 1: norm_phase(p, l, 0); if (l == 1) layer_prep(p, 1, smem); break;
    case 2: phaseC(p, l, smem); break;
    case 3: phaseD(p, l, smem); break;
    case 4: phaseE(p, smem); break;
    case 5: phaseF(p, l, smem); break;
    case 6: phaseG(p, l, smem); break;
    case 7: norm_phase(p, l, 1); break;
    case 8: phaseI(p, l, smem); break;
    case 9: phaseJ(p, l, smem); break;
    case 10: norm_phase(p, 0, 2); break;
  }
}

#if MULTI
__global__ void __launch_bounds__(256, 2) kphase(Params p, int ph, int l) {
  __shared__ __attribute__((aligned(16))) char smem[SMEM_BYTES];
  run_phase(p, ph, l, smem);
}
#else
__global__ void __launch_bounds__(256, 2) mega(Params p) {
  __shared__ __attribute__((aligned(16))) char smem[SMEM_BYTES];
  __shared__ uint4 xb_words;
  cg::grid_group grid = cg::this_grid();
  if (threadIdx.x == 0) xb_words = make_uint4(0u, 0u, 0u, 0u);
  __syncthreads();
  XcdBarrier xb = xcd_barrier_post((unsigned*)(p.ws + OFF_BAR), (volatile LAS unsigned*)&xb_words);
  run_phase(p, 0, 0, smem);
  grid.sync();
  for (int l = 0; l < 2; l++) {
    for (int ph = 1; ph <= 9; ph++) {
      run_phase(p, ph, l, smem);
      xcd_barrier(xb);
    }
  }
  run_phase(p, 10, 0, smem);
}
#endif

extern "C" void kernel_launch(void* const* d_in, const int* in_sizes, int n_in, void* d_out, int out_size, void* d_ws, size_t ws_size, hipStream_t stream) {
  Params p{};
  for (int i = 0; i < 36; i++) p.in[i] = (const float*)d_in[i];
  p.out = (float*)d_out;
  p.ws = (char*)d_ws;
  hipMemsetAsync((char*)d_ws + OFF_MOD, 0, ZERO_BYTES, stream);
  static int grid_blocks = 0;
#if MULTI
  if (!grid_blocks) {
    int dev = 0, cus = 0, per_cu = 0;
    hipGetDevice(&dev);
    hipDeviceGetAttribute(&cus, hipDeviceAttributeMultiprocessorCount, dev);
    hipOccupancyMaxActiveBlocksPerMultiprocessor(&per_cu, kphase, 256, 0);
    if (per_cu > 2) per_cu = 2;
    if (per_cu < 1) per_cu = 1;
    grid_blocks = cus * per_cu;
  }
  kphase<<<grid_blocks, 256, 0, stream>>>(p, 0, 0);
  for (int l = 0; l < 2; l++)
    for (int ph = 1; ph <= 9; ph++) kphase<<<grid_blocks, 256, 0, stream>>>(p, ph, l);
  kphase<<<grid_blocks, 256, 0, stream>>>(p, 10, 0);
#else
  if (!grid_blocks) {
    int dev = 0, cus = 0, per_cu = 0;
    hipGetDevice(&dev);
    hipDeviceGetAttribute(&cus, hipDeviceAttributeMultiprocessorCount, dev);
    hipOccupancyMaxActiveBlocksPerMultiprocessor(&per_cu, mega, 256, 0);
    if (per_cu > 2) per_cu = 2;
    if (per_cu < 1) per_cu = 1;
    grid_blocks = cus * per_cu;
  }
  void* args[] = {&p};
  hipError_t e = hipLaunchCooperativeKernel((void*)mega, dim3(grid_blocks), dim3(256), args, 0, stream);
  if (e != hipSuccess) fprintf(stderr, "cooperative launch failed: %s (grid %d)\n", hipGetErrorString(e), grid_blocks);
#endif
}
```

```cpp
#include <hip/hip_runtime.h>
#include <hip/hip_cooperative_groups.h>
#include <cstdio>
namespace cg = cooperative_groups;

#ifndef MULTI
#define MULTI 0
#endif

typedef unsigned short u16;
using bf16x8 = __attribute__((ext_vector_type(8))) short;
using f32x4 = __attribute__((ext_vector_type(4))) float;
using u32x4 = __attribute__((ext_vector_type(4))) unsigned;
using u32x2 = __attribute__((ext_vector_type(2))) unsigned;
#define DEV __device__ __forceinline__

constexpr int MT = 12288;
constexpr size_t OFF_WT = 0;
constexpr int WIN_O = 0, WGLU_O = 7340032, WRETO_O = 8388608, WHYO_O = 8912896, WOUT_O = 9437184, WFIN_O = 10485760, WFOUT_O = 16252928;
constexpr size_t OFF_G = 38273024;
constexpr size_t OFF_H = 48758784;
constexpr size_t OFF_ZA = 73924608;
constexpr size_t OFF_HYZ = 124256256;
constexpr size_t OFF_VT = 162004992;
constexpr size_t OFF_KT = 174587904;
constexpr size_t OFF_QR = 182976512;
constexpr size_t OFF_YP = 187170816;
constexpr size_t OFF_OUT1 = 212336640;
constexpr size_t OFF_MOD = 237502464;
constexpr size_t OFF_SUMSQ = OFF_MOD + 245760;
constexpr size_t OFF_BAR = OFF_SUMSQ + 16384;
constexpr size_t ZERO_BYTES = 245760 + 16384 + 16384;
constexpr size_t OFF_LAMBAR = OFF_BAR + 16384;
constexpr size_t OFF_BBAR = OFF_LAMBAR + 65536;
constexpr size_t OFF_CM = OFF_BBAR + 524288;
constexpr size_t OFF_ROPE = OFF_CM + 524288;
constexpr size_t OFF_S0T = OFF_ROPE + 524288;
constexpr size_t WS_END = OFF_S0T + 2097152;

struct Params {
  const float* in[36];
  float* out;
  char* ws;
};


DEV int TID() { int t = threadIdx.x; asm volatile("" : "+v"(t)); return t; }
DEV int BID() { int t = blockIdx.x; asm volatile("" : "+s"(t)); return t; }
#define GAS __attribute__((address_space(1)))
DEV char* WS(const Params& p) { unsigned long long w = (unsigned long long)p.ws; asm volatile("" : "+s"(w)); return (char*)(GAS char*)w; }
DEV float* OUTP(const Params& p) { unsigned long long w = (unsigned long long)p.out; asm volatile("" : "+s"(w)); return (float*)(GAS float*)w; }
DEV const float* INP(const Params& p, int i) { unsigned long long w = (unsigned long long)p.in[i]; asm volatile("" : "+s"(w)); return (const float*)(GAS const float*)w; }

DEV u16 f2bf(float f) { unsigned u = __float_as_uint(f); u += 0x7fffu + ((u >> 16) & 1u); return (u16)(u >> 16); }
DEV float bf2f(u16 h) { return __uint_as_float(((unsigned)h) << 16); }
DEV float sigm(float x) { return 1.f / (1.f + __expf(-x)); }
DEV float silu_(float x) { return x / (1.f + __expf(-x)); }
DEV float gelu_(float x) { float u = 0.7978845608028654f * (x + 0.044715f * x * x * x); return 0.5f * x * (1.f + tanhf(u)); }
DEV unsigned pack2(float a, float b) { return (unsigned)f2bf(a) | ((unsigned)f2bf(b) << 16); }

DEV const float* xin_row(const Params& p, int row) { return row < 8192 ? INP(p, 0) + (size_t)row * 1024 : INP(p, 1) + (size_t)(row - 8192) * 1024; }
DEV int modidx(int row) { return row < 8192 ? 0 : 1 + ((row - 8192) >> 10); }

template <int MF, int NF>
DEV void gemm_loop(const u16* __restrict__ A, int lda, const u16* __restrict__ B, int ldb, int K, f32x4 (&acc)[MF][NF], u16* sA) {
  const int tid = TID(), lane = tid & 63, wid = tid >> 6, wr = wid >> 1, wc = wid & 1, fr = lane & 15, fq = lane >> 4;
  u16* sB = sA + MF * 32 * 72;
  u32x4 ra[MF], rb[NF];
  const int crow = tid >> 3, ccol = (tid & 7) * 8;
  const u16* Ap = A + (size_t)crow * lda + ccol;
  const u16* Bp = B + (size_t)crow * ldb + ccol;
#pragma unroll
  for (int i = 0; i < MF; i++) ra[i] = *(const u32x4*)(Ap + (size_t)(i * 32) * lda);
#pragma unroll
  for (int i = 0; i < NF; i++) rb[i] = *(const u32x4*)(Bp + (size_t)(i * 32) * ldb);
  for (int k0 = 0; k0 < K; k0 += 64) {
    __syncthreads();
#pragma unroll
    for (int i = 0; i < MF; i++) *(u32x4*)(sA + (crow + i * 32) * 72 + ccol) = ra[i];
#pragma unroll
    for (int i = 0; i < NF; i++) *(u32x4*)(sB + (crow + i * 32) * 72 + ccol) = rb[i];
    __syncthreads();
    if (k0 + 64 < K) {
#pragma unroll
      for (int i = 0; i < MF; i++) ra[i] = *(const u32x4*)(Ap + (size_t)(i * 32) * lda + k0 + 64);
#pragma unroll
      for (int i = 0; i < NF; i++) rb[i] = *(const u32x4*)(Bp + (size_t)(i * 32) * ldb + k0 + 64);
    }
#pragma unroll
    for (int ks = 0; ks < 2; ks++) {
      bf16x8 bv[NF];
#pragma unroll
      for (int n = 0; n < NF; n++) bv[n] = *(const bf16x8*)(sB + (wc * (NF * 16) + n * 16 + fr) * 72 + ks * 32 + fq * 8);
#pragma unroll
      for (int m = 0; m < MF; m++) {
        bf16x8 af = *(const bf16x8*)(sA + (m * 32 + wr * 16 + fr) * 72 + ks * 32 + fq * 8);
#pragma unroll
        for (int n = 0; n < NF; n++) acc[m][n] = __builtin_amdgcn_mfma_f32_16x16x32_bf16(af, bv[n], acc[m][n], 0, 0, 0);
      }
    }
  }
}

template <int MF, int NF>
DEV void zero_acc(f32x4 (&acc)[MF][NF]) {
#pragma unroll
  for (int m = 0; m < MF; m++)
#pragma unroll
    for (int n = 0; n < NF; n++) acc[m][n] = f32x4{0.f, 0.f, 0.f, 0.f};
}

DEV float epi_op(float v, int op) { return op == 1 ? v * 0.08838834764831845f : (op == 2 ? silu_(v) : v); }
template <int MF, int NF, int TS>
DEV void acc_to_lds(const f32x4 (&acc)[MF][NF], u16* T, int m0, int op = 0) {
  const int tid = TID(), lane = tid & 63, wid = tid >> 6, wr = wid >> 1, wc = wid & 1, fr = lane & 15, fq = lane >> 4;
#pragma unroll
  for (int m = 0; m < 4; m++)
#pragma unroll
    for (int n = 0; n < NF; n++)
#pragma unroll
      for (int j = 0; j < 4; j++) T[(m * 32 + wr * 16 + fq * 4 + j) * TS + wc * (NF * 16) + n * 16 + fr] = f2bf(epi_op(acc[m0 + m][n][j], op));
}
template <int MF>
DEV void acc_to_lds_T(const f32x4 (&acc)[MF][4], u16* T, int m0, int op = 0) {
  const int tid = TID(), lane = tid & 63, wid = tid >> 6, wr = wid >> 1, wc = wid & 1, fr = lane & 15, fq = lane >> 4;
#pragma unroll
  for (int m = 0; m < 4; m++)
#pragma unroll
    for (int n = 0; n < 4; n++) {
      u32x2 v; v.x = pack2(epi_op(acc[m0 + m][n][0], op), epi_op(acc[m0 + m][n][1], op)); v.y = pack2(epi_op(acc[m0 + m][n][2], op), epi_op(acc[m0 + m][n][3], op));
      *(u32x2*)(T + (wc * 64 + n * 16 + fr) * 136 + m * 32 + wr * 16 + fq * 4) = v;
    }
}
template <int COLS, int TS>
DEV void copy_tile(const u16* T, u16* dst, int ld) {
  constexpr int CPR = COLS / 8;
  constexpr int NIT = 128 * CPR / 256;
#pragma unroll
  for (int i = 0; i < NIT; i++) {
    int id = TID() + i * 256; int r = id / CPR, ch = id % CPR;
    *(u32x4*)(dst + (size_t)r * ld + ch * 8) = *(const u32x4*)(T + r * TS + ch * 8);
  }
}

DEV void transpose_tile(const float* __restrict__ src, int K, int N, u16* __restrict__ dst, int tile, float* sm, int perm = 0) {
  int nk = K >> 6; int tk = tile % nk, tn = tile / nk; int k0 = tk * 64, n0 = tn * 64;
  int tx = TID() & 63, ty = TID() >> 6;
  __syncthreads();
#pragma unroll
  for (int i = 0; i < 16; i++) { int k = ty + i * 4; sm[k * 65 + tx] = src[(size_t)(k0 + k) * N + n0 + tx]; }
  __syncthreads();
#pragma unroll
  for (int i = 0; i < 16; i++) {
    int n = n0 + ty + i * 4;
    if (perm) { int half = N >> 1; int j = n < half ? n : n - half; n = (j >> 4) * 32 + (n < half ? 0 : 16) + (j & 15); }
    dst[(size_t)n * K + k0 + tx] = f2bf(sm[tx * 65 + (ty + i * 4)]);
  }
}

DEV void wt_task(const Params& p, int l, int t, float* sm) {
  u16* WT = (u16*)(WS(p) + OFF_WT);
  const float* src; int K, N, off, tt, perm = 0;
  if (t < 1792) { src = INP(p, 10) + (size_t)l * 1024 * 7168; K = 1024; N = 7168; off = WIN_O; tt = t; }
  else if (t < 2048) { src = INP(p, 19) + (size_t)l * 512 * 2048; K = 512; N = 2048; off = WGLU_O; tt = t - 1792; }
  else if (t < 2176) { src = INP(p, 21) + (size_t)l * 512 * 1024; K = 512; N = 1024; off = WRETO_O; tt = t - 2048; }
  else if (t < 2304) { src = INP(p, 31) + (size_t)l * 512 * 1024; K = 512; N = 1024; off = WHYO_O; tt = t - 2176; }
  else if (t < 2560) { src = INP(p, 32) + (size_t)l * 1024 * 1024; K = 1024; N = 1024; off = WOUT_O; tt = t - 2304; }
  else if (t < 3968) { src = INP(p, 33) + (size_t)l * 1024 * 5632; K = 1024; N = 5632; off = WFIN_O; tt = t - 2560; perm = 1; }
  else { src = INP(p, 34) + (size_t)l * 2816 * 1024; K = 2816; N = 1024; off = WFOUT_O; tt = t - 3968; }
  transpose_tile(src, K, N, WT + off, tt, sm, perm);
}

DEV void mod_task(const Params& p, int task, float* sm) {
  int cb = task % 96; int l = task / 96;
  int tid = TID(), lane = tid & 63, kq = tid >> 6;
  __syncthreads();
  for (int i = tid; i < 5120; i += 256) {
    int j = i >> 10, k = i & 1023;
    float c = (j == 0) ? INP(p, 5)[k] : INP(p, 4)[(j - 1) * 1024 + k];
    sm[i] = silu_(c);
  }
  __syncthreads();
  int col = cb * 64 + lane;
  const float* w = INP(p, 6) + (size_t)l * 1024 * 6144 + col;
  float a0 = 0, a1 = 0, a2 = 0, a3 = 0, a4 = 0;
#pragma unroll 8
  for (int kk = 0; kk < 256; kk++) {
    int k = kk * 4 + kq;
    float wv = w[(size_t)k * 6144];
    a0 += sm[k] * wv; a1 += sm[1024 + k] * wv; a2 += sm[2048 + k] * wv; a3 += sm[3072 + k] * wv; a4 += sm[4096 + k] * wv;
  }
  float* red = sm + 5120;
  red[(kq * 5 + 0) * 64 + lane] = a0; red[(kq * 5 + 1) * 64 + lane] = a1; red[(kq * 5 + 2) * 64 + lane] = a2;
  red[(kq * 5 + 3) * 64 + lane] = a3; red[(kq * 5 + 4) * 64 + lane] = a4;
  __syncthreads();
  float* MOD = (float*)(WS(p) + OFF_MOD);
  for (int i = tid; i < 320; i += 256) {
    int j = i >> 6, cc = i & 63;
    float v = ((red[(0 * 5 + j) * 64 + cc] + red[(1 * 5 + j) * 64 + cc]) + red[(2 * 5 + j) * 64 + cc]) + red[(3 * 5 + j) * 64 + cc];
    MOD[(l * 5 + j) * 6144 + cb * 64 + cc] = v;
  }
}

DEV void filt_task(const Params& p, int l, int task, float* sm) {
  int Lsel = task >= 32; int tb = Lsel ? task - 32 : task; int L = Lsel ? 1024 : 256; int t0 = tb * 8;
  int tid = TID();
  float* z = sm; float* h1 = sm + 264; float* h2 = sm + 264 + 512;
  const float* w1 = INP(p, 24) + l * 33 * 64; const float* b1 = INP(p, 25) + l * 64;
  const float* w2 = INP(p, 26) + l * 64 * 64; const float* b2 = INP(p, 27) + l * 64;
  const float* fr0 = INP(p, 28) + l * 128; const float* fr1 = fr0 + 64;
  const float* w3 = INP(p, 29) + (size_t)l * 64 * 2048;
  __syncthreads();
  for (int i = tid; i < 264; i += 256) {
    int tt = i / 33, e = i % 33; float t = (float)(t0 + tt); float v;
    if (e == 0) v = t / (float)L;
    else {
      int b = (e - 1) & 15; float band = 1e-4f + (float)b * ((15.f - 1e-4f) / 15.f);
      float ang = (6.283185307179586f / (float)L) * t * band;
      v = (e <= 16) ? cosf(ang) : -sinf(ang);
    }
    z[i] = v;
  }
  __syncthreads();
  for (int i = tid; i < 512; i += 256) {
    int tt = i >> 6, j = i & 63; float s = b1[j];
    for (int e = 0; e < 33; e++) s += z[tt * 33 + e] * w1[e * 64 + j];
    h1[i] = sinf(fr0[j] * s);
  }
  __syncthreads();
  for (int i = tid; i < 512; i += 256) {
    int tt = i >> 6, j = i & 63; float s = b2[j];
    for (int e = 0; e < 64; e++) s += h1[tt * 64 + e] * w2[e * 64 + j];
    h2[i] = sinf(fr1[j] * s);
  }
  __syncthreads();
  float* FB = (float*)(WS(p) + OFF_G) + (Lsel ? 524288 : 0);
  float* SUMSQ = (float*)(WS(p) + WS_END);
  for (int m = 0; m < 8; m++) {
    int col = tid + m * 256;
    float acc[8];
#pragma unroll
    for (int tt = 0; tt < 8; tt++) acc[tt] = 0.f;
    for (int j = 0; j < 64; j++) {
      float w = w3[j * 2048 + col];
#pragma unroll
      for (int tt = 0; tt < 8; tt++) acc[tt] += h2[tt * 64 + j] * w;
    }
    int dir = col >> 10, o = (col >> 9) & 1, c = col & 511;
    float rate = 3.0701134573253944f + (float)c * ((15.350567286626972f - 3.0701134573253944f) / 511.f);
    float ss = 0.f;
    float* Fo = FB + (size_t)o * (2 * L) * 512 + c;
#pragma unroll
    for (int tt = 0; tt < 8; tt++) {
      int t = t0 + tt;
      float val = acc[tt] * expf(-((float)t / (float)L) * rate);
      if (dir == 0) { Fo[(size_t)(L + t) * 512] = val; ss += val * val; }
      else if (t > 0) { Fo[(size_t)(L - t) * 512] = val; ss += val * val; }
      else { Fo[0] = 0.f; }
    }
    SUMSQ[((size_t)l * 160 + task) * 2048 + col] = ss;
  }
}

DEV void s5prep_task(const Params& p, int task) {
  int idx = task * 256 + TID();
  int pp = idx & 63; int lrg = idx >> 6;
  float lre = INP(p, 11)[idx], lim = INP(p, 12)[idx];
  float dt = expf(INP(p, 13)[lrg]);
  float mag = expf(lre * dt);
  float lbr = mag * cosf(lim * dt), lbi = mag * sinf(lim * dt);
  float nr = lbr - 1.f, ni = lbi; float den = lre * lre + lim * lim;
  float cr = (nr * lre + ni * lim) / den, ci = (ni * lre - nr * lim) / den;
  u16* BBAR = (u16*)(WS(p) + OFF_BBAR); u16* CM = (u16*)(WS(p) + OFF_CM); float* LB = (float*)(WS(p) + OFF_LAMBAR);
  LB[idx * 2] = lbr; LB[idx * 2 + 1] = lbi;
  for (int c = 0; c < 16; c++) {
    float br = INP(p, 14)[(size_t)idx * 16 + c], bi = INP(p, 15)[(size_t)idx * 16 + c];
    BBAR[(size_t)lrg * 2048 + pp * 16 + c] = f2bf(cr * br - ci * bi);
    BBAR[(size_t)lrg * 2048 + (64 + pp) * 16 + c] = f2bf(cr * bi + ci * br);
    CM[(size_t)lrg * 2048 + c * 128 + pp] = f2bf(INP(p, 16)[(size_t)lrg * 1024 + c * 64 + pp]);
    CM[(size_t)lrg * 2048 + c * 128 + 64 + pp] = f2bf(-INP(p, 17)[(size_t)lrg * 1024 + c * 64 + pp]);
  }
}

DEV void rope_task(const Params& p, int task) {
  int idx = task * 256 + TID(); int t = idx >> 6, d = idx & 63; int f = d & 31;
  float inv = powf(10000.f, -(float)f / 32.f);
  float pos = (d < 32) ? (float)(t >> 6) : (float)(t & 63);
  float ang = pos * inv;
  float* R = (float*)(WS(p) + OFF_ROPE);
  R[idx * 2] = cosf(ang); R[idx * 2 + 1] = sinf(ang);
}

DEV void layer_prep(const Params& p, int l, char* smem) {
  for (int t = BID(); t < 4672 + 160; t += gridDim.x) {
    if (t < 4672) wt_task(p, l, t, (float*)smem);
    else filt_task(p, l, t - 4672, (float*)smem);
  }
}
DEV void phaseA(const Params& p, char* smem) {
  for (int t = BID(); t < 192 + 32 + 256 + 256; t += gridDim.x) {
    if (t < 192) mod_task(p, t, (float*)smem);
    else if (t < 224) s5prep_task(p, t - 192);
    else if (t < 480) rope_task(p, t - 224);
    else { int tt = t - 480; int mi = tt >> 2; transpose_tile(INP(p, 3) + (size_t)mi * 16384, 128, 128, (u16*)(WS(p) + OFF_S0T) + (size_t)mi * 16384, tt & 3, (float*)smem); }
  }
  layer_prep(p, 0, smem);
}

DEV void norm_phase(const Params& p, int l, int which) {
  const int lane = TID() & 63;
  const int wave = (BID() * blockDim.x + TID()) >> 6, nw = (gridDim.x * blockDim.x) >> 6;
  u16* H = (u16*)(WS(p) + OFF_H);
  const float* MOD = (const float*)(WS(p) + OFF_MOD);
  for (int row = wave; row < MT; row += nw) {
    const float* x = (l == 0 && which == 0) ? xin_row(p, row) : OUTP(p) + (size_t)row * 1024;
    float4 v[4]; float ss = 0.f;
#pragma unroll
    for (int i = 0; i < 4; i++) { v[i] = *(const float4*)(x + i * 256 + lane * 4); ss += v[i].x * v[i].x + v[i].y * v[i].y + v[i].z * v[i].z + v[i].w * v[i].w; }
#pragma unroll
    for (int o = 32; o > 0; o >>= 1) ss += __shfl_xor(ss, o, 64);
    float rinv = rsqrtf(ss * (1.f / 1024.f) + 1e-6f);
    if (which == 2) {
      const float* nf = INP(p, 35);
#pragma unroll
      for (int i = 0; i < 4; i++) {
        float4 g = *(const float4*)(nf + i * 256 + lane * 4);
        float4 o; o.x = v[i].x * rinv * g.x; o.y = v[i].y * rinv * g.y; o.z = v[i].z * rinv * g.z; o.w = v[i].w * rinv * g.w;
        *(float4*)(OUTP(p) + (size_t)row * 1024 + i * 256 + lane * 4) = o;
      }
    } else {
      int j = modidx(row);
      const float* nwt = (which == 0 ? INP(p, 8) : INP(p, 9)) + l * 1024;
      const float* msh = MOD + (l * 5 + j) * 6144 + (which ? 3 : 0) * 1024;
      const float* msc = msh + 1024;
      const float* bsh = INP(p, 7) + l * 6144 + (which ? 3 : 0) * 1024;
      const float* bsc = bsh + 1024;
#pragma unroll
      for (int i = 0; i < 4; i++) {
        int k = i * 256 + lane * 4;
        float4 g = *(const float4*)(nwt + k);
        float4 sh = *(const float4*)(msh + k), sc = *(const float4*)(msc + k);
        float4 bh = *(const float4*)(bsh + k), bc = *(const float4*)(bsc + k);
        float o0 = v[i].x * rinv * g.x * (1.f + sc.x + bc.x) + sh.x + bh.x;
        float o1 = v[i].y * rinv * g.y * (1.f + sc.y + bc.y) + sh.y + bh.y;
        float o2 = v[i].z * rinv * g.z * (1.f + sc.z + bc.z) + sh.z + bh.z;
        float o3 = v[i].w * rinv * g.w * (1.f + sc.w + bc.w) + sh.w + bh.w;
        u32x2 pk; pk.x = pack2(o0, o1); pk.y = pack2(o2, o3);
        *(u32x2*)(H + (size_t)row * 1024 + k) = pk;
      }
    }
  }
}

DEV void phaseC(const Params& p, int l, char* smem) {
  u16* sA = (u16*)smem; u16* T = (u16*)smem;
  const u16* H = (const u16*)(WS(p) + OFF_H);
  const u16* WIN = (const u16*)(WS(p) + OFF_WT) + WIN_O;
  u16* ZA = (u16*)(WS(p) + OFF_ZA); u16* HYT = (u16*)(WS(p) + OFF_HYZ); u16* VT = (u16*)(WS(p) + OFF_VT);
  u16* KT = (u16*)(WS(p) + OFF_KT); u16* QR = (u16*)(WS(p) + OFF_QR);
  const float* ROPE = (const float*)(WS(p) + OFF_ROPE);
  const int tid = TID();
  for (int tile = BID(); tile < 48 * 32; tile += gridDim.x) {
    int tm = tile >> 5, tn = tile & 31;
    f32x4 acc[8][4]; zero_acc<8, 4>(acc);
    gemm_loop<8, 4>(H + (size_t)tm * 256 * 1024, 1024, WIN + (size_t)tn * 128 * 1024, 1024, 1024, acc, sA);
    int kind = tn >> 2, hd = tn & 3;
    const int op = kind == 2 ? 1 : (kind == 4 ? 2 : 0);
#pragma unroll
    for (int hh = 0; hh < 2; hh++) {
      int row0 = tm * 256 + hh * 128; bool lat = row0 >= 8192;
      int seq, t0, L;
      if (!lat) { seq = row0 >> 8; t0 = row0 & 255; L = 256; } else { seq = (row0 - 8192) >> 10; t0 = (row0 - 8192) & 1023; L = 1024; }
      __syncthreads();
      if (kind == 3 || kind >= 5) {
        acc_to_lds_T<8>(acc, T, hh * 4, 0);
        __syncthreads();
        u16* dst;
        if (kind == 3) dst = lat ? VT + (size_t)8192 * 512 + (size_t)((seq * 4 + hd) * 128) * 1024 + t0 : VT + (size_t)((seq * 4 + hd) * 128) * 256 + t0;
        else dst = lat ? HYT + (size_t)8192 * 1536 + ((size_t)seq * 1536 + (tn - 20) * 128) * 1024 + t0 : HYT + ((size_t)seq * 1536 + (tn - 20) * 128) * 256 + t0;
        copy_tile<128, 136>(T, dst, L);
      } else {
        acc_to_lds<8, 4, 136>(acc, T, hh * 4, op);
        __syncthreads();
        bool roped = lat && (kind == 1 || kind == 2);
        if (!(lat && kind == 2)) {
          u16* dst;
          if (kind == 0) dst = ZA + (size_t)row0 * 2048 + hd * 128;
          else if (kind == 1) dst = ZA + (size_t)row0 * 2048 + 512 + hd * 128;
          else if (kind == 2) dst = ZA + (size_t)row0 * 2048 + 1024 + hd * 128;
          else dst = ZA + (size_t)row0 * 2048 + 1536 + hd * 128;
          copy_tile<128, 136>(T, dst, 2048);
        }
        if (roped) {
          u16* dst; int ld;
          if (kind == 1) { dst = QR + (size_t)(row0 - 8192) * 512 + hd * 128; ld = 512; }
          else { dst = ZA + (size_t)row0 * 2048 + 1024 + hd * 128; ld = 2048; }
#pragma unroll 1
          for (int i = 0; i < 4; i++) {
            int id = tid + i * 256; int r = id >> 3, ch = id & 7;
            u32x4 a = *(const u32x4*)(T + r * 136 + ch * 8);
            u32x4 b = *(const u32x4*)(T + r * 136 + 64 + ch * 8);
            const float4* cs = (const float4*)(ROPE + ((size_t)(t0 + r) * 64 + ch * 8) * 2);
            u32x4 o1, o2;
#pragma unroll
            for (int q = 0; q < 4; q++) {
              float4 c4 = cs[q];
              float x1a = __uint_as_float(a[q] << 16), x1b = __uint_as_float(a[q] & 0xffff0000u);
              float x2a = __uint_as_float(b[q] << 16), x2b = __uint_as_float(b[q] & 0xffff0000u);
              o1[q] = pack2(x1a * c4.x - x2a * c4.y, x1b * c4.z - x2b * c4.w);
              o2[q] = pack2(x1a * c4.y + x2a * c4.x, x1b * c4.w + x2b * c4.z);
            }
            *(u32x4*)(dst + (size_t)r * ld + ch * 8) = o1;
            *(u32x4*)(dst + (size_t)r * ld + 64 + ch * 8) = o2;
          }
        }
        if (kind == 2 && !lat) {
          __syncthreads();
          acc_to_lds_T<8>(acc, T, hh * 4, op);
          __syncthreads();
          copy_tile<128, 136>(T, KT + (size_t)((seq * 4 + hd) * 128) * 256 + t0, 256);
        }
      }
    }
  }
}

DEV void s5_task(const Params& p, int l, int task, char* smem) {
  const int tid = TID(), lane = tid & 63, wid = tid >> 6, fr = lane & 15, fq = lane >> 4;
  int seq, gp;
  if (task < 64) { seq = 32 + (task >> 4); gp = task & 15; } else { int t2 = task - 64; seq = t2 >> 4; gp = t2 & 15; }
  const bool lat = seq >= 32;
  const int L = lat ? 1024 : 256;
  const int row0 = lat ? 8192 + (seq - 32) * 1024 : seq * 256;
  const int grp = gp * 2 + (wid >> 1), dir = wid & 1;
  const int lrg = (l * 2 + dir) * 32 + grp;
  float* BU = (float*)(smem + wid * 12544);
  u16* HB = (u16*)(smem + wid * 12544 + 8192);
  u16* ZA = (u16*)(WS(p) + OFF_ZA);
  float* YP = (float*)(WS(p) + OFF_YP);
  const u16* BBAR = (const u16*)(WS(p) + OFF_BBAR) + (size_t)lrg * 2048;
  const u16* CM = (const u16*)(WS(p) + OFF_CM) + (size_t)lrg * 2048;
  const float* LB = (const float*)(WS(p) + OFF_LAMBAR) + ((size_t)lrg * 64 + lane) * 2;
  const float lr = LB[0], li = LB[1];
  bf16x8 bfrag[8], cfrag[4];
  const bf16x8 zero8 = {0, 0, 0, 0, 0, 0, 0, 0};
#pragma unroll
  for (int nt = 0; nt < 8; nt++) bfrag[nt] = (fq < 2) ? *(const bf16x8*)(BBAR + (nt * 16 + fr) * 16 + fq * 8) : zero8;
#pragma unroll
  for (int ks = 0; ks < 4; ks++) cfrag[ks] = *(const bf16x8*)(CM + fr * 128 + ks * 32 + fq * 8);
  float hr = 0.f, hi = 0.f;
  if (lat) {
    const float* s0 = INP(p, 2) + ((((size_t)(seq - 32) * 2 + l) * 2 + dir) * 32 + grp) * 128 + lane * 2;
    hr = s0[0]; hi = s0[1];
  }
  const float dcoef = INP(p, 18)[l * 512 + grp * 16 + fr];
  const int nch = L >> 4;
  __syncthreads();
  const int half = nch >> 1;
  bf16x8 ua_next = (fq < 2) ? *(const bf16x8*)(ZA + (size_t)(row0 + (dir ? nch - 1 : 0) * 16 + fr) * 2048 + grp * 16 + fq * 8) : zero8;
  const int tbase = dir ? 15 : 0, tstep = dir ? -1 : 1;
  for (int i = 0; i < nch; i++) {
    const int ci = dir ? nch - 1 - i : i; const int t0 = ci * 16;
    if (i == half) { asm volatile("s_waitcnt vmcnt(0)" ::: "memory"); __threadfence(); asm volatile("s_waitcnt vmcnt(0)" ::: "memory"); __syncthreads(); }
    const bf16x8 ua = ua_next;
    if (i + 1 < nch) {
      const int cn = dir ? nch - 2 - i : i + 1;
      ua_next = (fq < 2) ? *(const bf16x8*)(ZA + (size_t)(row0 + cn * 16 + fr) * 2048 + grp * 16 + fq * 8) : zero8;
    }
#pragma unroll
    for (int nt = 0; nt < 8; nt++) {
      f32x4 r = __builtin_amdgcn_mfma_f32_16x16x32_bf16(ua, bfrag[nt], f32x4{0.f, 0.f, 0.f, 0.f}, 0, 0, 0);
#pragma unroll
      for (int j = 0; j < 4; j++) BU[(fq * 4 + j) * 128 + nt * 16 + fr] = r[j];
    }
    asm volatile("s_waitcnt lgkmcnt(0)" ::: "memory");
#pragma unroll
    for (int tt = 0; tt < 16; tt++) {
      const int t = tbase + tstep * tt;
      float re = BU[t * 128 + lane], im = BU[t * 128 + 64 + lane];
      float nr = lr * hr - li * hi + re; float ni = lr * hi + li * hr + im;
      hr = nr; hi = ni;
      HB[t * 136 + lane] = f2bf(hr); HB[t * 136 + 64 + lane] = f2bf(hi);
    }
    asm volatile("s_waitcnt lgkmcnt(0)" ::: "memory");
    f32x4 y = {0.f, 0.f, 0.f, 0.f};
#pragma unroll
    for (int ks = 0; ks < 4; ks++) {
      bf16x8 a = *(const bf16x8*)(HB + fr * 136 + ks * 32 + fq * 8);
      y = __builtin_amdgcn_mfma_f32_16x16x32_bf16(a, cfrag[ks], y, 0, 0, 0);
    }
    asm volatile("s_waitcnt lgkmcnt(0)" ::: "memory");
    if (i < half) {
#pragma unroll
      for (int j = 0; j < 4; j++) YP[(size_t)(row0 + t0 + fq * 4 + j) * 512 + grp * 16 + fr] = y[j];
    } else {
#pragma unroll
      for (int j = 0; j < 4; j++) {
        size_t row = (size_t)(row0 + t0 + fq * 4 + j);
        float other = __hip_atomic_load(&YP[row * 512 + grp * 16 + fr], __ATOMIC_RELAXED, __HIP_MEMORY_SCOPE_AGENT);
        u16* up = ZA + row * 2048 + grp * 16 + fr;
        float v = y[j] + other + dcoef * bf2f(*up);
        *up = f2bf(gelu_(v));
      }
    }
  }
  if (!lat) {
    float* o = OUTP(p) + 12582912 + ((((size_t)seq * 2 + l) * 2 + dir) * 32 + grp) * 128 + lane * 2;
    o[0] = hr; o[1] = hi;
  }
}

DEV void ret_task(const Params& p, int l, int task, char* smem) {
  const int tid = TID(), lane = tid & 63, wid = tid >> 6, fr = lane & 15, fq = lane >> 4;
  int seq, h, qt; bool lat;
  if (task < 256) { lat = true; seq = task >> 6; h = (task >> 4) & 3; qt = task & 15; }
  else { int t2 = task - 256; lat = false; seq = t2 >> 4; h = (t2 >> 2) & 3; qt = t2 & 3; }
  const int L = lat ? 1024 : 256;
  const int row0 = lat ? 8192 + seq * 1024 : seq * 256;
  u16* sK = (u16*)smem; u16* sV = sK + 64 * 136; u16* sP = sV + 128 * 72 + wid * 16 * 72;
  u16* ZA = (u16*)(WS(p) + OFF_ZA);
  const u16* QR = (const u16*)(WS(p) + OFF_QR);
  const u16* VT = (const u16*)(WS(p) + OFF_VT);
  const float lgf = log1pf(-expf(INP(p, 20)[(l * 2 + 0) * 4 + h])), lgb = log1pf(-expf(INP(p, 20)[(l * 2 + 1) * 4 + h]));
  const int qrow = qt * 64 + wid * 16;
  const u16* qsrc = lat ? QR + (size_t)(row0 - 8192 + qrow + fr) * 512 + h * 128 : ZA + (size_t)(row0 + qrow + fr) * 2048 + 512 + h * 128;
  bf16x8 qa[4];
#pragma unroll
  for (int ks = 0; ks < 4; ks++) qa[ks] = *(const bf16x8*)(qsrc + ks * 32 + fq * 8);
  f32x4 o[8];
#pragma unroll
  for (int n = 0; n < 8; n++) o[n] = f32x4{0.f, 0.f, 0.f, 0.f};
  const u16* Kbase = ZA + (size_t)row0 * 2048 + 1024 + h * 128;
  const u16* Vbase = lat ? VT + (size_t)8192 * 512 + (size_t)((seq * 4 + h) * 128) * 1024 : VT + (size_t)((seq * 4 + h) * 128) * 256;
  const int nkt = L >> 6;
  for (int jt = 0; jt < nkt; jt++) {
    __syncthreads();
#pragma unroll
    for (int i = 0; i < 4; i++) {
      int id = tid + i * 256; int r = id >> 4, ch = id & 15;
      *(u32x4*)(sK + r * 136 + ch * 8) = *(const u32x4*)(Kbase + (size_t)(jt * 64 + r) * 2048 + ch * 8);
    }
#pragma unroll
    for (int i = 0; i < 4; i++) {
      int id = tid + i * 256; int e = id >> 3, ch = id & 7;
      *(u32x4*)(sV + e * 72 + ch * 8) = *(const u32x4*)(Vbase + (size_t)e * L + jt * 64 + ch * 8);
    }
    __syncthreads();
    f32x4 s[4];
#pragma unroll
    for (int nt = 0; nt < 4; nt++) {
      s[nt] = f32x4{0.f, 0.f, 0.f, 0.f};
#pragma unroll
      for (int ks = 0; ks < 4; ks++) {
        bf16x8 b = *(const bf16x8*)(sK + (nt * 16 + fr) * 136 + ks * 32 + fq * 8);
        s[nt] = __builtin_amdgcn_mfma_f32_16x16x32_bf16(qa[ks], b, s[nt], 0, 0, 0);
      }
      asm volatile("" ::: "memory");
    }
#pragma unroll
    for (int nt = 0; nt < 4; nt++)
#pragma unroll
      for (int j = 0; j < 4; j++) {
        int d = (qrow + fq * 4 + j) - (jt * 64 + nt * 16 + fr);
        float w = d >= 0 ? __expf(lgf * (float)d) : __expf(lgb * (float)(-d));
        sP[(fq * 4 + j) * 72 + nt * 16 + fr] = f2bf(s[nt][j] * w);
      }
    asm volatile("s_waitcnt lgkmcnt(0)" ::: "memory");
#pragma unroll
    for (int k2 = 0; k2 < 2; k2++) {
      bf16x8 a = *(const bf16x8*)(sP + fr * 72 + k2 * 32 + fq * 8);
#pragma unroll
      for (int n2 = 0; n2 < 8; n2++) {
        bf16x8 b = *(const bf16x8*)(sV + (n2 * 16 + fr) * 72 + k2 * 32 + fq * 8);
        o[n2] = __builtin_amdgcn_mfma_f32_16x16x32_bf16(a, b, o[n2], 0, 0, 0);
        if (n2 == 3) asm volatile("" ::: "memory");
      }
      asm volatile("" ::: "memory");
    }
    asm volatile("s_waitcnt lgkmcnt(0)" ::: "memory");
  }
  if (lat) {
    const u16* q0src = ZA + (size_t)(row0 + qrow + fr) * 2048 + 512 + h * 128;
    bf16x8 q0[4];
#pragma unroll
    for (int ks = 0; ks < 4; ks++) q0[ks] = *(const bf16x8*)(q0src + ks * 32 + fq * 8);
#pragma unroll 1
    for (int dir = 0; dir < 2; dir++) {
      const u16* S0 = (const u16*)(WS(p) + OFF_S0T) + (size_t)((((seq * 2 + l) * 2 + dir) * 4 + h)) * 16384;
      float wj[4];
#pragma unroll
      for (int j = 0; j < 4; j++) { int gi = qrow + fq * 4 + j; wj[j] = dir == 0 ? __expf(lgf * (float)(gi + 1)) : __expf(lgb * (float)(L - 1 - gi)); }
#pragma unroll
      for (int n2 = 0; n2 < 8; n2++) {
        f32x4 tmp = {0.f, 0.f, 0.f, 0.f};
#pragma unroll
        for (int ks = 0; ks < 4; ks++) {
          bf16x8 b = *(const bf16x8*)(S0 + (size_t)(n2 * 16 + fr) * 128 + ks * 32 + fq * 8);
          tmp = __builtin_amdgcn_mfma_f32_16x16x32_bf16(q0[ks], b, tmp, 0, 0, 0);
        }
#pragma unroll
        for (int j = 0; j < 4; j++) o[n2][j] += wj[j] * tmp[j];
        asm volatile("" ::: "memory");
      }
    }
  }
#pragma unroll
  for (int j = 0; j < 4; j++) {
    float s = 0.f;
#pragma unroll
    for (int n2 = 0; n2 < 8; n2++) s += o[n2][j];
    s += __shfl_xor(s, 1, 64); s += __shfl_xor(s, 2, 64); s += __shfl_xor(s, 4, 64); s += __shfl_xor(s, 8, 64);
    float mean = s * (1.f / 128.f);
    float v = 0.f;
#pragma unroll
    for (int n2 = 0; n2 < 8; n2++) { float dd = o[n2][j] - mean; v += dd * dd; }
    v += __shfl_xor(v, 1, 64); v += __shfl_xor(v, 2, 64); v += __shfl_xor(v, 4, 64); v += __shfl_xor(v, 8, 64);
    float rstd = rsqrtf(v * (1.f / 128.f) + 1e-5f);
    size_t rbase = (size_t)(row0 + qrow + fq * 4 + j) * 2048;
#pragma unroll
    for (int n2 = 0; n2 < 8; n2++) {
      int e = n2 * 16 + fr;
      float gv = bf2f(ZA[rbase + 1536 + h * 128 + e]);
      ZA[rbase + 512 + h * 128 + e] = f2bf((o[n2][j] - mean) * rstd * gv);
    }
  }
}

DEV bf16x8 scale8(u32x4 raw, const float (&w)[8]) {
  union { u32x4 u; bf16x8 v; } r;
#pragma unroll
  for (int q = 0; q < 4; q++) {
    float a = __uint_as_float(raw[q] << 16) * w[q * 2], b = __uint_as_float(raw[q] & 0xffff0000u) * w[q * 2 + 1];
    r.u[q] = pack2(a, b);
  }
  return r.v;
}

DEV void retstate_task(const Params& p, int l, int task) {
  const int tid = TID(), lane = tid & 63, wid = tid >> 6, fr = lane & 15, fq = lane >> 4;
  int seq = task >> 3, h = (task >> 1) & 3, dir = task & 1;
  const u16* KT = (const u16*)(WS(p) + OFF_KT) + (size_t)((seq * 4 + h) * 128) * 256;
  const u16* VT = (const u16*)(WS(p) + OFF_VT) + (size_t)((seq * 4 + h) * 128) * 256;
  const float lg = log1pf(-expf(INP(p, 20)[(l * 2 + dir) * 4 + h]));
  f32x4 acc[2][8];
#pragma unroll
  for (int m = 0; m < 2; m++)
#pragma unroll
    for (int n = 0; n < 8; n++) acc[m][n] = f32x4{0.f, 0.f, 0.f, 0.f};
#pragma unroll 1
  for (int ks = 0; ks < 8; ks++) {
    float w[8];
#pragma unroll
    for (int jj = 0; jj < 8; jj++) { int j = ks * 32 + fq * 8 + jj; w[jj] = __expf(lg * (float)(dir == 0 ? 255 - j : j)); }
    bf16x8 a[2];
#pragma unroll
    for (int m = 0; m < 2; m++) a[m] = scale8(*(const u32x4*)(KT + (size_t)(wid * 32 + m * 16 + fr) * 256 + ks * 32 + fq * 8), w);
#pragma unroll
    for (int n = 0; n < 8; n++) {
      bf16x8 b = *(const bf16x8*)(VT + (size_t)(n * 16 + fr) * 256 + ks * 32 + fq * 8);
#pragma unroll
      for (int m = 0; m < 2; m++) acc[m][n] = __builtin_amdgcn_mfma_f32_16x16x32_bf16(a[m], b, acc[m][n], 0, 0, 0);
    }
  }
  float* o = OUTP(p) + 13107200 + ((((size_t)seq * 2 + l) * 2 + dir) * 4 + h) * 16384;
#pragma unroll
  for (int m = 0; m < 2; m++)
#pragma unroll
    for (int n = 0; n < 8; n++)
#pragma unroll
      for (int j = 0; j < 4; j++) o[(size_t)(wid * 32 + m * 16 + fq * 4 + j) * 128 + n * 16 + fr] = acc[m][n][j];
}

template <bool LAT>
DEV void hyena_mfma(const Params& p, int l, int task, char* smem) {
  constexpr int L = LAT ? 1024 : 256;
  constexpr int NV = LAT ? 4 : 16;
  constexpr int RS = L + 8, CS = 2 * L + 16;
  constexpr int MPW = L / 64, NKS = L / 32, NCH = L / 8, Lsel = LAT ? 1 : 0;
  const int tid = TID(), lane = tid & 63, wid = tid >> 6, fr = lane & 15, fq = lane >> 4;
  const int c = LAT ? task : (task >> 1);
  const int sg = LAT ? 0 : (task & 1);
  u16* CP = (u16*)smem; u16* XV = CP + 8 * CS; u16* GS = XV + NV * RS; u16* O1 = GS + NV * RS;
  const u16* HYT = (const u16*)(WS(p) + OFF_HYZ);
  u16* HYOT = (u16*)(WS(p) + OFF_OUT1) + (size_t)MT * 512;
  const float* cw = INP(p, 22) + (size_t)l * 3 * 1536; const float* cb = INP(p, 23) + l * 1536;
  auto sconv = [&](int arr, u16* dstA) {
    const int ch = arr * 512 + c;
    const float w0 = cw[ch], w1 = cw[1536 + ch], w2 = cw[3072 + ch], bb = cb[ch];
#pragma unroll
    for (int i = 0; i < (NV * NCH) / 256; i++) {
      int id = tid + i * 256; int n = id / NCH, t8 = (id % NCH) * 8;
      const u16* src = LAT ? HYT + (size_t)8192 * 1536 + ((size_t)n * 1536 + ch) * 1024 + t8 : HYT + ((size_t)(sg * 16 + n) * 1536 + ch) * 256 + t8;
      u32x4 raw = *(const u32x4*)src;
      float h[10];
      h[0] = t8 > 0 ? bf2f(src[-1]) : 0.f;
      h[9] = t8 + 8 < L ? bf2f(src[8]) : 0.f;
#pragma unroll
      for (int q = 0; q < 4; q++) { h[1 + 2 * q] = __uint_as_float(raw[q] << 16); h[2 + 2 * q] = __uint_as_float(raw[q] & 0xffff0000u); }
      u32x4 o;
#pragma unroll
      for (int q = 0; q < 4; q++) o[q] = pack2(w0 * h[2 * q] + w1 * h[2 * q + 1] + w2 * h[2 * q + 2] + bb, w0 * h[2 * q + 1] + w1 * h[2 * q + 2] + w2 * h[2 * q + 3] + bb);
      *(u32x4*)(dstA + n * RS + t8) = o;
    }
  };
  __syncthreads();
  sconv(0, GS);
  sconv(2, XV);
  const int rr = (-fr) & 7;
  const u16* cpl = CP + rr * CS + (L + 8 * fq - fr - rr);
#pragma unroll 1
  for (int o = 0; o < 2; o++) {
    if (o == 1) sconv(1, GS);
    u16* FL = o == 0 ? O1 : XV;
    const float* Gp = (const float*)(WS(p) + OFF_G) + (Lsel ? 524288 : 0) + (size_t)o * (2 * L) * 512 + c;
    if (tid < 2 * L / 8) {
      float f[8];
#pragma unroll
      for (int j = 0; j < 8; j++) { int u = tid * 8 + j; f[j] = u > 0 ? Gp[(size_t)(2 * L - u) * 512] : 0.f; }
      u32x4 v; v[0] = pack2(f[0], f[1]); v[1] = pack2(f[2], f[3]); v[2] = pack2(f[4], f[5]); v[3] = pack2(f[6], f[7]);
      *(u32x4*)(FL + tid * 8) = v;
    }
    if (tid < 2) *(u32x4*)(FL + 2 * L + tid * 8) = u32x4{0u, 0u, 0u, 0u};
    __syncthreads();
    if (tid < 2 * L / 8) {
      u32x4 a = *(const u32x4*)(FL + tid * 8), b = *(const u32x4*)(FL + tid * 8 + 8);
      unsigned d[8] = {a[0], a[1], a[2], a[3], b[0], b[1], b[2], b[3]};
#pragma unroll
      for (int r = 0; r < 8; r++) {
        u32x4 ov;
#pragma unroll
        for (int q = 0; q < 4; q++) ov[q] = (r & 1) ? ((d[q + (r >> 1)] >> 16) | (d[q + (r >> 1) + 1] << 16)) : d[q + (r >> 1)];
        *(u32x4*)(CP + r * CS + tid * 8) = ov;
      }
    }
    __syncthreads();
    float rn;
    {
      constexpr int NTB = LAT ? 128 : 32;
      const float* SP = (const float*)(WS(p) + WS_END) + ((size_t)l * 160 + (LAT ? 32 : 0)) * 2048 + o * 512 + c;
      float ssum = 0.f;
      for (int tb = lane; tb < NTB; tb += 64) ssum += SP[(size_t)tb * 2048] + SP[(size_t)tb * 2048 + 1024];
#pragma unroll
      for (int off = 32; off > 0; off >>= 1) ssum += __shfl_xor(ssum, off, 64);
      rn = rsqrtf(ssum + 1e-6f);
    }
    const float bias = INP(p, 30)[(l * 2 + o) * 512 + c];
    const u16* Xs = o == 0 ? XV : O1;
    f32x4 acc[MPW];
#pragma unroll
    for (int mi = 0; mi < MPW; mi++) acc[mi] = f32x4{0.f, 0.f, 0.f, 0.f};
    const bf16x8 zero8 = {0, 0, 0, 0, 0, 0, 0, 0};
#pragma unroll 2
    for (int ks = 0; ks < NKS; ks++) {
      bf16x8 b = (fr < NV) ? *(const bf16x8*)(Xs + fr * RS + ks * 32 + fq * 8) : zero8;
#pragma unroll
      for (int mi = 0; mi < MPW; mi++) {
        bf16x8 a = *(const bf16x8*)(cpl - 16 * (wid * MPW + mi) + 32 * ks);
        acc[mi] = __builtin_amdgcn_mfma_f32_16x16x32_bf16(a, b, acc[mi], 0, 0, 0);
      }
    }
    if (fr < NV) {
      const u16* gate = GS;
      const u16* vin = o == 0 ? XV : O1;
#pragma unroll
      for (int mi = 0; mi < MPW; mi++) {
        const int t0 = (wid * MPW + mi) * 16 + fq * 4;
        u32x2 gq = *(const u32x2*)(gate + fr * RS + t0), vq = *(const u32x2*)(vin + fr * RS + t0);
        float g4[4] = {__uint_as_float(gq[0] << 16), __uint_as_float(gq[0] & 0xffff0000u), __uint_as_float(gq[1] << 16), __uint_as_float(gq[1] & 0xffff0000u)};
        float v4[4] = {__uint_as_float(vq[0] << 16), __uint_as_float(vq[0] & 0xffff0000u), __uint_as_float(vq[1] << 16), __uint_as_float(vq[1] & 0xffff0000u)};
        float r4[4];
#pragma unroll
        for (int j = 0; j < 4; j++) r4[j] = g4[j] * (acc[mi][j] * rn + bias * v4[j]);
        if (o == 0) {
          u32x2 ov; ov[0] = pack2(r4[0], r4[1]); ov[1] = pack2(r4[2], r4[3]);
          *(u32x2*)(O1 + fr * RS + t0) = ov;
        } else {
          u16* dst = LAT ? HYOT + (size_t)8192 * 512 + ((size_t)fr * 512 + c) * 1024 + t0 : HYOT + ((size_t)(sg * 16 + fr) * 512 + c) * 256 + t0;
          u32x2 ov; ov[0] = pack2(r4[0], r4[1]); ov[1] = pack2(r4[2], r4[3]);
          *(u32x2*)dst = ov;
        }
      }
    }
    __syncthreads();
  }
}

DEV void phaseD(const Params& p, int l, char* smem) {
  const int nb = gridDim.x, b = BID();
#pragma unroll 1
  for (int t = b; t < 512; t += nb) hyena_mfma<true>(p, l, t, smem);
#pragma unroll 1
  for (int t = (b + nb - (512 % nb)) % nb; t < 768; t += nb) ret_task(p, l, t, smem);
#pragma unroll 1
  for (int t = (b + 2 * nb - ((512 + 768) % nb)) % nb; t < 576; t += nb) s5_task(p, l, t, smem);
#pragma unroll 1
  for (int t = (b + 3 * nb - ((512 + 768 + 576) % nb)) % nb; t < 1024; t += nb) hyena_mfma<false>(p, l, t, smem);
#pragma unroll 1
  for (int t = (b + 4 * nb - ((512 + 768 + 576 + 1024) % nb)) % nb; t < 256; t += nb) retstate_task(p, l, t);
}

DEV void phaseE(const Params& p, char* smem) {
  const u16* HYOT = (const u16*)(WS(p) + OFF_OUT1) + (size_t)MT * 512;
  u16* HYO = (u16*)(WS(p) + OFF_OUT1);
  u16* sm = (u16*)smem;
  const int tx = TID() & 63, ty = TID() >> 6;
  for (int tile = BID(); tile < 192 * 8; tile += gridDim.x) {
    int rt = tile >> 3, c0 = (tile & 7) * 64; int row0 = rt * 64;
    const u16* src = row0 < 8192 ? HYOT + ((size_t)(row0 >> 8) * 512 + c0) * 256 + (row0 & 255)
                                 : HYOT + (size_t)8192 * 512 + ((size_t)((row0 - 8192) >> 10) * 512 + c0) * 1024 + ((row0 - 8192) & 1023);
    const int L = row0 < 8192 ? 256 : 1024;
    __syncthreads();
#pragma unroll
    for (int i = 0; i < 16; i++) { int cc = ty + i * 4; sm[cc * 66 + tx] = src[(size_t)cc * L + tx]; }
    __syncthreads();
#pragma unroll
    for (int i = 0; i < 16; i++) { int tt = ty + i * 4; HYO[(size_t)(row0 + tt) * 512 + c0 + tx] = sm[tx * 66 + tt]; }
  }
}

DEV void phaseF(const Params& p, int l, char* smem) {
  u16* sA = (u16*)smem; u16* T = (u16*)smem;
  const u16* H = (const u16*)(WS(p) + OFF_H);
  const u16* WT = (const u16*)(WS(p) + OFF_WT);
  const u16* ZA = (const u16*)(WS(p) + OFF_ZA); const u16* HYO = (const u16*)(WS(p) + OFF_OUT1);
  u16* MG = (u16*)(WS(p) + OFF_YP);
  for (int tile = BID(); tile < 96 * 16; tile += gridDim.x) {
    int tm = tile >> 4, tn = tile & 15; int row0 = tm * 128, n0 = tn * 64;
    f32x4 a1[4][2], a2[4][2], tt[4][2];
    const u16* Hrow = H + (size_t)row0 * 1024;
    zero_acc<4, 2>(a1); zero_acc<4, 2>(tt);
#pragma unroll 1
    for (int ps = 0; ps < 7; ps++) {
      const u16* Ap; const u16* Bp; int lda, K;
      switch (ps) {
        case 0: Ap = ZA + (size_t)row0 * 2048; lda = 2048; Bp = WT + WGLU_O + (size_t)n0 * 512; K = 512; break;
        case 1: Ap = ZA + (size_t)row0 * 2048; lda = 2048; Bp = WT + WGLU_O + (size_t)(1024 + n0) * 512; K = 512; break;
        case 3: Ap = ZA + (size_t)row0 * 2048 + 512; lda = 2048; Bp = WT + WRETO_O + (size_t)n0 * 512; K = 512; break;
        case 5: Ap = HYO + (size_t)row0 * 512; lda = 512; Bp = WT + WHYO_O + (size_t)n0 * 512; K = 512; break;
        default: Ap = Hrow; lda = 1024; Bp = WT + WIN_O + (size_t)(4096 + ((ps - 2) >> 1) * 1024 + n0) * 1024; K = 1024; break;
      }
      zero_acc<4, 2>(a2);
      gemm_loop<4, 2>(Ap, lda, Bp, K, K, a2, sA);
      if (ps == 0 || ps == 3 || ps == 5) {
#pragma unroll
        for (int m = 0; m < 4; m++)
#pragma unroll
          for (int n = 0; n < 2; n++) a1[m][n] = a2[m][n];
      } else if (ps == 1) {
#pragma unroll
        for (int m = 0; m < 4; m++)
#pragma unroll
          for (int n = 0; n < 2; n++)
#pragma unroll
            for (int j = 0; j < 4; j++) a1[m][n][j] *= sigm(a2[m][n][j]);
      } else {
#pragma unroll
        for (int m = 0; m < 4; m++)
#pragma unroll
          for (int n = 0; n < 2; n++)
#pragma unroll
            for (int j = 0; j < 4; j++) tt[m][n][j] += a1[m][n][j] * sigm(a2[m][n][j]);
      }
    }
    __syncthreads();
    acc_to_lds<4, 2, 72>(tt, T, 0);
    __syncthreads();
    copy_tile<64, 72>(T, MG + (size_t)row0 * 1024 + n0, 1024);
  }
}

template <int MF, int NF>
DEV void resid_store(const Params& p, const f32x4 (&acc)[MF][NF], int l, int chunk, int row0, int col0, bool from_input) {
  const int tid = TID(), lane = tid & 63, wid = tid >> 6, wr = wid >> 1, wc = wid & 1, fr = lane & 15, fq = lane >> 4;
  float* out = OUTP(p);
#pragma unroll
  for (int m = 0; m < MF; m++) {
    const int rb = row0 + m * 32 + wr * 16 + fq * 4;
    const int j = modidx(rb);
    const float* MOD = (const float*)(WS(p) + OFF_MOD) + (l * 5 + j) * 6144 + chunk * 1024;
    const float* BM = INP(p, 7) + l * 6144 + chunk * 1024;
#pragma unroll
    for (int n = 0; n < NF; n++) {
      int col = col0 + wc * (NF * 16) + n * 16 + fr;
      float g = MOD[col] + BM[col];
#pragma unroll
      for (int jj = 0; jj < 4; jj++) {
        int row = rb + jj;
        float xo = from_input ? xin_row(p, row)[col] : out[(size_t)row * 1024 + col];
        out[(size_t)row * 1024 + col] = xo + g * acc[m][n][jj];
      }
    }
  }
}

DEV void phaseG(const Params& p, int l, char* smem) {
  u16* sA = (u16*)smem;
  const u16* MG = (const u16*)(WS(p) + OFF_YP);
  const u16* W = (const u16*)(WS(p) + OFF_WT) + WOUT_O;
  for (int tile = BID(); tile < 64 * 8; tile += gridDim.x) {
    int tm = tile >> 3, tn = tile & 7;
    f32x4 acc[6][4]; zero_acc<6, 4>(acc);
    gemm_loop<6, 4>(MG + (size_t)tm * 192 * 1024, 1024, W + (size_t)tn * 128 * 1024, 1024, 1024, acc, sA);
    resid_store<6, 4>(p, acc, l, 2, tm * 192, tn * 128, l == 0);
  }
}

DEV void phaseI(const Params& p, int l, char* smem) {
  u16* sA = (u16*)smem; u16* T = (u16*)smem;
  const u16* H = (const u16*)(WS(p) + OFF_H);
  const u16* W = (const u16*)(WS(p) + OFF_WT) + WFIN_O;
  u16* ACT = (u16*)(WS(p) + OFF_ZA);
  for (int tile = BID(); tile < 48 * 44; tile += gridDim.x) {
    int tm = tile / 44, tn = tile % 44;
    f32x4 acc[8][4]; zero_acc<8, 4>(acc);
    gemm_loop<8, 4>(H + (size_t)tm * 256 * 1024, 1024, W + (size_t)tn * 128 * 1024, 1024, 1024, acc, sA);
    const int tid = TID(), lane = tid & 63, wid = tid >> 6, wr = wid >> 1, wc = wid & 1, fr = lane & 15, fq = lane >> 4;
#pragma unroll
    for (int hh = 0; hh < 2; hh++) {
      __syncthreads();
#pragma unroll
      for (int m = 0; m < 4; m++)
#pragma unroll
        for (int n = 0; n < 2; n++)
#pragma unroll
          for (int j = 0; j < 4; j++)
            T[(m * 32 + wr * 16 + fq * 4 + j) * 72 + wc * 32 + n * 16 + fr] = f2bf(silu_(acc[hh * 4 + m][2 * n][j]) * acc[hh * 4 + m][2 * n + 1][j]);
      __syncthreads();
      copy_tile<64, 72>(T, ACT + (size_t)(tm * 256 + hh * 128) * 2816 + tn * 64, 2816);
    }
  }
}

DEV void phaseJ(const Params& p, int l, char* smem) {
  u16* sA = (u16*)smem;
  const u16* ACT = (const u16*)(WS(p) + OFF_ZA);
  const u16* W = (const u16*)(WS(p) + OFF_WT) + WFOUT_O;
  for (int tile = BID(); tile < 64 * 8; tile += gridDim.x) {
    int tm = tile >> 3, tn = tile & 7;
    f32x4 acc[6][4]; zero_acc<6, 4>(acc);
    gemm_loop<6, 4>(ACT + (size_t)tm * 192 * 2816, 2816, W + (size_t)tn * 128 * 2816, 2816, 2816, acc, sA);
    resid_store<6, 4>(p, acc, l, 5, tm * 192, tn * 128, false);
  }
}


#define XB_TMO      128
#define XB_XCNT(j)  (256  + 64 * (j))
#define XB_XSUB(j)  (1280 + 64 * (j))
#define XB_XGEN(j)  (2304 + 64 * (j))
#define XB_TOP      3328
#define XB_TOPGEN   3392
#define XB_SPIN_CAP (1u << 22)
#define LAS __attribute__((address_space(3)))
DEV unsigned xb_ld(unsigned* p) { return __hip_atomic_load(p, __ATOMIC_RELAXED, __HIP_MEMORY_SCOPE_AGENT); }
DEV unsigned xb_add(unsigned* p, unsigned v) { return __hip_atomic_fetch_add(p, v, __ATOMIC_RELAXED, __HIP_MEMORY_SCOPE_AGENT); }
DEV unsigned xb_xcc_id() { return (unsigned)__builtin_amdgcn_s_getreg((3 << 11) | 20) & 0xFu; }
#define XB_SPIN(cond, bar) do { unsigned _sp = 0; while (cond) { __builtin_amdgcn_s_sleep(1); \
    if ((++_sp & 255u) == 0u) { if (xb_ld(&(bar)[XB_TMO])) break; if (_sp > XB_SPIN_CAP) { atomicAdd(&(bar)[XB_TMO], 1u); break; } } } } while (0)
struct XcdBarrier { unsigned* bar; unsigned x; volatile LAS unsigned* st; };
DEV XcdBarrier xcd_barrier_post(unsigned* bar, volatile LAS unsigned* st) {
  XcdBarrier b; b.bar = bar; b.x = xb_xcc_id(); b.st = st;
  if (threadIdx.x == 0) (void)xb_add(&bar[XB_XCNT(b.x)], 1u);
  return b;
}
DEV void xcd_barrier_complete(unsigned* bar, unsigned x, unsigned& nloc, unsigned& nx) {
  const unsigned G = gridDim.x * gridDim.y * gridDim.z;
  unsigned sum, cnt, mine, sp = 0u;
  for (;;) {
    sum = 0u; cnt = 0u; mine = 0u;
#pragma unroll
    for (unsigned j = 0; j < 16; ++j) { const unsigned c = xb_ld(&bar[XB_XCNT(j)]); sum += c; cnt += (c > 0u) ? 1u : 0u; mine = (j == x) ? c : mine; }
    if (sum == G) break;
    __builtin_amdgcn_s_sleep(1);
    if ((++sp & 255u) == 0u) { if (xb_ld(&bar[XB_TMO])) break; if (sp > XB_SPIN_CAP) { atomicAdd(&bar[XB_TMO], 1u); break; } }
  }
  nloc = mine > 0u ? mine : 1u; nx = cnt > 0u ? cnt : 1u;
}
DEV void xcd_barrier(const XcdBarrier& b) {
  asm volatile("s_waitcnt vmcnt(0)" ::: "memory");
  __syncthreads();
  if (threadIdx.x == 0) {
    unsigned* bar = b.bar;
    __builtin_amdgcn_s_waitcnt(0);
    unsigned nloc = b.st[0], nx = b.st[1];
    if (nloc == 0u) { xcd_barrier_complete(bar, b.x, nloc, nx); b.st[0] = nloc; b.st[1] = nx; }
    const unsigned old = xb_add(&bar[XB_XSUB(b.x)], 1u);
    const unsigned gen = old / nloc;
    if (old + 1u == (gen + 1u) * nloc) {
      __builtin_amdgcn_fence(__ATOMIC_RELEASE, "agent");
      asm volatile("s_waitcnt vmcnt(0)" ::: "memory");
      const unsigned og = xb_add(&bar[XB_TOP], 1u);
      const unsigned tg = og / nx;
      if (og + 1u == (tg + 1u) * nx) xb_add(&bar[XB_TOPGEN], 1u);
      else XB_SPIN(xb_ld(&bar[XB_TOPGEN]) == tg, bar);
      __builtin_amdgcn_fence(__ATOMIC_ACQUIRE, "agent");
      xb_add(&bar[XB_XGEN(b.x)], 1u);
      asm volatile("s_waitcnt vmcnt(0)" ::: "memory");
    } else {
      XB_SPIN(xb_ld(&bar[XB_XGEN(b.x)]) == gen, bar);
      __builtin_amdgcn_fence(__ATOMIC_ACQUIRE, "agent");
      asm volatile("s_waitcnt vmcnt(0)" ::: "memory");
    }
  }
  __syncthreads();
}

constexpr int SMEM_BYTES = 57792;

DEV void run_phase(const Params& p, int ph, int l, char* smem) {
  switch (ph) {
    case 0: phaseA(p, smem); break;
    case 1: norm_phase(p, l, 0); if (l == 1) layer_prep(p, 1, smem); break;
    case 2: phaseC(p, l, smem); break;
    case 3: phaseD(p, l, smem); break;
    case 4: phaseE(p, smem); break;
    case 5: phaseF(p, l, smem); break;
    case 6: phaseG(p, l, smem); break;
    case 7: norm_phase(p, l, 1); break;
    case 8: phaseI(p, l, smem); break;
    case 9: phaseJ(p, l, smem); break;
    case 10: norm_phase(p, 0, 2); break;
  }
}

#if MULTI
__global__ void __launch_bounds__(256, 2) kphase(Params p, int ph, int l) {
  __shared__ __attribute__((aligned(16))) char smem[SMEM_BYTES];
  run_phase(p, ph, l, smem);
}
#else
__global__ void __launch_bounds__(256, 2) mega(Params p) {
  __shared__ __attribute__((aligned(16))) char smem[SMEM_BYTES];
  __shared__ uint4 xb_words;
  cg::grid_group grid = cg::this_grid();
  if (threadIdx.x == 0) xb_words = make_uint4(0u, 0u, 0u, 0u);
  __syncthreads();
  XcdBarrier xb = xcd_barrier_post((unsigned*)(p.ws + OFF_BAR), (volatile LAS unsigned*)&xb_words);
  run_phase(p, 0, 0, smem);
  grid.sync();
  for (int l = 0; l < 2; l++) {
    for (int ph = 1; ph <= 9; ph++) {
      run_phase(p, ph, l, smem);
      xcd_barrier(xb);
    }
  }
  run_phase(p, 10, 0, smem);
}
#endif

extern "C" void kernel_launch(void* const* d_in, const int* in_sizes, int n_in, void* d_out, int out_size, void* d_ws, size_t ws_size, hipStream_t stream) {
  Params p{};
  for (int i = 0; i < 36; i++) p.in[i] = (const float*)d_in[i];
  p.out = (float*)d_out;
  p.ws = (char*)d_ws;
  hipMemsetAsync((char*)d_ws + OFF_MOD, 0, ZERO_BYTES, stream);
  static int grid_blocks = 0;
#if MULTI
  if (!grid_blocks) {
    int dev = 0, cus = 0, per_cu = 0;
    hipGetDevice(&dev);
    hipDeviceGetAttribute(&cus, hipDeviceAttributeMultiprocessorCount, dev);
    hipOccupancyMaxActiveBlocksPerMultiprocessor(&per_cu, kphase, 256, 0);
    if (per_cu > 2) per_cu = 2;
    if (per_cu < 1) per_cu = 1;
    grid_blocks = cus * per_cu;
  }
  kphase<<<grid_blocks, 256, 0, stream>>>(p, 0, 0);
  for (int l = 0; l < 2; l++)
    for (int ph = 1; ph <= 9; ph++) kphase<<<grid_blocks, 256, 0, stream>>>(p, ph, l);
  kphase<<<grid_blocks, 256, 0, stream>>>(p, 10, 0);
#else
  if (!grid_blocks) {
    int dev = 0, cus = 0, per_cu = 0;
    hipGetDevice(&dev);
    hipDeviceGetAttribute(&cus, hipDeviceAttributeMultiprocessorCount, dev);
    hipOccupancyMaxActiveBlocksPerMultiprocessor(&per_cu, mega, 256, 0);
    if (per_cu > 2) per_cu = 2;
    if (per_cu < 1) per_cu = 1;
    grid_blocks = cus * per_cu;
  }
  void* args[] = {&p};
  hipError_t e = hipLaunchCooperativeKernel((void*)mega, dim3(grid_blocks), dim3(256), args, 0, stream);
  if (e != hipSuccess) fprintf(stderr, "cooperative launch failed: %s (grid %d)\n", hipGetErrorString(e), grid_blocks);
#endif
}
```

```cpp
#include <hip/hip_runtime.h>
#include <hip/hip_cooperative_groups.h>
#include <cstdio>
namespace cg = cooperative_groups;

#ifndef MULTI
#define MULTI 0
#endif

typedef unsigned short u16;
using bf16x8 = __attribute__((ext_vector_type(8))) short;
using f32x4 = __attribute__((ext_vector_type(4))) float;
using u32x4 = __attribute__((ext_vector_type(4))) unsigned;
using u32x2 = __attribute__((ext_vector_type(2))) unsigned;
#define DEV __device__ __forceinline__

constexpr int MT = 12288;
constexpr size_t OFF_WT = 0;
constexpr int WIN_O = 0, WGLU_O = 7340032, WRETO_O = 8388608, WHYO_O = 8912896, WOUT_O = 9437184, WFIN_O = 10485760, WFOUT_O = 16252928;
constexpr size_t OFF_G = 38273024;
constexpr size_t OFF_H = 48758784;
constexpr size_t OFF_ZA = 73924608;
constexpr size_t OFF_HYZ = 124256256;
constexpr size_t OFF_VT = 162004992;
constexpr size_t OFF_KT = 174587904;
constexpr size_t OFF_QR = 182976512;
constexpr size_t OFF_YP = 187170816;
constexpr size_t OFF_OUT1 = 212336640;
constexpr size_t OFF_MOD = 237502464;
constexpr size_t OFF_SUMSQ = OFF_MOD + 245760;
constexpr size_t OFF_BAR = OFF_SUMSQ + 16384;
constexpr size_t ZERO_BYTES = 245760 + 16384 + 16384;
constexpr size_t OFF_LAMBAR = OFF_BAR + 16384;
constexpr size_t OFF_BBAR = OFF_LAMBAR + 65536;
constexpr size_t OFF_CM = OFF_BBAR + 524288;
constexpr size_t OFF_ROPE = OFF_CM + 524288;
constexpr size_t OFF_S0T = OFF_ROPE + 524288;
constexpr size_t WS_END = OFF_S0T + 2097152;

struct Params {
  const float* in[36];
  float* out;
  char* ws;
};


DEV int TID() { int t = threadIdx.x; asm volatile("" : "+v"(t)); return t; }
DEV int BID() { int t = blockIdx.x; asm volatile("" : "+s"(t)); return t; }
#define GAS __attribute__((address_space(1)))
DEV char* WS(const Params& p) { unsigned long long w = (unsigned long long)p.ws; asm volatile("" : "+s"(w)); return (char*)(GAS char*)w; }
DEV float* OUTP(const Params& p) { unsigned long long w = (unsigned long long)p.out; asm volatile("" : "+s"(w)); return (float*)(GAS float*)w; }
DEV const float* INP(const Params& p, int i) { unsigned long long w = (unsigned long long)p.in[i]; asm volatile("" : "+s"(w)); return (const float*)(GAS const float*)w; }

DEV u16 f2bf(float f) { unsigned u = __float_as_uint(f); u += 0x7fffu + ((u >> 16) & 1u); return (u16)(u >> 16); }
DEV float bf2f(u16 h) { return __uint_as_float(((unsigned)h) << 16); }
DEV float sigm(float x) { return 1.f / (1.f + __expf(-x)); }
DEV float silu_(float x) { return x / (1.f + __expf(-x)); }
DEV float gelu_(float x) { float u = 0.7978845608028654f * (x + 0.044715f * x * x * x); return 0.5f * x * (1.f + tanhf(u)); }
DEV unsigned pack2(float a, float b) { return (unsigned)f2bf(a) | ((unsigned)f2bf(b) << 16); }

DEV const float* xin_row(const Params& p, int row) { return row < 8192 ? INP(p, 0) + (size_t)row * 1024 : INP(p, 1) + (size_t)(row - 8192) * 1024; }
DEV int modidx(int row) { return row < 8192 ? 0 : 1 + ((row - 8192) >> 10); }

template <int MF, int NF>
DEV void gemm_loop(const u16* __restrict__ A, int lda, const u16* __restrict__ B, int ldb, int K, f32x4 (&acc)[MF][NF], u16* sA) {
  const int tid = TID(), lane = tid & 63, wid = tid >> 6, wr = wid >> 1, wc = wid & 1, fr = lane & 15, fq = lane >> 4;
  u16* sB = sA + MF * 32 * 72;
  u32x4 ra[MF], rb[NF];
  const int crow = tid >> 3, ccol = (tid & 7) * 8;
  const u16* Ap = A + (size_t)crow * lda + ccol;
  const u16* Bp = B + (size_t)crow * ldb + ccol;
#pragma unroll
  for (int i = 0; i < MF; i++) ra[i] = *(const u32x4*)(Ap + (size_t)(i * 32) * lda);
#pragma unroll
  for (int i = 0; i < NF; i++) rb[i] = *(const u32x4*)(Bp + (size_t)(i * 32) * ldb);
  for (int k0 = 0; k0 < K; k0 += 64) {
    __syncthreads();
#pragma unroll
    for (int i = 0; i < MF; i++) *(u32x4*)(sA + (crow + i * 32) * 72 + ccol) = ra[i];
#pragma unroll
    for (int i = 0; i < NF; i++) *(u32x4*)(sB + (crow + i * 32) * 72 + ccol) = rb[i];
    __syncthreads();
    if (k0 + 64 < K) {
#pragma unroll
      for (int i = 0; i < MF; i++) ra[i] = *(const u32x4*)(Ap + (size_t)(i * 32) * lda + k0 + 64);
#pragma unroll
      for (int i = 0; i < NF; i++) rb[i] = *(const u32x4*)(Bp + (size_t)(i * 32) * ldb + k0 + 64);
    }
#pragma unroll
    for (int ks = 0; ks < 2; ks++) {
      bf16x8 bv[NF];
#pragma unroll
      for (int n = 0; n < NF; n++) bv[n] = *(const bf16x8*)(sB + (wc * (NF * 16) + n * 16 + fr) * 72 + ks * 32 + fq * 8);
#pragma unroll
      for (int m = 0; m < MF; m++) {
        bf16x8 af = *(const bf16x8*)(sA + (m * 32 + wr * 16 + fr) * 72 + ks * 32 + fq * 8);
#pragma unroll
        for (int n = 0; n < NF; n++) acc[m][n] = __builtin_amdgcn_mfma_f32_16x16x32_bf16(af, bv[n], acc[m][n], 0, 0, 0);
      }
    }
  }
}

template <int MF, int NF>
DEV void zero_acc(f32x4 (&acc)[MF][NF]) {
#pragma unroll
  for (int m = 0; m < MF; m++)
#pragma unroll
    for (int n = 0; n < NF; n++) acc[m][n] = f32x4{0.f, 0.f, 0.f, 0.f};
}

DEV float epi_op(float v, int op) { return op == 1 ? v * 0.08838834764831845f : (op == 2 ? silu_(v) : v); }
template <int MF, int NF, int TS>
DEV void acc_to_lds(const f32x4 (&acc)[MF][NF], u16* T, int m0, int op = 0) {
  const int tid = TID(), lane = tid & 63, wid = tid >> 6, wr = wid >> 1, wc = wid & 1, fr = lane & 15, fq = lane >> 4;
#pragma unroll
  for (int m = 0; m < 4; m++)
#pragma unroll
    for (int n = 0; n < NF; n++)
#pragma unroll
      for (int j = 0; j < 4; j++) T[(m * 32 + wr * 16 + fq * 4 + j) * TS + wc * (NF * 16) + n * 16 + fr] = f2bf(epi_op(acc[m0 + m][n][j], op));
}
template <int MF>
DEV void acc_to_lds_T(const f32x4 (&acc)[MF][4], u16* T, int m0, int op = 0) {
  const int tid = TID(), lane = tid & 63, wid = tid >> 6, wr = wid >> 1, wc = wid & 1, fr = lane & 15, fq = lane >> 4;
#pragma unroll
  for (int m = 0; m < 4; m++)
#pragma unroll
    for (int n = 0; n < 4; n++) {
      u32x2 v; v.x = pack2(epi_op(acc[m0 + m][n][0], op), epi_op(acc[m0 + m][n][1], op)); v.y = pack2(epi_op(acc[m0 + m][n][2], op), epi_op(acc[m0 + m][n][3], op));
      *(u32x2*)(T + (wc * 64 + n * 16 + fr) * 136 + m * 32 + wr * 16 + fq * 4) = v;
    }
}
template <int COLS, int TS>
DEV void copy_tile(const u16* T, u16* dst, int ld) {
  constexpr int CPR = COLS / 8;
  constexpr int NIT = 128 * CPR / 256;
#pragma unroll
  for (int i = 0; i < NIT; i++) {
    int id = TID() + i * 256; int r = id / CPR, ch = id % CPR;
    *(u32x4*)(dst + (size_t)r * ld + ch * 8) = *(const u32x4*)(T + r * TS + ch * 8);
  }
}

DEV void transpose_tile(const float* __restrict__ src, int K, int N, u16* __restrict__ dst, int tile, float* sm, int perm = 0) {
  int nk = K >> 6; int tk = tile % nk, tn = tile / nk; int k0 = tk * 64, n0 = tn * 64;
  int tx = TID() & 63, ty = TID() >> 6;
  __syncthreads();
#pragma unroll
  for (int i = 0; i < 16; i++) { int k = ty + i * 4; sm[k * 65 + tx] = src[(size_t)(k0 + k) * N + n0 + tx]; }
  __syncthreads();
#pragma unroll
  for (int i = 0; i < 16; i++) {
    int n = n0 + ty + i * 4;
    if (perm) { int half = N >> 1; int j = n < half ? n : n - half; n = (j >> 4) * 32 + (n < half ? 0 : 16) + (j & 15); }
    dst[(size_t)n * K + k0 + tx] = f2bf(sm[tx * 65 + (ty + i * 4)]);
  }
}

DEV void wt_task(const Params& p, int l, int t, float* sm) {
  u16* WT = (u16*)(WS(p) + OFF_WT);
  const float* src; int K, N, off, tt, perm = 0;
  if (t < 1792) { src = INP(p, 10) + (size_t)l * 1024 * 7168; K = 1024; N = 7168; off = WIN_O; tt = t; }
  else if (t < 2048) { src = INP(p, 19) + (size_t)l * 512 * 2048; K = 512; N = 2048; off = WGLU_O; tt = t - 1792; }
  else if (t < 2176) { src = INP(p, 21) + (size_t)l * 512 * 1024; K = 512; N = 1024; off = WRETO_O; tt = t - 2048; }
  else if (t < 2304) { src = INP(p, 31) + (size_t)l * 512 * 1024; K = 512; N = 1024; off = WHYO_O; tt = t - 2176; }
  else if (t < 2560) { src = INP(p, 32) + (size_t)l * 1024 * 1024; K = 1024; N = 1024; off = WOUT_O; tt = t - 2304; }
  else if (t < 3968) { src = INP(p, 33) + (size_t)l * 1024 * 5632; K = 1024; N = 5632; off = WFIN_O; tt = t - 2560; perm = 1; }
  else { src = INP(p, 34) + (size_t)l * 2816 * 1024; K = 2816; N = 1024; off = WFOUT_O; tt = t - 3968; }
  transpose_tile(src, K, N, WT + off, tt, sm, perm);
}

DEV void mod_task(const Params& p, int task, float* sm) {
  int cb = task % 96; int l = task / 96;
  int tid = TID(), lane = tid & 63, kq = tid >> 6;
  __syncthreads();
  for (int i = tid; i < 5120; i += 256) {
    int j = i >> 10, k = i & 1023;
    float c = (j == 0) ? INP(p, 5)[k] : INP(p, 4)[(j - 1) * 1024 + k];
    sm[i] = silu_(c);
  }
  __syncthreads();
  int col = cb * 64 + lane;
  const float* w = INP(p, 6) + (size_t)l * 1024 * 6144 + col;
  float a0 = 0, a1 = 0, a2 = 0, a3 = 0, a4 = 0;
#pragma unroll 8
  for (int kk = 0; kk < 256; kk++) {
    int k = kk * 4 + kq;
    float wv = w[(size_t)k * 6144];
    a0 += sm[k] * wv; a1 += sm[1024 + k] * wv; a2 += sm[2048 + k] * wv; a3 += sm[3072 + k] * wv; a4 += sm[4096 + k] * wv;
  }
  float* red = sm + 5120;
  red[(kq * 5 + 0) * 64 + lane] = a0; red[(kq * 5 + 1) * 64 + lane] = a1; red[(kq * 5 + 2) * 64 + lane] = a2;
  red[(kq * 5 + 3) * 64 + lane] = a3; red[(kq * 5 + 4) * 64 + lane] = a4;
  __syncthreads();
  float* MOD = (float*)(WS(p) + OFF_MOD);
  for (int i = tid; i < 320; i += 256) {
    int j = i >> 6, cc = i & 63;
    float v = ((red[(0 * 5 + j) * 64 + cc] + red[(1 * 5 + j) * 64 + cc]) + red[(2 * 5 + j) * 64 + cc]) + red[(3 * 5 + j) * 64 + cc];
    MOD[(l * 5 + j) * 6144 + cb * 64 + cc] = v;
  }
}

DEV void filt_task(const Params& p, int l, int task, float* sm) {
  int Lsel = task >= 32; int tb = Lsel ? task - 32 : task; int L = Lsel ? 1024 : 256; int t0 = tb * 8;
  int tid = TID();
  float* z = sm; float* h1 = sm + 264; float* h2 = sm + 264 + 512;
  const float* w1 = INP(p, 24) + l * 33 * 64; const float* b1 = INP(p, 25) + l * 64;
  const float* w2 = INP(p, 26) + l * 64 * 64; const float* b2 = INP(p, 27) + l * 64;
  const float* fr0 = INP(p, 28) + l * 128; const float* fr1 = fr0 + 64;
  const float* w3 = INP(p, 29) + (size_t)l * 64 * 2048;
  __syncthreads();
  for (int i = tid; i < 264; i += 256) {
    int tt = i / 33, e = i % 33; float t = (float)(t0 + tt); float v;
    if (e == 0) v = t / (float)L;
    else {
      int b = (e - 1) & 15; float band = 1e-4f + (float)b * ((15.f - 1e-4f) / 15.f);
      float ang = (6.283185307179586f / (float)L) * t * band;
      v = (e <= 16) ? cosf(ang) : -sinf(ang);
    }
    z[i] = v;
  }
  __syncthreads();
  for (int i = tid; i < 512; i += 256) {
    int tt = i >> 6, j = i & 63; float s = b1[j];
    for (int e = 0; e < 33; e++) s += z[tt * 33 + e] * w1[e * 64 + j];
    h1[i] = sinf(fr0[j] * s);
  }
  __syncthreads();
  for (int i = tid; i < 512; i += 256) {
    int tt = i >> 6, j = i & 63; float s = b2[j];
    for (int e = 0; e < 64; e++) s += h1[tt * 64 + e] * w2[e * 64 + j];
    h2[i] = sinf(fr1[j] * s);
  }
  __syncthreads();
  float* FB = (float*)(WS(p) + OFF_G) + (Lsel ? 524288 : 0);
  float* SUMSQ = (float*)(WS(p) + WS_END);
  for (int m = 0; m < 8; m++) {
    int col = tid + m * 256;
    float acc[8];
#pragma unroll
    for (int tt = 0; tt < 8; tt++) acc[tt] = 0.f;
    for (int j = 0; j < 64; j++) {
      float w = w3[j * 2048 + col];
#pragma unroll
      for (int tt = 0; tt < 8; tt++) acc[tt] += h2[tt * 64 + j] * w;
    }
    int dir = col >> 10, o = (col >> 9) & 1, c = col & 511;
    float rate = 3.0701134573253944f + (float)c * ((15.350567286626972f - 3.0701134573253944f) / 511.f);
    float ss = 0.f;
    float* Fo = FB + (size_t)o * (2 * L) * 512 + c;
#pragma unroll
    for (int tt = 0; tt < 8; tt++) {
      int t = t0 + tt;
      float val = acc[tt] * expf(-((float)t / (float)L) * rate);
      if (dir == 0) { Fo[(size_t)(L + t) * 512] = val; ss += val * val; }
      else if (t > 0) { Fo[(size_t)(L - t) * 512] = val; ss += val * val; }
      else { Fo[0] = 0.f; }
    }
    SUMSQ[((size_t)l * 160 + task) * 2048 + col] = ss;
  }
}

DEV void s5prep_task(const Params& p, int task) {
  int idx = task * 256 + TID();
  int pp = idx & 63; int lrg = idx >> 6;
  float lre = INP(p, 11)[idx], lim = INP(p, 12)[idx];
  float dt = expf(INP(p, 13)[lrg]);
  float mag = expf(lre * dt);
  float lbr = mag * cosf(lim * dt), lbi = mag * sinf(lim * dt);
  float nr = lbr - 1.f, ni = lbi; float den = lre * lre + lim * lim;
  float cr = (nr * lre + ni * lim) / den, ci = (ni * lre - nr * lim) / den;
  u16* BBAR = (u16*)(WS(p) + OFF_BBAR); u16* CM = (u16*)(WS(p) + OFF_CM); float* LB = (float*)(WS(p) + OFF_LAMBAR);
  LB[idx * 2] = lbr; LB[idx * 2 + 1] = lbi;
  for (int c = 0; c < 16; c++) {
    float br = INP(p, 14)[(size_t)idx * 16 + c], bi = INP(p, 15)[(size_t)idx * 16 + c];
    BBAR[(size_t)lrg * 2048 + pp * 16 + c] = f2bf(cr * br - ci * bi);
    BBAR[(size_t)lrg * 2048 + (64 + pp) * 16 + c] = f2bf(cr * bi + ci * br);
    CM[(size_t)lrg * 2048 + c * 128 + pp] = f2bf(INP(p, 16)[(size_t)lrg * 1024 + c * 64 + pp]);
    CM[(size_t)lrg * 2048 + c * 128 + 64 + pp] = f2bf(-INP(p, 17)[(size_t)lrg * 1024 + c * 64 + pp]);
  }
}

DEV void rope_task(const Params& p, int task) {
  int idx = task * 256 + TID(); int t = idx >> 6, d = idx & 63; int f = d & 31;
  float inv = powf(10000.f, -(float)f / 32.f);
  float pos = (d < 32) ? (float)(t >> 6) : (float)(t & 63);
  float ang = pos * inv;
  float* R = (float*)(WS(p) + OFF_ROPE);
  R[idx * 2] = cosf(ang); R[idx * 2 + 1] = sinf(ang);
}

DEV void layer_prep(const Params& p, int l, char* smem) {
  for (int t = BID(); t < 4672 + 160; t += gridDim.x) {
    if (t < 4672) wt_task(p, l, t, (float*)smem);
    else filt_task(p, l, t - 4672, (float*)smem);
  }
}
DEV void phaseA(const Params& p, char* smem) {
  for (int t = BID(); t < 192 + 32 + 256 + 256; t += gridDim.x) {
    if (t < 192) mod_task(p, t, (float*)smem);
    else if (t < 224) s5prep_task(p, t - 192);
    else if (t < 480) rope_task(p, t - 224);
    else { int tt = t - 480; int mi = tt >> 2; transpose_tile(INP(p, 3) + (size_t)mi * 16384, 128, 128, (u16*)(WS(p) + OFF_S0T) + (size_t)mi * 16384, tt & 3, (float*)smem); }
  }
  layer_prep(p, 0, smem);
}

DEV void norm_phase(const Params& p, int l, int which) {
  const int lane = TID() & 63;
  const int wave = (BID() * blockDim.x + TID()) >> 6, nw = (gridDim.x * blockDim.x) >> 6;
  u16* H = (u16*)(WS(p) + OFF_H);
  const float* MOD = (const float*)(WS(p) + OFF_MOD);
  for (int row = wave; row < MT; row += nw) {
    const float* x = (l == 0 && which == 0) ? xin_row(p, row) : OUTP(p) + (size_t)row * 1024;
    float4 v[4]; float ss = 0.f;
#pragma unroll
    for (int i = 0; i < 4; i++) { v[i] = *(const float4*)(x + i * 256 + lane * 4); ss += v[i].x * v[i].x + v[i].y * v[i].y + v[i].z * v[i].z + v[i].w * v[i].w; }
#pragma unroll
    for (int o = 32; o > 0; o >>= 1) ss += __shfl_xor(ss, o, 64);
    float rinv = rsqrtf(ss * (1.f / 1024.f) + 1e-6f);
    if (which == 2) {
      const float* nf = INP(p, 35);
#pragma unroll
      for (int i = 0; i < 4; i++) {
        float4 g = *(const float4*)(nf + i * 256 + lane * 4);
        float4 o; o.x = v[i].x * rinv * g.x; o.y = v[i].y * rinv * g.y; o.z = v[i].z * rinv * g.z; o.w = v[i].w * rinv * g.w;
        *(float4*)(OUTP(p) + (size_t)row * 1024 + i * 256 + lane * 4) = o;
      }
    } else {
      int j = modidx(row);
      const float* nwt = (which == 0 ? INP(p, 8) : INP(p, 9)) + l * 1024;
      const float* msh = MOD + (l * 5 + j) * 6144 + (which ? 3 : 0) * 1024;
      const float* msc = msh + 1024;
      const float* bsh = INP(p, 7) + l * 6144 + (which ? 3 : 0) * 1024;
      const float* bsc = bsh + 1024;
#pragma unroll
      for (int i = 0; i < 4; i++) {
        int k = i * 256 + lane * 4;
        float4 g = *(const float4*)(nwt + k);
        float4 sh = *(const float4*)(msh + k), sc = *(const float4*)(msc + k);
        float4 bh = *(const float4*)(bsh + k), bc = *(const float4*)(bsc + k);
        float o0 = v[i].x * rinv * g.x * (1.f + sc.x + bc.x) + sh.x + bh.x;
        float o1 = v[i].y * rinv * g.y * (1.f + sc.y + bc.y) + sh.y + bh.y;
        float o2 = v[i].z * rinv * g.z * (1.f + sc.z + bc.z) + sh.z + bh.z;
        float o3 = v[i].w * rinv * g.w * (1.f + sc.w + bc.w) + sh.w + bh.w;
        u32x2 pk; pk.x = pack2(o0, o1); pk.y = pack2(o2, o3);
        *(u32x2*)(H + (size_t)row * 1024 + k) = pk;
      }
    }
  }
}

DEV void phaseC(const Params& p, int l, char* smem) {
  u16* sA = (u16*)smem; u16* T = (u16*)smem;
  const u16* H = (const u16*)(WS(p) + OFF_H);
  const u16* WIN = (const u16*)(WS(p) + OFF_WT) + WIN_O;
  u16* ZA = (u16*)(WS(p) + OFF_ZA); u16* HYT = (u16*)(WS(p) + OFF_HYZ); u16* VT = (u16*)(WS(p) + OFF_VT);
  u16* KT = (u16*)(WS(p) + OFF_KT); u16* QR = (u16*)(WS(p) + OFF_QR);
  const float* ROPE = (const float*)(WS(p) + OFF_ROPE);
  const int tid = TID();
  for (int tile = BID(); tile < 48 * 32; tile += gridDim.x) {
    int tm = tile >> 5, tn = tile & 31;
    f32x4 acc[8][4]; zero_acc<8, 4>(acc);
    gemm_loop<8, 4>(H + (size_t)tm * 256 * 1024, 1024, WIN + (size_t)tn * 128 * 1024, 1024, 1024, acc, sA);
    int kind = tn >> 2, hd = tn & 3;
    const int op = kind == 2 ? 1 : (kind == 4 ? 2 : 0);
#pragma unroll
    for (int hh = 0; hh < 2; hh++) {
      int row0 = tm * 256 + hh * 128; bool lat = row0 >= 8192;
      int seq, t0, L;
      if (!lat) { seq = row0 >> 8; t0 = row0 & 255; L = 256; } else { seq = (row0 - 8192) >> 10; t0 = (row0 - 8192) & 1023; L = 1024; }
      __syncthreads();
      if (kind == 3 || kind >= 5) {
        acc_to_lds_T<8>(acc, T, hh * 4, 0);
        __syncthreads();
        u16* dst;
        if (kind == 3) dst = lat ? VT + (size_t)8192 * 512 + (size_t)((seq * 4 + hd) * 128) * 1024 + t0 : VT + (size_t)((seq * 4 + hd) * 128) * 256 + t0;
        else dst = lat ? HYT + (size_t)8192 * 1536 + ((size_t)seq * 1536 + (tn - 20) * 128) * 1024 + t0 : HYT + ((size_t)seq * 1536 + (tn - 20) * 128) * 256 + t0;
        copy_tile<128, 136>(T, dst, L);
      } else {
        acc_to_lds<8, 4, 136>(acc, T, hh * 4, op);
        __syncthreads();
        bool roped = lat && (kind == 1 || kind == 2);
        if (!(lat && kind == 2)) {
          u16* dst;
          if (kind == 0) dst = ZA + (size_t)row0 * 2048 + hd * 128;
          else if (kind == 1) dst = ZA + (size_t)row0 * 2048 + 512 + hd * 128;
          else if (kind == 2) dst = ZA + (size_t)row0 * 2048 + 1024 + hd * 128;
          else dst = ZA + (size_t)row0 * 2048 + 1536 + hd * 128;
          copy_tile<128, 136>(T, dst, 2048);
        }
        if (roped) {
          u16* dst; int ld;
          if (kind == 1) { dst = QR + (size_t)(row0 - 8192) * 512 + hd * 128; ld = 512; }
          else { dst = ZA + (size_t)row0 * 2048 + 1024 + hd * 128; ld = 2048; }
#pragma unroll 1
          for (int i = 0; i < 4; i++) {
            int id = tid + i * 256; int r = id >> 3, ch = id & 7;
            u32x4 a = *(const u32x4*)(T + r * 136 + ch * 8);
            u32x4 b = *(const u32x4*)(T + r * 136 + 64 + ch * 8);
            const float4* cs = (const float4*)(ROPE + ((size_t)(t0 + r) * 64 + ch * 8) * 2);
            u32x4 o1, o2;
#pragma unroll
            for (int q = 0; q < 4; q++) {
              float4 c4 = cs[q];
              float x1a = __uint_as_float(a[q] << 16), x1b = __uint_as_float(a[q] & 0xffff0000u);
              float x2a = __uint_as_float(b[q] << 16), x2b = __uint_as_float(b[q] & 0xffff0000u);
              o1[q] = pack2(x1a * c4.x - x2a * c4.y, x1b * c4.z - x2b * c4.w);
              o2[q] = pack2(x1a * c4.y + x2a * c4.x, x1b * c4.w + x2b * c4.z);
            }
            *(u32x4*)(dst + (size_t)r * ld + ch * 8) = o1;
            *(u32x4*)(dst + (size_t)r * ld + 64 + ch * 8) = o2;
          }
        }
        if (kind == 2 && !lat) {
          __syncthreads();
          acc_to_lds_T<8>(acc, T, hh * 4, op);
          __syncthreads();
          copy_tile<128, 136>(T, KT + (size_t)((seq * 4 + hd) * 128) * 256 + t0, 256);
        }
      }
    }
  }
}

DEV void s5_task(const Params& p, int l, int task, char* smem) {
  const int tid = TID(), lane = tid & 63, wid = tid >> 6, fr = lane & 15, fq = lane >> 4;
  int seq, gp;
  if (task < 64) { seq = 32 + (task >> 4); gp = task & 15; } else { int t2 = task - 64; seq = t2 >> 4; gp = t2 & 15; }
  const bool lat = seq >= 32;
  const int L = lat ? 1024 : 256;
  const int row0 = lat ? 8192 + (seq - 32) * 1024 : seq * 256;
  const int grp = gp * 2 + (wid >> 1), dir = wid & 1;
  const int lrg = (l * 2 + dir) * 32 + grp;
  float* BU = (float*)(smem + wid * 12544);
  u16* HB = (u16*)(smem + wid * 12544 + 8192);
  u16* ZA = (u16*)(WS(p) + OFF_ZA);
  float* YP = (float*)(WS(p) + OFF_YP);
  const u16* BBAR = (const u16*)(WS(p) + OFF_BBAR) + (size_t)lrg * 2048;
  const u16* CM = (const u16*)(WS(p) + OFF_CM) + (size_t)lrg * 2048;
  const float* LB = (const float*)(WS(p) + OFF_LAMBAR) + ((size_t)lrg * 64 + lane) * 2;
  const float lr = LB[0], li = LB[1];
  bf16x8 bfrag[8], cfrag[4];
  const bf16x8 zero8 = {0, 0, 0, 0, 0, 0, 0, 0};
#pragma unroll
  for (int nt = 0; nt < 8; nt++) bfrag[nt] = (fq < 2) ? *(const bf16x8*)(BBAR + (nt * 16 + fr) * 16 + fq * 8) : zero8;
#pragma unroll
  for (int ks = 0; ks < 4; ks++) cfrag[ks] = *(const bf16x8*)(CM + fr * 128 + ks * 32 + fq * 8);
  float hr = 0.f, hi = 0.f;
  if (lat) {
    const float* s0 = INP(p, 2) + ((((size_t)(seq - 32) * 2 + l) * 2 + dir) * 32 + grp) * 128 + lane * 2;
    hr = s0[0]; hi = s0[1];
  }
  const float dcoef = INP(p, 18)[l * 512 + grp * 16 + fr];
  const int nch = L >> 4;
  __syncthreads();
  const int half = nch >> 1;
  bf16x8 ua_next = (fq < 2) ? *(const bf16x8*)(ZA + (size_t)(row0 + (dir ? nch - 1 : 0) * 16 + fr) * 2048 + grp * 16 + fq * 8) : zero8;
  const int tbase = dir ? 15 : 0, tstep = dir ? -1 : 1;
  for (int i = 0; i < nch; i++) {
    const int ci = dir ? nch - 1 - i : i; const int t0 = ci * 16;
    if (i == half) { asm volatile("s_waitcnt vmcnt(0)" ::: "memory"); __threadfence(); asm volatile("s_waitcnt vmcnt(0)" ::: "memory"); __syncthreads(); }
    const bf16x8 ua = ua_next;
    if (i + 1 < nch) {
      const int cn = dir ? nch - 2 - i : i + 1;
      ua_next = (fq < 2) ? *(const bf16x8*)(ZA + (size_t)(row0 + cn * 16 + fr) * 2048 + grp * 16 + fq * 8) : zero8;
    }
#pragma unroll
    for (int nt = 0; nt < 8; nt++) {
      f32x4 r = __builtin_amdgcn_mfma_f32_16x16x32_bf16(ua, bfrag[nt], f32x4{0.f, 0.f, 0.f, 0.f}, 0, 0, 0);
#pragma unroll
      for (int j = 0; j < 4; j++) BU[(fq * 4 + j) * 128 + nt * 16 + fr] = r[j];
    }
    asm volatile("s_waitcnt lgkmcnt(0)" ::: "memory");
#pragma unroll
    for (int tt = 0; tt < 16; tt++) {
      const int t = tbase + tstep * tt;
      float re = BU[t * 128 + lane], im = BU[t * 128 + 64 + lane];
      float nr = lr * hr - li * hi + re; float ni = lr * hi + li * hr + im;
      hr = nr; hi = ni;
      HB[t * 136 + lane] = f2bf(hr); HB[t * 136 + 64 + lane] = f2bf(hi);
    }
    asm volatile("s_waitcnt lgkmcnt(0)" ::: "memory");
    f32x4 y = {0.f, 0.f, 0.f, 0.f};
#pragma unroll
    for (int ks = 0; ks < 4; ks++) {
      bf16x8 a = *(const bf16x8*)(HB + fr * 136 + ks * 32 + fq * 8);
      y = __builtin_amdgcn_mfma_f32_16x16x32_bf16(a, cfrag[ks], y, 0, 0, 0);
    }
    asm volatile("s_waitcnt lgkmcnt(0)" ::: "memory");
    if (i < half) {
#pragma unroll
      for (int j = 0; j < 4; j++) YP[(size_t)(row0 + t0 + fq * 4 + j) * 512 + grp * 16 + fr] = y[j];
    } else {
#pragma unroll
      for (int j = 0; j < 4; j++) {
        size_t row = (size_t)(row0 + t0 + fq * 4 + j);
        float other = __hip_atomic_load(&YP[row * 512 + grp * 16 + fr], __ATOMIC_RELAXED, __HIP_MEMORY_SCOPE_AGENT);
        u16* up = ZA + row * 2048 + grp * 16 + fr;
        float v = y[j] + other + dcoef * bf2f(*up);
        *up = f2bf(gelu_(v));
      }
    }
  }
  if (!lat) {
    float* o = OUTP(p) + 12582912 + ((((size_t)seq * 2 + l) * 2 + dir) * 32 + grp) * 128 + lane * 2;
    o[0] = hr; o[1] = hi;
  }
}

DEV void ret_task(const Params& p, int l, int task, char* smem) {
  const int tid = TID(), lane = tid & 63, wid = tid >> 6, fr = lane & 15, fq = lane >> 4;
  int seq, h, qt; bool lat;
  if (task < 256) { lat = true; seq = task >> 6; h = (task >> 4) & 3; qt = task & 15; }
  else { int t2 = task - 256; lat = false; seq = t2 >> 4; h = (t2 >> 2) & 3; qt = t2 & 3; }
  const int L = lat ? 1024 : 256;
  const int row0 = lat ? 8192 + seq * 1024 : seq * 256;
  u16* sK = (u16*)smem; u16* sV = sK + 64 * 136; u16* sP = sV + 128 * 72 + wid * 16 * 72;
  u16* ZA = (u16*)(WS(p) + OFF_ZA);
  const u16* QR = (const u16*)(WS(p) + OFF_QR);
  const u16* VT = (const u16*)(WS(p) + OFF_VT);
  const float lgf = log1pf(-expf(INP(p, 20)[(l * 2 + 0) * 4 + h])), lgb = log1pf(-expf(INP(p, 20)[(l * 2 + 1) * 4 + h]));
  const int qrow = qt * 64 + wid * 16;
  const u16* qsrc = lat ? QR + (size_t)(row0 - 8192 + qrow + fr) * 512 + h * 128 : ZA + (size_t)(row0 + qrow + fr) * 2048 + 512 + h * 128;
  bf16x8 qa[4];
#pragma unroll
  for (int ks = 0; ks < 4; ks++) qa[ks] = *(const bf16x8*)(qsrc + ks * 32 + fq * 8);
  f32x4 o[8];
#pragma unroll
  for (int n = 0; n < 8; n++) o[n] = f32x4{0.f, 0.f, 0.f, 0.f};
  const u16* Kbase = ZA + (size_t)row0 * 2048 + 1024 + h * 128;
  const u16* Vbase = lat ? VT + (size_t)8192 * 512 + (size_t)((seq * 4 + h) * 128) * 1024 : VT + (size_t)((seq * 4 + h) * 128) * 256;
  const int nkt = L >> 6;
  for (int jt = 0; jt < nkt; jt++) {
    __syncthreads();
#pragma unroll
    for (int i = 0; i < 4; i++) {
      int id = tid + i * 256; int r = id >> 4, ch = id & 15;
      *(u32x4*)(sK + r * 136 + ch * 8) = *(const u32x4*)(Kbase + (size_t)(jt * 64 + r) * 2048 + ch * 8);
    }
#pragma unroll
    for (int i = 0; i < 4; i++) {
      int id = tid + i * 256; int e = id >> 3, ch = id & 7;
      *(u32x4*)(sV + e * 72 + ch * 8) = *(const u32x4*)(Vbase + (size_t)e * L + jt * 64 + ch * 8);
    }
    __syncthreads();
    f32x4 s[4];
#pragma unroll
    for (int nt = 0; nt < 4; nt++) {
      s[nt] = f32x4{0.f, 0.f, 0.f, 0.f};
#pragma unroll
      for (int ks = 0; ks < 4; ks++) {
        bf16x8 b = *(const bf16x8*)(sK + (nt * 16 + fr) * 136 + ks * 32 + fq * 8);
        s[nt] = __builtin_amdgcn_mfma_f32_16x16x32_bf16(qa[ks], b, s[nt], 0, 0, 0);
      }
      asm volatile("" ::: "memory");
    }
#pragma unroll
    for (int nt = 0; nt < 4; nt++)
#pragma unroll
      for (int j = 0; j < 4; j++) {
        int d = (qrow + fq * 4 + j) - (jt * 64 + nt * 16 + fr);
        float w = d >= 0 ? __expf(lgf * (float)d) : __expf(lgb * (float)(-d));
        sP[(fq * 4 + j) * 72 + nt * 16 + fr] = f2bf(s[nt][j] * w);
      }
    asm volatile("s_waitcnt lgkmcnt(0)" ::: "memory");
#pragma unroll
    for (int k2 = 0; k2 < 2; k2++) {
      bf16x8 a = *(const bf16x8*)(sP + fr * 72 + k2 * 32 + fq * 8);
#pragma unroll
      for (int n2 = 0; n2 < 8; n2++) {
        bf16x8 b = *(const bf16x8*)(sV + (n2 * 16 + fr) * 72 + k2 * 32 + fq * 8);
        o[n2] = __builtin_amdgcn_mfma_f32_16x16x32_bf16(a, b, o[n2], 0, 0, 0);
        if (n2 == 3) asm volatile("" ::: "memory");
      }
      asm volatile("" ::: "memory");
    }
    asm volatile("s_waitcnt lgkmcnt(0)" ::: "memory");
  }
  if (lat) {
    const u16* q0src = ZA + (size_t)(row0 + qrow + fr) * 2048 + 512 + h * 128;
    bf16x8 q0[4];
#pragma unroll
    for (int ks = 0; ks < 4; ks++) q0[ks] = *(const bf16x8*)(q0src + ks * 32 + fq * 8);
#pragma unroll 1
    for (int dir = 0; dir < 2; dir++) {
      const u16* S0 = (const u16*)(WS(p) + OFF_S0T) + (size_t)((((seq * 2 + l) * 2 + dir) * 4 + h)) * 16384;
      float wj[4];
#pragma unroll
      for (int j = 0; j < 4; j++) { int gi = qrow + fq * 4 + j; wj[j] = dir == 0 ? __expf(lgf * (float)(gi + 1)) : __expf(lgb * (float)(L - 1 - gi)); }
#pragma unroll
      for (int n2 = 0; n2 < 8; n2++) {
        f32x4 tmp = {0.f, 0.f, 0.f, 0.f};
#pragma unroll
        for (int ks = 0; ks < 4; ks++) {
          bf16x8 b = *(const bf16x8*)(S0 + (size_t)(n2 * 16 + fr) * 128 + ks * 32 + fq * 8);
          tmp = __builtin_amdgcn_mfma_f32_16x16x32_bf16(q0[ks], b, tmp, 0, 0, 0);
        }
#pragma unroll
        for (int j = 0; j < 4; j++) o[n2][j] += wj[j] * tmp[j];
        asm volatile("" ::: "memory");
      }
    }
  }
#pragma unroll
  for (int j = 0; j < 4; j++) {
    float s = 0.f;
#pragma unroll
    for (int n2 = 0; n2 < 8; n2++) s += o[n2][j];
    s += __shfl_xor(s, 1, 64); s += __shfl_xor(s, 2, 64); s += __shfl_xor(s, 4, 64); s += __shfl_xor(s, 8, 64);
    float mean = s * (1.f / 128.f);
    float v = 0.f;
#pragma unroll
    for (int n2 = 0; n2 < 8; n2++) { float dd = o[n2][j] - mean; v += dd * dd; }
    v += __shfl_xor(v, 1, 64); v += __shfl_xor(v, 2, 64); v += __shfl_xor(v, 4, 64); v += __shfl_xor(v, 8, 64);
    float rstd = rsqrtf(v * (1.f / 128.f) + 1e-5f);
    size_t rbase = (size_t)(row0 + qrow + fq * 4 + j) * 2048;
#pragma unroll
    for (int n2 = 0; n2 < 8; n2++) {
      int e = n2 * 16 + fr;
      float gv = bf2f(ZA[rbase + 1536 + h * 128 + e]);
      ZA[rbase + 512 + h * 128 + e] = f2bf((o[n2][j] - mean) * rstd * gv);
    }
  }
}

DEV bf16x8 scale8(u32x4 raw, const float (&w)[8]) {
  union { u32x4 u; bf16x8 v; } r;
#pragma unroll
  for (int q = 0; q < 4; q++) {
    float a = __uint_as_float(raw[q] << 16) * w[q * 2], b = __uint_as_float(raw[q] & 0xffff0000u) * w[q * 2 + 1];
    r.u[q] = pack2(a, b);
  }
  return r.v;
}

DEV void retstate_task(const Params& p, int l, int task) {
  const int tid = TID(), lane = tid & 63, wid = tid >> 6, fr = lane & 15, fq = lane >> 4;
  int seq = task >> 3, h = (task >> 1) & 3, dir = task & 1;
  const u16* KT = (const u16*)(WS(p) + OFF_KT) + (size_t)((seq * 4 + h) * 128) * 256;
  const u16* VT = (const u16*)(WS(p) + OFF_VT) + (size_t)((seq * 4 + h) * 128) * 256;
  const float lg = log1pf(-expf(INP(p, 20)[(l * 2 + dir) * 4 + h]));
  f32x4 acc[2][8];
#pragma unroll
  for (int m = 0; m < 2; m++)
#pragma unroll
    for (int n = 0; n < 8; n++) acc[m][n] = f32x4{0.f, 0.f, 0.f, 0.f};
#pragma unroll 1
  for (int ks = 0; ks < 8; ks++) {
    float w[8];
#pragma unroll
    for (int jj = 0; jj < 8; jj++) { int j = ks * 32 + fq * 8 + jj; w[jj] = __expf(lg * (float)(dir == 0 ? 255 - j : j)); }
    bf16x8 a[2];
#pragma unroll
    for (int m = 0; m < 2; m++) a[m] = scale8(*(const u32x4*)(KT + (size_t)(wid * 32 + m * 16 + fr) * 256 + ks * 32 + fq * 8), w);
#pragma unroll
    for (int n = 0; n < 8; n++) {
      bf16x8 b = *(const bf16x8*)(VT + (size_t)(n * 16 + fr) * 256 + ks * 32 + fq * 8);
#pragma unroll
      for (int m = 0; m < 2; m++) acc[m][n] = __builtin_amdgcn_mfma_f32_16x16x32_bf16(a[m], b, acc[m][n], 0, 0, 0);
    }
  }
  float* o = OUTP(p) + 13107200 + ((((size_t)seq * 2 + l) * 2 + dir) * 4 + h) * 16384;
#pragma unroll
  for (int m = 0; m < 2; m++)
#pragma unroll
    for (int n = 0; n < 8; n++)
#pragma unroll
      for (int j = 0; j < 4; j++) o[(size_t)(wid * 32 + m * 16 + fq * 4 + j) * 128 + n * 16 + fr] = acc[m][n][j];
}

template <bool LAT>
DEV void hyena_mfma(const Params& p, int l, int task, char* smem) {
  constexpr int L = LAT ? 1024 : 256;
  constexpr int NV = LAT ? 4 : 16;
  constexpr int RS = L + 8, CS = 2 * L + 16;
  constexpr int MPW = L / 64, NKS = L / 32, NCH = L / 8, Lsel = LAT ? 1 : 0;
  const int tid = TID(), lane = tid & 63, wid = tid >> 6, fr = lane & 15, fq = lane >> 4;
  const int c = LAT ? task : (task >> 1);
  const int sg = LAT ? 0 : (task & 1);
  u16* CP = (u16*)smem; u16* XV = CP + 8 * CS; u16* GS = XV + NV * RS; u16* O1 = GS + NV * RS;
  const u16* HYT = (const u16*)(WS(p) + OFF_HYZ);
  u16* HYOT = (u16*)(WS(p) + OFF_OUT1) + (size_t)MT * 512;
  const float* cw = INP(p, 22) + (size_t)l * 3 * 1536; const float* cb = INP(p, 23) + l * 1536;
  auto sconv = [&](int arr, u16* dstA) {
    const int ch = arr * 512 + c;
    const float w0 = cw[ch], w1 = cw[1536 + ch], w2 = cw[3072 + ch], bb = cb[ch];
#pragma unroll
    for (int i = 0; i < (NV * NCH) / 256; i++) {
      int id = tid + i * 256; int n = id / NCH, t8 = (id % NCH) * 8;
      const u16* src = LAT ? HYT + (size_t)8192 * 1536 + ((size_t)n * 1536 + ch) * 1024 + t8 : HYT + ((size_t)(sg * 16 + n) * 1536 + ch) * 256 + t8;
      u32x4 raw = *(const u32x4*)src;
      float h[10];
      h[0] = t8 > 0 ? bf2f(src[-1]) : 0.f;
      h[9] = t8 + 8 < L ? bf2f(src[8]) : 0.f;
#pragma unroll
      for (int q = 0; q < 4; q++) { h[1 + 2 * q] = __uint_as_float(raw[q] << 16); h[2 + 2 * q] = __uint_as_float(raw[q] & 0xffff0000u); }
      u32x4 o;
#pragma unroll
      for (int q = 0; q < 4; q++) o[q] = pack2(w0 * h[2 * q] + w1 * h[2 * q + 1] + w2 * h[2 * q + 2] + bb, w0 * h[2 * q + 1] + w1 * h[2 * q + 2] + w2 * h[2 * q + 3] + bb);
      *(u32x4*)(dstA + n * RS + t8) = o;
    }
  };
  __syncthreads();
  sconv(0, GS);
  sconv(2, XV);
  const int rr = (-fr) & 7;
  const u16* cpl = CP + rr * CS + (L + 8 * fq - fr - rr);
#pragma unroll 1
  for (int o = 0; o < 2; o++) {
    if (o == 1) sconv(1, GS);
    u16* FL = o == 0 ? O1 : XV;
    const float* Gp = (const float*)(WS(p) + OFF_G) + (Lsel ? 524288 : 0) + (size_t)o * (2 * L) * 512 + c;
    if (tid < 2 * L / 8) {
      float f[8];
#pragma unroll
      for (int j = 0; j < 8; j++) { int u = tid * 8 + j; f[j] = u > 0 ? Gp[(size_t)(2 * L - u) * 512] : 0.f; }
      u32x4 v; v[0] = pack2(f[0], f[1]); v[1] = pack2(f[2], f[3]); v[2] = pack2(f[4], f[5]); v[3] = pack2(f[6], f[7]);
      *(u32x4*)(FL + tid * 8) = v;
    }
    if (tid < 2) *(u32x4*)(FL + 2 * L + tid * 8) = u32x4{0u, 0u, 0u, 0u};
    __syncthreads();
    if (tid < 2 * L / 8) {
      u32x4 a = *(const u32x4*)(FL + tid * 8), b = *(const u32x4*)(FL + tid * 8 + 8);
      unsigned d[8] = {a[0], a[1], a[2], a[3], b[0], b[1], b[2], b[3]};
#pragma unroll
      for (int r = 0; r < 8; r++) {
        u32x4 ov;
#pragma unroll
        for (int q = 0; q < 4; q++) ov[q] = (r & 1) ? ((d[q + (r >> 1)] >> 16) | (d[q + (r >> 1) + 1] << 16)) : d[q + (r >> 1)];
        *(u32x4*)(CP + r * CS + tid * 8) = ov;
      }
    }
    __syncthreads();
    float rn;
    {
      constexpr int NTB = LAT ? 128 : 32;
      const float* SP = (const float*)(WS(p) + WS_END) + ((size_t)l * 160 + (LAT ? 32 : 0)) * 2048 + o * 512 + c;
      float ssum = 0.f;
      for (int tb = lane; tb < NTB; tb += 64) ssum += SP[(size_t)tb * 2048] + SP[(size_t)tb * 2048 + 1024];
#pragma unroll
      for (int off = 32; off > 0; off >>= 1) ssum += __shfl_xor(ssum, off, 64);
      rn = rsqrtf(ssum + 1e-6f);
    }
    const float bias = INP(p, 30)[(l * 2 + o) * 512 + c];
    const u16* Xs = o == 0 ? XV : O1;
    f32x4 acc[MPW];
#pragma unroll
    for (int mi = 0; mi < MPW; mi++) acc[mi] = f32x4{0.f, 0.f, 0.f, 0.f};
    const bf16x8 zero8 = {0, 0, 0, 0, 0, 0, 0, 0};
#pragma unroll 2
    for (int ks = 0; ks < NKS; ks++) {
      bf16x8 b = (fr < NV) ? *(const bf16x8*)(Xs + fr * RS + ks * 32 + fq * 8) : zero8;
#pragma unroll
      for (int mi = 0; mi < MPW; mi++) {
        bf16x8 a = *(const bf16x8*)(cpl - 16 * (wid * MPW + mi) + 32 * ks);
        acc[mi] = __builtin_amdgcn_mfma_f32_16x16x32_bf16(a, b, acc[mi], 0, 0, 0);
      }
    }
    if (fr < NV) {
      const u16* gate = GS;
      const u16* vin = o == 0 ? XV : O1;
#pragma unroll
      for (int mi = 0; mi < MPW; mi++) {
        const int t0 = (wid * MPW + mi) * 16 + fq * 4;
        u32x2 gq = *(const u32x2*)(gate + fr * RS + t0), vq = *(const u32x2*)(vin + fr * RS + t0);
        float g4[4] = {__uint_as_float(gq[0] << 16), __uint_as_float(gq[0] & 0xffff0000u), __uint_as_float(gq[1] << 16), __uint_as_float(gq[1] & 0xffff0000u)};
        float v4[4] = {__uint_as_float(vq[0] << 16), __uint_as_float(vq[0] & 0xffff0000u), __uint_as_float(vq[1] << 16), __uint_as_float(vq[1] & 0xffff0000u)};
        float r4[4];
#pragma unroll
        for (int j = 0; j < 4; j++) r4[j] = g4[j] * (acc[mi][j] * rn + bias * v4[j]);
        if (o == 0) {
          u32x2 ov; ov[0] = pack2(r4[0], r4[1]); ov[1] = pack2(r4[2], r4[3]);
          *(u32x2*)(O1 + fr * RS + t0) = ov;
        } else {
          u16* dst = LAT ? HYOT + (size_t)8192 * 512 + ((size_t)fr * 512 + c) * 1024 + t0 : HYOT + ((size_t)(sg * 16 + fr) * 512 + c) * 256 + t0;
          u32x2 ov; ov[0] = pack2(r4[0], r4[1]); ov[1] = pack2(r4[2], r4[3]);
          *(u32x2*)dst = ov;
        }
      }
    }
    __syncthreads();
  }
}

DEV void phaseD(const Params& p, int l, char* smem) {
  const int nbt = gridDim.x, bt = BID();
  const bool ded = nbt >= 128;
  const bool s5only = ded && bt < 64;
  const int nb = ded ? nbt - 64 : nbt, b = ded ? bt - 64 : bt;
  const int BIG = 1 << 28;
#pragma unroll 1
  for (int t = s5only ? BIG : b; t < 512; t += nb) hyena_mfma<true>(p, l, t, smem);
#pragma unroll 1
  for (int t = s5only ? BIG : (b + nb - (512 % nb)) % nb; t < 768; t += nb) ret_task(p, l, t, smem);
  {
    int st, step, lo;
    if (s5only) { st = bt; step = BIG; }
    else { lo = ded ? 64 : 0; st = lo + (b + 2 * nb - ((512 + 768) % nb)) % nb; step = nb; }
#pragma unroll 1
    for (int t = st; t < 576; t += step) s5_task(p, l, t, smem);
  }
#pragma unroll 1
  for (int t = s5only ? BIG : (b + 3 * nb - ((512 + 768 + 576) % nb)) % nb; t < 1024; t += nb) hyena_mfma<false>(p, l, t, smem);
#pragma unroll 1
  for (int t = s5only ? BIG : (b + 4 * nb - ((512 + 768 + 576 + 1024) % nb)) % nb; t < 256; t += nb) retstate_task(p, l, t);
}

DEV void phaseE(const Params& p, char* smem) {
  const u16* HYOT = (const u16*)(WS(p) + OFF_OUT1) + (size_t)MT * 512;
  u16* HYO = (u16*)(WS(p) + OFF_OUT1);
  u16* sm = (u16*)smem;
  const int tx = TID() & 63, ty = TID() >> 6;
  for (int tile = BID(); tile < 192 * 8; tile += gridDim.x) {
    int rt = tile >> 3, c0 = (tile & 7) * 64; int row0 = rt * 64;
    const u16* src = row0 < 8192 ? HYOT + ((size_t)(row0 >> 8) * 512 + c0) * 256 + (row0 & 255)
                                 : HYOT + (size_t)8192 * 512 + ((size_t)((row0 - 8192) >> 10) * 512 + c0) * 1024 + ((row0 - 8192) & 1023);
    const int L = row0 < 8192 ? 256 : 1024;
    __syncthreads();
#pragma unroll
    for (int i = 0; i < 16; i++) { int cc = ty + i * 4; sm[cc * 66 + tx] = src[(size_t)cc * L + tx]; }
    __syncthreads();
#pragma unroll
    for (int i = 0; i < 16; i++) { int tt = ty + i * 4; HYO[(size_t)(row0 + tt) * 512 + c0 + tx] = sm[tx * 66 + tt]; }
  }
}

DEV void phaseF(const Params& p, int l, char* smem) {
  u16* sA = (u16*)smem; u16* T = (u16*)smem;
  const u16* H = (const u16*)(WS(p) + OFF_H);
  const u16* WT = (const u16*)(WS(p) + OFF_WT);
  const u16* ZA = (const u16*)(WS(p) + OFF_ZA); const u16* HYO = (const u16*)(WS(p) + OFF_OUT1);
  u16* MG = (u16*)(WS(p) + OFF_YP);
  for (int tile = BID(); tile < 96 * 16; tile += gridDim.x) {
    int tm = tile >> 4, tn = tile & 15; int row0 = tm * 128, n0 = tn * 64;
    f32x4 a1[4][2], a2[4][2], tt[4][2];
    const u16* Hrow = H + (size_t)row0 * 1024;
    zero_acc<4, 2>(a1); zero_acc<4, 2>(tt);
#pragma unroll 1
    for (int ps = 0; ps < 7; ps++) {
      const u16* Ap; const u16* Bp; int lda, K;
      switch (ps) {
        case 0: Ap = ZA + (size_t)row0 * 2048; lda = 2048; Bp = WT + WGLU_O + (size_t)n0 * 512; K = 512; break;
        case 1: Ap = ZA + (size_t)row0 * 2048; lda = 2048; Bp = WT + WGLU_O + (size_t)(1024 + n0) * 512; K = 512; break;
        case 3: Ap = ZA + (size_t)row0 * 2048 + 512; lda = 2048; Bp = WT + WRETO_O + (size_t)n0 * 512; K = 512; break;
        case 5: Ap = HYO + (size_t)row0 * 512; lda = 512; Bp = WT + WHYO_O + (size_t)n0 * 512; K = 512; break;
        default: Ap = Hrow; lda = 1024; Bp = WT + WIN_O + (size_t)(4096 + ((ps - 2) >> 1) * 1024 + n0) * 1024; K = 1024; break;
      }
      zero_acc<4, 2>(a2);
      gemm_loop<4, 2>(Ap, lda, Bp, K, K, a2, sA);
      if (ps == 0 || ps == 3 || ps == 5) {
#pragma unroll
        for (int m = 0; m < 4; m++)
#pragma unroll
          for (int n = 0; n < 2; n++) a1[m][n] = a2[m][n];
      } else if (ps == 1) {
#pragma unroll
        for (int m = 0; m < 4; m++)
#pragma unroll
          for (int n = 0; n < 2; n++)
#pragma unroll
            for (int j = 0; j < 4; j++) a1[m][n][j] *= sigm(a2[m][n][j]);
      } else {
#pragma unroll
        for (int m = 0; m < 4; m++)
#pragma unroll
          for (int n = 0; n < 2; n++)
#pragma unroll
            for (int j = 0; j < 4; j++) tt[m][n][j] += a1[m][n][j] * sigm(a2[m][n][j]);
      }
    }
    __syncthreads();
    acc_to_lds<4, 2, 72>(tt, T, 0);
    __syncthreads();
    copy_tile<64, 72>(T, MG + (size_t)row0 * 1024 + n0, 1024);
  }
}

template <int MF, int NF>
DEV void resid_store(const Params& p, const f32x4 (&acc)[MF][NF], int l, int chunk, int row0, int col0, bool from_input) {
  const int tid = TID(), lane = tid & 63, wid = tid >> 6, wr = wid >> 1, wc = wid & 1, fr = lane & 15, fq = lane >> 4;
  float* out = OUTP(p);
#pragma unroll
  for (int m = 0; m < MF; m++) {
    const int rb = row0 + m * 32 + wr * 16 + fq * 4;
    const int j = modidx(rb);
    const float* MOD = (const float*)(WS(p) + OFF_MOD) + (l * 5 + j) * 6144 + chunk * 1024;
    const float* BM = INP(p, 7) + l * 6144 + chunk * 1024;
#pragma unroll
    for (int n = 0; n < NF; n++) {
      int col = col0 + wc * (NF * 16) + n * 16 + fr;
      float g = MOD[col] + BM[col];
#pragma unroll
      for (int jj = 0; jj < 4; jj++) {
        int row = rb + jj;
        float xo = from_input ? xin_row(p, row)[col] : out[(size_t)row * 1024 + col];
        out[(size_t)row * 1024 + col] = xo + g * acc[m][n][jj];
      }
    }
  }
}

DEV void phaseG(const Params& p, int l, char* smem) {
  u16* sA = (u16*)smem;
  const u16* MG = (const u16*)(WS(p) + OFF_YP);
  const u16* W = (const u16*)(WS(p) + OFF_WT) + WOUT_O;
  for (int tile = BID(); tile < 64 * 8; tile += gridDim.x) {
    int tm = tile >> 3, tn = tile & 7;
    f32x4 acc[6][4]; zero_acc<6, 4>(acc);
    gemm_loop<6, 4>(MG + (size_t)tm * 192 * 1024, 1024, W + (size_t)tn * 128 * 1024, 1024, 1024, acc, sA);
    resid_store<6, 4>(p, acc, l, 2, tm * 192, tn * 128, l == 0);
  }
}

DEV void phaseI(const Params& p, int l, char* smem) {
  u16* sA = (u16*)smem; u16* T = (u16*)smem;
  const u16* H = (const u16*)(WS(p) + OFF_H);
  const u16* W = (const u16*)(WS(p) + OFF_WT) + WFIN_O;
  u16* ACT = (u16*)(WS(p) + OFF_ZA);
  for (int tile = BID(); tile < 48 * 44; tile += gridDim.x) {
    int tm = tile / 44, tn = tile % 44;
    f32x4 acc[8][4]; zero_acc<8, 4>(acc);
    gemm_loop<8, 4>(H + (size_t)tm * 256 * 1024, 1024, W + (size_t)tn * 128 * 1024, 1024, 1024, acc, sA);
    const int tid = TID(), lane = tid & 63, wid = tid >> 6, wr = wid >> 1, wc = wid & 1, fr = lane & 15, fq = lane >> 4;
#pragma unroll
    for (int hh = 0; hh < 2; hh++) {
      __syncthreads();
#pragma unroll
      for (int m = 0; m < 4; m++)
#pragma unroll
        for (int n = 0; n < 2; n++)
#pragma unroll
          for (int j = 0; j < 4; j++)
            T[(m * 32 + wr * 16 + fq * 4 + j) * 72 + wc * 32 + n * 16 + fr] = f2bf(silu_(acc[hh * 4 + m][2 * n][j]) * acc[hh * 4 + m][2 * n + 1][j]);
      __syncthreads();
      copy_tile<64, 72>(T, ACT + (size_t)(tm * 256 + hh * 128) * 2816 + tn * 64, 2816);
    }
  }
}

DEV void phaseJ(const Params& p, int l, char* smem) {
  u16* sA = (u16*)smem;
  const u16* ACT = (const u16*)(WS(p) + OFF_ZA);
  const u16* W = (const u16*)(WS(p) + OFF_WT) + WFOUT_O;
  for (int tile = BID(); tile < 64 * 8; tile += gridDim.x) {
    int tm = tile >> 3, tn = tile & 7;
    f32x4 acc[6][4]; zero_acc<6, 4>(acc);
    gemm_loop<6, 4>(ACT + (size_t)tm * 192 * 2816, 2816, W + (size_t)tn * 128 * 2816, 2816, 2816, acc, sA);
    resid_store<6, 4>(p, acc, l, 5, tm * 192, tn * 128, false);
  }
}


#define XB_TMO      128
#define XB_XCNT(j)  (256  + 64 * (j))
#define XB_XSUB(j)  (1280 + 64 * (j))
#define XB_XGEN(j)  (2304 + 64 * (j))
#define XB_TOP      3328
#define XB_TOPGEN   3392
#define XB_SPIN_CAP (1u << 22)
#define LAS __attribute__((address_space(3)))
DEV unsigned xb_ld(unsigned* p) { return __hip_atomic_load(p, __ATOMIC_RELAXED, __HIP_MEMORY_SCOPE_AGENT); }
DEV unsigned xb_add(unsigned* p, unsigned v) { return __hip_atomic_fetch_add(p, v, __ATOMIC_RELAXED, __HIP_MEMORY_SCOPE_AGENT); }
DEV unsigned xb_xcc_id() { return (unsigned)__builtin_amdgcn_s_getreg((3 << 11) | 20) & 0xFu; }
#define XB_SPIN(cond, bar) do { unsigned _sp = 0; while (cond) { __builtin_amdgcn_s_sleep(1); \
    if ((++_sp & 255u) == 0u) { if (xb_ld(&(bar)[XB_TMO])) break; if (_sp > XB_SPIN_CAP) { atomicAdd(&(bar)[XB_TMO], 1u); break; } } } } while (0)
struct XcdBarrier { unsigned* bar; unsigned x; volatile LAS unsigned* st; };
DEV XcdBarrier xcd_barrier_post(unsigned* bar, volatile LAS unsigned* st) {
  XcdBarrier b; b.bar = bar; b.x = xb_xcc_id(); b.st = st;
  if (threadIdx.x == 0) (void)xb_add(&bar[XB_XCNT(b.x)], 1u);
  return b;
}
DEV void xcd_barrier_complete(unsigned* bar, unsigned x, unsigned& nloc, unsigned& nx) {
  const unsigned G = gridDim.x * gridDim.y * gridDim.z;
  unsigned sum, cnt, mine, sp = 0u;
  for (;;) {
    sum = 0u; cnt = 0u; mine = 0u;
#pragma unroll
    for (unsigned j = 0; j < 16; ++j) { const unsigned c = xb_ld(&bar[XB_XCNT(j)]); sum += c; cnt += (c > 0u) ? 1u : 0u; mine = (j == x) ? c : mine; }
    if (sum == G) break;
    __builtin_amdgcn_s_sleep(1);
    if ((++sp & 255u) == 0u) { if (xb_ld(&bar[XB_TMO])) break; if (sp > XB_SPIN_CAP) { atomicAdd(&bar[XB_TMO], 1u); break; } }
  }
  nloc = mine > 0u ? mine : 1u; nx = cnt > 0u ? cnt : 1u;
}
DEV void xcd_barrier(const XcdBarrier& b) {
  asm volatile("s_waitcnt vmcnt(0)" ::: "memory");
  __syncthreads();
  if (threadIdx.x == 0) {
    unsigned* bar = b.bar;
    __builtin_amdgcn_s_waitcnt(0);
    unsigned nloc = b.st[0], nx = b.st[1];
    if (nloc == 0u) { xcd_barrier_complete(bar, b.x, nloc, nx); b.st[0] = nloc; b.st[1] = nx; }
    const unsigned old = xb_add(&bar[XB_XSUB(b.x)], 1u);
    const unsigned gen = old / nloc;
    if (old + 1u == (gen + 1u) * nloc) {
      __builtin_amdgcn_fence(__ATOMIC_RELEASE, "agent");
      asm volatile("s_waitcnt vmcnt(0)" ::: "memory");
      const unsigned og = xb_add(&bar[XB_TOP], 1u);
      const unsigned tg = og / nx;
      if (og + 1u == (tg + 1u) * nx) xb_add(&bar[XB_TOPGEN], 1u);
      else XB_SPIN(xb_ld(&bar[XB_TOPGEN]) == tg, bar);
      __builtin_amdgcn_fence(__ATOMIC_ACQUIRE, "agent");
      xb_add(&bar[XB_XGEN(b.x)], 1u);
      asm volatile("s_waitcnt vmcnt(0)" ::: "memory");
    } else {
      XB_SPIN(xb_ld(&bar[XB_XGEN(b.x)]) == gen, bar);
      __builtin_amdgcn_fence(__ATOMIC_ACQUIRE, "agent");
      asm volatile("s_waitcnt vmcnt(0)" ::: "memory");
    }
  }
  __syncthreads();
}

constexpr int SMEM_BYTES = 57792;

DEV void run_phase(const Params& p, int ph, int l, char* smem) {
  switch (ph) {
    case 0: phaseA(p, smem); break;
    case 1: norm_phase(p, l, 0); if (l == 1) layer_prep(p, 1, smem); break;
    case 2: phaseC(p, l, smem); break;
    case 3: phaseD(p, l, smem); break;
    case 4: phaseE(p, smem); break;
    case 5: phaseF(p, l, smem); break;
    case 6: phaseG(p, l, smem); break;
    case 7: norm_phase(p, l, 1); break;
    case 8: phaseI(p, l, smem); break;
    case 9: phaseJ(p, l, smem); break;
    case 10: norm_phase(p, 0, 2); break;
  }
}

#if MULTI
__global__ void __launch_bounds__(256, 2) kphase(Params p, int ph, int l) {
  __shared__ __attribute__((aligned(16))) char smem[SMEM_BYTES];
  run_phase(p, ph, l, smem);
}
#else
__global__ void __launch_bounds__(256, 2) mega(Params p) {
  __shared__ __attribute__((aligned(16))) char smem[SMEM_BYTES];
  __shared__ uint4 xb_words;
  cg::grid_group grid = cg::this_grid();
  if (threadIdx.x == 0) xb_words = make_uint4(0u, 0u, 0u, 0u);
  __syncthreads();
  XcdBarrier xb = xcd_barrier_post((unsigned*)(p.ws + OFF_BAR), (volatile LAS unsigned*)&xb_words);
  run_phase(p, 0, 0, smem);
  grid.sync();
  for (int l = 0; l < 2; l++) {
    for (int ph = 1; ph <= 9; ph++) {
      run_phase(p, ph, l, smem);
      xcd_barrier(xb);
    }
  }
  run_phase(p, 10, 0, smem);
}
#endif

extern "C" void kernel_launch(void* const* d_in, const int* in_sizes, int n_in, void* d_out, int out_size, void* d_ws, size_t ws_size, hipStream_t stream) {
  Params p{};
  for (int i = 0; i < 36; i++) p.in[i] = (const float*)d_in[i];
  p.out = (float*)d_out;
  p.ws = (char*)d_ws;
  hipMemsetAsync((char*)d_ws + OFF_MOD, 0, ZERO_BYTES, stream);
  static int grid_blocks = 0;
#if MULTI
  if (!grid_blocks) {
    int dev = 0, cus = 0, per_cu = 0;
    hipGetDevice(&dev);
    hipDeviceGetAttribute(&cus, hipDeviceAttributeMultiprocessorCount, dev);
    hipOccupancyMaxActiveBlocksPerMultiprocessor(&per_cu, kphase, 256, 0);
    if (per_cu > 2) per_cu = 2;
    if (per_cu < 1) per_cu = 1;
    grid_blocks = cus * per_cu;
  }
  kphase<<<grid_blocks, 256, 0, stream>>>(p, 0, 0);
  for (int l = 0; l < 2; l++)
    for (int ph = 1; ph <= 9; ph++) kphase<<<grid_blocks, 256, 0, stream>>>(p, ph, l);
  kphase<<<grid_blocks, 256, 0, stream>>>(p, 10, 0);
#else
  if (!grid_blocks) {
    int dev = 0, cus = 0, per_cu = 0;
    hipGetDevice(&dev);
    hipDeviceGetAttribute(&cus, hipDeviceAttributeMultiprocessorCount, dev);
    hipOccupancyMaxActiveBlocksPerMultiprocessor(&per_cu, mega, 256, 0);
    if (per_cu > 2) per_cu = 2;
    if (per_cu < 1) per_cu = 1;
    grid_blocks = cus * per_cu;
  }
  void* args[] = {&p};
  hipError_t e = hipLaunchCooperativeKernel((void*)mega, dim3(grid_blocks), dim3(256), args, 0, stream);
  if (e != hipSuccess) fprintf(stderr, "cooperative launch failed: %s (grid %d)\n", hipGetErrorString(e), grid_blocks);
#endif
}
```

```cpp
#include <hip/hip_runtime.h>
#include <hip/hip_cooperative_groups.h>
#include <cstdio>
namespace cg = cooperative_groups;

#ifndef MULTI
#define MULTI 0
#endif

typedef unsigned short u16;
using bf16x8 = __attribute__((ext_vector_type(8))) short;
using f32x4 = __attribute__((ext_vector_type(4))) float;
using u32x4 = __attribute__((ext_vector_type(4))) unsigned;
using u32x2 = __attribute__((ext_vector_type(2))) unsigned;
#define DEV __device__ __forceinline__

constexpr int MT = 12288;
constexpr size_t OFF_WT = 0;
constexpr int WIN_O = 0, WGLU_O = 7340032, WRETO_O = 8388608, WHYO_O = 8912896, WOUT_O = 9437184, WFIN_O = 10485760, WFOUT_O = 16252928;
constexpr size_t OFF_G = 38273024;
constexpr size_t OFF_H = 48758784;
constexpr size_t OFF_ZA = 73924608;
constexpr size_t OFF_HYZ = 124256256;
constexpr size_t OFF_VT = 162004992;
constexpr size_t OFF_KT = 174587904;
constexpr size_t OFF_QR = 182976512;
constexpr size_t OFF_YP = 187170816;
constexpr size_t OFF_OUT1 = 212336640;
constexpr size_t OFF_MOD = 237502464;
constexpr size_t OFF_SUMSQ = OFF_MOD + 245760;
constexpr size_t OFF_BAR = OFF_SUMSQ + 16384;
constexpr size_t ZERO_BYTES = 245760 + 16384 + 16384;
constexpr size_t OFF_LAMBAR = OFF_BAR + 16384;
constexpr size_t OFF_BBAR = OFF_LAMBAR + 65536;
constexpr size_t OFF_CM = OFF_BBAR + 524288;
constexpr size_t OFF_ROPE = OFF_CM + 524288;
constexpr size_t OFF_S0T = OFF_ROPE + 524288;
constexpr size_t WS_END = OFF_S0T + 2097152;

struct Params {
  const float* in[36];
  float* out;
  char* ws;
};


DEV int TID() { int t = threadIdx.x; asm volatile("" : "+v"(t)); return t; }
DEV int BID() { int t = blockIdx.x; asm volatile("" : "+s"(t)); return t; }
#define GAS __attribute__((address_space(1)))
DEV char* WS(const Params& p) { unsigned long long w = (unsigned long long)p.ws; asm volatile("" : "+s"(w)); return (char*)(GAS char*)w; }
DEV float* OUTP(const Params& p) { unsigned long long w = (unsigned long long)p.out; asm volatile("" : "+s"(w)); return (float*)(GAS float*)w; }
DEV const float* INP(const Params& p, int i) { unsigned long long w = (unsigned long long)p.in[i]; asm volatile("" : "+s"(w)); return (const float*)(GAS const float*)w; }

DEV u16 f2bf(float f) { unsigned u = __float_as_uint(f); u += 0x7fffu + ((u >> 16) & 1u); return (u16)(u >> 16); }
DEV float bf2f(u16 h) { return __uint_as_float(((unsigned)h) << 16); }
DEV float sigm(float x) { return 1.f / (1.f + __expf(-x)); }
DEV float silu_(float x) { return x / (1.f + __expf(-x)); }
DEV float gelu_(float x) { float u = 0.7978845608028654f * (x + 0.044715f * x * x * x); return 0.5f * x * (1.f + tanhf(u)); }
DEV unsigned pack2(float a, float b) { return (unsigned)f2bf(a) | ((unsigned)f2bf(b) << 16); }

DEV const float* xin_row(const Params& p, int row) { return row < 8192 ? INP(p, 0) + (size_t)row * 1024 : INP(p, 1) + (size_t)(row - 8192) * 1024; }
DEV int modidx(int row) { return row < 8192 ? 0 : 1 + ((row - 8192) >> 10); }

template <int MF, int NF>
DEV void gemm_loop(const u16* __restrict__ A, int lda, const u16* __restrict__ B, int ldb, int K, f32x4 (&acc)[MF][NF], u16* sA) {
  const int tid = TID(), lane = tid & 63, wid = tid >> 6, wr = wid >> 1, wc = wid & 1, fr = lane & 15, fq = lane >> 4;
  u16* sB = sA + MF * 32 * 72;
  u32x4 ra[MF], rb[NF];
  const int crow = tid >> 3, ccol = (tid & 7) * 8;
  const u16* Ap = A + (size_t)crow * lda + ccol;
  const u16* Bp = B + (size_t)crow * ldb + ccol;
#pragma unroll
  for (int i = 0; i < MF; i++) ra[i] = *(const u32x4*)(Ap + (size_t)(i * 32) * lda);
#pragma unroll
  for (int i = 0; i < NF; i++) rb[i] = *(const u32x4*)(Bp + (size_t)(i * 32) * ldb);
  for (int k0 = 0; k0 < K; k0 += 64) {
    __syncthreads();
#pragma unroll
    for (int i = 0; i < MF; i++) *(u32x4*)(sA + (crow + i * 32) * 72 + ccol) = ra[i];
#pragma unroll
    for (int i = 0; i < NF; i++) *(u32x4*)(sB + (crow + i * 32) * 72 + ccol) = rb[i];
    __syncthreads();
    if (k0 + 64 < K) {
#pragma unroll
      for (int i = 0; i < MF; i++) ra[i] = *(const u32x4*)(Ap + (size_t)(i * 32) * lda + k0 + 64);
#pragma unroll
      for (int i = 0; i < NF; i++) rb[i] = *(const u32x4*)(Bp + (size_t)(i * 32) * ldb + k0 + 64);
    }
#pragma unroll
    for (int ks = 0; ks < 2; ks++) {
      bf16x8 bv[NF];
#pragma unroll
      for (int n = 0; n < NF; n++) bv[n] = *(const bf16x8*)(sB + (wc * (NF * 16) + n * 16 + fr) * 72 + ks * 32 + fq * 8);
      const u16* sAf = sA + (wr * 16 + fr) * 72 + ks * 32 + fq * 8;
      bf16x8 a_cur = *(const bf16x8*)(sAf);
      bf16x8 a_nxt = *(const bf16x8*)(sAf + 32 * 72);
#pragma unroll
      for (int m = 0; m < MF; m++) {
        bf16x8 a_n2 = a_nxt;
        if (m + 2 < MF) a_n2 = *(const bf16x8*)(sAf + (m + 2) * 32 * 72);
        __builtin_amdgcn_sched_barrier(0);
#pragma unroll
        for (int n = 0; n < NF; n++) acc[m][n] = __builtin_amdgcn_mfma_f32_16x16x32_bf16(a_cur, bv[n], acc[m][n], 0, 0, 0);
        __builtin_amdgcn_sched_barrier(0);
        a_cur = a_nxt; a_nxt = a_n2;
      }
    }
  }
}

template <int MF, int NF>
DEV void zero_acc(f32x4 (&acc)[MF][NF]) {
#pragma unroll
  for (int m = 0; m < MF; m++)
#pragma unroll
    for (int n = 0; n < NF; n++) acc[m][n] = f32x4{0.f, 0.f, 0.f, 0.f};
}

DEV float epi_op(float v, int op) { return op == 1 ? v * 0.08838834764831845f : (op == 2 ? silu_(v) : v); }
template <int MF, int NF, int TS>
DEV void acc_to_lds(const f32x4 (&acc)[MF][NF], u16* T, int m0, int op = 0) {
  const int tid = TID(), lane = tid & 63, wid = tid >> 6, wr = wid >> 1, wc = wid & 1, fr = lane & 15, fq = lane >> 4;
#pragma unroll
  for (int m = 0; m < 4; m++)
#pragma unroll
    for (int n = 0; n < NF; n++)
#pragma unroll
      for (int j = 0; j < 4; j++) T[(m * 32 + wr * 16 + fq * 4 + j) * TS + wc * (NF * 16) + n * 16 + fr] = f2bf(epi_op(acc[m0 + m][n][j], op));
}
template <int MF>
DEV void acc_to_lds_T(const f32x4 (&acc)[MF][4], u16* T, int m0, int op = 0) {
  const int tid = TID(), lane = tid & 63, wid = tid >> 6, wr = wid >> 1, wc = wid & 1, fr = lane & 15, fq = lane >> 4;
#pragma unroll
  for (int m = 0; m < 4; m++)
#pragma unroll
    for (int n = 0; n < 4; n++) {
      u32x2 v; v.x = pack2(epi_op(acc[m0 + m][n][0], op), epi_op(acc[m0 + m][n][1], op)); v.y = pack2(epi_op(acc[m0 + m][n][2], op), epi_op(acc[m0 + m][n][3], op));
      *(u32x2*)(T + (wc * 64 + n * 16 + fr) * 136 + m * 32 + wr * 16 + fq * 4) = v;
    }
}
template <int COLS, int TS>
DEV void copy_tile(const u16* T, u16* dst, int ld) {
  constexpr int CPR = COLS / 8;
  constexpr int NIT = 128 * CPR / 256;
#pragma unroll
  for (int i = 0; i < NIT; i++) {
    int id = TID() + i * 256; int r = id / CPR, ch = id % CPR;
    *(u32x4*)(dst + (size_t)r * ld + ch * 8) = *(const u32x4*)(T + r * TS + ch * 8);
  }
}

DEV void transpose_tile(const float* __restrict__ src, int K, int N, u16* __restrict__ dst, int tile, float* sm, int perm = 0) {
  int nk = K >> 6; int tk = tile % nk, tn = tile / nk; int k0 = tk * 64, n0 = tn * 64;
  int tx = TID() & 63, ty = TID() >> 6;
  __syncthreads();
#pragma unroll
  for (int i = 0; i < 16; i++) { int k = ty + i * 4; sm[k * 65 + tx] = src[(size_t)(k0 + k) * N + n0 + tx]; }
  __syncthreads();
#pragma unroll
  for (int i = 0; i < 16; i++) {
    int n = n0 + ty + i * 4;
    if (perm) { int half = N >> 1; int j = n < half ? n : n - half; n = (j >> 4) * 32 + (n < half ? 0 : 16) + (j & 15); }
    dst[(size_t)n * K + k0 + tx] = f2bf(sm[tx * 65 + (ty + i * 4)]);
  }
}

DEV void wt_task(const Params& p, int l, int t, float* sm) {
  u16* WT = (u16*)(WS(p) + OFF_WT);
  const float* src; int K, N, off, tt, perm = 0;
  if (t < 1792) { src = INP(p, 10) + (size_t)l * 1024 * 7168; K = 1024; N = 7168; off = WIN_O; tt = t; }
  else if (t < 2048) { src = INP(p, 19) + (size_t)l * 512 * 2048; K = 512; N = 2048; off = WGLU_O; tt = t - 1792; }
  else if (t < 2176) { src = INP(p, 21) + (size_t)l * 512 * 1024; K = 512; N = 1024; off = WRETO_O; tt = t - 2048; }
  else if (t < 2304) { src = INP(p, 31) + (size_t)l * 512 * 1024; K = 512; N = 1024; off = WHYO_O; tt = t - 2176; }
  else if (t < 2560) { src = INP(p, 32) + (size_t)l * 1024 * 1024; K = 1024; N = 1024; off = WOUT_O; tt = t - 2304; }
  else if (t < 3968) { src = INP(p, 33) + (size_t)l * 1024 * 5632; K = 1024; N = 5632; off = WFIN_O; tt = t - 2560; perm = 1; }
  else { src = INP(p, 34) + (size_t)l * 2816 * 1024; K = 2816; N = 1024; off = WFOUT_O; tt = t - 3968; }
  transpose_tile(src, K, N, WT + off, tt, sm, perm);
}

DEV void mod_task(const Params& p, int task, float* sm) {
  int cb = task % 96; int l = task / 96;
  int tid = TID(), lane = tid & 63, kq = tid >> 6;
  __syncthreads();
  for (int i = tid; i < 5120; i += 256) {
    int j = i >> 10, k = i & 1023;
    float c = (j == 0) ? INP(p, 5)[k] : INP(p, 4)[(j - 1) * 1024 + k];
    sm[i] = silu_(c);
  }
  __syncthreads();
  int col = cb * 64 + lane;
  const float* w = INP(p, 6) + (size_t)l * 1024 * 6144 + col;
  float a0 = 0, a1 = 0, a2 = 0, a3 = 0, a4 = 0;
#pragma unroll 8
  for (int kk = 0; kk < 256; kk++) {
    int k = kk * 4 + kq;
    float wv = w[(size_t)k * 6144];
    a0 += sm[k] * wv; a1 += sm[1024 + k] * wv; a2 += sm[2048 + k] * wv; a3 += sm[3072 + k] * wv; a4 += sm[4096 + k] * wv;
  }
  float* red = sm + 5120;
  red[(kq * 5 + 0) * 64 + lane] = a0; red[(kq * 5 + 1) * 64 + lane] = a1; red[(kq * 5 + 2) * 64 + lane] = a2;
  red[(kq * 5 + 3) * 64 + lane] = a3; red[(kq * 5 + 4) * 64 + lane] = a4;
  __syncthreads();
  float* MOD = (float*)(WS(p) + OFF_MOD);
  for (int i = tid; i < 320; i += 256) {
    int j = i >> 6, cc = i & 63;
    float v = ((red[(0 * 5 + j) * 64 + cc] + red[(1 * 5 + j) * 64 + cc]) + red[(2 * 5 + j) * 64 + cc]) + red[(3 * 5 + j) * 64 + cc];
    MOD[(l * 5 + j) * 6144 + cb * 64 + cc] = v;
  }
}

DEV void filt_task(const Params& p, int l, int task, float* sm) {
  int Lsel = task >= 32; int tb = Lsel ? task - 32 : task; int L = Lsel ? 1024 : 256; int t0 = tb * 8;
  int tid = TID();
  float* z = sm; float* h1 = sm + 264; float* h2 = sm + 264 + 512;
  const float* w1 = INP(p, 24) + l * 33 * 64; const float* b1 = INP(p, 25) + l * 64;
  const float* w2 = INP(p, 26) + l * 64 * 64; const float* b2 = INP(p, 27) + l * 64;
  const float* fr0 = INP(p, 28) + l * 128; const float* fr1 = fr0 + 64;
  const float* w3 = INP(p, 29) + (size_t)l * 64 * 2048;
  __syncthreads();
  for (int i = tid; i < 264; i += 256) {
    int tt = i / 33, e = i % 33; float t = (float)(t0 + tt); float v;
    if (e == 0) v = t / (float)L;
    else {
      int b = (e - 1) & 15; float band = 1e-4f + (float)b * ((15.f - 1e-4f) / 15.f);
      float ang = (6.283185307179586f / (float)L) * t * band;
      v = (e <= 16) ? cosf(ang) : -sinf(ang);
    }
    z[i] = v;
  }
  __syncthreads();
  for (int i = tid; i < 512; i += 256) {
    int tt = i >> 6, j = i & 63; float s = b1[j];
    for (int e = 0; e < 33; e++) s += z[tt * 33 + e] * w1[e * 64 + j];
    h1[i] = sinf(fr0[j] * s);
  }
  __syncthreads();
  for (int i = tid; i < 512; i += 256) {
    int tt = i >> 6, j = i & 63; float s = b2[j];
    for (int e = 0; e < 64; e++) s += h1[tt * 64 + e] * w2[e * 64 + j];
    h2[i] = sinf(fr1[j] * s);
  }
  __syncthreads();
  float* FB = (float*)(WS(p) + OFF_G) + (Lsel ? 524288 : 0);
  float* SUMSQ = (float*)(WS(p) + WS_END);
  for (int m = 0; m < 8; m++) {
    int col = tid + m * 256;
    float acc[8];
#pragma unroll
    for (int tt = 0; tt < 8; tt++) acc[tt] = 0.f;
    for (int j = 0; j < 64; j++) {
      float w = w3[j * 2048 + col];
#pragma unroll
      for (int tt = 0; tt < 8; tt++) acc[tt] += h2[tt * 64 + j] * w;
    }
    int dir = col >> 10, o = (col >> 9) & 1, c = col & 511;
    float rate = 3.0701134573253944f + (float)c * ((15.350567286626972f - 3.0701134573253944f) / 511.f);
    float ss = 0.f;
    float* Fo = FB + (size_t)o * (2 * L) * 512 + c;
#pragma unroll
    for (int tt = 0; tt < 8; tt++) {
      int t = t0 + tt;
      float val = acc[tt] * expf(-((float)t / (float)L) * rate);
      if (dir == 0) { Fo[(size_t)(L + t) * 512] = val; ss += val * val; }
      else if (t > 0) { Fo[(size_t)(L - t) * 512] = val; ss += val * val; }
      else { Fo[0] = 0.f; }
    }
    SUMSQ[((size_t)l * 160 + task) * 2048 + col] = ss;
  }
}

DEV void s5prep_task(const Params& p, int task) {
  int idx = task * 256 + TID();
  int pp = idx & 63; int lrg = idx >> 6;
  float lre = INP(p, 11)[idx], lim = INP(p, 12)[idx];
  float dt = expf(INP(p, 13)[lrg]);
  float mag = expf(lre * dt);
  float lbr = mag * cosf(lim * dt), lbi = mag * sinf(lim * dt);
  float nr = lbr - 1.f, ni = lbi; float den = lre * lre + lim * lim;
  float cr = (nr * lre + ni * lim) / den, ci = (ni * lre - nr * lim) / den;
  u16* BBAR = (u16*)(WS(p) + OFF_BBAR); u16* CM = (u16*)(WS(p) + OFF_CM); float* LB = (float*)(WS(p) + OFF_LAMBAR);
  LB[idx * 2] = lbr; LB[idx * 2 + 1] = lbi;
  for (int c = 0; c < 16; c++) {
    float br = INP(p, 14)[(size_t)idx * 16 + c], bi = INP(p, 15)[(size_t)idx * 16 + c];
    BBAR[(size_t)lrg * 2048 + pp * 16 + c] = f2bf(cr * br - ci * bi);
    BBAR[(size_t)lrg * 2048 + (64 + pp) * 16 + c] = f2bf(cr * bi + ci * br);
    CM[(size_t)lrg * 2048 + c * 128 + pp] = f2bf(INP(p, 16)[(size_t)lrg * 1024 + c * 64 + pp]);
    CM[(size_t)lrg * 2048 + c * 128 + 64 + pp] = f2bf(-INP(p, 17)[(size_t)lrg * 1024 + c * 64 + pp]);
  }
}

DEV void rope_task(const Params& p, int task) {
  int idx = task * 256 + TID(); int t = idx >> 6, d = idx & 63; int f = d & 31;
  float inv = powf(10000.f, -(float)f / 32.f);
  float pos = (d < 32) ? (float)(t >> 6) : (float)(t & 63);
  float ang = pos * inv;
  float* R = (float*)(WS(p) + OFF_ROPE);
  R[idx * 2] = cosf(ang); R[idx * 2 + 1] = sinf(ang);
}

DEV void layer_prep(const Params& p, int l, char* smem) {
  for (int t = BID(); t < 4672 + 160; t += gridDim.x) {
    if (t < 4672) wt_task(p, l, t, (float*)smem);
    else filt_task(p, l, t - 4672, (float*)smem);
  }
}
DEV void phaseA(const Params& p, char* smem) {
  for (int t = BID(); t < 192 + 32 + 256 + 256; t += gridDim.x) {
    if (t < 192) mod_task(p, t, (float*)smem);
    else if (t < 224) s5prep_task(p, t - 192);
    else if (t < 480) rope_task(p, t - 224);
    else { int tt = t - 480; int mi = tt >> 2; transpose_tile(INP(p, 3) + (size_t)mi * 16384, 128, 128, (u16*)(WS(p) + OFF_S0T) + (size_t)mi * 16384, tt & 3, (float*)smem); }
  }
  layer_prep(p, 0, smem);
}

DEV void norm_phase(const Params& p, int l, int which) {
  const int lane = TID() & 63;
  const int wave = (BID() * blockDim.x + TID()) >> 6, nw = (gridDim.x * blockDim.x) >> 6;
  u16* H = (u16*)(WS(p) + OFF_H);
  const float* MOD = (const float*)(WS(p) + OFF_MOD);
  for (int row = wave; row < MT; row += nw) {
    const float* x = (l == 0 && which == 0) ? xin_row(p, row) : OUTP(p) + (size_t)row * 1024;
    float4 v[4]; float ss = 0.f;
#pragma unroll
    for (int i = 0; i < 4; i++) { v[i] = *(const float4*)(x + i * 256 + lane * 4); ss += v[i].x * v[i].x + v[i].y * v[i].y + v[i].z * v[i].z + v[i].w * v[i].w; }
#pragma unroll
    for (int o = 32; o > 0; o >>= 1) ss += __shfl_xor(ss, o, 64);
    float rinv = rsqrtf(ss * (1.f / 1024.f) + 1e-6f);
    if (which == 2) {
      const float* nf = INP(p, 35);
#pragma unroll
      for (int i = 0; i < 4; i++) {
        float4 g = *(const float4*)(nf + i * 256 + lane * 4);
        float4 o; o.x = v[i].x * rinv * g.x; o.y = v[i].y * rinv * g.y; o.z = v[i].z * rinv * g.z; o.w = v[i].w * rinv * g.w;
        *(float4*)(OUTP(p) + (size_t)row * 1024 + i * 256 + lane * 4) = o;
      }
    } else {
      int j = modidx(row);
      const float* nwt = (which == 0 ? INP(p, 8) : INP(p, 9)) + l * 1024;
      const float* msh = MOD + (l * 5 + j) * 6144 + (which ? 3 : 0) * 1024;
      const float* msc = msh + 1024;
      const float* bsh = INP(p, 7) + l * 6144 + (which ? 3 : 0) * 1024;
      const float* bsc = bsh + 1024;
#pragma unroll
      for (int i = 0; i < 4; i++) {
        int k = i * 256 + lane * 4;
        float4 g = *(const float4*)(nwt + k);
        float4 sh = *(const float4*)(msh + k), sc = *(const float4*)(msc + k);
        float4 bh = *(const float4*)(bsh + k), bc = *(const float4*)(bsc + k);
        float o0 = v[i].x * rinv * g.x * (1.f + sc.x + bc.x) + sh.x + bh.x;
        float o1 = v[i].y * rinv * g.y * (1.f + sc.y + bc.y) + sh.y + bh.y;
        float o2 = v[i].z * rinv * g.z * (1.f + sc.z + bc.z) + sh.z + bh.z;
        float o3 = v[i].w * rinv * g.w * (1.f + sc.w + bc.w) + sh.w + bh.w;
        u32x2 pk; pk.x = pack2(o0, o1); pk.y = pack2(o2, o3);
        *(u32x2*)(H + (size_t)row * 1024 + k) = pk;
      }
    }
  }
}

DEV void phaseC(const Params& p, int l, char* smem) {
  u16* sA = (u16*)smem; u16* T = (u16*)smem;
  const u16* H = (const u16*)(WS(p) + OFF_H);
  const u16* WIN = (const u16*)(WS(p) + OFF_WT) + WIN_O;
  u16* ZA = (u16*)(WS(p) + OFF_ZA); u16* HYT = (u16*)(WS(p) + OFF_HYZ); u16* VT = (u16*)(WS(p) + OFF_VT);
  u16* KT = (u16*)(WS(p) + OFF_KT); u16* QR = (u16*)(WS(p) + OFF_QR);
  const float* ROPE = (const float*)(WS(p) + OFF_ROPE);
  const int tid = TID();
  for (int tile = BID(); tile < 48 * 32; tile += gridDim.x) {
    int tm = tile >> 5, tn = tile & 31;
    f32x4 acc[8][4]; zero_acc<8, 4>(acc);
    gemm_loop<8, 4>(H + (size_t)tm * 256 * 1024, 1024, WIN + (size_t)tn * 128 * 1024, 1024, 1024, acc, sA);
    int kind = tn >> 2, hd = tn & 3;
    const int op = kind == 2 ? 1 : (kind == 4 ? 2 : 0);
#pragma unroll
    for (int hh = 0; hh < 2; hh++) {
      int row0 = tm * 256 + hh * 128; bool lat = row0 >= 8192;
      int seq, t0, L;
      if (!lat) { seq = row0 >> 8; t0 = row0 & 255; L = 256; } else { seq = (row0 - 8192) >> 10; t0 = (row0 - 8192) & 1023; L = 1024; }
      __syncthreads();
      if (kind == 3 || kind >= 5) {
        acc_to_lds_T<8>(acc, T, hh * 4, 0);
        __syncthreads();
        u16* dst;
        if (kind == 3) dst = lat ? VT + (size_t)8192 * 512 + (size_t)((seq * 4 + hd) * 128) * 1024 + t0 : VT + (size_t)((seq * 4 + hd) * 128) * 256 + t0;
        else dst = lat ? HYT + (size_t)8192 * 1536 + ((size_t)seq * 1536 + (tn - 20) * 128) * 1024 + t0 : HYT + ((size_t)seq * 1536 + (tn - 20) * 128) * 256 + t0;
        copy_tile<128, 136>(T, dst, L);
      } else {
        acc_to_lds<8, 4, 136>(acc, T, hh * 4, op);
        __syncthreads();
        bool roped = lat && (kind == 1 || kind == 2);
        if (!(lat && kind == 2)) {
          u16* dst;
          if (kind == 0) dst = ZA + (size_t)row0 * 2048 + hd * 128;
          else if (kind == 1) dst = ZA + (size_t)row0 * 2048 + 512 + hd * 128;
          else if (kind == 2) dst = ZA + (size_t)row0 * 2048 + 1024 + hd * 128;
          else dst = ZA + (size_t)row0 * 2048 + 1536 + hd * 128;
          copy_tile<128, 136>(T, dst, 2048);
        }
        if (roped) {
          u16* dst; int ld;
          if (kind == 1) { dst = QR + (size_t)(row0 - 8192) * 512 + hd * 128; ld = 512; }
          else { dst = ZA + (size_t)row0 * 2048 + 1024 + hd * 128; ld = 2048; }
#pragma unroll 1
          for (int i = 0; i < 4; i++) {
            int id = tid + i * 256; int r = id >> 3, ch = id & 7;
            u32x4 a = *(const u32x4*)(T + r * 136 + ch * 8);
            u32x4 b = *(const u32x4*)(T + r * 136 + 64 + ch * 8);
            const float4* cs = (const float4*)(ROPE + ((size_t)(t0 + r) * 64 + ch * 8) * 2);
            u32x4 o1, o2;
#pragma unroll
            for (int q = 0; q < 4; q++) {
              float4 c4 = cs[q];
              float x1a = __uint_as_float(a[q] << 16), x1b = __uint_as_float(a[q] & 0xffff0000u);
              float x2a = __uint_as_float(b[q] << 16), x2b = __uint_as_float(b[q] & 0xffff0000u);
              o1[q] = pack2(x1a * c4.x - x2a * c4.y, x1b * c4.z - x2b * c4.w);
              o2[q] = pack2(x1a * c4.y + x2a * c4.x, x1b * c4.w + x2b * c4.z);
            }
            *(u32x4*)(dst + (size_t)r * ld + ch * 8) = o1;
            *(u32x4*)(dst + (size_t)r * ld + 64 + ch * 8) = o2;
          }
        }
        if (kind == 2 && !lat) {
          __syncthreads();
          acc_to_lds_T<8>(acc, T, hh * 4, op);
          __syncthreads();
          copy_tile<128, 136>(T, KT + (size_t)((seq * 4 + hd) * 128) * 256 + t0, 256);
        }
      }
    }
  }
}

DEV void s5_task(const Params& p, int l, int task, char* smem) {
  const int tid = TID(), lane = tid & 63, wid = tid >> 6, fr = lane & 15, fq = lane >> 4;
  int seq, gp;
  if (task < 64) { seq = 32 + (task >> 4); gp = task & 15; } else { int t2 = task - 64; seq = t2 >> 4; gp = t2 & 15; }
  const bool lat = seq >= 32;
  const int L = lat ? 1024 : 256;
  const int row0 = lat ? 8192 + (seq - 32) * 1024 : seq * 256;
  const int grp = gp * 2 + (wid >> 1), dir = wid & 1;
  const int lrg = (l * 2 + dir) * 32 + grp;
  float* BU = (float*)(smem + wid * 12544);
  u16* HB = (u16*)(smem + wid * 12544 + 8192);
  u16* ZA = (u16*)(WS(p) + OFF_ZA);
  float* YP = (float*)(WS(p) + OFF_YP);
  const u16* BBAR = (const u16*)(WS(p) + OFF_BBAR) + (size_t)lrg * 2048;
  const u16* CM = (const u16*)(WS(p) + OFF_CM) + (size_t)lrg * 2048;
  const float* LB = (const float*)(WS(p) + OFF_LAMBAR) + ((size_t)lrg * 64 + lane) * 2;
  const float lr = LB[0], li = LB[1];
  bf16x8 bfrag[8], cfrag[4];
  const bf16x8 zero8 = {0, 0, 0, 0, 0, 0, 0, 0};
#pragma unroll
  for (int nt = 0; nt < 8; nt++) bfrag[nt] = (fq < 2) ? *(const bf16x8*)(BBAR + (nt * 16 + fr) * 16 + fq * 8) : zero8;
#pragma unroll
  for (int ks = 0; ks < 4; ks++) cfrag[ks] = *(const bf16x8*)(CM + fr * 128 + ks * 32 + fq * 8);
  float hr = 0.f, hi = 0.f;
  if (lat) {
    const float* s0 = INP(p, 2) + ((((size_t)(seq - 32) * 2 + l) * 2 + dir) * 32 + grp) * 128 + lane * 2;
    hr = s0[0]; hi = s0[1];
  }
  const float dcoef = INP(p, 18)[l * 512 + grp * 16 + fr];
  const int nch = L >> 4;
  __syncthreads();
  const int half = nch >> 1;
  bf16x8 ua_next = (fq < 2) ? *(const bf16x8*)(ZA + (size_t)(row0 + (dir ? nch - 1 : 0) * 16 + fr) * 2048 + grp * 16 + fq * 8) : zero8;
  const int tbase = dir ? 15 : 0, tstep = dir ? -1 : 1;
  for (int i = 0; i < nch; i++) {
    const int ci = dir ? nch - 1 - i : i; const int t0 = ci * 16;
    if (i == half) { asm volatile("s_waitcnt vmcnt(0)" ::: "memory"); __threadfence(); asm volatile("s_waitcnt vmcnt(0)" ::: "memory"); __syncthreads(); }
    const bf16x8 ua = ua_next;
    if (i + 1 < nch) {
      const int cn = dir ? nch - 2 - i : i + 1;
      ua_next = (fq < 2) ? *(const bf16x8*)(ZA + (size_t)(row0 + cn * 16 + fr) * 2048 + grp * 16 + fq * 8) : zero8;
    }
#pragma unroll
    for (int nt = 0; nt < 8; nt++) {
      f32x4 r = __builtin_amdgcn_mfma_f32_16x16x32_bf16(ua, bfrag[nt], f32x4{0.f, 0.f, 0.f, 0.f}, 0, 0, 0);
#pragma unroll
      for (int j = 0; j < 4; j++) BU[(fq * 4 + j) * 128 + nt * 16 + fr] = r[j];
    }
    asm volatile("s_waitcnt lgkmcnt(0)" ::: "memory");
#pragma unroll
    for (int tt = 0; tt < 16; tt++) {
      const int t = tbase + tstep * tt;
      float re = BU[t * 128 + lane], im = BU[t * 128 + 64 + lane];
      float nr = lr * hr - li * hi + re; float ni = lr * hi + li * hr + im;
      hr = nr; hi = ni;
      HB[t * 136 + lane] = f2bf(hr); HB[t * 136 + 64 + lane] = f2bf(hi);
    }
    asm volatile("s_waitcnt lgkmcnt(0)" ::: "memory");
    f32x4 y = {0.f, 0.f, 0.f, 0.f};
#pragma unroll
    for (int ks = 0; ks < 4; ks++) {
      bf16x8 a = *(const bf16x8*)(HB + fr * 136 + ks * 32 + fq * 8);
      y = __builtin_amdgcn_mfma_f32_16x16x32_bf16(a, cfrag[ks], y, 0, 0, 0);
    }
    asm volatile("s_waitcnt lgkmcnt(0)" ::: "memory");
    if (i < half) {
#pragma unroll
      for (int j = 0; j < 4; j++) YP[(size_t)(row0 + t0 + fq * 4 + j) * 512 + grp * 16 + fr] = y[j];
    } else {
#pragma unroll
      for (int j = 0; j < 4; j++) {
        size_t row = (size_t)(row0 + t0 + fq * 4 + j);
        float other = __hip_atomic_load(&YP[row * 512 + grp * 16 + fr], __ATOMIC_RELAXED, __HIP_MEMORY_SCOPE_AGENT);
        u16* up = ZA + row * 2048 + grp * 16 + fr;
        float v = y[j] + other + dcoef * bf2f(*up);
        *up = f2bf(gelu_(v));
      }
    }
  }
  if (!lat) {
    float* o = OUTP(p) + 12582912 + ((((size_t)seq * 2 + l) * 2 + dir) * 32 + grp) * 128 + lane * 2;
    o[0] = hr; o[1] = hi;
  }
}

DEV void ret_task(const Params& p, int l, int task, char* smem) {
  const int tid = TID(), lane = tid & 63, wid = tid >> 6, fr = lane & 15, fq = lane >> 4;
  int seq, h, qt; bool lat;
  if (task < 256) { lat = true; seq = task >> 6; h = (task >> 4) & 3; qt = task & 15; }
  else { int t2 = task - 256; lat = false; seq = t2 >> 4; h = (t2 >> 2) & 3; qt = t2 & 3; }
  const int L = lat ? 1024 : 256;
  const int row0 = lat ? 8192 + seq * 1024 : seq * 256;
  u16* sK = (u16*)smem; u16* sV = sK + 64 * 136; u16* sP = sV + 128 * 72 + wid * 16 * 72;
  u16* ZA = (u16*)(WS(p) + OFF_ZA);
  const u16* QR = (const u16*)(WS(p) + OFF_QR);
  const u16* VT = (const u16*)(WS(p) + OFF_VT);
  const float lgf = log1pf(-expf(INP(p, 20)[(l * 2 + 0) * 4 + h])), lgb = log1pf(-expf(INP(p, 20)[(l * 2 + 1) * 4 + h]));
  const int qrow = qt * 64 + wid * 16;
  const u16* qsrc = lat ? QR + (size_t)(row0 - 8192 + qrow + fr) * 512 + h * 128 : ZA + (size_t)(row0 + qrow + fr) * 2048 + 512 + h * 128;
  bf16x8 qa[4];
#pragma unroll
  for (int ks = 0; ks < 4; ks++) qa[ks] = *(const bf16x8*)(qsrc + ks * 32 + fq * 8);
  f32x4 o[8];
#pragma unroll
  for (int n = 0; n < 8; n++) o[n] = f32x4{0.f, 0.f, 0.f, 0.f};
  const u16* Kbase = ZA + (size_t)row0 * 2048 + 1024 + h * 128;
  const u16* Vbase = lat ? VT + (size_t)8192 * 512 + (size_t)((seq * 4 + h) * 128) * 1024 : VT + (size_t)((seq * 4 + h) * 128) * 256;
  const int nkt = L >> 6;
  for (int jt = 0; jt < nkt; jt++) {
    __syncthreads();
#pragma unroll
    for (int i = 0; i < 4; i++) {
      int id = tid + i * 256; int r = id >> 4, ch = id & 15;
      *(u32x4*)(sK + r * 136 + ch * 8) = *(const u32x4*)(Kbase + (size_t)(jt * 64 + r) * 2048 + ch * 8);
    }
#pragma unroll
    for (int i = 0; i < 4; i++) {
      int id = tid + i * 256; int e = id >> 3, ch = id & 7;
      *(u32x4*)(sV + e * 72 + ch * 8) = *(const u32x4*)(Vbase + (size_t)e * L + jt * 64 + ch * 8);
    }
    __syncthreads();
    f32x4 s[4];
#pragma unroll
    for (int nt = 0; nt < 4; nt++) {
      s[nt] = f32x4{0.f, 0.f, 0.f, 0.f};
#pragma unroll
      for (int ks = 0; ks < 4; ks++) {
        bf16x8 b = *(const bf16x8*)(sK + (nt * 16 + fr) * 136 + ks * 32 + fq * 8);
        s[nt] = __builtin_amdgcn_mfma_f32_16x16x32_bf16(qa[ks], b, s[nt], 0, 0, 0);
      }
      asm volatile("" ::: "memory");
    }
#pragma unroll
    for (int nt = 0; nt < 4; nt++)
#pragma unroll
      for (int j = 0; j < 4; j++) {
        int d = (qrow + fq * 4 + j) - (jt * 64 + nt * 16 + fr);
        float w = d >= 0 ? __expf(lgf * (float)d) : __expf(lgb * (float)(-d));
        sP[(fq * 4 + j) * 72 + nt * 16 + fr] = f2bf(s[nt][j] * w);
      }
    asm volatile("s_waitcnt lgkmcnt(0)" ::: "memory");
#pragma unroll
    for (int k2 = 0; k2 < 2; k2++) {
      bf16x8 a = *(const bf16x8*)(sP + fr * 72 + k2 * 32 + fq * 8);
#pragma unroll
      for (int n2 = 0; n2 < 8; n2++) {
        bf16x8 b = *(const bf16x8*)(sV + (n2 * 16 + fr) * 72 + k2 * 32 + fq * 8);
        o[n2] = __builtin_amdgcn_mfma_f32_16x16x32_bf16(a, b, o[n2], 0, 0, 0);
        if (n2 == 3) asm volatile("" ::: "memory");
      }
      asm volatile("" ::: "memory");
    }
    asm volatile("s_waitcnt lgkmcnt(0)" ::: "memory");
  }
  if (lat) {
    const u16* q0src = ZA + (size_t)(row0 + qrow + fr) * 2048 + 512 + h * 128;
    bf16x8 q0[4];
#pragma unroll
    for (int ks = 0; ks < 4; ks++) q0[ks] = *(const bf16x8*)(q0src + ks * 32 + fq * 8);
#pragma unroll 1
    for (int dir = 0; dir < 2; dir++) {
      const u16* S0 = (const u16*)(WS(p) + OFF_S0T) + (size_t)((((seq * 2 + l) * 2 + dir) * 4 + h)) * 16384;
      float wj[4];
#pragma unroll
      for (int j = 0; j < 4; j++) { int gi = qrow + fq * 4 + j; wj[j] = dir == 0 ? __expf(lgf * (float)(gi + 1)) : __expf(lgb * (float)(L - 1 - gi)); }
#pragma unroll
      for (int n2 = 0; n2 < 8; n2++) {
        f32x4 tmp = {0.f, 0.f, 0.f, 0.f};
#pragma unroll
        for (int ks = 0; ks < 4; ks++) {
          bf16x8 b = *(const bf16x8*)(S0 + (size_t)(n2 * 16 + fr) * 128 + ks * 32 + fq * 8);
          tmp = __builtin_amdgcn_mfma_f32_16x16x32_bf16(q0[ks], b, tmp, 0, 0, 0);
        }
#pragma unroll
        for (int j = 0; j < 4; j++) o[n2][j] += wj[j] * tmp[j];
        asm volatile("" ::: "memory");
      }
    }
  }
#pragma unroll
  for (int j = 0; j < 4; j++) {
    float s = 0.f;
#pragma unroll
    for (int n2 = 0; n2 < 8; n2++) s += o[n2][j];
    s += __shfl_xor(s, 1, 64); s += __shfl_xor(s, 2, 64); s += __shfl_xor(s, 4, 64); s += __shfl_xor(s, 8, 64);
    float mean = s * (1.f / 128.f);
    float v = 0.f;
#pragma unroll
    for (int n2 = 0; n2 < 8; n2++) { float dd = o[n2][j] - mean; v += dd * dd; }
    v += __shfl_xor(v, 1, 64); v += __shfl_xor(v, 2, 64); v += __shfl_xor(v, 4, 64); v += __shfl_xor(v, 8, 64);
    float rstd = rsqrtf(v * (1.f / 128.f) + 1e-5f);
    size_t rbase = (size_t)(row0 + qrow + fq * 4 + j) * 2048;
#pragma unroll
    for (int n2 = 0; n2 < 8; n2++) {
      int e = n2 * 16 + fr;
      float gv = bf2f(ZA[rbase + 1536 + h * 128 + e]);
      ZA[rbase + 512 + h * 128 + e] = f2bf((o[n2][j] - mean) * rstd * gv);
    }
  }
}

DEV bf16x8 scale8(u32x4 raw, const float (&w)[8]) {
  union { u32x4 u; bf16x8 v; } r;
#pragma unroll
  for (int q = 0; q < 4; q++) {
    float a = __uint_as_float(raw[q] << 16) * w[q * 2], b = __uint_as_float(raw[q] & 0xffff0000u) * w[q * 2 + 1];
    r.u[q] = pack2(a, b);
  }
  return r.v;
}

DEV void retstate_task(const Params& p, int l, int task) {
  const int tid = TID(), lane = tid & 63, wid = tid >> 6, fr = lane & 15, fq = lane >> 4;
  int seq = task >> 3, h = (task >> 1) & 3, dir = task & 1;
  const u16* KT = (const u16*)(WS(p) + OFF_KT) + (size_t)((seq * 4 + h) * 128) * 256;
  const u16* VT = (const u16*)(WS(p) + OFF_VT) + (size_t)((seq * 4 + h) * 128) * 256;
  const float lg = log1pf(-expf(INP(p, 20)[(l * 2 + dir) * 4 + h]));
  f32x4 acc[2][8];
#pragma unroll
  for (int m = 0; m < 2; m++)
#pragma unroll
    for (int n = 0; n < 8; n++) acc[m][n] = f32x4{0.f, 0.f, 0.f, 0.f};
#pragma unroll 1
  for (int ks = 0; ks < 8; ks++) {
    float w[8];
#pragma unroll
    for (int jj = 0; jj < 8; jj++) { int j = ks * 32 + fq * 8 + jj; w[jj] = __expf(lg * (float)(dir == 0 ? 255 - j : j)); }
    bf16x8 a[2];
#pragma unroll
    for (int m = 0; m < 2; m++) a[m] = scale8(*(const u32x4*)(KT + (size_t)(wid * 32 + m * 16 + fr) * 256 + ks * 32 + fq * 8), w);
#pragma unroll
    for (int n = 0; n < 8; n++) {
      bf16x8 b = *(const bf16x8*)(VT + (size_t)(n * 16 + fr) * 256 + ks * 32 + fq * 8);
#pragma unroll
      for (int m = 0; m < 2; m++) acc[m][n] = __builtin_amdgcn_mfma_f32_16x16x32_bf16(a[m], b, acc[m][n], 0, 0, 0);
    }
  }
  float* o = OUTP(p) + 13107200 + ((((size_t)seq * 2 + l) * 2 + dir) * 4 + h) * 16384;
#pragma unroll
  for (int m = 0; m < 2; m++)
#pragma unroll
    for (int n = 0; n < 8; n++)
#pragma unroll
      for (int j = 0; j < 4; j++) o[(size_t)(wid * 32 + m * 16 + fq * 4 + j) * 128 + n * 16 + fr] = acc[m][n][j];
}

template <bool LAT>
DEV void hyena_mfma(const Params& p, int l, int task, char* smem) {
  constexpr int L = LAT ? 1024 : 256;
  constexpr int NV = LAT ? 4 : 16;
  constexpr int RS = L + 8, CS = 2 * L + 16;
  constexpr int MPW = L / 64, NKS = L / 32, NCH = L / 8, Lsel = LAT ? 1 : 0;
  const int tid = TID(), lane = tid & 63, wid = tid >> 6, fr = lane & 15, fq = lane >> 4;
  const int c = LAT ? task : (task >> 1);
  const int sg = LAT ? 0 : (task & 1);
  u16* CP = (u16*)smem; u16* XV = CP + 8 * CS; u16* GS = XV + NV * RS; u16* O1 = GS + NV * RS;
  const u16* HYT = (const u16*)(WS(p) + OFF_HYZ);
  u16* HYOT = (u16*)(WS(p) + OFF_OUT1) + (size_t)MT * 512;
  const float* cw = INP(p, 22) + (size_t)l * 3 * 1536; const float* cb = INP(p, 23) + l * 1536;
  auto sconv = [&](int arr, u16* dstA) {
    const int ch = arr * 512 + c;
    const float w0 = cw[ch], w1 = cw[1536 + ch], w2 = cw[3072 + ch], bb = cb[ch];
#pragma unroll
    for (int i = 0; i < (NV * NCH) / 256; i++) {
      int id = tid + i * 256; int n = id / NCH, t8 = (id % NCH) * 8;
      const u16* src = LAT ? HYT + (size_t)8192 * 1536 + ((size_t)n * 1536 + ch) * 1024 + t8 : HYT + ((size_t)(sg * 16 + n) * 1536 + ch) * 256 + t8;
      u32x4 raw = *(const u32x4*)src;
      float h[10];
      h[0] = t8 > 0 ? bf2f(src[-1]) : 0.f;
      h[9] = t8 + 8 < L ? bf2f(src[8]) : 0.f;
#pragma unroll
      for (int q = 0; q < 4; q++) { h[1 + 2 * q] = __uint_as_float(raw[q] << 16); h[2 + 2 * q] = __uint_as_float(raw[q] & 0xffff0000u); }
      u32x4 o;
#pragma unroll
      for (int q = 0; q < 4; q++) o[q] = pack2(w0 * h[2 * q] + w1 * h[2 * q + 1] + w2 * h[2 * q + 2] + bb, w0 * h[2 * q + 1] + w1 * h[2 * q + 2] + w2 * h[2 * q + 3] + bb);
      *(u32x4*)(dstA + n * RS + t8) = o;
    }
  };
  __syncthreads();
  sconv(0, GS);
  sconv(2, XV);
  const int rr = (-fr) & 7;
  const u16* cpl = CP + rr * CS + (L + 8 * fq - fr - rr);
#pragma unroll 1
  for (int o = 0; o < 2; o++) {
    if (o == 1) sconv(1, GS);
    u16* FL = o == 0 ? O1 : XV;
    const float* Gp = (const float*)(WS(p) + OFF_G) + (Lsel ? 524288 : 0) + (size_t)o * (2 * L) * 512 + c;
    if (tid < 2 * L / 8) {
      float f[8];
#pragma unroll
      for (int j = 0; j < 8; j++) { int u = tid * 8 + j; f[j] = u > 0 ? Gp[(size_t)(2 * L - u) * 512] : 0.f; }
      u32x4 v; v[0] = pack2(f[0], f[1]); v[1] = pack2(f[2], f[3]); v[2] = pack2(f[4], f[5]); v[3] = pack2(f[6], f[7]);
      *(u32x4*)(FL + tid * 8) = v;
    }
    if (tid < 2) *(u32x4*)(FL + 2 * L + tid * 8) = u32x4{0u, 0u, 0u, 0u};
    __syncthreads();
    if (tid < 2 * L / 8) {
      u32x4 a = *(const u32x4*)(FL + tid * 8), b = *(const u32x4*)(FL + tid * 8 + 8);
      unsigned d[8] = {a[0], a[1], a[2], a[3], b[0], b[1], b[2], b[3]};
#pragma unroll
      for (int r = 0; r < 8; r++) {
        u32x4 ov;
#pragma unroll
        for (int q = 0; q < 4; q++) ov[q] = (r & 1) ? ((d[q + (r >> 1)] >> 16) | (d[q + (r >> 1) + 1] << 16)) : d[q + (r >> 1)];
        *(u32x4*)(CP + r * CS + tid * 8) = ov;
      }
    }
    __syncthreads();
    float rn;
    {
      constexpr int NTB = LAT ? 128 : 32;
      const float* SP = (const float*)(WS(p) + WS_END) + ((size_t)l * 160 + (LAT ? 32 : 0)) * 2048 + o * 512 + c;
      float ssum = 0.f;
      for (int tb = lane; tb < NTB; tb += 64) ssum += SP[(size_t)tb * 2048] + SP[(size_t)tb * 2048 + 1024];
#pragma unroll
      for (int off = 32; off > 0; off >>= 1) ssum += __shfl_xor(ssum, off, 64);
      rn = rsqrtf(ssum + 1e-6f);
    }
    const float bias = INP(p, 30)[(l * 2 + o) * 512 + c];
    const u16* Xs = o == 0 ? XV : O1;
    f32x4 acc[MPW];
#pragma unroll
    for (int mi = 0; mi < MPW; mi++) acc[mi] = f32x4{0.f, 0.f, 0.f, 0.f};
    const bf16x8 zero8 = {0, 0, 0, 0, 0, 0, 0, 0};
#pragma unroll 2
    for (int ks = 0; ks < NKS; ks++) {
      bf16x8 b = (fr < NV) ? *(const bf16x8*)(Xs + fr * RS + ks * 32 + fq * 8) : zero8;
#pragma unroll
      for (int mi = 0; mi < MPW; mi++) {
        bf16x8 a = *(const bf16x8*)(cpl - 16 * (wid * MPW + mi) + 32 * ks);
        acc[mi] = __builtin_amdgcn_mfma_f32_16x16x32_bf16(a, b, acc[mi], 0, 0, 0);
      }
    }
    if (fr < NV) {
      const u16* gate = GS;
      const u16* vin = o == 0 ? XV : O1;
#pragma unroll
      for (int mi = 0; mi < MPW; mi++) {
        const int t0 = (wid * MPW + mi) * 16 + fq * 4;
        u32x2 gq = *(const u32x2*)(gate + fr * RS + t0), vq = *(const u32x2*)(vin + fr * RS + t0);
        float g4[4] = {__uint_as_float(gq[0] << 16), __uint_as_float(gq[0] & 0xffff0000u), __uint_as_float(gq[1] << 16), __uint_as_float(gq[1] & 0xffff0000u)};
        float v4[4] = {__uint_as_float(vq[0] << 16), __uint_as_float(vq[0] & 0xffff0000u), __uint_as_float(vq[1] << 16), __uint_as_float(vq[1] & 0xffff0000u)};
        float r4[4];
#pragma unroll
        for (int j = 0; j < 4; j++) r4[j] = g4[j] * (acc[mi][j] * rn + bias * v4[j]);
        if (o == 0) {
          u32x2 ov; ov[0] = pack2(r4[0], r4[1]); ov[1] = pack2(r4[2], r4[3]);
          *(u32x2*)(O1 + fr * RS + t0) = ov;
        } else {
          u16* dst = LAT ? HYOT + (size_t)8192 * 512 + ((size_t)fr * 512 + c) * 1024 + t0 : HYOT + ((size_t)(sg * 16 + fr) * 512 + c) * 256 + t0;
          u32x2 ov; ov[0] = pack2(r4[0], r4[1]); ov[1] = pack2(r4[2], r4[3]);
          *(u32x2*)dst = ov;
        }
      }
    }
    __syncthreads();
  }
}

DEV void phaseD(const Params& p, int l, char* smem) {
  const int nbt = gridDim.x, bt = BID();
  const bool ded = nbt >= 128;
  const bool s5only = ded && bt < 64;
  const int nb = ded ? nbt - 64 : nbt, b = ded ? bt - 64 : bt;
  const int BIG = 1 << 28;
#pragma unroll 1
  for (int t = s5only ? BIG : b; t < 512; t += nb) hyena_mfma<true>(p, l, t, smem);
#pragma unroll 1
  for (int t = s5only ? BIG : (b + nb - (512 % nb)) % nb; t < 768; t += nb) ret_task(p, l, t, smem);
  {
    int st, step, lo;
    if (s5only) { st = bt; step = BIG; }
    else { lo = ded ? 64 : 0; st = lo + (b + 2 * nb - ((512 + 768) % nb)) % nb; step = nb; }
#pragma unroll 1
    for (int t = st; t < 576; t += step) s5_task(p, l, t, smem);
  }
#pragma unroll 1
  for (int t = s5only ? BIG : (b + 3 * nb - ((512 + 768 + 576) % nb)) % nb; t < 1024; t += nb) hyena_mfma<false>(p, l, t, smem);
#pragma unroll 1
  for (int t = s5only ? BIG : (b + 4 * nb - ((512 + 768 + 576 + 1024) % nb)) % nb; t < 256; t += nb) retstate_task(p, l, t);
}

DEV void phaseE(const Params& p, char* smem) {
  const u16* HYOT = (const u16*)(WS(p) + OFF_OUT1) + (size_t)MT * 512;
  u16* HYO = (u16*)(WS(p) + OFF_OUT1);
  u16* sm = (u16*)smem;
  const int tx = TID() & 63, ty = TID() >> 6;
  for (int tile = BID(); tile < 192 * 8; tile += gridDim.x) {
    int rt = tile >> 3, c0 = (tile & 7) * 64; int row0 = rt * 64;
    const u16* src = row0 < 8192 ? HYOT + ((size_t)(row0 >> 8) * 512 + c0) * 256 + (row0 & 255)
                                 : HYOT + (size_t)8192 * 512 + ((size_t)((row0 - 8192) >> 10) * 512 + c0) * 1024 + ((row0 - 8192) & 1023);
    const int L = row0 < 8192 ? 256 : 1024;
    __syncthreads();
#pragma unroll
    for (int i = 0; i < 16; i++) { int cc = ty + i * 4; sm[cc * 66 + tx] = src[(size_t)cc * L + tx]; }
    __syncthreads();
#pragma unroll
    for (int i = 0; i < 16; i++) { int tt = ty + i * 4; HYO[(size_t)(row0 + tt) * 512 + c0 + tx] = sm[tx * 66 + tt]; }
  }
}

DEV void phaseF(const Params& p, int l, char* smem) {
  u16* sA = (u16*)smem; u16* T = (u16*)smem;
  const u16* H = (const u16*)(WS(p) + OFF_H);
  const u16* WT = (const u16*)(WS(p) + OFF_WT);
  const u16* ZA = (const u16*)(WS(p) + OFF_ZA); const u16* HYO = (const u16*)(WS(p) + OFF_OUT1);
  u16* MG = (u16*)(WS(p) + OFF_YP);
  for (int tile = BID(); tile < 96 * 16; tile += gridDim.x) {
    int tm = tile >> 4, tn = tile & 15; int row0 = tm * 128, n0 = tn * 64;
    f32x4 a1[4][2], a2[4][2], tt[4][2];
    const u16* Hrow = H + (size_t)row0 * 1024;
    zero_acc<4, 2>(a1); zero_acc<4, 2>(tt);
#pragma unroll 1
    for (int ps = 0; ps < 7; ps++) {
      const u16* Ap; const u16* Bp; int lda, K;
      switch (ps) {
        case 0: Ap = ZA + (size_t)row0 * 2048; lda = 2048; Bp = WT + WGLU_O + (size_t)n0 * 512; K = 512; break;
        case 1: Ap = ZA + (size_t)row0 * 2048; lda = 2048; Bp = WT + WGLU_O + (size_t)(1024 + n0) * 512; K = 512; break;
        case 3: Ap = ZA + (size_t)row0 * 2048 + 512; lda = 2048; Bp = WT + WRETO_O + (size_t)n0 * 512; K = 512; break;
        case 5: Ap = HYO + (size_t)row0 * 512; lda = 512; Bp = WT + WHYO_O + (size_t)n0 * 512; K = 512; break;
        default: Ap = Hrow; lda = 1024; Bp = WT + WIN_O + (size_t)(4096 + ((ps - 2) >> 1) * 1024 + n0) * 1024; K = 1024; break;
      }
      zero_acc<4, 2>(a2);
      gemm_loop<4, 2>(Ap, lda, Bp, K, K, a2, sA);
      if (ps == 0 || ps == 3 || ps == 5) {
#pragma unroll
        for (int m = 0; m < 4; m++)
#pragma unroll
          for (int n = 0; n < 2; n++) a1[m][n] = a2[m][n];
      } else if (ps == 1) {
#pragma unroll
        for (int m = 0; m < 4; m++)
#pragma unroll
          for (int n = 0; n < 2; n++)
#pragma unroll
            for (int j = 0; j < 4; j++) a1[m][n][j] *= sigm(a2[m][n][j]);
      } else {
#pragma unroll
        for (int m = 0; m < 4; m++)
#pragma unroll
          for (int n = 0; n < 2; n++)
#pragma unroll
            for (int j = 0; j < 4; j++) tt[m][n][j] += a1[m][n][j] * sigm(a2[m][n][j]);
      }
    }
    __syncthreads();
    acc_to_lds<4, 2, 72>(tt, T, 0);
    __syncthreads();
    copy_tile<64, 72>(T, MG + (size_t)row0 * 1024 + n0, 1024);
  }
}

template <int MF, int NF>
DEV void resid_store(const Params& p, const f32x4 (&acc)[MF][NF], int l, int chunk, int row0, int col0, bool from_input) {
  const int tid = TID(), lane = tid & 63, wid = tid >> 6, wr = wid >> 1, wc = wid & 1, fr = lane & 15, fq = lane >> 4;
  float* out = OUTP(p);
#pragma unroll
  for (int m = 0; m < MF; m++) {
    const int rb = row0 + m * 32 + wr * 16 + fq * 4;
    const int j = modidx(rb);
    const float* MOD = (const float*)(WS(p) + OFF_MOD) + (l * 5 + j) * 6144 + chunk * 1024;
    const float* BM = INP(p, 7) + l * 6144 + chunk * 1024;
#pragma unroll
    for (int n = 0; n < NF; n++) {
      int col = col0 + wc * (NF * 16) + n * 16 + fr;
      float g = MOD[col] + BM[col];
#pragma unroll
      for (int jj = 0; jj < 4; jj++) {
        int row = rb + jj;
        float xo = from_input ? xin_row(p, row)[col] : out[(size_t)row * 1024 + col];
        out[(size_t)row * 1024 + col] = xo + g * acc[m][n][jj];
      }
    }
  }
}

DEV void phaseG(const Params& p, int l, char* smem) {
  u16* sA = (u16*)smem;
  const u16* MG = (const u16*)(WS(p) + OFF_YP);
  const u16* W = (const u16*)(WS(p) + OFF_WT) + WOUT_O;
  for (int tile = BID(); tile < 64 * 8; tile += gridDim.x) {
    int tm = tile >> 3, tn = tile & 7;
    f32x4 acc[6][4]; zero_acc<6, 4>(acc);
    gemm_loop<6, 4>(MG + (size_t)tm * 192 * 1024, 1024, W + (size_t)tn * 128 * 1024, 1024, 1024, acc, sA);
    resid_store<6, 4>(p, acc, l, 2, tm * 192, tn * 128, l == 0);
  }
}

DEV void phaseI(const Params& p, int l, char* smem) {
  u16* sA = (u16*)smem; u16* T = (u16*)smem;
  const u16* H = (const u16*)(WS(p) + OFF_H);
  const u16* W = (const u16*)(WS(p) + OFF_WT) + WFIN_O;
  u16* ACT = (u16*)(WS(p) + OFF_ZA);
  for (int tile = BID(); tile < 48 * 44; tile += gridDim.x) {
    int tm = tile / 44, tn = tile % 44;
    f32x4 acc[8][4]; zero_acc<8, 4>(acc);
    gemm_loop<8, 4>(H + (size_t)tm * 256 * 1024, 1024, W + (size_t)tn * 128 * 1024, 1024, 1024, acc, sA);
    const int tid = TID(), lane = tid & 63, wid = tid >> 6, wr = wid >> 1, wc = wid & 1, fr = lane & 15, fq = lane >> 4;
#pragma unroll
    for (int hh = 0; hh < 2; hh++) {
      __syncthreads();
#pragma unroll
      for (int m = 0; m < 4; m++)
#pragma unroll
        for (int n = 0; n < 2; n++)
#pragma unroll
          for (int j = 0; j < 4; j++)
            T[(m * 32 + wr * 16 + fq * 4 + j) * 72 + wc * 32 + n * 16 + fr] = f2bf(silu_(acc[hh * 4 + m][2 * n][j]) * acc[hh * 4 + m][2 * n + 1][j]);
      __syncthreads();
      copy_tile<64, 72>(T, ACT + (size_t)(tm * 256 + hh * 128) * 2816 + tn * 64, 2816);
    }
  }
}

DEV void phaseJ(const Params& p, int l, char* smem) {
  u16* sA = (u16*)smem;
  const u16* ACT = (const u16*)(WS(p) + OFF_ZA);
  const u16* W = (const u16*)(WS(p) + OFF_WT) + WFOUT_O;
  for (int tile = BID(); tile < 64 * 8; tile += gridDim.x) {
    int tm = tile >> 3, tn = tile & 7;
    f32x4 acc[6][4]; zero_acc<6, 4>(acc);
    gemm_loop<6, 4>(ACT + (size_t)tm * 192 * 2816, 2816, W + (size_t)tn * 128 * 2816, 2816, 2816, acc, sA);
    resid_store<6, 4>(p, acc, l, 5, tm * 192, tn * 128, false);
  }
}


#define XB_TMO      128
#define XB_XCNT(j)  (256  + 64 * (j))
#define XB_XSUB(j)  (1280 + 64 * (j))
#define XB_XGEN(j)  (2304 + 64 * (j))
#define XB_TOP      3328
#define XB_TOPGEN   3392
#define XB_SPIN_CAP (1u << 22)
#define LAS __attribute__((address_space(3)))
DEV unsigned xb_ld(unsigned* p) { return __hip_atomic_load(p, __ATOMIC_RELAXED, __HIP_MEMORY_SCOPE_AGENT); }
DEV unsigned xb_add(unsigned* p, unsigned v) { return __hip_atomic_fetch_add(p, v, __ATOMIC_RELAXED, __HIP_MEMORY_SCOPE_AGENT); }
DEV unsigned xb_xcc_id() { return (unsigned)__builtin_amdgcn_s_getreg((3 << 11) | 20) & 0xFu; }
#define XB_SPIN(cond, bar) do { unsigned _sp = 0; while (cond) { __builtin_amdgcn_s_sleep(1); \
    if ((++_sp & 255u) == 0u) { if (xb_ld(&(bar)[XB_TMO])) break; if (_sp > XB_SPIN_CAP) { atomicAdd(&(bar)[XB_TMO], 1u); break; } } } } while (0)
struct XcdBarrier { unsigned* bar; unsigned x; volatile LAS unsigned* st; };
DEV XcdBarrier xcd_barrier_post(unsigned* bar, volatile LAS unsigned* st) {
  XcdBarrier b; b.bar = bar; b.x = xb_xcc_id(); b.st = st;
  if (threadIdx.x == 0) (void)xb_add(&bar[XB_XCNT(b.x)], 1u);
  return b;
}
DEV void xcd_barrier_complete(unsigned* bar, unsigned x, unsigned& nloc, unsigned& nx) {
  const unsigned G = gridDim.x * gridDim.y * gridDim.z;
  unsigned sum, cnt, mine, sp = 0u;
  for (;;) {
    sum = 0u; cnt = 0u; mine = 0u;
#pragma unroll
    for (unsigned j = 0; j < 16; ++j) { const unsigned c = xb_ld(&bar[XB_XCNT(j)]); sum += c; cnt += (c > 0u) ? 1u : 0u; mine = (j == x) ? c : mine; }
    if (sum == G) break;
    __builtin_amdgcn_s_sleep(1);
    if ((++sp & 255u) == 0u) { if (xb_ld(&bar[XB_TMO])) break; if (sp > XB_SPIN_CAP) { atomicAdd(&bar[XB_TMO], 1u); break; } }
  }
  nloc = mine > 0u ? mine : 1u; nx = cnt > 0u ? cnt : 1u;
}
DEV void xcd_barrier(const XcdBarrier& b) {
  asm volatile("s_waitcnt vmcnt(0)" ::: "memory");
  __syncthreads();
  if (threadIdx.x == 0) {
    unsigned* bar = b.bar;
    __builtin_amdgcn_s_waitcnt(0);
    unsigned nloc = b.st[0], nx = b.st[1];
    if (nloc == 0u) { xcd_barrier_complete(bar, b.x, nloc, nx); b.st[0] = nloc; b.st[1] = nx; }
    const unsigned old = xb_add(&bar[XB_XSUB(b.x)], 1u);
    const unsigned gen = old / nloc;
    if (old + 1u == (gen + 1u) * nloc) {
      __builtin_amdgcn_fence(__ATOMIC_RELEASE, "agent");
      asm volatile("s_waitcnt vmcnt(0)" ::: "memory");
      const unsigned og = xb_add(&bar[XB_TOP], 1u);
      const unsigned tg = og / nx;
      if (og + 1u == (tg + 1u) * nx) xb_add(&bar[XB_TOPGEN], 1u);
      else XB_SPIN(xb_ld(&bar[XB_TOPGEN]) == tg, bar);
      __builtin_amdgcn_fence(__ATOMIC_ACQUIRE, "agent");
      xb_add(&bar[XB_XGEN(b.x)], 1u);
      asm volatile("s_waitcnt vmcnt(0)" ::: "memory");
    } else {
      XB_SPIN(xb_ld(&bar[XB_XGEN(b.x)]) == gen, bar);
      __builtin_amdgcn_fence(__ATOMIC_ACQUIRE, "agent");
      asm volatile("s_waitcnt vmcnt(0)" ::: "memory");
    }
  }
  __syncthreads();
}

constexpr int SMEM_BYTES = 57792;

DEV void run_phase(const Params& p, int ph, int l, char* smem) {
  switch (ph) {
    case 0: phaseA(p, smem); break;
    case 1: norm_phase(p, l, 0); if (l == 1) layer_prep(p, 1, smem); break;
    case 2: phaseC(p, l, smem); break;
    case 3: phaseD(p, l, smem); break;
    case 4: phaseE(p, smem); break;
    case 5: phaseF(p, l, smem); break;
    case 6: phaseG(p, l, smem); break;
    case 7: norm_phase(p, l, 1); break;
    case 8: phaseI(p, l, smem); break;
    case 9: phaseJ(p, l, smem); break;
    case 10: norm_phase(p, 0, 2); break;
  }
}

#if MULTI
__global__ void __launch_bounds__(256, 2) kphase(Params p, int ph, int l) {
  __shared__ __attribute__((aligned(16))) char smem[SMEM_BYTES];
  run_phase(p, ph, l, smem);
}
#else
__global__ void __launch_bounds__(256, 2) mega(Params p) {
  __shared__ __attribute__((aligned(16))) char smem[SMEM_BYTES];
  __shared__ uint4 xb_words;
  cg::grid_group grid = cg::this_grid();
  if (threadIdx.x == 0) xb_words = make_uint4(0u, 0u, 0u, 0u);
  __syncthreads();
  XcdBarrier xb = xcd_barrier_post((unsigned*)(p.ws + OFF_BAR), (volatile LAS unsigned*)&xb_words);
  run_phase(p, 0, 0, smem);
  grid.sync();
  for (int l = 0; l < 2; l++) {
    for (int ph = 1; ph <= 9; ph++) {
      run_phase(p, ph, l, smem);
      xcd_barrier(xb);
    }
  }
  run_phase(p, 10, 0, smem);
}
#endif

extern "C" void kernel_launch(void* const* d_in, const int* in_sizes, int n_in, void* d_out, int out_size, void* d_ws, size_t ws_size, hipStream_t stream) {
  Params p{};
  for (int i = 0; i < 36; i++) p.in[i] = (const float*)d_in[i];
  p.out = (float*)d_out;
  p.ws = (char*)d_ws;
  hipMemsetAsync((char*)d_ws + OFF_MOD, 0, ZERO_BYTES, stream);
  static int grid_blocks = 0;
#if MULTI
  if (!grid_blocks) {
    int dev = 0, cus = 0, per_cu = 0;
    hipGetDevice(&dev);
    hipDeviceGetAttribute(&cus, hipDeviceAttributeMultiprocessorCount, dev);
    hipOccupancyMaxActiveBlocksPerMultiprocessor(&per_cu, kphase, 256, 0);
    if (per_cu > 2) per_cu = 2;
    if (per_cu < 1) per_cu = 1;
    grid_blocks = cus * per_cu;
  }
  kphase<<<grid_blocks, 256, 0, stream>>>(p, 0, 0);
  for (int l = 0; l < 2; l++)
    for (int ph = 1; ph <= 9; ph++) kphase<<<grid_blocks, 256, 0, stream>>>(p, ph, l);
  kphase<<<grid_blocks, 256, 0, stream>>>(p, 10, 0);
#else
  if (!grid_blocks) {
    int dev = 0, cus = 0, per_cu = 0;
    hipGetDevice(&dev);
    hipDeviceGetAttribute(&cus, hipDeviceAttributeMultiprocessorCount, dev);
    hipOccupancyMaxActiveBlocksPerMultiprocessor(&per_cu, mega, 256, 0);
    if (per_cu > 2) per_cu = 2;
    if (per_cu < 1) per_cu = 1;
    grid_blocks = cus * per_cu;
  }
  void* args[] = {&p};
  hipError_t e = hipLaunchCooperativeKernel((void*)mega, dim3(grid_blocks), dim3(256), args, 0, stream);
  if (e != hipSuccess) fprintf(stderr, "cooperative launch failed: %s (grid %d)\n", hipGetErrorString(e), grid_blocks);
#endif
}
```

```cpp
#include <hip/hip_runtime.h>
#include <hip/hip_cooperative_groups.h>
#include <cstdio>
namespace cg = cooperative_groups;

#ifndef MULTI
#define MULTI 0
#endif

typedef unsigned short u16;
using bf16x8 = __attribute__((ext_vector_type(8))) short;
using f32x4 = __attribute__((ext_vector_type(4))) float;
using u32x4 = __attribute__((ext_vector_type(4))) unsigned;
using u32x2 = __attribute__((ext_vector_type(2))) unsigned;
#define DEV __device__ __forceinline__

constexpr int MT = 12288;
constexpr size_t OFF_WT = 0;
constexpr int WIN_O = 0, WGLU_O = 7340032, WRETO_O = 8388608, WHYO_O = 8912896, WOUT_O = 9437184, WFIN_O = 10485760, WFOUT_O = 16252928;
constexpr size_t OFF_G = 38273024;
constexpr size_t OFF_H = 48758784;
constexpr size_t OFF_ZA = 73924608;
constexpr size_t OFF_HYZ = 124256256;
constexpr size_t OFF_VT = 162004992;
constexpr size_t OFF_KT = 174587904;
constexpr size_t OFF_QR = 182976512;
constexpr size_t OFF_YP = 187170816;
constexpr size_t OFF_OUT1 = 212336640;
constexpr size_t OFF_MOD = 237502464;
constexpr size_t OFF_SUMSQ = OFF_MOD + 245760;
constexpr size_t OFF_BAR = OFF_SUMSQ + 16384;
constexpr size_t ZERO_BYTES = 245760 + 16384 + 16384;
constexpr size_t OFF_LAMBAR = OFF_BAR + 16384;
constexpr size_t OFF_BBAR = OFF_LAMBAR + 65536;
constexpr size_t OFF_CM = OFF_BBAR + 524288;
constexpr size_t OFF_ROPE = OFF_CM + 524288;
constexpr size_t OFF_S0T = OFF_ROPE + 524288;
constexpr size_t WS_END = OFF_S0T + 2097152;

struct Params {
  const float* in[36];
  float* out;
  char* ws;
};


DEV int TID() { int t = threadIdx.x; asm volatile("" : "+v"(t)); return t; }
DEV int BID() { int t = blockIdx.x; asm volatile("" : "+s"(t)); return t; }
#define GAS __attribute__((address_space(1)))
DEV char* WS(const Params& p) { unsigned long long w = (unsigned long long)p.ws; asm volatile("" : "+s"(w)); return (char*)(GAS char*)w; }
DEV float* OUTP(const Params& p) { unsigned long long w = (unsigned long long)p.out; asm volatile("" : "+s"(w)); return (float*)(GAS float*)w; }
DEV const float* INP(const Params& p, int i) { unsigned long long w = (unsigned long long)p.in[i]; asm volatile("" : "+s"(w)); return (const float*)(GAS const float*)w; }

DEV u16 f2bf(float f) { unsigned u = __float_as_uint(f); u += 0x7fffu + ((u >> 16) & 1u); return (u16)(u >> 16); }
DEV float bf2f(u16 h) { return __uint_as_float(((unsigned)h) << 16); }
DEV float sigm(float x) { return 1.f / (1.f + __expf(-x)); }
DEV float silu_(float x) { return x / (1.f + __expf(-x)); }
DEV float gelu_(float x) { float u = 0.7978845608028654f * (x + 0.044715f * x * x * x); return 0.5f * x * (1.f + tanhf(u)); }
DEV unsigned pack2(float a, float b) { return (unsigned)f2bf(a) | ((unsigned)f2bf(b) << 16); }

DEV const float* xin_row(const Params& p, int row) { return row < 8192 ? INP(p, 0) + (size_t)row * 1024 : INP(p, 1) + (size_t)(row - 8192) * 1024; }
DEV int modidx(int row) { return row < 8192 ? 0 : 1 + ((row - 8192) >> 10); }

template <int MF, int NF>
DEV void gemm_loop(const u16* __restrict__ A, int lda, const u16* __restrict__ B, int ldb, int K, f32x4 (&acc)[MF][NF], u16* sA) {
  const int tid = TID(), lane = tid & 63, wid = tid >> 6, wr = wid >> 1, wc = wid & 1, fr = lane & 15, fq = lane >> 4;
  u16* sB = sA + MF * 32 * 72;
  u32x4 ra[MF], rb[NF];
  const int crow = tid >> 3, ccol = (tid & 7) * 8;
  const u16* Ap = A + (size_t)crow * lda + ccol;
  const u16* Bp = B + (size_t)crow * ldb + ccol;
#pragma unroll
  for (int i = 0; i < MF; i++) ra[i] = *(const u32x4*)(Ap + (size_t)(i * 32) * lda);
#pragma unroll
  for (int i = 0; i < NF; i++) rb[i] = *(const u32x4*)(Bp + (size_t)(i * 32) * ldb);
  for (int k0 = 0; k0 < K; k0 += 64) {
    __syncthreads();
#pragma unroll
    for (int i = 0; i < MF; i++) *(u32x4*)(sA + (crow + i * 32) * 72 + ccol) = ra[i];
#pragma unroll
    for (int i = 0; i < NF; i++) *(u32x4*)(sB + (crow + i * 32) * 72 + ccol) = rb[i];
    __syncthreads();
    if (k0 + 64 < K) {
#pragma unroll
      for (int i = 0; i < MF; i++) ra[i] = *(const u32x4*)(Ap + (size_t)(i * 32) * lda + k0 + 64);
#pragma unroll
      for (int i = 0; i < NF; i++) rb[i] = *(const u32x4*)(Bp + (size_t)(i * 32) * ldb + k0 + 64);
    }
#pragma unroll
    for (int ks = 0; ks < 2; ks++) {
      bf16x8 bv[NF];
#pragma unroll
      for (int n = 0; n < NF; n++) bv[n] = *(const bf16x8*)(sB + (wc * (NF * 16) + n * 16 + fr) * 72 + ks * 32 + fq * 8);
      const u16* sAf = sA + (wr * 16 + fr) * 72 + ks * 32 + fq * 8;
      bf16x8 a_cur = *(const bf16x8*)(sAf);
      bf16x8 a_nxt = *(const bf16x8*)(sAf + 32 * 72);
#pragma unroll
      for (int m = 0; m < MF; m++) {
        bf16x8 a_n2 = a_nxt;
        if (m + 2 < MF) a_n2 = *(const bf16x8*)(sAf + (m + 2) * 32 * 72);
        __builtin_amdgcn_sched_barrier(0);
#pragma unroll
        for (int n = 0; n < NF; n++) acc[m][n] = __builtin_amdgcn_mfma_f32_16x16x32_bf16(a_cur, bv[n], acc[m][n], 0, 0, 0);
        __builtin_amdgcn_sched_barrier(0);
        a_cur = a_nxt; a_nxt = a_n2;
      }
    }
  }
}

template <int MF, int NF>
DEV void zero_acc(f32x4 (&acc)[MF][NF]) {
#pragma unroll
  for (int m = 0; m < MF; m++)
#pragma unroll
    for (int n = 0; n < NF; n++) acc[m][n] = f32x4{0.f, 0.f, 0.f, 0.f};
}

DEV float epi_op(float v, int op) { return op == 1 ? v * 0.08838834764831845f : (op == 2 ? silu_(v) : v); }
template <int MF, int NF, int TS>
DEV void acc_to_lds(const f32x4 (&acc)[MF][NF], u16* T, int m0, int op = 0) {
  const int tid = TID(), lane = tid & 63, wid = tid >> 6, wr = wid >> 1, wc = wid & 1, fr = lane & 15, fq = lane >> 4;
#pragma unroll
  for (int m = 0; m < 4; m++)
#pragma unroll
    for (int n = 0; n < NF; n++)
#pragma unroll
      for (int j = 0; j < 4; j++) T[(m * 32 + wr * 16 + fq * 4 + j) * TS + wc * (NF * 16) + n * 16 + fr] = f2bf(epi_op(acc[m0 + m][n][j], op));
}
template <int MF>
DEV void acc_to_lds_T(const f32x4 (&acc)[MF][4], u16* T, int m0, int op = 0) {
  const int tid = TID(), lane = tid & 63, wid = tid >> 6, wr = wid >> 1, wc = wid & 1, fr = lane & 15, fq = lane >> 4;
#pragma unroll
  for (int m = 0; m < 4; m++)
#pragma unroll
    for (int n = 0; n < 4; n++) {
      u32x2 v; v.x = pack2(epi_op(acc[m0 + m][n][0], op), epi_op(acc[m0 + m][n][1], op)); v.y = pack2(epi_op(acc[m0 + m][n][2], op), epi_op(acc[m0 + m][n][3], op));
      *(u32x2*)(T + (wc * 64 + n * 16 + fr) * 136 + m * 32 + wr * 16 + fq * 4) = v;
    }
}
template <int COLS, int TS>
DEV void copy_tile(const u16* T, u16* dst, int ld) {
  constexpr int CPR = COLS / 8;
  constexpr int NIT = 128 * CPR / 256;
#pragma unroll
  for (int i = 0; i < NIT; i++) {
    int id = TID() + i * 256; int r = id / CPR, ch = id % CPR;
    *(u32x4*)(dst + (size_t)r * ld + ch * 8) = *(const u32x4*)(T + r * TS + ch * 8);
  }
}

DEV void transpose_tile(const float* __restrict__ src, int K, int N, u16* __restrict__ dst, int tile, float* sm, int perm = 0) {
  int nk = K >> 6; int tk = tile % nk, tn = tile / nk; int k0 = tk * 64, n0 = tn * 64;
  int tx = TID() & 63, ty = TID() >> 6;
  __syncthreads();
#pragma unroll
  for (int i = 0; i < 16; i++) { int k = ty + i * 4; sm[k * 65 + tx] = src[(size_t)(k0 + k) * N + n0 + tx]; }
  __syncthreads();
#pragma unroll
  for (int i = 0; i < 16; i++) {
    int n = n0 + ty + i * 4;
    if (perm) { int half = N >> 1; int j = n < half ? n : n - half; n = (j >> 4) * 32 + (n < half ? 0 : 16) + (j & 15); }
    dst[(size_t)n * K + k0 + tx] = f2bf(sm[tx * 65 + (ty + i * 4)]);
  }
}

DEV void wt_task(const Params& p, int l, int t, float* sm) {
  u16* WT = (u16*)(WS(p) + OFF_WT);
  const float* src; int K, N, off, tt, perm = 0;
  if (t < 1792) { src = INP(p, 10) + (size_t)l * 1024 * 7168; K = 1024; N = 7168; off = WIN_O; tt = t; }
  else if (t < 2048) { src = INP(p, 19) + (size_t)l * 512 * 2048; K = 512; N = 2048; off = WGLU_O; tt = t - 1792; }
  else if (t < 2176) { src = INP(p, 21) + (size_t)l * 512 * 1024; K = 512; N = 1024; off = WRETO_O; tt = t - 2048; }
  else if (t < 2304) { src = INP(p, 31) + (size_t)l * 512 * 1024; K = 512; N = 1024; off = WHYO_O; tt = t - 2176; }
  else if (t < 2560) { src = INP(p, 32) + (size_t)l * 1024 * 1024; K = 1024; N = 1024; off = WOUT_O; tt = t - 2304; }
  else if (t < 3968) { src = INP(p, 33) + (size_t)l * 1024 * 5632; K = 1024; N = 5632; off = WFIN_O; tt = t - 2560; perm = 1; }
  else { src = INP(p, 34) + (size_t)l * 2816 * 1024; K = 2816; N = 1024; off = WFOUT_O; tt = t - 3968; }
  transpose_tile(src, K, N, WT + off, tt, sm, perm);
}

DEV void mod_task(const Params& p, int task, float* sm) {
  int cb = task % 96; int l = task / 96;
  int tid = TID(), lane = tid & 63, kq = tid >> 6;
  __syncthreads();
  for (int i = tid; i < 5120; i += 256) {
    int j = i >> 10, k = i & 1023;
    float c = (j == 0) ? INP(p, 5)[k] : INP(p, 4)[(j - 1) * 1024 + k];
    sm[i] = silu_(c);
  }
  __syncthreads();
  int col = cb * 64 + lane;
  const float* w = INP(p, 6) + (size_t)l * 1024 * 6144 + col;
  float a0 = 0, a1 = 0, a2 = 0, a3 = 0, a4 = 0;
#pragma unroll 8
  for (int kk = 0; kk < 256; kk++) {
    int k = kk * 4 + kq;
    float wv = w[(size_t)k * 6144];
    a0 += sm[k] * wv; a1 += sm[1024 + k] * wv; a2 += sm[2048 + k] * wv; a3 += sm[3072 + k] * wv; a4 += sm[4096 + k] * wv;
  }
  float* red = sm + 5120;
  red[(kq * 5 + 0) * 64 + lane] = a0; red[(kq * 5 + 1) * 64 + lane] = a1; red[(kq * 5 + 2) * 64 + lane] = a2;
  red[(kq * 5 + 3) * 64 + lane] = a3; red[(kq * 5 + 4) * 64 + lane] = a4;
  __syncthreads();
  float* MOD = (float*)(WS(p) + OFF_MOD);
  for (int i = tid; i < 320; i += 256) {
    int j = i >> 6, cc = i & 63;
    float v = ((red[(0 * 5 + j) * 64 + cc] + red[(1 * 5 + j) * 64 + cc]) + red[(2 * 5 + j) * 64 + cc]) + red[(3 * 5 + j) * 64 + cc];
    MOD[(l * 5 + j) * 6144 + cb * 64 + cc] = v;
  }
}

DEV void filt_task(const Params& p, int l, int task, float* sm) {
  int Lsel = task >= 32; int tb = Lsel ? task - 32 : task; int L = Lsel ? 1024 : 256; int t0 = tb * 8;
  int tid = TID();
  float* z = sm; float* h1 = sm + 264; float* h2 = sm + 264 + 512;
  const float* w1 = INP(p, 24) + l * 33 * 64; const float* b1 = INP(p, 25) + l * 64;
  const float* w2 = INP(p, 26) + l * 64 * 64; const float* b2 = INP(p, 27) + l * 64;
  const float* fr0 = INP(p, 28) + l * 128; const float* fr1 = fr0 + 64;
  const float* w3 = INP(p, 29) + (size_t)l * 64 * 2048;
  __syncthreads();
  for (int i = tid; i < 264; i += 256) {
    int tt = i / 33, e = i % 33; float t = (float)(t0 + tt); float v;
    if (e == 0) v = t / (float)L;
    else {
      int b = (e - 1) & 15; float band = 1e-4f + (float)b * ((15.f - 1e-4f) / 15.f);
      float ang = (6.283185307179586f / (float)L) * t * band;
      v = (e <= 16) ? cosf(ang) : -sinf(ang);
    }
    z[i] = v;
  }
  __syncthreads();
  for (int i = tid; i < 512; i += 256) {
    int tt = i >> 6, j = i & 63; float s = b1[j];
    for (int e = 0; e < 33; e++) s += z[tt * 33 + e] * w1[e * 64 + j];
    h1[i] = sinf(fr0[j] * s);
  }
  __syncthreads();
  for (int i = tid; i < 512; i += 256) {
    int tt = i >> 6, j = i & 63; float s = b2[j];
    for (int e = 0; e < 64; e++) s += h1[tt * 64 + e] * w2[e * 64 + j];
    h2[i] = sinf(fr1[j] * s);
  }
  __syncthreads();
  float* FB = (float*)(WS(p) + OFF_G) + (Lsel ? 524288 : 0);
  float* SUMSQ = (float*)(WS(p) + WS_END);
  for (int m = 0; m < 8; m++) {
    int col = tid + m * 256;
    float acc[8];
#pragma unroll
    for (int tt = 0; tt < 8; tt++) acc[tt] = 0.f;
    for (int j = 0; j < 64; j++) {
      float w = w3[j * 2048 + col];
#pragma unroll
      for (int tt = 0; tt < 8; tt++) acc[tt] += h2[tt * 64 + j] * w;
    }
    int dir = col >> 10, o = (col >> 9) & 1, c = col & 511;
    float rate = 3.0701134573253944f + (float)c * ((15.350567286626972f - 3.0701134573253944f) / 511.f);
    float ss = 0.f;
    float* Fo = FB + (size_t)o * (2 * L) * 512 + c;
#pragma unroll
    for (int tt = 0; tt < 8; tt++) {
      int t = t0 + tt;
      float val = acc[tt] * expf(-((float)t / (float)L) * rate);
      if (dir == 0) { Fo[(size_t)(L + t) * 512] = val; ss += val * val; }
      else if (t > 0) { Fo[(size_t)(L - t) * 512] = val; ss += val * val; }
      else { Fo[0] = 0.f; }
    }
    SUMSQ[((size_t)l * 160 + task) * 2048 + col] = ss;
  }
}

DEV void s5prep_task(const Params& p, int task) {
  int idx = task * 256 + TID();
  int pp = idx & 63; int lrg = idx >> 6;
  float lre = INP(p, 11)[idx], lim = INP(p, 12)[idx];
  float dt = expf(INP(p, 13)[lrg]);
  float mag = expf(lre * dt);
  float lbr = mag * cosf(lim * dt), lbi = mag * sinf(lim * dt);
  float nr = lbr - 1.f, ni = lbi; float den = lre * lre + lim * lim;
  float cr = (nr * lre + ni * lim) / den, ci = (ni * lre - nr * lim) / den;
  u16* BBAR = (u16*)(WS(p) + OFF_BBAR); u16* CM = (u16*)(WS(p) + OFF_CM); float* LB = (float*)(WS(p) + OFF_LAMBAR);
  LB[idx * 2] = lbr; LB[idx * 2 + 1] = lbi;
  for (int c = 0; c < 16; c++) {
    float br = INP(p, 14)[(size_t)idx * 16 + c], bi = INP(p, 15)[(size_t)idx * 16 + c];
    BBAR[(size_t)lrg * 2048 + pp * 16 + c] = f2bf(cr * br - ci * bi);
    BBAR[(size_t)lrg * 2048 + (64 + pp) * 16 + c] = f2bf(cr * bi + ci * br);
    CM[(size_t)lrg * 2048 + c * 128 + pp] = f2bf(INP(p, 16)[(size_t)lrg * 1024 + c * 64 + pp]);
    CM[(size_t)lrg * 2048 + c * 128 + 64 + pp] = f2bf(-INP(p, 17)[(size_t)lrg * 1024 + c * 64 + pp]);
  }
}

DEV void rope_task(const Params& p, int task) {
  int idx = task * 256 + TID(); int t = idx >> 6, d = idx & 63; int f = d & 31;
  float inv = powf(10000.f, -(float)f / 32.f);
  float pos = (d < 32) ? (float)(t >> 6) : (float)(t & 63);
  float ang = pos * inv;
  float* R = (float*)(WS(p) + OFF_ROPE);
  R[idx * 2] = cosf(ang); R[idx * 2 + 1] = sinf(ang);
}

DEV void layer_prep(const Params& p, int l, char* smem) {
  for (int t = BID(); t < 4672 + 160; t += gridDim.x) {
    if (t < 4672) wt_task(p, l, t, (float*)smem);
    else filt_task(p, l, t - 4672, (float*)smem);
  }
}
DEV void phaseA(const Params& p, char* smem) {
  for (int t = BID(); t < 192 + 32 + 256 + 256; t += gridDim.x) {
    if (t < 192) mod_task(p, t, (float*)smem);
    else if (t < 224) s5prep_task(p, t - 192);
    else if (t < 480) rope_task(p, t - 224);
    else { int tt = t - 480; int mi = tt >> 2; transpose_tile(INP(p, 3) + (size_t)mi * 16384, 128, 128, (u16*)(WS(p) + OFF_S0T) + (size_t)mi * 16384, tt & 3, (float*)smem); }
  }
  layer_prep(p, 0, smem);
}

DEV void norm_phase(const Params& p, int l, int which) {
  const int lane = TID() & 63;
  const int wave = (BID() * blockDim.x + TID()) >> 6, nw = (gridDim.x * blockDim.x) >> 6;
  u16* H = (u16*)(WS(p) + OFF_H);
  const float* MOD = (const float*)(WS(p) + OFF_MOD);
  for (int row = wave; row < MT; row += nw) {
    const float* x = (l == 0 && which == 0) ? xin_row(p, row) : OUTP(p) + (size_t)row * 1024;
    float4 v[4]; float ss = 0.f;
#pragma unroll
    for (int i = 0; i < 4; i++) { v[i] = *(const float4*)(x + i * 256 + lane * 4); ss += v[i].x * v[i].x + v[i].y * v[i].y + v[i].z * v[i].z + v[i].w * v[i].w; }
#pragma unroll
    for (int o = 32; o > 0; o >>= 1) ss += __shfl_xor(ss, o, 64);
    float rinv = rsqrtf(ss * (1.f / 1024.f) + 1e-6f);
    if (which == 2) {
      const float* nf = INP(p, 35);
#pragma unroll
      for (int i = 0; i < 4; i++) {
        float4 g = *(const float4*)(nf + i * 256 + lane * 4);
        float4 o; o.x = v[i].x * rinv * g.x; o.y = v[i].y * rinv * g.y; o.z = v[i].z * rinv * g.z; o.w = v[i].w * rinv * g.w;
        *(float4*)(OUTP(p) + (size_t)row * 1024 + i * 256 + lane * 4) = o;
      }
    } else {
      int j = modidx(row);
      const float* nwt = (which == 0 ? INP(p, 8) : INP(p, 9)) + l * 1024;
      const float* msh = MOD + (l * 5 + j) * 6144 + (which ? 3 : 0) * 1024;
      const float* msc = msh + 1024;
      const float* bsh = INP(p, 7) + l * 6144 + (which ? 3 : 0) * 1024;
      const float* bsc = bsh + 1024;
#pragma unroll
      for (int i = 0; i < 4; i++) {
        int k = i * 256 + lane * 4;
        float4 g = *(const float4*)(nwt + k);
        float4 sh = *(const float4*)(msh + k), sc = *(const float4*)(msc + k);
        float4 bh = *(const float4*)(bsh + k), bc = *(const float4*)(bsc + k);
        float o0 = v[i].x * rinv * g.x * (1.f + sc.x + bc.x) + sh.x + bh.x;
        float o1 = v[i].y * rinv * g.y * (1.f + sc.y + bc.y) + sh.y + bh.y;
        float o2 = v[i].z * rinv * g.z * (1.f + sc.z + bc.z) + sh.z + bh.z;
        float o3 = v[i].w * rinv * g.w * (1.f + sc.w + bc.w) + sh.w + bh.w;
        u32x2 pk; pk.x = pack2(o0, o1); pk.y = pack2(o2, o3);
        *(u32x2*)(H + (size_t)row * 1024 + k) = pk;
      }
    }
  }
}

DEV void phaseC(const Params& p, int l, char* smem) {
  u16* sA = (u16*)smem; u16* T = (u16*)smem;
  const u16* H = (const u16*)(WS(p) + OFF_H);
  const u16* WIN = (const u16*)(WS(p) + OFF_WT) + WIN_O;
  u16* ZA = (u16*)(WS(p) + OFF_ZA); u16* HYT = (u16*)(WS(p) + OFF_HYZ); u16* VT = (u16*)(WS(p) + OFF_VT);
  u16* KT = (u16*)(WS(p) + OFF_KT); u16* QR = (u16*)(WS(p) + OFF_QR);
  const float* ROPE = (const float*)(WS(p) + OFF_ROPE);
  const int tid = TID();
  for (int tile = BID(); tile < 48 * 32; tile += gridDim.x) {
    int tm = tile >> 5, tn = tile & 31;
    f32x4 acc[8][4]; zero_acc<8, 4>(acc);
    gemm_loop<8, 4>(H + (size_t)tm * 256 * 1024, 1024, WIN + (size_t)tn * 128 * 1024, 1024, 1024, acc, sA);
    int kind = tn >> 2, hd = tn & 3;
    const int op = kind == 2 ? 1 : (kind == 4 ? 2 : 0);
#pragma unroll
    for (int hh = 0; hh < 2; hh++) {
      int row0 = tm * 256 + hh * 128; bool lat = row0 >= 8192;
      int seq, t0, L;
      if (!lat) { seq = row0 >> 8; t0 = row0 & 255; L = 256; } else { seq = (row0 - 8192) >> 10; t0 = (row0 - 8192) & 1023; L = 1024; }
      __syncthreads();
      if (kind == 3 || kind >= 5) {
        acc_to_lds_T<8>(acc, T, hh * 4, 0);
        __syncthreads();
        u16* dst;
        if (kind == 3) dst = lat ? VT + (size_t)8192 * 512 + (size_t)((seq * 4 + hd) * 128) * 1024 + t0 : VT + (size_t)((seq * 4 + hd) * 128) * 256 + t0;
        else dst = lat ? HYT + (size_t)8192 * 1536 + ((size_t)seq * 1536 + (tn - 20) * 128) * 1024 + t0 : HYT + ((size_t)seq * 1536 + (tn - 20) * 128) * 256 + t0;
        copy_tile<128, 136>(T, dst, L);
      } else {
        acc_to_lds<8, 4, 136>(acc, T, hh * 4, op);
        __syncthreads();
        bool roped = lat && (kind == 1 || kind == 2);
        if (!(lat && kind == 2)) {
          u16* dst;
          if (kind == 0) dst = ZA + (size_t)row0 * 2048 + hd * 128;
          else if (kind == 1) dst = ZA + (size_t)row0 * 2048 + 512 + hd * 128;
          else if (kind == 2) dst = ZA + (size_t)row0 * 2048 + 1024 + hd * 128;
          else dst = ZA + (size_t)row0 * 2048 + 1536 + hd * 128;
          copy_tile<128, 136>(T, dst, 2048);
        }
        if (roped) {
          u16* dst; int ld;
          if (kind == 1) { dst = QR + (size_t)(row0 - 8192) * 512 + hd * 128; ld = 512; }
          else { dst = ZA + (size_t)row0 * 2048 + 1024 + hd * 128; ld = 2048; }
#pragma unroll 1
          for (int i = 0; i < 4; i++) {
            int id = tid + i * 256; int r = id >> 3, ch = id & 7;
            u32x4 a = *(const u32x4*)(T + r * 136 + ch * 8);
            u32x4 b = *(const u32x4*)(T + r * 136 + 64 + ch * 8);
            const float4* cs = (const float4*)(ROPE + ((size_t)(t0 + r) * 64 + ch * 8) * 2);
            u32x4 o1, o2;
#pragma unroll
            for (int q = 0; q < 4; q++) {
              float4 c4 = cs[q];
              float x1a = __uint_as_float(a[q] << 16), x1b = __uint_as_float(a[q] & 0xffff0000u);
              float x2a = __uint_as_float(b[q] << 16), x2b = __uint_as_float(b[q] & 0xffff0000u);
              o1[q] = pack2(x1a * c4.x - x2a * c4.y, x1b * c4.z - x2b * c4.w);
              o2[q] = pack2(x1a * c4.y + x2a * c4.x, x1b * c4.w + x2b * c4.z);
            }
            *(u32x4*)(dst + (size_t)r * ld + ch * 8) = o1;
            *(u32x4*)(dst + (size_t)r * ld + 64 + ch * 8) = o2;
          }
        }
        if (kind == 2 && !lat) {
          __syncthreads();
          acc_to_lds_T<8>(acc, T, hh * 4, op);
          __syncthreads();
          copy_tile<128, 136>(T, KT + (size_t)((seq * 4 + hd) * 128) * 256 + t0, 256);
        }
      }
    }
  }
}

DEV void s5_task(const Params& p, int l, int task, char* smem) {
  const int tid = TID(), lane = tid & 63, wid = tid >> 6, fr = lane & 15, fq = lane >> 4;
  int seq, gp;
  if (task < 64) { seq = 32 + (task >> 4); gp = task & 15; } else { int t2 = task - 64; seq = t2 >> 4; gp = t2 & 15; }
  const bool lat = seq >= 32;
  const int L = lat ? 1024 : 256;
  const int row0 = lat ? 8192 + (seq - 32) * 1024 : seq * 256;
  const int grp = gp * 2 + (wid >> 1), dir = wid & 1;
  const int lrg = (l * 2 + dir) * 32 + grp;
  float* BU = (float*)(smem + wid * 12544);
  u16* HB = (u16*)(smem + wid * 12544 + 8192);
  u16* ZA = (u16*)(WS(p) + OFF_ZA);
  float* YP = (float*)(WS(p) + OFF_YP);
  const u16* BBAR = (const u16*)(WS(p) + OFF_BBAR) + (size_t)lrg * 2048;
  const u16* CM = (const u16*)(WS(p) + OFF_CM) + (size_t)lrg * 2048;
  const float* LB = (const float*)(WS(p) + OFF_LAMBAR) + ((size_t)lrg * 64 + lane) * 2;
  const float lr = LB[0], li = LB[1];
  bf16x8 bfrag[8], cfrag[4];
  const bf16x8 zero8 = {0, 0, 0, 0, 0, 0, 0, 0};
#pragma unroll
  for (int nt = 0; nt < 8; nt++) bfrag[nt] = (fq < 2) ? *(const bf16x8*)(BBAR + (nt * 16 + fr) * 16 + fq * 8) : zero8;
#pragma unroll
  for (int ks = 0; ks < 4; ks++) cfrag[ks] = *(const bf16x8*)(CM + fr * 128 + ks * 32 + fq * 8);
  float hr = 0.f, hi = 0.f;
  if (lat) {
    const float* s0 = INP(p, 2) + ((((size_t)(seq - 32) * 2 + l) * 2 + dir) * 32 + grp) * 128 + lane * 2;
    hr = s0[0]; hi = s0[1];
  }
  const float dcoef = INP(p, 18)[l * 512 + grp * 16 + fr];
  const int nch = L >> 4;
  __syncthreads();
  const int half = nch >> 1;
  bf16x8 ua_next = (fq < 2) ? *(const bf16x8*)(ZA + (size_t)(row0 + (dir ? nch - 1 : 0) * 16 + fr) * 2048 + grp * 16 + fq * 8) : zero8;
  const int tbase = dir ? 15 : 0, tstep = dir ? -1 : 1;
  for (int i = 0; i < nch; i++) {
    const int ci = dir ? nch - 1 - i : i; const int t0 = ci * 16;
    if (i == half) { asm volatile("s_waitcnt vmcnt(0)" ::: "memory"); __threadfence(); asm volatile("s_waitcnt vmcnt(0)" ::: "memory"); __syncthreads(); }
    const bf16x8 ua = ua_next;
    if (i + 1 < nch) {
      const int cn = dir ? nch - 2 - i : i + 1;
      ua_next = (fq < 2) ? *(const bf16x8*)(ZA + (size_t)(row0 + cn * 16 + fr) * 2048 + grp * 16 + fq * 8) : zero8;
    }
    float oth[4] = {0.f, 0.f, 0.f, 0.f}, uu[4] = {0.f, 0.f, 0.f, 0.f};
    if (i >= half) {
#pragma unroll
      for (int j = 0; j < 4; j++) {
        size_t row = (size_t)(row0 + t0 + fq * 4 + j);
        oth[j] = YP[row * 512 + grp * 16 + fr];
        uu[j] = bf2f(ZA[row * 2048 + grp * 16 + fr]);
      }
    }
#pragma unroll
    for (int nt = 0; nt < 8; nt++) {
      f32x4 r = __builtin_amdgcn_mfma_f32_16x16x32_bf16(ua, bfrag[nt], f32x4{0.f, 0.f, 0.f, 0.f}, 0, 0, 0);
#pragma unroll
      for (int j = 0; j < 4; j++) BU[(fq * 4 + j) * 128 + nt * 16 + fr] = r[j];
    }
    asm volatile("s_waitcnt lgkmcnt(0)" ::: "memory");
#pragma unroll
    for (int tt = 0; tt < 16; tt++) {
      const int t = tbase + tstep * tt;
      float re = BU[t * 128 + lane], im = BU[t * 128 + 64 + lane];
      float nr = lr * hr - li * hi + re; float ni = lr * hi + li * hr + im;
      hr = nr; hi = ni;
      HB[t * 136 + lane] = f2bf(hr); HB[t * 136 + 64 + lane] = f2bf(hi);
    }
    asm volatile("s_waitcnt lgkmcnt(0)" ::: "memory");
    f32x4 y = {0.f, 0.f, 0.f, 0.f};
#pragma unroll
    for (int ks = 0; ks < 4; ks++) {
      bf16x8 a = *(const bf16x8*)(HB + fr * 136 + ks * 32 + fq * 8);
      y = __builtin_amdgcn_mfma_f32_16x16x32_bf16(a, cfrag[ks], y, 0, 0, 0);
    }
    asm volatile("s_waitcnt lgkmcnt(0)" ::: "memory");
    if (i < half) {
#pragma unroll
      for (int j = 0; j < 4; j++) YP[(size_t)(row0 + t0 + fq * 4 + j) * 512 + grp * 16 + fr] = y[j];
    } else {
#pragma unroll
      for (int j = 0; j < 4; j++) {
        size_t row = (size_t)(row0 + t0 + fq * 4 + j);
        float v = y[j] + oth[j] + dcoef * uu[j];
        ZA[row * 2048 + grp * 16 + fr] = f2bf(gelu_(v));
      }
    }
  }
  if (!lat) {
    float* o = OUTP(p) + 12582912 + ((((size_t)seq * 2 + l) * 2 + dir) * 32 + grp) * 128 + lane * 2;
    o[0] = hr; o[1] = hi;
  }
}

DEV void ret_task(const Params& p, int l, int task, char* smem) {
  const int tid = TID(), lane = tid & 63, wid = tid >> 6, fr = lane & 15, fq = lane >> 4;
  int seq, h, qt; bool lat;
  if (task < 256) { lat = true; seq = task >> 6; h = (task >> 4) & 3; qt = task & 15; }
  else { int t2 = task - 256; lat = false; seq = t2 >> 4; h = (t2 >> 2) & 3; qt = t2 & 3; }
  const int L = lat ? 1024 : 256;
  const int row0 = lat ? 8192 + seq * 1024 : seq * 256;
  u16* sK = (u16*)smem; u16* sV = sK + 64 * 136; u16* sP = sV + 128 * 72 + wid * 16 * 72;
  u16* ZA = (u16*)(WS(p) + OFF_ZA);
  const u16* QR = (const u16*)(WS(p) + OFF_QR);
  const u16* VT = (const u16*)(WS(p) + OFF_VT);
  const float lgf = log1pf(-expf(INP(p, 20)[(l * 2 + 0) * 4 + h])), lgb = log1pf(-expf(INP(p, 20)[(l * 2 + 1) * 4 + h]));
  const int qrow = qt * 64 + wid * 16;
  const u16* qsrc = lat ? QR + (size_t)(row0 - 8192 + qrow + fr) * 512 + h * 128 : ZA + (size_t)(row0 + qrow + fr) * 2048 + 512 + h * 128;
  bf16x8 qa[4];
#pragma unroll
  for (int ks = 0; ks < 4; ks++) qa[ks] = *(const bf16x8*)(qsrc + ks * 32 + fq * 8);
  f32x4 o[8];
#pragma unroll
  for (int n = 0; n < 8; n++) o[n] = f32x4{0.f, 0.f, 0.f, 0.f};
  const u16* Kbase = ZA + (size_t)row0 * 2048 + 1024 + h * 128;
  const u16* Vbase = lat ? VT + (size_t)8192 * 512 + (size_t)((seq * 4 + h) * 128) * 1024 : VT + (size_t)((seq * 4 + h) * 128) * 256;
  const int nkt = L >> 6;
  for (int jt = 0; jt < nkt; jt++) {
    __syncthreads();
#pragma unroll
    for (int i = 0; i < 4; i++) {
      int id = tid + i * 256; int r = id >> 4, ch = id & 15;
      *(u32x4*)(sK + r * 136 + ch * 8) = *(const u32x4*)(Kbase + (size_t)(jt * 64 + r) * 2048 + ch * 8);
    }
#pragma unroll
    for (int i = 0; i < 4; i++) {
      int id = tid + i * 256; int e = id >> 3, ch = id & 7;
      *(u32x4*)(sV + e * 72 + ch * 8) = *(const u32x4*)(Vbase + (size_t)e * L + jt * 64 + ch * 8);
    }
    __syncthreads();
    f32x4 s[4];
#pragma unroll
    for (int nt = 0; nt < 4; nt++) s[nt] = f32x4{0.f, 0.f, 0.f, 0.f};
    {
      const u16* kp = sK + fr * 136 + fq * 8;
      bf16x8 b_cur = *(const bf16x8*)(kp);
      bf16x8 b_nxt = *(const bf16x8*)(kp + 32);
#pragma unroll
      for (int i = 0; i < 16; i++) {
        bf16x8 b_n2 = b_nxt;
        if (i + 2 < 16) b_n2 = *(const bf16x8*)(kp + ((i + 2) >> 2) * 16 * 136 + ((i + 2) & 3) * 32);
        __builtin_amdgcn_sched_barrier(0);
        s[i >> 2] = __builtin_amdgcn_mfma_f32_16x16x32_bf16(qa[i & 3], b_cur, s[i >> 2], 0, 0, 0);
        __builtin_amdgcn_sched_barrier(0);
        b_cur = b_nxt; b_nxt = b_n2;
      }
    }
#pragma unroll
    for (int nt = 0; nt < 4; nt++)
#pragma unroll
      for (int j = 0; j < 4; j++) {
        int d = (qrow + fq * 4 + j) - (jt * 64 + nt * 16 + fr);
        float w = d >= 0 ? __expf(lgf * (float)d) : __expf(lgb * (float)(-d));
        sP[(fq * 4 + j) * 72 + nt * 16 + fr] = f2bf(s[nt][j] * w);
      }
    asm volatile("s_waitcnt lgkmcnt(0)" ::: "memory");
    {
      bf16x8 pa[2];
      pa[0] = *(const bf16x8*)(sP + fr * 72 + fq * 8);
      pa[1] = *(const bf16x8*)(sP + fr * 72 + 32 + fq * 8);
      const u16* vp = sV + fr * 72 + fq * 8;
      bf16x8 b_cur = *(const bf16x8*)(vp);
      bf16x8 b_nxt = *(const bf16x8*)(vp + 16 * 72);
#pragma unroll
      for (int i = 0; i < 16; i++) {
        bf16x8 b_n2 = b_nxt;
        if (i + 2 < 16) b_n2 = *(const bf16x8*)(vp + ((i + 2) & 7) * 16 * 72 + ((i + 2) >> 3) * 32);
        __builtin_amdgcn_sched_barrier(0);
        o[i & 7] = __builtin_amdgcn_mfma_f32_16x16x32_bf16(pa[i >> 3], b_cur, o[i & 7], 0, 0, 0);
        __builtin_amdgcn_sched_barrier(0);
        b_cur = b_nxt; b_nxt = b_n2;
      }
    }
    asm volatile("s_waitcnt lgkmcnt(0)" ::: "memory");
  }
  if (lat) {
    const u16* q0src = ZA + (size_t)(row0 + qrow + fr) * 2048 + 512 + h * 128;
    bf16x8 q0[4];
#pragma unroll
    for (int ks = 0; ks < 4; ks++) q0[ks] = *(const bf16x8*)(q0src + ks * 32 + fq * 8);
#pragma unroll 1
    for (int dir = 0; dir < 2; dir++) {
      const u16* S0 = (const u16*)(WS(p) + OFF_S0T) + (size_t)((((seq * 2 + l) * 2 + dir) * 4 + h)) * 16384;
      float wj[4];
#pragma unroll
      for (int j = 0; j < 4; j++) { int gi = qrow + fq * 4 + j; wj[j] = dir == 0 ? __expf(lgf * (float)(gi + 1)) : __expf(lgb * (float)(L - 1 - gi)); }
#pragma unroll
      for (int n2 = 0; n2 < 8; n2++) {
        f32x4 tmp = {0.f, 0.f, 0.f, 0.f};
#pragma unroll
        for (int ks = 0; ks < 4; ks++) {
          bf16x8 b = *(const bf16x8*)(S0 + (size_t)(n2 * 16 + fr) * 128 + ks * 32 + fq * 8);
          tmp = __builtin_amdgcn_mfma_f32_16x16x32_bf16(q0[ks], b, tmp, 0, 0, 0);
        }
#pragma unroll
        for (int j = 0; j < 4; j++) o[n2][j] += wj[j] * tmp[j];
        asm volatile("" ::: "memory");
      }
    }
  }
#pragma unroll
  for (int j = 0; j < 4; j++) {
    float s = 0.f;
#pragma unroll
    for (int n2 = 0; n2 < 8; n2++) s += o[n2][j];
    s += __shfl_xor(s, 1, 64); s += __shfl_xor(s, 2, 64); s += __shfl_xor(s, 4, 64); s += __shfl_xor(s, 8, 64);
    float mean = s * (1.f / 128.f);
    float v = 0.f;
#pragma unroll
    for (int n2 = 0; n2 < 8; n2++) { float dd = o[n2][j] - mean; v += dd * dd; }
    v += __shfl_xor(v, 1, 64); v += __shfl_xor(v, 2, 64); v += __shfl_xor(v, 4, 64); v += __shfl_xor(v, 8, 64);
    float rstd = rsqrtf(v * (1.f / 128.f) + 1e-5f);
    size_t rbase = (size_t)(row0 + qrow + fq * 4 + j) * 2048;
#pragma unroll
    for (int n2 = 0; n2 < 8; n2++) {
      int e = n2 * 16 + fr;
      float gv = bf2f(ZA[rbase + 1536 + h * 128 + e]);
      ZA[rbase + 512 + h * 128 + e] = f2bf((o[n2][j] - mean) * rstd * gv);
    }
  }
}

DEV bf16x8 scale8(u32x4 raw, const float (&w)[8]) {
  union { u32x4 u; bf16x8 v; } r;
#pragma unroll
  for (int q = 0; q < 4; q++) {
    float a = __uint_as_float(raw[q] << 16) * w[q * 2], b = __uint_as_float(raw[q] & 0xffff0000u) * w[q * 2 + 1];
    r.u[q] = pack2(a, b);
  }
  return r.v;
}

DEV void retstate_task(const Params& p, int l, int task) {
  const int tid = TID(), lane = tid & 63, wid = tid >> 6, fr = lane & 15, fq = lane >> 4;
  int seq = task >> 3, h = (task >> 1) & 3, dir = task & 1;
  const u16* KT = (const u16*)(WS(p) + OFF_KT) + (size_t)((seq * 4 + h) * 128) * 256;
  const u16* VT = (const u16*)(WS(p) + OFF_VT) + (size_t)((seq * 4 + h) * 128) * 256;
  const float lg = log1pf(-expf(INP(p, 20)[(l * 2 + dir) * 4 + h]));
  f32x4 acc[2][8];
#pragma unroll
  for (int m = 0; m < 2; m++)
#pragma unroll
    for (int n = 0; n < 8; n++) acc[m][n] = f32x4{0.f, 0.f, 0.f, 0.f};
#pragma unroll 1
  for (int ks = 0; ks < 8; ks++) {
    float w[8];
#pragma unroll
    for (int jj = 0; jj < 8; jj++) { int j = ks * 32 + fq * 8 + jj; w[jj] = __expf(lg * (float)(dir == 0 ? 255 - j : j)); }
    bf16x8 a[2];
#pragma unroll
    for (int m = 0; m < 2; m++) a[m] = scale8(*(const u32x4*)(KT + (size_t)(wid * 32 + m * 16 + fr) * 256 + ks * 32 + fq * 8), w);
#pragma unroll
    for (int n = 0; n < 8; n++) {
      bf16x8 b = *(const bf16x8*)(VT + (size_t)(n * 16 + fr) * 256 + ks * 32 + fq * 8);
#pragma unroll
      for (int m = 0; m < 2; m++) acc[m][n] = __builtin_amdgcn_mfma_f32_16x16x32_bf16(a[m], b, acc[m][n], 0, 0, 0);
    }
  }
  float* o = OUTP(p) + 13107200 + ((((size_t)seq * 2 + l) * 2 + dir) * 4 + h) * 16384;
#pragma unroll
  for (int m = 0; m < 2; m++)
#pragma unroll
    for (int n = 0; n < 8; n++)
#pragma unroll
      for (int j = 0; j < 4; j++) o[(size_t)(wid * 32 + m * 16 + fq * 4 + j) * 128 + n * 16 + fr] = acc[m][n][j];
}

template <bool LAT>
DEV void hyena_mfma(const Params& p, int l, int task, char* smem) {
  constexpr int L = LAT ? 1024 : 256;
  constexpr int NV = LAT ? 4 : 16;
  constexpr int RS = L + 8, CS = 2 * L + 16;
  constexpr int MPW = L / 64, NKS = L / 32, NCH = L / 8, Lsel = LAT ? 1 : 0;
  const int tid = TID(), lane = tid & 63, wid = tid >> 6, fr = lane & 15, fq = lane >> 4;
  const int c = LAT ? task : (task >> 1);
  const int sg = LAT ? 0 : (task & 1);
  u16* CP = (u16*)smem; u16* XV = CP + 8 * CS; u16* GS = XV + NV * RS; u16* O1 = GS + NV * RS;
  const u16* HYT = (const u16*)(WS(p) + OFF_HYZ);
  u16* HYOT = (u16*)(WS(p) + OFF_OUT1) + (size_t)MT * 512;
  const float* cw = INP(p, 22) + (size_t)l * 3 * 1536; const float* cb = INP(p, 23) + l * 1536;
  auto sconv = [&](int arr, u16* dstA) {
    const int ch = arr * 512 + c;
    const float w0 = cw[ch], w1 = cw[1536 + ch], w2 = cw[3072 + ch], bb = cb[ch];
#pragma unroll
    for (int i = 0; i < (NV * NCH) / 256; i++) {
      int id = tid + i * 256; int n = id / NCH, t8 = (id % NCH) * 8;
      const u16* src = LAT ? HYT + (size_t)8192 * 1536 + ((size_t)n * 1536 + ch) * 1024 + t8 : HYT + ((size_t)(sg * 16 + n) * 1536 + ch) * 256 + t8;
      u32x4 raw = *(const u32x4*)src;
      float h[10];
      h[0] = t8 > 0 ? bf2f(src[-1]) : 0.f;
      h[9] = t8 + 8 < L ? bf2f(src[8]) : 0.f;
#pragma unroll
      for (int q = 0; q < 4; q++) { h[1 + 2 * q] = __uint_as_float(raw[q] << 16); h[2 + 2 * q] = __uint_as_float(raw[q] & 0xffff0000u); }
      u32x4 o;
#pragma unroll
      for (int q = 0; q < 4; q++) o[q] = pack2(w0 * h[2 * q] + w1 * h[2 * q + 1] + w2 * h[2 * q + 2] + bb, w0 * h[2 * q + 1] + w1 * h[2 * q + 2] + w2 * h[2 * q + 3] + bb);
      *(u32x4*)(dstA + n * RS + t8) = o;
    }
  };
  __syncthreads();
  sconv(0, GS);
  sconv(2, XV);
  const int rr = (-fr) & 7;
  const u16* cpl = CP + rr * CS + (L + 8 * fq - fr - rr);
#pragma unroll 1
  for (int o = 0; o < 2; o++) {
    if (o == 1) sconv(1, GS);
    u16* FL = o == 0 ? O1 : XV;
    const float* Gp = (const float*)(WS(p) + OFF_G) + (Lsel ? 524288 : 0) + (size_t)o * (2 * L) * 512 + c;
    if (tid < 2 * L / 8) {
      float f[8];
#pragma unroll
      for (int j = 0; j < 8; j++) { int u = tid * 8 + j; f[j] = u > 0 ? Gp[(size_t)(2 * L - u) * 512] : 0.f; }
      u32x4 v; v[0] = pack2(f[0], f[1]); v[1] = pack2(f[2], f[3]); v[2] = pack2(f[4], f[5]); v[3] = pack2(f[6], f[7]);
      *(u32x4*)(FL + tid * 8) = v;
    }
    if (tid < 2) *(u32x4*)(FL + 2 * L + tid * 8) = u32x4{0u, 0u, 0u, 0u};
    __syncthreads();
    if (tid < 2 * L / 8) {
      u32x4 a = *(const u32x4*)(FL + tid * 8), b = *(const u32x4*)(FL + tid * 8 + 8);
      unsigned d[8] = {a[0], a[1], a[2], a[3], b[0], b[1], b[2], b[3]};
#pragma unroll
      for (int r = 0; r < 8; r++) {
        u32x4 ov;
#pragma unroll
        for (int q = 0; q < 4; q++) ov[q] = (r & 1) ? ((d[q + (r >> 1)] >> 16) | (d[q + (r >> 1) + 1] << 16)) : d[q + (r >> 1)];
        *(u32x4*)(CP + r * CS + tid * 8) = ov;
      }
    }
    __syncthreads();
    float rn;
    {
      constexpr int NTB = LAT ? 128 : 32;
      const float* SP = (const float*)(WS(p) + WS_END) + ((size_t)l * 160 + (LAT ? 32 : 0)) * 2048 + o * 512 + c;
      float ssum = 0.f;
      for (int tb = lane; tb < NTB; tb += 64) ssum += SP[(size_t)tb * 2048] + SP[(size_t)tb * 2048 + 1024];
#pragma unroll
      for (int off = 32; off > 0; off >>= 1) ssum += __shfl_xor(ssum, off, 64);
      rn = rsqrtf(ssum + 1e-6f);
    }
    const float bias = INP(p, 30)[(l * 2 + o) * 512 + c];
    const u16* Xs = o == 0 ? XV : O1;
    f32x4 acc[MPW];
#pragma unroll
    for (int mi = 0; mi < MPW; mi++) acc[mi] = f32x4{0.f, 0.f, 0.f, 0.f};
    const bf16x8 zero8 = {0, 0, 0, 0, 0, 0, 0, 0};
    {
      bf16x8 b_next = (fr < NV) ? *(const bf16x8*)(Xs + fr * RS + fq * 8) : zero8;
#pragma unroll 1
      for (int ks = 0; ks < NKS; ks++) {
        const bf16x8 b = b_next;
        const u16* ap = cpl - 16 * (wid * MPW) + 32 * ks;
        bf16x8 a_cur = *(const bf16x8*)(ap);
        bf16x8 a_nxt = *(const bf16x8*)(ap - 16);
        if (ks + 1 < NKS) b_next = (fr < NV) ? *(const bf16x8*)(Xs + fr * RS + (ks + 1) * 32 + fq * 8) : zero8;
#pragma unroll
        for (int mi = 0; mi < MPW; mi++) {
          bf16x8 a_n2 = a_nxt;
          if (mi + 2 < MPW) a_n2 = *(const bf16x8*)(ap - 16 * (mi + 2));
          __builtin_amdgcn_sched_barrier(0);
          acc[mi] = __builtin_amdgcn_mfma_f32_16x16x32_bf16(a_cur, b, acc[mi], 0, 0, 0);
          __builtin_amdgcn_sched_barrier(0);
          a_cur = a_nxt; a_nxt = a_n2;
        }
      }
    }
    if (fr < NV) {
      const u16* gate = GS;
      const u16* vin = o == 0 ? XV : O1;
#pragma unroll
      for (int mi = 0; mi < MPW; mi++) {
        const int t0 = (wid * MPW + mi) * 16 + fq * 4;
        u32x2 gq = *(const u32x2*)(gate + fr * RS + t0), vq = *(const u32x2*)(vin + fr * RS + t0);
        float g4[4] = {__uint_as_float(gq[0] << 16), __uint_as_float(gq[0] & 0xffff0000u), __uint_as_float(gq[1] << 16), __uint_as_float(gq[1] & 0xffff0000u)};
        float v4[4] = {__uint_as_float(vq[0] << 16), __uint_as_float(vq[0] & 0xffff0000u), __uint_as_float(vq[1] << 16), __uint_as_float(vq[1] & 0xffff0000u)};
        float r4[4];
#pragma unroll
        for (int j = 0; j < 4; j++) r4[j] = g4[j] * (acc[mi][j] * rn + bias * v4[j]);
        if (o == 0) {
          u32x2 ov; ov[0] = pack2(r4[0], r4[1]); ov[1] = pack2(r4[2], r4[3]);
          *(u32x2*)(O1 + fr * RS + t0) = ov;
        } else {
          u16* dst = LAT ? HYOT + (size_t)8192 * 512 + ((size_t)fr * 512 + c) * 1024 + t0 : HYOT + ((size_t)(sg * 16 + fr) * 512 + c) * 256 + t0;
          u32x2 ov; ov[0] = pack2(r4[0], r4[1]); ov[1] = pack2(r4[2], r4[3]);
          *(u32x2*)dst = ov;
        }
      }
    }
    __syncthreads();
  }
}

DEV void phaseD(const Params& p, int l, char* smem) {
  const int nbt = gridDim.x, bt = BID();
  const bool ded = nbt >= 128;
  const bool s5only = ded && bt < 64;
  const int nb = ded ? nbt - 64 : nbt, b = ded ? bt - 64 : bt;
  const int BIG = 1 << 28;
#pragma unroll 1
  for (int t = s5only ? BIG : b; t < 512; t += nb) hyena_mfma<true>(p, l, t, smem);
#pragma unroll 1
  for (int t = s5only ? BIG : (b + nb - (512 % nb)) % nb; t < 768; t += nb) ret_task(p, l, t, smem);
  {
    int st, step, lo;
    if (s5only) { st = bt; step = BIG; }
    else { lo = ded ? 64 : 0; st = lo + (b + 2 * nb - ((512 + 768) % nb)) % nb; step = nb; }
#pragma unroll 1
    for (int t = st; t < 576; t += step) s5_task(p, l, t, smem);
  }
#pragma unroll 1
  for (int t = s5only ? BIG : (b + 3 * nb - ((512 + 768 + 576) % nb)) % nb; t < 1024; t += nb) hyena_mfma<false>(p, l, t, smem);
#pragma unroll 1
  for (int t = s5only ? BIG : (b + 4 * nb - ((512 + 768 + 576 + 1024) % nb)) % nb; t < 256; t += nb) retstate_task(p, l, t);
}

DEV void phaseE(const Params& p, char* smem) {
  const u16* HYOT = (const u16*)(WS(p) + OFF_OUT1) + (size_t)MT * 512;
  u16* HYO = (u16*)(WS(p) + OFF_OUT1);
  u16* sm = (u16*)smem;
  const int tx = TID() & 63, ty = TID() >> 6;
  for (int tile = BID(); tile < 192 * 8; tile += gridDim.x) {
    int rt = tile >> 3, c0 = (tile & 7) * 64; int row0 = rt * 64;
    const u16* src = row0 < 8192 ? HYOT + ((size_t)(row0 >> 8) * 512 + c0) * 256 + (row0 & 255)
                                 : HYOT + (size_t)8192 * 512 + ((size_t)((row0 - 8192) >> 10) * 512 + c0) * 1024 + ((row0 - 8192) & 1023);
    const int L = row0 < 8192 ? 256 : 1024;
    __syncthreads();
#pragma unroll
    for (int i = 0; i < 16; i++) { int cc = ty + i * 4; sm[cc * 66 + tx] = src[(size_t)cc * L + tx]; }
    __syncthreads();
#pragma unroll
    for (int i = 0; i < 16; i++) { int tt = ty + i * 4; HYO[(size_t)(row0 + tt) * 512 + c0 + tx] = sm[tx * 66 + tt]; }
  }
}

DEV void phaseF(const Params& p, int l, char* smem) {
  u16* sA = (u16*)smem; u16* T = (u16*)smem;
  const u16* H = (const u16*)(WS(p) + OFF_H);
  const u16* WT = (const u16*)(WS(p) + OFF_WT);
  const u16* ZA = (const u16*)(WS(p) + OFF_ZA); const u16* HYO = (const u16*)(WS(p) + OFF_OUT1);
  u16* MG = (u16*)(WS(p) + OFF_YP);
  for (int tile = BID(); tile < 96 * 16; tile += gridDim.x) {
    int tm = tile >> 4, tn = tile & 15; int row0 = tm * 128, n0 = tn * 64;
    f32x4 a1[4][2], a2[4][2], tt[4][2];
    const u16* Hrow = H + (size_t)row0 * 1024;
    zero_acc<4, 2>(a1); zero_acc<4, 2>(tt);
#pragma unroll 1
    for (int ps = 0; ps < 7; ps++) {
      const u16* Ap; const u16* Bp; int lda, K;
      switch (ps) {
        case 0: Ap = ZA + (size_t)row0 * 2048; lda = 2048; Bp = WT + WGLU_O + (size_t)n0 * 512; K = 512; break;
        case 1: Ap = ZA + (size_t)row0 * 2048; lda = 2048; Bp = WT + WGLU_O + (size_t)(1024 + n0) * 512; K = 512; break;
        case 3: Ap = ZA + (size_t)row0 * 2048 + 512; lda = 2048; Bp = WT + WRETO_O + (size_t)n0 * 512; K = 512; break;
        case 5: Ap = HYO + (size_t)row0 * 512; lda = 512; Bp = WT + WHYO_O + (size_t)n0 * 512; K = 512; break;
        default: Ap = Hrow; lda = 1024; Bp = WT + WIN_O + (size_t)(4096 + ((ps - 2) >> 1) * 1024 + n0) * 1024; K = 1024; break;
      }
      zero_acc<4, 2>(a2);
      gemm_loop<4, 2>(Ap, lda, Bp, K, K, a2, sA);
      if (ps == 0 || ps == 3 || ps == 5) {
#pragma unroll
        for (int m = 0; m < 4; m++)
#pragma unroll
          for (int n = 0; n < 2; n++) a1[m][n] = a2[m][n];
      } else if (ps == 1) {
#pragma unroll
        for (int m = 0; m < 4; m++)
#pragma unroll
          for (int n = 0; n < 2; n++)
#pragma unroll
            for (int j = 0; j < 4; j++) a1[m][n][j] *= sigm(a2[m][n][j]);
      } else {
#pragma unroll
        for (int m = 0; m < 4; m++)
#pragma unroll
          for (int n = 0; n < 2; n++)
#pragma unroll
            for (int j = 0; j < 4; j++) tt[m][n][j] += a1[m][n][j] * sigm(a2[m][n][j]);
      }
    }
    __syncthreads();
    acc_to_lds<4, 2, 72>(tt, T, 0);
    __syncthreads();
    copy_tile<64, 72>(T, MG + (size_t)row0 * 1024 + n0, 1024);
  }
}

template <int MF, int NF>
DEV void resid_store(const Params& p, const f32x4 (&acc)[MF][NF], int l, int chunk, int row0, int col0, bool from_input) {
  const int tid = TID(), lane = tid & 63, wid = tid >> 6, wr = wid >> 1, wc = wid & 1, fr = lane & 15, fq = lane >> 4;
  float* out = OUTP(p);
#pragma unroll
  for (int m = 0; m < MF; m++) {
    const int rb = row0 + m * 32 + wr * 16 + fq * 4;
    const int j = modidx(rb);
    const float* MOD = (const float*)(WS(p) + OFF_MOD) + (l * 5 + j) * 6144 + chunk * 1024;
    const float* BM = INP(p, 7) + l * 6144 + chunk * 1024;
#pragma unroll
    for (int n = 0; n < NF; n++) {
      int col = col0 + wc * (NF * 16) + n * 16 + fr;
      float g = MOD[col] + BM[col];
#pragma unroll
      for (int jj = 0; jj < 4; jj++) {
        int row = rb + jj;
        float xo = from_input ? xin_row(p, row)[col] : out[(size_t)row * 1024 + col];
        out[(size_t)row * 1024 + col] = xo + g * acc[m][n][jj];
      }
    }
  }
}

DEV void phaseG(const Params& p, int l, char* smem) {
  u16* sA = (u16*)smem;
  const u16* MG = (const u16*)(WS(p) + OFF_YP);
  const u16* W = (const u16*)(WS(p) + OFF_WT) + WOUT_O;
  for (int tile = BID(); tile < 64 * 8; tile += gridDim.x) {
    int tm = tile >> 3, tn = tile & 7;
    f32x4 acc[6][4]; zero_acc<6, 4>(acc);
    gemm_loop<6, 4>(MG + (size_t)tm * 192 * 1024, 1024, W + (size_t)tn * 128 * 1024, 1024, 1024, acc, sA);
    resid_store<6, 4>(p, acc, l, 2, tm * 192, tn * 128, l == 0);
  }
}

DEV void phaseI(const Params& p, int l, char* smem) {
  u16* sA = (u16*)smem; u16* T = (u16*)smem;
  const u16* H = (const u16*)(WS(p) + OFF_H);
  const u16* W = (const u16*)(WS(p) + OFF_WT) + WFIN_O;
  u16* ACT = (u16*)(WS(p) + OFF_ZA);
  for (int tile = BID(); tile < 48 * 44; tile += gridDim.x) {
    int tm = tile / 44, tn = tile % 44;
    f32x4 acc[8][4]; zero_acc<8, 4>(acc);
    gemm_loop<8, 4>(H + (size_t)tm * 256 * 1024, 1024, W + (size_t)tn * 128 * 1024, 1024, 1024, acc, sA);
    const int tid = TID(), lane = tid & 63, wid = tid >> 6, wr = wid >> 1, wc = wid & 1, fr = lane & 15, fq = lane >> 4;
#pragma unroll
    for (int hh = 0; hh < 2; hh++) {
      __syncthreads();
#pragma unroll
      for (int m = 0; m < 4; m++)
#pragma unroll
        for (int n = 0; n < 2; n++)
#pragma unroll
          for (int j = 0; j < 4; j++)
            T[(m * 32 + wr * 16 + fq * 4 + j) * 72 + wc * 32 + n * 16 + fr] = f2bf(silu_(acc[hh * 4 + m][2 * n][j]) * acc[hh * 4 + m][2 * n + 1][j]);
      __syncthreads();
      copy_tile<64, 72>(T, ACT + (size_t)(tm * 256 + hh * 128) * 2816 + tn * 64, 2816);
    }
  }
}

DEV void phaseJ(const Params& p, int l, char* smem) {
  u16* sA = (u16*)smem;
  const u16* ACT = (const u16*)(WS(p) + OFF_ZA);
  const u16* W = (const u16*)(WS(p) + OFF_WT) + WFOUT_O;
  for (int tile = BID(); tile < 64 * 8; tile += gridDim.x) {
    int tm = tile >> 3, tn = tile & 7;
    f32x4 acc[6][4]; zero_acc<6, 4>(acc);
    gemm_loop<6, 4>(ACT + (size_t)tm * 192 * 2816, 2816, W + (size_t)tn * 128 * 2816, 2816, 2816, acc, sA);
    resid_store<6, 4>(p, acc, l, 5, tm * 192, tn * 128, false);
  }
}


#define XB_TMO      128
#define XB_XCNT(j)  (256  + 64 * (j))
#define XB_XSUB(j)  (1280 + 64 * (j))
#define XB_XGEN(j)  (2304 + 64 * (j))
#define XB_TOP      3328
#define XB_TOPGEN   3392
#define XB_SPIN_CAP (1u << 22)
#define LAS __attribute__((address_space(3)))
DEV unsigned xb_ld(unsigned* p) { return __hip_atomic_load(p, __ATOMIC_RELAXED, __HIP_MEMORY_SCOPE_AGENT); }
DEV unsigned xb_add(unsigned* p, unsigned v) { return __hip_atomic_fetch_add(p, v, __ATOMIC_RELAXED, __HIP_MEMORY_SCOPE_AGENT); }
DEV unsigned xb_xcc_id() { return (unsigned)__builtin_amdgcn_s_getreg((3 << 11) | 20) & 0xFu; }
#define XB_SPIN(cond, bar) do { unsigned _sp = 0; while (cond) { __builtin_amdgcn_s_sleep(1); \
    if ((++_sp & 255u) == 0u) { if (xb_ld(&(bar)[XB_TMO])) break; if (_sp > XB_SPIN_CAP) { atomicAdd(&(bar)[XB_TMO], 1u); break; } } } } while (0)
struct XcdBarrier { unsigned* bar; unsigned x; volatile LAS unsigned* st; };
DEV XcdBarrier xcd_barrier_post(unsigned* bar, volatile LAS unsigned* st) {
  XcdBarrier b; b.bar = bar; b.x = xb_xcc_id(); b.st = st;
  if (threadIdx.x == 0) (void)xb_add(&bar[XB_XCNT(b.x)], 1u);
  return b;
}
DEV void xcd_barrier_complete(unsigned* bar, unsigned x, unsigned& nloc, unsigned& nx) {
  const unsigned G = gridDim.x * gridDim.y * gridDim.z;
  unsigned sum, cnt, mine, sp = 0u;
  for (;;) {
    sum = 0u; cnt = 0u; mine = 0u;
#pragma unroll
    for (unsigned j = 0; j < 16; ++j) { const unsigned c = xb_ld(&bar[XB_XCNT(j)]); sum += c; cnt += (c > 0u) ? 1u : 0u; mine = (j == x) ? c : mine; }
    if (sum == G) break;
    __builtin_amdgcn_s_sleep(1);
    if ((++sp & 255u) == 0u) { if (xb_ld(&bar[XB_TMO])) break; if (sp > XB_SPIN_CAP) { atomicAdd(&bar[XB_TMO], 1u); break; } }
  }
  nloc = mine > 0u ? mine : 1u; nx = cnt > 0u ? cnt : 1u;
}
DEV void xcd_barrier(const XcdBarrier& b) {
  asm volatile("s_waitcnt vmcnt(0)" ::: "memory");
  __syncthreads();
  if (threadIdx.x == 0) {
    unsigned* bar = b.bar;
    __builtin_amdgcn_s_waitcnt(0);
    unsigned nloc = b.st[0], nx = b.st[1];
    if (nloc == 0u) { xcd_barrier_complete(bar, b.x, nloc, nx); b.st[0] = nloc; b.st[1] = nx; }
    const unsigned old = xb_add(&bar[XB_XSUB(b.x)], 1u);
    const unsigned gen = old / nloc;
    if (old + 1u == (gen + 1u) * nloc) {
      __builtin_amdgcn_fence(__ATOMIC_RELEASE, "agent");
      asm volatile("s_waitcnt vmcnt(0)" ::: "memory");
      const unsigned og = xb_add(&bar[XB_TOP], 1u);
      const unsigned tg = og / nx;
      if (og + 1u == (tg + 1u) * nx) xb_add(&bar[XB_TOPGEN], 1u);
      else XB_SPIN(xb_ld(&bar[XB_TOPGEN]) == tg, bar);
      __builtin_amdgcn_fence(__ATOMIC_ACQUIRE, "agent");
      xb_add(&bar[XB_XGEN(b.x)], 1u);
      asm volatile("s_waitcnt vmcnt(0)" ::: "memory");
    } else {
      XB_SPIN(xb_ld(&bar[XB_XGEN(b.x)]) == gen, bar);
      __builtin_amdgcn_fence(__ATOMIC_ACQUIRE, "agent");
      asm volatile("s_waitcnt vmcnt(0)" ::: "memory");
    }
  }
  __syncthreads();
}

constexpr int SMEM_BYTES = 57792;

DEV void run_phase(const Params& p, int ph, int l, char* smem) {
  switch (ph) {
    case 0: phaseA(p, smem); break;
    case 1: norm_phase(p, l, 0); if (l == 1) layer_prep(p, 1, smem); break;
    case 2: phaseC(p, l, smem); break;
    case 3: phaseD(p, l, smem); break;
    case 4: phaseE(p, smem); break;
    case 5: phaseF(p, l, smem); break;
    case 6: phaseG(p, l, smem); break;
    case 7: norm_phase(p, l, 1); break;
    case 8: phaseI(p, l, smem); break;
    case 9: phaseJ(p, l, smem); break;
    case 10: norm_phase(p, 0, 2); break;
  }
}

#if MULTI
__global__ void __launch_bounds__(256, 2) kphase(Params p, int ph, int l) {
  __shared__ __attribute__((aligned(16))) char smem[SMEM_BYTES];
  run_phase(p, ph, l, smem);
}
#else
__global__ void __launch_bounds__(256, 2) mega(Params p) {
  __shared__ __attribute__((aligned(16))) char smem[SMEM_BYTES];
  __shared__ uint4 xb_words;
  cg::grid_group grid = cg::this_grid();
  if (threadIdx.x == 0) xb_words = make_uint4(0u, 0u, 0u, 0u);
  __syncthreads();
  XcdBarrier xb = xcd_barrier_post((unsigned*)(p.ws + OFF_BAR), (volatile LAS unsigned*)&xb_words);
  run_phase(p, 0, 0, smem);
  grid.sync();
  for (int l = 0; l < 2; l++) {
    for (int ph = 1; ph <= 9; ph++) {
      run_phase(p, ph, l, smem);
      xcd_barrier(xb);
    }
  }
  run_phase(p, 10, 0, smem);
}
#endif

extern "C" void kernel_launch(void* const* d_in, const int* in_sizes, int n_in, void* d_out, int out_size, void* d_ws, size_t ws_size, hipStream_t stream) {
  Params p{};
  for (int i = 0; i < 36; i++) p.in[i] = (const float*)d_in[i];
  p.out = (float*)d_out;
  p.ws = (char*)d_ws;
  hipMemsetAsync((char*)d_ws + OFF_MOD, 0, ZERO_BYTES, stream);
  static int grid_blocks = 0;
#if MULTI
  if (!grid_blocks) {
    int dev = 0, cus = 0, per_cu = 0;
    hipGetDevice(&dev);
    hipDeviceGetAttribute(&cus, hipDeviceAttributeMultiprocessorCount, dev);
    hipOccupancyMaxActiveBlocksPerMultiprocessor(&per_cu, kphase, 256, 0);
    if (per_cu > 2) per_cu = 2;
    if (per_cu < 1) per_cu = 1;
    grid_blocks = cus * per_cu;
  }
  kphase<<<grid_blocks, 256, 0, stream>>>(p, 0, 0);
  for (int l = 0; l < 2; l++)
    for (int ph = 1; ph <= 9; ph++) kphase<<<grid_blocks, 256, 0, stream>>>(p, ph, l);
  kphase<<<grid_blocks, 256, 0, stream>>>(p, 10, 0);
#else
  if (!grid_blocks) {
    int dev = 0, cus = 0, per_cu = 0;
    hipGetDevice(&dev);
    hipDeviceGetAttribute(&cus, hipDeviceAttributeMultiprocessorCount, dev);
    hipOccupancyMaxActiveBlocksPerMultiprocessor(&per_cu, mega, 256, 0);
    if (per_cu > 2) per_cu = 2;
    if (per_cu < 1) per_cu = 1;
    grid_blocks = cus * per_cu;
  }
  void* args[] = {&p};
  hipError_t e = hipLaunchCooperativeKernel((void*)mega, dim3(grid_blocks), dim3(256), args, 0, stream);
  if (e != hipSuccess) fprintf(stderr, "cooperative launch failed: %s (grid %d)\n", hipGetErrorString(e), grid_blocks);
#endif
}
```

```cpp
#include <hip/hip_runtime.h>
#include <hip/hip_cooperative_groups.h>
#include <cstdio>
namespace cg = cooperative_groups;

#ifndef MULTI
#define MULTI 0
#endif

typedef unsigned short u16;
using bf16x8 = __attribute__((ext_vector_type(8))) short;
using f32x4 = __attribute__((ext_vector_type(4))) float;
using u32x4 = __attribute__((ext_vector_type(4))) unsigned;
using u32x2 = __attribute__((ext_vector_type(2))) unsigned;
#define DEV __device__ __forceinline__

constexpr int MT = 12288;
constexpr size_t OFF_WT = 0;
constexpr int WIN_O = 0, WGLU_O = 7340032, WRETO_O = 8388608, WHYO_O = 8912896, WOUT_O = 9437184, WFIN_O = 10485760, WFOUT_O = 16252928;
constexpr size_t OFF_G = 38273024;
constexpr size_t OFF_H = 48758784;
constexpr size_t OFF_ZA = 73924608;
constexpr size_t OFF_HYZ = 124256256;
constexpr size_t OFF_VT = 162004992;
constexpr size_t OFF_KT = 174587904;
constexpr size_t OFF_QR = 182976512;
constexpr size_t OFF_YP = 187170816;
constexpr size_t OFF_OUT1 = 212336640;
constexpr size_t OFF_MOD = 237502464;
constexpr size_t OFF_SUMSQ = OFF_MOD + 245760;
constexpr size_t OFF_BAR = OFF_SUMSQ + 16384;
constexpr size_t ZERO_BYTES = 245760 + 16384 + 16384;
constexpr size_t OFF_LAMBAR = OFF_BAR + 16384;
constexpr size_t OFF_BBAR = OFF_LAMBAR + 65536;
constexpr size_t OFF_CM = OFF_BBAR + 524288;
constexpr size_t OFF_ROPE = OFF_CM + 524288;
constexpr size_t OFF_S0T = OFF_ROPE + 524288;
constexpr size_t WS_END = OFF_S0T + 2097152;

struct Params {
  const float* in[36];
  float* out;
  char* ws;
};


DEV int TID() { int t = threadIdx.x; asm volatile("" : "+v"(t)); return t; }
DEV int BID() { int t = blockIdx.x; asm volatile("" : "+s"(t)); return t; }
#define GAS __attribute__((address_space(1)))
DEV char* WS(const Params& p) { unsigned long long w = (unsigned long long)p.ws; asm volatile("" : "+s"(w)); return (char*)(GAS char*)w; }
DEV float* OUTP(const Params& p) { unsigned long long w = (unsigned long long)p.out; asm volatile("" : "+s"(w)); return (float*)(GAS float*)w; }
DEV const float* INP(const Params& p, int i) { unsigned long long w = (unsigned long long)p.in[i]; asm volatile("" : "+s"(w)); return (const float*)(GAS const float*)w; }

DEV u16 f2bf(float f) { unsigned u = __float_as_uint(f); u += 0x7fffu + ((u >> 16) & 1u); return (u16)(u >> 16); }
DEV float bf2f(u16 h) { return __uint_as_float(((unsigned)h) << 16); }
DEV float sigm(float x) { return 1.f / (1.f + __expf(-x)); }
DEV float silu_(float x) { return x / (1.f + __expf(-x)); }
DEV float gelu_(float x) { float u = 0.7978845608028654f * (x + 0.044715f * x * x * x); return 0.5f * x * (1.f + tanhf(u)); }
DEV unsigned pack2(float a, float b) { return (unsigned)f2bf(a) | ((unsigned)f2bf(b) << 16); }

DEV const float* xin_row(const Params& p, int row) { return row < 8192 ? INP(p, 0) + (size_t)row * 1024 : INP(p, 1) + (size_t)(row - 8192) * 1024; }
DEV int modidx(int row) { return row < 8192 ? 0 : 1 + ((row - 8192) >> 10); }

template <int MF, int NF>
DEV void gemm_loop(const u16* __restrict__ A, int lda, const u16* __restrict__ B, int ldb, int K, f32x4 (&acc)[MF][NF], u16* sA) {
  const int tid = TID(), lane = tid & 63, wid = tid >> 6, wr = wid >> 1, wc = wid & 1, fr = lane & 15, fq = lane >> 4;
  u16* sB = sA + MF * 32 * 72;
  u32x4 ra[MF], rb[NF];
  const int crow = tid >> 3, ccol = (tid & 7) * 8;
  const u16* Ap = A + (size_t)crow * lda + ccol;
  const u16* Bp = B + (size_t)crow * ldb + ccol;
#pragma unroll
  for (int i = 0; i < MF; i++) ra[i] = *(const u32x4*)(Ap + (size_t)(i * 32) * lda);
#pragma unroll
  for (int i = 0; i < NF; i++) rb[i] = *(const u32x4*)(Bp + (size_t)(i * 32) * ldb);
  for (int k0 = 0; k0 < K; k0 += 64) {
    __syncthreads();
#pragma unroll
    for (int i = 0; i < MF; i++) *(u32x4*)(sA + (crow + i * 32) * 72 + ccol) = ra[i];
#pragma unroll
    for (int i = 0; i < NF; i++) *(u32x4*)(sB + (crow + i * 32) * 72 + ccol) = rb[i];
    __syncthreads();
    if (k0 + 64 < K) {
#pragma unroll
      for (int i = 0; i < MF; i++) ra[i] = *(const u32x4*)(Ap + (size_t)(i * 32) * lda + k0 + 64);
#pragma unroll
      for (int i = 0; i < NF; i++) rb[i] = *(const u32x4*)(Bp + (size_t)(i * 32) * ldb + k0 + 64);
    }
#pragma unroll
    for (int ks = 0; ks < 2; ks++) {
      bf16x8 bv[NF];
#pragma unroll
      for (int n = 0; n < NF; n++) bv[n] = *(const bf16x8*)(sB + (wc * (NF * 16) + n * 16 + fr) * 72 + ks * 32 + fq * 8);
      const u16* sAf = sA + (wr * 16 + fr) * 72 + ks * 32 + fq * 8;
      bf16x8 a_cur = *(const bf16x8*)(sAf);
      bf16x8 a_nxt = *(const bf16x8*)(sAf + 32 * 72);
#pragma unroll
      for (int m = 0; m < MF; m++) {
        bf16x8 a_n2 = a_nxt;
        if (m + 2 < MF) a_n2 = *(const bf16x8*)(sAf + (m + 2) * 32 * 72);
        __builtin_amdgcn_sched_barrier(0);
#pragma unroll
        for (int n = 0; n < NF; n++) acc[m][n] = __builtin_amdgcn_mfma_f32_16x16x32_bf16(a_cur, bv[n], acc[m][n], 0, 0, 0);
        __builtin_amdgcn_sched_barrier(0);
        a_cur = a_nxt; a_nxt = a_n2;
      }
    }
  }
}

template <int MF, int NF>
DEV void zero_acc(f32x4 (&acc)[MF][NF]) {
#pragma unroll
  for (int m = 0; m < MF; m++)
#pragma unroll
    for (int n = 0; n < NF; n++) acc[m][n] = f32x4{0.f, 0.f, 0.f, 0.f};
}

DEV float epi_op(float v, int op) { return op == 1 ? v * 0.08838834764831845f : (op == 2 ? silu_(v) : v); }
template <int MF, int NF, int TS>
DEV void acc_to_lds(const f32x4 (&acc)[MF][NF], u16* T, int m0, int op = 0) {
  const int tid = TID(), lane = tid & 63, wid = tid >> 6, wr = wid >> 1, wc = wid & 1, fr = lane & 15, fq = lane >> 4;
#pragma unroll
  for (int m = 0; m < 4; m++)
#pragma unroll
    for (int n = 0; n < NF; n++)
#pragma unroll
      for (int j = 0; j < 4; j++) T[(m * 32 + wr * 16 + fq * 4 + j) * TS + wc * (NF * 16) + n * 16 + fr] = f2bf(epi_op(acc[m0 + m][n][j], op));
}
template <int MF>
DEV void acc_to_lds_T(const f32x4 (&acc)[MF][4], u16* T, int m0, int op = 0) {
  const int tid = TID(), lane = tid & 63, wid = tid >> 6, wr = wid >> 1, wc = wid & 1, fr = lane & 15, fq = lane >> 4;
#pragma unroll
  for (int m = 0; m < 4; m++)
#pragma unroll
    for (int n = 0; n < 4; n++) {
      u32x2 v; v.x = pack2(epi_op(acc[m0 + m][n][0], op), epi_op(acc[m0 + m][n][1], op)); v.y = pack2(epi_op(acc[m0 + m][n][2], op), epi_op(acc[m0 + m][n][3], op));
      *(u32x2*)(T + (wc * 64 + n * 16 + fr) * 136 + m * 32 + wr * 16 + fq * 4) = v;
    }
}
template <int COLS, int TS>
DEV void copy_tile(const u16* T, u16* dst, int ld) {
  constexpr int CPR = COLS / 8;
  constexpr int NIT = 128 * CPR / 256;
#pragma unroll
  for (int i = 0; i < NIT; i++) {
    int id = TID() + i * 256; int r = id / CPR, ch = id % CPR;
    *(u32x4*)(dst + (size_t)r * ld + ch * 8) = *(const u32x4*)(T + r * TS + ch * 8);
  }
}

DEV void transpose_tile(const float* __restrict__ src, int K, int N, u16* __restrict__ dst, int tile, float* sm, int perm = 0) {
  int nk = K >> 6; int tk = tile % nk, tn = tile / nk; int k0 = tk * 64, n0 = tn * 64;
  int tx = TID() & 63, ty = TID() >> 6;
  __syncthreads();
#pragma unroll
  for (int i = 0; i < 16; i++) { int k = ty + i * 4; sm[k * 65 + tx] = src[(size_t)(k0 + k) * N + n0 + tx]; }
  __syncthreads();
#pragma unroll
  for (int i = 0; i < 16; i++) {
    int n = n0 + ty + i * 4;
    if (perm) { int half = N >> 1; int j = n < half ? n : n - half; n = (j >> 4) * 32 + (n < half ? 0 : 16) + (j & 15); }
    dst[(size_t)n * K + k0 + tx] = f2bf(sm[tx * 65 + (ty + i * 4)]);
  }
}

DEV void wt_task(const Params& p, int l, int t, float* sm) {
  u16* WT = (u16*)(WS(p) + OFF_WT);
  const float* src; int K, N, off, tt, perm = 0;
  if (t < 1792) { src = INP(p, 10) + (size_t)l * 1024 * 7168; K = 1024; N = 7168; off = WIN_O; tt = t; }
  else if (t < 2048) { src = INP(p, 19) + (size_t)l * 512 * 2048; K = 512; N = 2048; off = WGLU_O; tt = t - 1792; }
  else if (t < 2176) { src = INP(p, 21) + (size_t)l * 512 * 1024; K = 512; N = 1024; off = WRETO_O; tt = t - 2048; }
  else if (t < 2304) { src = INP(p, 31) + (size_t)l * 512 * 1024; K = 512; N = 1024; off = WHYO_O; tt = t - 2176; }
  else if (t < 2560) { src = INP(p, 32) + (size_t)l * 1024 * 1024; K = 1024; N = 1024; off = WOUT_O; tt = t - 2304; }
  else if (t < 3968) { src = INP(p, 33) + (size_t)l * 1024 * 5632; K = 1024; N = 5632; off = WFIN_O; tt = t - 2560; perm = 1; }
  else { src = INP(p, 34) + (size_t)l * 2816 * 1024; K = 2816; N = 1024; off = WFOUT_O; tt = t - 3968; }
  transpose_tile(src, K, N, WT + off, tt, sm, perm);
}

DEV void mod_task(const Params& p, int task, float* sm) {
  int cb = task % 96; int l = task / 96;
  int tid = TID(), lane = tid & 63, kq = tid >> 6;
  __syncthreads();
  for (int i = tid; i < 5120; i += 256) {
    int j = i >> 10, k = i & 1023;
    float c = (j == 0) ? INP(p, 5)[k] : INP(p, 4)[(j - 1) * 1024 + k];
    sm[i] = silu_(c);
  }
  __syncthreads();
  int col = cb * 64 + lane;
  const float* w = INP(p, 6) + (size_t)l * 1024 * 6144 + col;
  float a0 = 0, a1 = 0, a2 = 0, a3 = 0, a4 = 0;
#pragma unroll 8
  for (int kk = 0; kk < 256; kk++) {
    int k = kk * 4 + kq;
    float wv = w[(size_t)k * 6144];
    a0 += sm[k] * wv; a1 += sm[1024 + k] * wv; a2 += sm[2048 + k] * wv; a3 += sm[3072 + k] * wv; a4 += sm[4096 + k] * wv;
  }
  float* red = sm + 5120;
  red[(kq * 5 + 0) * 64 + lane] = a0; red[(kq * 5 + 1) * 64 + lane] = a1; red[(kq * 5 + 2) * 64 + lane] = a2;
  red[(kq * 5 + 3) * 64 + lane] = a3; red[(kq * 5 + 4) * 64 + lane] = a4;
  __syncthreads();
  float* MOD = (float*)(WS(p) + OFF_MOD);
  for (int i = tid; i < 320; i += 256) {
    int j = i >> 6, cc = i & 63;
    float v = ((red[(0 * 5 + j) * 64 + cc] + red[(1 * 5 + j) * 64 + cc]) + red[(2 * 5 + j) * 64 + cc]) + red[(3 * 5 + j) * 64 + cc];
    MOD[(l * 5 + j) * 6144 + cb * 64 + cc] = v;
  }
}

DEV void filt_task(const Params& p, int l, int task, float* sm) {
  int Lsel = task >= 32; int tb = Lsel ? task - 32 : task; int L = Lsel ? 1024 : 256; int t0 = tb * 8;
  int tid = TID();
  float* z = sm; float* h1 = sm + 264; float* h2 = sm + 264 + 512;
  const float* w1 = INP(p, 24) + l * 33 * 64; const float* b1 = INP(p, 25) + l * 64;
  const float* w2 = INP(p, 26) + l * 64 * 64; const float* b2 = INP(p, 27) + l * 64;
  const float* fr0 = INP(p, 28) + l * 128; const float* fr1 = fr0 + 64;
  const float* w3 = INP(p, 29) + (size_t)l * 64 * 2048;
  __syncthreads();
  for (int i = tid; i < 264; i += 256) {
    int tt = i / 33, e = i % 33; float t = (float)(t0 + tt); float v;
    if (e == 0) v = t / (float)L;
    else {
      int b = (e - 1) & 15; float band = 1e-4f + (float)b * ((15.f - 1e-4f) / 15.f);
      float ang = (6.283185307179586f / (float)L) * t * band;
      v = (e <= 16) ? cosf(ang) : -sinf(ang);
    }
    z[i] = v;
  }
  __syncthreads();
  for (int i = tid; i < 512; i += 256) {
    int tt = i >> 6, j = i & 63; float s = b1[j];
    for (int e = 0; e < 33; e++) s += z[tt * 33 + e] * w1[e * 64 + j];
    h1[i] = sinf(fr0[j] * s);
  }
  __syncthreads();
  for (int i = tid; i < 512; i += 256) {
    int tt = i >> 6, j = i & 63; float s = b2[j];
    for (int e = 0; e < 64; e++) s += h1[tt * 64 + e] * w2[e * 64 + j];
    h2[i] = sinf(fr1[j] * s);
  }
  __syncthreads();
  float* FB = (float*)(WS(p) + OFF_G) + (Lsel ? 524288 : 0);
  float* SUMSQ = (float*)(WS(p) + WS_END);
  for (int m = 0; m < 8; m++) {
    int col = tid + m * 256;
    float acc[8];
#pragma unroll
    for (int tt = 0; tt < 8; tt++) acc[tt] = 0.f;
    for (int j = 0; j < 64; j++) {
      float w = w3[j * 2048 + col];
#pragma unroll
      for (int tt = 0; tt < 8; tt++) acc[tt] += h2[tt * 64 + j] * w;
    }
    int dir = col >> 10, o = (col >> 9) & 1, c = col & 511;
    float rate = 3.0701134573253944f + (float)c * ((15.350567286626972f - 3.0701134573253944f) / 511.f);
    float ss = 0.f;
    float* Fo = FB + (size_t)o * (2 * L) * 512 + c;
#pragma unroll
    for (int tt = 0; tt < 8; tt++) {
      int t = t0 + tt;
      float val = acc[tt] * expf(-((float)t / (float)L) * rate);
      if (dir == 0) { Fo[(size_t)(L + t) * 512] = val; ss += val * val; }
      else if (t > 0) { Fo[(size_t)(L - t) * 512] = val; ss += val * val; }
      else { Fo[0] = 0.f; }
    }
    SUMSQ[((size_t)l * 160 + task) * 2048 + col] = ss;
  }
}

DEV void s5prep_task(const Params& p, int task) {
  int idx = task * 256 + TID();
  int pp = idx & 63; int lrg = idx >> 6;
  float lre = INP(p, 11)[idx], lim = INP(p, 12)[idx];
  float dt = expf(INP(p, 13)[lrg]);
  float mag = expf(lre * dt);
  float lbr = mag * cosf(lim * dt), lbi = mag * sinf(lim * dt);
  float nr = lbr - 1.f, ni = lbi; float den = lre * lre + lim * lim;
  float cr = (nr * lre + ni * lim) / den, ci = (ni * lre - nr * lim) / den;
  u16* BBAR = (u16*)(WS(p) + OFF_BBAR); u16* CM = (u16*)(WS(p) + OFF_CM); float* LB = (float*)(WS(p) + OFF_LAMBAR);
  LB[idx * 2] = lbr; LB[idx * 2 + 1] = lbi;
  for (int c = 0; c < 16; c++) {
    float br = INP(p, 14)[(size_t)idx * 16 + c], bi = INP(p, 15)[(size_t)idx * 16 + c];
    BBAR[(size_t)lrg * 2048 + pp * 16 + c] = f2bf(cr * br - ci * bi);
    BBAR[(size_t)lrg * 2048 + (64 + pp) * 16 + c] = f2bf(cr * bi + ci * br);
    CM[(size_t)lrg * 2048 + c * 128 + pp] = f2bf(INP(p, 16)[(size_t)lrg * 1024 + c * 64 + pp]);
    CM[(size_t)lrg * 2048 + c * 128 + 64 + pp] = f2bf(-INP(p, 17)[(size_t)lrg * 1024 + c * 64 + pp]);
  }
}

DEV void rope_task(const Params& p, int task) {
  int idx = task * 256 + TID(); int t = idx >> 6, d = idx & 63; int f = d & 31;
  float inv = powf(10000.f, -(float)f / 32.f);
  float pos = (d < 32) ? (float)(t >> 6) : (float)(t & 63);
  float ang = pos * inv;
  float* R = (float*)(WS(p) + OFF_ROPE);
  R[idx * 2] = cosf(ang); R[idx * 2 + 1] = sinf(ang);
}

DEV void layer_prep(const Params& p, int l, char* smem) {
  for (int t = BID(); t < 4672 + 160; t += gridDim.x) {
    if (t < 4672) wt_task(p, l, t, (float*)smem);
    else filt_task(p, l, t - 4672, (float*)smem);
  }
}
DEV void phaseA(const Params& p, char* smem) {
  for (int t = BID(); t < 192 + 32 + 256 + 256; t += gridDim.x) {
    if (t < 192) mod_task(p, t, (float*)smem);
    else if (t < 224) s5prep_task(p, t - 192);
    else if (t < 480) rope_task(p, t - 224);
    else { int tt = t - 480; int mi = tt >> 2; transpose_tile(INP(p, 3) + (size_t)mi * 16384, 128, 128, (u16*)(WS(p) + OFF_S0T) + (size_t)mi * 16384, tt & 3, (float*)smem); }
  }
  layer_prep(p, 0, smem);
}

DEV void norm_phase(const Params& p, int l, int which) {
  const int lane = TID() & 63;
  const int wave = (BID() * blockDim.x + TID()) >> 6, nw = (gridDim.x * blockDim.x) >> 6;
  u16* H = (u16*)(WS(p) + OFF_H);
  const float* MOD = (const float*)(WS(p) + OFF_MOD);
  for (int row = wave; row < MT; row += nw) {
    const float* x = (l == 0 && which == 0) ? xin_row(p, row) : OUTP(p) + (size_t)row * 1024;
    float4 v[4]; float ss = 0.f;
#pragma unroll
    for (int i = 0; i < 4; i++) { v[i] = *(const float4*)(x + i * 256 + lane * 4); ss += v[i].x * v[i].x + v[i].y * v[i].y + v[i].z * v[i].z + v[i].w * v[i].w; }
#pragma unroll
    for (int o = 32; o > 0; o >>= 1) ss += __shfl_xor(ss, o, 64);
    float rinv = rsqrtf(ss * (1.f / 1024.f) + 1e-6f);
    if (which == 2) {
      const float* nf = INP(p, 35);
#pragma unroll
      for (int i = 0; i < 4; i++) {
        float4 g = *(const float4*)(nf + i * 256 + lane * 4);
        float4 o; o.x = v[i].x * rinv * g.x; o.y = v[i].y * rinv * g.y; o.z = v[i].z * rinv * g.z; o.w = v[i].w * rinv * g.w;
        *(float4*)(OUTP(p) + (size_t)row * 1024 + i * 256 + lane * 4) = o;
      }
    } else {
      int j = modidx(row);
      const float* nwt = (which == 0 ? INP(p, 8) : INP(p, 9)) + l * 1024;
      const float* msh = MOD + (l * 5 + j) * 6144 + (which ? 3 : 0) * 1024;
      const float* msc = msh + 1024;
      const float* bsh = INP(p, 7) + l * 6144 + (which ? 3 : 0) * 1024;
      const float* bsc = bsh + 1024;
#pragma unroll
      for (int i = 0; i < 4; i++) {
        int k = i * 256 + lane * 4;
        float4 g = *(const float4*)(nwt + k);
        float4 sh = *(const float4*)(msh + k), sc = *(const float4*)(msc + k);
        float4 bh = *(const float4*)(bsh + k), bc = *(const float4*)(bsc + k);
        float o0 = v[i].x * rinv * g.x * (1.f + sc.x + bc.x) + sh.x + bh.x;
        float o1 = v[i].y * rinv * g.y * (1.f + sc.y + bc.y) + sh.y + bh.y;
        float o2 = v[i].z * rinv * g.z * (1.f + sc.z + bc.z) + sh.z + bh.z;
        float o3 = v[i].w * rinv * g.w * (1.f + sc.w + bc.w) + sh.w + bh.w;
        u32x2 pk; pk.x = pack2(o0, o1); pk.y = pack2(o2, o3);
        *(u32x2*)(H + (size_t)row * 1024 + k) = pk;
      }
    }
  }
}

DEV void phaseC(const Params& p, int l, char* smem) {
  u16* sA = (u16*)smem; u16* T = (u16*)smem;
  const u16* H = (const u16*)(WS(p) + OFF_H);
  const u16* WIN = (const u16*)(WS(p) + OFF_WT) + WIN_O;
  u16* ZA = (u16*)(WS(p) + OFF_ZA); u16* HYT = (u16*)(WS(p) + OFF_HYZ); u16* VT = (u16*)(WS(p) + OFF_VT);
  u16* KT = (u16*)(WS(p) + OFF_KT); u16* QR = (u16*)(WS(p) + OFF_QR);
  const float* ROPE = (const float*)(WS(p) + OFF_ROPE);
  const int tid = TID();
  for (int tile = BID(); tile < 48 * 32; tile += gridDim.x) {
    int tm = tile >> 5, tn = tile & 31;
    f32x4 acc[8][4]; zero_acc<8, 4>(acc);
    gemm_loop<8, 4>(H + (size_t)tm * 256 * 1024, 1024, WIN + (size_t)tn * 128 * 1024, 1024, 1024, acc, sA);
    int kind = tn >> 2, hd = tn & 3;
    const int op = kind == 2 ? 1 : (kind == 4 ? 2 : 0);
#pragma unroll
    for (int hh = 0; hh < 2; hh++) {
      int row0 = tm * 256 + hh * 128; bool lat = row0 >= 8192;
      int seq, t0, L;
      if (!lat) { seq = row0 >> 8; t0 = row0 & 255; L = 256; } else { seq = (row0 - 8192) >> 10; t0 = (row0 - 8192) & 1023; L = 1024; }
      __syncthreads();
      if (kind == 3 || kind >= 5) {
        acc_to_lds_T<8>(acc, T, hh * 4, 0);
        __syncthreads();
        u16* dst;
        if (kind == 3) dst = lat ? VT + (size_t)8192 * 512 + (size_t)((seq * 4 + hd) * 128) * 1024 + t0 : VT + (size_t)((seq * 4 + hd) * 128) * 256 + t0;
        else dst = lat ? HYT + (size_t)8192 * 1536 + ((size_t)seq * 1536 + (tn - 20) * 128) * 1024 + t0 : HYT + ((size_t)seq * 1536 + (tn - 20) * 128) * 256 + t0;
        copy_tile<128, 136>(T, dst, L);
      } else {
        acc_to_lds<8, 4, 136>(acc, T, hh * 4, op);
        __syncthreads();
        bool roped = lat && (kind == 1 || kind == 2);
        if (!(lat && kind == 2)) {
          u16* dst;
          if (kind == 0) dst = ZA + (size_t)row0 * 2048 + hd * 128;
          else if (kind == 1) dst = ZA + (size_t)row0 * 2048 + 512 + hd * 128;
          else if (kind == 2) dst = ZA + (size_t)row0 * 2048 + 1024 + hd * 128;
          else dst = ZA + (size_t)row0 * 2048 + 1536 + hd * 128;
          copy_tile<128, 136>(T, dst, 2048);
        }
        if (roped) {
          u16* dst; int ld;
          if (kind == 1) { dst = QR + (size_t)(row0 - 8192) * 512 + hd * 128; ld = 512; }
          else { dst = ZA + (size_t)row0 * 2048 + 1024 + hd * 128; ld = 2048; }
#pragma unroll 1
          for (int i = 0; i < 4; i++) {
            int id = tid + i * 256; int r = id >> 3, ch = id & 7;
            u32x4 a = *(const u32x4*)(T + r * 136 + ch * 8);
            u32x4 b = *(const u32x4*)(T + r * 136 + 64 + ch * 8);
            const float4* cs = (const float4*)(ROPE + ((size_t)(t0 + r) * 64 + ch * 8) * 2);
            u32x4 o1, o2;
#pragma unroll
            for (int q = 0; q < 4; q++) {
              float4 c4 = cs[q];
              float x1a = __uint_as_float(a[q] << 16), x1b = __uint_as_float(a[q] & 0xffff0000u);
              float x2a = __uint_as_float(b[q] << 16), x2b = __uint_as_float(b[q] & 0xffff0000u);
              o1[q] = pack2(x1a * c4.x - x2a * c4.y, x1b * c4.z - x2b * c4.w);
              o2[q] = pack2(x1a * c4.y + x2a * c4.x, x1b * c4.w + x2b * c4.z);
            }
            *(u32x4*)(dst + (size_t)r * ld + ch * 8) = o1;
            *(u32x4*)(dst + (size_t)r * ld + 64 + ch * 8) = o2;
          }
        }
        if (kind == 2 && !lat) {
          __syncthreads();
          acc_to_lds_T<8>(acc, T, hh * 4, op);
          __syncthreads();
          copy_tile<128, 136>(T, KT + (size_t)((seq * 4 + hd) * 128) * 256 + t0, 256);
        }
      }
    }
  }
}

DEV void s5_task(const Params& p, int l, int task, char* smem) {
  const int tid = TID(), lane = tid & 63, wid = tid >> 6, fr = lane & 15, fq = lane >> 4;
  int seq, gp;
  if (task < 64) { seq = 32 + (task >> 4); gp = task & 15; } else { int t2 = task - 64; seq = t2 >> 4; gp = t2 & 15; }
  const bool lat = seq >= 32;
  const int L = lat ? 1024 : 256;
  const int row0 = lat ? 8192 + (seq - 32) * 1024 : seq * 256;
  const int grp = gp * 2 + (wid >> 1), dir = wid & 1;
  const int lrg = (l * 2 + dir) * 32 + grp;
  float* BU = (float*)(smem + wid * 12544);
  u16* HB = (u16*)(smem + wid * 12544 + 8192);
  u16* ZA = (u16*)(WS(p) + OFF_ZA);
  float* YP = (float*)(WS(p) + OFF_YP);
  const u16* BBAR = (const u16*)(WS(p) + OFF_BBAR) + (size_t)lrg * 2048;
  const u16* CM = (const u16*)(WS(p) + OFF_CM) + (size_t)lrg * 2048;
  const float* LB = (const float*)(WS(p) + OFF_LAMBAR) + ((size_t)lrg * 64 + lane) * 2;
  const float lr = LB[0], li = LB[1];
  bf16x8 bfrag[8], cfrag[4];
  const bf16x8 zero8 = {0, 0, 0, 0, 0, 0, 0, 0};
#pragma unroll
  for (int nt = 0; nt < 8; nt++) bfrag[nt] = (fq < 2) ? *(const bf16x8*)(BBAR + (nt * 16 + fr) * 16 + fq * 8) : zero8;
#pragma unroll
  for (int ks = 0; ks < 4; ks++) cfrag[ks] = *(const bf16x8*)(CM + fr * 128 + ks * 32 + fq * 8);
  float hr = 0.f, hi = 0.f;
  if (lat) {
    const float* s0 = INP(p, 2) + ((((size_t)(seq - 32) * 2 + l) * 2 + dir) * 32 + grp) * 128 + lane * 2;
    hr = s0[0]; hi = s0[1];
  }
  const float dcoef = INP(p, 18)[l * 512 + grp * 16 + fr];
  const int nch = L >> 4;
  __syncthreads();
  const int half = nch >> 1;
  bf16x8 ua_next = (fq < 2) ? *(const bf16x8*)(ZA + (size_t)(row0 + (dir ? nch - 1 : 0) * 16 + fr) * 2048 + grp * 16 + fq * 8) : zero8;
  const int tbase = dir ? 15 : 0, tstep = dir ? -1 : 1;
  for (int i = 0; i < nch; i++) {
    const int ci = dir ? nch - 1 - i : i; const int t0 = ci * 16;
    if (i == half) { asm volatile("s_waitcnt vmcnt(0)" ::: "memory"); __threadfence(); asm volatile("s_waitcnt vmcnt(0)" ::: "memory"); __syncthreads(); }
    const bf16x8 ua = ua_next;
    if (i + 1 < nch) {
      const int cn = dir ? nch - 2 - i : i + 1;
      ua_next = (fq < 2) ? *(const bf16x8*)(ZA + (size_t)(row0 + cn * 16 + fr) * 2048 + grp * 16 + fq * 8) : zero8;
    }
    float oth[4] = {0.f, 0.f, 0.f, 0.f}, uu[4] = {0.f, 0.f, 0.f, 0.f};
    if (i >= half) {
#pragma unroll
      for (int j = 0; j < 4; j++) {
        size_t row = (size_t)(row0 + t0 + fq * 4 + j);
        oth[j] = YP[row * 512 + grp * 16 + fr];
        uu[j] = bf2f(ZA[row * 2048 + grp * 16 + fr]);
      }
    }
#pragma unroll
    for (int nt = 0; nt < 8; nt++) {
      f32x4 r = __builtin_amdgcn_mfma_f32_16x16x32_bf16(ua, bfrag[nt], f32x4{0.f, 0.f, 0.f, 0.f}, 0, 0, 0);
#pragma unroll
      for (int j = 0; j < 4; j++) BU[(fq * 4 + j) * 128 + nt * 16 + fr] = r[j];
    }
    asm volatile("s_waitcnt lgkmcnt(0)" ::: "memory");
#pragma unroll
    for (int tt = 0; tt < 16; tt++) {
      const int t = tbase + tstep * tt;
      float re = BU[t * 128 + lane], im = BU[t * 128 + 64 + lane];
      float nr = lr * hr - li * hi + re; float ni = lr * hi + li * hr + im;
      hr = nr; hi = ni;
      HB[t * 136 + lane] = f2bf(hr); HB[t * 136 + 64 + lane] = f2bf(hi);
    }
    asm volatile("s_waitcnt lgkmcnt(0)" ::: "memory");
    f32x4 y = {0.f, 0.f, 0.f, 0.f};
#pragma unroll
    for (int ks = 0; ks < 4; ks++) {
      bf16x8 a = *(const bf16x8*)(HB + fr * 136 + ks * 32 + fq * 8);
      y = __builtin_amdgcn_mfma_f32_16x16x32_bf16(a, cfrag[ks], y, 0, 0, 0);
    }
    asm volatile("s_waitcnt lgkmcnt(0)" ::: "memory");
    if (i < half) {
#pragma unroll
      for (int j = 0; j < 4; j++) YP[(size_t)(row0 + t0 + fq * 4 + j) * 512 + grp * 16 + fr] = y[j];
    } else {
#pragma unroll
      for (int j = 0; j < 4; j++) {
        size_t row = (size_t)(row0 + t0 + fq * 4 + j);
        float v = y[j] + oth[j] + dcoef * uu[j];
        ZA[row * 2048 + grp * 16 + fr] = f2bf(gelu_(v));
      }
    }
  }
  if (!lat) {
    float* o = OUTP(p) + 12582912 + ((((size_t)seq * 2 + l) * 2 + dir) * 32 + grp) * 128 + lane * 2;
    o[0] = hr; o[1] = hi;
  }
}

DEV void ret_task(const Params& p, int l, int task, char* smem) {
  const int tid = TID(), lane = tid & 63, wid = tid >> 6, fr = lane & 15, fq = lane >> 4;
  int seq, h, qt; bool lat;
  if (task < 256) { lat = true; seq = task >> 6; h = (task >> 4) & 3; qt = task & 15; }
  else { int t2 = task - 256; lat = false; seq = t2 >> 4; h = (t2 >> 2) & 3; qt = t2 & 3; }
  const int L = lat ? 1024 : 256;
  const int row0 = lat ? 8192 + seq * 1024 : seq * 256;
  u16* sK = (u16*)smem; u16* sV = sK + 64 * 136; u16* sP = sV + 128 * 72 + wid * 16 * 72;
  u16* ZA = (u16*)(WS(p) + OFF_ZA);
  const u16* QR = (const u16*)(WS(p) + OFF_QR);
  const u16* VT = (const u16*)(WS(p) + OFF_VT);
  const float lgf = log1pf(-expf(INP(p, 20)[(l * 2 + 0) * 4 + h])), lgb = log1pf(-expf(INP(p, 20)[(l * 2 + 1) * 4 + h]));
  const int qrow = qt * 64 + wid * 16;
  const u16* qsrc = lat ? QR + (size_t)(row0 - 8192 + qrow + fr) * 512 + h * 128 : ZA + (size_t)(row0 + qrow + fr) * 2048 + 512 + h * 128;
  bf16x8 qa[4];
#pragma unroll
  for (int ks = 0; ks < 4; ks++) qa[ks] = *(const bf16x8*)(qsrc + ks * 32 + fq * 8);
  f32x4 o[8];
#pragma unroll
  for (int n = 0; n < 8; n++) o[n] = f32x4{0.f, 0.f, 0.f, 0.f};
  const u16* Kbase = ZA + (size_t)row0 * 2048 + 1024 + h * 128;
  const u16* Vbase = lat ? VT + (size_t)8192 * 512 + (size_t)((seq * 4 + h) * 128) * 1024 : VT + (size_t)((seq * 4 + h) * 128) * 256;
  const int nkt = L >> 6;
  for (int jt = 0; jt < nkt; jt++) {
    __syncthreads();
#pragma unroll
    for (int i = 0; i < 4; i++) {
      int id = tid + i * 256; int r = id >> 4, ch = id & 15;
      *(u32x4*)(sK + r * 136 + ch * 8) = *(const u32x4*)(Kbase + (size_t)(jt * 64 + r) * 2048 + ch * 8);
    }
#pragma unroll
    for (int i = 0; i < 4; i++) {
      int id = tid + i * 256; int e = id >> 3, ch = id & 7;
      *(u32x4*)(sV + e * 72 + ch * 8) = *(const u32x4*)(Vbase + (size_t)e * L + jt * 64 + ch * 8);
    }
    __syncthreads();
    f32x4 s[4];
#pragma unroll
    for (int nt = 0; nt < 4; nt++) s[nt] = f32x4{0.f, 0.f, 0.f, 0.f};
    {
      const u16* kp = sK + fr * 136 + fq * 8;
      bf16x8 b_cur = *(const bf16x8*)(kp);
      bf16x8 b_nxt = *(const bf16x8*)(kp + 32);
#pragma unroll
      for (int i = 0; i < 16; i++) {
        bf16x8 b_n2 = b_nxt;
        if (i + 2 < 16) b_n2 = *(const bf16x8*)(kp + ((i + 2) >> 2) * 16 * 136 + ((i + 2) & 3) * 32);
        __builtin_amdgcn_sched_barrier(0);
        s[i >> 2] = __builtin_amdgcn_mfma_f32_16x16x32_bf16(qa[i & 3], b_cur, s[i >> 2], 0, 0, 0);
        __builtin_amdgcn_sched_barrier(0);
        b_cur = b_nxt; b_nxt = b_n2;
      }
    }
#pragma unroll
    for (int nt = 0; nt < 4; nt++)
#pragma unroll
      for (int j = 0; j < 4; j++) {
        int d = (qrow + fq * 4 + j) - (jt * 64 + nt * 16 + fr);
        float w = d >= 0 ? __expf(lgf * (float)d) : __expf(lgb * (float)(-d));
        sP[(fq * 4 + j) * 72 + nt * 16 + fr] = f2bf(s[nt][j] * w);
      }
    asm volatile("s_waitcnt lgkmcnt(0)" ::: "memory");
    {
      bf16x8 pa[2];
      pa[0] = *(const bf16x8*)(sP + fr * 72 + fq * 8);
      pa[1] = *(const bf16x8*)(sP + fr * 72 + 32 + fq * 8);
      const u16* vp = sV + fr * 72 + fq * 8;
      bf16x8 b_cur = *(const bf16x8*)(vp);
      bf16x8 b_nxt = *(const bf16x8*)(vp + 16 * 72);
#pragma unroll
      for (int i = 0; i < 16; i++) {
        bf16x8 b_n2 = b_nxt;
        if (i + 2 < 16) b_n2 = *(const bf16x8*)(vp + ((i + 2) & 7) * 16 * 72 + ((i + 2) >> 3) * 32);
        __builtin_amdgcn_sched_barrier(0);
        o[i & 7] = __builtin_amdgcn_mfma_f32_16x16x32_bf16(pa[i >> 3], b_cur, o[i & 7], 0, 0, 0);
        __builtin_amdgcn_sched_barrier(0);
        b_cur = b_nxt; b_nxt = b_n2;
      }
    }
    asm volatile("s_waitcnt lgkmcnt(0)" ::: "memory");
  }
  if (lat) {
    const u16* q0src = ZA + (size_t)(row0 + qrow + fr) * 2048 + 512 + h * 128;
    bf16x8 q0[4];
#pragma unroll
    for (int ks = 0; ks < 4; ks++) q0[ks] = *(const bf16x8*)(q0src + ks * 32 + fq * 8);
#pragma unroll 1
    for (int dir = 0; dir < 2; dir++) {
      const u16* S0 = (const u16*)(WS(p) + OFF_S0T) + (size_t)((((seq * 2 + l) * 2 + dir) * 4 + h)) * 16384;
      float wj[4];
#pragma unroll
      for (int j = 0; j < 4; j++) { int gi = qrow + fq * 4 + j; wj[j] = dir == 0 ? __expf(lgf * (float)(gi + 1)) : __expf(lgb * (float)(L - 1 - gi)); }
#pragma unroll
      for (int n2 = 0; n2 < 8; n2++) {
        f32x4 tmp = {0.f, 0.f, 0.f, 0.f};
#pragma unroll
        for (int ks = 0; ks < 4; ks++) {
          bf16x8 b = *(const bf16x8*)(S0 + (size_t)(n2 * 16 + fr) * 128 + ks * 32 + fq * 8);
          tmp = __builtin_amdgcn_mfma_f32_16x16x32_bf16(q0[ks], b, tmp, 0, 0, 0);
        }
#pragma unroll
        for (int j = 0; j < 4; j++) o[n2][j] += wj[j] * tmp[j];
        asm volatile("" ::: "memory");
      }
    }
  }
#pragma unroll
  for (int j = 0; j < 4; j++) {
    float s = 0.f;
#pragma unroll
    for (int n2 = 0; n2 < 8; n2++) s += o[n2][j];
    s += __shfl_xor(s, 1, 64); s += __shfl_xor(s, 2, 64); s += __shfl_xor(s, 4, 64); s += __shfl_xor(s, 8, 64);
    float mean = s * (1.f / 128.f);
    float v = 0.f;
#pragma unroll
    for (int n2 = 0; n2 < 8; n2++) { float dd = o[n2][j] - mean; v += dd * dd; }
    v += __shfl_xor(v, 1, 64); v += __shfl_xor(v, 2, 64); v += __shfl_xor(v, 4, 64); v += __shfl_xor(v, 8, 64);
    float rstd = rsqrtf(v * (1.f / 128.f) + 1e-5f);
    size_t rbase = (size_t)(row0 + qrow + fq * 4 + j) * 2048;
#pragma unroll
    for (int n2 = 0; n2 < 8; n2++) {
      int e = n2 * 16 + fr;
      float gv = bf2f(ZA[rbase + 1536 + h * 128 + e]);
      ZA[rbase + 512 + h * 128 + e] = f2bf((o[n2][j] - mean) * rstd * gv);
    }
  }
}

DEV bf16x8 scale8(u32x4 raw, const float (&w)[8]) {
  union { u32x4 u; bf16x8 v; } r;
#pragma unroll
  for (int q = 0; q < 4; q++) {
    float a = __uint_as_float(raw[q] << 16) * w[q * 2], b = __uint_as_float(raw[q] & 0xffff0000u) * w[q * 2 + 1];
    r.u[q] = pack2(a, b);
  }
  return r.v;
}

DEV void retstate_task(const Params& p, int l, int task) {
  const int tid = TID(), lane = tid & 63, wid = tid >> 6, fr = lane & 15, fq = lane >> 4;
  int seq = task >> 3, h = (task >> 1) & 3, dir = task & 1;
  const u16* KT = (const u16*)(WS(p) + OFF_KT) + (size_t)((seq * 4 + h) * 128) * 256;
  const u16* VT = (const u16*)(WS(p) + OFF_VT) + (size_t)((seq * 4 + h) * 128) * 256;
  const float lg = log1pf(-expf(INP(p, 20)[(l * 2 + dir) * 4 + h]));
  f32x4 acc[2][8];
#pragma unroll
  for (int m = 0; m < 2; m++)
#pragma unroll
    for (int n = 0; n < 8; n++) acc[m][n] = f32x4{0.f, 0.f, 0.f, 0.f};
#pragma unroll 1
  for (int ks = 0; ks < 8; ks++) {
    float w[8];
#pragma unroll
    for (int jj = 0; jj < 8; jj++) { int j = ks * 32 + fq * 8 + jj; w[jj] = __expf(lg * (float)(dir == 0 ? 255 - j : j)); }
    bf16x8 a[2];
#pragma unroll
    for (int m = 0; m < 2; m++) a[m] = scale8(*(const u32x4*)(KT + (size_t)(wid * 32 + m * 16 + fr) * 256 + ks * 32 + fq * 8), w);
#pragma unroll
    for (int n = 0; n < 8; n++) {
      bf16x8 b = *(const bf16x8*)(VT + (size_t)(n * 16 + fr) * 256 + ks * 32 + fq * 8);
#pragma unroll
      for (int m = 0; m < 2; m++) acc[m][n] = __builtin_amdgcn_mfma_f32_16x16x32_bf16(a[m], b, acc[m][n], 0, 0, 0);
    }
  }
  float* o = OUTP(p) + 13107200 + ((((size_t)seq * 2 + l) * 2 + dir) * 4 + h) * 16384;
#pragma unroll
  for (int m = 0; m < 2; m++)
#pragma unroll
    for (int n = 0; n < 8; n++)
#pragma unroll
      for (int j = 0; j < 4; j++) o[(size_t)(wid * 32 + m * 16 + fq * 4 + j) * 128 + n * 16 + fr] = acc[m][n][j];
}

template <bool LAT>
DEV void hyena_mfma(const Params& p, int l, int task, char* smem) {
  constexpr int L = LAT ? 1024 : 256;
  constexpr int NV = LAT ? 4 : 16;
  constexpr int RS = L + 8, CS = 2 * L + 16;
  constexpr int MPW = L / 64, NKS = L / 32, NCH = L / 8, Lsel = LAT ? 1 : 0;
  const int tid = TID(), lane = tid & 63, wid = tid >> 6, fr = lane & 15, fq = lane >> 4;
  const int c = LAT ? task : (task >> 1);
  const int sg = LAT ? 0 : (task & 1);
  u16* CP = (u16*)smem; u16* XV = CP + 8 * CS; u16* GS = XV + NV * RS; u16* O1 = GS + NV * RS;
  const u16* HYT = (const u16*)(WS(p) + OFF_HYZ);
  u16* HYOT = (u16*)(WS(p) + OFF_OUT1) + (size_t)MT * 512;
  const float* cw = INP(p, 22) + (size_t)l * 3 * 1536; const float* cb = INP(p, 23) + l * 1536;
  auto sconv = [&](int arr, u16* dstA) {
    const int ch = arr * 512 + c;
    const float w0 = cw[ch], w1 = cw[1536 + ch], w2 = cw[3072 + ch], bb = cb[ch];
#pragma unroll
    for (int i = 0; i < (NV * NCH) / 256; i++) {
      int id = tid + i * 256; int n = id / NCH, t8 = (id % NCH) * 8;
      const u16* src = LAT ? HYT + (size_t)8192 * 1536 + ((size_t)n * 1536 + ch) * 1024 + t8 : HYT + ((size_t)(sg * 16 + n) * 1536 + ch) * 256 + t8;
      u32x4 raw = *(const u32x4*)src;
      float h[10];
      h[0] = t8 > 0 ? bf2f(src[-1]) : 0.f;
      h[9] = t8 + 8 < L ? bf2f(src[8]) : 0.f;
#pragma unroll
      for (int q = 0; q < 4; q++) { h[1 + 2 * q] = __uint_as_float(raw[q] << 16); h[2 + 2 * q] = __uint_as_float(raw[q] & 0xffff0000u); }
      u32x4 o;
#pragma unroll
      for (int q = 0; q < 4; q++) o[q] = pack2(w0 * h[2 * q] + w1 * h[2 * q + 1] + w2 * h[2 * q + 2] + bb, w0 * h[2 * q + 1] + w1 * h[2 * q + 2] + w2 * h[2 * q + 3] + bb);
      *(u32x4*)(dstA + n * RS + t8) = o;
    }
  };
  __syncthreads();
  sconv(0, GS);
  sconv(2, XV);
  const int rr = (-fr) & 7;
  const u16* cpl = CP + rr * CS + (L + 8 * fq - fr - rr);
#pragma unroll 1
  for (int o = 0; o < 2; o++) {
    if (o == 1) sconv(1, GS);
    u16* FL = o == 0 ? O1 : XV;
    const float* Gp = (const float*)(WS(p) + OFF_G) + (Lsel ? 524288 : 0) + (size_t)o * (2 * L) * 512 + c;
    if (tid < 2 * L / 8) {
      float f[8];
#pragma unroll
      for (int j = 0; j < 8; j++) { int u = tid * 8 + j; f[j] = u > 0 ? Gp[(size_t)(2 * L - u) * 512] : 0.f; }
      u32x4 v; v[0] = pack2(f[0], f[1]); v[1] = pack2(f[2], f[3]); v[2] = pack2(f[4], f[5]); v[3] = pack2(f[6], f[7]);
      *(u32x4*)(FL + tid * 8) = v;
    }
    if (tid < 2) *(u32x4*)(FL + 2 * L + tid * 8) = u32x4{0u, 0u, 0u, 0u};
    __syncthreads();
    if (tid < 2 * L / 8) {
      u32x4 a = *(const u32x4*)(FL + tid * 8), b = *(const u32x4*)(FL + tid * 8 + 8);
      unsigned d[8] = {a[0], a[1], a[2], a[3], b[0], b[1], b[2], b[3]};
#pragma unroll
      for (int r = 0; r < 8; r++) {
        u32x4 ov;
#pragma unroll
        for (int q = 0; q < 4; q++) ov[q] = (r & 1) ? ((d[q + (r >> 1)] >> 16) | (d[q + (r >> 1) + 1] << 16)) : d[q + (r >> 1)];
        *(u32x4*)(CP + r * CS + tid * 8) = ov;
      }
    }
    __syncthreads();
    float rn;
    {
      constexpr int NTB = LAT ? 128 : 32;
      const float* SP = (const float*)(WS(p) + WS_END) + ((size_t)l * 160 + (LAT ? 32 : 0)) * 2048 + o * 512 + c;
      float ssum = 0.f;
      for (int tb = lane; tb < NTB; tb += 64) ssum += SP[(size_t)tb * 2048] + SP[(size_t)tb * 2048 + 1024];
#pragma unroll
      for (int off = 32; off > 0; off >>= 1) ssum += __shfl_xor(ssum, off, 64);
      rn = rsqrtf(ssum + 1e-6f);
    }
    const float bias = INP(p, 30)[(l * 2 + o) * 512 + c];
    const u16* Xs = o == 0 ? XV : O1;
    f32x4 acc[MPW];
#pragma unroll
    for (int mi = 0; mi < MPW; mi++) acc[mi] = f32x4{0.f, 0.f, 0.f, 0.f};
    const bf16x8 zero8 = {0, 0, 0, 0, 0, 0, 0, 0};
    {
      bf16x8 b_next = (fr < NV) ? *(const bf16x8*)(Xs + fr * RS + fq * 8) : zero8;
#pragma unroll 1
      for (int ks = 0; ks < NKS; ks++) {
        const bf16x8 b = b_next;
        const u16* ap = cpl - 16 * (wid * MPW) + 32 * ks;
        bf16x8 a_cur = *(const bf16x8*)(ap);
        bf16x8 a_nxt = *(const bf16x8*)(ap - 16);
        if (ks + 1 < NKS) b_next = (fr < NV) ? *(const bf16x8*)(Xs + fr * RS + (ks + 1) * 32 + fq * 8) : zero8;
#pragma unroll
        for (int mi = 0; mi < MPW; mi++) {
          bf16x8 a_n2 = a_nxt;
          if (mi + 2 < MPW) a_n2 = *(const bf16x8*)(ap - 16 * (mi + 2));
          __builtin_amdgcn_sched_barrier(0);
          acc[mi] = __builtin_amdgcn_mfma_f32_16x16x32_bf16(a_cur, b, acc[mi], 0, 0, 0);
          __builtin_amdgcn_sched_barrier(0);
          a_cur = a_nxt; a_nxt = a_n2;
        }
      }
    }
    if (fr < NV) {
      const u16* gate = GS;
      const u16* vin = o == 0 ? XV : O1;
#pragma unroll
      for (int mi = 0; mi < MPW; mi++) {
        const int t0 = (wid * MPW + mi) * 16 + fq * 4;
        u32x2 gq = *(const u32x2*)(gate + fr * RS + t0), vq = *(const u32x2*)(vin + fr * RS + t0);
        float g4[4] = {__uint_as_float(gq[0] << 16), __uint_as_float(gq[0] & 0xffff0000u), __uint_as_float(gq[1] << 16), __uint_as_float(gq[1] & 0xffff0000u)};
        float v4[4] = {__uint_as_float(vq[0] << 16), __uint_as_float(vq[0] & 0xffff0000u), __uint_as_float(vq[1] << 16), __uint_as_float(vq[1] & 0xffff0000u)};
        float r4[4];
#pragma unroll
        for (int j = 0; j < 4; j++) r4[j] = g4[j] * (acc[mi][j] * rn + bias * v4[j]);
        if (o == 0) {
          u32x2 ov; ov[0] = pack2(r4[0], r4[1]); ov[1] = pack2(r4[2], r4[3]);
          *(u32x2*)(O1 + fr * RS + t0) = ov;
        } else {
          u16* dst = LAT ? HYOT + (size_t)8192 * 512 + ((size_t)fr * 512 + c) * 1024 + t0 : HYOT + ((size_t)(sg * 16 + fr) * 512 + c) * 256 + t0;
          u32x2 ov; ov[0] = pack2(r4[0], r4[1]); ov[1] = pack2(r4[2], r4[3]);
          *(u32x2*)dst = ov;
        }
      }
    }
    __syncthreads();
  }
}

DEV void phaseD(const Params& p, int l, char* smem) {
  const int nbt = gridDim.x, bt = BID();
  __shared__ int s_task;
  unsigned* ctr = (unsigned*)(WS(p) + OFF_BAR) + 3600 + l * 8;
  if (nbt >= 128 && bt < 64) {
    s5_task(p, l, bt, smem);
    return;
  }
  const int s5lo = nbt >= 128 ? 64 : 0;
#define PULL(pool, limit, body) for (;;) { __syncthreads(); if (threadIdx.x == 0) s_task = (int)atomicAdd(&ctr[pool], 1u); __syncthreads(); \
                                           const int t = s_task; if (t >= (limit)) break; body; }
  PULL(0, 768, ret_task(p, l, t, smem))
  PULL(1, 512, hyena_mfma<true>(p, l, t, smem))
  PULL(2, 576 - s5lo, s5_task(p, l, s5lo + t, smem))
  PULL(3, 1024, hyena_mfma<false>(p, l, t, smem))
  PULL(4, 256, retstate_task(p, l, t))
#undef PULL
}

DEV void phaseE(const Params& p, char* smem) {
  const u16* HYOT = (const u16*)(WS(p) + OFF_OUT1) + (size_t)MT * 512;
  u16* HYO = (u16*)(WS(p) + OFF_OUT1);
  u16* sm = (u16*)smem;
  const int tx = TID() & 63, ty = TID() >> 6;
  for (int tile = BID(); tile < 192 * 8; tile += gridDim.x) {
    int rt = tile >> 3, c0 = (tile & 7) * 64; int row0 = rt * 64;
    const u16* src = row0 < 8192 ? HYOT + ((size_t)(row0 >> 8) * 512 + c0) * 256 + (row0 & 255)
                                 : HYOT + (size_t)8192 * 512 + ((size_t)((row0 - 8192) >> 10) * 512 + c0) * 1024 + ((row0 - 8192) & 1023);
    const int L = row0 < 8192 ? 256 : 1024;
    __syncthreads();
#pragma unroll
    for (int i = 0; i < 16; i++) { int cc = ty + i * 4; sm[cc * 66 + tx] = src[(size_t)cc * L + tx]; }
    __syncthreads();
#pragma unroll
    for (int i = 0; i < 16; i++) { int tt = ty + i * 4; HYO[(size_t)(row0 + tt) * 512 + c0 + tx] = sm[tx * 66 + tt]; }
  }
}

DEV void phaseF(const Params& p, int l, char* smem) {
  u16* sA = (u16*)smem; u16* T = (u16*)smem;
  const u16* H = (const u16*)(WS(p) + OFF_H);
  const u16* WT = (const u16*)(WS(p) + OFF_WT);
  const u16* ZA = (const u16*)(WS(p) + OFF_ZA); const u16* HYO = (const u16*)(WS(p) + OFF_OUT1);
  u16* MG = (u16*)(WS(p) + OFF_YP);
  for (int tile = BID(); tile < 96 * 16; tile += gridDim.x) {
    int tm = tile >> 4, tn = tile & 15; int row0 = tm * 128, n0 = tn * 64;
    f32x4 a1[4][2], a2[4][2], tt[4][2];
    const u16* Hrow = H + (size_t)row0 * 1024;
    zero_acc<4, 2>(a1); zero_acc<4, 2>(tt);
#pragma unroll 1
    for (int ps = 0; ps < 7; ps++) {
      const u16* Ap; const u16* Bp; int lda, K;
      switch (ps) {
        case 0: Ap = ZA + (size_t)row0 * 2048; lda = 2048; Bp = WT + WGLU_O + (size_t)n0 * 512; K = 512; break;
        case 1: Ap = ZA + (size_t)row0 * 2048; lda = 2048; Bp = WT + WGLU_O + (size_t)(1024 + n0) * 512; K = 512; break;
        case 3: Ap = ZA + (size_t)row0 * 2048 + 512; lda = 2048; Bp = WT + WRETO_O + (size_t)n0 * 512; K = 512; break;
        case 5: Ap = HYO + (size_t)row0 * 512; lda = 512; Bp = WT + WHYO_O + (size_t)n0 * 512; K = 512; break;
        default: Ap = Hrow; lda = 1024; Bp = WT + WIN_O + (size_t)(4096 + ((ps - 2) >> 1) * 1024 + n0) * 1024; K = 1024; break;
      }
      zero_acc<4, 2>(a2);
      gemm_loop<4, 2>(Ap, lda, Bp, K, K, a2, sA);
      if (ps == 0 || ps == 3 || ps == 5) {
#pragma unroll
        for (int m = 0; m < 4; m++)
#pragma unroll
          for (int n = 0; n < 2; n++) a1[m][n] = a2[m][n];
      } else if (ps == 1) {
#pragma unroll
        for (int m = 0; m < 4; m++)
#pragma unroll
          for (int n = 0; n < 2; n++)
#pragma unroll
            for (int j = 0; j < 4; j++) a1[m][n][j] *= sigm(a2[m][n][j]);
      } else {
#pragma unroll
        for (int m = 0; m < 4; m++)
#pragma unroll
          for (int n = 0; n < 2; n++)
#pragma unroll
            for (int j = 0; j < 4; j++) tt[m][n][j] += a1[m][n][j] * sigm(a2[m][n][j]);
      }
    }
    __syncthreads();
    acc_to_lds<4, 2, 72>(tt, T, 0);
    __syncthreads();
    copy_tile<64, 72>(T, MG + (size_t)row0 * 1024 + n0, 1024);
  }
}

template <int MF, int NF>
DEV void resid_store(const Params& p, const f32x4 (&acc)[MF][NF], int l, int chunk, int row0, int col0, bool from_input) {
  const int tid = TID(), lane = tid & 63, wid = tid >> 6, wr = wid >> 1, wc = wid & 1, fr = lane & 15, fq = lane >> 4;
  float* out = OUTP(p);
#pragma unroll
  for (int m = 0; m < MF; m++) {
    const int rb = row0 + m * 32 + wr * 16 + fq * 4;
    const int j = modidx(rb);
    const float* MOD = (const float*)(WS(p) + OFF_MOD) + (l * 5 + j) * 6144 + chunk * 1024;
    const float* BM = INP(p, 7) + l * 6144 + chunk * 1024;
#pragma unroll
    for (int n = 0; n < NF; n++) {
      int col = col0 + wc * (NF * 16) + n * 16 + fr;
      float g = MOD[col] + BM[col];
#pragma unroll
      for (int jj = 0; jj < 4; jj++) {
        int row = rb + jj;
        float xo = from_input ? xin_row(p, row)[col] : out[(size_t)row * 1024 + col];
        out[(size_t)row * 1024 + col] = xo + g * acc[m][n][jj];
      }
    }
  }
}

DEV void phaseG(const Params& p, int l, char* smem) {
  u16* sA = (u16*)smem;
  const u16* MG = (const u16*)(WS(p) + OFF_YP);
  const u16* W = (const u16*)(WS(p) + OFF_WT) + WOUT_O;
  for (int tile = BID(); tile < 64 * 8; tile += gridDim.x) {
    int tm = tile >> 3, tn = tile & 7;
    f32x4 acc[6][4]; zero_acc<6, 4>(acc);
    gemm_loop<6, 4>(MG + (size_t)tm * 192 * 1024, 1024, W + (size_t)tn * 128 * 1024, 1024, 1024, acc, sA);
    resid_store<6, 4>(p, acc, l, 2, tm * 192, tn * 128, l == 0);
  }
}

DEV void phaseI(const Params& p, int l, char* smem) {
  u16* sA = (u16*)smem; u16* T = (u16*)smem;
  const u16* H = (const u16*)(WS(p) + OFF_H);
  const u16* W = (const u16*)(WS(p) + OFF_WT) + WFIN_O;
  u16* ACT = (u16*)(WS(p) + OFF_ZA);
  for (int tile = BID(); tile < 48 * 44; tile += gridDim.x) {
    int tm = tile / 44, tn = tile % 44;
    f32x4 acc[8][4]; zero_acc<8, 4>(acc);
    gemm_loop<8, 4>(H + (size_t)tm * 256 * 1024, 1024, W + (size_t)tn * 128 * 1024, 1024, 1024, acc, sA);
    const int tid = TID(), lane = tid & 63, wid = tid >> 6, wr = wid >> 1, wc = wid & 1, fr = lane & 15, fq = lane >> 4;
#pragma unroll
    for (int hh = 0; hh < 2; hh++) {
      __syncthreads();
#pragma unroll
      for (int m = 0; m < 4; m++)
#pragma unroll
        for (int n = 0; n < 2; n++)
#pragma unroll
          for (int j = 0; j < 4; j++)
            T[(m * 32 + wr * 16 + fq * 4 + j) * 72 + wc * 32 + n * 16 + fr] = f2bf(silu_(acc[hh * 4 + m][2 * n][j]) * acc[hh * 4 + m][2 * n + 1][j]);
      __syncthreads();
      copy_tile<64, 72>(T, ACT + (size_t)(tm * 256 + hh * 128) * 2816 + tn * 64, 2816);
    }
  }
}

DEV void phaseJ(const Params& p, int l, char* smem) {
  u16* sA = (u16*)smem;
  const u16* ACT = (const u16*)(WS(p) + OFF_ZA);
  const u16* W = (const u16*)(WS(p) + OFF_WT) + WFOUT_O;
  for (int tile = BID(); tile < 64 * 8; tile += gridDim.x) {
    int tm = tile >> 3, tn = tile & 7;
    f32x4 acc[6][4]; zero_acc<6, 4>(acc);
    gemm_loop<6, 4>(ACT + (size_t)tm * 192 * 2816, 2816, W + (size_t)tn * 128 * 2816, 2816, 2816, acc, sA);
    resid_store<6, 4>(p, acc, l, 5, tm * 192, tn * 128, false);
  }
}


#define XB_TMO      128
#define XB_XCNT(j)  (256  + 64 * (j))
#define XB_XSUB(j)  (1280 + 64 * (j))
#define XB_XGEN(j)  (2304 + 64 * (j))
#define XB_TOP      3328
#define XB_TOPGEN   3392
#define XB_SPIN_CAP (1u << 22)
#define LAS __attribute__((address_space(3)))
DEV unsigned xb_ld(unsigned* p) { return __hip_atomic_load(p, __ATOMIC_RELAXED, __HIP_MEMORY_SCOPE_AGENT); }
DEV unsigned xb_add(unsigned* p, unsigned v) { return __hip_atomic_fetch_add(p, v, __ATOMIC_RELAXED, __HIP_MEMORY_SCOPE_AGENT); }
DEV unsigned xb_xcc_id() { return (unsigned)__builtin_amdgcn_s_getreg((3 << 11) | 20) & 0xFu; }
#define XB_SPIN(cond, bar) do { unsigned _sp = 0; while (cond) { __builtin_amdgcn_s_sleep(1); \
    if ((++_sp & 255u) == 0u) { if (xb_ld(&(bar)[XB_TMO])) break; if (_sp > XB_SPIN_CAP) { atomicAdd(&(bar)[XB_TMO], 1u); break; } } } } while (0)
struct XcdBarrier { unsigned* bar; unsigned x; volatile LAS unsigned* st; };
DEV XcdBarrier xcd_barrier_post(unsigned* bar, volatile LAS unsigned* st) {
  XcdBarrier b; b.bar = bar; b.x = xb_xcc_id(); b.st = st;
  if (threadIdx.x == 0) (void)xb_add(&bar[XB_XCNT(b.x)], 1u);
  return b;
}
DEV void xcd_barrier_complete(unsigned* bar, unsigned x, unsigned& nloc, unsigned& nx) {
  const unsigned G = gridDim.x * gridDim.y * gridDim.z;
  unsigned sum, cnt, mine, sp = 0u;
  for (;;) {
    sum = 0u; cnt = 0u; mine = 0u;
#pragma unroll
    for (unsigned j = 0; j < 16; ++j) { const unsigned c = xb_ld(&bar[XB_XCNT(j)]); sum += c; cnt += (c > 0u) ? 1u : 0u; mine = (j == x) ? c : mine; }
    if (sum == G) break;
    __builtin_amdgcn_s_sleep(1);
    if ((++sp & 255u) == 0u) { if (xb_ld(&bar[XB_TMO])) break; if (sp > XB_SPIN_CAP) { atomicAdd(&bar[XB_TMO], 1u); break; } }
  }
  nloc = mine > 0u ? mine : 1u; nx = cnt > 0u ? cnt : 1u;
}
DEV void xcd_barrier(const XcdBarrier& b) {
  asm volatile("s_waitcnt vmcnt(0)" ::: "memory");
  __syncthreads();
  if (threadIdx.x == 0) {
    unsigned* bar = b.bar;
    __builtin_amdgcn_s_waitcnt(0);
    unsigned nloc = b.st[0], nx = b.st[1];
    if (nloc == 0u) { xcd_barrier_complete(bar, b.x, nloc, nx); b.st[0] = nloc; b.st[1] = nx; }
    const unsigned old = xb_add(&bar[XB_XSUB(b.x)], 1u);
    const unsigned gen = old / nloc;
    if (old + 1u == (gen + 1u) * nloc) {
      __builtin_amdgcn_fence(__ATOMIC_RELEASE, "agent");
      asm volatile("s_waitcnt vmcnt(0)" ::: "memory");
      const unsigned og = xb_add(&bar[XB_TOP], 1u);
      const unsigned tg = og / nx;
      if (og + 1u == (tg + 1u) * nx) xb_add(&bar[XB_TOPGEN], 1u);
      else XB_SPIN(xb_ld(&bar[XB_TOPGEN]) == tg, bar);
      __builtin_amdgcn_fence(__ATOMIC_ACQUIRE, "agent");
      xb_add(&bar[XB_XGEN(b.x)], 1u);
      asm volatile("s_waitcnt vmcnt(0)" ::: "memory");
    } else {
      XB_SPIN(xb_ld(&bar[XB_XGEN(b.x)]) == gen, bar);
      __builtin_amdgcn_fence(__ATOMIC_ACQUIRE, "agent");
      asm volatile("s_waitcnt vmcnt(0)" ::: "memory");
    }
  }
  __syncthreads();
}

constexpr int SMEM_BYTES = 57792;

DEV void run_phase(const Params& p, int ph, int l, char* smem) {
  switch (ph) {
    case 0: phaseA(p, smem); break;
    case 1: norm_phase(p, l, 0); if (l == 1) layer_prep(p, 1, smem); break;
    case 2: phaseC(p, l, smem); break;
    case 3: phaseD(p, l, smem); break;
    case 4: phaseE(p, smem); break;
    case 5: phaseF(p, l, smem); break;
    case 6: phaseG(p, l, smem); break;
    case 7: norm_phase(p, l, 1); break;
    case 8: phaseI(p, l, smem); break;
    case 9: phaseJ(p, l, smem); break;
    case 10: norm_phase(p, 0, 2); break;
  }
}

#if MULTI
__global__ void __launch_bounds__(256, 2) kphase(Params p, int ph, int l) {
  __shared__ __attribute__((aligned(16))) char smem[SMEM_BYTES];
  run_phase(p, ph, l, smem);
}
#else
__global__ void __launch_bounds__(256, 2) mega(Params p) {
  __shared__ __attribute__((aligned(16))) char smem[SMEM_BYTES];
  __shared__ uint4 xb_words;
  cg::grid_group grid = cg::this_grid();
  if (threadIdx.x == 0) xb_words = make_uint4(0u, 0u, 0u, 0u);
  __syncthreads();
  XcdBarrier xb = xcd_barrier_post((unsigned*)(p.ws + OFF_BAR), (volatile LAS unsigned*)&xb_words);
  run_phase(p, 0, 0, smem);
  grid.sync();
  for (int l = 0; l < 2; l++) {
    for (int ph = 1; ph <= 9; ph++) {
      run_phase(p, ph, l, smem);
      xcd_barrier(xb);
    }
  }
  run_phase(p, 10, 0, smem);
}
#endif

extern "C" void kernel_launch(void* const* d_in, const int* in_sizes, int n_in, void* d_out, int out_size, void* d_ws, size_t ws_size, hipStream_t stream) {
  Params p{};
  for (int i = 0; i < 36; i++) p.in[i] = (const float*)d_in[i];
  p.out = (float*)d_out;
  p.ws = (char*)d_ws;
  hipMemsetAsync((char*)d_ws + OFF_MOD, 0, ZERO_BYTES, stream);
  static int grid_blocks = 0;
#if MULTI
  if (!grid_blocks) {
    int dev = 0, cus = 0, per_cu = 0;
    hipGetDevice(&dev);
    hipDeviceGetAttribute(&cus, hipDeviceAttributeMultiprocessorCount, dev);
    hipOccupancyMaxActiveBlocksPerMultiprocessor(&per_cu, kphase, 256, 0);
    if (per_cu > 2) per_cu = 2;
    if (per_cu < 1) per_cu = 1;
    grid_blocks = cus * per_cu;
  }
  kphase<<<grid_blocks, 256, 0, stream>>>(p, 0, 0);
  for (int l = 0; l < 2; l++)
    for (int ph = 1; ph <= 9; ph++) kphase<<<grid_blocks, 256, 0, stream>>>(p, ph, l);
  kphase<<<grid_blocks, 256, 0, stream>>>(p, 10, 0);
#else
  if (!grid_blocks) {
    int dev = 0, cus = 0, per_cu = 0;
    hipGetDevice(&dev);
    hipDeviceGetAttribute(&cus, hipDeviceAttributeMultiprocessorCount, dev);
    hipOccupancyMaxActiveBlocksPerMultiprocessor(&per_cu, mega, 256, 0);
    if (per_cu > 2) per_cu = 2;
    if (per_cu < 1) per_cu = 1;
    grid_blocks = cus * per_cu;
  }
  void* args[] = {&p};
  hipError_t e = hipLaunchCooperativeKernel((void*)mega, dim3(grid_blocks), dim3(256), args, 0, stream);
  if (e != hipSuccess) fprintf(stderr, "cooperative launch failed: %s (grid %d)\n", hipGetErrorString(e), grid_blocks);
#endif
}
```

```cpp
#include <hip/hip_runtime.h>
#include <hip/hip_cooperative_groups.h>
#include <cstdio>
namespace cg = cooperative_groups;

#ifndef MULTI
#define MULTI 0
#endif

typedef unsigned short u16;
using bf16x8 = __attribute__((ext_vector_type(8))) short;
using f32x4 = __attribute__((ext_vector_type(4))) float;
using u32x4 = __attribute__((ext_vector_type(4))) unsigned;
using u32x2 = __attribute__((ext_vector_type(2))) unsigned;
#define DEV __device__ __forceinline__

constexpr int MT = 12288;
constexpr size_t OFF_WT = 0;
constexpr int WIN_O = 0, WGLU_O = 7340032, WRETO_O = 8388608, WHYO_O = 8912896, WOUT_O = 9437184, WFIN_O = 10485760, WFOUT_O = 16252928;
constexpr size_t OFF_G = 38273024;
constexpr size_t OFF_H = 48758784;
constexpr size_t OFF_ZA = 73924608;
constexpr size_t OFF_HYZ = 124256256;
constexpr size_t OFF_VT = 162004992;
constexpr size_t OFF_KT = 174587904;
constexpr size_t OFF_QR = 182976512;
constexpr size_t OFF_YP = 187170816;
constexpr size_t OFF_OUT1 = 212336640;
constexpr size_t OFF_MOD = 237502464;
constexpr size_t OFF_SUMSQ = OFF_MOD + 245760;
constexpr size_t OFF_BAR = OFF_SUMSQ + 16384;
constexpr size_t ZERO_BYTES = 245760 + 16384 + 16384;
constexpr size_t OFF_LAMBAR = OFF_BAR + 16384;
constexpr size_t OFF_BBAR = OFF_LAMBAR + 65536;
constexpr size_t OFF_CM = OFF_BBAR + 524288;
constexpr size_t OFF_ROPE = OFF_CM + 524288;
constexpr size_t OFF_S0T = OFF_ROPE + 524288;
constexpr size_t WS_END = OFF_S0T + 2097152;

struct Params {
  const float* in[36];
  float* out;
  char* ws;
};


DEV int TID() { int t = threadIdx.x; asm volatile("" : "+v"(t)); return t; }
DEV int BID() { int t = blockIdx.x; asm volatile("" : "+s"(t)); return t; }
#define GAS __attribute__((address_space(1)))
DEV char* WS(const Params& p) { unsigned long long w = (unsigned long long)p.ws; asm volatile("" : "+s"(w)); return (char*)(GAS char*)w; }
DEV float* OUTP(const Params& p) { unsigned long long w = (unsigned long long)p.out; asm volatile("" : "+s"(w)); return (float*)(GAS float*)w; }
DEV const float* INP(const Params& p, int i) { unsigned long long w = (unsigned long long)p.in[i]; asm volatile("" : "+s"(w)); return (const float*)(GAS const float*)w; }

DEV u16 f2bf(float f) { unsigned u = __float_as_uint(f); u += 0x7fffu + ((u >> 16) & 1u); return (u16)(u >> 16); }
DEV float bf2f(u16 h) { return __uint_as_float(((unsigned)h) << 16); }
DEV float sigm(float x) { return 1.f / (1.f + __expf(-x)); }
DEV float silu_(float x) { return x / (1.f + __expf(-x)); }
DEV float gelu_(float x) { float u = 0.7978845608028654f * (x + 0.044715f * x * x * x); return 0.5f * x * (1.f + tanhf(u)); }
DEV unsigned pack2(float a, float b) { return (unsigned)f2bf(a) | ((unsigned)f2bf(b) << 16); }

DEV const float* xin_row(const Params& p, int row) { return row < 8192 ? INP(p, 0) + (size_t)row * 1024 : INP(p, 1) + (size_t)(row - 8192) * 1024; }
DEV int modidx(int row) { return row < 8192 ? 0 : 1 + ((row - 8192) >> 10); }

template <int MF, int NF>
DEV void gemm_loop(const u16* __restrict__ A, int lda, const u16* __restrict__ B, int ldb, int K, f32x4 (&acc)[MF][NF], u16* sA) {
  const int tid = TID(), lane = tid & 63, wid = tid >> 6, wr = wid >> 1, wc = wid & 1, fr = lane & 15, fq = lane >> 4;
  u16* sB = sA + MF * 32 * 72;
  u32x4 ra[MF], rb[NF];
  const int crow = tid >> 3, ccol = (tid & 7) * 8;
  const u16* Ap = A + (size_t)crow * lda + ccol;
  const u16* Bp = B + (size_t)crow * ldb + ccol;
#pragma unroll
  for (int i = 0; i < MF; i++) ra[i] = *(const u32x4*)(Ap + (size_t)(i * 32) * lda);
#pragma unroll
  for (int i = 0; i < NF; i++) rb[i] = *(const u32x4*)(Bp + (size_t)(i * 32) * ldb);
  for (int k0 = 0; k0 < K; k0 += 64) {
    __syncthreads();
#pragma unroll
    for (int i = 0; i < MF; i++) *(u32x4*)(sA + (crow + i * 32) * 72 + ccol) = ra[i];
#pragma unroll
    for (int i = 0; i < NF; i++) *(u32x4*)(sB + (crow + i * 32) * 72 + ccol) = rb[i];
    __syncthreads();
    if (k0 + 64 < K) {
#pragma unroll
      for (int i = 0; i < MF; i++) ra[i] = *(const u32x4*)(Ap + (size_t)(i * 32) * lda + k0 + 64);
#pragma unroll
      for (int i = 0; i < NF; i++) rb[i] = *(const u32x4*)(Bp + (size_t)(i * 32) * ldb + k0 + 64);
    }
#pragma unroll
    for (int ks = 0; ks < 2; ks++) {
      bf16x8 bv[NF];
#pragma unroll
      for (int n = 0; n < NF; n++) bv[n] = *(const bf16x8*)(sB + (wc * (NF * 16) + n * 16 + fr) * 72 + ks * 32 + fq * 8);
      const u16* sAf = sA + (wr * 16 + fr) * 72 + ks * 32 + fq * 8;
      bf16x8 a_cur = *(const bf16x8*)(sAf);
      bf16x8 a_nxt = *(const bf16x8*)(sAf + 32 * 72);
#pragma unroll
      for (int m = 0; m < MF; m++) {
        bf16x8 a_n2 = a_nxt;
        if (m + 2 < MF) a_n2 = *(const bf16x8*)(sAf + (m + 2) * 32 * 72);
        __builtin_amdgcn_sched_barrier(0);
#pragma unroll
        for (int n = 0; n < NF; n++) acc[m][n] = __builtin_amdgcn_mfma_f32_16x16x32_bf16(a_cur, bv[n], acc[m][n], 0, 0, 0);
        __builtin_amdgcn_sched_barrier(0);
        a_cur = a_nxt; a_nxt = a_n2;
      }
    }
  }
}

template <int MF, int NF>
DEV void zero_acc(f32x4 (&acc)[MF][NF]) {
#pragma unroll
  for (int m = 0; m < MF; m++)
#pragma unroll
    for (int n = 0; n < NF; n++) acc[m][n] = f32x4{0.f, 0.f, 0.f, 0.f};
}

DEV float epi_op(float v, int op) { return op == 1 ? v * 0.08838834764831845f : (op == 2 ? silu_(v) : v); }
template <int MF, int NF, int TS>
DEV void acc_to_lds(const f32x4 (&acc)[MF][NF], u16* T, int m0, int op = 0) {
  const int tid = TID(), lane = tid & 63, wid = tid >> 6, wr = wid >> 1, wc = wid & 1, fr = lane & 15, fq = lane >> 4;
#pragma unroll
  for (int m = 0; m < 4; m++)
#pragma unroll
    for (int n = 0; n < NF; n++)
#pragma unroll
      for (int j = 0; j < 4; j++) T[(m * 32 + wr * 16 + fq * 4 + j) * TS + wc * (NF * 16) + n * 16 + fr] = f2bf(epi_op(acc[m0 + m][n][j], op));
}
template <int MF>
DEV void acc_to_lds_T(const f32x4 (&acc)[MF][4], u16* T, int m0, int op = 0) {
  const int tid = TID(), lane = tid & 63, wid = tid >> 6, wr = wid >> 1, wc = wid & 1, fr = lane & 15, fq = lane >> 4;
#pragma unroll
  for (int m = 0; m < 4; m++)
#pragma unroll
    for (int n = 0; n < 4; n++) {
      u32x2 v; v.x = pack2(epi_op(acc[m0 + m][n][0], op), epi_op(acc[m0 + m][n][1], op)); v.y = pack2(epi_op(acc[m0 + m][n][2], op), epi_op(acc[m0 + m][n][3], op));
      *(u32x2*)(T + (wc * 64 + n * 16 + fr) * 136 + m * 32 + wr * 16 + fq * 4) = v;
    }
}
template <int COLS, int TS>
DEV void copy_tile(const u16* T, u16* dst, int ld) {
  constexpr int CPR = COLS / 8;
  constexpr int NIT = 128 * CPR / 256;
#pragma unroll
  for (int i = 0; i < NIT; i++) {
    int id = TID() + i * 256; int r = id / CPR, ch = id % CPR;
    *(u32x4*)(dst + (size_t)r * ld + ch * 8) = *(const u32x4*)(T + r * TS + ch * 8);
  }
}

DEV void transpose_tile(const float* __restrict__ src, int K, int N, u16* __restrict__ dst, int tile, float* sm, int perm = 0) {
  int nk = K >> 6; int tk = tile % nk, tn = tile / nk; int k0 = tk * 64, n0 = tn * 64;
  int tx = TID() & 63, ty = TID() >> 6;
  __syncthreads();
#pragma unroll
  for (int i = 0; i < 16; i++) { int k = ty + i * 4; sm[k * 65 + tx] = src[(size_t)(k0 + k) * N + n0 + tx]; }
  __syncthreads();
#pragma unroll
  for (int i = 0; i < 16; i++) {
    int n = n0 + ty + i * 4;
    if (perm) { int half = N >> 1; int j = n < half ? n : n - half; n = (j >> 4) * 32 + (n < half ? 0 : 16) + (j & 15); }
    dst[(size_t)n * K + k0 + tx] = f2bf(sm[tx * 65 + (ty + i * 4)]);
  }
}

DEV void wt_task(const Params& p, int l, int t, float* sm) {
  u16* WT = (u16*)(WS(p) + OFF_WT);
  const float* src; int K, N, off, tt, perm = 0;
  if (t < 1792) { src = INP(p, 10) + (size_t)l * 1024 * 7168; K = 1024; N = 7168; off = WIN_O; tt = t; }
  else if (t < 2048) { src = INP(p, 19) + (size_t)l * 512 * 2048; K = 512; N = 2048; off = WGLU_O; tt = t - 1792; }
  else if (t < 2176) { src = INP(p, 21) + (size_t)l * 512 * 1024; K = 512; N = 1024; off = WRETO_O; tt = t - 2048; }
  else if (t < 2304) { src = INP(p, 31) + (size_t)l * 512 * 1024; K = 512; N = 1024; off = WHYO_O; tt = t - 2176; }
  else if (t < 2560) { src = INP(p, 32) + (size_t)l * 1024 * 1024; K = 1024; N = 1024; off = WOUT_O; tt = t - 2304; }
  else if (t < 3968) { src = INP(p, 33) + (size_t)l * 1024 * 5632; K = 1024; N = 5632; off = WFIN_O; tt = t - 2560; perm = 1; }
  else { src = INP(p, 34) + (size_t)l * 2816 * 1024; K = 2816; N = 1024; off = WFOUT_O; tt = t - 3968; }
  transpose_tile(src, K, N, WT + off, tt, sm, perm);
}

DEV void mod_task(const Params& p, int task, float* sm) {
  int cb = task % 96; int l = task / 96;
  int tid = TID(), lane = tid & 63, kq = tid >> 6;
  __syncthreads();
  for (int i = tid; i < 5120; i += 256) {
    int j = i >> 10, k = i & 1023;
    float c = (j == 0) ? INP(p, 5)[k] : INP(p, 4)[(j - 1) * 1024 + k];
    sm[i] = silu_(c);
  }
  __syncthreads();
  int col = cb * 64 + lane;
  const float* w = INP(p, 6) + (size_t)l * 1024 * 6144 + col;
  float a0 = 0, a1 = 0, a2 = 0, a3 = 0, a4 = 0;
#pragma unroll 8
  for (int kk = 0; kk < 256; kk++) {
    int k = kk * 4 + kq;
    float wv = w[(size_t)k * 6144];
    a0 += sm[k] * wv; a1 += sm[1024 + k] * wv; a2 += sm[2048 + k] * wv; a3 += sm[3072 + k] * wv; a4 += sm[4096 + k] * wv;
  }
  float* red = sm + 5120;
  red[(kq * 5 + 0) * 64 + lane] = a0; red[(kq * 5 + 1) * 64 + lane] = a1; red[(kq * 5 + 2) * 64 + lane] = a2;
  red[(kq * 5 + 3) * 64 + lane] = a3; red[(kq * 5 + 4) * 64 + lane] = a4;
  __syncthreads();
  float* MOD = (float*)(WS(p) + OFF_MOD);
  for (int i = tid; i < 320; i += 256) {
    int j = i >> 6, cc = i & 63;
    float v = ((red[(0 * 5 + j) * 64 + cc] + red[(1 * 5 + j) * 64 + cc]) + red[(2 * 5 + j) * 64 + cc]) + red[(3 * 5 + j) * 64 + cc];
    MOD[(l * 5 + j) * 6144 + cb * 64 + cc] = v;
  }
}

DEV void filt_task(const Params& p, int l, int task, float* sm) {
  int Lsel = task >= 32; int tb = Lsel ? task - 32 : task; int L = Lsel ? 1024 : 256; int t0 = tb * 8;
  int tid = TID();
  float* z = sm; float* h1 = sm + 264; float* h2 = sm + 264 + 512;
  const float* w1 = INP(p, 24) + l * 33 * 64; const float* b1 = INP(p, 25) + l * 64;
  const float* w2 = INP(p, 26) + l * 64 * 64; const float* b2 = INP(p, 27) + l * 64;
  const float* fr0 = INP(p, 28) + l * 128; const float* fr1 = fr0 + 64;
  const float* w3 = INP(p, 29) + (size_t)l * 64 * 2048;
  __syncthreads();
  for (int i = tid; i < 264; i += 256) {
    int tt = i / 33, e = i % 33; float t = (float)(t0 + tt); float v;
    if (e == 0) v = t / (float)L;
    else {
      int b = (e - 1) & 15; float band = 1e-4f + (float)b * ((15.f - 1e-4f) / 15.f);
      float ang = (6.283185307179586f / (float)L) * t * band;
      v = (e <= 16) ? cosf(ang) : -sinf(ang);
    }
    z[i] = v;
  }
  __syncthreads();
  for (int i = tid; i < 512; i += 256) {
    int tt = i >> 6, j = i & 63; float s = b1[j];
    for (int e = 0; e < 33; e++) s += z[tt * 33 + e] * w1[e * 64 + j];
    h1[i] = sinf(fr0[j] * s);
  }
  __syncthreads();
  for (int i = tid; i < 512; i += 256) {
    int tt = i >> 6, j = i & 63; float s = b2[j];
    for (int e = 0; e < 64; e++) s += h1[tt * 64 + e] * w2[e * 64 + j];
    h2[i] = sinf(fr1[j] * s);
  }
  __syncthreads();
  float* FB = (float*)(WS(p) + OFF_G) + (Lsel ? 524288 : 0);
  float* SUMSQ = (float*)(WS(p) + WS_END);
  for (int m = 0; m < 8; m++) {
    int col = tid + m * 256;
    float acc[8];
#pragma unroll
    for (int tt = 0; tt < 8; tt++) acc[tt] = 0.f;
    for (int j = 0; j < 64; j++) {
      float w = w3[j * 2048 + col];
#pragma unroll
      for (int tt = 0; tt < 8; tt++) acc[tt] += h2[tt * 64 + j] * w;
    }
    int dir = col >> 10, o = (col >> 9) & 1, c = col & 511;
    float rate = 3.0701134573253944f + (float)c * ((15.350567286626972f - 3.0701134573253944f) / 511.f);
    float ss = 0.f;
    float* Fo = FB + (size_t)o * (2 * L) * 512 + c;
#pragma unroll
    for (int tt = 0; tt < 8; tt++) {
      int t = t0 + tt;
      float val = acc[tt] * expf(-((float)t / (float)L) * rate);
      if (dir == 0) { Fo[(size_t)(L + t) * 512] = val; ss += val * val; }
      else if (t > 0) { Fo[(size_t)(L - t) * 512] = val; ss += val * val; }
      else { Fo[0] = 0.f; }
    }
    SUMSQ[((size_t)l * 160 + task) * 2048 + col] = ss;
  }
}

DEV void s5prep_task(const Params& p, int task) {
  int idx = task * 256 + TID();
  int pp = idx & 63; int lrg = idx >> 6;
  float lre = INP(p, 11)[idx], lim = INP(p, 12)[idx];
  float dt = expf(INP(p, 13)[lrg]);
  float mag = expf(lre * dt);
  float lbr = mag * cosf(lim * dt), lbi = mag * sinf(lim * dt);
  float nr = lbr - 1.f, ni = lbi; float den = lre * lre + lim * lim;
  float cr = (nr * lre + ni * lim) / den, ci = (ni * lre - nr * lim) / den;
  u16* BBAR = (u16*)(WS(p) + OFF_BBAR); u16* CM = (u16*)(WS(p) + OFF_CM); float* LB = (float*)(WS(p) + OFF_LAMBAR);
  LB[idx * 2] = lbr; LB[idx * 2 + 1] = lbi;
  for (int c = 0; c < 16; c++) {
    float br = INP(p, 14)[(size_t)idx * 16 + c], bi = INP(p, 15)[(size_t)idx * 16 + c];
    BBAR[(size_t)lrg * 2048 + pp * 16 + c] = f2bf(cr * br - ci * bi);
    BBAR[(size_t)lrg * 2048 + (64 + pp) * 16 + c] = f2bf(cr * bi + ci * br);
    CM[(size_t)lrg * 2048 + c * 128 + pp] = f2bf(INP(p, 16)[(size_t)lrg * 1024 + c * 64 + pp]);
    CM[(size_t)lrg * 2048 + c * 128 + 64 + pp] = f2bf(-INP(p, 17)[(size_t)lrg * 1024 + c * 64 + pp]);
  }
}

DEV void rope_task(const Params& p, int task) {
  int idx = task * 256 + TID(); int t = idx >> 6, d = idx & 63; int f = d & 31;
  float inv = powf(10000.f, -(float)f / 32.f);
  float pos = (d < 32) ? (float)(t >> 6) : (float)(t & 63);
  float ang = pos * inv;
  float* R = (float*)(WS(p) + OFF_ROPE);
  R[idx * 2] = cosf(ang); R[idx * 2 + 1] = sinf(ang);
}

DEV void layer_prep(const Params& p, int l, char* smem) {
  for (int t = BID(); t < 4672 + 160; t += gridDim.x) {
    if (t < 4672) wt_task(p, l, t, (float*)smem);
    else filt_task(p, l, t - 4672, (float*)smem);
  }
}
DEV void phaseA(const Params& p, char* smem) {
  for (int t = BID(); t < 192 + 32 + 256 + 256; t += gridDim.x) {
    if (t < 192) mod_task(p, t, (float*)smem);
    else if (t < 224) s5prep_task(p, t - 192);
    else if (t < 480) rope_task(p, t - 224);
    else { int tt = t - 480; int mi = tt >> 2; transpose_tile(INP(p, 3) + (size_t)mi * 16384, 128, 128, (u16*)(WS(p) + OFF_S0T) + (size_t)mi * 16384, tt & 3, (float*)smem); }
  }
  layer_prep(p, 0, smem);
}

DEV void norm_phase(const Params& p, int l, int which) {
  const int lane = TID() & 63;
  const int wave = (BID() * blockDim.x + TID()) >> 6, nw = (gridDim.x * blockDim.x) >> 6;
  u16* H = (u16*)(WS(p) + OFF_H);
  const float* MOD = (const float*)(WS(p) + OFF_MOD);
  for (int row = wave; row < MT; row += nw) {
    const float* x = (l == 0 && which == 0) ? xin_row(p, row) : OUTP(p) + (size_t)row * 1024;
    float4 v[4]; float ss = 0.f;
#pragma unroll
    for (int i = 0; i < 4; i++) { v[i] = *(const float4*)(x + i * 256 + lane * 4); ss += v[i].x * v[i].x + v[i].y * v[i].y + v[i].z * v[i].z + v[i].w * v[i].w; }
#pragma unroll
    for (int o = 32; o > 0; o >>= 1) ss += __shfl_xor(ss, o, 64);
    float rinv = rsqrtf(ss * (1.f / 1024.f) + 1e-6f);
    if (which == 2) {
      const float* nf = INP(p, 35);
#pragma unroll
      for (int i = 0; i < 4; i++) {
        float4 g = *(const float4*)(nf + i * 256 + lane * 4);
        float4 o; o.x = v[i].x * rinv * g.x; o.y = v[i].y * rinv * g.y; o.z = v[i].z * rinv * g.z; o.w = v[i].w * rinv * g.w;
        *(float4*)(OUTP(p) + (size_t)row * 1024 + i * 256 + lane * 4) = o;
      }
    } else {
      int j = modidx(row);
      const float* nwt = (which == 0 ? INP(p, 8) : INP(p, 9)) + l * 1024;
      const float* msh = MOD + (l * 5 + j) * 6144 + (which ? 3 : 0) * 1024;
      const float* msc = msh + 1024;
      const float* bsh = INP(p, 7) + l * 6144 + (which ? 3 : 0) * 1024;
      const float* bsc = bsh + 1024;
#pragma unroll
      for (int i = 0; i < 4; i++) {
        int k = i * 256 + lane * 4;
        float4 g = *(const float4*)(nwt + k);
        float4 sh = *(const float4*)(msh + k), sc = *(const float4*)(msc + k);
        float4 bh = *(const float4*)(bsh + k), bc = *(const float4*)(bsc + k);
        float o0 = v[i].x * rinv * g.x * (1.f + sc.x + bc.x) + sh.x + bh.x;
        float o1 = v[i].y * rinv * g.y * (1.f + sc.y + bc.y) + sh.y + bh.y;
        float o2 = v[i].z * rinv * g.z * (1.f + sc.z + bc.z) + sh.z + bh.z;
        float o3 = v[i].w * rinv * g.w * (1.f + sc.w + bc.w) + sh.w + bh.w;
        u32x2 pk; pk.x = pack2(o0, o1); pk.y = pack2(o2, o3);
        *(u32x2*)(H + (size_t)row * 1024 + k) = pk;
      }
    }
  }
}

DEV void phaseC(const Params& p, int l, char* smem) {
  u16* sA = (u16*)smem; u16* T = (u16*)smem;
  const u16* H = (const u16*)(WS(p) + OFF_H);
  const u16* WIN = (const u16*)(WS(p) + OFF_WT) + WIN_O;
  u16* ZA = (u16*)(WS(p) + OFF_ZA); u16* HYT = (u16*)(WS(p) + OFF_HYZ); u16* VT = (u16*)(WS(p) + OFF_VT);
  u16* KT = (u16*)(WS(p) + OFF_KT); u16* QR = (u16*)(WS(p) + OFF_QR);
  const float* ROPE = (const float*)(WS(p) + OFF_ROPE);
  const int tid = TID();
  for (int tile = BID(); tile < 48 * 32; tile += gridDim.x) {
    int tm = tile >> 5, tn = tile & 31;
    f32x4 acc[8][4]; zero_acc<8, 4>(acc);
    gemm_loop<8, 4>(H + (size_t)tm * 256 * 1024, 1024, WIN + (size_t)tn * 128 * 1024, 1024, 1024, acc, sA);
    int kind = tn >> 2, hd = tn & 3;
    const int op = kind == 2 ? 1 : (kind == 4 ? 2 : 0);
#pragma unroll
    for (int hh = 0; hh < 2; hh++) {
      int row0 = tm * 256 + hh * 128; bool lat = row0 >= 8192;
      int seq, t0, L;
      if (!lat) { seq = row0 >> 8; t0 = row0 & 255; L = 256; } else { seq = (row0 - 8192) >> 10; t0 = (row0 - 8192) & 1023; L = 1024; }
      __syncthreads();
      if (kind == 3 || kind >= 5) {
        acc_to_lds_T<8>(acc, T, hh * 4, 0);
        __syncthreads();
        u16* dst;
        if (kind == 3) dst = lat ? VT + (size_t)8192 * 512 + (size_t)((seq * 4 + hd) * 128) * 1024 + t0 : VT + (size_t)((seq * 4 + hd) * 128) * 256 + t0;
        else dst = lat ? HYT + (size_t)8192 * 1536 + ((size_t)seq * 1536 + (tn - 20) * 128) * 1024 + t0 : HYT + ((size_t)seq * 1536 + (tn - 20) * 128) * 256 + t0;
        copy_tile<128, 136>(T, dst, L);
      } else {
        acc_to_lds<8, 4, 136>(acc, T, hh * 4, op);
        __syncthreads();
        bool roped = lat && (kind == 1 || kind == 2);
        if (!(lat && kind == 2)) {
          u16* dst;
          if (kind == 0) dst = ZA + (size_t)row0 * 2048 + hd * 128;
          else if (kind == 1) dst = ZA + (size_t)row0 * 2048 + 512 + hd * 128;
          else if (kind == 2) dst = ZA + (size_t)row0 * 2048 + 1024 + hd * 128;
          else dst = ZA + (size_t)row0 * 2048 + 1536 + hd * 128;
          copy_tile<128, 136>(T, dst, 2048);
        }
        if (roped) {
          u16* dst; int ld;
          if (kind == 1) { dst = QR + (size_t)(row0 - 8192) * 512 + hd * 128; ld = 512; }
          else { dst = ZA + (size_t)row0 * 2048 + 1024 + hd * 128; ld = 2048; }
#pragma unroll 1
          for (int i = 0; i < 4; i++) {
            int id = tid + i * 256; int r = id >> 3, ch = id & 7;
            u32x4 a = *(const u32x4*)(T + r * 136 + ch * 8);
            u32x4 b = *(const u32x4*)(T + r * 136 + 64 + ch * 8);
            const float4* cs = (const float4*)(ROPE + ((size_t)(t0 + r) * 64 + ch * 8) * 2);
            u32x4 o1, o2;
#pragma unroll
            for (int q = 0; q < 4; q++) {
              float4 c4 = cs[q];
              float x1a = __uint_as_float(a[q] << 16), x1b = __uint_as_float(a[q] & 0xffff0000u);
              float x2a = __uint_as_float(b[q] << 16), x2b = __uint_as_float(b[q] & 0xffff0000u);
              o1[q] = pack2(x1a * c4.x - x2a * c4.y, x1b * c4.z - x2b * c4.w);
              o2[q] = pack2(x1a * c4.y + x2a * c4.x, x1b * c4.w + x2b * c4.z);
            }
            *(u32x4*)(dst + (size_t)r * ld + ch * 8) = o1;
            *(u32x4*)(dst + (size_t)r * ld + 64 + ch * 8) = o2;
          }
        }
        if (kind == 2 && !lat) {
          __syncthreads();
          acc_to_lds_T<8>(acc, T, hh * 4, op);
          __syncthreads();
          copy_tile<128, 136>(T, KT + (size_t)((seq * 4 + hd) * 128) * 256 + t0, 256);
        }
      }
    }
  }
}

DEV void s5_task(const Params& p, int l, int task, char* smem) {
  const int tid = TID(), lane = tid & 63, wid = tid >> 6, fr = lane & 15, fq = lane >> 4;
  int seq, gp;
  if (task < 64) { seq = 32 + (task >> 4); gp = task & 15; } else { int t2 = task - 64; seq = t2 >> 4; gp = t2 & 15; }
  const bool lat = seq >= 32;
  const int L = lat ? 1024 : 256;
  const int row0 = lat ? 8192 + (seq - 32) * 1024 : seq * 256;
  const int grp = gp * 2 + (wid >> 1), dir = wid & 1;
  const int lrg = (l * 2 + dir) * 32 + grp;
  float* BU = (float*)(smem + wid * 12544);
  u16* HB = (u16*)(smem + wid * 12544 + 8192);
  u16* ZA = (u16*)(WS(p) + OFF_ZA);
  float* YP = (float*)(WS(p) + OFF_YP);
  const u16* BBAR = (const u16*)(WS(p) + OFF_BBAR) + (size_t)lrg * 2048;
  const u16* CM = (const u16*)(WS(p) + OFF_CM) + (size_t)lrg * 2048;
  const float* LB = (const float*)(WS(p) + OFF_LAMBAR) + ((size_t)lrg * 64 + lane) * 2;
  const float lr = LB[0], li = LB[1];
  bf16x8 bfrag[8], cfrag[4];
  const bf16x8 zero8 = {0, 0, 0, 0, 0, 0, 0, 0};
#pragma unroll
  for (int nt = 0; nt < 8; nt++) bfrag[nt] = (fq < 2) ? *(const bf16x8*)(BBAR + (nt * 16 + fr) * 16 + fq * 8) : zero8;
#pragma unroll
  for (int ks = 0; ks < 4; ks++) cfrag[ks] = *(const bf16x8*)(CM + fr * 128 + ks * 32 + fq * 8);
  float hr = 0.f, hi = 0.f;
  if (lat) {
    const float* s0 = INP(p, 2) + ((((size_t)(seq - 32) * 2 + l) * 2 + dir) * 32 + grp) * 128 + lane * 2;
    hr = s0[0]; hi = s0[1];
  }
  const float dcoef = INP(p, 18)[l * 512 + grp * 16 + fr];
  const int nch = L >> 4;
  __syncthreads();
  const int half = nch >> 1;
  bf16x8 ua_next = (fq < 2) ? *(const bf16x8*)(ZA + (size_t)(row0 + (dir ? nch - 1 : 0) * 16 + fr) * 2048 + grp * 16 + fq * 8) : zero8;
  const int tbase = dir ? 15 : 0, tstep = dir ? -1 : 1;
  for (int i = 0; i < nch; i++) {
    const int ci = dir ? nch - 1 - i : i; const int t0 = ci * 16;
    if (i == half) { asm volatile("s_waitcnt vmcnt(0)" ::: "memory"); __threadfence(); asm volatile("s_waitcnt vmcnt(0)" ::: "memory"); __syncthreads(); }
    const bf16x8 ua = ua_next;
    if (i + 1 < nch) {
      const int cn = dir ? nch - 2 - i : i + 1;
      ua_next = (fq < 2) ? *(const bf16x8*)(ZA + (size_t)(row0 + cn * 16 + fr) * 2048 + grp * 16 + fq * 8) : zero8;
    }
    float oth[4] = {0.f, 0.f, 0.f, 0.f}, uu[4] = {0.f, 0.f, 0.f, 0.f};
    if (i >= half) {
#pragma unroll
      for (int j = 0; j < 4; j++) {
        size_t row = (size_t)(row0 + t0 + fq * 4 + j);
        oth[j] = YP[row * 512 + grp * 16 + fr];
        uu[j] = bf2f(ZA[row * 2048 + grp * 16 + fr]);
      }
    }
#pragma unroll
    for (int nt = 0; nt < 8; nt++) {
      f32x4 r = __builtin_amdgcn_mfma_f32_16x16x32_bf16(ua, bfrag[nt], f32x4{0.f, 0.f, 0.f, 0.f}, 0, 0, 0);
#pragma unroll
      for (int j = 0; j < 4; j++) BU[(fq * 4 + j) * 128 + nt * 16 + fr] = r[j];
    }
    asm volatile("s_waitcnt lgkmcnt(0)" ::: "memory");
#pragma unroll
    for (int tt = 0; tt < 16; tt++) {
      const int t = tbase + tstep * tt;
      float re = BU[t * 128 + lane], im = BU[t * 128 + 64 + lane];
      float nr = lr * hr - li * hi + re; float ni = lr * hi + li * hr + im;
      hr = nr; hi = ni;
      HB[t * 136 + lane] = f2bf(hr); HB[t * 136 + 64 + lane] = f2bf(hi);
    }
    asm volatile("s_waitcnt lgkmcnt(0)" ::: "memory");
    f32x4 y = {0.f, 0.f, 0.f, 0.f};
#pragma unroll
    for (int ks = 0; ks < 4; ks++) {
      bf16x8 a = *(const bf16x8*)(HB + fr * 136 + ks * 32 + fq * 8);
      y = __builtin_amdgcn_mfma_f32_16x16x32_bf16(a, cfrag[ks], y, 0, 0, 0);
    }
    asm volatile("s_waitcnt lgkmcnt(0)" ::: "memory");
    if (i < half) {
#pragma unroll
      for (int j = 0; j < 4; j++) YP[(size_t)(row0 + t0 + fq * 4 + j) * 512 + grp * 16 + fr] = y[j];
    } else {
#pragma unroll
      for (int j = 0; j < 4; j++) {
        size_t row = (size_t)(row0 + t0 + fq * 4 + j);
        float v = y[j] + oth[j] + dcoef * uu[j];
        ZA[row * 2048 + grp * 16 + fr] = f2bf(gelu_(v));
      }
    }
  }
  if (!lat) {
    float* o = OUTP(p) + 12582912 + ((((size_t)seq * 2 + l) * 2 + dir) * 32 + grp) * 128 + lane * 2;
    o[0] = hr; o[1] = hi;
  }
}

DEV void ret_task(const Params& p, int l, int task, char* smem) {
  const int tid = TID(), lane = tid & 63, wid = tid >> 6, fr = lane & 15, fq = lane >> 4;
  int seq, h, qt; bool lat;
  if (task < 256) { lat = true; seq = task >> 6; h = (task >> 4) & 3; qt = task & 15; }
  else { int t2 = task - 256; lat = false; seq = t2 >> 4; h = (t2 >> 2) & 3; qt = t2 & 3; }
  const int L = lat ? 1024 : 256;
  const int row0 = lat ? 8192 + seq * 1024 : seq * 256;
  u16* sK = (u16*)smem; u16* sV = sK + 64 * 136; u16* sP = sV + 128 * 72 + wid * 16 * 72;
  u16* ZA = (u16*)(WS(p) + OFF_ZA);
  const u16* QR = (const u16*)(WS(p) + OFF_QR);
  const u16* VT = (const u16*)(WS(p) + OFF_VT);
  const float lgf = log1pf(-expf(INP(p, 20)[(l * 2 + 0) * 4 + h])), lgb = log1pf(-expf(INP(p, 20)[(l * 2 + 1) * 4 + h]));
  const int qrow = qt * 64 + wid * 16;
  const u16* qsrc = lat ? QR + (size_t)(row0 - 8192 + qrow + fr) * 512 + h * 128 : ZA + (size_t)(row0 + qrow + fr) * 2048 + 512 + h * 128;
  bf16x8 qa[4];
#pragma unroll
  for (int ks = 0; ks < 4; ks++) qa[ks] = *(const bf16x8*)(qsrc + ks * 32 + fq * 8);
  f32x4 o[8];
#pragma unroll
  for (int n = 0; n < 8; n++) o[n] = f32x4{0.f, 0.f, 0.f, 0.f};
  const u16* Kbase = ZA + (size_t)row0 * 2048 + 1024 + h * 128;
  const u16* Vbase = lat ? VT + (size_t)8192 * 512 + (size_t)((seq * 4 + h) * 128) * 1024 : VT + (size_t)((seq * 4 + h) * 128) * 256;
  const int nkt = L >> 6;
  u32x4 kreg[4], vreg[4];
  const int kr = tid >> 4, kc = (tid & 15) * 8;
  const int ve = tid >> 3, vc = (tid & 7) * 8;
#pragma unroll
  for (int i = 0; i < 4; i++) {
    kreg[i] = *(const u32x4*)(Kbase + (size_t)(kr + 16 * i) * 2048 + kc);
    vreg[i] = *(const u32x4*)(Vbase + (size_t)(ve + 32 * i) * L + vc);
  }
  for (int jt = 0; jt < nkt; jt++) {
    __syncthreads();
#pragma unroll
    for (int i = 0; i < 4; i++) {
      *(u32x4*)(sK + (kr + 16 * i) * 136 + kc) = kreg[i];
      *(u32x4*)(sV + (ve + 32 * i) * 72 + vc) = vreg[i];
    }
    __syncthreads();
    if (jt + 1 < nkt) {
#pragma unroll
      for (int i = 0; i < 4; i++) {
        kreg[i] = *(const u32x4*)(Kbase + (size_t)((jt + 1) * 64 + kr + 16 * i) * 2048 + kc);
        vreg[i] = *(const u32x4*)(Vbase + (size_t)(ve + 32 * i) * L + (jt + 1) * 64 + vc);
      }
    }
    f32x4 s[4];
#pragma unroll
    for (int nt = 0; nt < 4; nt++) s[nt] = f32x4{0.f, 0.f, 0.f, 0.f};
    {
      const u16* kp = sK + fr * 136 + fq * 8;
      bf16x8 b_cur = *(const bf16x8*)(kp);
      bf16x8 b_nxt = *(const bf16x8*)(kp + 32);
#pragma unroll
      for (int i = 0; i < 16; i++) {
        bf16x8 b_n2 = b_nxt;
        if (i + 2 < 16) b_n2 = *(const bf16x8*)(kp + ((i + 2) >> 2) * 16 * 136 + ((i + 2) & 3) * 32);
        __builtin_amdgcn_sched_barrier(0);
        s[i >> 2] = __builtin_amdgcn_mfma_f32_16x16x32_bf16(qa[i & 3], b_cur, s[i >> 2], 0, 0, 0);
        __builtin_amdgcn_sched_barrier(0);
        b_cur = b_nxt; b_nxt = b_n2;
      }
    }
#pragma unroll
    for (int nt = 0; nt < 4; nt++)
#pragma unroll
      for (int j = 0; j < 4; j++) {
        int d = (qrow + fq * 4 + j) - (jt * 64 + nt * 16 + fr);
        float w = d >= 0 ? __expf(lgf * (float)d) : __expf(lgb * (float)(-d));
        sP[(fq * 4 + j) * 72 + nt * 16 + fr] = f2bf(s[nt][j] * w);
      }
    asm volatile("s_waitcnt lgkmcnt(0)" ::: "memory");
    {
      bf16x8 pa[2];
      pa[0] = *(const bf16x8*)(sP + fr * 72 + fq * 8);
      pa[1] = *(const bf16x8*)(sP + fr * 72 + 32 + fq * 8);
      const u16* vp = sV + fr * 72 + fq * 8;
      bf16x8 b_cur = *(const bf16x8*)(vp);
      bf16x8 b_nxt = *(const bf16x8*)(vp + 16 * 72);
#pragma unroll
      for (int i = 0; i < 16; i++) {
        bf16x8 b_n2 = b_nxt;
        if (i + 2 < 16) b_n2 = *(const bf16x8*)(vp + ((i + 2) & 7) * 16 * 72 + ((i + 2) >> 3) * 32);
        __builtin_amdgcn_sched_barrier(0);
        o[i & 7] = __builtin_amdgcn_mfma_f32_16x16x32_bf16(pa[i >> 3], b_cur, o[i & 7], 0, 0, 0);
        __builtin_amdgcn_sched_barrier(0);
        b_cur = b_nxt; b_nxt = b_n2;
      }
    }
    asm volatile("s_waitcnt lgkmcnt(0)" ::: "memory");
  }
  if (lat) {
    const u16* q0src = ZA + (size_t)(row0 + qrow + fr) * 2048 + 512 + h * 128;
    bf16x8 q0[4];
#pragma unroll
    for (int ks = 0; ks < 4; ks++) q0[ks] = *(const bf16x8*)(q0src + ks * 32 + fq * 8);
#pragma unroll 1
    for (int dir = 0; dir < 2; dir++) {
      const u16* S0 = (const u16*)(WS(p) + OFF_S0T) + (size_t)((((seq * 2 + l) * 2 + dir) * 4 + h)) * 16384;
      u16* sS = sK;
      __syncthreads();
#pragma unroll
      for (int i = 0; i < 8; i++) {
        int id = tid + i * 256; int e = id >> 4, ch = id & 15;
        *(u32x4*)(sS + e * 136 + ch * 8) = *(const u32x4*)(S0 + (size_t)e * 128 + ch * 8);
      }
      __syncthreads();
      float wj[4];
#pragma unroll
      for (int j = 0; j < 4; j++) { int gi = qrow + fq * 4 + j; wj[j] = dir == 0 ? __expf(lgf * (float)(gi + 1)) : __expf(lgb * (float)(L - 1 - gi)); }
#pragma unroll
      for (int n2 = 0; n2 < 8; n2++) {
        f32x4 tmp = {0.f, 0.f, 0.f, 0.f};
#pragma unroll
        for (int ks = 0; ks < 4; ks++) {
          bf16x8 b = *(const bf16x8*)(sS + (n2 * 16 + fr) * 136 + ks * 32 + fq * 8);
          tmp = __builtin_amdgcn_mfma_f32_16x16x32_bf16(q0[ks], b, tmp, 0, 0, 0);
        }
#pragma unroll
        for (int j = 0; j < 4; j++) o[n2][j] += wj[j] * tmp[j];
      }
    }
  }
#pragma unroll
  for (int j = 0; j < 4; j++) {
    float s = 0.f;
#pragma unroll
    for (int n2 = 0; n2 < 8; n2++) s += o[n2][j];
    s += __shfl_xor(s, 1, 64); s += __shfl_xor(s, 2, 64); s += __shfl_xor(s, 4, 64); s += __shfl_xor(s, 8, 64);
    float mean = s * (1.f / 128.f);
    float v = 0.f;
#pragma unroll
    for (int n2 = 0; n2 < 8; n2++) { float dd = o[n2][j] - mean; v += dd * dd; }
    v += __shfl_xor(v, 1, 64); v += __shfl_xor(v, 2, 64); v += __shfl_xor(v, 4, 64); v += __shfl_xor(v, 8, 64);
    float rstd = rsqrtf(v * (1.f / 128.f) + 1e-5f);
    size_t rbase = (size_t)(row0 + qrow + fq * 4 + j) * 2048;
#pragma unroll
    for (int n2 = 0; n2 < 8; n2++) {
      int e = n2 * 16 + fr;
      float gv = bf2f(ZA[rbase + 1536 + h * 128 + e]);
      ZA[rbase + 512 + h * 128 + e] = f2bf((o[n2][j] - mean) * rstd * gv);
    }
  }
}

DEV bf16x8 scale8(u32x4 raw, const float (&w)[8]) {
  union { u32x4 u; bf16x8 v; } r;
#pragma unroll
  for (int q = 0; q < 4; q++) {
    float a = __uint_as_float(raw[q] << 16) * w[q * 2], b = __uint_as_float(raw[q] & 0xffff0000u) * w[q * 2 + 1];
    r.u[q] = pack2(a, b);
  }
  return r.v;
}

DEV void retstate_task(const Params& p, int l, int task) {
  const int tid = TID(), lane = tid & 63, wid = tid >> 6, fr = lane & 15, fq = lane >> 4;
  int seq = task >> 3, h = (task >> 1) & 3, dir = task & 1;
  const u16* KT = (const u16*)(WS(p) + OFF_KT) + (size_t)((seq * 4 + h) * 128) * 256;
  const u16* VT = (const u16*)(WS(p) + OFF_VT) + (size_t)((seq * 4 + h) * 128) * 256;
  const float lg = log1pf(-expf(INP(p, 20)[(l * 2 + dir) * 4 + h]));
  f32x4 acc[2][8];
#pragma unroll
  for (int m = 0; m < 2; m++)
#pragma unroll
    for (int n = 0; n < 8; n++) acc[m][n] = f32x4{0.f, 0.f, 0.f, 0.f};
#pragma unroll 1
  for (int ks = 0; ks < 8; ks++) {
    float w[8];
#pragma unroll
    for (int jj = 0; jj < 8; jj++) { int j = ks * 32 + fq * 8 + jj; w[jj] = __expf(lg * (float)(dir == 0 ? 255 - j : j)); }
    bf16x8 a[2];
#pragma unroll
    for (int m = 0; m < 2; m++) a[m] = scale8(*(const u32x4*)(KT + (size_t)(wid * 32 + m * 16 + fr) * 256 + ks * 32 + fq * 8), w);
#pragma unroll
    for (int n = 0; n < 8; n++) {
      bf16x8 b = *(const bf16x8*)(VT + (size_t)(n * 16 + fr) * 256 + ks * 32 + fq * 8);
#pragma unroll
      for (int m = 0; m < 2; m++) acc[m][n] = __builtin_amdgcn_mfma_f32_16x16x32_bf16(a[m], b, acc[m][n], 0, 0, 0);
    }
  }
  float* o = OUTP(p) + 13107200 + ((((size_t)seq * 2 + l) * 2 + dir) * 4 + h) * 16384;
#pragma unroll
  for (int m = 0; m < 2; m++)
#pragma unroll
    for (int n = 0; n < 8; n++)
#pragma unroll
      for (int j = 0; j < 4; j++) o[(size_t)(wid * 32 + m * 16 + fq * 4 + j) * 128 + n * 16 + fr] = acc[m][n][j];
}

template <bool LAT>
DEV void hyena_mfma(const Params& p, int l, int task, char* smem) {
  constexpr int L = LAT ? 1024 : 256;
  constexpr int NV = LAT ? 4 : 16;
  constexpr int RS = L + 8, CS = 2 * L + 16;
  constexpr int MPW = L / 64, NKS = L / 32, NCH = L / 8, Lsel = LAT ? 1 : 0;
  const int tid = TID(), lane = tid & 63, wid = tid >> 6, fr = lane & 15, fq = lane >> 4;
  const int c = LAT ? task : (task >> 1);
  const int sg = LAT ? 0 : (task & 1);
  u16* CP = (u16*)smem; u16* XV = CP + 8 * CS; u16* GS = XV + NV * RS; u16* O1 = GS + NV * RS;
  const u16* HYT = (const u16*)(WS(p) + OFF_HYZ);
  u16* HYOT = (u16*)(WS(p) + OFF_OUT1) + (size_t)MT * 512;
  const float* cw = INP(p, 22) + (size_t)l * 3 * 1536; const float* cb = INP(p, 23) + l * 1536;
  auto sconv = [&](int arr, u16* dstA) {
    const int ch = arr * 512 + c;
    const float w0 = cw[ch], w1 = cw[1536 + ch], w2 = cw[3072 + ch], bb = cb[ch];
#pragma unroll
    for (int i = 0; i < (NV * NCH) / 256; i++) {
      int id = tid + i * 256; int n = id / NCH, t8 = (id % NCH) * 8;
      const u16* src = LAT ? HYT + (size_t)8192 * 1536 + ((size_t)n * 1536 + ch) * 1024 + t8 : HYT + ((size_t)(sg * 16 + n) * 1536 + ch) * 256 + t8;
      u32x4 raw = *(const u32x4*)src;
      float h[10];
      h[0] = t8 > 0 ? bf2f(src[-1]) : 0.f;
      h[9] = t8 + 8 < L ? bf2f(src[8]) : 0.f;
#pragma unroll
      for (int q = 0; q < 4; q++) { h[1 + 2 * q] = __uint_as_float(raw[q] << 16); h[2 + 2 * q] = __uint_as_float(raw[q] & 0xffff0000u); }
      u32x4 o;
#pragma unroll
      for (int q = 0; q < 4; q++) o[q] = pack2(w0 * h[2 * q] + w1 * h[2 * q + 1] + w2 * h[2 * q + 2] + bb, w0 * h[2 * q + 1] + w1 * h[2 * q + 2] + w2 * h[2 * q + 3] + bb);
      *(u32x4*)(dstA + n * RS + t8) = o;
    }
  };
  __syncthreads();
  sconv(0, GS);
  sconv(2, XV);
  const int rr = (-fr) & 7;
  const u16* cpl = CP + rr * CS + (L + 8 * fq - fr - rr);
#pragma unroll 1
  for (int o = 0; o < 2; o++) {
    if (o == 1) sconv(1, GS);
    u16* FL = o == 0 ? O1 : XV;
    const float* Gp = (const float*)(WS(p) + OFF_G) + (Lsel ? 524288 : 0) + (size_t)o * (2 * L) * 512 + c;
    if (tid < 2 * L / 8) {
      float f[8];
#pragma unroll
      for (int j = 0; j < 8; j++) { int u = tid * 8 + j; f[j] = u > 0 ? Gp[(size_t)(2 * L - u) * 512] : 0.f; }
      u32x4 v; v[0] = pack2(f[0], f[1]); v[1] = pack2(f[2], f[3]); v[2] = pack2(f[4], f[5]); v[3] = pack2(f[6], f[7]);
      *(u32x4*)(FL + tid * 8) = v;
    }
    if (tid < 2) *(u32x4*)(FL + 2 * L + tid * 8) = u32x4{0u, 0u, 0u, 0u};
    __syncthreads();
    if (tid < 2 * L / 8) {
      u32x4 a = *(const u32x4*)(FL + tid * 8), b = *(const u32x4*)(FL + tid * 8 + 8);
      unsigned d[8] = {a[0], a[1], a[2], a[3], b[0], b[1], b[2], b[3]};
#pragma unroll
      for (int r = 0; r < 8; r++) {
        u32x4 ov;
#pragma unroll
        for (int q = 0; q < 4; q++) ov[q] = (r & 1) ? ((d[q + (r >> 1)] >> 16) | (d[q + (r >> 1) + 1] << 16)) : d[q + (r >> 1)];
        *(u32x4*)(CP + r * CS + tid * 8) = ov;
      }
    }
    __syncthreads();
    float rn;
    {
      constexpr int NTB = LAT ? 128 : 32;
      const float* SP = (const float*)(WS(p) + WS_END) + ((size_t)l * 160 + (LAT ? 32 : 0)) * 2048 + o * 512 + c;
      float ssum = 0.f;
      for (int tb = lane; tb < NTB; tb += 64) ssum += SP[(size_t)tb * 2048] + SP[(size_t)tb * 2048 + 1024];
#pragma unroll
      for (int off = 32; off > 0; off >>= 1) ssum += __shfl_xor(ssum, off, 64);
      rn = rsqrtf(ssum + 1e-6f);
    }
    const float bias = INP(p, 30)[(l * 2 + o) * 512 + c];
    const u16* Xs = o == 0 ? XV : O1;
    f32x4 acc[MPW];
#pragma unroll
    for (int mi = 0; mi < MPW; mi++) acc[mi] = f32x4{0.f, 0.f, 0.f, 0.f};
    const bf16x8 zero8 = {0, 0, 0, 0, 0, 0, 0, 0};
    {
      bf16x8 b_next = (fr < NV) ? *(const bf16x8*)(Xs + fr * RS + fq * 8) : zero8;
#pragma unroll 1
      for (int ks = 0; ks < NKS; ks++) {
        const bf16x8 b = b_next;
        const u16* ap = cpl - 16 * (wid * MPW) + 32 * ks;
        bf16x8 a_cur = *(const bf16x8*)(ap);
        bf16x8 a_nxt = *(const bf16x8*)(ap - 16);
        if (ks + 1 < NKS) b_next = (fr < NV) ? *(const bf16x8*)(Xs + fr * RS + (ks + 1) * 32 + fq * 8) : zero8;
#pragma unroll
        for (int mi = 0; mi < MPW; mi++) {
          bf16x8 a_n2 = a_nxt;
          if (mi + 2 < MPW) a_n2 = *(const bf16x8*)(ap - 16 * (mi + 2));
          __builtin_amdgcn_sched_barrier(0);
          acc[mi] = __builtin_amdgcn_mfma_f32_16x16x32_bf16(a_cur, b, acc[mi], 0, 0, 0);
          __builtin_amdgcn_sched_barrier(0);
          a_cur = a_nxt; a_nxt = a_n2;
        }
      }
    }
    if (fr < NV) {
      const u16* gate = GS;
      const u16* vin = o == 0 ? XV : O1;
#pragma unroll
      for (int mi = 0; mi < MPW; mi++) {
        const int t0 = (wid * MPW + mi) * 16 + fq * 4;
        u32x2 gq = *(const u32x2*)(gate + fr * RS + t0), vq = *(const u32x2*)(vin + fr * RS + t0);
        float g4[4] = {__uint_as_float(gq[0] << 16), __uint_as_float(gq[0] & 0xffff0000u), __uint_as_float(gq[1] << 16), __uint_as_float(gq[1] & 0xffff0000u)};
        float v4[4] = {__uint_as_float(vq[0] << 16), __uint_as_float(vq[0] & 0xffff0000u), __uint_as_float(vq[1] << 16), __uint_as_float(vq[1] & 0xffff0000u)};
        float r4[4];
#pragma unroll
        for (int j = 0; j < 4; j++) r4[j] = g4[j] * (acc[mi][j] * rn + bias * v4[j]);
        if (o == 0) {
          u32x2 ov; ov[0] = pack2(r4[0], r4[1]); ov[1] = pack2(r4[2], r4[3]);
          *(u32x2*)(O1 + fr * RS + t0) = ov;
        } else {
          u16* dst = LAT ? HYOT + (size_t)8192 * 512 + ((size_t)fr * 512 + c) * 1024 + t0 : HYOT + ((size_t)(sg * 16 + fr) * 512 + c) * 256 + t0;
          u32x2 ov; ov[0] = pack2(r4[0], r4[1]); ov[1] = pack2(r4[2], r4[3]);
          *(u32x2*)dst = ov;
        }
      }
    }
    __syncthreads();
  }
}

DEV void phaseD(const Params& p, int l, char* smem) {
  const int nbt = gridDim.x, bt = BID();
  __shared__ int s_task;
  unsigned* ctr = (unsigned*)(WS(p) + OFF_BAR) + 3600 + l * 8;
  if (nbt >= 128 && bt < 64) {
    s5_task(p, l, bt, smem);
    return;
  }
  const int s5lo = nbt >= 128 ? 64 : 0;
#define PULL(pool, limit, body) for (;;) { __syncthreads(); if (threadIdx.x == 0) s_task = (int)atomicAdd(&ctr[pool], 1u); __syncthreads(); \
                                           const int t = s_task; if (t >= (limit)) break; body; }
  PULL(0, 768, ret_task(p, l, t, smem))
  PULL(1, 512, hyena_mfma<true>(p, l, t, smem))
  PULL(2, 576 - s5lo, s5_task(p, l, s5lo + t, smem))
  PULL(3, 1024, hyena_mfma<false>(p, l, t, smem))
  PULL(4, 256, retstate_task(p, l, t))
#undef PULL
}

DEV void phaseE(const Params& p, char* smem) {
  const u16* HYOT = (const u16*)(WS(p) + OFF_OUT1) + (size_t)MT * 512;
  u16* HYO = (u16*)(WS(p) + OFF_OUT1);
  u16* sm = (u16*)smem;
  const int tx = TID() & 63, ty = TID() >> 6;
  for (int tile = BID(); tile < 192 * 8; tile += gridDim.x) {
    int rt = tile >> 3, c0 = (tile & 7) * 64; int row0 = rt * 64;
    const u16* src = row0 < 8192 ? HYOT + ((size_t)(row0 >> 8) * 512 + c0) * 256 + (row0 & 255)
                                 : HYOT + (size_t)8192 * 512 + ((size_t)((row0 - 8192) >> 10) * 512 + c0) * 1024 + ((row0 - 8192) & 1023);
    const int L = row0 < 8192 ? 256 : 1024;
    __syncthreads();
#pragma unroll
    for (int i = 0; i < 16; i++) { int cc = ty + i * 4; sm[cc * 66 + tx] = src[(size_t)cc * L + tx]; }
    __syncthreads();
#pragma unroll
    for (int i = 0; i < 16; i++) { int tt = ty + i * 4; HYO[(size_t)(row0 + tt) * 512 + c0 + tx] = sm[tx * 66 + tt]; }
  }
}

DEV void phaseF(const Params& p, int l, char* smem) {
  u16* sA = (u16*)smem; u16* T = (u16*)smem;
  const u16* H = (const u16*)(WS(p) + OFF_H);
  const u16* WT = (const u16*)(WS(p) + OFF_WT);
  const u16* ZA = (const u16*)(WS(p) + OFF_ZA); const u16* HYO = (const u16*)(WS(p) + OFF_OUT1);
  u16* MG = (u16*)(WS(p) + OFF_YP);
  for (int tile = BID(); tile < 96 * 16; tile += gridDim.x) {
    int tm = tile >> 4, tn = tile & 15; int row0 = tm * 128, n0 = tn * 64;
    f32x4 a1[4][2], a2[4][2], tt[4][2];
    const u16* Hrow = H + (size_t)row0 * 1024;
    zero_acc<4, 2>(a1); zero_acc<4, 2>(tt);
#pragma unroll 1
    for (int ps = 0; ps < 7; ps++) {
      const u16* Ap; const u16* Bp; int lda, K;
      switch (ps) {
        case 0: Ap = ZA + (size_t)row0 * 2048; lda = 2048; Bp = WT + WGLU_O + (size_t)n0 * 512; K = 512; break;
        case 1: Ap = ZA + (size_t)row0 * 2048; lda = 2048; Bp = WT + WGLU_O + (size_t)(1024 + n0) * 512; K = 512; break;
        case 3: Ap = ZA + (size_t)row0 * 2048 + 512; lda = 2048; Bp = WT + WRETO_O + (size_t)n0 * 512; K = 512; break;
        case 5: Ap = HYO + (size_t)row0 * 512; lda = 512; Bp = WT + WHYO_O + (size_t)n0 * 512; K = 512; break;
        default: Ap = Hrow; lda = 1024; Bp = WT + WIN_O + (size_t)(4096 + ((ps - 2) >> 1) * 1024 + n0) * 1024; K = 1024; break;
      }
      zero_acc<4, 2>(a2);
      gemm_loop<4, 2>(Ap, lda, Bp, K, K, a2, sA);
      if (ps == 0 || ps == 3 || ps == 5) {
#pragma unroll
        for (int m = 0; m < 4; m++)
#pragma unroll
          for (int n = 0; n < 2; n++) a1[m][n] = a2[m][n];
      } else if (ps == 1) {
#pragma unroll
        for (int m = 0; m < 4; m++)
#pragma unroll
          for (int n = 0; n < 2; n++)
#pragma unroll
            for (int j = 0; j < 4; j++) a1[m][n][j] *= sigm(a2[m][n][j]);
      } else {
#pragma unroll
        for (int m = 0; m < 4; m++)
#pragma unroll
          for (int n = 0; n < 2; n++)
#pragma unroll
            for (int j = 0; j < 4; j++) tt[m][n][j] += a1[m][n][j] * sigm(a2[m][n][j]);
      }
    }
    __syncthreads();
    acc_to_lds<4, 2, 72>(tt, T, 0);
    __syncthreads();
    copy_tile<64, 72>(T, MG + (size_t)row0 * 1024 + n0, 1024);
  }
}

template <int MF, int NF>
DEV void resid_store(const Params& p, const f32x4 (&acc)[MF][NF], int l, int chunk, int row0, int col0, bool from_input) {
  const int tid = TID(), lane = tid & 63, wid = tid >> 6, wr = wid >> 1, wc = wid & 1, fr = lane & 15, fq = lane >> 4;
  float* out = OUTP(p);
#pragma unroll
  for (int m = 0; m < MF; m++) {
    const int rb = row0 + m * 32 + wr * 16 + fq * 4;
    const int j = modidx(rb);
    const float* MOD = (const float*)(WS(p) + OFF_MOD) + (l * 5 + j) * 6144 + chunk * 1024;
    const float* BM = INP(p, 7) + l * 6144 + chunk * 1024;
#pragma unroll
    for (int n = 0; n < NF; n++) {
      int col = col0 + wc * (NF * 16) + n * 16 + fr;
      float g = MOD[col] + BM[col];
#pragma unroll
      for (int jj = 0; jj < 4; jj++) {
        int row = rb + jj;
        float xo = from_input ? xin_row(p, row)[col] : out[(size_t)row * 1024 + col];
        out[(size_t)row * 1024 + col] = xo + g * acc[m][n][jj];
      }
    }
  }
}

DEV void phaseG(const Params& p, int l, char* smem) {
  u16* sA = (u16*)smem;
  const u16* MG = (const u16*)(WS(p) + OFF_YP);
  const u16* W = (const u16*)(WS(p) + OFF_WT) + WOUT_O;
  for (int tile = BID(); tile < 64 * 8; tile += gridDim.x) {
    int tm = tile >> 3, tn = tile & 7;
    f32x4 acc[6][4]; zero_acc<6, 4>(acc);
    gemm_loop<6, 4>(MG + (size_t)tm * 192 * 1024, 1024, W + (size_t)tn * 128 * 1024, 1024, 1024, acc, sA);
    resid_store<6, 4>(p, acc, l, 2, tm * 192, tn * 128, l == 0);
  }
}

DEV void phaseI(const Params& p, int l, char* smem) {
  u16* sA = (u16*)smem; u16* T = (u16*)smem;
  const u16* H = (const u16*)(WS(p) + OFF_H);
  const u16* W = (const u16*)(WS(p) + OFF_WT) + WFIN_O;
  u16* ACT = (u16*)(WS(p) + OFF_ZA);
  for (int tile = BID(); tile < 48 * 44; tile += gridDim.x) {
    int tm = tile / 44, tn = tile % 44;
    f32x4 acc[8][4]; zero_acc<8, 4>(acc);
    gemm_loop<8, 4>(H + (size_t)tm * 256 * 1024, 1024, W + (size_t)tn * 128 * 1024, 1024, 1024, acc, sA);
    const int tid = TID(), lane = tid & 63, wid = tid >> 6, wr = wid >> 1, wc = wid & 1, fr = lane & 15, fq = lane >> 4;
#pragma unroll
    for (int hh = 0; hh < 2; hh++) {
      __syncthreads();
#pragma unroll
      for (int m = 0; m < 4; m++)
#pragma unroll
        for (int n = 0; n < 2; n++)
#pragma unroll
          for (int j = 0; j < 4; j++)
            T[(m * 32 + wr * 16 + fq * 4 + j) * 72 + wc * 32 + n * 16 + fr] = f2bf(silu_(acc[hh * 4 + m][2 * n][j]) * acc[hh * 4 + m][2 * n + 1][j]);
      __syncthreads();
      copy_tile<64, 72>(T, ACT + (size_t)(tm * 256 + hh * 128) * 2816 + tn * 64, 2816);
    }
  }
}

DEV void phaseJ(const Params& p, int l, char* smem) {
  u16* sA = (u16*)smem;
  const u16* ACT = (const u16*)(WS(p) + OFF_ZA);
  const u16* W = (const u16*)(WS(p) + OFF_WT) + WFOUT_O;
  for (int tile = BID(); tile < 64 * 8; tile += gridDim.x) {
    int tm = tile >> 3, tn = tile & 7;
    f32x4 acc[6][4]; zero_acc<6, 4>(acc);
    gemm_loop<6, 4>(ACT + (size_t)tm * 192 * 2816, 2816, W + (size_t)tn * 128 * 2816, 2816, 2816, acc, sA);
    resid_store<6, 4>(p, acc, l, 5, tm * 192, tn * 128, false);
  }
}


#define XB_TMO      128
#define XB_XCNT(j)  (256  + 64 * (j))
#define XB_XSUB(j)  (1280 + 64 * (j))
#define XB_XGEN(j)  (2304 + 64 * (j))
#define XB_TOP      3328
#define XB_TOPGEN   3392
#define XB_SPIN_CAP (1u << 22)
#define LAS __attribute__((address_space(3)))
DEV unsigned xb_ld(unsigned* p) { return __hip_atomic_load(p, __ATOMIC_RELAXED, __HIP_MEMORY_SCOPE_AGENT); }
DEV unsigned xb_add(unsigned* p, unsigned v) { return __hip_atomic_fetch_add(p, v, __ATOMIC_RELAXED, __HIP_MEMORY_SCOPE_AGENT); }
DEV unsigned xb_xcc_id() { return (unsigned)__builtin_amdgcn_s_getreg((3 << 11) | 20) & 0xFu; }
#define XB_SPIN(cond, bar) do { unsigned _sp = 0; while (cond) { __builtin_amdgcn_s_sleep(1); \
    if ((++_sp & 255u) == 0u) { if (xb_ld(&(bar)[XB_TMO])) break; if (_sp > XB_SPIN_CAP) { atomicAdd(&(bar)[XB_TMO], 1u); break; } } } } while (0)
struct XcdBarrier { unsigned* bar; unsigned x; volatile LAS unsigned* st; };
DEV XcdBarrier xcd_barrier_post(unsigned* bar, volatile LAS unsigned* st) {
  XcdBarrier b; b.bar = bar; b.x = xb_xcc_id(); b.st = st;
  if (threadIdx.x == 0) (void)xb_add(&bar[XB_XCNT(b.x)], 1u);
  return b;
}
DEV void xcd_barrier_complete(unsigned* bar, unsigned x, unsigned& nloc, unsigned& nx) {
  const unsigned G = gridDim.x * gridDim.y * gridDim.z;
  unsigned sum, cnt, mine, sp = 0u;
  for (;;) {
    sum = 0u; cnt = 0u; mine = 0u;
#pragma unroll
    for (unsigned j = 0; j < 16; ++j) { const unsigned c = xb_ld(&bar[XB_XCNT(j)]); sum += c; cnt += (c > 0u) ? 1u : 0u; mine = (j == x) ? c : mine; }
    if (sum == G) break;
    __builtin_amdgcn_s_sleep(1);
    if ((++sp & 255u) == 0u) { if (xb_ld(&bar[XB_TMO])) break; if (sp > XB_SPIN_CAP) { atomicAdd(&bar[XB_TMO], 1u); break; } }
  }
  nloc = mine > 0u ? mine : 1u; nx = cnt > 0u ? cnt : 1u;
}
DEV void xcd_barrier(const XcdBarrier& b) {
  asm volatile("s_waitcnt vmcnt(0)" ::: "memory");
  __syncthreads();
  if (threadIdx.x == 0) {
    unsigned* bar = b.bar;
    __builtin_amdgcn_s_waitcnt(0);
    unsigned nloc = b.st[0], nx = b.st[1];
    if (nloc == 0u) { xcd_barrier_complete(bar, b.x, nloc, nx); b.st[0] = nloc; b.st[1] = nx; }
    const unsigned old = xb_add(&bar[XB_XSUB(b.x)], 1u);
    const unsigned gen = old / nloc;
    if (old + 1u == (gen + 1u) * nloc) {
      __builtin_amdgcn_fence(__ATOMIC_RELEASE, "agent");
      asm volatile("s_waitcnt vmcnt(0)" ::: "memory");
      const unsigned og = xb_add(&bar[XB_TOP], 1u);
      const unsigned tg = og / nx;
      if (og + 1u == (tg + 1u) * nx) xb_add(&bar[XB_TOPGEN], 1u);
      else XB_SPIN(xb_ld(&bar[XB_TOPGEN]) == tg, bar);
      __builtin_amdgcn_fence(__ATOMIC_ACQUIRE, "agent");
      xb_add(&bar[XB_XGEN(b.x)], 1u);
      asm volatile("s_waitcnt vmcnt(0)" ::: "memory");
    } else {
      XB_SPIN(xb_ld(&bar[XB_XGEN(b.x)]) == gen, bar);
      __builtin_amdgcn_fence(__ATOMIC_ACQUIRE, "agent");
      asm volatile("s_waitcnt vmcnt(0)" ::: "memory");
    }
  }
  __syncthreads();
}

constexpr int SMEM_BYTES = 57792;

DEV void run_phase(const Params& p, int ph, int l, char* smem) {
  switch (ph) {
    case 0: phaseA(p, smem); break;
    case 1: norm_phase(p, l, 0); if (l == 1) layer_prep(p, 1, smem); break;
    case 2: phaseC(p, l, smem); break;
    case 3: phaseD(p, l, smem); break;
    case 4: phaseE(p, smem); break;
    case 5: phaseF(p, l, smem); break;
    case 6: phaseG(p, l, smem); break;
    case 7: norm_phase(p, l, 1); break;
    case 8: phaseI(p, l, smem); break;
    case 9: phaseJ(p, l, smem); break;
    case 10: norm_phase(p, 0, 2); break;
  }
}

#if MULTI
__global__ void __launch_bounds__(256, 2) kphase(Params p, int ph, int l) {
  __shared__ __attribute__((aligned(16))) char smem[SMEM_BYTES];
  run_phase(p, ph, l, smem);
}
#else
__global__ void __launch_bounds__(256, 2) mega(Params p) {
  __shared__ __attribute__((aligned(16))) char smem[SMEM_BYTES];
  __shared__ uint4 xb_words;
  cg::grid_group grid = cg::this_grid();
  if (threadIdx.x == 0) xb_words = make_uint4(0u, 0u, 0u, 0u);
  __syncthreads();
  XcdBarrier xb = xcd_barrier_post((unsigned*)(p.ws + OFF_BAR), (volatile LAS unsigned*)&xb_words);
  run_phase(p, 0, 0, smem);
  grid.sync();
  for (int l = 0; l < 2; l++) {
    for (int ph = 1; ph <= 9; ph++) {
      run_phase(p, ph, l, smem);
      xcd_barrier(xb);
    }
  }
  run_phase(p, 10, 0, smem);
}
#endif

extern "C" void kernel_launch(void* const* d_in, const int* in_sizes, int n_in, void* d_out, int out_size, void* d_ws, size_t ws_size, hipStream_t stream) {
  Params p{};
  for (int i = 0; i < 36; i++) p.in[i] = (const float*)d_in[i];
  p.out = (float*)d_out;
  p.ws = (char*)d_ws;
  hipMemsetAsync((char*)d_ws + OFF_MOD, 0, ZERO_BYTES, stream);
  static int grid_blocks = 0;
#if MULTI
  if (!grid_blocks) {
    int dev = 0, cus = 0, per_cu = 0;
    hipGetDevice(&dev);
    hipDeviceGetAttribute(&cus, hipDeviceAttributeMultiprocessorCount, dev);
    hipOccupancyMaxActiveBlocksPerMultiprocessor(&per_cu, kphase, 256, 0);
    if (per_cu > 2) per_cu = 2;
    if (per_cu < 1) per_cu = 1;
    grid_blocks = cus * per_cu;
  }
  kphase<<<grid_blocks, 256, 0, stream>>>(p, 0, 0);
  for (int l = 0; l < 2; l++)
    for (int ph = 1; ph <= 9; ph++) kphase<<<grid_blocks, 256, 0, stream>>>(p, ph, l);
  kphase<<<grid_blocks, 256, 0, stream>>>(p, 10, 0);
#else
  if (!grid_blocks) {
    int dev = 0, cus = 0, per_cu = 0;
    hipGetDevice(&dev);
    hipDeviceGetAttribute(&cus, hipDeviceAttributeMultiprocessorCount, dev);
    hipOccupancyMaxActiveBlocksPerMultiprocessor(&per_cu, mega, 256, 0);
    if (per_cu > 2) per_cu = 2;
    if (per_cu < 1) per_cu = 1;
    grid_blocks = cus * per_cu;
  }
  void* args[] = {&p};
  hipError_t e = hipLaunchCooperativeKernel((void*)mega, dim3(grid_blocks), dim3(256), args, 0, stream);
  if (e != hipSuccess) fprintf(stderr, "cooperative launch failed: %s (grid %d)\n", hipGetErrorString(e), grid_blocks);
#endif
}
```

```cpp
#include <hip/hip_runtime.h>
#include <hip/hip_cooperative_groups.h>
#include <cstdio>
namespace cg = cooperative_groups;

#ifndef MULTI
#define MULTI 0
#endif

typedef unsigned short u16;
using bf16x8 = __attribute__((ext_vector_type(8))) short;
using f32x4 = __attribute__((ext_vector_type(4))) float;
using u32x4 = __attribute__((ext_vector_type(4))) unsigned;
using u32x2 = __attribute__((ext_vector_type(2))) unsigned;
#define DEV __device__ __forceinline__

constexpr int MT = 12288;
constexpr size_t OFF_WT = 0;
constexpr int WIN_O = 0, WGLU_O = 7340032, WRETO_O = 8388608, WHYO_O = 8912896, WOUT_O = 9437184, WFIN_O = 10485760, WFOUT_O = 16252928;
constexpr size_t OFF_G = 38273024;
constexpr size_t OFF_H = 48758784;
constexpr size_t OFF_ZA = 73924608;
constexpr size_t OFF_HYZ = 124256256;
constexpr size_t OFF_VT = 162004992;
constexpr size_t OFF_KT = 174587904;
constexpr size_t OFF_QR = 182976512;
constexpr size_t OFF_YP = 187170816;
constexpr size_t OFF_OUT1 = 212336640;
constexpr size_t OFF_MOD = 237502464;
constexpr size_t OFF_SUMSQ = OFF_MOD + 245760;
constexpr size_t OFF_BAR = OFF_SUMSQ + 16384;
constexpr size_t ZERO_BYTES = 245760 + 16384 + 16384;
constexpr size_t OFF_LAMBAR = OFF_BAR + 16384;
constexpr size_t OFF_BBAR = OFF_LAMBAR + 65536;
constexpr size_t OFF_CM = OFF_BBAR + 524288;
constexpr size_t OFF_ROPE = OFF_CM + 524288;
constexpr size_t OFF_S0T = OFF_ROPE + 524288;
constexpr size_t WS_END = OFF_S0T + 2097152;

struct Params {
  const float* in[36];
  float* out;
  char* ws;
};


DEV int TID() { int t = threadIdx.x; asm volatile("" : "+v"(t)); return t; }
DEV int BID() { int t = blockIdx.x; asm volatile("" : "+s"(t)); return t; }
#define GAS __attribute__((address_space(1)))
DEV char* WS(const Params& p) { unsigned long long w = (unsigned long long)p.ws; asm volatile("" : "+s"(w)); return (char*)(GAS char*)w; }
DEV float* OUTP(const Params& p) { unsigned long long w = (unsigned long long)p.out; asm volatile("" : "+s"(w)); return (float*)(GAS float*)w; }
DEV const float* INP(const Params& p, int i) { unsigned long long w = (unsigned long long)p.in[i]; asm volatile("" : "+s"(w)); return (const float*)(GAS const float*)w; }

DEV u16 f2bf(float f) { unsigned u = __float_as_uint(f); u += 0x7fffu + ((u >> 16) & 1u); return (u16)(u >> 16); }
DEV float bf2f(u16 h) { return __uint_as_float(((unsigned)h) << 16); }
DEV float sigm(float x) { return 1.f / (1.f + __expf(-x)); }
DEV float silu_(float x) { return x / (1.f + __expf(-x)); }
DEV float gelu_(float x) { float u = 0.7978845608028654f * (x + 0.044715f * x * x * x); return 0.5f * x * (1.f + tanhf(u)); }
DEV unsigned pack2(float a, float b) { return (unsigned)f2bf(a) | ((unsigned)f2bf(b) << 16); }

DEV const float* xin_row(const Params& p, int row) { return row < 8192 ? INP(p, 0) + (size_t)row * 1024 : INP(p, 1) + (size_t)(row - 8192) * 1024; }
DEV int modidx(int row) { return row < 8192 ? 0 : 1 + ((row - 8192) >> 10); }

template <int MF, int NF>
DEV void gemm_loop(const u16* __restrict__ A, int lda, const u16* __restrict__ B, int ldb, int K, f32x4 (&acc)[MF][NF], u16* sA) {
  const int tid = TID(), lane = tid & 63, wid = tid >> 6, wr = wid >> 1, wc = wid & 1, fr = lane & 15, fq = lane >> 4;
  u16* sB = sA + MF * 32 * 72;
  u32x4 ra[MF], rb[NF];
  const int crow = tid >> 3, ccol = (tid & 7) * 8;
  const u16* Ap = A + (size_t)crow * lda + ccol;
  const u16* Bp = B + (size_t)crow * ldb + ccol;
#pragma unroll
  for (int i = 0; i < MF; i++) ra[i] = *(const u32x4*)(Ap + (size_t)(i * 32) * lda);
#pragma unroll
  for (int i = 0; i < NF; i++) rb[i] = *(const u32x4*)(Bp + (size_t)(i * 32) * ldb);
  for (int k0 = 0; k0 < K; k0 += 64) {
    __syncthreads();
#pragma unroll
    for (int i = 0; i < MF; i++) *(u32x4*)(sA + (crow + i * 32) * 72 + ccol) = ra[i];
#pragma unroll
    for (int i = 0; i < NF; i++) *(u32x4*)(sB + (crow + i * 32) * 72 + ccol) = rb[i];
    __syncthreads();
    if (k0 + 64 < K) {
#pragma unroll
      for (int i = 0; i < MF; i++) ra[i] = *(const u32x4*)(Ap + (size_t)(i * 32) * lda + k0 + 64);
#pragma unroll
      for (int i = 0; i < NF; i++) rb[i] = *(const u32x4*)(Bp + (size_t)(i * 32) * ldb + k0 + 64);
    }
#pragma unroll
    for (int ks = 0; ks < 2; ks++) {
      bf16x8 bv[NF];
#pragma unroll
      for (int n = 0; n < NF; n++) bv[n] = *(const bf16x8*)(sB + (wc * (NF * 16) + n * 16 + fr) * 72 + ks * 32 + fq * 8);
      const u16* sAf = sA + (wr * 16 + fr) * 72 + ks * 32 + fq * 8;
      bf16x8 a_cur = *(const bf16x8*)(sAf);
      bf16x8 a_nxt = *(const bf16x8*)(sAf + 32 * 72);
#pragma unroll
      for (int m = 0; m < MF; m++) {
        bf16x8 a_n2 = a_nxt;
        if (m + 2 < MF) a_n2 = *(const bf16x8*)(sAf + (m + 2) * 32 * 72);
        __builtin_amdgcn_sched_barrier(0);
#pragma unroll
        for (int n = 0; n < NF; n++) acc[m][n] = __builtin_amdgcn_mfma_f32_16x16x32_bf16(a_cur, bv[n], acc[m][n], 0, 0, 0);
        __builtin_amdgcn_sched_barrier(0);
        a_cur = a_nxt; a_nxt = a_n2;
      }
    }
  }
}

template <int MF, int NF>
DEV void zero_acc(f32x4 (&acc)[MF][NF]) {
#pragma unroll
  for (int m = 0; m < MF; m++)
#pragma unroll
    for (int n = 0; n < NF; n++) acc[m][n] = f32x4{0.f, 0.f, 0.f, 0.f};
}

DEV float epi_op(float v, int op) { return op == 1 ? v * 0.08838834764831845f : (op == 2 ? silu_(v) : v); }
template <int MF, int NF, int TS>
DEV void acc_to_lds(const f32x4 (&acc)[MF][NF], u16* T, int m0, int op = 0) {
  const int tid = TID(), lane = tid & 63, wid = tid >> 6, wr = wid >> 1, wc = wid & 1, fr = lane & 15, fq = lane >> 4;
#pragma unroll
  for (int m = 0; m < 4; m++)
#pragma unroll
    for (int n = 0; n < NF; n++)
#pragma unroll
      for (int j = 0; j < 4; j++) T[(m * 32 + wr * 16 + fq * 4 + j) * TS + wc * (NF * 16) + n * 16 + fr] = f2bf(epi_op(acc[m0 + m][n][j], op));
}
template <int MF>
DEV void acc_to_lds_T(const f32x4 (&acc)[MF][4], u16* T, int m0, int op = 0) {
  const int tid = TID(), lane = tid & 63, wid = tid >> 6, wr = wid >> 1, wc = wid & 1, fr = lane & 15, fq = lane >> 4;
#pragma unroll
  for (int m = 0; m < 4; m++)
#pragma unroll
    for (int n = 0; n < 4; n++) {
      u32x2 v; v.x = pack2(epi_op(acc[m0 + m][n][0], op), epi_op(acc[m0 + m][n][1], op)); v.y = pack2(epi_op(acc[m0 + m][n][2], op), epi_op(acc[m0 + m][n][3], op));
      *(u32x2*)(T + (wc * 64 + n * 16 + fr) * 136 + m * 32 + wr * 16 + fq * 4) = v;
    }
}
template <int COLS, int TS>
DEV void copy_tile(const u16* T, u16* dst, int ld) {
  constexpr int CPR = COLS / 8;
  constexpr int NIT = 128 * CPR / 256;
#pragma unroll
  for (int i = 0; i < NIT; i++) {
    int id = TID() + i * 256; int r = id / CPR, ch = id % CPR;
    *(u32x4*)(dst + (size_t)r * ld + ch * 8) = *(const u32x4*)(T + r * TS + ch * 8);
  }
}

DEV void transpose_tile(const float* __restrict__ src, int K, int N, u16* __restrict__ dst, int tile, float* sm, int perm = 0) {
  int nk = K >> 6; int tk = tile % nk, tn = tile / nk; int k0 = tk * 64, n0 = tn * 64;
  int tx = TID() & 63, ty = TID() >> 6;
  __syncthreads();
#pragma unroll
  for (int i = 0; i < 16; i++) { int k = ty + i * 4; sm[k * 65 + tx] = src[(size_t)(k0 + k) * N + n0 + tx]; }
  __syncthreads();
#pragma unroll
  for (int i = 0; i < 16; i++) {
    int n = n0 + ty + i * 4;
    if (perm) { int half = N >> 1; int j = n < half ? n : n - half; n = (j >> 4) * 32 + (n < half ? 0 : 16) + (j & 15); }
    dst[(size_t)n * K + k0 + tx] = f2bf(sm[tx * 65 + (ty + i * 4)]);
  }
}

DEV void wt_task(const Params& p, int l, int t, float* sm) {
  u16* WT = (u16*)(WS(p) + OFF_WT);
  const float* src; int K, N, off, tt, perm = 0;
  if (t < 1792) { src = INP(p, 10) + (size_t)l * 1024 * 7168; K = 1024; N = 7168; off = WIN_O; tt = t; }
  else if (t < 2048) { src = INP(p, 19) + (size_t)l * 512 * 2048; K = 512; N = 2048; off = WGLU_O; tt = t - 1792; }
  else if (t < 2176) { src = INP(p, 21) + (size_t)l * 512 * 1024; K = 512; N = 1024; off = WRETO_O; tt = t - 2048; }
  else if (t < 2304) { src = INP(p, 31) + (size_t)l * 512 * 1024; K = 512; N = 1024; off = WHYO_O; tt = t - 2176; }
  else if (t < 2560) { src = INP(p, 32) + (size_t)l * 1024 * 1024; K = 1024; N = 1024; off = WOUT_O; tt = t - 2304; }
  else if (t < 3968) { src = INP(p, 33) + (size_t)l * 1024 * 5632; K = 1024; N = 5632; off = WFIN_O; tt = t - 2560; perm = 1; }
  else { src = INP(p, 34) + (size_t)l * 2816 * 1024; K = 2816; N = 1024; off = WFOUT_O; tt = t - 3968; }
  transpose_tile(src, K, N, WT + off, tt, sm, perm);
}

DEV void mod_task(const Params& p, int task, float* sm) {
  int cb = task % 96; int l = task / 96;
  int tid = TID(), lane = tid & 63, kq = tid >> 6;
  __syncthreads();
  for (int i = tid; i < 5120; i += 256) {
    int j = i >> 10, k = i & 1023;
    float c = (j == 0) ? INP(p, 5)[k] : INP(p, 4)[(j - 1) * 1024 + k];
    sm[i] = silu_(c);
  }
  __syncthreads();
  int col = cb * 64 + lane;
  const float* w = INP(p, 6) + (size_t)l * 1024 * 6144 + col;
  float a0 = 0, a1 = 0, a2 = 0, a3 = 0, a4 = 0;
#pragma unroll 8
  for (int kk = 0; kk < 256; kk++) {
    int k = kk * 4 + kq;
    float wv = w[(size_t)k * 6144];
    a0 += sm[k] * wv; a1 += sm[1024 + k] * wv; a2 += sm[2048 + k] * wv; a3 += sm[3072 + k] * wv; a4 += sm[4096 + k] * wv;
  }
  float* red = sm + 5120;
  red[(kq * 5 + 0) * 64 + lane] = a0; red[(kq * 5 + 1) * 64 + lane] = a1; red[(kq * 5 + 2) * 64 + lane] = a2;
  red[(kq * 5 + 3) * 64 + lane] = a3; red[(kq * 5 + 4) * 64 + lane] = a4;
  __syncthreads();
  float* MOD = (float*)(WS(p) + OFF_MOD);
  for (int i = tid; i < 320; i += 256) {
    int j = i >> 6, cc = i & 63;
    float v = ((red[(0 * 5 + j) * 64 + cc] + red[(1 * 5 + j) * 64 + cc]) + red[(2 * 5 + j) * 64 + cc]) + red[(3 * 5 + j) * 64 + cc];
    MOD[(l * 5 + j) * 6144 + cb * 64 + cc] = v;
  }
}

DEV void filt_task(const Params& p, int l, int task, float* sm) {
  int Lsel = task >= 32; int tb = Lsel ? task - 32 : task; int L = Lsel ? 1024 : 256; int t0 = tb * 8;
  int tid = TID();
  float* z = sm; float* h1 = sm + 264; float* h2 = sm + 264 + 512;
  const float* w1 = INP(p, 24) + l * 33 * 64; const float* b1 = INP(p, 25) + l * 64;
  const float* w2 = INP(p, 26) + l * 64 * 64; const float* b2 = INP(p, 27) + l * 64;
  const float* fr0 = INP(p, 28) + l * 128; const float* fr1 = fr0 + 64;
  const float* w3 = INP(p, 29) + (size_t)l * 64 * 2048;
  __syncthreads();
  for (int i = tid; i < 264; i += 256) {
    int tt = i / 33, e = i % 33; float t = (float)(t0 + tt); float v;
    if (e == 0) v = t / (float)L;
    else {
      int b = (e - 1) & 15; float band = 1e-4f + (float)b * ((15.f - 1e-4f) / 15.f);
      float ang = (6.283185307179586f / (float)L) * t * band;
      v = (e <= 16) ? cosf(ang) : -sinf(ang);
    }
    z[i] = v;
  }
  __syncthreads();
  for (int i = tid; i < 512; i += 256) {
    int tt = i >> 6, j = i & 63; float s = b1[j];
    for (int e = 0; e < 33; e++) s += z[tt * 33 + e] * w1[e * 64 + j];
    h1[i] = sinf(fr0[j] * s);
  }
  __syncthreads();
  for (int i = tid; i < 512; i += 256) {
    int tt = i >> 6, j = i & 63; float s = b2[j];
    for (int e = 0; e < 64; e++) s += h1[tt * 64 + e] * w2[e * 64 + j];
    h2[i] = sinf(fr1[j] * s);
  }
  __syncthreads();
  float* FB = (float*)(WS(p) + OFF_G) + (Lsel ? 524288 : 0);
  float* SUMSQ = (float*)(WS(p) + WS_END);
  for (int m = 0; m < 8; m++) {
    int col = tid + m * 256;
    float acc[8];
#pragma unroll
    for (int tt = 0; tt < 8; tt++) acc[tt] = 0.f;
    for (int j = 0; j < 64; j++) {
      float w = w3[j * 2048 + col];
#pragma unroll
      for (int tt = 0; tt < 8; tt++) acc[tt] += h2[tt * 64 + j] * w;
    }
    int dir = col >> 10, o = (col >> 9) & 1, c = col & 511;
    float rate = 3.0701134573253944f + (float)c * ((15.350567286626972f - 3.0701134573253944f) / 511.f);
    float ss = 0.f;
    float* Fo = FB + (size_t)o * (2 * L) * 512 + c;
#pragma unroll
    for (int tt = 0; tt < 8; tt++) {
      int t = t0 + tt;
      float val = acc[tt] * expf(-((float)t / (float)L) * rate);
      if (dir == 0) { Fo[(size_t)(L + t) * 512] = val; ss += val * val; }
      else if (t > 0) { Fo[(size_t)(L - t) * 512] = val; ss += val * val; }
      else { Fo[0] = 0.f; }
    }
    SUMSQ[((size_t)l * 160 + task) * 2048 + col] = ss;
  }
}

DEV void s5prep_task(const Params& p, int task) {
  int idx = task * 256 + TID();
  int pp = idx & 63; int lrg = idx >> 6;
  float lre = INP(p, 11)[idx], lim = INP(p, 12)[idx];
  float dt = expf(INP(p, 13)[lrg]);
  float mag = expf(lre * dt);
  float lbr = mag * cosf(lim * dt), lbi = mag * sinf(lim * dt);
  float nr = lbr - 1.f, ni = lbi; float den = lre * lre + lim * lim;
  float cr = (nr * lre + ni * lim) / den, ci = (ni * lre - nr * lim) / den;
  u16* BBAR = (u16*)(WS(p) + OFF_BBAR); u16* CM = (u16*)(WS(p) + OFF_CM); float* LB = (float*)(WS(p) + OFF_LAMBAR);
  LB[idx * 2] = lbr; LB[idx * 2 + 1] = lbi;
  for (int c = 0; c < 16; c++) {
    float br = INP(p, 14)[(size_t)idx * 16 + c], bi = INP(p, 15)[(size_t)idx * 16 + c];
    BBAR[(size_t)lrg * 2048 + pp * 16 + c] = f2bf(cr * br - ci * bi);
    BBAR[(size_t)lrg * 2048 + (64 + pp) * 16 + c] = f2bf(cr * bi + ci * br);
    CM[(size_t)lrg * 2048 + c * 128 + pp] = f2bf(INP(p, 16)[(size_t)lrg * 1024 + c * 64 + pp]);
    CM[(size_t)lrg * 2048 + c * 128 + 64 + pp] = f2bf(-INP(p, 17)[(size_t)lrg * 1024 + c * 64 + pp]);
  }
}

DEV void rope_task(const Params& p, int task) {
  int idx = task * 256 + TID(); int t = idx >> 6, d = idx & 63; int f = d & 31;
  float inv = powf(10000.f, -(float)f / 32.f);
  float pos = (d < 32) ? (float)(t >> 6) : (float)(t & 63);
  float ang = pos * inv;
  float* R = (float*)(WS(p) + OFF_ROPE);
  R[idx * 2] = cosf(ang); R[idx * 2 + 1] = sinf(ang);
}

DEV void layer_prep(const Params& p, int l, char* smem) {
  for (int t = BID(); t < 4672 + 160; t += gridDim.x) {
    if (t < 4672) wt_task(p, l, t, (float*)smem);
    else filt_task(p, l, t - 4672, (float*)smem);
  }
}
DEV void phaseA(const Params& p, char* smem) {
  for (int t = BID(); t < 192 + 32 + 256 + 256; t += gridDim.x) {
    if (t < 192) mod_task(p, t, (float*)smem);
    else if (t < 224) s5prep_task(p, t - 192);
    else if (t < 480) rope_task(p, t - 224);
    else { int tt = t - 480; int mi = tt >> 2; transpose_tile(INP(p, 3) + (size_t)mi * 16384, 128, 128, (u16*)(WS(p) + OFF_S0T) + (size_t)mi * 16384, tt & 3, (float*)smem); }
  }
  layer_prep(p, 0, smem);
}

DEV void norm_phase(const Params& p, int l, int which) {
  const int lane = TID() & 63;
  const int wave = (BID() * blockDim.x + TID()) >> 6, nw = (gridDim.x * blockDim.x) >> 6;
  u16* H = (u16*)(WS(p) + OFF_H);
  const float* MOD = (const float*)(WS(p) + OFF_MOD);
  for (int row = wave; row < MT; row += nw) {
    const float* x = (l == 0 && which == 0) ? xin_row(p, row) : OUTP(p) + (size_t)row * 1024;
    float4 v[4]; float ss = 0.f;
#pragma unroll
    for (int i = 0; i < 4; i++) { v[i] = *(const float4*)(x + i * 256 + lane * 4); ss += v[i].x * v[i].x + v[i].y * v[i].y + v[i].z * v[i].z + v[i].w * v[i].w; }
#pragma unroll
    for (int o = 32; o > 0; o >>= 1) ss += __shfl_xor(ss, o, 64);
    float rinv = rsqrtf(ss * (1.f / 1024.f) + 1e-6f);
    if (which == 2) {
      const float* nf = INP(p, 35);
#pragma unroll
      for (int i = 0; i < 4; i++) {
        float4 g = *(const float4*)(nf + i * 256 + lane * 4);
        float4 o; o.x = v[i].x * rinv * g.x; o.y = v[i].y * rinv * g.y; o.z = v[i].z * rinv * g.z; o.w = v[i].w * rinv * g.w;
        *(float4*)(OUTP(p) + (size_t)row * 1024 + i * 256 + lane * 4) = o;
      }
    } else {
      int j = modidx(row);
      const float* nwt = (which == 0 ? INP(p, 8) : INP(p, 9)) + l * 1024;
      const float* msh = MOD + (l * 5 + j) * 6144 + (which ? 3 : 0) * 1024;
      const float* msc = msh + 1024;
      const float* bsh = INP(p, 7) + l * 6144 + (which ? 3 : 0) * 1024;
      const float* bsc = bsh + 1024;
#pragma unroll
      for (int i = 0; i < 4; i++) {
        int k = i * 256 + lane * 4;
        float4 g = *(const float4*)(nwt + k);
        float4 sh = *(const float4*)(msh + k), sc = *(const float4*)(msc + k);
        float4 bh = *(const float4*)(bsh + k), bc = *(const float4*)(bsc + k);
        float o0 = v[i].x * rinv * g.x * (1.f + sc.x + bc.x) + sh.x + bh.x;
        float o1 = v[i].y * rinv * g.y * (1.f + sc.y + bc.y) + sh.y + bh.y;
        float o2 = v[i].z * rinv * g.z * (1.f + sc.z + bc.z) + sh.z + bh.z;
        float o3 = v[i].w * rinv * g.w * (1.f + sc.w + bc.w) + sh.w + bh.w;
        u32x2 pk; pk.x = pack2(o0, o1); pk.y = pack2(o2, o3);
        *(u32x2*)(H + (size_t)row * 1024 + k) = pk;
      }
    }
  }
}

DEV void phaseC(const Params& p, int l, char* smem) {
  u16* sA = (u16*)smem; u16* T = (u16*)smem;
  const u16* H = (const u16*)(WS(p) + OFF_H);
  const u16* WIN = (const u16*)(WS(p) + OFF_WT) + WIN_O;
  u16* ZA = (u16*)(WS(p) + OFF_ZA); u16* HYT = (u16*)(WS(p) + OFF_HYZ); u16* VT = (u16*)(WS(p) + OFF_VT);
  u16* KT = (u16*)(WS(p) + OFF_KT); u16* QR = (u16*)(WS(p) + OFF_QR);
  const float* ROPE = (const float*)(WS(p) + OFF_ROPE);
  const int tid = TID();
  for (int tile = BID(); tile < 48 * 32; tile += gridDim.x) {
    int tm = tile >> 5, tn = tile & 31;
    if (gridDim.x == 512) {
      const int r = tile >> 9, bb = tile & 511, x = bb & 7, j = bb >> 3;
      tm = r * 16 + (x >> 2) * 8 + (j >> 3); tn = (x & 3) * 8 + (j & 7);
    }
    f32x4 acc[8][4]; zero_acc<8, 4>(acc);
    gemm_loop<8, 4>(H + (size_t)tm * 256 * 1024, 1024, WIN + (size_t)tn * 128 * 1024, 1024, 1024, acc, sA);
    int kind = tn >> 2, hd = tn & 3;
    const int op = kind == 2 ? 1 : (kind == 4 ? 2 : 0);
#pragma unroll
    for (int hh = 0; hh < 2; hh++) {
      int row0 = tm * 256 + hh * 128; bool lat = row0 >= 8192;
      int seq, t0, L;
      if (!lat) { seq = row0 >> 8; t0 = row0 & 255; L = 256; } else { seq = (row0 - 8192) >> 10; t0 = (row0 - 8192) & 1023; L = 1024; }
      __syncthreads();
      if (kind == 3 || kind >= 5) {
        acc_to_lds_T<8>(acc, T, hh * 4, 0);
        __syncthreads();
        u16* dst;
        if (kind == 3) dst = lat ? VT + (size_t)8192 * 512 + (size_t)((seq * 4 + hd) * 128) * 1024 + t0 : VT + (size_t)((seq * 4 + hd) * 128) * 256 + t0;
        else dst = lat ? HYT + (size_t)8192 * 1536 + ((size_t)seq * 1536 + (tn - 20) * 128) * 1024 + t0 : HYT + ((size_t)seq * 1536 + (tn - 20) * 128) * 256 + t0;
        copy_tile<128, 136>(T, dst, L);
      } else {
        acc_to_lds<8, 4, 136>(acc, T, hh * 4, op);
        __syncthreads();
        bool roped = lat && (kind == 1 || kind == 2);
        if (!(lat && kind == 2)) {
          u16* dst;
          if (kind == 0) dst = ZA + (size_t)row0 * 2048 + hd * 128;
          else if (kind == 1) dst = ZA + (size_t)row0 * 2048 + 512 + hd * 128;
          else if (kind == 2) dst = ZA + (size_t)row0 * 2048 + 1024 + hd * 128;
          else dst = ZA + (size_t)row0 * 2048 + 1536 + hd * 128;
          copy_tile<128, 136>(T, dst, 2048);
        }
        if (roped) {
          u16* dst; int ld;
          if (kind == 1) { dst = QR + (size_t)(row0 - 8192) * 512 + hd * 128; ld = 512; }
          else { dst = ZA + (size_t)row0 * 2048 + 1024 + hd * 128; ld = 2048; }
#pragma unroll 1
          for (int i = 0; i < 4; i++) {
            int id = tid + i * 256; int r = id >> 3, ch = id & 7;
            u32x4 a = *(const u32x4*)(T + r * 136 + ch * 8);
            u32x4 b = *(const u32x4*)(T + r * 136 + 64 + ch * 8);
            const float4* cs = (const float4*)(ROPE + ((size_t)(t0 + r) * 64 + ch * 8) * 2);
            u32x4 o1, o2;
#pragma unroll
            for (int q = 0; q < 4; q++) {
              float4 c4 = cs[q];
              float x1a = __uint_as_float(a[q] << 16), x1b = __uint_as_float(a[q] & 0xffff0000u);
              float x2a = __uint_as_float(b[q] << 16), x2b = __uint_as_float(b[q] & 0xffff0000u);
              o1[q] = pack2(x1a * c4.x - x2a * c4.y, x1b * c4.z - x2b * c4.w);
              o2[q] = pack2(x1a * c4.y + x2a * c4.x, x1b * c4.w + x2b * c4.z);
            }
            *(u32x4*)(dst + (size_t)r * ld + ch * 8) = o1;
            *(u32x4*)(dst + (size_t)r * ld + 64 + ch * 8) = o2;
          }
        }
        if (kind == 2 && !lat) {
          __syncthreads();
          acc_to_lds_T<8>(acc, T, hh * 4, op);
          __syncthreads();
          copy_tile<128, 136>(T, KT + (size_t)((seq * 4 + hd) * 128) * 256 + t0, 256);
        }
      }
    }
  }
}

DEV void s5_task(const Params& p, int l, int task, char* smem) {
  const int tid = TID(), lane = tid & 63, wid = tid >> 6, fr = lane & 15, fq = lane >> 4;
  int seq, gp;
  if (task < 64) { seq = 32 + (task >> 4); gp = task & 15; } else { int t2 = task - 64; seq = t2 >> 4; gp = t2 & 15; }
  const bool lat = seq >= 32;
  const int L = lat ? 1024 : 256;
  const int row0 = lat ? 8192 + (seq - 32) * 1024 : seq * 256;
  const int grp = gp * 2 + (wid >> 1), dir = wid & 1;
  const int lrg = (l * 2 + dir) * 32 + grp;
  float* BU = (float*)(smem + wid * 12544);
  u16* HB = (u16*)(smem + wid * 12544 + 8192);
  u16* ZA = (u16*)(WS(p) + OFF_ZA);
  float* YP = (float*)(WS(p) + OFF_YP);
  const u16* BBAR = (const u16*)(WS(p) + OFF_BBAR) + (size_t)lrg * 2048;
  const u16* CM = (const u16*)(WS(p) + OFF_CM) + (size_t)lrg * 2048;
  const float* LB = (const float*)(WS(p) + OFF_LAMBAR) + ((size_t)lrg * 64 + lane) * 2;
  const float lr = LB[0], li = LB[1];
  bf16x8 bfrag[8], cfrag[4];
  const bf16x8 zero8 = {0, 0, 0, 0, 0, 0, 0, 0};
#pragma unroll
  for (int nt = 0; nt < 8; nt++) bfrag[nt] = (fq < 2) ? *(const bf16x8*)(BBAR + (nt * 16 + fr) * 16 + fq * 8) : zero8;
#pragma unroll
  for (int ks = 0; ks < 4; ks++) cfrag[ks] = *(const bf16x8*)(CM + fr * 128 + ks * 32 + fq * 8);
  float hr = 0.f, hi = 0.f;
  if (lat) {
    const float* s0 = INP(p, 2) + ((((size_t)(seq - 32) * 2 + l) * 2 + dir) * 32 + grp) * 128 + lane * 2;
    hr = s0[0]; hi = s0[1];
  }
  const float dcoef = INP(p, 18)[l * 512 + grp * 16 + fr];
  const int nch = L >> 4;
  __syncthreads();
  const int half = nch >> 1;
  bf16x8 ua_next = (fq < 2) ? *(const bf16x8*)(ZA + (size_t)(row0 + (dir ? nch - 1 : 0) * 16 + fr) * 2048 + grp * 16 + fq * 8) : zero8;
  const int tbase = dir ? 15 : 0, tstep = dir ? -1 : 1;
  for (int i = 0; i < nch; i++) {
    const int ci = dir ? nch - 1 - i : i; const int t0 = ci * 16;
    if (i == half) { asm volatile("s_waitcnt vmcnt(0)" ::: "memory"); __threadfence(); asm volatile("s_waitcnt vmcnt(0)" ::: "memory"); __syncthreads(); }
    const bf16x8 ua = ua_next;
    if (i + 1 < nch) {
      const int cn = dir ? nch - 2 - i : i + 1;
      ua_next = (fq < 2) ? *(const bf16x8*)(ZA + (size_t)(row0 + cn * 16 + fr) * 2048 + grp * 16 + fq * 8) : zero8;
    }
    float oth[4] = {0.f, 0.f, 0.f, 0.f}, uu[4] = {0.f, 0.f, 0.f, 0.f};
    if (i >= half) {
#pragma unroll
      for (int j = 0; j < 4; j++) {
        size_t row = (size_t)(row0 + t0 + fq * 4 + j);
        oth[j] = YP[row * 512 + grp * 16 + fr];
        uu[j] = bf2f(ZA[row * 2048 + grp * 16 + fr]);
      }
    }
#pragma unroll
    for (int nt = 0; nt < 8; nt++) {
      f32x4 r = __builtin_amdgcn_mfma_f32_16x16x32_bf16(ua, bfrag[nt], f32x4{0.f, 0.f, 0.f, 0.f}, 0, 0, 0);
#pragma unroll
      for (int j = 0; j < 4; j++) BU[(fq * 4 + j) * 128 + nt * 16 + fr] = r[j];
    }
    asm volatile("s_waitcnt lgkmcnt(0)" ::: "memory");
#pragma unroll
    for (int tt = 0; tt < 16; tt++) {
      const int t = tbase + tstep * tt;
      float re = BU[t * 128 + lane], im = BU[t * 128 + 64 + lane];
      float nr = lr * hr - li * hi + re; float ni = lr * hi + li * hr + im;
      hr = nr; hi = ni;
      HB[t * 136 + lane] = f2bf(hr); HB[t * 136 + 64 + lane] = f2bf(hi);
    }
    asm volatile("s_waitcnt lgkmcnt(0)" ::: "memory");
    f32x4 y = {0.f, 0.f, 0.f, 0.f};
#pragma unroll
    for (int ks = 0; ks < 4; ks++) {
      bf16x8 a = *(const bf16x8*)(HB + fr * 136 + ks * 32 + fq * 8);
      y = __builtin_amdgcn_mfma_f32_16x16x32_bf16(a, cfrag[ks], y, 0, 0, 0);
    }
    asm volatile("s_waitcnt lgkmcnt(0)" ::: "memory");
    if (i < half) {
#pragma unroll
      for (int j = 0; j < 4; j++) YP[(size_t)(row0 + t0 + fq * 4 + j) * 512 + grp * 16 + fr] = y[j];
    } else {
#pragma unroll
      for (int j = 0; j < 4; j++) {
        size_t row = (size_t)(row0 + t0 + fq * 4 + j);
        float v = y[j] + oth[j] + dcoef * uu[j];
        ZA[row * 2048 + grp * 16 + fr] = f2bf(gelu_(v));
      }
    }
  }
  if (!lat) {
    float* o = OUTP(p) + 12582912 + ((((size_t)seq * 2 + l) * 2 + dir) * 32 + grp) * 128 + lane * 2;
    o[0] = hr; o[1] = hi;
  }
}

DEV void ret_task(const Params& p, int l, int task, char* smem) {
  const int tid = TID(), lane = tid & 63, wid = tid >> 6, fr = lane & 15, fq = lane >> 4;
  int seq, h, qt; bool lat;
  if (task < 256) { lat = true; seq = task >> 6; h = (task >> 4) & 3; qt = task & 15; }
  else { int t2 = task - 256; lat = false; seq = t2 >> 4; h = (t2 >> 2) & 3; qt = t2 & 3; }
  const int L = lat ? 1024 : 256;
  const int row0 = lat ? 8192 + seq * 1024 : seq * 256;
  u16* sK = (u16*)smem; u16* sV = sK + 64 * 136; u16* sP = sV + 128 * 72 + wid * 16 * 72;
  u16* ZA = (u16*)(WS(p) + OFF_ZA);
  const u16* QR = (const u16*)(WS(p) + OFF_QR);
  const u16* VT = (const u16*)(WS(p) + OFF_VT);
  const float lgf = log1pf(-expf(INP(p, 20)[(l * 2 + 0) * 4 + h])), lgb = log1pf(-expf(INP(p, 20)[(l * 2 + 1) * 4 + h]));
  const int qrow = qt * 64 + wid * 16;
  const u16* qsrc = lat ? QR + (size_t)(row0 - 8192 + qrow + fr) * 512 + h * 128 : ZA + (size_t)(row0 + qrow + fr) * 2048 + 512 + h * 128;
  bf16x8 qa[4];
#pragma unroll
  for (int ks = 0; ks < 4; ks++) qa[ks] = *(const bf16x8*)(qsrc + ks * 32 + fq * 8);
  f32x4 o[8];
#pragma unroll
  for (int n = 0; n < 8; n++) o[n] = f32x4{0.f, 0.f, 0.f, 0.f};
  const u16* Kbase = ZA + (size_t)row0 * 2048 + 1024 + h * 128;
  const u16* Vbase = lat ? VT + (size_t)8192 * 512 + (size_t)((seq * 4 + h) * 128) * 1024 : VT + (size_t)((seq * 4 + h) * 128) * 256;
  const int nkt = L >> 6;
  u32x4 kreg[4], vreg[4];
  const int kr = tid >> 4, kc = (tid & 15) * 8;
  const int ve = tid >> 3, vc = (tid & 7) * 8;
#pragma unroll
  for (int i = 0; i < 4; i++) {
    kreg[i] = *(const u32x4*)(Kbase + (size_t)(kr + 16 * i) * 2048 + kc);
    vreg[i] = *(const u32x4*)(Vbase + (size_t)(ve + 32 * i) * L + vc);
  }
  for (int jt = 0; jt < nkt; jt++) {
    __syncthreads();
#pragma unroll
    for (int i = 0; i < 4; i++) {
      *(u32x4*)(sK + (kr + 16 * i) * 136 + kc) = kreg[i];
      *(u32x4*)(sV + (ve + 32 * i) * 72 + vc) = vreg[i];
    }
    __syncthreads();
    if (jt + 1 < nkt) {
#pragma unroll
      for (int i = 0; i < 4; i++) {
        kreg[i] = *(const u32x4*)(Kbase + (size_t)((jt + 1) * 64 + kr + 16 * i) * 2048 + kc);
        vreg[i] = *(const u32x4*)(Vbase + (size_t)(ve + 32 * i) * L + (jt + 1) * 64 + vc);
      }
    }
    f32x4 s[4];
#pragma unroll
    for (int nt = 0; nt < 4; nt++) s[nt] = f32x4{0.f, 0.f, 0.f, 0.f};
    {
      const u16* kp = sK + fr * 136 + fq * 8;
      bf16x8 b_cur = *(const bf16x8*)(kp);
      bf16x8 b_nxt = *(const bf16x8*)(kp + 32);
#pragma unroll
      for (int i = 0; i < 16; i++) {
        bf16x8 b_n2 = b_nxt;
        if (i + 2 < 16) b_n2 = *(const bf16x8*)(kp + ((i + 2) >> 2) * 16 * 136 + ((i + 2) & 3) * 32);
        __builtin_amdgcn_sched_barrier(0);
        s[i >> 2] = __builtin_amdgcn_mfma_f32_16x16x32_bf16(qa[i & 3], b_cur, s[i >> 2], 0, 0, 0);
        __builtin_amdgcn_sched_barrier(0);
        b_cur = b_nxt; b_nxt = b_n2;
      }
    }
#pragma unroll
    for (int nt = 0; nt < 4; nt++)
#pragma unroll
      for (int j = 0; j < 4; j++) {
        int d = (qrow + fq * 4 + j) - (jt * 64 + nt * 16 + fr);
        float w = d >= 0 ? __expf(lgf * (float)d) : __expf(lgb * (float)(-d));
        sP[(fq * 4 + j) * 72 + nt * 16 + fr] = f2bf(s[nt][j] * w);
      }
    asm volatile("s_waitcnt lgkmcnt(0)" ::: "memory");
    {
      bf16x8 pa[2];
      pa[0] = *(const bf16x8*)(sP + fr * 72 + fq * 8);
      pa[1] = *(const bf16x8*)(sP + fr * 72 + 32 + fq * 8);
      const u16* vp = sV + fr * 72 + fq * 8;
      bf16x8 b_cur = *(const bf16x8*)(vp);
      bf16x8 b_nxt = *(const bf16x8*)(vp + 16 * 72);
#pragma unroll
      for (int i = 0; i < 16; i++) {
        bf16x8 b_n2 = b_nxt;
        if (i + 2 < 16) b_n2 = *(const bf16x8*)(vp + ((i + 2) & 7) * 16 * 72 + ((i + 2) >> 3) * 32);
        __builtin_amdgcn_sched_barrier(0);
        o[i & 7] = __builtin_amdgcn_mfma_f32_16x16x32_bf16(pa[i >> 3], b_cur, o[i & 7], 0, 0, 0);
        __builtin_amdgcn_sched_barrier(0);
        b_cur = b_nxt; b_nxt = b_n2;
      }
    }
    asm volatile("s_waitcnt lgkmcnt(0)" ::: "memory");
  }
  if (lat) {
    const u16* q0src = ZA + (size_t)(row0 + qrow + fr) * 2048 + 512 + h * 128;
    bf16x8 q0[4];
#pragma unroll
    for (int ks = 0; ks < 4; ks++) q0[ks] = *(const bf16x8*)(q0src + ks * 32 + fq * 8);
#pragma unroll 1
    for (int dir = 0; dir < 2; dir++) {
      const u16* S0 = (const u16*)(WS(p) + OFF_S0T) + (size_t)((((seq * 2 + l) * 2 + dir) * 4 + h)) * 16384;
      u16* sS = sK;
      __syncthreads();
#pragma unroll
      for (int i = 0; i < 8; i++) {
        int id = tid + i * 256; int e = id >> 4, ch = id & 15;
        *(u32x4*)(sS + e * 136 + ch * 8) = *(const u32x4*)(S0 + (size_t)e * 128 + ch * 8);
      }
      __syncthreads();
      float wj[4];
#pragma unroll
      for (int j = 0; j < 4; j++) { int gi = qrow + fq * 4 + j; wj[j] = dir == 0 ? __expf(lgf * (float)(gi + 1)) : __expf(lgb * (float)(L - 1 - gi)); }
#pragma unroll
      for (int n2 = 0; n2 < 8; n2++) {
        f32x4 tmp = {0.f, 0.f, 0.f, 0.f};
#pragma unroll
        for (int ks = 0; ks < 4; ks++) {
          bf16x8 b = *(const bf16x8*)(sS + (n2 * 16 + fr) * 136 + ks * 32 + fq * 8);
          tmp = __builtin_amdgcn_mfma_f32_16x16x32_bf16(q0[ks], b, tmp, 0, 0, 0);
        }
#pragma unroll
        for (int j = 0; j < 4; j++) o[n2][j] += wj[j] * tmp[j];
      }
    }
  }
#pragma unroll
  for (int j = 0; j < 4; j++) {
    float s = 0.f;
#pragma unroll
    for (int n2 = 0; n2 < 8; n2++) s += o[n2][j];
    s += __shfl_xor(s, 1, 64); s += __shfl_xor(s, 2, 64); s += __shfl_xor(s, 4, 64); s += __shfl_xor(s, 8, 64);
    float mean = s * (1.f / 128.f);
    float v = 0.f;
#pragma unroll
    for (int n2 = 0; n2 < 8; n2++) { float dd = o[n2][j] - mean; v += dd * dd; }
    v += __shfl_xor(v, 1, 64); v += __shfl_xor(v, 2, 64); v += __shfl_xor(v, 4, 64); v += __shfl_xor(v, 8, 64);
    float rstd = rsqrtf(v * (1.f / 128.f) + 1e-5f);
    size_t rbase = (size_t)(row0 + qrow + fq * 4 + j) * 2048;
#pragma unroll
    for (int n2 = 0; n2 < 8; n2++) {
      int e = n2 * 16 + fr;
      float gv = bf2f(ZA[rbase + 1536 + h * 128 + e]);
      ZA[rbase + 512 + h * 128 + e] = f2bf((o[n2][j] - mean) * rstd * gv);
    }
  }
}

DEV bf16x8 scale8(u32x4 raw, const float (&w)[8]) {
  union { u32x4 u; bf16x8 v; } r;
#pragma unroll
  for (int q = 0; q < 4; q++) {
    float a = __uint_as_float(raw[q] << 16) * w[q * 2], b = __uint_as_float(raw[q] & 0xffff0000u) * w[q * 2 + 1];
    r.u[q] = pack2(a, b);
  }
  return r.v;
}

DEV void retstate_task(const Params& p, int l, int task) {
  const int tid = TID(), lane = tid & 63, wid = tid >> 6, fr = lane & 15, fq = lane >> 4;
  int seq = task >> 3, h = (task >> 1) & 3, dir = task & 1;
  const u16* KT = (const u16*)(WS(p) + OFF_KT) + (size_t)((seq * 4 + h) * 128) * 256;
  const u16* VT = (const u16*)(WS(p) + OFF_VT) + (size_t)((seq * 4 + h) * 128) * 256;
  const float lg = log1pf(-expf(INP(p, 20)[(l * 2 + dir) * 4 + h]));
  f32x4 acc[2][8];
#pragma unroll
  for (int m = 0; m < 2; m++)
#pragma unroll
    for (int n = 0; n < 8; n++) acc[m][n] = f32x4{0.f, 0.f, 0.f, 0.f};
#pragma unroll 1
  for (int ks = 0; ks < 8; ks++) {
    float w[8];
#pragma unroll
    for (int jj = 0; jj < 8; jj++) { int j = ks * 32 + fq * 8 + jj; w[jj] = __expf(lg * (float)(dir == 0 ? 255 - j : j)); }
    bf16x8 a[2];
#pragma unroll
    for (int m = 0; m < 2; m++) a[m] = scale8(*(const u32x4*)(KT + (size_t)(wid * 32 + m * 16 + fr) * 256 + ks * 32 + fq * 8), w);
#pragma unroll
    for (int n = 0; n < 8; n++) {
      bf16x8 b = *(const bf16x8*)(VT + (size_t)(n * 16 + fr) * 256 + ks * 32 + fq * 8);
#pragma unroll
      for (int m = 0; m < 2; m++) acc[m][n] = __builtin_amdgcn_mfma_f32_16x16x32_bf16(a[m], b, acc[m][n], 0, 0, 0);
    }
  }
  float* o = OUTP(p) + 13107200 + ((((size_t)seq * 2 + l) * 2 + dir) * 4 + h) * 16384;
#pragma unroll
  for (int m = 0; m < 2; m++)
#pragma unroll
    for (int n = 0; n < 8; n++)
#pragma unroll
      for (int j = 0; j < 4; j++) o[(size_t)(wid * 32 + m * 16 + fq * 4 + j) * 128 + n * 16 + fr] = acc[m][n][j];
}

template <bool LAT>
DEV void hyena_mfma(const Params& p, int l, int task, char* smem) {
  constexpr int L = LAT ? 1024 : 256;
  constexpr int NV = LAT ? 4 : 16;
  constexpr int RS = L + 8, CS = 2 * L + 16;
  constexpr int MPW = L / 64, NKS = L / 32, NCH = L / 8, Lsel = LAT ? 1 : 0;
  const int tid = TID(), lane = tid & 63, wid = tid >> 6, fr = lane & 15, fq = lane >> 4;
  const int c = LAT ? task : (task >> 1);
  const int sg = LAT ? 0 : (task & 1);
  u16* CP = (u16*)smem; u16* XV = CP + 8 * CS; u16* GS = XV + NV * RS; u16* O1 = GS + NV * RS;
  const u16* HYT = (const u16*)(WS(p) + OFF_HYZ);
  u16* HYOT = (u16*)(WS(p) + OFF_OUT1) + (size_t)MT * 512;
  const float* cw = INP(p, 22) + (size_t)l * 3 * 1536; const float* cb = INP(p, 23) + l * 1536;
  auto sconv = [&](int arr, u16* dstA) {
    const int ch = arr * 512 + c;
    const float w0 = cw[ch], w1 = cw[1536 + ch], w2 = cw[3072 + ch], bb = cb[ch];
#pragma unroll
    for (int i = 0; i < (NV * NCH) / 256; i++) {
      int id = tid + i * 256; int n = id / NCH, t8 = (id % NCH) * 8;
      const u16* src = LAT ? HYT + (size_t)8192 * 1536 + ((size_t)n * 1536 + ch) * 1024 + t8 : HYT + ((size_t)(sg * 16 + n) * 1536 + ch) * 256 + t8;
      u32x4 raw = *(const u32x4*)src;
      float h[10];
      h[0] = t8 > 0 ? bf2f(src[-1]) : 0.f;
      h[9] = t8 + 8 < L ? bf2f(src[8]) : 0.f;
#pragma unroll
      for (int q = 0; q < 4; q++) { h[1 + 2 * q] = __uint_as_float(raw[q] << 16); h[2 + 2 * q] = __uint_as_float(raw[q] & 0xffff0000u); }
      u32x4 o;
#pragma unroll
      for (int q = 0; q < 4; q++) o[q] = pack2(w0 * h[2 * q] + w1 * h[2 * q + 1] + w2 * h[2 * q + 2] + bb, w0 * h[2 * q + 1] + w1 * h[2 * q + 2] + w2 * h[2 * q + 3] + bb);
      *(u32x4*)(dstA + n * RS + t8) = o;
    }
  };
  __syncthreads();
  sconv(0, GS);
  sconv(2, XV);
  const int rr = (-fr) & 7;
  const u16* cpl = CP + rr * CS + (L + 8 * fq - fr - rr);
#pragma unroll 1
  for (int o = 0; o < 2; o++) {
    if (o == 1) sconv(1, GS);
    u16* FL = o == 0 ? O1 : XV;
    const float* Gp = (const float*)(WS(p) + OFF_G) + (Lsel ? 524288 : 0) + (size_t)o * (2 * L) * 512 + c;
    if (tid < 2 * L / 8) {
      float f[8];
#pragma unroll
      for (int j = 0; j < 8; j++) { int u = tid * 8 + j; f[j] = u > 0 ? Gp[(size_t)(2 * L - u) * 512] : 0.f; }
      u32x4 v; v[0] = pack2(f[0], f[1]); v[1] = pack2(f[2], f[3]); v[2] = pack2(f[4], f[5]); v[3] = pack2(f[6], f[7]);
      *(u32x4*)(FL + tid * 8) = v;
    }
    if (tid < 2) *(u32x4*)(FL + 2 * L + tid * 8) = u32x4{0u, 0u, 0u, 0u};
    __syncthreads();
    if (tid < 2 * L / 8) {
      u32x4 a = *(const u32x4*)(FL + tid * 8), b = *(const u32x4*)(FL + tid * 8 + 8);
      unsigned d[8] = {a[0], a[1], a[2], a[3], b[0], b[1], b[2], b[3]};
#pragma unroll
      for (int r = 0; r < 8; r++) {
        u32x4 ov;
#pragma unroll
        for (int q = 0; q < 4; q++) ov[q] = (r & 1) ? ((d[q + (r >> 1)] >> 16) | (d[q + (r >> 1) + 1] << 16)) : d[q + (r >> 1)];
        *(u32x4*)(CP + r * CS + tid * 8) = ov;
      }
    }
    __syncthreads();
    float rn;
    {
      constexpr int NTB = LAT ? 128 : 32;
      const float* SP = (const float*)(WS(p) + WS_END) + ((size_t)l * 160 + (LAT ? 32 : 0)) * 2048 + o * 512 + c;
      float ssum = 0.f;
      for (int tb = lane; tb < NTB; tb += 64) ssum += SP[(size_t)tb * 2048] + SP[(size_t)tb * 2048 + 1024];
#pragma unroll
      for (int off = 32; off > 0; off >>= 1) ssum += __shfl_xor(ssum, off, 64);
      rn = rsqrtf(ssum + 1e-6f);
    }
    const float bias = INP(p, 30)[(l * 2 + o) * 512 + c];
    const u16* Xs = o == 0 ? XV : O1;
    f32x4 acc[MPW];
#pragma unroll
    for (int mi = 0; mi < MPW; mi++) acc[mi] = f32x4{0.f, 0.f, 0.f, 0.f};
    const bf16x8 zero8 = {0, 0, 0, 0, 0, 0, 0, 0};
    {
      bf16x8 b_next = (fr < NV) ? *(const bf16x8*)(Xs + fr * RS + fq * 8) : zero8;
#pragma unroll 1
      for (int ks = 0; ks < NKS; ks++) {
        const bf16x8 b = b_next;
        const u16* ap = cpl - 16 * (wid * MPW) + 32 * ks;
        bf16x8 a_cur = *(const bf16x8*)(ap);
        bf16x8 a_nxt = *(const bf16x8*)(ap - 16);
        if (ks + 1 < NKS) b_next = (fr < NV) ? *(const bf16x8*)(Xs + fr * RS + (ks + 1) * 32 + fq * 8) : zero8;
#pragma unroll
        for (int mi = 0; mi < MPW; mi++) {
          bf16x8 a_n2 = a_nxt;
          if (mi + 2 < MPW) a_n2 = *(const bf16x8*)(ap - 16 * (mi + 2));
          __builtin_amdgcn_sched_barrier(0);
          acc[mi] = __builtin_amdgcn_mfma_f32_16x16x32_bf16(a_cur, b, acc[mi], 0, 0, 0);
          __builtin_amdgcn_sched_barrier(0);
          a_cur = a_nxt; a_nxt = a_n2;
        }
      }
    }
    if (fr < NV) {
      const u16* gate = GS;
      const u16* vin = o == 0 ? XV : O1;
#pragma unroll
      for (int mi = 0; mi < MPW; mi++) {
        const int t0 = (wid * MPW + mi) * 16 + fq * 4;
        u32x2 gq = *(const u32x2*)(gate + fr * RS + t0), vq = *(const u32x2*)(vin + fr * RS + t0);
        float g4[4] = {__uint_as_float(gq[0] << 16), __uint_as_float(gq[0] & 0xffff0000u), __uint_as_float(gq[1] << 16), __uint_as_float(gq[1] & 0xffff0000u)};
        float v4[4] = {__uint_as_float(vq[0] << 16), __uint_as_float(vq[0] & 0xffff0000u), __uint_as_float(vq[1] << 16), __uint_as_float(vq[1] & 0xffff0000u)};
        float r4[4];
#pragma unroll
        for (int j = 0; j < 4; j++) r4[j] = g4[j] * (acc[mi][j] * rn + bias * v4[j]);
        if (o == 0) {
          u32x2 ov; ov[0] = pack2(r4[0], r4[1]); ov[1] = pack2(r4[2], r4[3]);
          *(u32x2*)(O1 + fr * RS + t0) = ov;
        } else {
          u16* dst = LAT ? HYOT + (size_t)8192 * 512 + ((size_t)fr * 512 + c) * 1024 + t0 : HYOT + ((size_t)(sg * 16 + fr) * 512 + c) * 256 + t0;
          u32x2 ov; ov[0] = pack2(r4[0], r4[1]); ov[1] = pack2(r4[2], r4[3]);
          *(u32x2*)dst = ov;
        }
      }
    }
    __syncthreads();
  }
}

DEV void phaseD(const Params& p, int l, char* smem) {
  const int nbt = gridDim.x, bt = BID();
  __shared__ int s_task;
  unsigned* ctr = (unsigned*)(WS(p) + OFF_BAR) + 3600 + l * 8;
  if (nbt >= 128 && bt < 64) {
    s5_task(p, l, bt, smem);
    return;
  }
  const int s5lo = nbt >= 128 ? 64 : 0;
#define PULL(pool, limit, body) for (;;) { __syncthreads(); if (threadIdx.x == 0) s_task = (int)atomicAdd(&ctr[pool], 1u); __syncthreads(); \
                                           const int t = s_task; if (t >= (limit)) break; body; }
  PULL(0, 768, ret_task(p, l, t, smem))
  PULL(1, 512, hyena_mfma<true>(p, l, t, smem))
  PULL(2, 576 - s5lo, s5_task(p, l, s5lo + t, smem))
  PULL(3, 1024, hyena_mfma<false>(p, l, t, smem))
  PULL(4, 256, retstate_task(p, l, t))
#undef PULL
}

DEV void phaseE(const Params& p, char* smem) {
  const u16* HYOT = (const u16*)(WS(p) + OFF_OUT1) + (size_t)MT * 512;
  u16* HYO = (u16*)(WS(p) + OFF_OUT1);
  u16* sm = (u16*)smem;
  const int tx = TID() & 63, ty = TID() >> 6;
  for (int tile = BID(); tile < 192 * 8; tile += gridDim.x) {
    int rt = tile >> 3, c0 = (tile & 7) * 64; int row0 = rt * 64;
    const u16* src = row0 < 8192 ? HYOT + ((size_t)(row0 >> 8) * 512 + c0) * 256 + (row0 & 255)
                                 : HYOT + (size_t)8192 * 512 + ((size_t)((row0 - 8192) >> 10) * 512 + c0) * 1024 + ((row0 - 8192) & 1023);
    const int L = row0 < 8192 ? 256 : 1024;
    __syncthreads();
#pragma unroll
    for (int i = 0; i < 16; i++) { int cc = ty + i * 4; sm[cc * 66 + tx] = src[(size_t)cc * L + tx]; }
    __syncthreads();
#pragma unroll
    for (int i = 0; i < 16; i++) { int tt = ty + i * 4; HYO[(size_t)(row0 + tt) * 512 + c0 + tx] = sm[tx * 66 + tt]; }
  }
}

DEV void phaseF(const Params& p, int l, char* smem) {
  u16* sA = (u16*)smem; u16* T = (u16*)smem;
  const u16* H = (const u16*)(WS(p) + OFF_H);
  const u16* WT = (const u16*)(WS(p) + OFF_WT);
  const u16* ZA = (const u16*)(WS(p) + OFF_ZA); const u16* HYO = (const u16*)(WS(p) + OFF_OUT1);
  u16* MG = (u16*)(WS(p) + OFF_YP);
  for (int tile = BID(); tile < 96 * 16; tile += gridDim.x) {
    int tm = tile >> 4, tn = tile & 15;
    if (gridDim.x == 512) {
      const int r = tile >> 9, bb = tile & 511, x = bb & 7, j = bb >> 3;
      tm = r * 32 + (x >> 1) * 8 + (j >> 3); tn = (x & 1) * 8 + (j & 7);
    }
    int row0 = tm * 128, n0 = tn * 64;
    f32x4 a1[4][2], a2[4][2], tt[4][2];
    const u16* Hrow = H + (size_t)row0 * 1024;
    zero_acc<4, 2>(a1); zero_acc<4, 2>(tt);
#pragma unroll 1
    for (int ps = 0; ps < 7; ps++) {
      const u16* Ap; const u16* Bp; int lda, K;
      switch (ps) {
        case 0: Ap = ZA + (size_t)row0 * 2048; lda = 2048; Bp = WT + WGLU_O + (size_t)n0 * 512; K = 512; break;
        case 1: Ap = ZA + (size_t)row0 * 2048; lda = 2048; Bp = WT + WGLU_O + (size_t)(1024 + n0) * 512; K = 512; break;
        case 3: Ap = ZA + (size_t)row0 * 2048 + 512; lda = 2048; Bp = WT + WRETO_O + (size_t)n0 * 512; K = 512; break;
        case 5: Ap = HYO + (size_t)row0 * 512; lda = 512; Bp = WT + WHYO_O + (size_t)n0 * 512; K = 512; break;
        default: Ap = Hrow; lda = 1024; Bp = WT + WIN_O + (size_t)(4096 + ((ps - 2) >> 1) * 1024 + n0) * 1024; K = 1024; break;
      }
      zero_acc<4, 2>(a2);
      gemm_loop<4, 2>(Ap, lda, Bp, K, K, a2, sA);
      if (ps == 0 || ps == 3 || ps == 5) {
#pragma unroll
        for (int m = 0; m < 4; m++)
#pragma unroll
          for (int n = 0; n < 2; n++) a1[m][n] = a2[m][n];
      } else if (ps == 1) {
#pragma unroll
        for (int m = 0; m < 4; m++)
#pragma unroll
          for (int n = 0; n < 2; n++)
#pragma unroll
            for (int j = 0; j < 4; j++) a1[m][n][j] *= sigm(a2[m][n][j]);
      } else {
#pragma unroll
        for (int m = 0; m < 4; m++)
#pragma unroll
          for (int n = 0; n < 2; n++)
#pragma unroll
            for (int j = 0; j < 4; j++) tt[m][n][j] += a1[m][n][j] * sigm(a2[m][n][j]);
      }
    }
    __syncthreads();
    acc_to_lds<4, 2, 72>(tt, T, 0);
    __syncthreads();
    copy_tile<64, 72>(T, MG + (size_t)row0 * 1024 + n0, 1024);
  }
}

template <int MF, int NF>
DEV void resid_store(const Params& p, const f32x4 (&acc)[MF][NF], int l, int chunk, int row0, int col0, bool from_input) {
  const int tid = TID(), lane = tid & 63, wid = tid >> 6, wr = wid >> 1, wc = wid & 1, fr = lane & 15, fq = lane >> 4;
  float* out = OUTP(p);
#pragma unroll
  for (int m = 0; m < MF; m++) {
    const int rb = row0 + m * 32 + wr * 16 + fq * 4;
    const int j = modidx(rb);
    const float* MOD = (const float*)(WS(p) + OFF_MOD) + (l * 5 + j) * 6144 + chunk * 1024;
    const float* BM = INP(p, 7) + l * 6144 + chunk * 1024;
#pragma unroll
    for (int n = 0; n < NF; n++) {
      int col = col0 + wc * (NF * 16) + n * 16 + fr;
      float g = MOD[col] + BM[col];
#pragma unroll
      for (int jj = 0; jj < 4; jj++) {
        int row = rb + jj;
        float xo = from_input ? xin_row(p, row)[col] : out[(size_t)row * 1024 + col];
        out[(size_t)row * 1024 + col] = xo + g * acc[m][n][jj];
      }
    }
  }
}

DEV void phaseG(const Params& p, int l, char* smem) {
  u16* sA = (u16*)smem;
  const u16* MG = (const u16*)(WS(p) + OFF_YP);
  const u16* W = (const u16*)(WS(p) + OFF_WT) + WOUT_O;
  for (int tile = BID(); tile < 64 * 8; tile += gridDim.x) {
    int tm = tile >> 3, tn = tile & 7;
    f32x4 acc[6][4]; zero_acc<6, 4>(acc);
    gemm_loop<6, 4>(MG + (size_t)tm * 192 * 1024, 1024, W + (size_t)tn * 128 * 1024, 1024, 1024, acc, sA);
    resid_store<6, 4>(p, acc, l, 2, tm * 192, tn * 128, l == 0);
  }
}

DEV void phaseI(const Params& p, int l, char* smem) {
  u16* sA = (u16*)smem; u16* T = (u16*)smem;
  const u16* H = (const u16*)(WS(p) + OFF_H);
  const u16* W = (const u16*)(WS(p) + OFF_WT) + WFIN_O;
  u16* ACT = (u16*)(WS(p) + OFF_ZA);
  for (int tile = BID(); tile < 48 * 44; tile += gridDim.x) {
    int tm = tile / 44, tn = tile % 44;
    if (gridDim.x == 512) {
      const int r = tile >> 9, bb = tile & 511, x = bb & 7, j = bb >> 3;
      int sb = r * 16 + x * 2 + (j >> 5), inner = j & 31;
      if (r == 4) { sb = 64 + (bb >> 5); inner = bb & 31; }
      tm = (sb / 11) * 8 + (inner >> 2); tn = (sb % 11) * 4 + (inner & 3);
    }
    f32x4 acc[8][4]; zero_acc<8, 4>(acc);
    gemm_loop<8, 4>(H + (size_t)tm * 256 * 1024, 1024, W + (size_t)tn * 128 * 1024, 1024, 1024, acc, sA);
    const int tid = TID(), lane = tid & 63, wid = tid >> 6, wr = wid >> 1, wc = wid & 1, fr = lane & 15, fq = lane >> 4;
#pragma unroll
    for (int hh = 0; hh < 2; hh++) {
      __syncthreads();
#pragma unroll
      for (int m = 0; m < 4; m++)
#pragma unroll
        for (int n = 0; n < 2; n++)
#pragma unroll
          for (int j = 0; j < 4; j++)
            T[(m * 32 + wr * 16 + fq * 4 + j) * 72 + wc * 32 + n * 16 + fr] = f2bf(silu_(acc[hh * 4 + m][2 * n][j]) * acc[hh * 4 + m][2 * n + 1][j]);
      __syncthreads();
      copy_tile<64, 72>(T, ACT + (size_t)(tm * 256 + hh * 128) * 2816 + tn * 64, 2816);
    }
  }
}

DEV void phaseJ(const Params& p, int l, char* smem) {
  u16* sA = (u16*)smem;
  const u16* ACT = (const u16*)(WS(p) + OFF_ZA);
  const u16* W = (const u16*)(WS(p) + OFF_WT) + WFOUT_O;
  for (int tile = BID(); tile < 64 * 8; tile += gridDim.x) {
    int tm = tile >> 3, tn = tile & 7;
    f32x4 acc[6][4]; zero_acc<6, 4>(acc);
    gemm_loop<6, 4>(ACT + (size_t)tm * 192 * 2816, 2816, W + (size_t)tn * 128 * 2816, 2816, 2816, acc, sA);
    resid_store<6, 4>(p, acc, l, 5, tm * 192, tn * 128, false);
  }
}


#define XB_TMO      128
#define XB_XCNT(j)  (256  + 64 * (j))
#define XB_XSUB(j)  (1280 + 64 * (j))
#define XB_XGEN(j)  (2304 + 64 * (j))
#define XB_TOP      3328
#define XB_TOPGEN   3392
#define XB_SPIN_CAP (1u << 22)
#define LAS __attribute__((address_space(3)))
DEV unsigned xb_ld(unsigned* p) { return __hip_atomic_load(p, __ATOMIC_RELAXED, __HIP_MEMORY_SCOPE_AGENT); }
DEV unsigned xb_add(unsigned* p, unsigned v) { return __hip_atomic_fetch_add(p, v, __ATOMIC_RELAXED, __HIP_MEMORY_SCOPE_AGENT); }
DEV unsigned xb_xcc_id() { return (unsigned)__builtin_amdgcn_s_getreg((3 << 11) | 20) & 0xFu; }
#define XB_SPIN(cond, bar) do { unsigned _sp = 0; while (cond) { __builtin_amdgcn_s_sleep(1); \
    if ((++_sp & 255u) == 0u) { if (xb_ld(&(bar)[XB_TMO])) break; if (_sp > XB_SPIN_CAP) { atomicAdd(&(bar)[XB_TMO], 1u); break; } } } } while (0)
struct XcdBarrier { unsigned* bar; unsigned x; volatile LAS unsigned* st; };
DEV XcdBarrier xcd_barrier_post(unsigned* bar, volatile LAS unsigned* st) {
  XcdBarrier b; b.bar = bar; b.x = xb_xcc_id(); b.st = st;
  if (threadIdx.x == 0) (void)xb_add(&bar[XB_XCNT(b.x)], 1u);
  return b;
}
DEV void xcd_barrier_complete(unsigned* bar, unsigned x, unsigned& nloc, unsigned& nx) {
  const unsigned G = gridDim.x * gridDim.y * gridDim.z;
  unsigned sum, cnt, mine, sp = 0u;
  for (;;) {
    sum = 0u; cnt = 0u; mine = 0u;
#pragma unroll
    for (unsigned j = 0; j < 16; ++j) { const unsigned c = xb_ld(&bar[XB_XCNT(j)]); sum += c; cnt += (c > 0u) ? 1u : 0u; mine = (j == x) ? c : mine; }
    if (sum == G) break;
    __builtin_amdgcn_s_sleep(1);
    if ((++sp & 255u) == 0u) { if (xb_ld(&bar[XB_TMO])) break; if (sp > XB_SPIN_CAP) { atomicAdd(&bar[XB_TMO], 1u); break; } }
  }
  nloc = mine > 0u ? mine : 1u; nx = cnt > 0u ? cnt : 1u;
}
DEV void xcd_barrier(const XcdBarrier& b) {
  asm volatile("s_waitcnt vmcnt(0)" ::: "memory");
  __syncthreads();
  if (threadIdx.x == 0) {
    unsigned* bar = b.bar;
    __builtin_amdgcn_s_waitcnt(0);
    unsigned nloc = b.st[0], nx = b.st[1];
    if (nloc == 0u) { xcd_barrier_complete(bar, b.x, nloc, nx); b.st[0] = nloc; b.st[1] = nx; }
    const unsigned old = xb_add(&bar[XB_XSUB(b.x)], 1u);
    const unsigned gen = old / nloc;
    if (old + 1u == (gen + 1u) * nloc) {
      __builtin_amdgcn_fence(__ATOMIC_RELEASE, "agent");
      asm volatile("s_waitcnt vmcnt(0)" ::: "memory");
      const unsigned og = xb_add(&bar[XB_TOP], 1u);
      const unsigned tg = og / nx;
      if (og + 1u == (tg + 1u) * nx) xb_add(&bar[XB_TOPGEN], 1u);
      else XB_SPIN(xb_ld(&bar[XB_TOPGEN]) == tg, bar);
      __builtin_amdgcn_fence(__ATOMIC_ACQUIRE, "agent");
      xb_add(&bar[XB_XGEN(b.x)], 1u);
      asm volatile("s_waitcnt vmcnt(0)" ::: "memory");
    } else {
      XB_SPIN(xb_ld(&bar[XB_XGEN(b.x)]) == gen, bar);
      __builtin_amdgcn_fence(__ATOMIC_ACQUIRE, "agent");
      asm volatile("s_waitcnt vmcnt(0)" ::: "memory");
    }
  }
  __syncthreads();
}

constexpr int SMEM_BYTES = 57792;

DEV void run_phase(const Params& p, int ph, int l, char* smem) {
  switch (ph) {
    case 0: phaseA(p, smem); break;
    case 1: norm_phase(p, l, 0); if (l == 1) layer_prep(p, 1, smem); break;
    case 2: phaseC(p, l, smem); break;
    case 3: phaseD(p, l, smem); break;
    case 4: phaseE(p, smem); break;
    case 5: phaseF(p, l, smem); break;
    case 6: phaseG(p, l, smem); break;
    case 7: norm_phase(p, l, 1); break;
    case 8: phaseI(p, l, smem); break;
    case 9: phaseJ(p, l, smem); break;
    case 10: norm_phase(p, 0, 2); break;
  }
}

#if MULTI
__global__ void __launch_bounds__(256, 2) kphase(Params p, int ph, int l) {
  __shared__ __attribute__((aligned(16))) char smem[SMEM_BYTES];
  run_phase(p, ph, l, smem);
}
#else
__global__ void __launch_bounds__(256, 2) mega(Params p) {
  __shared__ __attribute__((aligned(16))) char smem[SMEM_BYTES];
  __shared__ uint4 xb_words;
  cg::grid_group grid = cg::this_grid();
  if (threadIdx.x == 0) xb_words = make_uint4(0u, 0u, 0u, 0u);
  __syncthreads();
  XcdBarrier xb = xcd_barrier_post((unsigned*)(p.ws + OFF_BAR), (volatile LAS unsigned*)&xb_words);
  run_phase(p, 0, 0, smem);
  grid.sync();
  for (int l = 0; l < 2; l++) {
    for (int ph = 1; ph <= 9; ph++) {
      run_phase(p, ph, l, smem);
      xcd_barrier(xb);
    }
  }
  run_phase(p, 10, 0, smem);
}
#endif

extern "C" void kernel_launch(void* const* d_in, const int* in_sizes, int n_in, void* d_out, int out_size, void* d_ws, size_t ws_size, hipStream_t stream) {
  Params p{};
  for (int i = 0; i < 36; i++) p.in[i] = (const float*)d_in[i];
  p.out = (float*)d_out;
  p.ws = (char*)d_ws;
  hipMemsetAsync((char*)d_ws + OFF_MOD, 0, ZERO_BYTES, stream);
  static int grid_blocks = 0;
#if MULTI
  if (!grid_blocks) {
    int dev = 0, cus = 0, per_cu = 0;
    hipGetDevice(&dev);
    hipDeviceGetAttribute(&cus, hipDeviceAttributeMultiprocessorCount, dev);
    hipOccupancyMaxActiveBlocksPerMultiprocessor(&per_cu, kphase, 256, 0);
    if (per_cu > 2) per_cu = 2;
    if (per_cu < 1) per_cu = 1;
    grid_blocks = cus * per_cu;
  }
  kphase<<<grid_blocks, 256, 0, stream>>>(p, 0, 0);
  for (int l = 0; l < 2; l++)
    for (int ph = 1; ph <= 9; ph++) kphase<<<grid_blocks, 256, 0, stream>>>(p, ph, l);
  kphase<<<grid_blocks, 256, 0, stream>>>(p, 10, 0);
#else
  if (!grid_blocks) {
    int dev = 0, cus = 0, per_cu = 0;
    hipGetDevice(&dev);
    hipDeviceGetAttribute(&cus, hipDeviceAttributeMultiprocessorCount, dev);
    hipOccupancyMaxActiveBlocksPerMultiprocessor(&per_cu, mega, 256, 0);
    if (per_cu > 2) per_cu = 2;
    if (per_cu < 1) per_cu = 1;
    grid_blocks = cus * per_cu;
  }
  void* args[] = {&p};
  hipError_t e = hipLaunchCooperativeKernel((void*)mega, dim3(grid_blocks), dim3(256), args, 0, stream);
  if (e != hipSuccess) fprintf(stderr, "cooperative launch failed: %s (grid %d)\n", hipGetErrorString(e), grid_blocks);
#endif
}
```

```cpp
#include <hip/hip_runtime.h>
#include <hip/hip_cooperative_groups.h>
#include <cstdio>
namespace cg = cooperative_groups;

#ifndef MULTI
#define MULTI 0
#endif

typedef unsigned short u16;
using bf16x8 = __attribute__((ext_vector_type(8))) short;
using f32x4 = __attribute__((ext_vector_type(4))) float;
using u32x4 = __attribute__((ext_vector_type(4))) unsigned;
using u32x2 = __attribute__((ext_vector_type(2))) unsigned;
#define DEV __device__ __forceinline__

constexpr int MT = 12288;
constexpr size_t OFF_WT = 0;
constexpr int WIN_O = 0, WGLU_O = 7340032, WRETO_O = 8388608, WHYO_O = 8912896, WOUT_O = 9437184, WFIN_O = 10485760, WFOUT_O = 16252928;
constexpr size_t OFF_G = 38273024;
constexpr size_t OFF_H = 48758784;
constexpr size_t OFF_ZA = 73924608;
constexpr size_t OFF_HYZ = 124256256;
constexpr size_t OFF_VT = 162004992;
constexpr size_t OFF_KT = 174587904;
constexpr size_t OFF_QR = 182976512;
constexpr size_t OFF_YP = 187170816;
constexpr size_t OFF_OUT1 = 212336640;
constexpr size_t OFF_MOD = 237502464;
constexpr size_t OFF_SUMSQ = OFF_MOD + 245760;
constexpr size_t OFF_BAR = OFF_SUMSQ + 16384;
constexpr size_t ZERO_BYTES = 245760 + 16384 + 16384;
constexpr size_t OFF_LAMBAR = OFF_BAR + 16384;
constexpr size_t OFF_BBAR = OFF_LAMBAR + 65536;
constexpr size_t OFF_CM = OFF_BBAR + 524288;
constexpr size_t OFF_ROPE = OFF_CM + 524288;
constexpr size_t OFF_S0T = OFF_ROPE + 524288;
constexpr size_t WS_END = OFF_S0T + 2097152;

struct Params {
  const float* in[36];
  float* out;
  char* ws;
};


DEV int TID() { int t = threadIdx.x; asm volatile("" : "+v"(t)); return t; }
DEV int BID() { int t = blockIdx.x; asm volatile("" : "+s"(t)); return t; }
#define GAS __attribute__((address_space(1)))
DEV char* WS(const Params& p) { unsigned long long w = (unsigned long long)p.ws; asm volatile("" : "+s"(w)); return (char*)(GAS char*)w; }
DEV float* OUTP(const Params& p) { unsigned long long w = (unsigned long long)p.out; asm volatile("" : "+s"(w)); return (float*)(GAS float*)w; }
DEV const float* INP(const Params& p, int i) { unsigned long long w = (unsigned long long)p.in[i]; asm volatile("" : "+s"(w)); return (const float*)(GAS const float*)w; }

DEV u16 f2bf(float f) { unsigned u = __float_as_uint(f); u += 0x7fffu + ((u >> 16) & 1u); return (u16)(u >> 16); }
DEV float bf2f(u16 h) { return __uint_as_float(((unsigned)h) << 16); }
DEV float sigm(float x) { return 1.f / (1.f + __expf(-x)); }
DEV float silu_(float x) { return x / (1.f + __expf(-x)); }
DEV float gelu_(float x) { float u = 0.7978845608028654f * (x + 0.044715f * x * x * x); return 0.5f * x * (1.f + tanhf(u)); }
DEV unsigned pack2(float a, float b) { return (unsigned)f2bf(a) | ((unsigned)f2bf(b) << 16); }

DEV const float* xin_row(const Params& p, int row) { return row < 8192 ? INP(p, 0) + (size_t)row * 1024 : INP(p, 1) + (size_t)(row - 8192) * 1024; }
DEV int modidx(int row) { return row < 8192 ? 0 : 1 + ((row - 8192) >> 10); }

template <int MF, int NF>
DEV void gemm_loop(const u16* __restrict__ A, int lda, const u16* __restrict__ B, int ldb, int K, f32x4 (&acc)[MF][NF], u16* sA) {
  const int tid = TID(), lane = tid & 63, wid = tid >> 6, wr = wid >> 1, wc = wid & 1, fr = lane & 15, fq = lane >> 4;
  u16* sB = sA + MF * 32 * 72;
  u32x4 ra[MF], rb[NF];
  const int crow = tid >> 3, ccol = (tid & 7) * 8;
  const u16* Ap = A + (size_t)crow * lda + ccol;
  const u16* Bp = B + (size_t)crow * ldb + ccol;
#pragma unroll
  for (int i = 0; i < MF; i++) ra[i] = *(const u32x4*)(Ap + (size_t)(i * 32) * lda);
#pragma unroll
  for (int i = 0; i < NF; i++) rb[i] = *(const u32x4*)(Bp + (size_t)(i * 32) * ldb);
  for (int k0 = 0; k0 < K; k0 += 64) {
    __syncthreads();
#pragma unroll
    for (int i = 0; i < MF; i++) *(u32x4*)(sA + (crow + i * 32) * 72 + ccol) = ra[i];
#pragma unroll
    for (int i = 0; i < NF; i++) *(u32x4*)(sB + (crow + i * 32) * 72 + ccol) = rb[i];
    __syncthreads();
    if (k0 + 64 < K) {
#pragma unroll
      for (int i = 0; i < MF; i++) ra[i] = *(const u32x4*)(Ap + (size_t)(i * 32) * lda + k0 + 64);
#pragma unroll
      for (int i = 0; i < NF; i++) rb[i] = *(const u32x4*)(Bp + (size_t)(i * 32) * ldb + k0 + 64);
    }
    {
      const u16* sAf = sA + (wr * 16 + fr) * 72 + fq * 8;
      const u16* sBf = sB + (wc * (NF * 16) + fr) * 72 + fq * 8;
      bf16x8 bvA[NF], bvB[NF];
#pragma unroll
      for (int n = 0; n < NF; n++) bvA[n] = *(const bf16x8*)(sBf + n * 16 * 72);
      bf16x8 a_cur = *(const bf16x8*)(sAf);
      bf16x8 a_nxt = *(const bf16x8*)(sAf + 32 * 72);
#pragma unroll
      for (int st = 0; st < 2 * MF; st++) {
        const int ks = st / MF, m = st % MF;
        bf16x8 a_n2 = a_nxt;
        if (st + 2 < 2 * MF) { const int s2 = st + 2; a_n2 = *(const bf16x8*)(sAf + (s2 % MF) * 32 * 72 + (s2 / MF) * 32); }
        if (st == (MF > 3 ? MF - 3 : 0)) {
#pragma unroll
          for (int n = 0; n < NF; n++) bvB[n] = *(const bf16x8*)(sBf + n * 16 * 72 + 32);
        }
        __builtin_amdgcn_sched_barrier(0);
#pragma unroll
        for (int n = 0; n < NF; n++) acc[m][n] = __builtin_amdgcn_mfma_f32_16x16x32_bf16(a_cur, ks == 0 ? bvA[n] : bvB[n], acc[m][n], 0, 0, 0);
        __builtin_amdgcn_sched_barrier(0);
        a_cur = a_nxt; a_nxt = a_n2;
      }
    }
  }
}

template <int MF, int NF>
DEV void zero_acc(f32x4 (&acc)[MF][NF]) {
#pragma unroll
  for (int m = 0; m < MF; m++)
#pragma unroll
    for (int n = 0; n < NF; n++) acc[m][n] = f32x4{0.f, 0.f, 0.f, 0.f};
}

DEV float epi_op(float v, int op) { return op == 1 ? v * 0.08838834764831845f : (op == 2 ? silu_(v) : v); }
template <int MF, int NF, int TS>
DEV void acc_to_lds(const f32x4 (&acc)[MF][NF], u16* T, int m0, int op = 0) {
  const int tid = TID(), lane = tid & 63, wid = tid >> 6, wr = wid >> 1, wc = wid & 1, fr = lane & 15, fq = lane >> 4;
#pragma unroll
  for (int m = 0; m < 4; m++)
#pragma unroll
    for (int n = 0; n < NF; n++)
#pragma unroll
      for (int j = 0; j < 4; j++) T[(m * 32 + wr * 16 + fq * 4 + j) * TS + wc * (NF * 16) + n * 16 + fr] = f2bf(epi_op(acc[m0 + m][n][j], op));
}
template <int MF>
DEV void acc_to_lds_T(const f32x4 (&acc)[MF][4], u16* T, int m0, int op = 0) {
  const int tid = TID(), lane = tid & 63, wid = tid >> 6, wr = wid >> 1, wc = wid & 1, fr = lane & 15, fq = lane >> 4;
#pragma unroll
  for (int m = 0; m < 4; m++)
#pragma unroll
    for (int n = 0; n < 4; n++) {
      u32x2 v; v.x = pack2(epi_op(acc[m0 + m][n][0], op), epi_op(acc[m0 + m][n][1], op)); v.y = pack2(epi_op(acc[m0 + m][n][2], op), epi_op(acc[m0 + m][n][3], op));
      *(u32x2*)(T + (wc * 64 + n * 16 + fr) * 136 + m * 32 + wr * 16 + fq * 4) = v;
    }
}
template <int COLS, int TS>
DEV void copy_tile(const u16* T, u16* dst, int ld) {
  constexpr int CPR = COLS / 8;
  constexpr int NIT = 128 * CPR / 256;
#pragma unroll
  for (int i = 0; i < NIT; i++) {
    int id = TID() + i * 256; int r = id / CPR, ch = id % CPR;
    *(u32x4*)(dst + (size_t)r * ld + ch * 8) = *(const u32x4*)(T + r * TS + ch * 8);
  }
}

DEV void transpose_tile(const float* __restrict__ src, int K, int N, u16* __restrict__ dst, int tile, float* sm, int perm = 0) {
  int nk = K >> 6; int tk = tile % nk, tn = tile / nk; int k0 = tk * 64, n0 = tn * 64;
  int tx = TID() & 63, ty = TID() >> 6;
  __syncthreads();
#pragma unroll
  for (int i = 0; i < 16; i++) { int k = ty + i * 4; sm[k * 65 + tx] = src[(size_t)(k0 + k) * N + n0 + tx]; }
  __syncthreads();
#pragma unroll
  for (int i = 0; i < 16; i++) {
    int n = n0 + ty + i * 4;
    if (perm) { int half = N >> 1; int j = n < half ? n : n - half; n = (j >> 4) * 32 + (n < half ? 0 : 16) + (j & 15); }
    dst[(size_t)n * K + k0 + tx] = f2bf(sm[tx * 65 + (ty + i * 4)]);
  }
}

DEV void wt_task(const Params& p, int l, int t, float* sm) {
  u16* WT = (u16*)(WS(p) + OFF_WT);
  const float* src; int K, N, off, tt, perm = 0;
  if (t < 1792) { src = INP(p, 10) + (size_t)l * 1024 * 7168; K = 1024; N = 7168; off = WIN_O; tt = t; }
  else if (t < 2048) { src = INP(p, 19) + (size_t)l * 512 * 2048; K = 512; N = 2048; off = WGLU_O; tt = t - 1792; }
  else if (t < 2176) { src = INP(p, 21) + (size_t)l * 512 * 1024; K = 512; N = 1024; off = WRETO_O; tt = t - 2048; }
  else if (t < 2304) { src = INP(p, 31) + (size_t)l * 512 * 1024; K = 512; N = 1024; off = WHYO_O; tt = t - 2176; }
  else if (t < 2560) { src = INP(p, 32) + (size_t)l * 1024 * 1024; K = 1024; N = 1024; off = WOUT_O; tt = t - 2304; }
  else if (t < 3968) { src = INP(p, 33) + (size_t)l * 1024 * 5632; K = 1024; N = 5632; off = WFIN_O; tt = t - 2560; perm = 1; }
  else { src = INP(p, 34) + (size_t)l * 2816 * 1024; K = 2816; N = 1024; off = WFOUT_O; tt = t - 3968; }
  transpose_tile(src, K, N, WT + off, tt, sm, perm);
}

DEV void mod_task(const Params& p, int task, float* sm) {
  int cb = task % 96; int l = task / 96;
  int tid = TID(), lane = tid & 63, kq = tid >> 6;
  __syncthreads();
  for (int i = tid; i < 5120; i += 256) {
    int j = i >> 10, k = i & 1023;
    float c = (j == 0) ? INP(p, 5)[k] : INP(p, 4)[(j - 1) * 1024 + k];
    sm[i] = silu_(c);
  }
  __syncthreads();
  int col = cb * 64 + lane;
  const float* w = INP(p, 6) + (size_t)l * 1024 * 6144 + col;
  float a0 = 0, a1 = 0, a2 = 0, a3 = 0, a4 = 0;
#pragma unroll 8
  for (int kk = 0; kk < 256; kk++) {
    int k = kk * 4 + kq;
    float wv = w[(size_t)k * 6144];
    a0 += sm[k] * wv; a1 += sm[1024 + k] * wv; a2 += sm[2048 + k] * wv; a3 += sm[3072 + k] * wv; a4 += sm[4096 + k] * wv;
  }
  float* red = sm + 5120;
  red[(kq * 5 + 0) * 64 + lane] = a0; red[(kq * 5 + 1) * 64 + lane] = a1; red[(kq * 5 + 2) * 64 + lane] = a2;
  red[(kq * 5 + 3) * 64 + lane] = a3; red[(kq * 5 + 4) * 64 + lane] = a4;
  __syncthreads();
  float* MOD = (float*)(WS(p) + OFF_MOD);
  for (int i = tid; i < 320; i += 256) {
    int j = i >> 6, cc = i & 63;
    float v = ((red[(0 * 5 + j) * 64 + cc] + red[(1 * 5 + j) * 64 + cc]) + red[(2 * 5 + j) * 64 + cc]) + red[(3 * 5 + j) * 64 + cc];
    MOD[(l * 5 + j) * 6144 + cb * 64 + cc] = v;
  }
}

DEV void filt_task(const Params& p, int l, int task, float* sm) {
  int Lsel = task >= 32; int tb = Lsel ? task - 32 : task; int L = Lsel ? 1024 : 256; int t0 = tb * 8;
  int tid = TID();
  float* z = sm; float* h1 = sm + 264; float* h2 = sm + 264 + 512;
  const float* w1 = INP(p, 24) + l * 33 * 64; const float* b1 = INP(p, 25) + l * 64;
  const float* w2 = INP(p, 26) + l * 64 * 64; const float* b2 = INP(p, 27) + l * 64;
  const float* fr0 = INP(p, 28) + l * 128; const float* fr1 = fr0 + 64;
  const float* w3 = INP(p, 29) + (size_t)l * 64 * 2048;
  __syncthreads();
  for (int i = tid; i < 264; i += 256) {
    int tt = i / 33, e = i % 33; float t = (float)(t0 + tt); float v;
    if (e == 0) v = t / (float)L;
    else {
      int b = (e - 1) & 15; float band = 1e-4f + (float)b * ((15.f - 1e-4f) / 15.f);
      float ang = (6.283185307179586f / (float)L) * t * band;
      v = (e <= 16) ? cosf(ang) : -sinf(ang);
    }
    z[i] = v;
  }
  __syncthreads();
  for (int i = tid; i < 512; i += 256) {
    int tt = i >> 6, j = i & 63; float s = b1[j];
    for (int e = 0; e < 33; e++) s += z[tt * 33 + e] * w1[e * 64 + j];
    h1[i] = sinf(fr0[j] * s);
  }
  __syncthreads();
  for (int i = tid; i < 512; i += 256) {
    int tt = i >> 6, j = i & 63; float s = b2[j];
    for (int e = 0; e < 64; e++) s += h1[tt * 64 + e] * w2[e * 64 + j];
    h2[i] = sinf(fr1[j] * s);
  }
  __syncthreads();
  float* FB = (float*)(WS(p) + OFF_G) + (Lsel ? 524288 : 0);
  float* SUMSQ = (float*)(WS(p) + WS_END);
  for (int m = 0; m < 8; m++) {
    int col = tid + m * 256;
    float acc[8];
#pragma unroll
    for (int tt = 0; tt < 8; tt++) acc[tt] = 0.f;
    for (int j = 0; j < 64; j++) {
      float w = w3[j * 2048 + col];
#pragma unroll
      for (int tt = 0; tt < 8; tt++) acc[tt] += h2[tt * 64 + j] * w;
    }
    int dir = col >> 10, o = (col >> 9) & 1, c = col & 511;
    float rate = 3.0701134573253944f + (float)c * ((15.350567286626972f - 3.0701134573253944f) / 511.f);
    float ss = 0.f;
    float* Fo = FB + (size_t)o * (2 * L) * 512 + c;
#pragma unroll
    for (int tt = 0; tt < 8; tt++) {
      int t = t0 + tt;
      float val = acc[tt] * expf(-((float)t / (float)L) * rate);
      if (dir == 0) { Fo[(size_t)(L + t) * 512] = val; ss += val * val; }
      else if (t > 0) { Fo[(size_t)(L - t) * 512] = val; ss += val * val; }
      else { Fo[0] = 0.f; }
    }
    SUMSQ[((size_t)l * 160 + task) * 2048 + col] = ss;
  }
}

DEV void s5prep_task(const Params& p, int task) {
  int idx = task * 256 + TID();
  int pp = idx & 63; int lrg = idx >> 6;
  float lre = INP(p, 11)[idx], lim = INP(p, 12)[idx];
  float dt = expf(INP(p, 13)[lrg]);
  float mag = expf(lre * dt);
  float lbr = mag * cosf(lim * dt), lbi = mag * sinf(lim * dt);
  float nr = lbr - 1.f, ni = lbi; float den = lre * lre + lim * lim;
  float cr = (nr * lre + ni * lim) / den, ci = (ni * lre - nr * lim) / den;
  u16* BBAR = (u16*)(WS(p) + OFF_BBAR); u16* CM = (u16*)(WS(p) + OFF_CM); float* LB = (float*)(WS(p) + OFF_LAMBAR);
  LB[idx * 2] = lbr; LB[idx * 2 + 1] = lbi;
  for (int c = 0; c < 16; c++) {
    float br = INP(p, 14)[(size_t)idx * 16 + c], bi = INP(p, 15)[(size_t)idx * 16 + c];
    BBAR[(size_t)lrg * 2048 + pp * 16 + c] = f2bf(cr * br - ci * bi);
    BBAR[(size_t)lrg * 2048 + (64 + pp) * 16 + c] = f2bf(cr * bi + ci * br);
    CM[(size_t)lrg * 2048 + c * 128 + pp] = f2bf(INP(p, 16)[(size_t)lrg * 1024 + c * 64 + pp]);
    CM[(size_t)lrg * 2048 + c * 128 + 64 + pp] = f2bf(-INP(p, 17)[(size_t)lrg * 1024 + c * 64 + pp]);
  }
}

DEV void rope_task(const Params& p, int task) {
  int idx = task * 256 + TID(); int t = idx >> 6, d = idx & 63; int f = d & 31;
  float inv = powf(10000.f, -(float)f / 32.f);
  float pos = (d < 32) ? (float)(t >> 6) : (float)(t & 63);
  float ang = pos * inv;
  float* R = (float*)(WS(p) + OFF_ROPE);
  R[idx * 2] = cosf(ang); R[idx * 2 + 1] = sinf(ang);
}

DEV void layer_prep(const Params& p, int l, char* smem) {
  for (int t = BID(); t < 4672 + 160; t += gridDim.x) {
    if (t < 4672) wt_task(p, l, t, (float*)smem);
    else filt_task(p, l, t - 4672, (float*)smem);
  }
}
DEV void phaseA(const Params& p, char* smem) {
  for (int t = BID(); t < 192 + 32 + 256 + 256; t += gridDim.x) {
    if (t < 192) mod_task(p, t, (float*)smem);
    else if (t < 224) s5prep_task(p, t - 192);
    else if (t < 480) rope_task(p, t - 224);
    else { int tt = t - 480; int mi = tt >> 2; transpose_tile(INP(p, 3) + (size_t)mi * 16384, 128, 128, (u16*)(WS(p) + OFF_S0T) + (size_t)mi * 16384, tt & 3, (float*)smem); }
  }
  layer_prep(p, 0, smem);
}

DEV void norm_phase(const Params& p, int l, int which) {
  const int lane = TID() & 63;
  const int wave = (BID() * blockDim.x + TID()) >> 6, nw = (gridDim.x * blockDim.x) >> 6;
  u16* H = (u16*)(WS(p) + OFF_H);
  const float* MOD = (const float*)(WS(p) + OFF_MOD);
  for (int row = wave; row < MT; row += nw) {
    const float* x = (l == 0 && which == 0) ? xin_row(p, row) : OUTP(p) + (size_t)row * 1024;
    float4 v[4]; float ss = 0.f;
#pragma unroll
    for (int i = 0; i < 4; i++) { v[i] = *(const float4*)(x + i * 256 + lane * 4); ss += v[i].x * v[i].x + v[i].y * v[i].y + v[i].z * v[i].z + v[i].w * v[i].w; }
#pragma unroll
    for (int o = 32; o > 0; o >>= 1) ss += __shfl_xor(ss, o, 64);
    float rinv = rsqrtf(ss * (1.f / 1024.f) + 1e-6f);
    if (which == 2) {
      const float* nf = INP(p, 35);
#pragma unroll
      for (int i = 0; i < 4; i++) {
        float4 g = *(const float4*)(nf + i * 256 + lane * 4);
        float4 o; o.x = v[i].x * rinv * g.x; o.y = v[i].y * rinv * g.y; o.z = v[i].z * rinv * g.z; o.w = v[i].w * rinv * g.w;
        *(float4*)(OUTP(p) + (size_t)row * 1024 + i * 256 + lane * 4) = o;
      }
    } else {
      int j = modidx(row);
      const float* nwt = (which == 0 ? INP(p, 8) : INP(p, 9)) + l * 1024;
      const float* msh = MOD + (l * 5 + j) * 6144 + (which ? 3 : 0) * 1024;
      const float* msc = msh + 1024;
      const float* bsh = INP(p, 7) + l * 6144 + (which ? 3 : 0) * 1024;
      const float* bsc = bsh + 1024;
#pragma unroll
      for (int i = 0; i < 4; i++) {
        int k = i * 256 + lane * 4;
        float4 g = *(const float4*)(nwt + k);
        float4 sh = *(const float4*)(msh + k), sc = *(const float4*)(msc + k);
        float4 bh = *(const float4*)(bsh + k), bc = *(const float4*)(bsc + k);
        float o0 = v[i].x * rinv * g.x * (1.f + sc.x + bc.x) + sh.x + bh.x;
        float o1 = v[i].y * rinv * g.y * (1.f + sc.y + bc.y) + sh.y + bh.y;
        float o2 = v[i].z * rinv * g.z * (1.f + sc.z + bc.z) + sh.z + bh.z;
        float o3 = v[i].w * rinv * g.w * (1.f + sc.w + bc.w) + sh.w + bh.w;
        u32x2 pk; pk.x = pack2(o0, o1); pk.y = pack2(o2, o3);
        *(u32x2*)(H + (size_t)row * 1024 + k) = pk;
      }
    }
  }
}

DEV void phaseC(const Params& p, int l, char* smem) {
  u16* sA = (u16*)smem; u16* T = (u16*)smem;
  const u16* H = (const u16*)(WS(p) + OFF_H);
  const u16* WIN = (const u16*)(WS(p) + OFF_WT) + WIN_O;
  u16* ZA = (u16*)(WS(p) + OFF_ZA); u16* HYT = (u16*)(WS(p) + OFF_HYZ); u16* VT = (u16*)(WS(p) + OFF_VT);
  u16* KT = (u16*)(WS(p) + OFF_KT); u16* QR = (u16*)(WS(p) + OFF_QR);
  const float* ROPE = (const float*)(WS(p) + OFF_ROPE);
  const int tid = TID();
  for (int tile = BID(); tile < 48 * 32; tile += gridDim.x) {
    int tm = tile >> 5, tn = tile & 31;
    if (gridDim.x == 512) {
      const int r = tile >> 9, bb = tile & 511, x = bb & 7, j = bb >> 3;
      tm = r * 16 + (x >> 2) * 8 + (j >> 3); tn = (x & 3) * 8 + (j & 7);
    }
    f32x4 acc[8][4]; zero_acc<8, 4>(acc);
    gemm_loop<8, 4>(H + (size_t)tm * 256 * 1024, 1024, WIN + (size_t)tn * 128 * 1024, 1024, 1024, acc, sA);
    int kind = tn >> 2, hd = tn & 3;
    const int op = kind == 2 ? 1 : (kind == 4 ? 2 : 0);
#pragma unroll
    for (int hh = 0; hh < 2; hh++) {
      int row0 = tm * 256 + hh * 128; bool lat = row0 >= 8192;
      int seq, t0, L;
      if (!lat) { seq = row0 >> 8; t0 = row0 & 255; L = 256; } else { seq = (row0 - 8192) >> 10; t0 = (row0 - 8192) & 1023; L = 1024; }
      __syncthreads();
      if (kind == 3 || kind >= 5) {
        acc_to_lds_T<8>(acc, T, hh * 4, 0);
        __syncthreads();
        u16* dst;
        if (kind == 3) dst = lat ? VT + (size_t)8192 * 512 + (size_t)((seq * 4 + hd) * 128) * 1024 + t0 : VT + (size_t)((seq * 4 + hd) * 128) * 256 + t0;
        else dst = lat ? HYT + (size_t)8192 * 1536 + ((size_t)seq * 1536 + (tn - 20) * 128) * 1024 + t0 : HYT + ((size_t)seq * 1536 + (tn - 20) * 128) * 256 + t0;
        copy_tile<128, 136>(T, dst, L);
      } else {
        acc_to_lds<8, 4, 136>(acc, T, hh * 4, op);
        __syncthreads();
        bool roped = lat && (kind == 1 || kind == 2);
        if (!(lat && kind == 2)) {
          u16* dst;
          if (kind == 0) dst = ZA + (size_t)row0 * 2048 + hd * 128;
          else if (kind == 1) dst = ZA + (size_t)row0 * 2048 + 512 + hd * 128;
          else if (kind == 2) dst = ZA + (size_t)row0 * 2048 + 1024 + hd * 128;
          else dst = ZA + (size_t)row0 * 2048 + 1536 + hd * 128;
          copy_tile<128, 136>(T, dst, 2048);
        }
        if (roped) {
          u16* dst; int ld;
          if (kind == 1) { dst = QR + (size_t)(row0 - 8192) * 512 + hd * 128; ld = 512; }
          else { dst = ZA + (size_t)row0 * 2048 + 1024 + hd * 128; ld = 2048; }
#pragma unroll 1
          for (int i = 0; i < 4; i++) {
            int id = tid + i * 256; int r = id >> 3, ch = id & 7;
            u32x4 a = *(const u32x4*)(T + r * 136 + ch * 8);
            u32x4 b = *(const u32x4*)(T + r * 136 + 64 + ch * 8);
            const float4* cs = (const float4*)(ROPE + ((size_t)(t0 + r) * 64 + ch * 8) * 2);
            u32x4 o1, o2;
#pragma unroll
            for (int q = 0; q < 4; q++) {
              float4 c4 = cs[q];
              float x1a = __uint_as_float(a[q] << 16), x1b = __uint_as_float(a[q] & 0xffff0000u);
              float x2a = __uint_as_float(b[q] << 16), x2b = __uint_as_float(b[q] & 0xffff0000u);
              o1[q] = pack2(x1a * c4.x - x2a * c4.y, x1b * c4.z - x2b * c4.w);
              o2[q] = pack2(x1a * c4.y + x2a * c4.x, x1b * c4.w + x2b * c4.z);
            }
            *(u32x4*)(dst + (size_t)r * ld + ch * 8) = o1;
            *(u32x4*)(dst + (size_t)r * ld + 64 + ch * 8) = o2;
          }
        }
        if (kind == 2 && !lat) {
          __syncthreads();
          acc_to_lds_T<8>(acc, T, hh * 4, op);
          __syncthreads();
          copy_tile<128, 136>(T, KT + (size_t)((seq * 4 + hd) * 128) * 256 + t0, 256);
        }
      }
    }
  }
}

DEV void s5_task(const Params& p, int l, int task, char* smem) {
  const int tid = TID(), lane = tid & 63, wid = tid >> 6, fr = lane & 15, fq = lane >> 4;
  int seq, gp;
  if (task < 64) { seq = 32 + (task >> 4); gp = task & 15; } else { int t2 = task - 64; seq = t2 >> 4; gp = t2 & 15; }
  const bool lat = seq >= 32;
  const int L = lat ? 1024 : 256;
  const int row0 = lat ? 8192 + (seq - 32) * 1024 : seq * 256;
  const int grp = gp * 2 + (wid >> 1), dir = wid & 1;
  const int lrg = (l * 2 + dir) * 32 + grp;
  float* BU = (float*)(smem + wid * 12544);
  u16* HB = (u16*)(smem + wid * 12544 + 8192);
  u16* ZA = (u16*)(WS(p) + OFF_ZA);
  float* YP = (float*)(WS(p) + OFF_YP);
  const u16* BBAR = (const u16*)(WS(p) + OFF_BBAR) + (size_t)lrg * 2048;
  const u16* CM = (const u16*)(WS(p) + OFF_CM) + (size_t)lrg * 2048;
  const float* LB = (const float*)(WS(p) + OFF_LAMBAR) + ((size_t)lrg * 64 + lane) * 2;
  const float lr = LB[0], li = LB[1];
  bf16x8 bfrag[8], cfrag[4];
  const bf16x8 zero8 = {0, 0, 0, 0, 0, 0, 0, 0};
#pragma unroll
  for (int nt = 0; nt < 8; nt++) bfrag[nt] = (fq < 2) ? *(const bf16x8*)(BBAR + (nt * 16 + fr) * 16 + fq * 8) : zero8;
#pragma unroll
  for (int ks = 0; ks < 4; ks++) cfrag[ks] = *(const bf16x8*)(CM + fr * 128 + ks * 32 + fq * 8);
  float hr = 0.f, hi = 0.f;
  if (lat) {
    const float* s0 = INP(p, 2) + ((((size_t)(seq - 32) * 2 + l) * 2 + dir) * 32 + grp) * 128 + lane * 2;
    hr = s0[0]; hi = s0[1];
  }
  const float dcoef = INP(p, 18)[l * 512 + grp * 16 + fr];
  const int nch = L >> 4;
  __syncthreads();
  const int half = nch >> 1;
  bf16x8 ua_next = (fq < 2) ? *(const bf16x8*)(ZA + (size_t)(row0 + (dir ? nch - 1 : 0) * 16 + fr) * 2048 + grp * 16 + fq * 8) : zero8;
  const int tbase = dir ? 15 : 0, tstep = dir ? -1 : 1;
  for (int i = 0; i < nch; i++) {
    const int ci = dir ? nch - 1 - i : i; const int t0 = ci * 16;
    if (i == half) { asm volatile("s_waitcnt vmcnt(0)" ::: "memory"); __threadfence(); asm volatile("s_waitcnt vmcnt(0)" ::: "memory"); __syncthreads(); }
    const bf16x8 ua = ua_next;
    if (i + 1 < nch) {
      const int cn = dir ? nch - 2 - i : i + 1;
      ua_next = (fq < 2) ? *(const bf16x8*)(ZA + (size_t)(row0 + cn * 16 + fr) * 2048 + grp * 16 + fq * 8) : zero8;
    }
    float oth[4] = {0.f, 0.f, 0.f, 0.f}, uu[4] = {0.f, 0.f, 0.f, 0.f};
    if (i >= half) {
#pragma unroll
      for (int j = 0; j < 4; j++) {
        size_t row = (size_t)(row0 + t0 + fq * 4 + j);
        oth[j] = YP[row * 512 + grp * 16 + fr];
        uu[j] = bf2f(ZA[row * 2048 + grp * 16 + fr]);
      }
    }
#pragma unroll
    for (int nt = 0; nt < 8; nt++) {
      f32x4 r = __builtin_amdgcn_mfma_f32_16x16x32_bf16(ua, bfrag[nt], f32x4{0.f, 0.f, 0.f, 0.f}, 0, 0, 0);
#pragma unroll
      for (int j = 0; j < 4; j++) BU[(fq * 4 + j) * 128 + nt * 16 + fr] = r[j];
    }
    asm volatile("s_waitcnt lgkmcnt(0)" ::: "memory");
#pragma unroll
    for (int tt = 0; tt < 16; tt++) {
      const int t = tbase + tstep * tt;
      float re = BU[t * 128 + lane], im = BU[t * 128 + 64 + lane];
      float nr = lr * hr - li * hi + re; float ni = lr * hi + li * hr + im;
      hr = nr; hi = ni;
      HB[t * 136 + lane] = f2bf(hr); HB[t * 136 + 64 + lane] = f2bf(hi);
    }
    asm volatile("s_waitcnt lgkmcnt(0)" ::: "memory");
    f32x4 y = {0.f, 0.f, 0.f, 0.f};
#pragma unroll
    for (int ks = 0; ks < 4; ks++) {
      bf16x8 a = *(const bf16x8*)(HB + fr * 136 + ks * 32 + fq * 8);
      y = __builtin_amdgcn_mfma_f32_16x16x32_bf16(a, cfrag[ks], y, 0, 0, 0);
    }
    asm volatile("s_waitcnt lgkmcnt(0)" ::: "memory");
    if (i < half) {
#pragma unroll
      for (int j = 0; j < 4; j++) YP[(size_t)(row0 + t0 + fq * 4 + j) * 512 + grp * 16 + fr] = y[j];
    } else {
#pragma unroll
      for (int j = 0; j < 4; j++) {
        size_t row = (size_t)(row0 + t0 + fq * 4 + j);
        float v = y[j] + oth[j] + dcoef * uu[j];
        ZA[row * 2048 + grp * 16 + fr] = f2bf(gelu_(v));
      }
    }
  }
  if (!lat) {
    float* o = OUTP(p) + 12582912 + ((((size_t)seq * 2 + l) * 2 + dir) * 32 + grp) * 128 + lane * 2;
    o[0] = hr; o[1] = hi;
  }
}

DEV void ret_task(const Params& p, int l, int task, char* smem) {
  const int tid = TID(), lane = tid & 63, wid = tid >> 6, fr = lane & 15, fq = lane >> 4;
  int seq, h, qt; bool lat;
  if (task < 256) { lat = true; seq = task >> 6; h = (task >> 4) & 3; qt = task & 15; }
  else { int t2 = task - 256; lat = false; seq = t2 >> 4; h = (t2 >> 2) & 3; qt = t2 & 3; }
  const int L = lat ? 1024 : 256;
  const int row0 = lat ? 8192 + seq * 1024 : seq * 256;
  u16* sK = (u16*)smem; u16* sV = sK + 64 * 136; u16* sP = sV + 128 * 72 + wid * 16 * 72;
  u16* ZA = (u16*)(WS(p) + OFF_ZA);
  const u16* QR = (const u16*)(WS(p) + OFF_QR);
  const u16* VT = (const u16*)(WS(p) + OFF_VT);
  const float lgf = log1pf(-expf(INP(p, 20)[(l * 2 + 0) * 4 + h])), lgb = log1pf(-expf(INP(p, 20)[(l * 2 + 1) * 4 + h]));
  const int qrow = qt * 64 + wid * 16;
  const u16* qsrc = lat ? QR + (size_t)(row0 - 8192 + qrow + fr) * 512 + h * 128 : ZA + (size_t)(row0 + qrow + fr) * 2048 + 512 + h * 128;
  bf16x8 qa[4];
#pragma unroll
  for (int ks = 0; ks < 4; ks++) qa[ks] = *(const bf16x8*)(qsrc + ks * 32 + fq * 8);
  f32x4 o[8];
#pragma unroll
  for (int n = 0; n < 8; n++) o[n] = f32x4{0.f, 0.f, 0.f, 0.f};
  const u16* Kbase = ZA + (size_t)row0 * 2048 + 1024 + h * 128;
  const u16* Vbase = lat ? VT + (size_t)8192 * 512 + (size_t)((seq * 4 + h) * 128) * 1024 : VT + (size_t)((seq * 4 + h) * 128) * 256;
  const int nkt = L >> 6;
  u32x4 kreg[4], vreg[4];
  const int kr = tid >> 4, kc = (tid & 15) * 8;
  const int ve = tid >> 3, vc = (tid & 7) * 8;
#pragma unroll
  for (int i = 0; i < 4; i++) {
    kreg[i] = *(const u32x4*)(Kbase + (size_t)(kr + 16 * i) * 2048 + kc);
    vreg[i] = *(const u32x4*)(Vbase + (size_t)(ve + 32 * i) * L + vc);
  }
  for (int jt = 0; jt < nkt; jt++) {
    __syncthreads();
#pragma unroll
    for (int i = 0; i < 4; i++) {
      *(u32x4*)(sK + (kr + 16 * i) * 136 + kc) = kreg[i];
      *(u32x4*)(sV + (ve + 32 * i) * 72 + vc) = vreg[i];
    }
    __syncthreads();
    if (jt + 1 < nkt) {
#pragma unroll
      for (int i = 0; i < 4; i++) {
        kreg[i] = *(const u32x4*)(Kbase + (size_t)((jt + 1) * 64 + kr + 16 * i) * 2048 + kc);
        vreg[i] = *(const u32x4*)(Vbase + (size_t)(ve + 32 * i) * L + (jt + 1) * 64 + vc);
      }
    }
    f32x4 s[4];
#pragma unroll
    for (int nt = 0; nt < 4; nt++) s[nt] = f32x4{0.f, 0.f, 0.f, 0.f};
    {
      const u16* kp = sK + fr * 136 + fq * 8;
      bf16x8 b_cur = *(const bf16x8*)(kp);
      bf16x8 b_nxt = *(const bf16x8*)(kp + 32);
#pragma unroll
      for (int i = 0; i < 16; i++) {
        bf16x8 b_n2 = b_nxt;
        if (i + 2 < 16) b_n2 = *(const bf16x8*)(kp + ((i + 2) >> 2) * 16 * 136 + ((i + 2) & 3) * 32);
        __builtin_amdgcn_sched_barrier(0);
        s[i >> 2] = __builtin_amdgcn_mfma_f32_16x16x32_bf16(qa[i & 3], b_cur, s[i >> 2], 0, 0, 0);
        __builtin_amdgcn_sched_barrier(0);
        b_cur = b_nxt; b_nxt = b_n2;
      }
    }
#pragma unroll
    for (int nt = 0; nt < 4; nt++)
#pragma unroll
      for (int j = 0; j < 4; j++) {
        int d = (qrow + fq * 4 + j) - (jt * 64 + nt * 16 + fr);
        float w = d >= 0 ? __expf(lgf * (float)d) : __expf(lgb * (float)(-d));
        sP[(fq * 4 + j) * 72 + nt * 16 + fr] = f2bf(s[nt][j] * w);
      }
    asm volatile("s_waitcnt lgkmcnt(0)" ::: "memory");
    {
      bf16x8 pa[2];
      pa[0] = *(const bf16x8*)(sP + fr * 72 + fq * 8);
      pa[1] = *(const bf16x8*)(sP + fr * 72 + 32 + fq * 8);
      const u16* vp = sV + fr * 72 + fq * 8;
      bf16x8 b_cur = *(const bf16x8*)(vp);
      bf16x8 b_nxt = *(const bf16x8*)(vp + 16 * 72);
#pragma unroll
      for (int i = 0; i < 16; i++) {
        bf16x8 b_n2 = b_nxt;
        if (i + 2 < 16) b_n2 = *(const bf16x8*)(vp + ((i + 2) & 7) * 16 * 72 + ((i + 2) >> 3) * 32);
        __builtin_amdgcn_sched_barrier(0);
        o[i & 7] = __builtin_amdgcn_mfma_f32_16x16x32_bf16(pa[i >> 3], b_cur, o[i & 7], 0, 0, 0);
        __builtin_amdgcn_sched_barrier(0);
        b_cur = b_nxt; b_nxt = b_n2;
      }
    }
    asm volatile("s_waitcnt lgkmcnt(0)" ::: "memory");
  }
  if (lat) {
    const u16* q0src = ZA + (size_t)(row0 + qrow + fr) * 2048 + 512 + h * 128;
    bf16x8 q0[4];
#pragma unroll
    for (int ks = 0; ks < 4; ks++) q0[ks] = *(const bf16x8*)(q0src + ks * 32 + fq * 8);
#pragma unroll 1
    for (int dir = 0; dir < 2; dir++) {
      const u16* S0 = (const u16*)(WS(p) + OFF_S0T) + (size_t)((((seq * 2 + l) * 2 + dir) * 4 + h)) * 16384;
      u16* sS = sK;
      __syncthreads();
#pragma unroll
      for (int i = 0; i < 8; i++) {
        int id = tid + i * 256; int e = id >> 4, ch = id & 15;
        *(u32x4*)(sS + e * 136 + ch * 8) = *(const u32x4*)(S0 + (size_t)e * 128 + ch * 8);
      }
      __syncthreads();
      float wj[4];
#pragma unroll
      for (int j = 0; j < 4; j++) { int gi = qrow + fq * 4 + j; wj[j] = dir == 0 ? __expf(lgf * (float)(gi + 1)) : __expf(lgb * (float)(L - 1 - gi)); }
#pragma unroll
      for (int n2 = 0; n2 < 8; n2++) {
        f32x4 tmp = {0.f, 0.f, 0.f, 0.f};
#pragma unroll
        for (int ks = 0; ks < 4; ks++) {
          bf16x8 b = *(const bf16x8*)(sS + (n2 * 16 + fr) * 136 + ks * 32 + fq * 8);
          tmp = __builtin_amdgcn_mfma_f32_16x16x32_bf16(q0[ks], b, tmp, 0, 0, 0);
        }
#pragma unroll
        for (int j = 0; j < 4; j++) o[n2][j] += wj[j] * tmp[j];
      }
    }
  }
#pragma unroll
  for (int j = 0; j < 4; j++) {
    float s = 0.f;
#pragma unroll
    for (int n2 = 0; n2 < 8; n2++) s += o[n2][j];
    s += __shfl_xor(s, 1, 64); s += __shfl_xor(s, 2, 64); s += __shfl_xor(s, 4, 64); s += __shfl_xor(s, 8, 64);
    float mean = s * (1.f / 128.f);
    float v = 0.f;
#pragma unroll
    for (int n2 = 0; n2 < 8; n2++) { float dd = o[n2][j] - mean; v += dd * dd; }
    v += __shfl_xor(v, 1, 64); v += __shfl_xor(v, 2, 64); v += __shfl_xor(v, 4, 64); v += __shfl_xor(v, 8, 64);
    float rstd = rsqrtf(v * (1.f / 128.f) + 1e-5f);
    size_t rbase = (size_t)(row0 + qrow + fq * 4 + j) * 2048;
#pragma unroll
    for (int n2 = 0; n2 < 8; n2++) {
      int e = n2 * 16 + fr;
      float gv = bf2f(ZA[rbase + 1536 + h * 128 + e]);
      ZA[rbase + 512 + h * 128 + e] = f2bf((o[n2][j] - mean) * rstd * gv);
    }
  }
}

DEV bf16x8 scale8(u32x4 raw, const float (&w)[8]) {
  union { u32x4 u; bf16x8 v; } r;
#pragma unroll
  for (int q = 0; q < 4; q++) {
    float a = __uint_as_float(raw[q] << 16) * w[q * 2], b = __uint_as_float(raw[q] & 0xffff0000u) * w[q * 2 + 1];
    r.u[q] = pack2(a, b);
  }
  return r.v;
}

DEV void retstate_task(const Params& p, int l, int task) {
  const int tid = TID(), lane = tid & 63, wid = tid >> 6, fr = lane & 15, fq = lane >> 4;
  int seq = task >> 3, h = (task >> 1) & 3, dir = task & 1;
  const u16* KT = (const u16*)(WS(p) + OFF_KT) + (size_t)((seq * 4 + h) * 128) * 256;
  const u16* VT = (const u16*)(WS(p) + OFF_VT) + (size_t)((seq * 4 + h) * 128) * 256;
  const float lg = log1pf(-expf(INP(p, 20)[(l * 2 + dir) * 4 + h]));
  f32x4 acc[2][8];
#pragma unroll
  for (int m = 0; m < 2; m++)
#pragma unroll
    for (int n = 0; n < 8; n++) acc[m][n] = f32x4{0.f, 0.f, 0.f, 0.f};
#pragma unroll 1
  for (int ks = 0; ks < 8; ks++) {
    float w[8];
#pragma unroll
    for (int jj = 0; jj < 8; jj++) { int j = ks * 32 + fq * 8 + jj; w[jj] = __expf(lg * (float)(dir == 0 ? 255 - j : j)); }
    bf16x8 a[2];
#pragma unroll
    for (int m = 0; m < 2; m++) a[m] = scale8(*(const u32x4*)(KT + (size_t)(wid * 32 + m * 16 + fr) * 256 + ks * 32 + fq * 8), w);
#pragma unroll
    for (int n = 0; n < 8; n++) {
      bf16x8 b = *(const bf16x8*)(VT + (size_t)(n * 16 + fr) * 256 + ks * 32 + fq * 8);
#pragma unroll
      for (int m = 0; m < 2; m++) acc[m][n] = __builtin_amdgcn_mfma_f32_16x16x32_bf16(a[m], b, acc[m][n], 0, 0, 0);
    }
  }
  float* o = OUTP(p) + 13107200 + ((((size_t)seq * 2 + l) * 2 + dir) * 4 + h) * 16384;
#pragma unroll
  for (int m = 0; m < 2; m++)
#pragma unroll
    for (int n = 0; n < 8; n++)
#pragma unroll
      for (int j = 0; j < 4; j++) o[(size_t)(wid * 32 + m * 16 + fq * 4 + j) * 128 + n * 16 + fr] = acc[m][n][j];
}

template <bool LAT>
DEV void hyena_mfma(const Params& p, int l, int task, char* smem) {
  constexpr int L = LAT ? 1024 : 256;
  constexpr int NV = LAT ? 4 : 16;
  constexpr int RS = L + 8, CS = 2 * L + 16;
  constexpr int MPW = L / 64, NKS = L / 32, NCH = L / 8, Lsel = LAT ? 1 : 0;
  const int tid = TID(), lane = tid & 63, wid = tid >> 6, fr = lane & 15, fq = lane >> 4;
  const int c = LAT ? task : (task >> 1);
  const int sg = LAT ? 0 : (task & 1);
  u16* CP = (u16*)smem; u16* XV = CP + 8 * CS; u16* GS = XV + NV * RS; u16* O1 = GS + NV * RS;
  const u16* HYT = (const u16*)(WS(p) + OFF_HYZ);
  u16* HYOT = (u16*)(WS(p) + OFF_OUT1) + (size_t)MT * 512;
  const float* cw = INP(p, 22) + (size_t)l * 3 * 1536; const float* cb = INP(p, 23) + l * 1536;
  auto sconv = [&](int arr, u16* dstA) {
    const int ch = arr * 512 + c;
    const float w0 = cw[ch], w1 = cw[1536 + ch], w2 = cw[3072 + ch], bb = cb[ch];
#pragma unroll
    for (int i = 0; i < (NV * NCH) / 256; i++) {
      int id = tid + i * 256; int n = id / NCH, t8 = (id % NCH) * 8;
      const u16* src = LAT ? HYT + (size_t)8192 * 1536 + ((size_t)n * 1536 + ch) * 1024 + t8 : HYT + ((size_t)(sg * 16 + n) * 1536 + ch) * 256 + t8;
      u32x4 raw = *(const u32x4*)src;
      float h[10];
      h[0] = t8 > 0 ? bf2f(src[-1]) : 0.f;
      h[9] = t8 + 8 < L ? bf2f(src[8]) : 0.f;
#pragma unroll
      for (int q = 0; q < 4; q++) { h[1 + 2 * q] = __uint_as_float(raw[q] << 16); h[2 + 2 * q] = __uint_as_float(raw[q] & 0xffff0000u); }
      u32x4 o;
#pragma unroll
      for (int q = 0; q < 4; q++) o[q] = pack2(w0 * h[2 * q] + w1 * h[2 * q + 1] + w2 * h[2 * q + 2] + bb, w0 * h[2 * q + 1] + w1 * h[2 * q + 2] + w2 * h[2 * q + 3] + bb);
      *(u32x4*)(dstA + n * RS + t8) = o;
    }
  };
  __syncthreads();
  sconv(0, GS);
  sconv(2, XV);
  const int rr = (-fr) & 7;
  const u16* cpl = CP + rr * CS + (L + 8 * fq - fr - rr);
#pragma unroll 1
  for (int o = 0; o < 2; o++) {
    if (o == 1) sconv(1, GS);
    u16* FL = o == 0 ? O1 : XV;
    const float* Gp = (const float*)(WS(p) + OFF_G) + (Lsel ? 524288 : 0) + (size_t)o * (2 * L) * 512 + c;
    if (tid < 2 * L / 8) {
      float f[8];
#pragma unroll
      for (int j = 0; j < 8; j++) { int u = tid * 8 + j; f[j] = u > 0 ? Gp[(size_t)(2 * L - u) * 512] : 0.f; }
      u32x4 v; v[0] = pack2(f[0], f[1]); v[1] = pack2(f[2], f[3]); v[2] = pack2(f[4], f[5]); v[3] = pack2(f[6], f[7]);
      *(u32x4*)(FL + tid * 8) = v;
    }
    if (tid < 2) *(u32x4*)(FL + 2 * L + tid * 8) = u32x4{0u, 0u, 0u, 0u};
    __syncthreads();
    if (tid < 2 * L / 8) {
      u32x4 a = *(const u32x4*)(FL + tid * 8), b = *(const u32x4*)(FL + tid * 8 + 8);
      unsigned d[8] = {a[0], a[1], a[2], a[3], b[0], b[1], b[2], b[3]};
#pragma unroll
      for (int r = 0; r < 8; r++) {
        u32x4 ov;
#pragma unroll
        for (int q = 0; q < 4; q++) ov[q] = (r & 1) ? ((d[q + (r >> 1)] >> 16) | (d[q + (r >> 1) + 1] << 16)) : d[q + (r >> 1)];
        *(u32x4*)(CP + r * CS + tid * 8) = ov;
      }
    }
    __syncthreads();
    float rn;
    {
      constexpr int NTB = LAT ? 128 : 32;
      const float* SP = (const float*)(WS(p) + WS_END) + ((size_t)l * 160 + (LAT ? 32 : 0)) * 2048 + o * 512 + c;
      float ssum = 0.f;
      for (int tb = lane; tb < NTB; tb += 64) ssum += SP[(size_t)tb * 2048] + SP[(size_t)tb * 2048 + 1024];
#pragma unroll
      for (int off = 32; off > 0; off >>= 1) ssum += __shfl_xor(ssum, off, 64);
      rn = rsqrtf(ssum + 1e-6f);
    }
    const float bias = INP(p, 30)[(l * 2 + o) * 512 + c];
    const u16* Xs = o == 0 ? XV : O1;
    f32x4 acc[MPW];
#pragma unroll
    for (int mi = 0; mi < MPW; mi++) acc[mi] = f32x4{0.f, 0.f, 0.f, 0.f};
    const bf16x8 zero8 = {0, 0, 0, 0, 0, 0, 0, 0};
    {
      bf16x8 b_next = (fr < NV) ? *(const bf16x8*)(Xs + fr * RS + fq * 8) : zero8;
#pragma unroll 1
      for (int ks = 0; ks < NKS; ks++) {
        const bf16x8 b = b_next;
        const u16* ap = cpl - 16 * (wid * MPW) + 32 * ks;
        bf16x8 a_cur = *(const bf16x8*)(ap);
        bf16x8 a_nxt = *(const bf16x8*)(ap - 16);
        if (ks + 1 < NKS) b_next = (fr < NV) ? *(const bf16x8*)(Xs + fr * RS + (ks + 1) * 32 + fq * 8) : zero8;
#pragma unroll
        for (int mi = 0; mi < MPW; mi++) {
          bf16x8 a_n2 = a_nxt;
          if (mi + 2 < MPW) a_n2 = *(const bf16x8*)(ap - 16 * (mi + 2));
          __builtin_amdgcn_sched_barrier(0);
          acc[mi] = __builtin_amdgcn_mfma_f32_16x16x32_bf16(a_cur, b, acc[mi], 0, 0, 0);
          __builtin_amdgcn_sched_barrier(0);
          a_cur = a_nxt; a_nxt = a_n2;
        }
      }
    }
    if (fr < NV) {
      const u16* gate = GS;
      const u16* vin = o == 0 ? XV : O1;
#pragma unroll
      for (int mi = 0; mi < MPW; mi++) {
        const int t0 = (wid * MPW + mi) * 16 + fq * 4;
        u32x2 gq = *(const u32x2*)(gate + fr * RS + t0), vq = *(const u32x2*)(vin + fr * RS + t0);
        float g4[4] = {__uint_as_float(gq[0] << 16), __uint_as_float(gq[0] & 0xffff0000u), __uint_as_float(gq[1] << 16), __uint_as_float(gq[1] & 0xffff0000u)};
        float v4[4] = {__uint_as_float(vq[0] << 16), __uint_as_float(vq[0] & 0xffff0000u), __uint_as_float(vq[1] << 16), __uint_as_float(vq[1] & 0xffff0000u)};
        float r4[4];
#pragma unroll
        for (int j = 0; j < 4; j++) r4[j] = g4[j] * (acc[mi][j] * rn + bias * v4[j]);
        if (o == 0) {
          u32x2 ov; ov[0] = pack2(r4[0], r4[1]); ov[1] = pack2(r4[2], r4[3]);
          *(u32x2*)(O1 + fr * RS + t0) = ov;
        } else {
          u16* dst = LAT ? HYOT + (size_t)8192 * 512 + ((size_t)fr * 512 + c) * 1024 + t0 : HYOT + ((size_t)(sg * 16 + fr) * 512 + c) * 256 + t0;
          u32x2 ov; ov[0] = pack2(r4[0], r4[1]); ov[1] = pack2(r4[2], r4[3]);
          *(u32x2*)dst = ov;
        }
      }
    }
    __syncthreads();
  }
}

DEV void phaseD(const Params& p, int l, char* smem) {
  const int nbt = gridDim.x, bt = BID();
  __shared__ int s_task;
  unsigned* ctr = (unsigned*)(WS(p) + OFF_BAR) + 3600 + l * 8;
  if (nbt >= 128 && bt < 64) {
    s5_task(p, l, bt, smem);
    return;
  }
  const int s5lo = nbt >= 128 ? 64 : 0;
#define PULL(pool, limit, body) for (;;) { __syncthreads(); if (threadIdx.x == 0) s_task = (int)atomicAdd(&ctr[pool], 1u); __syncthreads(); \
                                           const int t = s_task; if (t >= (limit)) break; body; }
  PULL(0, 768, ret_task(p, l, t, smem))
  PULL(1, 512, hyena_mfma<true>(p, l, t, smem))
  PULL(2, 576 - s5lo, s5_task(p, l, s5lo + t, smem))
  PULL(3, 1024, hyena_mfma<false>(p, l, t, smem))
  PULL(4, 256, retstate_task(p, l, t))
#undef PULL
}

DEV void phaseE(const Params& p, char* smem) {
  const u16* HYOT = (const u16*)(WS(p) + OFF_OUT1) + (size_t)MT * 512;
  u16* HYO = (u16*)(WS(p) + OFF_OUT1);
  u16* sm = (u16*)smem;
  const int tx = TID() & 63, ty = TID() >> 6;
  for (int tile = BID(); tile < 192 * 8; tile += gridDim.x) {
    int rt = tile >> 3, c0 = (tile & 7) * 64; int row0 = rt * 64;
    const u16* src = row0 < 8192 ? HYOT + ((size_t)(row0 >> 8) * 512 + c0) * 256 + (row0 & 255)
                                 : HYOT + (size_t)8192 * 512 + ((size_t)((row0 - 8192) >> 10) * 512 + c0) * 1024 + ((row0 - 8192) & 1023);
    const int L = row0 < 8192 ? 256 : 1024;
    __syncthreads();
#pragma unroll
    for (int i = 0; i < 16; i++) { int cc = ty + i * 4; sm[cc * 66 + tx] = src[(size_t)cc * L + tx]; }
    __syncthreads();
#pragma unroll
    for (int i = 0; i < 16; i++) { int tt = ty + i * 4; HYO[(size_t)(row0 + tt) * 512 + c0 + tx] = sm[tx * 66 + tt]; }
  }
}

DEV void phaseF(const Params& p, int l, char* smem) {
  u16* sA = (u16*)smem; u16* T = (u16*)smem;
  const u16* H = (const u16*)(WS(p) + OFF_H);
  const u16* WT = (const u16*)(WS(p) + OFF_WT);
  const u16* ZA = (const u16*)(WS(p) + OFF_ZA); const u16* HYO = (const u16*)(WS(p) + OFF_OUT1);
  u16* MG = (u16*)(WS(p) + OFF_YP);
  for (int tile = BID(); tile < 96 * 16; tile += gridDim.x) {
    int tm = tile >> 4, tn = tile & 15;
    if (gridDim.x == 512) {
      const int r = tile >> 9, bb = tile & 511, x = bb & 7, j = bb >> 3;
      tm = r * 32 + (x >> 1) * 8 + (j >> 3); tn = (x & 1) * 8 + (j & 7);
    }
    int row0 = tm * 128, n0 = tn * 64;
    f32x4 a1[4][2], a2[4][2], tt[4][2];
    const u16* Hrow = H + (size_t)row0 * 1024;
    zero_acc<4, 2>(a1); zero_acc<4, 2>(tt);
#pragma unroll 1
    for (int ps = 0; ps < 7; ps++) {
      const u16* Ap; const u16* Bp; int lda, K;
      switch (ps) {
        case 0: Ap = ZA + (size_t)row0 * 2048; lda = 2048; Bp = WT + WGLU_O + (size_t)n0 * 512; K = 512; break;
        case 1: Ap = ZA + (size_t)row0 * 2048; lda = 2048; Bp = WT + WGLU_O + (size_t)(1024 + n0) * 512; K = 512; break;
        case 3: Ap = ZA + (size_t)row0 * 2048 + 512; lda = 2048; Bp = WT + WRETO_O + (size_t)n0 * 512; K = 512; break;
        case 5: Ap = HYO + (size_t)row0 * 512; lda = 512; Bp = WT + WHYO_O + (size_t)n0 * 512; K = 512; break;
        default: Ap = Hrow; lda = 1024; Bp = WT + WIN_O + (size_t)(4096 + ((ps - 2) >> 1) * 1024 + n0) * 1024; K = 1024; break;
      }
      zero_acc<4, 2>(a2);
      gemm_loop<4, 2>(Ap, lda, Bp, K, K, a2, sA);
      if (ps == 0 || ps == 3 || ps == 5) {
#pragma unroll
        for (int m = 0; m < 4; m++)
#pragma unroll
          for (int n = 0; n < 2; n++) a1[m][n] = a2[m][n];
      } else if (ps == 1) {
#pragma unroll
        for (int m = 0; m < 4; m++)
#pragma unroll
          for (int n = 0; n < 2; n++)
#pragma unroll
            for (int j = 0; j < 4; j++) a1[m][n][j] *= sigm(a2[m][n][j]);
      } else {
#pragma unroll
        for (int m = 0; m < 4; m++)
#pragma unroll
          for (int n = 0; n < 2; n++)
#pragma unroll
            for (int j = 0; j < 4; j++) tt[m][n][j] += a1[m][n][j] * sigm(a2[m][n][j]);
      }
    }
    __syncthreads();
    acc_to_lds<4, 2, 72>(tt, T, 0);
    __syncthreads();
    copy_tile<64, 72>(T, MG + (size_t)row0 * 1024 + n0, 1024);
  }
}

template <int MF, int NF>
DEV void resid_store(const Params& p, const f32x4 (&acc)[MF][NF], int l, int chunk, int row0, int col0, bool from_input) {
  const int tid = TID(), lane = tid & 63, wid = tid >> 6, wr = wid >> 1, wc = wid & 1, fr = lane & 15, fq = lane >> 4;
  float* out = OUTP(p);
#pragma unroll
  for (int m = 0; m < MF; m++) {
    const int rb = row0 + m * 32 + wr * 16 + fq * 4;
    const int j = modidx(rb);
    const float* MOD = (const float*)(WS(p) + OFF_MOD) + (l * 5 + j) * 6144 + chunk * 1024;
    const float* BM = INP(p, 7) + l * 6144 + chunk * 1024;
#pragma unroll
    for (int n = 0; n < NF; n++) {
      int col = col0 + wc * (NF * 16) + n * 16 + fr;
      float g = MOD[col] + BM[col];
#pragma unroll
      for (int jj = 0; jj < 4; jj++) {
        int row = rb + jj;
        float xo = from_input ? xin_row(p, row)[col] : out[(size_t)row * 1024 + col];
        out[(size_t)row * 1024 + col] = xo + g * acc[m][n][jj];
      }
    }
  }
}

DEV void phaseG(const Params& p, int l, char* smem) {
  u16* sA = (u16*)smem;
  const u16* MG = (const u16*)(WS(p) + OFF_YP);
  const u16* W = (const u16*)(WS(p) + OFF_WT) + WOUT_O;
  for (int tile = BID(); tile < 64 * 8; tile += gridDim.x) {
    int tm = tile >> 3, tn = tile & 7;
    f32x4 acc[6][4]; zero_acc<6, 4>(acc);
    gemm_loop<6, 4>(MG + (size_t)tm * 192 * 1024, 1024, W + (size_t)tn * 128 * 1024, 1024, 1024, acc, sA);
    resid_store<6, 4>(p, acc, l, 2, tm * 192, tn * 128, l == 0);
  }
}

DEV void phaseI(const Params& p, int l, char* smem) {
  u16* sA = (u16*)smem; u16* T = (u16*)smem;
  const u16* H = (const u16*)(WS(p) + OFF_H);
  const u16* W = (const u16*)(WS(p) + OFF_WT) + WFIN_O;
  u16* ACT = (u16*)(WS(p) + OFF_ZA);
  for (int tile = BID(); tile < 48 * 44; tile += gridDim.x) {
    int tm = tile / 44, tn = tile % 44;
    if (gridDim.x == 512) {
      const int r = tile >> 9, bb = tile & 511, x = bb & 7, j = bb >> 3;
      int sb = r * 16 + x * 2 + (j >> 5), inner = j & 31;
      if (r == 4) { sb = 64 + (bb >> 5); inner = bb & 31; }
      tm = (sb / 11) * 8 + (inner >> 2); tn = (sb % 11) * 4 + (inner & 3);
    }
    f32x4 acc[8][4]; zero_acc<8, 4>(acc);
    gemm_loop<8, 4>(H + (size_t)tm * 256 * 1024, 1024, W + (size_t)tn * 128 * 1024, 1024, 1024, acc, sA);
    const int tid = TID(), lane = tid & 63, wid = tid >> 6, wr = wid >> 1, wc = wid & 1, fr = lane & 15, fq = lane >> 4;
#pragma unroll
    for (int hh = 0; hh < 2; hh++) {
      __syncthreads();
#pragma unroll
      for (int m = 0; m < 4; m++)
#pragma unroll
        for (int n = 0; n < 2; n++)
#pragma unroll
          for (int j = 0; j < 4; j++)
            T[(m * 32 + wr * 16 + fq * 4 + j) * 72 + wc * 32 + n * 16 + fr] = f2bf(silu_(acc[hh * 4 + m][2 * n][j]) * acc[hh * 4 + m][2 * n + 1][j]);
      __syncthreads();
      copy_tile<64, 72>(T, ACT + (size_t)(tm * 256 + hh * 128) * 2816 + tn * 64, 2816);
    }
  }
}

DEV void phaseJ(const Params& p, int l, char* smem) {
  u16* sA = (u16*)smem;
  const u16* ACT = (const u16*)(WS(p) + OFF_ZA);
  const u16* W = (const u16*)(WS(p) + OFF_WT) + WFOUT_O;
  for (int tile = BID(); tile < 64 * 8; tile += gridDim.x) {
    int tm = tile >> 3, tn = tile & 7;
    f32x4 acc[6][4]; zero_acc<6, 4>(acc);
    gemm_loop<6, 4>(ACT + (size_t)tm * 192 * 2816, 2816, W + (size_t)tn * 128 * 2816, 2816, 2816, acc, sA);
    resid_store<6, 4>(p, acc, l, 5, tm * 192, tn * 128, false);
  }
}


#define XB_TMO      128
#define XB_XCNT(j)  (256  + 64 * (j))
#define XB_XSUB(j)  (1280 + 64 * (j))
#define XB_XGEN(j)  (2304 + 64 * (j))
#define XB_TOP      3328
#define XB_TOPGEN   3392
#define XB_SPIN_CAP (1u << 22)
#define LAS __attribute__((address_space(3)))
DEV unsigned xb_ld(unsigned* p) { return __hip_atomic_load(p, __ATOMIC_RELAXED, __HIP_MEMORY_SCOPE_AGENT); }
DEV unsigned xb_add(unsigned* p, unsigned v) { return __hip_atomic_fetch_add(p, v, __ATOMIC_RELAXED, __HIP_MEMORY_SCOPE_AGENT); }
DEV unsigned xb_xcc_id() { return (unsigned)__builtin_amdgcn_s_getreg((3 << 11) | 20) & 0xFu; }
#define XB_SPIN(cond, bar) do { unsigned _sp = 0; while (cond) { __builtin_amdgcn_s_sleep(1); \
    if ((++_sp & 255u) == 0u) { if (xb_ld(&(bar)[XB_TMO])) break; if (_sp > XB_SPIN_CAP) { atomicAdd(&(bar)[XB_TMO], 1u); break; } } } } while (0)
struct XcdBarrier { unsigned* bar; unsigned x; volatile LAS unsigned* st; };
DEV XcdBarrier xcd_barrier_post(unsigned* bar, volatile LAS unsigned* st) {
  XcdBarrier b; b.bar = bar; b.x = xb_xcc_id(); b.st = st;
  if (threadIdx.x == 0) (void)xb_add(&bar[XB_XCNT(b.x)], 1u);
  return b;
}
DEV void xcd_barrier_complete(unsigned* bar, unsigned x, unsigned& nloc, unsigned& nx) {
  const unsigned G = gridDim.x * gridDim.y * gridDim.z;
  unsigned sum, cnt, mine, sp = 0u;
  for (;;) {
    sum = 0u; cnt = 0u; mine = 0u;
#pragma unroll
    for (unsigned j = 0; j < 16; ++j) { const unsigned c = xb_ld(&bar[XB_XCNT(j)]); sum += c; cnt += (c > 0u) ? 1u : 0u; mine = (j == x) ? c : mine; }
    if (sum == G) break;
    __builtin_amdgcn_s_sleep(1);
    if ((++sp & 255u) == 0u) { if (xb_ld(&bar[XB_TMO])) break; if (sp > XB_SPIN_CAP) { atomicAdd(&bar[XB_TMO], 1u); break; } }
  }
  nloc = mine > 0u ? mine : 1u; nx = cnt > 0u ? cnt : 1u;
}
DEV void xcd_barrier(const XcdBarrier& b) {
  asm volatile("s_waitcnt vmcnt(0)" ::: "memory");
  __syncthreads();
  if (threadIdx.x == 0) {
    unsigned* bar = b.bar;
    __builtin_amdgcn_s_waitcnt(0);
    unsigned nloc = b.st[0], nx = b.st[1];
    if (nloc == 0u) { xcd_barrier_complete(bar, b.x, nloc, nx); b.st[0] = nloc; b.st[1] = nx; }
    const unsigned old = xb_add(&bar[XB_XSUB(b.x)], 1u);
    const unsigned gen = old / nloc;
    if (old + 1u == (gen + 1u) * nloc) {
      __builtin_amdgcn_fence(__ATOMIC_RELEASE, "agent");
      asm volatile("s_waitcnt vmcnt(0)" ::: "memory");
      const unsigned og = xb_add(&bar[XB_TOP], 1u);
      const unsigned tg = og / nx;
      if (og + 1u == (tg + 1u) * nx) xb_add(&bar[XB_TOPGEN], 1u);
      else XB_SPIN(xb_ld(&bar[XB_TOPGEN]) == tg, bar);
      __builtin_amdgcn_fence(__ATOMIC_ACQUIRE, "agent");
      xb_add(&bar[XB_XGEN(b.x)], 1u);
      asm volatile("s_waitcnt vmcnt(0)" ::: "memory");
    } else {
      XB_SPIN(xb_ld(&bar[XB_XGEN(b.x)]) == gen, bar);
      __builtin_amdgcn_fence(__ATOMIC_ACQUIRE, "agent");
      asm volatile("s_waitcnt vmcnt(0)" ::: "memory");
    }
  }
  __syncthreads();
}

constexpr int SMEM_BYTES = 57792;

DEV void run_phase(const Params& p, int ph, int l, char* smem) {
  switch (ph) {
    case 0: phaseA(p, smem); break;
    case 1: norm_phase(p, l, 0); if (l == 1) layer_prep(p, 1, smem); break;
    case 2: phaseC(p, l, smem); break;
    case 3: phaseD(p, l, smem); break;
    case 4: phaseE(p, smem); break;
    case 5: phaseF(p, l, smem); break;
    case 6: phaseG(p, l, smem); break;
    case 7: norm_phase(p, l, 1); break;
    case 8: phaseI(p, l, smem); break;
    case 9: phaseJ(p, l, smem); break;
    case 10: norm_phase(p, 0, 2); break;
  }
}

#if MULTI
__global__ void __launch_bounds__(256, 2) kphase(Params p, int ph, int l) {
  __shared__ __attribute__((aligned(16))) char smem[SMEM_BYTES];
  run_phase(p, ph, l, smem);
}
#else
__global__ void __launch_bounds__(256, 2) mega(Params p) {
  __shared__ __attribute__((aligned(16))) char smem[SMEM_BYTES];
  __shared__ uint4 xb_words;
  cg::grid_group grid = cg::this_grid();
  if (threadIdx.x == 0) xb_words = make_uint4(0u, 0u, 0u, 0u);
  __syncthreads();
  XcdBarrier xb = xcd_barrier_post((unsigned*)(p.ws + OFF_BAR), (volatile LAS unsigned*)&xb_words);
  run_phase(p, 0, 0, smem);
  grid.sync();
  for (int l = 0; l < 2; l++) {
    for (int ph = 1; ph <= 9; ph++) {
      run_phase(p, ph, l, smem);
      xcd_barrier(xb);
    }
  }
  run_phase(p, 10, 0, smem);
}
#endif

extern "C" void kernel_launch(void* const* d_in, const int* in_sizes, int n_in, void* d_out, int out_size, void* d_ws, size_t ws_size, hipStream_t stream) {
  Params p{};
  for (int i = 0; i < 36; i++) p.in[i] = (const float*)d_in[i];
  p.out = (float*)d_out;
  p.ws = (char*)d_ws;
  hipMemsetAsync((char*)d_ws + OFF_MOD, 0, ZERO_BYTES, stream);
  static int grid_blocks = 0;
#if MULTI
  if (!grid_blocks) {
    int dev = 0, cus = 0, per_cu = 0;
    hipGetDevice(&dev);
    hipDeviceGetAttribute(&cus, hipDeviceAttributeMultiprocessorCount, dev);
    hipOccupancyMaxActiveBlocksPerMultiprocessor(&per_cu, kphase, 256, 0);
    if (per_cu > 2) per_cu = 2;
    if (per_cu < 1) per_cu = 1;
    grid_blocks = cus * per_cu;
  }
  kphase<<<grid_blocks, 256, 0, stream>>>(p, 0, 0);
  for (int l = 0; l < 2; l++)
    for (int ph = 1; ph <= 9; ph++) kphase<<<grid_blocks, 256, 0, stream>>>(p, ph, l);
  kphase<<<grid_blocks, 256, 0, stream>>>(p, 10, 0);
#else
  if (!grid_blocks) {
    int dev = 0, cus = 0, per_cu = 0;
    hipGetDevice(&dev);
    hipDeviceGetAttribute(&cus, hipDeviceAttributeMultiprocessorCount, dev);
    hipOccupancyMaxActiveBlocksPerMultiprocessor(&per_cu, mega, 256, 0);
    if (per_cu > 2) per_cu = 2;
    if (per_cu < 1) per_cu = 1;
    grid_blocks = cus * per_cu;
  }
  void* args[] = {&p};
  hipError_t e = hipLaunchCooperativeKernel((void*)mega, dim3(grid_blocks), dim3(256), args, 0, stream);
  if (e != hipSuccess) fprintf(stderr, "cooperative launch failed: %s (grid %d)\n", hipGetErrorString(e), grid_blocks);
#endif
}
```

```cpp
#include <hip/hip_runtime.h>
#include <hip/hip_cooperative_groups.h>
#include <cstdio>
namespace cg = cooperative_groups;

#ifndef MULTI
#define MULTI 0
#endif

typedef unsigned short u16;
using bf16x8 = __attribute__((ext_vector_type(8))) short;
using f32x4 = __attribute__((ext_vector_type(4))) float;
using u32x4 = __attribute__((ext_vector_type(4))) unsigned;
using u32x2 = __attribute__((ext_vector_type(2))) unsigned;
#define DEV __device__ __forceinline__

constexpr int MT = 12288;
constexpr size_t OFF_WT = 0;
constexpr int WIN_O = 0, WGLU_O = 7340032, WRETO_O = 8388608, WHYO_O = 8912896, WOUT_O = 9437184, WFIN_O = 10485760, WFOUT_O = 16252928;
constexpr size_t OFF_G = 38273024;
constexpr size_t OFF_H = 48758784;
constexpr size_t OFF_ZA = 73924608;
constexpr size_t OFF_HYZ = 124256256;
constexpr size_t OFF_VT = 162004992;
constexpr size_t OFF_KT = 174587904;
constexpr size_t OFF_QR = 182976512;
constexpr size_t OFF_YP = 187170816;
constexpr size_t OFF_OUT1 = 212336640;
constexpr size_t OFF_MOD = 237502464;
constexpr size_t OFF_SUMSQ = OFF_MOD + 245760;
constexpr size_t OFF_BAR = OFF_SUMSQ + 16384;
constexpr size_t ZERO_BYTES = 245760 + 16384 + 16384;
constexpr size_t OFF_LAMBAR = OFF_BAR + 16384;
constexpr size_t OFF_BBAR = OFF_LAMBAR + 65536;
constexpr size_t OFF_CM = OFF_BBAR + 524288;
constexpr size_t OFF_ROPE = OFF_CM + 524288;
constexpr size_t OFF_S0T = OFF_ROPE + 524288;
constexpr size_t WS_END = OFF_S0T + 2097152;

struct Params {
  const float* in[36];
  float* out;
  char* ws;
};


DEV int TID() { int t = threadIdx.x; asm volatile("" : "+v"(t)); return t; }
DEV int BID() { int t = blockIdx.x; asm volatile("" : "+s"(t)); return t; }
#define GAS __attribute__((address_space(1)))
DEV char* WS(const Params& p) { unsigned long long w = (unsigned long long)p.ws; asm volatile("" : "+s"(w)); return (char*)(GAS char*)w; }
DEV float* OUTP(const Params& p) { unsigned long long w = (unsigned long long)p.out; asm volatile("" : "+s"(w)); return (float*)(GAS float*)w; }
DEV const float* INP(const Params& p, int i) { unsigned long long w = (unsigned long long)p.in[i]; asm volatile("" : "+s"(w)); return (const float*)(GAS const float*)w; }

DEV u16 f2bf(float f) { unsigned u = __float_as_uint(f); u += 0x7fffu + ((u >> 16) & 1u); return (u16)(u >> 16); }
DEV float bf2f(u16 h) { return __uint_as_float(((unsigned)h) << 16); }
DEV float sigm(float x) { return 1.f / (1.f + __expf(-x)); }
DEV float silu_(float x) { return x / (1.f + __expf(-x)); }
DEV float gelu_(float x) { float u = 0.7978845608028654f * (x + 0.044715f * x * x * x); return 0.5f * x * (1.f + tanhf(u)); }
DEV unsigned pack2(float a, float b) { return (unsigned)f2bf(a) | ((unsigned)f2bf(b) << 16); }

DEV const float* xin_row(const Params& p, int row) { return row < 8192 ? INP(p, 0) + (size_t)row * 1024 : INP(p, 1) + (size_t)(row - 8192) * 1024; }
DEV int modidx(int row) { return row < 8192 ? 0 : 1 + ((row - 8192) >> 10); }

template <int MF, int NF>
DEV void gemm_loop(const u16* __restrict__ A, int lda, const u16* __restrict__ B, int ldb, int K, f32x4 (&acc)[MF][NF], u16* sA) {
  const int tid = TID(), lane = tid & 63, wid = tid >> 6, wr = wid >> 1, wc = wid & 1, fr = lane & 15, fq = lane >> 4;
  u16* sB = sA + MF * 32 * 72;
  u32x4 ra[MF], rb[NF];
  const int crow = tid >> 3, ccol = (tid & 7) * 8;
  const u16* Ap = A + (size_t)crow * lda + ccol;
  const u16* Bp = B + (size_t)crow * ldb + ccol;
#pragma unroll
  for (int i = 0; i < MF; i++) ra[i] = *(const u32x4*)(Ap + (size_t)(i * 32) * lda);
#pragma unroll
  for (int i = 0; i < NF; i++) rb[i] = *(const u32x4*)(Bp + (size_t)(i * 32) * ldb);
  for (int k0 = 0; k0 < K; k0 += 64) {
    __syncthreads();
#pragma unroll
    for (int i = 0; i < MF; i++) *(u32x4*)(sA + (crow + i * 32) * 72 + ccol) = ra[i];
#pragma unroll
    for (int i = 0; i < NF; i++) *(u32x4*)(sB + (crow + i * 32) * 72 + ccol) = rb[i];
    __syncthreads();
    if (k0 + 64 < K) {
#pragma unroll
      for (int i = 0; i < MF; i++) ra[i] = *(const u32x4*)(Ap + (size_t)(i * 32) * lda + k0 + 64);
#pragma unroll
      for (int i = 0; i < NF; i++) rb[i] = *(const u32x4*)(Bp + (size_t)(i * 32) * ldb + k0 + 64);
    }
    {
      const u16* sAf = sA + (wr * 16 + fr) * 72 + fq * 8;
      const u16* sBf = sB + (wc * (NF * 16) + fr) * 72 + fq * 8;
      bf16x8 bvA[NF], bvB[NF];
#pragma unroll
      for (int n = 0; n < NF; n++) bvA[n] = *(const bf16x8*)(sBf + n * 16 * 72);
      bf16x8 a_cur = *(const bf16x8*)(sAf);
      bf16x8 a_nxt = *(const bf16x8*)(sAf + 32 * 72);
      __builtin_amdgcn_s_setprio(1);
#pragma unroll
      for (int st = 0; st < 2 * MF; st++) {
        const int ks = st / MF, m = st % MF;
        bf16x8 a_n2 = a_nxt;
        if (st + 2 < 2 * MF) { const int s2 = st + 2; a_n2 = *(const bf16x8*)(sAf + (s2 % MF) * 32 * 72 + (s2 / MF) * 32); }
        if (st == (MF > 3 ? MF - 3 : 0)) {
#pragma unroll
          for (int n = 0; n < NF; n++) bvB[n] = *(const bf16x8*)(sBf + n * 16 * 72 + 32);
        }
        __builtin_amdgcn_sched_barrier(0);
#pragma unroll
        for (int n = 0; n < NF; n++) acc[m][n] = __builtin_amdgcn_mfma_f32_16x16x32_bf16(a_cur, ks == 0 ? bvA[n] : bvB[n], acc[m][n], 0, 0, 0);
        __builtin_amdgcn_sched_barrier(0);
        a_cur = a_nxt; a_nxt = a_n2;
      }
      __builtin_amdgcn_s_setprio(0);
    }
  }
}

template <int MF, int NF>
DEV void zero_acc(f32x4 (&acc)[MF][NF]) {
#pragma unroll
  for (int m = 0; m < MF; m++)
#pragma unroll
    for (int n = 0; n < NF; n++) acc[m][n] = f32x4{0.f, 0.f, 0.f, 0.f};
}

DEV float epi_op(float v, int op) { return op == 1 ? v * 0.08838834764831845f : (op == 2 ? silu_(v) : v); }
template <int MF, int NF, int TS>
DEV void acc_to_lds(const f32x4 (&acc)[MF][NF], u16* T, int m0, int op = 0) {
  const int tid = TID(), lane = tid & 63, wid = tid >> 6, wr = wid >> 1, wc = wid & 1, fr = lane & 15, fq = lane >> 4;
#pragma unroll
  for (int m = 0; m < 4; m++)
#pragma unroll
    for (int n = 0; n < NF; n++)
#pragma unroll
      for (int j = 0; j < 4; j++) T[(m * 32 + wr * 16 + fq * 4 + j) * TS + wc * (NF * 16) + n * 16 + fr] = f2bf(epi_op(acc[m0 + m][n][j], op));
}
template <int MF>
DEV void acc_to_lds_T(const f32x4 (&acc)[MF][4], u16* T, int m0, int op = 0) {
  const int tid = TID(), lane = tid & 63, wid = tid >> 6, wr = wid >> 1, wc = wid & 1, fr = lane & 15, fq = lane >> 4;
#pragma unroll
  for (int m = 0; m < 4; m++)
#pragma unroll
    for (int n = 0; n < 4; n++) {
      u32x2 v; v.x = pack2(epi_op(acc[m0 + m][n][0], op), epi_op(acc[m0 + m][n][1], op)); v.y = pack2(epi_op(acc[m0 + m][n][2], op), epi_op(acc[m0 + m][n][3], op));
      *(u32x2*)(T + (wc * 64 + n * 16 + fr) * 136 + m * 32 + wr * 16 + fq * 4) = v;
    }
}
template <int COLS, int TS>
DEV void copy_tile(const u16* T, u16* dst, int ld) {
  constexpr int CPR = COLS / 8;
  constexpr int NIT = 128 * CPR / 256;
#pragma unroll
  for (int i = 0; i < NIT; i++) {
    int id = TID() + i * 256; int r = id / CPR, ch = id % CPR;
    *(u32x4*)(dst + (size_t)r * ld + ch * 8) = *(const u32x4*)(T + r * TS + ch * 8);
  }
}

DEV void transpose_tile(const float* __restrict__ src, int K, int N, u16* __restrict__ dst, int tile, float* sm, int perm = 0) {
  int nk = K >> 6; int tk = tile % nk, tn = tile / nk; int k0 = tk * 64, n0 = tn * 64;
  int tx = TID() & 63, ty = TID() >> 6;
  __syncthreads();
#pragma unroll
  for (int i = 0; i < 16; i++) { int k = ty + i * 4; sm[k * 65 + tx] = src[(size_t)(k0 + k) * N + n0 + tx]; }
  __syncthreads();
#pragma unroll
  for (int i = 0; i < 16; i++) {
    int n = n0 + ty + i * 4;
    if (perm) { int half = N >> 1; int j = n < half ? n : n - half; n = (j >> 4) * 32 + (n < half ? 0 : 16) + (j & 15); }
    dst[(size_t)n * K + k0 + tx] = f2bf(sm[tx * 65 + (ty + i * 4)]);
  }
}

DEV void wt_task(const Params& p, int l, int t, float* sm) {
  u16* WT = (u16*)(WS(p) + OFF_WT);
  const float* src; int K, N, off, tt, perm = 0;
  if (t < 1792) { src = INP(p, 10) + (size_t)l * 1024 * 7168; K = 1024; N = 7168; off = WIN_O; tt = t; }
  else if (t < 2048) { src = INP(p, 19) + (size_t)l * 512 * 2048; K = 512; N = 2048; off = WGLU_O; tt = t - 1792; }
  else if (t < 2176) { src = INP(p, 21) + (size_t)l * 512 * 1024; K = 512; N = 1024; off = WRETO_O; tt = t - 2048; }
  else if (t < 2304) { src = INP(p, 31) + (size_t)l * 512 * 1024; K = 512; N = 1024; off = WHYO_O; tt = t - 2176; }
  else if (t < 2560) { src = INP(p, 32) + (size_t)l * 1024 * 1024; K = 1024; N = 1024; off = WOUT_O; tt = t - 2304; }
  else if (t < 3968) { src = INP(p, 33) + (size_t)l * 1024 * 5632; K = 1024; N = 5632; off = WFIN_O; tt = t - 2560; perm = 1; }
  else { src = INP(p, 34) + (size_t)l * 2816 * 1024; K = 2816; N = 1024; off = WFOUT_O; tt = t - 3968; }
  transpose_tile(src, K, N, WT + off, tt, sm, perm);
}

DEV void mod_task(const Params& p, int task, float* sm) {
  int cb = task % 96; int l = task / 96;
  int tid = TID(), lane = tid & 63, kq = tid >> 6;
  __syncthreads();
  for (int i = tid; i < 5120; i += 256) {
    int j = i >> 10, k = i & 1023;
    float c = (j == 0) ? INP(p, 5)[k] : INP(p, 4)[(j - 1) * 1024 + k];
    sm[i] = silu_(c);
  }
  __syncthreads();
  int col = cb * 64 + lane;
  const float* w = INP(p, 6) + (size_t)l * 1024 * 6144 + col;
  float a0 = 0, a1 = 0, a2 = 0, a3 = 0, a4 = 0;
#pragma unroll 8
  for (int kk = 0; kk < 256; kk++) {
    int k = kk * 4 + kq;
    float wv = w[(size_t)k * 6144];
    a0 += sm[k] * wv; a1 += sm[1024 + k] * wv; a2 += sm[2048 + k] * wv; a3 += sm[3072 + k] * wv; a4 += sm[4096 + k] * wv;
  }
  float* red = sm + 5120;
  red[(kq * 5 + 0) * 64 + lane] = a0; red[(kq * 5 + 1) * 64 + lane] = a1; red[(kq * 5 + 2) * 64 + lane] = a2;
  red[(kq * 5 + 3) * 64 + lane] = a3; red[(kq * 5 + 4) * 64 + lane] = a4;
  __syncthreads();
  float* MOD = (float*)(WS(p) + OFF_MOD);
  for (int i = tid; i < 320; i += 256) {
    int j = i >> 6, cc = i & 63;
    float v = ((red[(0 * 5 + j) * 64 + cc] + red[(1 * 5 + j) * 64 + cc]) + red[(2 * 5 + j) * 64 + cc]) + red[(3 * 5 + j) * 64 + cc];
    MOD[(l * 5 + j) * 6144 + cb * 64 + cc] = v;
  }
}

DEV void filt_task(const Params& p, int l, int task, float* sm) {
  int Lsel = task >= 32; int tb = Lsel ? task - 32 : task; int L = Lsel ? 1024 : 256; int t0 = tb * 8;
  int tid = TID();
  float* z = sm; float* h1 = sm + 264; float* h2 = sm + 264 + 512;
  const float* w1 = INP(p, 24) + l * 33 * 64; const float* b1 = INP(p, 25) + l * 64;
  const float* w2 = INP(p, 26) + l * 64 * 64; const float* b2 = INP(p, 27) + l * 64;
  const float* fr0 = INP(p, 28) + l * 128; const float* fr1 = fr0 + 64;
  const float* w3 = INP(p, 29) + (size_t)l * 64 * 2048;
  __syncthreads();
  for (int i = tid; i < 264; i += 256) {
    int tt = i / 33, e = i % 33; float t = (float)(t0 + tt); float v;
    if (e == 0) v = t / (float)L;
    else {
      int b = (e - 1) & 15; float band = 1e-4f + (float)b * ((15.f - 1e-4f) / 15.f);
      float ang = (6.283185307179586f / (float)L) * t * band;
      v = (e <= 16) ? cosf(ang) : -sinf(ang);
    }
    z[i] = v;
  }
  __syncthreads();
  for (int i = tid; i < 512; i += 256) {
    int tt = i >> 6, j = i & 63; float s = b1[j];
    for (int e = 0; e < 33; e++) s += z[tt * 33 + e] * w1[e * 64 + j];
    h1[i] = sinf(fr0[j] * s);
  }
  __syncthreads();
  for (int i = tid; i < 512; i += 256) {
    int tt = i >> 6, j = i & 63; float s = b2[j];
    for (int e = 0; e < 64; e++) s += h1[tt * 64 + e] * w2[e * 64 + j];
    h2[i] = sinf(fr1[j] * s);
  }
  __syncthreads();
  float* FB = (float*)(WS(p) + OFF_G) + (Lsel ? 524288 : 0);
  float* SUMSQ = (float*)(WS(p) + WS_END);
  for (int m = 0; m < 8; m++) {
    int col = tid + m * 256;
    float acc[8];
#pragma unroll
    for (int tt = 0; tt < 8; tt++) acc[tt] = 0.f;
    for (int j = 0; j < 64; j++) {
      float w = w3[j * 2048 + col];
#pragma unroll
      for (int tt = 0; tt < 8; tt++) acc[tt] += h2[tt * 64 + j] * w;
    }
    int dir = col >> 10, o = (col >> 9) & 1, c = col & 511;
    float rate = 3.0701134573253944f + (float)c * ((15.350567286626972f - 3.0701134573253944f) / 511.f);
    float ss = 0.f;
    float* Fo = FB + (size_t)o * (2 * L) * 512 + c;
#pragma unroll
    for (int tt = 0; tt < 8; tt++) {
      int t = t0 + tt;
      float val = acc[tt] * expf(-((float)t / (float)L) * rate);
      if (dir == 0) { Fo[(size_t)(L + t) * 512] = val; ss += val * val; }
      else if (t > 0) { Fo[(size_t)(L - t) * 512] = val; ss += val * val; }
      else { Fo[0] = 0.f; }
    }
    SUMSQ[((size_t)l * 160 + task) * 2048 + col] = ss;
  }
}

DEV void s5prep_task(const Params& p, int task) {
  int idx = task * 256 + TID();
  int pp = idx & 63; int lrg = idx >> 6;
  float lre = INP(p, 11)[idx], lim = INP(p, 12)[idx];
  float dt = expf(INP(p, 13)[lrg]);
  float mag = expf(lre * dt);
  float lbr = mag * cosf(lim * dt), lbi = mag * sinf(lim * dt);
  float nr = lbr - 1.f, ni = lbi; float den = lre * lre + lim * lim;
  float cr = (nr * lre + ni * lim) / den, ci = (ni * lre - nr * lim) / den;
  u16* BBAR = (u16*)(WS(p) + OFF_BBAR); u16* CM = (u16*)(WS(p) + OFF_CM); float* LB = (float*)(WS(p) + OFF_LAMBAR);
  LB[idx * 2] = lbr; LB[idx * 2 + 1] = lbi;
  for (int c = 0; c < 16; c++) {
    float br = INP(p, 14)[(size_t)idx * 16 + c], bi = INP(p, 15)[(size_t)idx * 16 + c];
    BBAR[(size_t)lrg * 2048 + pp * 16 + c] = f2bf(cr * br - ci * bi);
    BBAR[(size_t)lrg * 2048 + (64 + pp) * 16 + c] = f2bf(cr * bi + ci * br);
    CM[(size_t)lrg * 2048 + c * 128 + pp] = f2bf(INP(p, 16)[(size_t)lrg * 1024 + c * 64 + pp]);
    CM[(size_t)lrg * 2048 + c * 128 + 64 + pp] = f2bf(-INP(p, 17)[(size_t)lrg * 1024 + c * 64 + pp]);
  }
}

DEV void rope_task(const Params& p, int task) {
  int idx = task * 256 + TID(); int t = idx >> 6, d = idx & 63; int f = d & 31;
  float inv = powf(10000.f, -(float)f / 32.f);
  float pos = (d < 32) ? (float)(t >> 6) : (float)(t & 63);
  float ang = pos * inv;
  float* R = (float*)(WS(p) + OFF_ROPE);
  R[idx * 2] = cosf(ang); R[idx * 2 + 1] = sinf(ang);
}

DEV void layer_prep(const Params& p, int l, char* smem) {
  for (int t = BID(); t < 4672 + 160; t += gridDim.x) {
    if (t < 4672) wt_task(p, l, t, (float*)smem);
    else filt_task(p, l, t - 4672, (float*)smem);
  }
}
DEV void phaseA(const Params& p, char* smem) {
  for (int t = BID(); t < 192 + 32 + 256 + 256; t += gridDim.x) {
    if (t < 192) mod_task(p, t, (float*)smem);
    else if (t < 224) s5prep_task(p, t - 192);
    else if (t < 480) rope_task(p, t - 224);
    else { int tt = t - 480; int mi = tt >> 2; transpose_tile(INP(p, 3) + (size_t)mi * 16384, 128, 128, (u16*)(WS(p) + OFF_S0T) + (size_t)mi * 16384, tt & 3, (float*)smem); }
  }
  layer_prep(p, 0, smem);
}

DEV void norm_phase(const Params& p, int l, int which) {
  const int lane = TID() & 63;
  const int wave = (BID() * blockDim.x + TID()) >> 6, nw = (gridDim.x * blockDim.x) >> 6;
  u16* H = (u16*)(WS(p) + OFF_H);
  const float* MOD = (const float*)(WS(p) + OFF_MOD);
  for (int row = wave; row < MT; row += nw) {
    const float* x = (l == 0 && which == 0) ? xin_row(p, row) : OUTP(p) + (size_t)row * 1024;
    float4 v[4]; float ss = 0.f;
#pragma unroll
    for (int i = 0; i < 4; i++) { v[i] = *(const float4*)(x + i * 256 + lane * 4); ss += v[i].x * v[i].x + v[i].y * v[i].y + v[i].z * v[i].z + v[i].w * v[i].w; }
#pragma unroll
    for (int o = 32; o > 0; o >>= 1) ss += __shfl_xor(ss, o, 64);
    float rinv = rsqrtf(ss * (1.f / 1024.f) + 1e-6f);
    if (which == 2) {
      const float* nf = INP(p, 35);
#pragma unroll
      for (int i = 0; i < 4; i++) {
        float4 g = *(const float4*)(nf + i * 256 + lane * 4);
        float4 o; o.x = v[i].x * rinv * g.x; o.y = v[i].y * rinv * g.y; o.z = v[i].z * rinv * g.z; o.w = v[i].w * rinv * g.w;
        *(float4*)(OUTP(p) + (size_t)row * 1024 + i * 256 + lane * 4) = o;
      }
    } else {
      int j = modidx(row);
      const float* nwt = (which == 0 ? INP(p, 8) : INP(p, 9)) + l * 1024;
      const float* msh = MOD + (l * 5 + j) * 6144 + (which ? 3 : 0) * 1024;
      const float* msc = msh + 1024;
      const float* bsh = INP(p, 7) + l * 6144 + (which ? 3 : 0) * 1024;
      const float* bsc = bsh + 1024;
#pragma unroll
      for (int i = 0; i < 4; i++) {
        int k = i * 256 + lane * 4;
        float4 g = *(const float4*)(nwt + k);
        float4 sh = *(const float4*)(msh + k), sc = *(const float4*)(msc + k);
        float4 bh = *(const float4*)(bsh + k), bc = *(const float4*)(bsc + k);
        float o0 = v[i].x * rinv * g.x * (1.f + sc.x + bc.x) + sh.x + bh.x;
        float o1 = v[i].y * rinv * g.y * (1.f + sc.y + bc.y) + sh.y + bh.y;
        float o2 = v[i].z * rinv * g.z * (1.f + sc.z + bc.z) + sh.z + bh.z;
        float o3 = v[i].w * rinv * g.w * (1.f + sc.w + bc.w) + sh.w + bh.w;
        u32x2 pk; pk.x = pack2(o0, o1); pk.y = pack2(o2, o3);
        *(u32x2*)(H + (size_t)row * 1024 + k) = pk;
      }
    }
  }
}

DEV void phaseC(const Params& p, int l, char* smem) {
  u16* sA = (u16*)smem; u16* T = (u16*)smem;
  const u16* H = (const u16*)(WS(p) + OFF_H);
  const u16* WIN = (const u16*)(WS(p) + OFF_WT) + WIN_O;
  u16* ZA = (u16*)(WS(p) + OFF_ZA); u16* HYT = (u16*)(WS(p) + OFF_HYZ); u16* VT = (u16*)(WS(p) + OFF_VT);
  u16* KT = (u16*)(WS(p) + OFF_KT); u16* QR = (u16*)(WS(p) + OFF_QR);
  const float* ROPE = (const float*)(WS(p) + OFF_ROPE);
  const int tid = TID();
  for (int tile = BID(); tile < 48 * 32; tile += gridDim.x) {
    int tm = tile >> 5, tn = tile & 31;
    if (gridDim.x == 512) {
      const int r = tile >> 9, bb = tile & 511, x = bb & 7, j = bb >> 3;
      tm = r * 16 + (x >> 2) * 8 + (j >> 3); tn = (x & 3) * 8 + (j & 7);
    }
    f32x4 acc[8][4]; zero_acc<8, 4>(acc);
    gemm_loop<8, 4>(H + (size_t)tm * 256 * 1024, 1024, WIN + (size_t)tn * 128 * 1024, 1024, 1024, acc, sA);
    int kind = tn >> 2, hd = tn & 3;
    const int op = kind == 2 ? 1 : (kind == 4 ? 2 : 0);
#pragma unroll
    for (int hh = 0; hh < 2; hh++) {
      int row0 = tm * 256 + hh * 128; bool lat = row0 >= 8192;
      int seq, t0, L;
      if (!lat) { seq = row0 >> 8; t0 = row0 & 255; L = 256; } else { seq = (row0 - 8192) >> 10; t0 = (row0 - 8192) & 1023; L = 1024; }
      __syncthreads();
      if (kind == 3 || kind >= 5) {
        acc_to_lds_T<8>(acc, T, hh * 4, 0);
        __syncthreads();
        u16* dst;
        if (kind == 3) dst = lat ? VT + (size_t)8192 * 512 + (size_t)((seq * 4 + hd) * 128) * 1024 + t0 : VT + (size_t)((seq * 4 + hd) * 128) * 256 + t0;
        else dst = lat ? HYT + (size_t)8192 * 1536 + ((size_t)seq * 1536 + (tn - 20) * 128) * 1024 + t0 : HYT + ((size_t)seq * 1536 + (tn - 20) * 128) * 256 + t0;
        copy_tile<128, 136>(T, dst, L);
      } else {
        acc_to_lds<8, 4, 136>(acc, T, hh * 4, op);
        __syncthreads();
        bool roped = lat && (kind == 1 || kind == 2);
        if (!(lat && kind == 2)) {
          u16* dst;
          if (kind == 0) dst = ZA + (size_t)row0 * 2048 + hd * 128;
          else if (kind == 1) dst = ZA + (size_t)row0 * 2048 + 512 + hd * 128;
          else if (kind == 2) dst = ZA + (size_t)row0 * 2048 + 1024 + hd * 128;
          else dst = ZA + (size_t)row0 * 2048 + 1536 + hd * 128;
          copy_tile<128, 136>(T, dst, 2048);
        }
        if (roped) {
          u16* dst; int ld;
          if (kind == 1) { dst = QR + (size_t)(row0 - 8192) * 512 + hd * 128; ld = 512; }
          else { dst = ZA + (size_t)row0 * 2048 + 1024 + hd * 128; ld = 2048; }
#pragma unroll 1
          for (int i = 0; i < 4; i++) {
            int id = tid + i * 256; int r = id >> 3, ch = id & 7;
            u32x4 a = *(const u32x4*)(T + r * 136 + ch * 8);
            u32x4 b = *(const u32x4*)(T + r * 136 + 64 + ch * 8);
            const float4* cs = (const float4*)(ROPE + ((size_t)(t0 + r) * 64 + ch * 8) * 2);
            u32x4 o1, o2;
#pragma unroll
            for (int q = 0; q < 4; q++) {
              float4 c4 = cs[q];
              float x1a = __uint_as_float(a[q] << 16), x1b = __uint_as_float(a[q] & 0xffff0000u);
              float x2a = __uint_as_float(b[q] << 16), x2b = __uint_as_float(b[q] & 0xffff0000u);
              o1[q] = pack2(x1a * c4.x - x2a * c4.y, x1b * c4.z - x2b * c4.w);
              o2[q] = pack2(x1a * c4.y + x2a * c4.x, x1b * c4.w + x2b * c4.z);
            }
            *(u32x4*)(dst + (size_t)r * ld + ch * 8) = o1;
            *(u32x4*)(dst + (size_t)r * ld + 64 + ch * 8) = o2;
          }
        }
        if (kind == 2 && !lat) {
          __syncthreads();
          acc_to_lds_T<8>(acc, T, hh * 4, op);
          __syncthreads();
          copy_tile<128, 136>(T, KT + (size_t)((seq * 4 + hd) * 128) * 256 + t0, 256);
        }
      }
    }
  }
}

DEV void s5_task(const Params& p, int l, int task, char* smem) {
  const int tid = TID(), lane = tid & 63, wid = tid >> 6, fr = lane & 15, fq = lane >> 4;
  int seq, gp;
  if (task < 64) { seq = 32 + (task >> 4); gp = task & 15; } else { int t2 = task - 64; seq = t2 >> 4; gp = t2 & 15; }
  const bool lat = seq >= 32;
  const int L = lat ? 1024 : 256;
  const int row0 = lat ? 8192 + (seq - 32) * 1024 : seq * 256;
  const int grp = gp * 2 + (wid >> 1), dir = wid & 1;
  const int lrg = (l * 2 + dir) * 32 + grp;
  float* BU = (float*)(smem + wid * 12544);
  u16* HB = (u16*)(smem + wid * 12544 + 8192);
  u16* ZA = (u16*)(WS(p) + OFF_ZA);
  float* YP = (float*)(WS(p) + OFF_YP);
  const u16* BBAR = (const u16*)(WS(p) + OFF_BBAR) + (size_t)lrg * 2048;
  const u16* CM = (const u16*)(WS(p) + OFF_CM) + (size_t)lrg * 2048;
  const float* LB = (const float*)(WS(p) + OFF_LAMBAR) + ((size_t)lrg * 64 + lane) * 2;
  const float lr = LB[0], li = LB[1];
  bf16x8 bfrag[8], cfrag[4];
  const bf16x8 zero8 = {0, 0, 0, 0, 0, 0, 0, 0};
#pragma unroll
  for (int nt = 0; nt < 8; nt++) bfrag[nt] = (fq < 2) ? *(const bf16x8*)(BBAR + (nt * 16 + fr) * 16 + fq * 8) : zero8;
#pragma unroll
  for (int ks = 0; ks < 4; ks++) cfrag[ks] = *(const bf16x8*)(CM + fr * 128 + ks * 32 + fq * 8);
  float hr = 0.f, hi = 0.f;
  if (lat) {
    const float* s0 = INP(p, 2) + ((((size_t)(seq - 32) * 2 + l) * 2 + dir) * 32 + grp) * 128 + lane * 2;
    hr = s0[0]; hi = s0[1];
  }
  const float dcoef = INP(p, 18)[l * 512 + grp * 16 + fr];
  const int nch = L >> 4;
  __syncthreads();
  const int half = nch >> 1;
  bf16x8 ua_next = (fq < 2) ? *(const bf16x8*)(ZA + (size_t)(row0 + (dir ? nch - 1 : 0) * 16 + fr) * 2048 + grp * 16 + fq * 8) : zero8;
  const int tbase = dir ? 15 : 0, tstep = dir ? -1 : 1;
  for (int i = 0; i < nch; i++) {
    const int ci = dir ? nch - 1 - i : i; const int t0 = ci * 16;
    if (i == half) { asm volatile("s_waitcnt vmcnt(0)" ::: "memory"); __threadfence(); asm volatile("s_waitcnt vmcnt(0)" ::: "memory"); __syncthreads(); }
    const bf16x8 ua = ua_next;
    if (i + 1 < nch) {
      const int cn = dir ? nch - 2 - i : i + 1;
      ua_next = (fq < 2) ? *(const bf16x8*)(ZA + (size_t)(row0 + cn * 16 + fr) * 2048 + grp * 16 + fq * 8) : zero8;
    }
    float oth[4] = {0.f, 0.f, 0.f, 0.f}, uu[4] = {0.f, 0.f, 0.f, 0.f};
    if (i >= half) {
#pragma unroll
      for (int j = 0; j < 4; j++) {
        size_t row = (size_t)(row0 + t0 + fq * 4 + j);
        oth[j] = YP[row * 512 + grp * 16 + fr];
        uu[j] = bf2f(ZA[row * 2048 + grp * 16 + fr]);
      }
    }
#pragma unroll
    for (int nt = 0; nt < 8; nt++) {
      f32x4 r = __builtin_amdgcn_mfma_f32_16x16x32_bf16(ua, bfrag[nt], f32x4{0.f, 0.f, 0.f, 0.f}, 0, 0, 0);
#pragma unroll
      for (int j = 0; j < 4; j++) BU[(fq * 4 + j) * 128 + nt * 16 + fr] = r[j];
    }
    asm volatile("s_waitcnt lgkmcnt(0)" ::: "memory");
#pragma unroll
    for (int tt = 0; tt < 16; tt++) {
      const int t = tbase + tstep * tt;
      float re = BU[t * 128 + lane], im = BU[t * 128 + 64 + lane];
      float nr = lr * hr - li * hi + re; float ni = lr * hi + li * hr + im;
      hr = nr; hi = ni;
      HB[t * 136 + lane] = f2bf(hr); HB[t * 136 + 64 + lane] = f2bf(hi);
    }
    asm volatile("s_waitcnt lgkmcnt(0)" ::: "memory");
    f32x4 y = {0.f, 0.f, 0.f, 0.f};
#pragma unroll
    for (int ks = 0; ks < 4; ks++) {
      bf16x8 a = *(const bf16x8*)(HB + fr * 136 + ks * 32 + fq * 8);
      y = __builtin_amdgcn_mfma_f32_16x16x32_bf16(a, cfrag[ks], y, 0, 0, 0);
    }
    asm volatile("s_waitcnt lgkmcnt(0)" ::: "memory");
    if (i < half) {
#pragma unroll
      for (int j = 0; j < 4; j++) YP[(size_t)(row0 + t0 + fq * 4 + j) * 512 + grp * 16 + fr] = y[j];
    } else {
#pragma unroll
      for (int j = 0; j < 4; j++) {
        size_t row = (size_t)(row0 + t0 + fq * 4 + j);
        float v = y[j] + oth[j] + dcoef * uu[j];
        ZA[row * 2048 + grp * 16 + fr] = f2bf(gelu_(v));
      }
    }
  }
  if (!lat) {
    float* o = OUTP(p) + 12582912 + ((((size_t)seq * 2 + l) * 2 + dir) * 32 + grp) * 128 + lane * 2;
    o[0] = hr; o[1] = hi;
  }
}

DEV void ret_task(const Params& p, int l, int task, char* smem) {
  const int tid = TID(), lane = tid & 63, wid = tid >> 6, fr = lane & 15, fq = lane >> 4;
  int seq, h, qt; bool lat;
  if (task < 256) { lat = true; seq = task >> 6; h = (task >> 4) & 3; qt = task & 15; }
  else { int t2 = task - 256; lat = false; seq = t2 >> 4; h = (t2 >> 2) & 3; qt = t2 & 3; }
  const int L = lat ? 1024 : 256;
  const int row0 = lat ? 8192 + seq * 1024 : seq * 256;
  u16* sK = (u16*)smem; u16* sV = sK + 64 * 136; u16* sP = sV + 128 * 72 + wid * 16 * 72;
  u16* ZA = (u16*)(WS(p) + OFF_ZA);
  const u16* QR = (const u16*)(WS(p) + OFF_QR);
  const u16* VT = (const u16*)(WS(p) + OFF_VT);
  const float lgf = log1pf(-expf(INP(p, 20)[(l * 2 + 0) * 4 + h])), lgb = log1pf(-expf(INP(p, 20)[(l * 2 + 1) * 4 + h]));
  const int qrow = qt * 64 + wid * 16;
  const u16* qsrc = lat ? QR + (size_t)(row0 - 8192 + qrow + fr) * 512 + h * 128 : ZA + (size_t)(row0 + qrow + fr) * 2048 + 512 + h * 128;
  bf16x8 qa[4];
#pragma unroll
  for (int ks = 0; ks < 4; ks++) qa[ks] = *(const bf16x8*)(qsrc + ks * 32 + fq * 8);
  f32x4 o[8];
#pragma unroll
  for (int n = 0; n < 8; n++) o[n] = f32x4{0.f, 0.f, 0.f, 0.f};
  const u16* Kbase = ZA + (size_t)row0 * 2048 + 1024 + h * 128;
  const u16* Vbase = lat ? VT + (size_t)8192 * 512 + (size_t)((seq * 4 + h) * 128) * 1024 : VT + (size_t)((seq * 4 + h) * 128) * 256;
  const int nkt = L >> 6;
  u32x4 kreg[4], vreg[4];
  const int kr = tid >> 4, kc = (tid & 15) * 8;
  const int ve = tid >> 3, vc = (tid & 7) * 8;
#pragma unroll
  for (int i = 0; i < 4; i++) {
    kreg[i] = *(const u32x4*)(Kbase + (size_t)(kr + 16 * i) * 2048 + kc);
    vreg[i] = *(const u32x4*)(Vbase + (size_t)(ve + 32 * i) * L + vc);
  }
  for (int jt = 0; jt < nkt; jt++) {
    __syncthreads();
#pragma unroll
    for (int i = 0; i < 4; i++) {
      *(u32x4*)(sK + (kr + 16 * i) * 136 + kc) = kreg[i];
      *(u32x4*)(sV + (ve + 32 * i) * 72 + vc) = vreg[i];
    }
    __syncthreads();
    if (jt + 1 < nkt) {
#pragma unroll
      for (int i = 0; i < 4; i++) {
        kreg[i] = *(const u32x4*)(Kbase + (size_t)((jt + 1) * 64 + kr + 16 * i) * 2048 + kc);
        vreg[i] = *(const u32x4*)(Vbase + (size_t)(ve + 32 * i) * L + (jt + 1) * 64 + vc);
      }
    }
    f32x4 s[4];
#pragma unroll
    for (int nt = 0; nt < 4; nt++) s[nt] = f32x4{0.f, 0.f, 0.f, 0.f};
    {
      const u16* kp = sK + fr * 136 + fq * 8;
      bf16x8 b_cur = *(const bf16x8*)(kp);
      bf16x8 b_nxt = *(const bf16x8*)(kp + 32);
#pragma unroll
      for (int i = 0; i < 16; i++) {
        bf16x8 b_n2 = b_nxt;
        if (i + 2 < 16) b_n2 = *(const bf16x8*)(kp + ((i + 2) >> 2) * 16 * 136 + ((i + 2) & 3) * 32);
        __builtin_amdgcn_sched_barrier(0);
        s[i >> 2] = __builtin_amdgcn_mfma_f32_16x16x32_bf16(qa[i & 3], b_cur, s[i >> 2], 0, 0, 0);
        __builtin_amdgcn_sched_barrier(0);
        b_cur = b_nxt; b_nxt = b_n2;
      }
    }
#pragma unroll
    for (int nt = 0; nt < 4; nt++)
#pragma unroll
      for (int j = 0; j < 4; j++) {
        int d = (qrow + fq * 4 + j) - (jt * 64 + nt * 16 + fr);
        float w = d >= 0 ? __expf(lgf * (float)d) : __expf(lgb * (float)(-d));
        sP[(fq * 4 + j) * 72 + nt * 16 + fr] = f2bf(s[nt][j] * w);
      }
    asm volatile("s_waitcnt lgkmcnt(0)" ::: "memory");
    {
      bf16x8 pa[2];
      pa[0] = *(const bf16x8*)(sP + fr * 72 + fq * 8);
      pa[1] = *(const bf16x8*)(sP + fr * 72 + 32 + fq * 8);
      const u16* vp = sV + fr * 72 + fq * 8;
      bf16x8 b_cur = *(const bf16x8*)(vp);
      bf16x8 b_nxt = *(const bf16x8*)(vp + 16 * 72);
#pragma unroll
      for (int i = 0; i < 16; i++) {
        bf16x8 b_n2 = b_nxt;
        if (i + 2 < 16) b_n2 = *(const bf16x8*)(vp + ((i + 2) & 7) * 16 * 72 + ((i + 2) >> 3) * 32);
        __builtin_amdgcn_sched_barrier(0);
        o[i & 7] = __builtin_amdgcn_mfma_f32_16x16x32_bf16(pa[i >> 3], b_cur, o[i & 7], 0, 0, 0);
        __builtin_amdgcn_sched_barrier(0);
        b_cur = b_nxt; b_nxt = b_n2;
      }
    }
    asm volatile("s_waitcnt lgkmcnt(0)" ::: "memory");
  }
  if (lat) {
    const u16* q0src = ZA + (size_t)(row0 + qrow + fr) * 2048 + 512 + h * 128;
    bf16x8 q0[4];
#pragma unroll
    for (int ks = 0; ks < 4; ks++) q0[ks] = *(const bf16x8*)(q0src + ks * 32 + fq * 8);
#pragma unroll 1
    for (int dir = 0; dir < 2; dir++) {
      const u16* S0 = (const u16*)(WS(p) + OFF_S0T) + (size_t)((((seq * 2 + l) * 2 + dir) * 4 + h)) * 16384;
      u16* sS = sK;
      __syncthreads();
#pragma unroll
      for (int i = 0; i < 8; i++) {
        int id = tid + i * 256; int e = id >> 4, ch = id & 15;
        *(u32x4*)(sS + e * 136 + ch * 8) = *(const u32x4*)(S0 + (size_t)e * 128 + ch * 8);
      }
      __syncthreads();
      float wj[4];
#pragma unroll
      for (int j = 0; j < 4; j++) { int gi = qrow + fq * 4 + j; wj[j] = dir == 0 ? __expf(lgf * (float)(gi + 1)) : __expf(lgb * (float)(L - 1 - gi)); }
#pragma unroll
      for (int n2 = 0; n2 < 8; n2++) {
        f32x4 tmp = {0.f, 0.f, 0.f, 0.f};
#pragma unroll
        for (int ks = 0; ks < 4; ks++) {
          bf16x8 b = *(const bf16x8*)(sS + (n2 * 16 + fr) * 136 + ks * 32 + fq * 8);
          tmp = __builtin_amdgcn_mfma_f32_16x16x32_bf16(q0[ks], b, tmp, 0, 0, 0);
        }
#pragma unroll
        for (int j = 0; j < 4; j++) o[n2][j] += wj[j] * tmp[j];
      }
    }
  }
#pragma unroll
  for (int j = 0; j < 4; j++) {
    float s = 0.f;
#pragma unroll
    for (int n2 = 0; n2 < 8; n2++) s += o[n2][j];
    s += __shfl_xor(s, 1, 64); s += __shfl_xor(s, 2, 64); s += __shfl_xor(s, 4, 64); s += __shfl_xor(s, 8, 64);
    float mean = s * (1.f / 128.f);
    float v = 0.f;
#pragma unroll
    for (int n2 = 0; n2 < 8; n2++) { float dd = o[n2][j] - mean; v += dd * dd; }
    v += __shfl_xor(v, 1, 64); v += __shfl_xor(v, 2, 64); v += __shfl_xor(v, 4, 64); v += __shfl_xor(v, 8, 64);
    float rstd = rsqrtf(v * (1.f / 128.f) + 1e-5f);
    size_t rbase = (size_t)(row0 + qrow + fq * 4 + j) * 2048;
#pragma unroll
    for (int n2 = 0; n2 < 8; n2++) {
      int e = n2 * 16 + fr;
      float gv = bf2f(ZA[rbase + 1536 + h * 128 + e]);
      ZA[rbase + 512 + h * 128 + e] = f2bf((o[n2][j] - mean) * rstd * gv);
    }
  }
}

DEV bf16x8 scale8(u32x4 raw, const float (&w)[8]) {
  union { u32x4 u; bf16x8 v; } r;
#pragma unroll
  for (int q = 0; q < 4; q++) {
    float a = __uint_as_float(raw[q] << 16) * w[q * 2], b = __uint_as_float(raw[q] & 0xffff0000u) * w[q * 2 + 1];
    r.u[q] = pack2(a, b);
  }
  return r.v;
}

DEV void retstate_task(const Params& p, int l, int task) {
  const int tid = TID(), lane = tid & 63, wid = tid >> 6, fr = lane & 15, fq = lane >> 4;
  int seq = task >> 3, h = (task >> 1) & 3, dir = task & 1;
  const u16* KT = (const u16*)(WS(p) + OFF_KT) + (size_t)((seq * 4 + h) * 128) * 256;
  const u16* VT = (const u16*)(WS(p) + OFF_VT) + (size_t)((seq * 4 + h) * 128) * 256;
  const float lg = log1pf(-expf(INP(p, 20)[(l * 2 + dir) * 4 + h]));
  f32x4 acc[2][8];
#pragma unroll
  for (int m = 0; m < 2; m++)
#pragma unroll
    for (int n = 0; n < 8; n++) acc[m][n] = f32x4{0.f, 0.f, 0.f, 0.f};
#pragma unroll 1
  for (int ks = 0; ks < 8; ks++) {
    float w[8];
#pragma unroll
    for (int jj = 0; jj < 8; jj++) { int j = ks * 32 + fq * 8 + jj; w[jj] = __expf(lg * (float)(dir == 0 ? 255 - j : j)); }
    bf16x8 a[2];
#pragma unroll
    for (int m = 0; m < 2; m++) a[m] = scale8(*(const u32x4*)(KT + (size_t)(wid * 32 + m * 16 + fr) * 256 + ks * 32 + fq * 8), w);
#pragma unroll
    for (int n = 0; n < 8; n++) {
      bf16x8 b = *(const bf16x8*)(VT + (size_t)(n * 16 + fr) * 256 + ks * 32 + fq * 8);
#pragma unroll
      for (int m = 0; m < 2; m++) acc[m][n] = __builtin_amdgcn_mfma_f32_16x16x32_bf16(a[m], b, acc[m][n], 0, 0, 0);
    }
  }
  float* o = OUTP(p) + 13107200 + ((((size_t)seq * 2 + l) * 2 + dir) * 4 + h) * 16384;
#pragma unroll
  for (int m = 0; m < 2; m++)
#pragma unroll
    for (int n = 0; n < 8; n++)
#pragma unroll
      for (int j = 0; j < 4; j++) o[(size_t)(wid * 32 + m * 16 + fq * 4 + j) * 128 + n * 16 + fr] = acc[m][n][j];
}

template <bool LAT>
DEV void hyena_mfma(const Params& p, int l, int task, char* smem) {
  constexpr int L = LAT ? 1024 : 256;
  constexpr int NV = LAT ? 4 : 16;
  constexpr int RS = L + 8, CS = 2 * L + 16;
  constexpr int MPW = L / 64, NKS = L / 32, NCH = L / 8, Lsel = LAT ? 1 : 0;
  const int tid = TID(), lane = tid & 63, wid = tid >> 6, fr = lane & 15, fq = lane >> 4;
  const int c = LAT ? task : (task >> 1);
  const int sg = LAT ? 0 : (task & 1);
  u16* CP = (u16*)smem; u16* XV = CP + 8 * CS; u16* GS = XV + NV * RS; u16* O1 = GS + NV * RS;
  const u16* HYT = (const u16*)(WS(p) + OFF_HYZ);
  u16* HYOT = (u16*)(WS(p) + OFF_OUT1) + (size_t)MT * 512;
  const float* cw = INP(p, 22) + (size_t)l * 3 * 1536; const float* cb = INP(p, 23) + l * 1536;
  auto sconv = [&](int arr, u16* dstA) {
    const int ch = arr * 512 + c;
    const float w0 = cw[ch], w1 = cw[1536 + ch], w2 = cw[3072 + ch], bb = cb[ch];
#pragma unroll
    for (int i = 0; i < (NV * NCH) / 256; i++) {
      int id = tid + i * 256; int n = id / NCH, t8 = (id % NCH) * 8;
      const u16* src = LAT ? HYT + (size_t)8192 * 1536 + ((size_t)n * 1536 + ch) * 1024 + t8 : HYT + ((size_t)(sg * 16 + n) * 1536 + ch) * 256 + t8;
      u32x4 raw = *(const u32x4*)src;
      float h[10];
      h[0] = t8 > 0 ? bf2f(src[-1]) : 0.f;
      h[9] = t8 + 8 < L ? bf2f(src[8]) : 0.f;
#pragma unroll
      for (int q = 0; q < 4; q++) { h[1 + 2 * q] = __uint_as_float(raw[q] << 16); h[2 + 2 * q] = __uint_as_float(raw[q] & 0xffff0000u); }
      u32x4 o;
#pragma unroll
      for (int q = 0; q < 4; q++) o[q] = pack2(w0 * h[2 * q] + w1 * h[2 * q + 1] + w2 * h[2 * q + 2] + bb, w0 * h[2 * q + 1] + w1 * h[2 * q + 2] + w2 * h[2 * q + 3] + bb);
      *(u32x4*)(dstA + n * RS + t8) = o;
    }
  };
  __syncthreads();
  sconv(0, GS);
  sconv(2, XV);
  const int rr = (-fr) & 7;
  const u16* cpl = CP + rr * CS + (L + 8 * fq - fr - rr);
#pragma unroll 1
  for (int o = 0; o < 2; o++) {
    if (o == 1) sconv(1, GS);
    u16* FL = o == 0 ? O1 : XV;
    const float* Gp = (const float*)(WS(p) + OFF_G) + (Lsel ? 524288 : 0) + (size_t)o * (2 * L) * 512 + c;
    if (tid < 2 * L / 8) {
      float f[8];
#pragma unroll
      for (int j = 0; j < 8; j++) { int u = tid * 8 + j; f[j] = u > 0 ? Gp[(size_t)(2 * L - u) * 512] : 0.f; }
      u32x4 v; v[0] = pack2(f[0], f[1]); v[1] = pack2(f[2], f[3]); v[2] = pack2(f[4], f[5]); v[3] = pack2(f[6], f[7]);
      *(u32x4*)(FL + tid * 8) = v;
    }
    if (tid < 2) *(u32x4*)(FL + 2 * L + tid * 8) = u32x4{0u, 0u, 0u, 0u};
    __syncthreads();
    if (tid < 2 * L / 8) {
      u32x4 a = *(const u32x4*)(FL + tid * 8), b = *(const u32x4*)(FL + tid * 8 + 8);
      unsigned d[8] = {a[0], a[1], a[2], a[3], b[0], b[1], b[2], b[3]};
#pragma unroll
      for (int r = 0; r < 8; r++) {
        u32x4 ov;
#pragma unroll
        for (int q = 0; q < 4; q++) ov[q] = (r & 1) ? ((d[q + (r >> 1)] >> 16) | (d[q + (r >> 1) + 1] << 16)) : d[q + (r >> 1)];
        *(u32x4*)(CP + r * CS + tid * 8) = ov;
      }
    }
    __syncthreads();
    float rn;
    {
      constexpr int NTB = LAT ? 128 : 32;
      const float* SP = (const float*)(WS(p) + WS_END) + ((size_t)l * 160 + (LAT ? 32 : 0)) * 2048 + o * 512 + c;
      float ssum = 0.f;
      for (int tb = lane; tb < NTB; tb += 64) ssum += SP[(size_t)tb * 2048] + SP[(size_t)tb * 2048 + 1024];
#pragma unroll
      for (int off = 32; off > 0; off >>= 1) ssum += __shfl_xor(ssum, off, 64);
      rn = rsqrtf(ssum + 1e-6f);
    }
    const float bias = INP(p, 30)[(l * 2 + o) * 512 + c];
    const u16* Xs = o == 0 ? XV : O1;
    f32x4 acc[MPW];
#pragma unroll
    for (int mi = 0; mi < MPW; mi++) acc[mi] = f32x4{0.f, 0.f, 0.f, 0.f};
    const bf16x8 zero8 = {0, 0, 0, 0, 0, 0, 0, 0};
    {
      bf16x8 b_next = (fr < NV) ? *(const bf16x8*)(Xs + fr * RS + fq * 8) : zero8;
#pragma unroll 1
      for (int ks = 0; ks < NKS; ks++) {
        const bf16x8 b = b_next;
        const u16* ap = cpl - 16 * (wid * MPW) + 32 * ks;
        bf16x8 a_cur = *(const bf16x8*)(ap);
        bf16x8 a_nxt = *(const bf16x8*)(ap - 16);
        if (ks + 1 < NKS) b_next = (fr < NV) ? *(const bf16x8*)(Xs + fr * RS + (ks + 1) * 32 + fq * 8) : zero8;
#pragma unroll
        for (int mi = 0; mi < MPW; mi++) {
          bf16x8 a_n2 = a_nxt;
          if (mi + 2 < MPW) a_n2 = *(const bf16x8*)(ap - 16 * (mi + 2));
          __builtin_amdgcn_sched_barrier(0);
          acc[mi] = __builtin_amdgcn_mfma_f32_16x16x32_bf16(a_cur, b, acc[mi], 0, 0, 0);
          __builtin_amdgcn_sched_barrier(0);
          a_cur = a_nxt; a_nxt = a_n2;
        }
      }
    }
    if (fr < NV) {
      const u16* gate = GS;
      const u16* vin = o == 0 ? XV : O1;
#pragma unroll
      for (int mi = 0; mi < MPW; mi++) {
        const int t0 = (wid * MPW + mi) * 16 + fq * 4;
        u32x2 gq = *(const u32x2*)(gate + fr * RS + t0), vq = *(const u32x2*)(vin + fr * RS + t0);
        float g4[4] = {__uint_as_float(gq[0] << 16), __uint_as_float(gq[0] & 0xffff0000u), __uint_as_float(gq[1] << 16), __uint_as_float(gq[1] & 0xffff0000u)};
        float v4[4] = {__uint_as_float(vq[0] << 16), __uint_as_float(vq[0] & 0xffff0000u), __uint_as_float(vq[1] << 16), __uint_as_float(vq[1] & 0xffff0000u)};
        float r4[4];
#pragma unroll
        for (int j = 0; j < 4; j++) r4[j] = g4[j] * (acc[mi][j] * rn + bias * v4[j]);
        if (o == 0) {
          u32x2 ov; ov[0] = pack2(r4[0], r4[1]); ov[1] = pack2(r4[2], r4[3]);
          *(u32x2*)(O1 + fr * RS + t0) = ov;
        } else {
          u16* dst = LAT ? HYOT + (size_t)8192 * 512 + ((size_t)fr * 512 + c) * 1024 + t0 : HYOT + ((size_t)(sg * 16 + fr) * 512 + c) * 256 + t0;
          u32x2 ov; ov[0] = pack2(r4[0], r4[1]); ov[1] = pack2(r4[2], r4[3]);
          *(u32x2*)dst = ov;
        }
      }
    }
    __syncthreads();
  }
}

DEV void phaseD(const Params& p, int l, char* smem) {
  const int nbt = gridDim.x, bt = BID();
  __shared__ int s_task;
  unsigned* ctr = (unsigned*)(WS(p) + OFF_BAR) + 3600 + l * 8;
  if (nbt >= 128 && bt < 64) {
    s5_task(p, l, bt, smem);
    return;
  }
  const int s5lo = nbt >= 128 ? 64 : 0;
#define PULL(pool, limit, body) for (;;) { __syncthreads(); if (threadIdx.x == 0) s_task = (int)atomicAdd(&ctr[pool], 1u); __syncthreads(); \
                                           const int t = s_task; if (t >= (limit)) break; body; }
  PULL(0, 768, ret_task(p, l, t, smem))
  PULL(1, 512, hyena_mfma<true>(p, l, t, smem))
  PULL(2, 576 - s5lo, s5_task(p, l, s5lo + t, smem))
  PULL(3, 1024, hyena_mfma<false>(p, l, t, smem))
  PULL(4, 256, retstate_task(p, l, t))
#undef PULL
}

DEV void phaseE(const Params& p, char* smem) {
  const u16* HYOT = (const u16*)(WS(p) + OFF_OUT1) + (size_t)MT * 512;
  u16* HYO = (u16*)(WS(p) + OFF_OUT1);
  u16* sm = (u16*)smem;
  const int tx = TID() & 63, ty = TID() >> 6;
  for (int tile = BID(); tile < 192 * 8; tile += gridDim.x) {
    int rt = tile >> 3, c0 = (tile & 7) * 64; int row0 = rt * 64;
    const u16* src = row0 < 8192 ? HYOT + ((size_t)(row0 >> 8) * 512 + c0) * 256 + (row0 & 255)
                                 : HYOT + (size_t)8192 * 512 + ((size_t)((row0 - 8192) >> 10) * 512 + c0) * 1024 + ((row0 - 8192) & 1023);
    const int L = row0 < 8192 ? 256 : 1024;
    __syncthreads();
#pragma unroll
    for (int i = 0; i < 16; i++) { int cc = ty + i * 4; sm[cc * 66 + tx] = src[(size_t)cc * L + tx]; }
    __syncthreads();
#pragma unroll
    for (int i = 0; i < 16; i++) { int tt = ty + i * 4; HYO[(size_t)(row0 + tt) * 512 + c0 + tx] = sm[tx * 66 + tt]; }
  }
}

DEV void phaseF(const Params& p, int l, char* smem) {
  u16* sA = (u16*)smem; u16* T = (u16*)smem;
  const u16* H = (const u16*)(WS(p) + OFF_H);
  const u16* WT = (const u16*)(WS(p) + OFF_WT);
  const u16* ZA = (const u16*)(WS(p) + OFF_ZA); const u16* HYO = (const u16*)(WS(p) + OFF_OUT1);
  u16* MG = (u16*)(WS(p) + OFF_YP);
  for (int tile = BID(); tile < 96 * 16; tile += gridDim.x) {
    int tm = tile >> 4, tn = tile & 15;
    if (gridDim.x == 512) {
      const int r = tile >> 9, bb = tile & 511, x = bb & 7, j = bb >> 3;
      tm = r * 32 + (x >> 1) * 8 + (j >> 3); tn = (x & 1) * 8 + (j & 7);
    }
    int row0 = tm * 128, n0 = tn * 64;
    f32x4 a1[4][2], a2[4][2], tt[4][2];
    const u16* Hrow = H + (size_t)row0 * 1024;
    zero_acc<4, 2>(a1); zero_acc<4, 2>(tt);
#pragma unroll 1
    for (int ps = 0; ps < 7; ps++) {
      const u16* Ap; const u16* Bp; int lda, K;
      switch (ps) {
        case 0: Ap = ZA + (size_t)row0 * 2048; lda = 2048; Bp = WT + WGLU_O + (size_t)n0 * 512; K = 512; break;
        case 1: Ap = ZA + (size_t)row0 * 2048; lda = 2048; Bp = WT + WGLU_O + (size_t)(1024 + n0) * 512; K = 512; break;
        case 3: Ap = ZA + (size_t)row0 * 2048 + 512; lda = 2048; Bp = WT + WRETO_O + (size_t)n0 * 512; K = 512; break;
        case 5: Ap = HYO + (size_t)row0 * 512; lda = 512; Bp = WT + WHYO_O + (size_t)n0 * 512; K = 512; break;
        default: Ap = Hrow; lda = 1024; Bp = WT + WIN_O + (size_t)(4096 + ((ps - 2) >> 1) * 1024 + n0) * 1024; K = 1024; break;
      }
      zero_acc<4, 2>(a2);
      gemm_loop<4, 2>(Ap, lda, Bp, K, K, a2, sA);
      if (ps == 0 || ps == 3 || ps == 5) {
#pragma unroll
        for (int m = 0; m < 4; m++)
#pragma unroll
          for (int n = 0; n < 2; n++) a1[m][n] = a2[m][n];
      } else if (ps == 1) {
#pragma unroll
        for (int m = 0; m < 4; m++)
#pragma unroll
          for (int n = 0; n < 2; n++)
#pragma unroll
            for (int j = 0; j < 4; j++) a1[m][n][j] *= sigm(a2[m][n][j]);
      } else {
#pragma unroll
        for (int m = 0; m < 4; m++)
#pragma unroll
          for (int n = 0; n < 2; n++)
#pragma unroll
            for (int j = 0; j < 4; j++) tt[m][n][j] += a1[m][n][j] * sigm(a2[m][n][j]);
      }
    }
    __syncthreads();
    acc_to_lds<4, 2, 72>(tt, T, 0);
    __syncthreads();
    copy_tile<64, 72>(T, MG + (size_t)row0 * 1024 + n0, 1024);
  }
}

template <int MF, int NF>
DEV void resid_store(const Params& p, const f32x4 (&acc)[MF][NF], int l, int chunk, int row0, int col0, bool from_input) {
  const int tid = TID(), lane = tid & 63, wid = tid >> 6, wr = wid >> 1, wc = wid & 1, fr = lane & 15, fq = lane >> 4;
  float* out = OUTP(p);
#pragma unroll
  for (int m = 0; m < MF; m++) {
    const int rb = row0 + m * 32 + wr * 16 + fq * 4;
    const int j = modidx(rb);
    const float* MOD = (const float*)(WS(p) + OFF_MOD) + (l * 5 + j) * 6144 + chunk * 1024;
    const float* BM = INP(p, 7) + l * 6144 + chunk * 1024;
#pragma unroll
    for (int n = 0; n < NF; n++) {
      int col = col0 + wc * (NF * 16) + n * 16 + fr;
      float g = MOD[col] + BM[col];
#pragma unroll
      for (int jj = 0; jj < 4; jj++) {
        int row = rb + jj;
        float xo = from_input ? xin_row(p, row)[col] : out[(size_t)row * 1024 + col];
        out[(size_t)row * 1024 + col] = xo + g * acc[m][n][jj];
      }
    }
  }
}

DEV void phaseG(const Params& p, int l, char* smem) {
  u16* sA = (u16*)smem;
  const u16* MG = (const u16*)(WS(p) + OFF_YP);
  const u16* W = (const u16*)(WS(p) + OFF_WT) + WOUT_O;
  for (int tile = BID(); tile < 64 * 8; tile += gridDim.x) {
    int tm = tile >> 3, tn = tile & 7;
    f32x4 acc[6][4]; zero_acc<6, 4>(acc);
    gemm_loop<6, 4>(MG + (size_t)tm * 192 * 1024, 1024, W + (size_t)tn * 128 * 1024, 1024, 1024, acc, sA);
    resid_store<6, 4>(p, acc, l, 2, tm * 192, tn * 128, l == 0);
  }
}

DEV void phaseI(const Params& p, int l, char* smem) {
  u16* sA = (u16*)smem; u16* T = (u16*)smem;
  const u16* H = (const u16*)(WS(p) + OFF_H);
  const u16* W = (const u16*)(WS(p) + OFF_WT) + WFIN_O;
  u16* ACT = (u16*)(WS(p) + OFF_ZA);
  for (int tile = BID(); tile < 48 * 44; tile += gridDim.x) {
    int tm = tile / 44, tn = tile % 44;
    if (gridDim.x == 512) {
      const int r = tile >> 9, bb = tile & 511, x = bb & 7, j = bb >> 3;
      int sb = r * 16 + x * 2 + (j >> 5), inner = j & 31;
      if (r == 4) { sb = 64 + (bb >> 5); inner = bb & 31; }
      tm = (sb / 11) * 8 + (inner >> 2); tn = (sb % 11) * 4 + (inner & 3);
    }
    f32x4 acc[8][4]; zero_acc<8, 4>(acc);
    gemm_loop<8, 4>(H + (size_t)tm * 256 * 1024, 1024, W + (size_t)tn * 128 * 1024, 1024, 1024, acc, sA);
    const int tid = TID(), lane = tid & 63, wid = tid >> 6, wr = wid >> 1, wc = wid & 1, fr = lane & 15, fq = lane >> 4;
#pragma unroll
    for (int hh = 0; hh < 2; hh++) {
      __syncthreads();
#pragma unroll
      for (int m = 0; m < 4; m++)
#pragma unroll
        for (int n = 0; n < 2; n++)
#pragma unroll
          for (int j = 0; j < 4; j++)
            T[(m * 32 + wr * 16 + fq * 4 + j) * 72 + wc * 32 + n * 16 + fr] = f2bf(silu_(acc[hh * 4 + m][2 * n][j]) * acc[hh * 4 + m][2 * n + 1][j]);
      __syncthreads();
      copy_tile<64, 72>(T, ACT + (size_t)(tm * 256 + hh * 128) * 2816 + tn * 64, 2816);
    }
  }
}

DEV void phaseJ(const Params& p, int l, char* smem) {
  u16* sA = (u16*)smem;
  const u16* ACT = (const u16*)(WS(p) + OFF_ZA);
  const u16* W = (const u16*)(WS(p) + OFF_WT) + WFOUT_O;
  for (int tile = BID(); tile < 64 * 8; tile += gridDim.x) {
    int tm = tile >> 3, tn = tile & 7;
    f32x4 acc[6][4]; zero_acc<6, 4>(acc);
    gemm_loop<6, 4>(ACT + (size_t)tm * 192 * 2816, 2816, W + (size_t)tn * 128 * 2816, 2816, 2816, acc, sA);
    resid_store<6, 4>(p, acc, l, 5, tm * 192, tn * 128, false);
  }
}


#define XB_TMO      128
#define XB_XCNT(j)  (256  + 64 * (j))
#define XB_XSUB(j)  (1280 + 64 * (j))
#define XB_XGEN(j)  (2304 + 64 * (j))
#define XB_TOP      3328
#define XB_TOPGEN   3392
#define XB_SPIN_CAP (1u << 22)
#define LAS __attribute__((address_space(3)))
DEV unsigned xb_ld(unsigned* p) { return __hip_atomic_load(p, __ATOMIC_RELAXED, __HIP_MEMORY_SCOPE_AGENT); }
DEV unsigned xb_add(unsigned* p, unsigned v) { return __hip_atomic_fetch_add(p, v, __ATOMIC_RELAXED, __HIP_MEMORY_SCOPE_AGENT); }
DEV unsigned xb_xcc_id() { return (unsigned)__builtin_amdgcn_s_getreg((3 << 11) | 20) & 0xFu; }
#define XB_SPIN(cond, bar) do { unsigned _sp = 0; while (cond) { __builtin_amdgcn_s_sleep(1); \
    if ((++_sp & 255u) == 0u) { if (xb_ld(&(bar)[XB_TMO])) break; if (_sp > XB_SPIN_CAP) { atomicAdd(&(bar)[XB_TMO], 1u); break; } } } } while (0)
struct XcdBarrier { unsigned* bar; unsigned x; volatile LAS unsigned* st; };
DEV XcdBarrier xcd_barrier_post(unsigned* bar, volatile LAS unsigned* st) {
  XcdBarrier b; b.bar = bar; b.x = xb_xcc_id(); b.st = st;
  if (threadIdx.x == 0) (void)xb_add(&bar[XB_XCNT(b.x)], 1u);
  return b;
}
DEV void xcd_barrier_complete(unsigned* bar, unsigned x, unsigned& nloc, unsigned& nx) {
  const unsigned G = gridDim.x * gridDim.y * gridDim.z;
  unsigned sum, cnt, mine, sp = 0u;
  for (;;) {
    sum = 0u; cnt = 0u; mine = 0u;
#pragma unroll
    for (unsigned j = 0; j < 16; ++j) { const unsigned c = xb_ld(&bar[XB_XCNT(j)]); sum += c; cnt += (c > 0u) ? 1u : 0u; mine = (j == x) ? c : mine; }
    if (sum == G) break;
    __builtin_amdgcn_s_sleep(1);
    if ((++sp & 255u) == 0u) { if (xb_ld(&bar[XB_TMO])) break; if (sp > XB_SPIN_CAP) { atomicAdd(&bar[XB_TMO], 1u); break; } }
  }
  nloc = mine > 0u ? mine : 1u; nx = cnt > 0u ? cnt : 1u;
}
DEV void xcd_barrier(const XcdBarrier& b) {
  asm volatile("s_waitcnt vmcnt(0)" ::: "memory");
  __syncthreads();
  if (threadIdx.x == 0) {
    unsigned* bar = b.bar;
    __builtin_amdgcn_s_waitcnt(0);
    unsigned nloc = b.st[0], nx = b.st[1];
    if (nloc == 0u) { xcd_barrier_complete(bar, b.x, nloc, nx); b.st[0] = nloc; b.st[1] = nx; }
    const unsigned old = xb_add(&bar[XB_XSUB(b.x)], 1u);
    const unsigned gen = old / nloc;
    if (old + 1u == (gen + 1u) * nloc) {
      __builtin_amdgcn_fence(__ATOMIC_RELEASE, "agent");
      asm volatile("s_waitcnt vmcnt(0)" ::: "memory");
      const unsigned og = xb_add(&bar[XB_TOP], 1u);
      const unsigned tg = og / nx;
      if (og + 1u == (tg + 1u) * nx) xb_add(&bar[XB_TOPGEN], 1u);
      else XB_SPIN(xb_ld(&bar[XB_TOPGEN]) == tg, bar);
      __builtin_amdgcn_fence(__ATOMIC_ACQUIRE, "agent");
      xb_add(&bar[XB_XGEN(b.x)], 1u);
      asm volatile("s_waitcnt vmcnt(0)" ::: "memory");
    } else {
      XB_SPIN(xb_ld(&bar[XB_XGEN(b.x)]) == gen, bar);
      __builtin_amdgcn_fence(__ATOMIC_ACQUIRE, "agent");
      asm volatile("s_waitcnt vmcnt(0)" ::: "memory");
    }
  }
  __syncthreads();
}

constexpr int SMEM_BYTES = 57792;

DEV void run_phase(const Params& p, int ph, int l, char* smem) {
  switch (ph) {
    case 0: phaseA(p, smem); break;
    case 1: norm_phase(p, l, 0); if (l == 1) layer_prep(p, 1, smem); break;
    case 2: phaseC(p, l, smem); break;
    case 3: phaseD(p, l, smem); break;
    case 4: phaseE(p, smem); break;
    case 5: phaseF(p, l, smem); break;
    case 6: phaseG(p, l, smem); break;
    case 7: norm_phase(p, l, 1); break;
    case 8: phaseI(p, l, smem); break;
    case 9: phaseJ(p, l, smem); break;
    case 10: norm_phase(p, 0, 2); break;
  }
}

#if MULTI
__global__ void __launch_bounds__(256, 2) kphase(Params p, int ph, int l) {
  __shared__ __attribute__((aligned(16))) char smem[SMEM_BYTES];
  run_phase(p, ph, l, smem);
}
#else
__global__ void __launch_bounds__(256, 2) mega(Params p) {
  __shared__ __attribute__((aligned(16))) char smem[SMEM_BYTES];
  __shared__ uint4 xb_words;
  cg::grid_group grid = cg::this_grid();
  if (threadIdx.x == 0) xb_words = make_uint4(0u, 0u, 0u, 0u);
  __syncthreads();
  XcdBarrier xb = xcd_barrier_post((unsigned*)(p.ws + OFF_BAR), (volatile LAS unsigned*)&xb_words);
  run_phase(p, 0, 0, smem);
  grid.sync();
  for (int l = 0; l < 2; l++) {
    for (int ph = 1; ph <= 9; ph++) {
      run_phase(p, ph, l, smem);
      xcd_barrier(xb);
    }
  }
  run_phase(p, 10, 0, smem);
}
#endif

extern "C" void kernel_launch(void* const* d_in, const int* in_sizes, int n_in, void* d_out, int out_size, void* d_ws, size_t ws_size, hipStream_t stream) {
  Params p{};
  for (int i = 0; i < 36; i++) p.in[i] = (const float*)d_in[i];
  p.out = (float*)d_out;
  p.ws = (char*)d_ws;
  hipMemsetAsync((char*)d_ws + OFF_MOD, 0, ZERO_BYTES, stream);
  static int grid_blocks = 0;
#if MULTI
  if (!grid_blocks) {
    int dev = 0, cus = 0, per_cu = 0;
    hipGetDevice(&dev);
    hipDeviceGetAttribute(&cus, hipDeviceAttributeMultiprocessorCount, dev);
    hipOccupancyMaxActiveBlocksPerMultiprocessor(&per_cu, kphase, 256, 0);
    if (per_cu > 2) per_cu = 2;
    if (per_cu < 1) per_cu = 1;
    grid_blocks = cus * per_cu;
  }
  kphase<<<grid_blocks, 256, 0, stream>>>(p, 0, 0);
  for (int l = 0; l < 2; l++)
    for (int ph = 1; ph <= 9; ph++) kphase<<<grid_blocks, 256, 0, stream>>>(p, ph, l);
  kphase<<<grid_blocks, 256, 0, stream>>>(p, 10, 0);
#else
  if (!grid_blocks) {
    int dev = 0, cus = 0, per_cu = 0;
    hipGetDevice(&dev);
    hipDeviceGetAttribute(&cus, hipDeviceAttributeMultiprocessorCount, dev);
    hipOccupancyMaxActiveBlocksPerMultiprocessor(&per_cu, mega, 256, 0);
    if (per_cu > 2) per_cu = 2;
    if (per_cu < 1) per_cu = 1;
    grid_blocks = cus * per_cu;
  }
  void* args[] = {&p};
  hipError_t e = hipLaunchCooperativeKernel((void*)mega, dim3(grid_blocks), dim3(256), args, 0, stream);
  if (e != hipSuccess) fprintf(stderr, "cooperative launch failed: %s (grid %d)\n", hipGetErrorString(e), grid_blocks);
#endif
}
```

```cpp
#include <hip/hip_runtime.h>
#include <hip/hip_cooperative_groups.h>
#include <cstdio>
namespace cg = cooperative_groups;

#ifndef MULTI
#define MULTI 0
#endif

typedef unsigned short u16;
using bf16x8 = __attribute__((ext_vector_type(8))) short;
using f32x4 = __attribute__((ext_vector_type(4))) float;
using u32x4 = __attribute__((ext_vector_type(4))) unsigned;
using u32x2 = __attribute__((ext_vector_type(2))) unsigned;
#define DEV __device__ __forceinline__

constexpr int MT = 12288;
constexpr size_t OFF_WT = 0;
constexpr int WIN_O = 0, WGLU_O = 7340032, WRETO_O = 8388608, WHYO_O = 8912896, WOUT_O = 9437184, WFIN_O = 10485760, WFOUT_O = 16252928;
constexpr size_t OFF_G = 38273024;
constexpr size_t OFF_H = 48758784;
constexpr size_t OFF_ZA = 73924608;
constexpr size_t OFF_HYZ = 124256256;
constexpr size_t OFF_VT = 162004992;
constexpr size_t OFF_KT = 174587904;
constexpr size_t OFF_QR = 182976512;
constexpr size_t OFF_YP = 187170816;
constexpr size_t OFF_OUT1 = 212336640;
constexpr size_t OFF_MOD = 237502464;
constexpr size_t OFF_SUMSQ = OFF_MOD + 245760;
constexpr size_t OFF_BAR = OFF_SUMSQ + 16384;
constexpr size_t ZERO_BYTES = 245760 + 16384 + 16384;
constexpr size_t OFF_LAMBAR = OFF_BAR + 16384;
constexpr size_t OFF_BBAR = OFF_LAMBAR + 65536;
constexpr size_t OFF_CM = OFF_BBAR + 524288;
constexpr size_t OFF_ROPE = OFF_CM + 524288;
constexpr size_t OFF_S0T = OFF_ROPE + 524288;
constexpr size_t WS_END = OFF_S0T + 2097152;

struct Params {
  const float* in[36];
  float* out;
  char* ws;
};


DEV int TID() { int t = threadIdx.x; asm volatile("" : "+v"(t)); return t; }
DEV int BID() { int t = blockIdx.x; asm volatile("" : "+s"(t)); return t; }
#define GAS __attribute__((address_space(1)))
DEV char* WS(const Params& p) { unsigned long long w = (unsigned long long)p.ws; asm volatile("" : "+s"(w)); return (char*)(GAS char*)w; }
DEV float* OUTP(const Params& p) { unsigned long long w = (unsigned long long)p.out; asm volatile("" : "+s"(w)); return (float*)(GAS float*)w; }
DEV const float* INP(const Params& p, int i) { unsigned long long w = (unsigned long long)p.in[i]; asm volatile("" : "+s"(w)); return (const float*)(GAS const float*)w; }

DEV u16 f2bf(float f) { unsigned u = __float_as_uint(f); u += 0x7fffu + ((u >> 16) & 1u); return (u16)(u >> 16); }
DEV float bf2f(u16 h) { return __uint_as_float(((unsigned)h) << 16); }
DEV float sigm(float x) { return 1.f / (1.f + __expf(-x)); }
DEV float silu_(float x) { return x / (1.f + __expf(-x)); }
DEV float gelu_(float x) { float u = 0.7978845608028654f * (x + 0.044715f * x * x * x); return 0.5f * x * (1.f + tanhf(u)); }
DEV unsigned pack2(float a, float b) { return (unsigned)f2bf(a) | ((unsigned)f2bf(b) << 16); }

DEV const float* xin_row(const Params& p, int row) { return row < 8192 ? INP(p, 0) + (size_t)row * 1024 : INP(p, 1) + (size_t)(row - 8192) * 1024; }
DEV int modidx(int row) { return row < 8192 ? 0 : 1 + ((row - 8192) >> 10); }

template <int MF, int NF>
DEV void gemm_loop(const u16* __restrict__ A, int lda, const u16* __restrict__ B, int ldb, int K, f32x4 (&acc)[MF][NF], u16* sA) {
  const int tid = TID(), lane = tid & 63, wid = tid >> 6, wr = wid >> 1, wc = wid & 1, fr = lane & 15, fq = lane >> 4;
  u16* sB = sA + MF * 32 * 72;
  u32x4 ra[MF], rb[NF];
  const int crow = tid >> 3, ccol = (tid & 7) * 8;
  const u16* Ap = A + (size_t)crow * lda + ccol;
  const u16* Bp = B + (size_t)crow * ldb + ccol;
#pragma unroll
  for (int i = 0; i < MF; i++) ra[i] = *(const u32x4*)(Ap + (size_t)(i * 32) * lda);
#pragma unroll
  for (int i = 0; i < NF; i++) rb[i] = *(const u32x4*)(Bp + (size_t)(i * 32) * ldb);
  for (int k0 = 0; k0 < K; k0 += 64) {
    __syncthreads();
#pragma unroll
    for (int i = 0; i < MF; i++) *(u32x4*)(sA + (crow + i * 32) * 72 + ccol) = ra[i];
#pragma unroll
    for (int i = 0; i < NF; i++) *(u32x4*)(sB + (crow + i * 32) * 72 + ccol) = rb[i];
    __syncthreads();
    if (k0 + 64 < K) {
#pragma unroll
      for (int i = 0; i < MF; i++) ra[i] = *(const u32x4*)(Ap + (size_t)(i * 32) * lda + k0 + 64);
#pragma unroll
      for (int i = 0; i < NF; i++) rb[i] = *(const u32x4*)(Bp + (size_t)(i * 32) * ldb + k0 + 64);
    }
    {
      const u16* sAf = sA + (wr * 16 + fr) * 72 + fq * 8;
      const u16* sBf = sB + (wc * (NF * 16) + fr) * 72 + fq * 8;
      bf16x8 bvA[NF], bvB[NF];
#pragma unroll
      for (int n = 0; n < NF; n++) bvA[n] = *(const bf16x8*)(sBf + n * 16 * 72);
      bf16x8 a_cur = *(const bf16x8*)(sAf);
      bf16x8 a_nxt = *(const bf16x8*)(sAf + 32 * 72);
      __builtin_amdgcn_s_setprio(1);
#pragma unroll
      for (int st = 0; st < 2 * MF; st++) {
        const int ks = st / MF, m = st % MF;
        bf16x8 a_n2 = a_nxt;
        if (st + 2 < 2 * MF) { const int s2 = st + 2; a_n2 = *(const bf16x8*)(sAf + (s2 % MF) * 32 * 72 + (s2 / MF) * 32); }
        if (st == (MF > 3 ? MF - 3 : 0)) {
#pragma unroll
          for (int n = 0; n < NF; n++) bvB[n] = *(const bf16x8*)(sBf + n * 16 * 72 + 32);
        }
        __builtin_amdgcn_sched_barrier(0);
#pragma unroll
        for (int n = 0; n < NF; n++) acc[m][n] = __builtin_amdgcn_mfma_f32_16x16x32_bf16(a_cur, ks == 0 ? bvA[n] : bvB[n], acc[m][n], 0, 0, 0);
        __builtin_amdgcn_sched_barrier(0);
        a_cur = a_nxt; a_nxt = a_n2;
      }
      __builtin_amdgcn_s_setprio(0);
    }
  }
}

template <int MF, int NF>
DEV void zero_acc(f32x4 (&acc)[MF][NF]) {
#pragma unroll
  for (int m = 0; m < MF; m++)
#pragma unroll
    for (int n = 0; n < NF; n++) acc[m][n] = f32x4{0.f, 0.f, 0.f, 0.f};
}

DEV float epi_op(float v, int op) { return op == 1 ? v * 0.08838834764831845f : (op == 2 ? silu_(v) : v); }
template <int MF, int NF, int TS>
DEV void acc_to_lds(const f32x4 (&acc)[MF][NF], u16* T, int m0, int op = 0) {
  const int tid = TID(), lane = tid & 63, wid = tid >> 6, wr = wid >> 1, wc = wid & 1, fr = lane & 15, fq = lane >> 4;
#pragma unroll
  for (int m = 0; m < 4; m++)
#pragma unroll
    for (int n = 0; n < NF; n++)
#pragma unroll
      for (int j = 0; j < 4; j++) T[(m * 32 + wr * 16 + fq * 4 + j) * TS + wc * (NF * 16) + n * 16 + fr] = f2bf(epi_op(acc[m0 + m][n][j], op));
}
template <int MF>
DEV void acc_to_lds_T(const f32x4 (&acc)[MF][4], u16* T, int m0, int op = 0) {
  const int tid = TID(), lane = tid & 63, wid = tid >> 6, wr = wid >> 1, wc = wid & 1, fr = lane & 15, fq = lane >> 4;
#pragma unroll
  for (int m = 0; m < 4; m++)
#pragma unroll
    for (int n = 0; n < 4; n++) {
      u32x2 v; v.x = pack2(epi_op(acc[m0 + m][n][0], op), epi_op(acc[m0 + m][n][1], op)); v.y = pack2(epi_op(acc[m0 + m][n][2], op), epi_op(acc[m0 + m][n][3], op));
      *(u32x2*)(T + (wc * 64 + n * 16 + fr) * 136 + m * 32 + wr * 16 + fq * 4) = v;
    }
}
template <int COLS, int TS>
DEV void copy_tile(const u16* T, u16* dst, int ld) {
  constexpr int CPR = COLS / 8;
  constexpr int NIT = 128 * CPR / 256;
#pragma unroll
  for (int i = 0; i < NIT; i++) {
    int id = TID() + i * 256; int r = id / CPR, ch = id % CPR;
    *(u32x4*)(dst + (size_t)r * ld + ch * 8) = *(const u32x4*)(T + r * TS + ch * 8);
  }
}

DEV void transpose_tile(const float* __restrict__ src, int K, int N, u16* __restrict__ dst, int tile, float* sm, int perm = 0) {
  int nk = K >> 6; int tk = tile % nk, tn = tile / nk; int k0 = tk * 64, n0 = tn * 64;
  int tx = TID() & 63, ty = TID() >> 6;
  __syncthreads();
#pragma unroll
  for (int i = 0; i < 16; i++) { int k = ty + i * 4; sm[k * 65 + tx] = src[(size_t)(k0 + k) * N + n0 + tx]; }
  __syncthreads();
#pragma unroll
  for (int i = 0; i < 16; i++) {
    int n = n0 + ty + i * 4;
    if (perm) { int half = N >> 1; int j = n < half ? n : n - half; n = (j >> 4) * 32 + (n < half ? 0 : 16) + (j & 15); }
    dst[(size_t)n * K + k0 + tx] = f2bf(sm[tx * 65 + (ty + i * 4)]);
  }
}

DEV void wt_task(const Params& p, int l, int t, float* sm) {
  u16* WT = (u16*)(WS(p) + OFF_WT);
  const float* src; int K, N, off, tt, perm = 0;
  if (t < 1792) { src = INP(p, 10) + (size_t)l * 1024 * 7168; K = 1024; N = 7168; off = WIN_O; tt = t; }
  else if (t < 2048) { src = INP(p, 19) + (size_t)l * 512 * 2048; K = 512; N = 2048; off = WGLU_O; tt = t - 1792; }
  else if (t < 2176) { src = INP(p, 21) + (size_t)l * 512 * 1024; K = 512; N = 1024; off = WRETO_O; tt = t - 2048; }
  else if (t < 2304) { src = INP(p, 31) + (size_t)l * 512 * 1024; K = 512; N = 1024; off = WHYO_O; tt = t - 2176; }
  else if (t < 2560) { src = INP(p, 32) + (size_t)l * 1024 * 1024; K = 1024; N = 1024; off = WOUT_O; tt = t - 2304; }
  else if (t < 3968) { src = INP(p, 33) + (size_t)l * 1024 * 5632; K = 1024; N = 5632; off = WFIN_O; tt = t - 2560; perm = 1; }
  else { src = INP(p, 34) + (size_t)l * 2816 * 1024; K = 2816; N = 1024; off = WFOUT_O; tt = t - 3968; }
  transpose_tile(src, K, N, WT + off, tt, sm, perm);
}

DEV void mod_task(const Params& p, int task, float* sm) {
  int cb = task % 96; int l = task / 96;
  int tid = TID(), lane = tid & 63, kq = tid >> 6;
  __syncthreads();
  for (int i = tid; i < 5120; i += 256) {
    int j = i >> 10, k = i & 1023;
    float c = (j == 0) ? INP(p, 5)[k] : INP(p, 4)[(j - 1) * 1024 + k];
    sm[i] = silu_(c);
  }
  __syncthreads();
  int col = cb * 64 + lane;
  const float* w = INP(p, 6) + (size_t)l * 1024 * 6144 + col;
  float a0 = 0, a1 = 0, a2 = 0, a3 = 0, a4 = 0;
#pragma unroll 8
  for (int kk = 0; kk < 256; kk++) {
    int k = kk * 4 + kq;
    float wv = w[(size_t)k * 6144];
    a0 += sm[k] * wv; a1 += sm[1024 + k] * wv; a2 += sm[2048 + k] * wv; a3 += sm[3072 + k] * wv; a4 += sm[4096 + k] * wv;
  }
  float* red = sm + 5120;
  red[(kq * 5 + 0) * 64 + lane] = a0; red[(kq * 5 + 1) * 64 + lane] = a1; red[(kq * 5 + 2) * 64 + lane] = a2;
  red[(kq * 5 + 3) * 64 + lane] = a3; red[(kq * 5 + 4) * 64 + lane] = a4;
  __syncthreads();
  float* MOD = (float*)(WS(p) + OFF_MOD);
  for (int i = tid; i < 320; i += 256) {
    int j = i >> 6, cc = i & 63;
    float v = ((red[(0 * 5 + j) * 64 + cc] + red[(1 * 5 + j) * 64 + cc]) + red[(2 * 5 + j) * 64 + cc]) + red[(3 * 5 + j) * 64 + cc];
    MOD[(l * 5 + j) * 6144 + cb * 64 + cc] = v;
  }
}

DEV void filt_task(const Params& p, int l, int task, float* sm) {
  int Lsel = task >= 32; int tb = Lsel ? task - 32 : task; int L = Lsel ? 1024 : 256; int t0 = tb * 8;
  int tid = TID();
  float* z = sm; float* h1 = sm + 264; float* h2 = sm + 264 + 512;
  const float* w1 = INP(p, 24) + l * 33 * 64; const float* b1 = INP(p, 25) + l * 64;
  const float* w2 = INP(p, 26) + l * 64 * 64; const float* b2 = INP(p, 27) + l * 64;
  const float* fr0 = INP(p, 28) + l * 128; const float* fr1 = fr0 + 64;
  const float* w3 = INP(p, 29) + (size_t)l * 64 * 2048;
  __syncthreads();
  for (int i = tid; i < 264; i += 256) {
    int tt = i / 33, e = i % 33; float t = (float)(t0 + tt); float v;
    if (e == 0) v = t / (float)L;
    else {
      int b = (e - 1) & 15; float band = 1e-4f + (float)b * ((15.f - 1e-4f) / 15.f);
      float ang = (6.283185307179586f / (float)L) * t * band;
      v = (e <= 16) ? cosf(ang) : -sinf(ang);
    }
    z[i] = v;
  }
  __syncthreads();
  for (int i = tid; i < 512; i += 256) {
    int tt = i >> 6, j = i & 63; float s = b1[j];
    for (int e = 0; e < 33; e++) s += z[tt * 33 + e] * w1[e * 64 + j];
    h1[i] = sinf(fr0[j] * s);
  }
  __syncthreads();
  for (int i = tid; i < 512; i += 256) {
    int tt = i >> 6, j = i & 63; float s = b2[j];
    for (int e = 0; e < 64; e++) s += h1[tt * 64 + e] * w2[e * 64 + j];
    h2[i] = sinf(fr1[j] * s);
  }
  __syncthreads();
  float* FB = (float*)(WS(p) + OFF_G) + (Lsel ? 524288 : 0);
  float* SUMSQ = (float*)(WS(p) + WS_END);
  for (int m = 0; m < 8; m++) {
    int col = tid + m * 256;
    float acc[8];
#pragma unroll
    for (int tt = 0; tt < 8; tt++) acc[tt] = 0.f;
    for (int j = 0; j < 64; j++) {
      float w = w3[j * 2048 + col];
#pragma unroll
      for (int tt = 0; tt < 8; tt++) acc[tt] += h2[tt * 64 + j] * w;
    }
    int dir = col >> 10, o = (col >> 9) & 1, c = col & 511;
    float rate = 3.0701134573253944f + (float)c * ((15.350567286626972f - 3.0701134573253944f) / 511.f);
    float ss = 0.f;
    float* Fo = FB + (size_t)o * (2 * L) * 512 + c;
#pragma unroll
    for (int tt = 0; tt < 8; tt++) {
      int t = t0 + tt;
      float val = acc[tt] * expf(-((float)t / (float)L) * rate);
      if (dir == 0) { Fo[(size_t)(L + t) * 512] = val; ss += val * val; }
      else if (t > 0) { Fo[(size_t)(L - t) * 512] = val; ss += val * val; }
      else { Fo[0] = 0.f; }
    }
    SUMSQ[((size_t)l * 160 + task) * 2048 + col] = ss;
  }
}

DEV void s5prep_task(const Params& p, int task) {
  int idx = task * 256 + TID();
  int pp = idx & 63; int lrg = idx >> 6;
  float lre = INP(p, 11)[idx], lim = INP(p, 12)[idx];
  float dt = expf(INP(p, 13)[lrg]);
  float mag = expf(lre * dt);
  float lbr = mag * cosf(lim * dt), lbi = mag * sinf(lim * dt);
  float nr = lbr - 1.f, ni = lbi; float den = lre * lre + lim * lim;
  float cr = (nr * lre + ni * lim) / den, ci = (ni * lre - nr * lim) / den;
  u16* BBAR = (u16*)(WS(p) + OFF_BBAR); u16* CM = (u16*)(WS(p) + OFF_CM); float* LB = (float*)(WS(p) + OFF_LAMBAR);
  LB[idx * 2] = lbr; LB[idx * 2 + 1] = lbi;
  for (int c = 0; c < 16; c++) {
    float br = INP(p, 14)[(size_t)idx * 16 + c], bi = INP(p, 15)[(size_t)idx * 16 + c];
    BBAR[(size_t)lrg * 2048 + pp * 16 + c] = f2bf(cr * br - ci * bi);
    BBAR[(size_t)lrg * 2048 + (64 + pp) * 16 + c] = f2bf(cr * bi + ci * br);
    CM[(size_t)lrg * 2048 + c * 128 + pp] = f2bf(INP(p, 16)[(size_t)lrg * 1024 + c * 64 + pp]);
    CM[(size_t)lrg * 2048 + c * 128 + 64 + pp] = f2bf(-INP(p, 17)[(size_t)lrg * 1024 + c * 64 + pp]);
  }
}

DEV void rope_task(const Params& p, int task) {
  int idx = task * 256 + TID(); int t = idx >> 6, d = idx & 63; int f = d & 31;
  float inv = powf(10000.f, -(float)f / 32.f);
  float pos = (d < 32) ? (float)(t >> 6) : (float)(t & 63);
  float ang = pos * inv;
  float* R = (float*)(WS(p) + OFF_ROPE);
  R[idx * 2] = cosf(ang); R[idx * 2 + 1] = sinf(ang);
}

DEV int pull_task(unsigned* ctr, int* s_task) {
  __syncthreads();
  if (threadIdx.x == 0) *s_task = (int)atomicAdd(ctr, 1u);
  __syncthreads();
  return *s_task;
}
DEV void layer_prep(const Params& p, int l, char* smem) {
  __shared__ int s_lp;
  unsigned* ctr = (unsigned*)(WS(p) + OFF_BAR) + 3700 + l;
  for (;;) {
    const int t = pull_task(ctr, &s_lp);
    if (t >= 160 + 4672) break;
    if (t < 160) filt_task(p, l, t, (float*)smem);
    else wt_task(p, l, t - 160, (float*)smem);
  }
}
DEV void phaseA(const Params& p, char* smem) {
  __shared__ int s_pa;
  unsigned* ctr = (unsigned*)(WS(p) + OFF_BAR) + 3710;
  for (;;) {
    const int t = pull_task(ctr, &s_pa);
    if (t >= 192 + 256 + 256 + 32) break;
    if (t < 192) mod_task(p, t, (float*)smem);
    else if (t < 448) { int tt = t - 192; int mi = tt >> 2; transpose_tile(INP(p, 3) + (size_t)mi * 16384, 128, 128, (u16*)(WS(p) + OFF_S0T) + (size_t)mi * 16384, tt & 3, (float*)smem); }
    else if (t < 704) rope_task(p, t - 448);
    else s5prep_task(p, t - 704);
  }
  layer_prep(p, 0, smem);
}

DEV void norm_phase(const Params& p, int l, int which) {
  const int lane = TID() & 63;
  const int wave = (BID() * blockDim.x + TID()) >> 6, nw = (gridDim.x * blockDim.x) >> 6;
  u16* H = (u16*)(WS(p) + OFF_H);
  const float* MOD = (const float*)(WS(p) + OFF_MOD);
  for (int row = wave; row < MT; row += nw) {
    const float* x = (l == 0 && which == 0) ? xin_row(p, row) : OUTP(p) + (size_t)row * 1024;
    float4 v[4]; float ss = 0.f;
#pragma unroll
    for (int i = 0; i < 4; i++) { v[i] = *(const float4*)(x + i * 256 + lane * 4); ss += v[i].x * v[i].x + v[i].y * v[i].y + v[i].z * v[i].z + v[i].w * v[i].w; }
#pragma unroll
    for (int o = 32; o > 0; o >>= 1) ss += __shfl_xor(ss, o, 64);
    float rinv = rsqrtf(ss * (1.f / 1024.f) + 1e-6f);
    if (which == 2) {
      const float* nf = INP(p, 35);
#pragma unroll
      for (int i = 0; i < 4; i++) {
        float4 g = *(const float4*)(nf + i * 256 + lane * 4);
        float4 o; o.x = v[i].x * rinv * g.x; o.y = v[i].y * rinv * g.y; o.z = v[i].z * rinv * g.z; o.w = v[i].w * rinv * g.w;
        *(float4*)(OUTP(p) + (size_t)row * 1024 + i * 256 + lane * 4) = o;
      }
    } else {
      int j = modidx(row);
      const float* nwt = (which == 0 ? INP(p, 8) : INP(p, 9)) + l * 1024;
      const float* msh = MOD + (l * 5 + j) * 6144 + (which ? 3 : 0) * 1024;
      const float* msc = msh + 1024;
      const float* bsh = INP(p, 7) + l * 6144 + (which ? 3 : 0) * 1024;
      const float* bsc = bsh + 1024;
#pragma unroll
      for (int i = 0; i < 4; i++) {
        int k = i * 256 + lane * 4;
        float4 g = *(const float4*)(nwt + k);
        float4 sh = *(const float4*)(msh + k), sc = *(const float4*)(msc + k);
        float4 bh = *(const float4*)(bsh + k), bc = *(const float4*)(bsc + k);
        float o0 = v[i].x * rinv * g.x * (1.f + sc.x + bc.x) + sh.x + bh.x;
        float o1 = v[i].y * rinv * g.y * (1.f + sc.y + bc.y) + sh.y + bh.y;
        float o2 = v[i].z * rinv * g.z * (1.f + sc.z + bc.z) + sh.z + bh.z;
        float o3 = v[i].w * rinv * g.w * (1.f + sc.w + bc.w) + sh.w + bh.w;
        u32x2 pk; pk.x = pack2(o0, o1); pk.y = pack2(o2, o3);
        *(u32x2*)(H + (size_t)row * 1024 + k) = pk;
      }
    }
  }
}

DEV void phaseC(const Params& p, int l, char* smem) {
  u16* sA = (u16*)smem; u16* T = (u16*)smem;
  const u16* H = (const u16*)(WS(p) + OFF_H);
  const u16* WIN = (const u16*)(WS(p) + OFF_WT) + WIN_O;
  u16* ZA = (u16*)(WS(p) + OFF_ZA); u16* HYT = (u16*)(WS(p) + OFF_HYZ); u16* VT = (u16*)(WS(p) + OFF_VT);
  u16* KT = (u16*)(WS(p) + OFF_KT); u16* QR = (u16*)(WS(p) + OFF_QR);
  const float* ROPE = (const float*)(WS(p) + OFF_ROPE);
  const int tid = TID();
  for (int tile = BID(); tile < 48 * 32; tile += gridDim.x) {
    int tm = tile >> 5, tn = tile & 31;
    if (gridDim.x == 512) {
      const int r = tile >> 9, bb = tile & 511, x = bb & 7, j = bb >> 3;
      tm = r * 16 + (x >> 2) * 8 + (j >> 3); tn = (x & 3) * 8 + (j & 7);
    }
    f32x4 acc[8][4]; zero_acc<8, 4>(acc);
    gemm_loop<8, 4>(H + (size_t)tm * 256 * 1024, 1024, WIN + (size_t)tn * 128 * 1024, 1024, 1024, acc, sA);
    int kind = tn >> 2, hd = tn & 3;
    const int op = kind == 2 ? 1 : (kind == 4 ? 2 : 0);
#pragma unroll
    for (int hh = 0; hh < 2; hh++) {
      int row0 = tm * 256 + hh * 128; bool lat = row0 >= 8192;
      int seq, t0, L;
      if (!lat) { seq = row0 >> 8; t0 = row0 & 255; L = 256; } else { seq = (row0 - 8192) >> 10; t0 = (row0 - 8192) & 1023; L = 1024; }
      __syncthreads();
      if (kind == 3 || kind >= 5) {
        acc_to_lds_T<8>(acc, T, hh * 4, 0);
        __syncthreads();
        u16* dst;
        if (kind == 3) dst = lat ? VT + (size_t)8192 * 512 + (size_t)((seq * 4 + hd) * 128) * 1024 + t0 : VT + (size_t)((seq * 4 + hd) * 128) * 256 + t0;
        else dst = lat ? HYT + (size_t)8192 * 1536 + ((size_t)seq * 1536 + (tn - 20) * 128) * 1024 + t0 : HYT + ((size_t)seq * 1536 + (tn - 20) * 128) * 256 + t0;
        copy_tile<128, 136>(T, dst, L);
      } else {
        acc_to_lds<8, 4, 136>(acc, T, hh * 4, op);
        __syncthreads();
        bool roped = lat && (kind == 1 || kind == 2);
        if (!(lat && kind == 2)) {
          u16* dst;
          if (kind == 0) dst = ZA + (size_t)row0 * 2048 + hd * 128;
          else if (kind == 1) dst = ZA + (size_t)row0 * 2048 + 512 + hd * 128;
          else if (kind == 2) dst = ZA + (size_t)row0 * 2048 + 1024 + hd * 128;
          else dst = ZA + (size_t)row0 * 2048 + 1536 + hd * 128;
          copy_tile<128, 136>(T, dst, 2048);
        }
        if (roped) {
          u16* dst; int ld;
          if (kind == 1) { dst = QR + (size_t)(row0 - 8192) * 512 + hd * 128; ld = 512; }
          else { dst = ZA + (size_t)row0 * 2048 + 1024 + hd * 128; ld = 2048; }
#pragma unroll 1
          for (int i = 0; i < 4; i++) {
            int id = tid + i * 256; int r = id >> 3, ch = id & 7;
            u32x4 a = *(const u32x4*)(T + r * 136 + ch * 8);
            u32x4 b = *(const u32x4*)(T + r * 136 + 64 + ch * 8);
            const float4* cs = (const float4*)(ROPE + ((size_t)(t0 + r) * 64 + ch * 8) * 2);
            u32x4 o1, o2;
#pragma unroll
            for (int q = 0; q < 4; q++) {
              float4 c4 = cs[q];
              float x1a = __uint_as_float(a[q] << 16), x1b = __uint_as_float(a[q] & 0xffff0000u);
              float x2a = __uint_as_float(b[q] << 16), x2b = __uint_as_float(b[q] & 0xffff0000u);
              o1[q] = pack2(x1a * c4.x - x2a * c4.y, x1b * c4.z - x2b * c4.w);
              o2[q] = pack2(x1a * c4.y + x2a * c4.x, x1b * c4.w + x2b * c4.z);
            }
            *(u32x4*)(dst + (size_t)r * ld + ch * 8) = o1;
            *(u32x4*)(dst + (size_t)r * ld + 64 + ch * 8) = o2;
          }
        }
        if (kind == 2 && !lat) {
          __syncthreads();
          acc_to_lds_T<8>(acc, T, hh * 4, op);
          __syncthreads();
          copy_tile<128, 136>(T, KT + (size_t)((seq * 4 + hd) * 128) * 256 + t0, 256);
        }
      }
    }
  }
}

DEV void s5_task(const Params& p, int l, int task, char* smem) {
  const int tid = TID(), lane = tid & 63, wid = tid >> 6, fr = lane & 15, fq = lane >> 4;
  int seq, gp;
  if (task < 64) { seq = 32 + (task >> 4); gp = task & 15; } else { int t2 = task - 64; seq = t2 >> 4; gp = t2 & 15; }
  const bool lat = seq >= 32;
  const int L = lat ? 1024 : 256;
  const int row0 = lat ? 8192 + (seq - 32) * 1024 : seq * 256;
  const int grp = gp * 2 + (wid >> 1), dir = wid & 1;
  const int lrg = (l * 2 + dir) * 32 + grp;
  float* BU = (float*)(smem + wid * 12544);
  u16* HB = (u16*)(smem + wid * 12544 + 8192);
  u16* ZA = (u16*)(WS(p) + OFF_ZA);
  float* YP = (float*)(WS(p) + OFF_YP);
  const u16* BBAR = (const u16*)(WS(p) + OFF_BBAR) + (size_t)lrg * 2048;
  const u16* CM = (const u16*)(WS(p) + OFF_CM) + (size_t)lrg * 2048;
  const float* LB = (const float*)(WS(p) + OFF_LAMBAR) + ((size_t)lrg * 64 + lane) * 2;
  const float lr = LB[0], li = LB[1];
  bf16x8 bfrag[8], cfrag[4];
  const bf16x8 zero8 = {0, 0, 0, 0, 0, 0, 0, 0};
#pragma unroll
  for (int nt = 0; nt < 8; nt++) bfrag[nt] = (fq < 2) ? *(const bf16x8*)(BBAR + (nt * 16 + fr) * 16 + fq * 8) : zero8;
#pragma unroll
  for (int ks = 0; ks < 4; ks++) cfrag[ks] = *(const bf16x8*)(CM + fr * 128 + ks * 32 + fq * 8);
  float hr = 0.f, hi = 0.f;
  if (lat) {
    const float* s0 = INP(p, 2) + ((((size_t)(seq - 32) * 2 + l) * 2 + dir) * 32 + grp) * 128 + lane * 2;
    hr = s0[0]; hi = s0[1];
  }
  const float dcoef = INP(p, 18)[l * 512 + grp * 16 + fr];
  const int nch = L >> 4;
  __syncthreads();
  const int half = nch >> 1;
  bf16x8 ua_next = (fq < 2) ? *(const bf16x8*)(ZA + (size_t)(row0 + (dir ? nch - 1 : 0) * 16 + fr) * 2048 + grp * 16 + fq * 8) : zero8;
  const int tbase = dir ? 15 : 0, tstep = dir ? -1 : 1;
  for (int i = 0; i < nch; i++) {
    const int ci = dir ? nch - 1 - i : i; const int t0 = ci * 16;
    if (i == half) { asm volatile("s_waitcnt vmcnt(0)" ::: "memory"); __threadfence(); asm volatile("s_waitcnt vmcnt(0)" ::: "memory"); __syncthreads(); }
    const bf16x8 ua = ua_next;
    if (i + 1 < nch) {
      const int cn = dir ? nch - 2 - i : i + 1;
      ua_next = (fq < 2) ? *(const bf16x8*)(ZA + (size_t)(row0 + cn * 16 + fr) * 2048 + grp * 16 + fq * 8) : zero8;
    }
    float oth[4] = {0.f, 0.f, 0.f, 0.f}, uu[4] = {0.f, 0.f, 0.f, 0.f};
    if (i >= half) {
#pragma unroll
      for (int j = 0; j < 4; j++) {
        size_t row = (size_t)(row0 + t0 + fq * 4 + j);
        oth[j] = YP[row * 512 + grp * 16 + fr];
        uu[j] = bf2f(ZA[row * 2048 + grp * 16 + fr]);
      }
    }
#pragma unroll
    for (int nt = 0; nt < 8; nt++) {
      f32x4 r = __builtin_amdgcn_mfma_f32_16x16x32_bf16(ua, bfrag[nt], f32x4{0.f, 0.f, 0.f, 0.f}, 0, 0, 0);
#pragma unroll
      for (int j = 0; j < 4; j++) BU[(fq * 4 + j) * 128 + nt * 16 + fr] = r[j];
    }
    asm volatile("s_waitcnt lgkmcnt(0)" ::: "memory");
#pragma unroll
    for (int tt = 0; tt < 16; tt++) {
      const int t = tbase + tstep * tt;
      float re = BU[t * 128 + lane], im = BU[t * 128 + 64 + lane];
      float nr = lr * hr - li * hi + re; float ni = lr * hi + li * hr + im;
      hr = nr; hi = ni;
      HB[t * 136 + lane] = f2bf(hr); HB[t * 136 + 64 + lane] = f2bf(hi);
    }
    asm volatile("s_waitcnt lgkmcnt(0)" ::: "memory");
    f32x4 y = {0.f, 0.f, 0.f, 0.f};
#pragma unroll
    for (int ks = 0; ks < 4; ks++) {
      bf16x8 a = *(const bf16x8*)(HB + fr * 136 + ks * 32 + fq * 8);
      y = __builtin_amdgcn_mfma_f32_16x16x32_bf16(a, cfrag[ks], y, 0, 0, 0);
    }
    asm volatile("s_waitcnt lgkmcnt(0)" ::: "memory");
    if (i < half) {
#pragma unroll
      for (int j = 0; j < 4; j++) YP[(size_t)(row0 + t0 + fq * 4 + j) * 512 + grp * 16 + fr] = y[j];
    } else {
#pragma unroll
      for (int j = 0; j < 4; j++) {
        size_t row = (size_t)(row0 + t0 + fq * 4 + j);
        float v = y[j] + oth[j] + dcoef * uu[j];
        ZA[row * 2048 + grp * 16 + fr] = f2bf(gelu_(v));
      }
    }
  }
  if (!lat) {
    float* o = OUTP(p) + 12582912 + ((((size_t)seq * 2 + l) * 2 + dir) * 32 + grp) * 128 + lane * 2;
    o[0] = hr; o[1] = hi;
  }
}

DEV void ret_task(const Params& p, int l, int task, char* smem) {
  const int tid = TID(), lane = tid & 63, wid = tid >> 6, fr = lane & 15, fq = lane >> 4;
  int seq, h, qt; bool lat;
  if (task < 256) { lat = true; seq = task >> 6; h = (task >> 4) & 3; qt = task & 15; }
  else { int t2 = task - 256; lat = false; seq = t2 >> 4; h = (t2 >> 2) & 3; qt = t2 & 3; }
  const int L = lat ? 1024 : 256;
  const int row0 = lat ? 8192 + seq * 1024 : seq * 256;
  u16* sK = (u16*)smem; u16* sV = sK + 64 * 136; u16* sP = sV + 128 * 72 + wid * 16 * 72;
  u16* ZA = (u16*)(WS(p) + OFF_ZA);
  const u16* QR = (const u16*)(WS(p) + OFF_QR);
  const u16* VT = (const u16*)(WS(p) + OFF_VT);
  const float lgf = log1pf(-expf(INP(p, 20)[(l * 2 + 0) * 4 + h])), lgb = log1pf(-expf(INP(p, 20)[(l * 2 + 1) * 4 + h]));
  const int qrow = qt * 64 + wid * 16;
  const u16* qsrc = lat ? QR + (size_t)(row0 - 8192 + qrow + fr) * 512 + h * 128 : ZA + (size_t)(row0 + qrow + fr) * 2048 + 512 + h * 128;
  bf16x8 qa[4];
#pragma unroll
  for (int ks = 0; ks < 4; ks++) qa[ks] = *(const bf16x8*)(qsrc + ks * 32 + fq * 8);
  f32x4 o[8];
#pragma unroll
  for (int n = 0; n < 8; n++) o[n] = f32x4{0.f, 0.f, 0.f, 0.f};
  const u16* Kbase = ZA + (size_t)row0 * 2048 + 1024 + h * 128;
  const u16* Vbase = lat ? VT + (size_t)8192 * 512 + (size_t)((seq * 4 + h) * 128) * 1024 : VT + (size_t)((seq * 4 + h) * 128) * 256;
  const int nkt = L >> 6;
  u32x4 kreg[4], vreg[4];
  const int kr = tid >> 4, kc = (tid & 15) * 8;
  const int ve = tid >> 3, vc = (tid & 7) * 8;
#pragma unroll
  for (int i = 0; i < 4; i++) {
    kreg[i] = *(const u32x4*)(Kbase + (size_t)(kr + 16 * i) * 2048 + kc);
    vreg[i] = *(const u32x4*)(Vbase + (size_t)(ve + 32 * i) * L + vc);
  }
  for (int jt = 0; jt < nkt; jt++) {
    __syncthreads();
#pragma unroll
    for (int i = 0; i < 4; i++) {
      *(u32x4*)(sK + (kr + 16 * i) * 136 + kc) = kreg[i];
      *(u32x4*)(sV + (ve + 32 * i) * 72 + vc) = vreg[i];
    }
    __syncthreads();
    if (jt + 1 < nkt) {
#pragma unroll
      for (int i = 0; i < 4; i++) {
        kreg[i] = *(const u32x4*)(Kbase + (size_t)((jt + 1) * 64 + kr + 16 * i) * 2048 + kc);
        vreg[i] = *(const u32x4*)(Vbase + (size_t)(ve + 32 * i) * L + (jt + 1) * 64 + vc);
      }
    }
    f32x4 s[4];
#pragma unroll
    for (int nt = 0; nt < 4; nt++) s[nt] = f32x4{0.f, 0.f, 0.f, 0.f};
    {
      const u16* kp = sK + fr * 136 + fq * 8;
      bf16x8 b_cur = *(const bf16x8*)(kp);
      bf16x8 b_nxt = *(const bf16x8*)(kp + 32);
#pragma unroll
      for (int i = 0; i < 16; i++) {
        bf16x8 b_n2 = b_nxt;
        if (i + 2 < 16) b_n2 = *(const bf16x8*)(kp + ((i + 2) >> 2) * 16 * 136 + ((i + 2) & 3) * 32);
        __builtin_amdgcn_sched_barrier(0);
        s[i >> 2] = __builtin_amdgcn_mfma_f32_16x16x32_bf16(qa[i & 3], b_cur, s[i >> 2], 0, 0, 0);
        __builtin_amdgcn_sched_barrier(0);
        b_cur = b_nxt; b_nxt = b_n2;
      }
    }
#pragma unroll
    for (int nt = 0; nt < 4; nt++)
#pragma unroll
      for (int j = 0; j < 4; j++) {
        int d = (qrow + fq * 4 + j) - (jt * 64 + nt * 16 + fr);
        float w = d >= 0 ? __expf(lgf * (float)d) : __expf(lgb * (float)(-d));
        sP[(fq * 4 + j) * 72 + nt * 16 + fr] = f2bf(s[nt][j] * w);
      }
    asm volatile("s_waitcnt lgkmcnt(0)" ::: "memory");
    {
      bf16x8 pa[2];
      pa[0] = *(const bf16x8*)(sP + fr * 72 + fq * 8);
      pa[1] = *(const bf16x8*)(sP + fr * 72 + 32 + fq * 8);
      const u16* vp = sV + fr * 72 + fq * 8;
      bf16x8 b_cur = *(const bf16x8*)(vp);
      bf16x8 b_nxt = *(const bf16x8*)(vp + 16 * 72);
#pragma unroll
      for (int i = 0; i < 16; i++) {
        bf16x8 b_n2 = b_nxt;
        if (i + 2 < 16) b_n2 = *(const bf16x8*)(vp + ((i + 2) & 7) * 16 * 72 + ((i + 2) >> 3) * 32);
        __builtin_amdgcn_sched_barrier(0);
        o[i & 7] = __builtin_amdgcn_mfma_f32_16x16x32_bf16(pa[i >> 3], b_cur, o[i & 7], 0, 0, 0);
        __builtin_amdgcn_sched_barrier(0);
        b_cur = b_nxt; b_nxt = b_n2;
      }
    }
    asm volatile("s_waitcnt lgkmcnt(0)" ::: "memory");
  }
  if (lat) {
    const u16* q0src = ZA + (size_t)(row0 + qrow + fr) * 2048 + 512 + h * 128;
    bf16x8 q0[4];
#pragma unroll
    for (int ks = 0; ks < 4; ks++) q0[ks] = *(const bf16x8*)(q0src + ks * 32 + fq * 8);
#pragma unroll 1
    for (int dir = 0; dir < 2; dir++) {
      const u16* S0 = (const u16*)(WS(p) + OFF_S0T) + (size_t)((((seq * 2 + l) * 2 + dir) * 4 + h)) * 16384;
      u16* sS = sK;
      __syncthreads();
#pragma unroll
      for (int i = 0; i < 8; i++) {
        int id = tid + i * 256; int e = id >> 4, ch = id & 15;
        *(u32x4*)(sS + e * 136 + ch * 8) = *(const u32x4*)(S0 + (size_t)e * 128 + ch * 8);
      }
      __syncthreads();
      float wj[4];
#pragma unroll
      for (int j = 0; j < 4; j++) { int gi = qrow + fq * 4 + j; wj[j] = dir == 0 ? __expf(lgf * (float)(gi + 1)) : __expf(lgb * (float)(L - 1 - gi)); }
#pragma unroll
      for (int n2 = 0; n2 < 8; n2++) {
        f32x4 tmp = {0.f, 0.f, 0.f, 0.f};
#pragma unroll
        for (int ks = 0; ks < 4; ks++) {
          bf16x8 b = *(const bf16x8*)(sS + (n2 * 16 + fr) * 136 + ks * 32 + fq * 8);
          tmp = __builtin_amdgcn_mfma_f32_16x16x32_bf16(q0[ks], b, tmp, 0, 0, 0);
        }
#pragma unroll
        for (int j = 0; j < 4; j++) o[n2][j] += wj[j] * tmp[j];
      }
    }
  }
#pragma unroll
  for (int j = 0; j < 4; j++) {
    float s = 0.f;
#pragma unroll
    for (int n2 = 0; n2 < 8; n2++) s += o[n2][j];
    s += __shfl_xor(s, 1, 64); s += __shfl_xor(s, 2, 64); s += __shfl_xor(s, 4, 64); s += __shfl_xor(s, 8, 64);
    float mean = s * (1.f / 128.f);
    float v = 0.f;
#pragma unroll
    for (int n2 = 0; n2 < 8; n2++) { float dd = o[n2][j] - mean; v += dd * dd; }
    v += __shfl_xor(v, 1, 64); v += __shfl_xor(v, 2, 64); v += __shfl_xor(v, 4, 64); v += __shfl_xor(v, 8, 64);
    float rstd = rsqrtf(v * (1.f / 128.f) + 1e-5f);
    size_t rbase = (size_t)(row0 + qrow + fq * 4 + j) * 2048;
#pragma unroll
    for (int n2 = 0; n2 < 8; n2++) {
      int e = n2 * 16 + fr;
      float gv = bf2f(ZA[rbase + 1536 + h * 128 + e]);
      ZA[rbase + 512 + h * 128 + e] = f2bf((o[n2][j] - mean) * rstd * gv);
    }
  }
}

DEV bf16x8 scale8(u32x4 raw, const float (&w)[8]) {
  union { u32x4 u; bf16x8 v; } r;
#pragma unroll
  for (int q = 0; q < 4; q++) {
    float a = __uint_as_float(raw[q] << 16) * w[q * 2], b = __uint_as_float(raw[q] & 0xffff0000u) * w[q * 2 + 1];
    r.u[q] = pack2(a, b);
  }
  return r.v;
}

DEV void retstate_task(const Params& p, int l, int task) {
  const int tid = TID(), lane = tid & 63, wid = tid >> 6, fr = lane & 15, fq = lane >> 4;
  int seq = task >> 3, h = (task >> 1) & 3, dir = task & 1;
  const u16* KT = (const u16*)(WS(p) + OFF_KT) + (size_t)((seq * 4 + h) * 128) * 256;
  const u16* VT = (const u16*)(WS(p) + OFF_VT) + (size_t)((seq * 4 + h) * 128) * 256;
  const float lg = log1pf(-expf(INP(p, 20)[(l * 2 + dir) * 4 + h]));
  f32x4 acc[2][8];
#pragma unroll
  for (int m = 0; m < 2; m++)
#pragma unroll
    for (int n = 0; n < 8; n++) acc[m][n] = f32x4{0.f, 0.f, 0.f, 0.f};
#pragma unroll 1
  for (int ks = 0; ks < 8; ks++) {
    float w[8];
#pragma unroll
    for (int jj = 0; jj < 8; jj++) { int j = ks * 32 + fq * 8 + jj; w[jj] = __expf(lg * (float)(dir == 0 ? 255 - j : j)); }
    bf16x8 a[2];
#pragma unroll
    for (int m = 0; m < 2; m++) a[m] = scale8(*(const u32x4*)(KT + (size_t)(wid * 32 + m * 16 + fr) * 256 + ks * 32 + fq * 8), w);
#pragma unroll
    for (int n = 0; n < 8; n++) {
      bf16x8 b = *(const bf16x8*)(VT + (size_t)(n * 16 + fr) * 256 + ks * 32 + fq * 8);
#pragma unroll
      for (int m = 0; m < 2; m++) acc[m][n] = __builtin_amdgcn_mfma_f32_16x16x32_bf16(a[m], b, acc[m][n], 0, 0, 0);
    }
  }
  float* o = OUTP(p) + 13107200 + ((((size_t)seq * 2 + l) * 2 + dir) * 4 + h) * 16384;
#pragma unroll
  for (int m = 0; m < 2; m++)
#pragma unroll
    for (int n = 0; n < 8; n++)
#pragma unroll
      for (int j = 0; j < 4; j++) o[(size_t)(wid * 32 + m * 16 + fq * 4 + j) * 128 + n * 16 + fr] = acc[m][n][j];
}

template <bool LAT>
DEV void hyena_mfma(const Params& p, int l, int task, char* smem) {
  constexpr int L = LAT ? 1024 : 256;
  constexpr int NV = LAT ? 4 : 16;
  constexpr int RS = L + 8, CS = 2 * L + 16;
  constexpr int MPW = L / 64, NKS = L / 32, NCH = L / 8, Lsel = LAT ? 1 : 0;
  const int tid = TID(), lane = tid & 63, wid = tid >> 6, fr = lane & 15, fq = lane >> 4;
  const int c = LAT ? task : (task >> 1);
  const int sg = LAT ? 0 : (task & 1);
  u16* CP = (u16*)smem; u16* XV = CP + 8 * CS; u16* GS = XV + NV * RS; u16* O1 = GS + NV * RS;
  const u16* HYT = (const u16*)(WS(p) + OFF_HYZ);
  u16* HYOT = (u16*)(WS(p) + OFF_OUT1) + (size_t)MT * 512;
  const float* cw = INP(p, 22) + (size_t)l * 3 * 1536; const float* cb = INP(p, 23) + l * 1536;
  auto sconv = [&](int arr, u16* dstA) {
    const int ch = arr * 512 + c;
    const float w0 = cw[ch], w1 = cw[1536 + ch], w2 = cw[3072 + ch], bb = cb[ch];
#pragma unroll
    for (int i = 0; i < (NV * NCH) / 256; i++) {
      int id = tid + i * 256; int n = id / NCH, t8 = (id % NCH) * 8;
      const u16* src = LAT ? HYT + (size_t)8192 * 1536 + ((size_t)n * 1536 + ch) * 1024 + t8 : HYT + ((size_t)(sg * 16 + n) * 1536 + ch) * 256 + t8;
      u32x4 raw = *(const u32x4*)src;
      float h[10];
      h[0] = t8 > 0 ? bf2f(src[-1]) : 0.f;
      h[9] = t8 + 8 < L ? bf2f(src[8]) : 0.f;
#pragma unroll
      for (int q = 0; q < 4; q++) { h[1 + 2 * q] = __uint_as_float(raw[q] << 16); h[2 + 2 * q] = __uint_as_float(raw[q] & 0xffff0000u); }
      u32x4 o;
#pragma unroll
      for (int q = 0; q < 4; q++) o[q] = pack2(w0 * h[2 * q] + w1 * h[2 * q + 1] + w2 * h[2 * q + 2] + bb, w0 * h[2 * q + 1] + w1 * h[2 * q + 2] + w2 * h[2 * q + 3] + bb);
      *(u32x4*)(dstA + n * RS + t8) = o;
    }
  };
  __syncthreads();
  sconv(0, GS);
  sconv(2, XV);
  const int rr = (-fr) & 7;
  const u16* cpl = CP + rr * CS + (L + 8 * fq - fr - rr);
#pragma unroll 1
  for (int o = 0; o < 2; o++) {
    if (o == 1) sconv(1, GS);
    u16* FL = o == 0 ? O1 : XV;
    const float* Gp = (const float*)(WS(p) + OFF_G) + (Lsel ? 524288 : 0) + (size_t)o * (2 * L) * 512 + c;
    if (tid < 2 * L / 8) {
      float f[8];
#pragma unroll
      for (int j = 0; j < 8; j++) { int u = tid * 8 + j; f[j] = u > 0 ? Gp[(size_t)(2 * L - u) * 512] : 0.f; }
      u32x4 v; v[0] = pack2(f[0], f[1]); v[1] = pack2(f[2], f[3]); v[2] = pack2(f[4], f[5]); v[3] = pack2(f[6], f[7]);
      *(u32x4*)(FL + tid * 8) = v;
    }
    if (tid < 2) *(u32x4*)(FL + 2 * L + tid * 8) = u32x4{0u, 0u, 0u, 0u};
    __syncthreads();
    if (tid < 2 * L / 8) {
      u32x4 a = *(const u32x4*)(FL + tid * 8), b = *(const u32x4*)(FL + tid * 8 + 8);
      unsigned d[8] = {a[0], a[1], a[2], a[3], b[0], b[1], b[2], b[3]};
#pragma unroll
      for (int r = 0; r < 8; r++) {
        u32x4 ov;
#pragma unroll
        for (int q = 0; q < 4; q++) ov[q] = (r & 1) ? ((d[q + (r >> 1)] >> 16) | (d[q + (r >> 1) + 1] << 16)) : d[q + (r >> 1)];
        *(u32x4*)(CP + r * CS + tid * 8) = ov;
      }
    }
    __syncthreads();
    float rn;
    {
      constexpr int NTB = LAT ? 128 : 32;
      const float* SP = (const float*)(WS(p) + WS_END) + ((size_t)l * 160 + (LAT ? 32 : 0)) * 2048 + o * 512 + c;
      float ssum = 0.f;
      for (int tb = lane; tb < NTB; tb += 64) ssum += SP[(size_t)tb * 2048] + SP[(size_t)tb * 2048 + 1024];
#pragma unroll
      for (int off = 32; off > 0; off >>= 1) ssum += __shfl_xor(ssum, off, 64);
      rn = rsqrtf(ssum + 1e-6f);
    }
    const float bias = INP(p, 30)[(l * 2 + o) * 512 + c];
    const u16* Xs = o == 0 ? XV : O1;
    f32x4 acc[MPW];
#pragma unroll
    for (int mi = 0; mi < MPW; mi++) acc[mi] = f32x4{0.f, 0.f, 0.f, 0.f};
    const bf16x8 zero8 = {0, 0, 0, 0, 0, 0, 0, 0};
    {
      bf16x8 b_next = (fr < NV) ? *(const bf16x8*)(Xs + fr * RS + fq * 8) : zero8;
#pragma unroll 1
      for (int ks = 0; ks < NKS; ks++) {
        const bf16x8 b = b_next;
        const u16* ap = cpl - 16 * (wid * MPW) + 32 * ks;
        bf16x8 a_cur = *(const bf16x8*)(ap);
        bf16x8 a_nxt = *(const bf16x8*)(ap - 16);
        if (ks + 1 < NKS) b_next = (fr < NV) ? *(const bf16x8*)(Xs + fr * RS + (ks + 1) * 32 + fq * 8) : zero8;
#pragma unroll
        for (int mi = 0; mi < MPW; mi++) {
          bf16x8 a_n2 = a_nxt;
          if (mi + 2 < MPW) a_n2 = *(const bf16x8*)(ap - 16 * (mi + 2));
          __builtin_amdgcn_sched_barrier(0);
          acc[mi] = __builtin_amdgcn_mfma_f32_16x16x32_bf16(a_cur, b, acc[mi], 0, 0, 0);
          __builtin_amdgcn_sched_barrier(0);
          a_cur = a_nxt; a_nxt = a_n2;
        }
      }
    }
    if (fr < NV) {
      const u16* gate = GS;
      const u16* vin = o == 0 ? XV : O1;
#pragma unroll
      for (int mi = 0; mi < MPW; mi++) {
        const int t0 = (wid * MPW + mi) * 16 + fq * 4;
        u32x2 gq = *(const u32x2*)(gate + fr * RS + t0), vq = *(const u32x2*)(vin + fr * RS + t0);
        float g4[4] = {__uint_as_float(gq[0] << 16), __uint_as_float(gq[0] & 0xffff0000u), __uint_as_float(gq[1] << 16), __uint_as_float(gq[1] & 0xffff0000u)};
        float v4[4] = {__uint_as_float(vq[0] << 16), __uint_as_float(vq[0] & 0xffff0000u), __uint_as_float(vq[1] << 16), __uint_as_float(vq[1] & 0xffff0000u)};
        float r4[4];
#pragma unroll
        for (int j = 0; j < 4; j++) r4[j] = g4[j] * (acc[mi][j] * rn + bias * v4[j]);
        if (o == 0) {
          u32x2 ov; ov[0] = pack2(r4[0], r4[1]); ov[1] = pack2(r4[2], r4[3]);
          *(u32x2*)(O1 + fr * RS + t0) = ov;
        } else {
          u16* dst = LAT ? HYOT + (size_t)8192 * 512 + ((size_t)fr * 512 + c) * 1024 + t0 : HYOT + ((size_t)(sg * 16 + fr) * 512 + c) * 256 + t0;
          u32x2 ov; ov[0] = pack2(r4[0], r4[1]); ov[1] = pack2(r4[2], r4[3]);
          *(u32x2*)dst = ov;
        }
      }
    }
    __syncthreads();
  }
}

DEV void phaseD(const Params& p, int l, char* smem) {
  const int nbt = gridDim.x, bt = BID();
  __shared__ int s_task;
  unsigned* ctr = (unsigned*)(WS(p) + OFF_BAR) + 3600 + l * 8;
  if (nbt >= 128 && bt < 64) {
    s5_task(p, l, bt, smem);
    return;
  }
  const int s5lo = nbt >= 128 ? 64 : 0;
#define PULL(pool, limit, body) for (;;) { __syncthreads(); if (threadIdx.x == 0) s_task = (int)atomicAdd(&ctr[pool], 1u); __syncthreads(); \
                                           const int t = s_task; if (t >= (limit)) break; body; }
  PULL(0, 768, ret_task(p, l, t, smem))
  PULL(1, 512, hyena_mfma<true>(p, l, t, smem))
  PULL(2, 576 - s5lo, s5_task(p, l, s5lo + t, smem))
  PULL(3, 1024, hyena_mfma<false>(p, l, t, smem))
  PULL(4, 256, retstate_task(p, l, t))
#undef PULL
}

DEV void phaseE(const Params& p, char* smem) {
  const u16* HYOT = (const u16*)(WS(p) + OFF_OUT1) + (size_t)MT * 512;
  u16* HYO = (u16*)(WS(p) + OFF_OUT1);
  u16* sm = (u16*)smem;
  const int tx = TID() & 63, ty = TID() >> 6;
  for (int tile = BID(); tile < 192 * 8; tile += gridDim.x) {
    int rt = tile >> 3, c0 = (tile & 7) * 64; int row0 = rt * 64;
    const u16* src = row0 < 8192 ? HYOT + ((size_t)(row0 >> 8) * 512 + c0) * 256 + (row0 & 255)
                                 : HYOT + (size_t)8192 * 512 + ((size_t)((row0 - 8192) >> 10) * 512 + c0) * 1024 + ((row0 - 8192) & 1023);
    const int L = row0 < 8192 ? 256 : 1024;
    __syncthreads();
#pragma unroll
    for (int i = 0; i < 16; i++) { int cc = ty + i * 4; sm[cc * 66 + tx] = src[(size_t)cc * L + tx]; }
    __syncthreads();
#pragma unroll
    for (int i = 0; i < 16; i++) { int tt = ty + i * 4; HYO[(size_t)(row0 + tt) * 512 + c0 + tx] = sm[tx * 66 + tt]; }
  }
}

DEV void phaseF(const Params& p, int l, char* smem) {
  u16* sA = (u16*)smem; u16* T = (u16*)smem;
  const u16* H = (const u16*)(WS(p) + OFF_H);
  const u16* WT = (const u16*)(WS(p) + OFF_WT);
  const u16* ZA = (const u16*)(WS(p) + OFF_ZA); const u16* HYO = (const u16*)(WS(p) + OFF_OUT1);
  u16* MG = (u16*)(WS(p) + OFF_YP);
  for (int tile = BID(); tile < 96 * 16; tile += gridDim.x) {
    int tm = tile >> 4, tn = tile & 15;
    if (gridDim.x == 512) {
      const int r = tile >> 9, bb = tile & 511, x = bb & 7, j = bb >> 3;
      tm = r * 32 + (x >> 1) * 8 + (j >> 3); tn = (x & 1) * 8 + (j & 7);
    }
    int row0 = tm * 128, n0 = tn * 64;
    f32x4 a1[4][2], a2[4][2], tt[4][2];
    const u16* Hrow = H + (size_t)row0 * 1024;
    zero_acc<4, 2>(a1); zero_acc<4, 2>(tt);
#pragma unroll 1
    for (int ps = 0; ps < 7; ps++) {
      const u16* Ap; const u16* Bp; int lda, K;
      switch (ps) {
        case 0: Ap = ZA + (size_t)row0 * 2048; lda = 2048; Bp = WT + WGLU_O + (size_t)n0 * 512; K = 512; break;
        case 1: Ap = ZA + (size_t)row0 * 2048; lda = 2048; Bp = WT + WGLU_O + (size_t)(1024 + n0) * 512; K = 512; break;
        case 3: Ap = ZA + (size_t)row0 * 2048 + 512; lda = 2048; Bp = WT + WRETO_O + (size_t)n0 * 512; K = 512; break;
        case 5: Ap = HYO + (size_t)row0 * 512; lda = 512; Bp = WT + WHYO_O + (size_t)n0 * 512; K = 512; break;
        default: Ap = Hrow; lda = 1024; Bp = WT + WIN_O + (size_t)(4096 + ((ps - 2) >> 1) * 1024 + n0) * 1024; K = 1024; break;
      }
      zero_acc<4, 2>(a2);
      gemm_loop<4, 2>(Ap, lda, Bp, K, K, a2, sA);
      if (ps == 0 || ps == 3 || ps == 5) {
#pragma unroll
        for (int m = 0; m < 4; m++)
#pragma unroll
          for (int n = 0; n < 2; n++) a1[m][n] = a2[m][n];
      } else if (ps == 1) {
#pragma unroll
        for (int m = 0; m < 4; m++)
#pragma unroll
          for (int n = 0; n < 2; n++)
#pragma unroll
            for (int j = 0; j < 4; j++) a1[m][n][j] *= sigm(a2[m][n][j]);
      } else {
#pragma unroll
        for (int m = 0; m < 4; m++)
#pragma unroll
          for (int n = 0; n < 2; n++)
#pragma unroll
            for (int j = 0; j < 4; j++) tt[m][n][j] += a1[m][n][j] * sigm(a2[m][n][j]);
      }
    }
    __syncthreads();
    acc_to_lds<4, 2, 72>(tt, T, 0);
    __syncthreads();
    copy_tile<64, 72>(T, MG + (size_t)row0 * 1024 + n0, 1024);
  }
}

template <int MF, int NF>
DEV void resid_store(const Params& p, const f32x4 (&acc)[MF][NF], int l, int chunk, int row0, int col0, bool from_input) {
  const int tid = TID(), lane = tid & 63, wid = tid >> 6, wr = wid >> 1, wc = wid & 1, fr = lane & 15, fq = lane >> 4;
  float* out = OUTP(p);
#pragma unroll
  for (int m = 0; m < MF; m++) {
    const int rb = row0 + m * 32 + wr * 16 + fq * 4;
    const int j = modidx(rb);
    const float* MOD = (const float*)(WS(p) + OFF_MOD) + (l * 5 + j) * 6144 + chunk * 1024;
    const float* BM = INP(p, 7) + l * 6144 + chunk * 1024;
#pragma unroll
    for (int n = 0; n < NF; n++) {
      int col = col0 + wc * (NF * 16) + n * 16 + fr;
      float g = MOD[col] + BM[col];
#pragma unroll
      for (int jj = 0; jj < 4; jj++) {
        int row = rb + jj;
        float xo = from_input ? xin_row(p, row)[col] : out[(size_t)row * 1024 + col];
        out[(size_t)row * 1024 + col] = xo + g * acc[m][n][jj];
      }
    }
  }
}

DEV void phaseG(const Params& p, int l, char* smem) {
  u16* sA = (u16*)smem;
  const u16* MG = (const u16*)(WS(p) + OFF_YP);
  const u16* W = (const u16*)(WS(p) + OFF_WT) + WOUT_O;
  for (int tile = BID(); tile < 64 * 8; tile += gridDim.x) {
    int tm = tile >> 3, tn = tile & 7;
    f32x4 acc[6][4]; zero_acc<6, 4>(acc);
    gemm_loop<6, 4>(MG + (size_t)tm * 192 * 1024, 1024, W + (size_t)tn * 128 * 1024, 1024, 1024, acc, sA);
    resid_store<6, 4>(p, acc, l, 2, tm * 192, tn * 128, l == 0);
  }
}

DEV void phaseI(const Params& p, int l, char* smem) {
  u16* sA = (u16*)smem; u16* T = (u16*)smem;
  const u16* H = (const u16*)(WS(p) + OFF_H);
  const u16* W = (const u16*)(WS(p) + OFF_WT) + WFIN_O;
  u16* ACT = (u16*)(WS(p) + OFF_ZA);
  for (int tile = BID(); tile < 48 * 44; tile += gridDim.x) {
    int tm = tile / 44, tn = tile % 44;
    if (gridDim.x == 512) {
      const int r = tile >> 9, bb = tile & 511, x = bb & 7, j = bb >> 3;
      int sb = r * 16 + x * 2 + (j >> 5), inner = j & 31;
      if (r == 4) { sb = 64 + (bb >> 5); inner = bb & 31; }
      tm = (sb / 11) * 8 + (inner >> 2); tn = (sb % 11) * 4 + (inner & 3);
    }
    f32x4 acc[8][4]; zero_acc<8, 4>(acc);
    gemm_loop<8, 4>(H + (size_t)tm * 256 * 1024, 1024, W + (size_t)tn * 128 * 1024, 1024, 1024, acc, sA);
    const int tid = TID(), lane = tid & 63, wid = tid >> 6, wr = wid >> 1, wc = wid & 1, fr = lane & 15, fq = lane >> 4;
#pragma unroll
    for (int hh = 0; hh < 2; hh++) {
      __syncthreads();
#pragma unroll
      for (int m = 0; m < 4; m++)
#pragma unroll
        for (int n = 0; n < 2; n++)
#pragma unroll
          for (int j = 0; j < 4; j++)
            T[(m * 32 + wr * 16 + fq * 4 + j) * 72 + wc * 32 + n * 16 + fr] = f2bf(silu_(acc[hh * 4 + m][2 * n][j]) * acc[hh * 4 + m][2 * n + 1][j]);
      __syncthreads();
      copy_tile<64, 72>(T, ACT + (size_t)(tm * 256 + hh * 128) * 2816 + tn * 64, 2816);
    }
  }
}

DEV void phaseJ(const Params& p, int l, char* smem) {
  u16* sA = (u16*)smem;
  const u16* ACT = (const u16*)(WS(p) + OFF_ZA);
  const u16* W = (const u16*)(WS(p) + OFF_WT) + WFOUT_O;
  for (int tile = BID(); tile < 64 * 8; tile += gridDim.x) {
    int tm = tile >> 3, tn = tile & 7;
    f32x4 acc[6][4]; zero_acc<6, 4>(acc);
    gemm_loop<6, 4>(ACT + (size_t)tm * 192 * 2816, 2816, W + (size_t)tn * 128 * 2816, 2816, 2816, acc, sA);
    resid_store<6, 4>(p, acc, l, 5, tm * 192, tn * 128, false);
  }
}


#define XB_TMO      128
#define XB_XCNT(j)  (256  + 64 * (j))
#define XB_XSUB(j)  (1280 + 64 * (j))
#define XB_XGEN(j)  (2304 + 64 * (j))
#define XB_TOP      3328
#define XB_TOPGEN   3392
#define XB_SPIN_CAP (1u << 22)
#define LAS __attribute__((address_space(3)))
DEV unsigned xb_ld(unsigned* p) { return __hip_atomic_load(p, __ATOMIC_RELAXED, __HIP_MEMORY_SCOPE_AGENT); }
DEV unsigned xb_add(unsigned* p, unsigned v) { return __hip_atomic_fetch_add(p, v, __ATOMIC_RELAXED, __HIP_MEMORY_SCOPE_AGENT); }
DEV unsigned xb_xcc_id() { return (unsigned)__builtin_amdgcn_s_getreg((3 << 11) | 20) & 0xFu; }
#define XB_SPIN(cond, bar) do { unsigned _sp = 0; while (cond) { __builtin_amdgcn_s_sleep(1); \
    if ((++_sp & 255u) == 0u) { if (xb_ld(&(bar)[XB_TMO])) break; if (_sp > XB_SPIN_CAP) { atomicAdd(&(bar)[XB_TMO], 1u); break; } } } } while (0)
struct XcdBarrier { unsigned* bar; unsigned x; volatile LAS unsigned* st; };
DEV XcdBarrier xcd_barrier_post(unsigned* bar, volatile LAS unsigned* st) {
  XcdBarrier b; b.bar = bar; b.x = xb_xcc_id(); b.st = st;
  if (threadIdx.x == 0) (void)xb_add(&bar[XB_XCNT(b.x)], 1u);
  return b;
}
DEV void xcd_barrier_complete(unsigned* bar, unsigned x, unsigned& nloc, unsigned& nx) {
  const unsigned G = gridDim.x * gridDim.y * gridDim.z;
  unsigned sum, cnt, mine, sp = 0u;
  for (;;) {
    sum = 0u; cnt = 0u; mine = 0u;
#pragma unroll
    for (unsigned j = 0; j < 16; ++j) { const unsigned c = xb_ld(&bar[XB_XCNT(j)]); sum += c; cnt += (c > 0u) ? 1u : 0u; mine = (j == x) ? c : mine; }
    if (sum == G) break;
    __builtin_amdgcn_s_sleep(1);
    if ((++sp & 255u) == 0u) { if (xb_ld(&bar[XB_TMO])) break; if (sp > XB_SPIN_CAP) { atomicAdd(&bar[XB_TMO], 1u); break; } }
  }
  nloc = mine > 0u ? mine : 1u; nx = cnt > 0u ? cnt : 1u;
}
DEV void xcd_barrier(const XcdBarrier& b) {
  asm volatile("s_waitcnt vmcnt(0)" ::: "memory");
  __syncthreads();
  if (threadIdx.x == 0) {
    unsigned* bar = b.bar;
    __builtin_amdgcn_s_waitcnt(0);
    unsigned nloc = b.st[0], nx = b.st[1];
    if (nloc == 0u) { xcd_barrier_complete(bar, b.x, nloc, nx); b.st[0] = nloc; b.st[1] = nx; }
    const unsigned old = xb_add(&bar[XB_XSUB(b.x)], 1u);
    const unsigned gen = old / nloc;
    if (old + 1u == (gen + 1u) * nloc) {
      __builtin_amdgcn_fence(__ATOMIC_RELEASE, "agent");
      asm volatile("s_waitcnt vmcnt(0)" ::: "memory");
      const unsigned og = xb_add(&bar[XB_TOP], 1u);
      const unsigned tg = og / nx;
      if (og + 1u == (tg + 1u) * nx) xb_add(&bar[XB_TOPGEN], 1u);
      else XB_SPIN(xb_ld(&bar[XB_TOPGEN]) == tg, bar);
      __builtin_amdgcn_fence(__ATOMIC_ACQUIRE, "agent");
      xb_add(&bar[XB_XGEN(b.x)], 1u);
      asm volatile("s_waitcnt vmcnt(0)" ::: "memory");
    } else {
      XB_SPIN(xb_ld(&bar[XB_XGEN(b.x)]) == gen, bar);
      __builtin_amdgcn_fence(__ATOMIC_ACQUIRE, "agent");
      asm volatile("s_waitcnt vmcnt(0)" ::: "memory");
    }
  }
  __syncthreads();
}

constexpr int SMEM_BYTES = 57792;

DEV void run_phase(const Params& p, int ph, int l, char* smem) {
  switch (ph) {
    case 0: phaseA(p, smem); break;
    case 1: norm_phase(p, l, 0); if (l == 1) layer_prep(p, 1, smem); break;
    case 2: phaseC(p, l, smem); break;
    case 3: phaseD(p, l, smem); break;
    case 4: phaseE(p, smem); break;
    case 5: phaseF(p, l, smem); break;
    case 6: phaseG(p, l, smem); break;
    case 7: norm_phase(p, l, 1); break;
    case 8: phaseI(p, l, smem); break;
    case 9: phaseJ(p, l, smem); break;
    case 10: norm_phase(p, 0, 2); break;
  }
}

#if MULTI
__global__ void __launch_bounds__(256, 2) kphase(Params p, int ph, int l) {
  __shared__ __attribute__((aligned(16))) char smem[SMEM_BYTES];
  run_phase(p, ph, l, smem);
}
#else
__global__ void __launch_bounds__(256, 2) mega(Params p) {
  __shared__ __attribute__((aligned(16))) char smem[SMEM_BYTES];
  __shared__ uint4 xb_words;
  cg::grid_group grid = cg::this_grid();
  if (threadIdx.x == 0) xb_words = make_uint4(0u, 0u, 0u, 0u);
  __syncthreads();
  XcdBarrier xb = xcd_barrier_post((unsigned*)(p.ws + OFF_BAR), (volatile LAS unsigned*)&xb_words);
  run_phase(p, 0, 0, smem);
  grid.sync();
  for (int l = 0; l < 2; l++) {
    for (int ph = 1; ph <= 9; ph++) {
      run_phase(p, ph, l, smem);
      xcd_barrier(xb);
    }
  }
  run_phase(p, 10, 0, smem);
}
#endif

extern "C" void kernel_launch(void* const* d_in, const int* in_sizes, int n_in, void* d_out, int out_size, void* d_ws, size_t ws_size, hipStream_t stream) {
  Params p{};
  for (int i = 0; i < 36; i++) p.in[i] = (const float*)d_in[i];
  p.out = (float*)d_out;
  p.ws = (char*)d_ws;
  hipMemsetAsync((char*)d_ws + OFF_MOD, 0, ZERO_BYTES, stream);
  static int grid_blocks = 0;
#if MULTI
  if (!grid_blocks) {
    int dev = 0, cus = 0, per_cu = 0;
    hipGetDevice(&dev);
    hipDeviceGetAttribute(&cus, hipDeviceAttributeMultiprocessorCount, dev);
    hipOccupancyMaxActiveBlocksPerMultiprocessor(&per_cu, kphase, 256, 0);
    if (per_cu > 2) per_cu = 2;
    if (per_cu < 1) per_cu = 1;
    grid_blocks = cus * per_cu;
  }
  kphase<<<grid_blocks, 256, 0, stream>>>(p, 0, 0);
  for (int l = 0; l < 2; l++)
    for (int ph = 1; ph <= 9; ph++) kphase<<<grid_blocks, 256, 0, stream>>>(p, ph, l);
  kphase<<<grid_blocks, 256, 0, stream>>>(p, 10, 0);
#else
  if (!grid_blocks) {
    int dev = 0, cus = 0, per_cu = 0;
    hipGetDevice(&dev);
    hipDeviceGetAttribute(&cus, hipDeviceAttributeMultiprocessorCount, dev);
    hipOccupancyMaxActiveBlocksPerMultiprocessor(&per_cu, mega, 256, 0);
    if (per_cu > 2) per_cu = 2;
    if (per_cu < 1) per_cu = 1;
    grid_blocks = cus * per_cu;
  }
  void* args[] = {&p};
  hipError_t e = hipLaunchCooperativeKernel((void*)mega, dim3(grid_blocks), dim3(256), args, 0, stream);
  if (e != hipSuccess) fprintf(stderr, "cooperative launch failed: %s (grid %d)\n", hipGetErrorString(e), grid_blocks);
#endif
}
```

```cpp
#include <hip/hip_runtime.h>
#include <hip/hip_cooperative_groups.h>
#include <cstdio>
namespace cg = cooperative_groups;

#ifndef MULTI
#define MULTI 0
#endif

typedef unsigned short u16;
using bf16x8 = __attribute__((ext_vector_type(8))) short;
using f32x4 = __attribute__((ext_vector_type(4))) float;
using u32x4 = __attribute__((ext_vector_type(4))) unsigned;
using u32x2 = __attribute__((ext_vector_type(2))) unsigned;
#define DEV __device__ __forceinline__

constexpr int MT = 12288;
constexpr size_t OFF_WT = 0;
constexpr int WIN_O = 0, WGLU_O = 7340032, WRETO_O = 8388608, WHYO_O = 8912896, WOUT_O = 9437184, WFIN_O = 10485760, WFOUT_O = 16252928;
constexpr size_t OFF_G = 38273024;
constexpr size_t OFF_H = 48758784;
constexpr size_t OFF_ZA = 73924608;
constexpr size_t OFF_HYZ = 124256256;
constexpr size_t OFF_VT = 162004992;
constexpr size_t OFF_KT = 174587904;
constexpr size_t OFF_QR = 182976512;
constexpr size_t OFF_YP = 187170816;
constexpr size_t OFF_OUT1 = 212336640;
constexpr size_t OFF_MOD = 237502464;
constexpr size_t OFF_SUMSQ = OFF_MOD + 245760;
constexpr size_t OFF_BAR = OFF_SUMSQ + 16384;
constexpr size_t ZERO_BYTES = 245760 + 16384 + 16384;
constexpr size_t OFF_LAMBAR = OFF_BAR + 16384;
constexpr size_t OFF_BBAR = OFF_LAMBAR + 65536;
constexpr size_t OFF_CM = OFF_BBAR + 524288;
constexpr size_t OFF_ROPE = OFF_CM + 524288;
constexpr size_t OFF_S0T = OFF_ROPE + 524288;
constexpr size_t WS_END = OFF_S0T + 2097152;

struct Params {
  const float* in[36];
  float* out;
  char* ws;
};


DEV int TID() { int t = threadIdx.x; asm volatile("" : "+v"(t)); return t; }
DEV int BID() { int t = blockIdx.x; asm volatile("" : "+s"(t)); return t; }
#define GAS __attribute__((address_space(1)))
DEV char* WS(const Params& p) { unsigned long long w = (unsigned long long)p.ws; asm volatile("" : "+s"(w)); return (char*)(GAS char*)w; }
DEV float* OUTP(const Params& p) { unsigned long long w = (unsigned long long)p.out; asm volatile("" : "+s"(w)); return (float*)(GAS float*)w; }
DEV const float* INP(const Params& p, int i) { unsigned long long w = (unsigned long long)p.in[i]; asm volatile("" : "+s"(w)); return (const float*)(GAS const float*)w; }

DEV u16 f2bf(float f) { unsigned u = __float_as_uint(f); u += 0x7fffu + ((u >> 16) & 1u); return (u16)(u >> 16); }
DEV float bf2f(u16 h) { return __uint_as_float(((unsigned)h) << 16); }
DEV float sigm(float x) { return 1.f / (1.f + __expf(-x)); }
DEV float silu_(float x) { return x / (1.f + __expf(-x)); }
DEV float gelu_(float x) { float u = 0.7978845608028654f * (x + 0.044715f * x * x * x); return 0.5f * x * (1.f + tanhf(u)); }
DEV unsigned pack2(float a, float b) { return (unsigned)f2bf(a) | ((unsigned)f2bf(b) << 16); }

DEV const float* xin_row(const Params& p, int row) { return row < 8192 ? INP(p, 0) + (size_t)row * 1024 : INP(p, 1) + (size_t)(row - 8192) * 1024; }
DEV int modidx(int row) { return row < 8192 ? 0 : 1 + ((row - 8192) >> 10); }

template <int MF, int NF>
DEV void gemm_loop(const u16* __restrict__ A, int lda, const u16* __restrict__ B, int ldb, int K, f32x4 (&acc)[MF][NF], u16* sA) {
  const int tid = TID(), lane = tid & 63, wid = tid >> 6, wr = wid >> 1, wc = wid & 1, fr = lane & 15, fq = lane >> 4;
  u16* sB = sA + MF * 32 * 72;
  u32x4 ra[MF], rb[NF];
  const int crow = tid >> 3, ccol = (tid & 7) * 8;
  const u16* Ap = A + (size_t)crow * lda + ccol;
  const u16* Bp = B + (size_t)crow * ldb + ccol;
#pragma unroll
  for (int i = 0; i < MF; i++) ra[i] = *(const u32x4*)(Ap + (size_t)(i * 32) * lda);
#pragma unroll
  for (int i = 0; i < NF; i++) rb[i] = *(const u32x4*)(Bp + (size_t)(i * 32) * ldb);
  for (int k0 = 0; k0 < K; k0 += 64) {
    __syncthreads();
#pragma unroll
    for (int i = 0; i < MF; i++) *(u32x4*)(sA + (crow + i * 32) * 72 + ccol) = ra[i];
#pragma unroll
    for (int i = 0; i < NF; i++) *(u32x4*)(sB + (crow + i * 32) * 72 + ccol) = rb[i];
    __syncthreads();
    if (k0 + 64 < K) {
#pragma unroll
      for (int i = 0; i < MF; i++) ra[i] = *(const u32x4*)(Ap + (size_t)(i * 32) * lda + k0 + 64);
#pragma unroll
      for (int i = 0; i < NF; i++) rb[i] = *(const u32x4*)(Bp + (size_t)(i * 32) * ldb + k0 + 64);
    }
    {
      const u16* sAf = sA + (wr * 16 + fr) * 72 + fq * 8;
      const u16* sBf = sB + (wc * (NF * 16) + fr) * 72 + fq * 8;
      bf16x8 bvA[NF], bvB[NF];
#pragma unroll
      for (int n = 0; n < NF; n++) bvA[n] = *(const bf16x8*)(sBf + n * 16 * 72);
      bf16x8 a_cur = *(const bf16x8*)(sAf);
      bf16x8 a_nxt = *(const bf16x8*)(sAf + 32 * 72);
      __builtin_amdgcn_s_setprio(1);
#pragma unroll
      for (int st = 0; st < 2 * MF; st++) {
        const int ks = st / MF, m = st % MF;
        bf16x8 a_n2 = a_nxt;
        if (st + 2 < 2 * MF) { const int s2 = st + 2; a_n2 = *(const bf16x8*)(sAf + (s2 % MF) * 32 * 72 + (s2 / MF) * 32); }
        if (st == (MF > 3 ? MF - 3 : 0)) {
#pragma unroll
          for (int n = 0; n < NF; n++) bvB[n] = *(const bf16x8*)(sBf + n * 16 * 72 + 32);
        }
        __builtin_amdgcn_sched_barrier(0);
#pragma unroll
        for (int n = 0; n < NF; n++) acc[m][n] = __builtin_amdgcn_mfma_f32_16x16x32_bf16(a_cur, ks == 0 ? bvA[n] : bvB[n], acc[m][n], 0, 0, 0);
        __builtin_amdgcn_sched_barrier(0);
        a_cur = a_nxt; a_nxt = a_n2;
      }
      __builtin_amdgcn_s_setprio(0);
    }
  }
}

template <int MF, int NF>
DEV void zero_acc(f32x4 (&acc)[MF][NF]) {
#pragma unroll
  for (int m = 0; m < MF; m++)
#pragma unroll
    for (int n = 0; n < NF; n++) acc[m][n] = f32x4{0.f, 0.f, 0.f, 0.f};
}

DEV float epi_op(float v, int op) { return op == 1 ? v * 0.08838834764831845f : (op == 2 ? silu_(v) : v); }
template <int MF, int NF, int TS>
DEV void acc_to_lds(const f32x4 (&acc)[MF][NF], u16* T, int m0, int op = 0) {
  const int tid = TID(), lane = tid & 63, wid = tid >> 6, wr = wid >> 1, wc = wid & 1, fr = lane & 15, fq = lane >> 4;
#pragma unroll
  for (int m = 0; m < 4; m++)
#pragma unroll
    for (int n = 0; n < NF; n++)
#pragma unroll
      for (int j = 0; j < 4; j++) T[(m * 32 + wr * 16 + fq * 4 + j) * TS + wc * (NF * 16) + n * 16 + fr] = f2bf(epi_op(acc[m0 + m][n][j], op));
}
template <int MF>
DEV void acc_to_lds_T(const f32x4 (&acc)[MF][4], u16* T, int m0, int op = 0) {
  const int tid = TID(), lane = tid & 63, wid = tid >> 6, wr = wid >> 1, wc = wid & 1, fr = lane & 15, fq = lane >> 4;
#pragma unroll
  for (int m = 0; m < 4; m++)
#pragma unroll
    for (int n = 0; n < 4; n++) {
      u32x2 v; v.x = pack2(epi_op(acc[m0 + m][n][0], op), epi_op(acc[m0 + m][n][1], op)); v.y = pack2(epi_op(acc[m0 + m][n][2], op), epi_op(acc[m0 + m][n][3], op));
      *(u32x2*)(T + (wc * 64 + n * 16 + fr) * 136 + m * 32 + wr * 16 + fq * 4) = v;
    }
}
template <int COLS, int TS>
DEV void copy_tile(const u16* T, u16* dst, int ld) {
  constexpr int CPR = COLS / 8;
  constexpr int NIT = 128 * CPR / 256;
#pragma unroll
  for (int i = 0; i < NIT; i++) {
    int id = TID() + i * 256; int r = id / CPR, ch = id % CPR;
    *(u32x4*)(dst + (size_t)r * ld + ch * 8) = *(const u32x4*)(T + r * TS + ch * 8);
  }
}

DEV void transpose_tile(const float* __restrict__ src, int K, int N, u16* __restrict__ dst, int tile, float* sm, int perm = 0) {
  int nk = K >> 6; int tk = tile % nk, tn = tile / nk; int k0 = tk * 64, n0 = tn * 64;
  int tx = TID() & 63, ty = TID() >> 6;
  __syncthreads();
#pragma unroll
  for (int i = 0; i < 16; i++) { int k = ty + i * 4; sm[k * 65 + tx] = src[(size_t)(k0 + k) * N + n0 + tx]; }
  __syncthreads();
#pragma unroll
  for (int i = 0; i < 16; i++) {
    int n = n0 + ty + i * 4;
    if (perm) { int half = N >> 1; int j = n < half ? n : n - half; n = (j >> 4) * 32 + (n < half ? 0 : 16) + (j & 15); }
    dst[(size_t)n * K + k0 + tx] = f2bf(sm[tx * 65 + (ty + i * 4)]);
  }
}

DEV void wt_task(const Params& p, int l, int t, float* sm) {
  u16* WT = (u16*)(WS(p) + OFF_WT);
  const float* src; int K, N, off, tt, perm = 0;
  if (t < 1792) { src = INP(p, 10) + (size_t)l * 1024 * 7168; K = 1024; N = 7168; off = WIN_O; tt = t; }
  else if (t < 2048) { src = INP(p, 19) + (size_t)l * 512 * 2048; K = 512; N = 2048; off = WGLU_O; tt = t - 1792; }
  else if (t < 2176) { src = INP(p, 21) + (size_t)l * 512 * 1024; K = 512; N = 1024; off = WRETO_O; tt = t - 2048; }
  else if (t < 2304) { src = INP(p, 31) + (size_t)l * 512 * 1024; K = 512; N = 1024; off = WHYO_O; tt = t - 2176; }
  else if (t < 2560) { src = INP(p, 32) + (size_t)l * 1024 * 1024; K = 1024; N = 1024; off = WOUT_O; tt = t - 2304; }
  else if (t < 3968) { src = INP(p, 33) + (size_t)l * 1024 * 5632; K = 1024; N = 5632; off = WFIN_O; tt = t - 2560; perm = 1; }
  else { src = INP(p, 34) + (size_t)l * 2816 * 1024; K = 2816; N = 1024; off = WFOUT_O; tt = t - 3968; }
  transpose_tile(src, K, N, WT + off, tt, sm, perm);
}

DEV void mod_task(const Params& p, int task, float* sm) {
  int cb = task % 96; int l = task / 96;
  int tid = TID(), lane = tid & 63, kq = tid >> 6;
  __syncthreads();
  for (int i = tid; i < 5120; i += 256) {
    int j = i >> 10, k = i & 1023;
    float c = (j == 0) ? INP(p, 5)[k] : INP(p, 4)[(j - 1) * 1024 + k];
    sm[i] = silu_(c);
  }
  __syncthreads();
  int col = cb * 64 + lane;
  const float* w = INP(p, 6) + (size_t)l * 1024 * 6144 + col;
  float a0 = 0, a1 = 0, a2 = 0, a3 = 0, a4 = 0;
#pragma unroll 32
  for (int kk = 0; kk < 256; kk++) {
    int k = kk * 4 + kq;
    float wv = w[(size_t)k * 6144];
    a0 += sm[k] * wv; a1 += sm[1024 + k] * wv; a2 += sm[2048 + k] * wv; a3 += sm[3072 + k] * wv; a4 += sm[4096 + k] * wv;
  }
  float* red = sm + 5120;
  red[(kq * 5 + 0) * 64 + lane] = a0; red[(kq * 5 + 1) * 64 + lane] = a1; red[(kq * 5 + 2) * 64 + lane] = a2;
  red[(kq * 5 + 3) * 64 + lane] = a3; red[(kq * 5 + 4) * 64 + lane] = a4;
  __syncthreads();
  float* MOD = (float*)(WS(p) + OFF_MOD);
  for (int i = tid; i < 320; i += 256) {
    int j = i >> 6, cc = i & 63;
    float v = ((red[(0 * 5 + j) * 64 + cc] + red[(1 * 5 + j) * 64 + cc]) + red[(2 * 5 + j) * 64 + cc]) + red[(3 * 5 + j) * 64 + cc];
    MOD[(l * 5 + j) * 6144 + cb * 64 + cc] = v;
  }
}

DEV void filt_task(const Params& p, int l, int task, float* sm) {
  int Lsel = task >= 32; int tb = Lsel ? task - 32 : task; int L = Lsel ? 1024 : 256; int t0 = tb * 8;
  int tid = TID();
  float* z = sm; float* h1 = sm + 264; float* h2 = sm + 264 + 512;
  const float* w1 = INP(p, 24) + l * 33 * 64; const float* b1 = INP(p, 25) + l * 64;
  const float* w2 = INP(p, 26) + l * 64 * 64; const float* b2 = INP(p, 27) + l * 64;
  const float* fr0 = INP(p, 28) + l * 128; const float* fr1 = fr0 + 64;
  const float* w3 = INP(p, 29) + (size_t)l * 64 * 2048;
  __syncthreads();
  for (int i = tid; i < 264; i += 256) {
    int tt = i / 33, e = i % 33; float t = (float)(t0 + tt); float v;
    if (e == 0) v = t / (float)L;
    else {
      int b = (e - 1) & 15; float band = 1e-4f + (float)b * ((15.f - 1e-4f) / 15.f);
      float ang = (6.283185307179586f / (float)L) * t * band;
      v = (e <= 16) ? cosf(ang) : -sinf(ang);
    }
    z[i] = v;
  }
  __syncthreads();
  for (int i = tid; i < 512; i += 256) {
    int tt = i >> 6, j = i & 63; float s = b1[j];
    for (int e = 0; e < 33; e++) s += z[tt * 33 + e] * w1[e * 64 + j];
    h1[i] = sinf(fr0[j] * s);
  }
  __syncthreads();
  for (int i = tid; i < 512; i += 256) {
    int tt = i >> 6, j = i & 63; float s = b2[j];
    for (int e = 0; e < 64; e++) s += h1[tt * 64 + e] * w2[e * 64 + j];
    h2[i] = sinf(fr1[j] * s);
  }
  __syncthreads();
  float* FB = (float*)(WS(p) + OFF_G) + (Lsel ? 524288 : 0);
  float* SUMSQ = (float*)(WS(p) + WS_END);
  for (int m = 0; m < 8; m++) {
    int col = tid + m * 256;
    float acc[8];
#pragma unroll
    for (int tt = 0; tt < 8; tt++) acc[tt] = 0.f;
    for (int j = 0; j < 64; j++) {
      float w = w3[j * 2048 + col];
#pragma unroll
      for (int tt = 0; tt < 8; tt++) acc[tt] += h2[tt * 64 + j] * w;
    }
    int dir = col >> 10, o = (col >> 9) & 1, c = col & 511;
    float rate = 3.0701134573253944f + (float)c * ((15.350567286626972f - 3.0701134573253944f) / 511.f);
    float ss = 0.f;
    float* Fo = FB + (size_t)o * (2 * L) * 512 + c;
#pragma unroll
    for (int tt = 0; tt < 8; tt++) {
      int t = t0 + tt;
      float val = acc[tt] * expf(-((float)t / (float)L) * rate);
      if (dir == 0) { Fo[(size_t)(L + t) * 512] = val; ss += val * val; }
      else if (t > 0) { Fo[(size_t)(L - t) * 512] = val; ss += val * val; }
      else { Fo[0] = 0.f; }
    }
    SUMSQ[((size_t)l * 160 + task) * 2048 + col] = ss;
  }
}

DEV void s5prep_task(const Params& p, int task) {
  int idx = task * 256 + TID();
  int pp = idx & 63; int lrg = idx >> 6;
  float lre = INP(p, 11)[idx], lim = INP(p, 12)[idx];
  float dt = expf(INP(p, 13)[lrg]);
  float mag = expf(lre * dt);
  float lbr = mag * cosf(lim * dt), lbi = mag * sinf(lim * dt);
  float nr = lbr - 1.f, ni = lbi; float den = lre * lre + lim * lim;
  float cr = (nr * lre + ni * lim) / den, ci = (ni * lre - nr * lim) / den;
  u16* BBAR = (u16*)(WS(p) + OFF_BBAR); u16* CM = (u16*)(WS(p) + OFF_CM); float* LB = (float*)(WS(p) + OFF_LAMBAR);
  LB[idx * 2] = lbr; LB[idx * 2 + 1] = lbi;
  for (int c = 0; c < 16; c++) {
    float br = INP(p, 14)[(size_t)idx * 16 + c], bi = INP(p, 15)[(size_t)idx * 16 + c];
    BBAR[(size_t)lrg * 2048 + pp * 16 + c] = f2bf(cr * br - ci * bi);
    BBAR[(size_t)lrg * 2048 + (64 + pp) * 16 + c] = f2bf(cr * bi + ci * br);
    CM[(size_t)lrg * 2048 + c * 128 + pp] = f2bf(INP(p, 16)[(size_t)lrg * 1024 + c * 64 + pp]);
    CM[(size_t)lrg * 2048 + c * 128 + 64 + pp] = f2bf(-INP(p, 17)[(size_t)lrg * 1024 + c * 64 + pp]);
  }
}

DEV void rope_task(const Params& p, int task) {
  int idx = task * 256 + TID(); int t = idx >> 6, d = idx & 63; int f = d & 31;
  float inv = powf(10000.f, -(float)f / 32.f);
  float pos = (d < 32) ? (float)(t >> 6) : (float)(t & 63);
  float ang = pos * inv;
  float* R = (float*)(WS(p) + OFF_ROPE);
  R[idx * 2] = cosf(ang); R[idx * 2 + 1] = sinf(ang);
}

DEV int pull_task(unsigned* ctr, int* s_task) {
  __syncthreads();
  if (threadIdx.x == 0) *s_task = (int)atomicAdd(ctr, 1u);
  __syncthreads();
  return *s_task;
}
DEV void layer_prep(const Params& p, int l, char* smem) {
  __shared__ int s_lp;
  unsigned* ctr = (unsigned*)(WS(p) + OFF_BAR) + 3700 + l;
  for (;;) {
    const int t = pull_task(ctr, &s_lp);
    if (t >= 160 + 4672) break;
    if (t < 160) filt_task(p, l, t, (float*)smem);
    else wt_task(p, l, t - 160, (float*)smem);
  }
}
DEV void phaseA(const Params& p, char* smem) {
  __shared__ int s_pa;
  unsigned* ctr = (unsigned*)(WS(p) + OFF_BAR) + 3710;
  for (;;) {
    const int t = pull_task(ctr, &s_pa);
    if (t >= 192 + 256 + 256 + 32) break;
    if (t < 192) mod_task(p, t, (float*)smem);
    else if (t < 448) { int tt = t - 192; int mi = tt >> 2; transpose_tile(INP(p, 3) + (size_t)mi * 16384, 128, 128, (u16*)(WS(p) + OFF_S0T) + (size_t)mi * 16384, tt & 3, (float*)smem); }
    else if (t < 704) rope_task(p, t - 448);
    else s5prep_task(p, t - 704);
  }
  layer_prep(p, 0, smem);
}

DEV void norm_phase(const Params& p, int l, int which) {
  const int lane = TID() & 63;
  const int wave = (BID() * blockDim.x + TID()) >> 6, nw = (gridDim.x * blockDim.x) >> 6;
  u16* H = (u16*)(WS(p) + OFF_H);
  const float* MOD = (const float*)(WS(p) + OFF_MOD);
  for (int row = wave; row < MT; row += nw) {
    const float* x = (l == 0 && which == 0) ? xin_row(p, row) : OUTP(p) + (size_t)row * 1024;
    float4 v[4]; float ss = 0.f;
#pragma unroll
    for (int i = 0; i < 4; i++) { v[i] = *(const float4*)(x + i * 256 + lane * 4); ss += v[i].x * v[i].x + v[i].y * v[i].y + v[i].z * v[i].z + v[i].w * v[i].w; }
#pragma unroll
    for (int o = 32; o > 0; o >>= 1) ss += __shfl_xor(ss, o, 64);
    float rinv = rsqrtf(ss * (1.f / 1024.f) + 1e-6f);
    if (which == 2) {
      const float* nf = INP(p, 35);
#pragma unroll
      for (int i = 0; i < 4; i++) {
        float4 g = *(const float4*)(nf + i * 256 + lane * 4);
        float4 o; o.x = v[i].x * rinv * g.x; o.y = v[i].y * rinv * g.y; o.z = v[i].z * rinv * g.z; o.w = v[i].w * rinv * g.w;
        *(float4*)(OUTP(p) + (size_t)row * 1024 + i * 256 + lane * 4) = o;
      }
    } else {
      int j = modidx(row);
      const float* nwt = (which == 0 ? INP(p, 8) : INP(p, 9)) + l * 1024;
      const float* msh = MOD + (l * 5 + j) * 6144 + (which ? 3 : 0) * 1024;
      const float* msc = msh + 1024;
      const float* bsh = INP(p, 7) + l * 6144 + (which ? 3 : 0) * 1024;
      const float* bsc = bsh + 1024;
#pragma unroll
      for (int i = 0; i < 4; i++) {
        int k = i * 256 + lane * 4;
        float4 g = *(const float4*)(nwt + k);
        float4 sh = *(const float4*)(msh + k), sc = *(const float4*)(msc + k);
        float4 bh = *(const float4*)(bsh + k), bc = *(const float4*)(bsc + k);
        float o0 = v[i].x * rinv * g.x * (1.f + sc.x + bc.x) + sh.x + bh.x;
        float o1 = v[i].y * rinv * g.y * (1.f + sc.y + bc.y) + sh.y + bh.y;
        float o2 = v[i].z * rinv * g.z * (1.f + sc.z + bc.z) + sh.z + bh.z;
        float o3 = v[i].w * rinv * g.w * (1.f + sc.w + bc.w) + sh.w + bh.w;
        u32x2 pk; pk.x = pack2(o0, o1); pk.y = pack2(o2, o3);
        *(u32x2*)(H + (size_t)row * 1024 + k) = pk;
      }
    }
  }
}

DEV void phaseC(const Params& p, int l, char* smem) {
  u16* sA = (u16*)smem; u16* T = (u16*)smem;
  const u16* H = (const u16*)(WS(p) + OFF_H);
  const u16* WIN = (const u16*)(WS(p) + OFF_WT) + WIN_O;
  u16* ZA = (u16*)(WS(p) + OFF_ZA); u16* HYT = (u16*)(WS(p) + OFF_HYZ); u16* VT = (u16*)(WS(p) + OFF_VT);
  u16* KT = (u16*)(WS(p) + OFF_KT); u16* QR = (u16*)(WS(p) + OFF_QR);
  const float* ROPE = (const float*)(WS(p) + OFF_ROPE);
  const int tid = TID();
  for (int tile = BID(); tile < 48 * 32; tile += gridDim.x) {
    int tm = tile >> 5, tn = tile & 31;
    if (gridDim.x == 512) {
      const int r = tile >> 9, bb = tile & 511, x = bb & 7, j = bb >> 3;
      tm = r * 16 + (x >> 2) * 8 + (j >> 3); tn = (x & 3) * 8 + (j & 7);
    }
    f32x4 acc[8][4]; zero_acc<8, 4>(acc);
    gemm_loop<8, 4>(H + (size_t)tm * 256 * 1024, 1024, WIN + (size_t)tn * 128 * 1024, 1024, 1024, acc, sA);
    int kind = tn >> 2, hd = tn & 3;
    const int op = kind == 2 ? 1 : (kind == 4 ? 2 : 0);
#pragma unroll
    for (int hh = 0; hh < 2; hh++) {
      int row0 = tm * 256 + hh * 128; bool lat = row0 >= 8192;
      int seq, t0, L;
      if (!lat) { seq = row0 >> 8; t0 = row0 & 255; L = 256; } else { seq = (row0 - 8192) >> 10; t0 = (row0 - 8192) & 1023; L = 1024; }
      __syncthreads();
      if (kind == 3 || kind >= 5) {
        acc_to_lds_T<8>(acc, T, hh * 4, 0);
        __syncthreads();
        u16* dst;
        if (kind == 3) dst = lat ? VT + (size_t)8192 * 512 + (size_t)((seq * 4 + hd) * 128) * 1024 + t0 : VT + (size_t)((seq * 4 + hd) * 128) * 256 + t0;
        else dst = lat ? HYT + (size_t)8192 * 1536 + ((size_t)seq * 1536 + (tn - 20) * 128) * 1024 + t0 : HYT + ((size_t)seq * 1536 + (tn - 20) * 128) * 256 + t0;
        copy_tile<128, 136>(T, dst, L);
      } else {
        acc_to_lds<8, 4, 136>(acc, T, hh * 4, op);
        __syncthreads();
        bool roped = lat && (kind == 1 || kind == 2);
        if (!(lat && kind == 2)) {
          u16* dst;
          if (kind == 0) dst = ZA + (size_t)row0 * 2048 + hd * 128;
          else if (kind == 1) dst = ZA + (size_t)row0 * 2048 + 512 + hd * 128;
          else if (kind == 2) dst = ZA + (size_t)row0 * 2048 + 1024 + hd * 128;
          else dst = ZA + (size_t)row0 * 2048 + 1536 + hd * 128;
          copy_tile<128, 136>(T, dst, 2048);
        }
        if (roped) {
          u16* dst; int ld;
          if (kind == 1) { dst = QR + (size_t)(row0 - 8192) * 512 + hd * 128; ld = 512; }
          else { dst = ZA + (size_t)row0 * 2048 + 1024 + hd * 128; ld = 2048; }
#pragma unroll 1
          for (int i = 0; i < 4; i++) {
            int id = tid + i * 256; int r = id >> 3, ch = id & 7;
            u32x4 a = *(const u32x4*)(T + r * 136 + ch * 8);
            u32x4 b = *(const u32x4*)(T + r * 136 + 64 + ch * 8);
            const float4* cs = (const float4*)(ROPE + ((size_t)(t0 + r) * 64 + ch * 8) * 2);
            u32x4 o1, o2;
#pragma unroll
            for (int q = 0; q < 4; q++) {
              float4 c4 = cs[q];
              float x1a = __uint_as_float(a[q] << 16), x1b = __uint_as_float(a[q] & 0xffff0000u);
              float x2a = __uint_as_float(b[q] << 16), x2b = __uint_as_float(b[q] & 0xffff0000u);
              o1[q] = pack2(x1a * c4.x - x2a * c4.y, x1b * c4.z - x2b * c4.w);
              o2[q] = pack2(x1a * c4.y + x2a * c4.x, x1b * c4.w + x2b * c4.z);
            }
            *(u32x4*)(dst + (size_t)r * ld + ch * 8) = o1;
            *(u32x4*)(dst + (size_t)r * ld + 64 + ch * 8) = o2;
          }
        }
        if (kind == 2 && !lat) {
          __syncthreads();
          acc_to_lds_T<8>(acc, T, hh * 4, op);
          __syncthreads();
          copy_tile<128, 136>(T, KT + (size_t)((seq * 4 + hd) * 128) * 256 + t0, 256);
        }
      }
    }
  }
}

DEV void s5_task(const Params& p, int l, int task, char* smem) {
  const int tid = TID(), lane = tid & 63, wid = tid >> 6, fr = lane & 15, fq = lane >> 4;
  int seq, gp;
  if (task < 64) { seq = 32 + (task >> 4); gp = task & 15; } else { int t2 = task - 64; seq = t2 >> 4; gp = t2 & 15; }
  const bool lat = seq >= 32;
  const int L = lat ? 1024 : 256;
  const int row0 = lat ? 8192 + (seq - 32) * 1024 : seq * 256;
  const int grp = gp * 2 + (wid >> 1), dir = wid & 1;
  const int lrg = (l * 2 + dir) * 32 + grp;
  float* BU = (float*)(smem + wid * 12544);
  u16* HB = (u16*)(smem + wid * 12544 + 8192);
  u16* ZA = (u16*)(WS(p) + OFF_ZA);
  float* YP = (float*)(WS(p) + OFF_YP);
  const u16* BBAR = (const u16*)(WS(p) + OFF_BBAR) + (size_t)lrg * 2048;
  const u16* CM = (const u16*)(WS(p) + OFF_CM) + (size_t)lrg * 2048;
  const float* LB = (const float*)(WS(p) + OFF_LAMBAR) + ((size_t)lrg * 64 + lane) * 2;
  const float lr = LB[0], li = LB[1];
  bf16x8 bfrag[8], cfrag[4];
  const bf16x8 zero8 = {0, 0, 0, 0, 0, 0, 0, 0};
#pragma unroll
  for (int nt = 0; nt < 8; nt++) bfrag[nt] = (fq < 2) ? *(const bf16x8*)(BBAR + (nt * 16 + fr) * 16 + fq * 8) : zero8;
#pragma unroll
  for (int ks = 0; ks < 4; ks++) cfrag[ks] = *(const bf16x8*)(CM + fr * 128 + ks * 32 + fq * 8);
  float hr = 0.f, hi = 0.f;
  if (lat) {
    const float* s0 = INP(p, 2) + ((((size_t)(seq - 32) * 2 + l) * 2 + dir) * 32 + grp) * 128 + lane * 2;
    hr = s0[0]; hi = s0[1];
  }
  const float dcoef = INP(p, 18)[l * 512 + grp * 16 + fr];
  const int nch = L >> 4;
  __syncthreads();
  const int half = nch >> 1;
  bf16x8 ua_next = (fq < 2) ? *(const bf16x8*)(ZA + (size_t)(row0 + (dir ? nch - 1 : 0) * 16 + fr) * 2048 + grp * 16 + fq * 8) : zero8;
  const int tbase = dir ? 15 : 0, tstep = dir ? -1 : 1;
  for (int i = 0; i < nch; i++) {
    const int ci = dir ? nch - 1 - i : i; const int t0 = ci * 16;
    if (i == half) { asm volatile("s_waitcnt vmcnt(0)" ::: "memory"); __syncthreads(); }
    const bf16x8 ua = ua_next;
    if (i + 1 < nch) {
      const int cn = dir ? nch - 2 - i : i + 1;
      ua_next = (fq < 2) ? *(const bf16x8*)(ZA + (size_t)(row0 + cn * 16 + fr) * 2048 + grp * 16 + fq * 8) : zero8;
    }
    float oth[4] = {0.f, 0.f, 0.f, 0.f}, uu[4] = {0.f, 0.f, 0.f, 0.f};
    if (i >= half) {
#pragma unroll
      for (int j = 0; j < 4; j++) {
        size_t row = (size_t)(row0 + t0 + fq * 4 + j);
        oth[j] = YP[row * 512 + grp * 16 + fr];
        uu[j] = bf2f(ZA[row * 2048 + grp * 16 + fr]);
      }
    }
#pragma unroll
    for (int nt = 0; nt < 8; nt++) {
      f32x4 r = __builtin_amdgcn_mfma_f32_16x16x32_bf16(ua, bfrag[nt], f32x4{0.f, 0.f, 0.f, 0.f}, 0, 0, 0);
#pragma unroll
      for (int j = 0; j < 4; j++) BU[(fq * 4 + j) * 128 + nt * 16 + fr] = r[j];
    }
    asm volatile("s_waitcnt lgkmcnt(0)" ::: "memory");
#pragma unroll
    for (int tt = 0; tt < 16; tt++) {
      const int t = tbase + tstep * tt;
      float re = BU[t * 128 + lane], im = BU[t * 128 + 64 + lane];
      float nr = lr * hr - li * hi + re; float ni = lr * hi + li * hr + im;
      hr = nr; hi = ni;
      HB[t * 136 + lane] = f2bf(hr); HB[t * 136 + 64 + lane] = f2bf(hi);
    }
    asm volatile("s_waitcnt lgkmcnt(0)" ::: "memory");
    f32x4 y = {0.f, 0.f, 0.f, 0.f};
#pragma unroll
    for (int ks = 0; ks < 4; ks++) {
      bf16x8 a = *(const bf16x8*)(HB + fr * 136 + ks * 32 + fq * 8);
      y = __builtin_amdgcn_mfma_f32_16x16x32_bf16(a, cfrag[ks], y, 0, 0, 0);
    }
    asm volatile("s_waitcnt lgkmcnt(0)" ::: "memory");
    if (i < half) {
#pragma unroll
      for (int j = 0; j < 4; j++) YP[(size_t)(row0 + t0 + fq * 4 + j) * 512 + grp * 16 + fr] = y[j];
    } else {
#pragma unroll
      for (int j = 0; j < 4; j++) {
        size_t row = (size_t)(row0 + t0 + fq * 4 + j);
        float v = y[j] + oth[j] + dcoef * uu[j];
        ZA[row * 2048 + grp * 16 + fr] = f2bf(gelu_(v));
      }
    }
  }
  if (!lat) {
    float* o = OUTP(p) + 12582912 + ((((size_t)seq * 2 + l) * 2 + dir) * 32 + grp) * 128 + lane * 2;
    o[0] = hr; o[1] = hi;
  }
}

DEV void ret_task(const Params& p, int l, int task, char* smem) {
  const int tid = TID(), lane = tid & 63, wid = tid >> 6, fr = lane & 15, fq = lane >> 4;
  int seq, h, qt; bool lat;
  if (task < 256) { lat = true; seq = task >> 6; h = (task >> 4) & 3; qt = task & 15; }
  else { int t2 = task - 256; lat = false; seq = t2 >> 4; h = (t2 >> 2) & 3; qt = t2 & 3; }
  const int L = lat ? 1024 : 256;
  const int row0 = lat ? 8192 + seq * 1024 : seq * 256;
  u16* sK = (u16*)smem; u16* sV = sK + 64 * 136; u16* sP = sV + 128 * 72 + wid * 16 * 72;
  u16* ZA = (u16*)(WS(p) + OFF_ZA);
  const u16* QR = (const u16*)(WS(p) + OFF_QR);
  const u16* VT = (const u16*)(WS(p) + OFF_VT);
  const float lgf = log1pf(-expf(INP(p, 20)[(l * 2 + 0) * 4 + h])), lgb = log1pf(-expf(INP(p, 20)[(l * 2 + 1) * 4 + h]));
  const int qrow = qt * 64 + wid * 16;
  const u16* qsrc = lat ? QR + (size_t)(row0 - 8192 + qrow + fr) * 512 + h * 128 : ZA + (size_t)(row0 + qrow + fr) * 2048 + 512 + h * 128;
  bf16x8 qa[4];
#pragma unroll
  for (int ks = 0; ks < 4; ks++) qa[ks] = *(const bf16x8*)(qsrc + ks * 32 + fq * 8);
  f32x4 o[8];
#pragma unroll
  for (int n = 0; n < 8; n++) o[n] = f32x4{0.f, 0.f, 0.f, 0.f};
  const u16* Kbase = ZA + (size_t)row0 * 2048 + 1024 + h * 128;
  const u16* Vbase = lat ? VT + (size_t)8192 * 512 + (size_t)((seq * 4 + h) * 128) * 1024 : VT + (size_t)((seq * 4 + h) * 128) * 256;
  const int nkt = L >> 6;
  u32x4 kreg[4], vreg[4];
  const int kr = tid >> 4, kc = (tid & 15) * 8;
  const int ve = tid >> 3, vc = (tid & 7) * 8;
#pragma unroll
  for (int i = 0; i < 4; i++) {
    kreg[i] = *(const u32x4*)(Kbase + (size_t)(kr + 16 * i) * 2048 + kc);
    vreg[i] = *(const u32x4*)(Vbase + (size_t)(ve + 32 * i) * L + vc);
  }
  for (int jt = 0; jt < nkt; jt++) {
    __syncthreads();
#pragma unroll
    for (int i = 0; i < 4; i++) {
      *(u32x4*)(sK + (kr + 16 * i) * 136 + kc) = kreg[i];
      *(u32x4*)(sV + (ve + 32 * i) * 72 + vc) = vreg[i];
    }
    __syncthreads();
    if (jt + 1 < nkt) {
#pragma unroll
      for (int i = 0; i < 4; i++) {
        kreg[i] = *(const u32x4*)(Kbase + (size_t)((jt + 1) * 64 + kr + 16 * i) * 2048 + kc);
        vreg[i] = *(const u32x4*)(Vbase + (size_t)(ve + 32 * i) * L + (jt + 1) * 64 + vc);
      }
    }
    f32x4 s[4];
#pragma unroll
    for (int nt = 0; nt < 4; nt++) s[nt] = f32x4{0.f, 0.f, 0.f, 0.f};
    {
      const u16* kp = sK + fr * 136 + fq * 8;
      bf16x8 b_cur = *(const bf16x8*)(kp);
      bf16x8 b_nxt = *(const bf16x8*)(kp + 32);
#pragma unroll
      for (int i = 0; i < 16; i++) {
        bf16x8 b_n2 = b_nxt;
        if (i + 2 < 16) b_n2 = *(const bf16x8*)(kp + ((i + 2) >> 2) * 16 * 136 + ((i + 2) & 3) * 32);
        __builtin_amdgcn_sched_barrier(0);
        s[i >> 2] = __builtin_amdgcn_mfma_f32_16x16x32_bf16(qa[i & 3], b_cur, s[i >> 2], 0, 0, 0);
        __builtin_amdgcn_sched_barrier(0);
        b_cur = b_nxt; b_nxt = b_n2;
      }
    }
#pragma unroll
    for (int nt = 0; nt < 4; nt++)
#pragma unroll
      for (int j = 0; j < 4; j++) {
        int d = (qrow + fq * 4 + j) - (jt * 64 + nt * 16 + fr);
        float w = d >= 0 ? __expf(lgf * (float)d) : __expf(lgb * (float)(-d));
        sP[(fq * 4 + j) * 72 + nt * 16 + fr] = f2bf(s[nt][j] * w);
      }
    asm volatile("s_waitcnt lgkmcnt(0)" ::: "memory");
    {
      bf16x8 pa[2];
      pa[0] = *(const bf16x8*)(sP + fr * 72 + fq * 8);
      pa[1] = *(const bf16x8*)(sP + fr * 72 + 32 + fq * 8);
      const u16* vp = sV + fr * 72 + fq * 8;
      bf16x8 b_cur = *(const bf16x8*)(vp);
      bf16x8 b_nxt = *(const bf16x8*)(vp + 16 * 72);
#pragma unroll
      for (int i = 0; i < 16; i++) {
        bf16x8 b_n2 = b_nxt;
        if (i + 2 < 16) b_n2 = *(const bf16x8*)(vp + ((i + 2) & 7) * 16 * 72 + ((i + 2) >> 3) * 32);
        __builtin_amdgcn_sched_barrier(0);
        o[i & 7] = __builtin_amdgcn_mfma_f32_16x16x32_bf16(pa[i >> 3], b_cur, o[i & 7], 0, 0, 0);
        __builtin_amdgcn_sched_barrier(0);
        b_cur = b_nxt; b_nxt = b_n2;
      }
    }
    asm volatile("s_waitcnt lgkmcnt(0)" ::: "memory");
  }
  if (lat) {
    const u16* q0src = ZA + (size_t)(row0 + qrow + fr) * 2048 + 512 + h * 128;
    bf16x8 q0[4];
#pragma unroll
    for (int ks = 0; ks < 4; ks++) q0[ks] = *(const bf16x8*)(q0src + ks * 32 + fq * 8);
#pragma unroll 1
    for (int dir = 0; dir < 2; dir++) {
      const u16* S0 = (const u16*)(WS(p) + OFF_S0T) + (size_t)((((seq * 2 + l) * 2 + dir) * 4 + h)) * 16384;
      u16* sS = sK;
      __syncthreads();
#pragma unroll
      for (int i = 0; i < 8; i++) {
        int id = tid + i * 256; int e = id >> 4, ch = id & 15;
        *(u32x4*)(sS + e * 136 + ch * 8) = *(const u32x4*)(S0 + (size_t)e * 128 + ch * 8);
      }
      __syncthreads();
      float wj[4];
#pragma unroll
      for (int j = 0; j < 4; j++) { int gi = qrow + fq * 4 + j; wj[j] = dir == 0 ? __expf(lgf * (float)(gi + 1)) : __expf(lgb * (float)(L - 1 - gi)); }
#pragma unroll
      for (int n2 = 0; n2 < 8; n2++) {
        f32x4 tmp = {0.f, 0.f, 0.f, 0.f};
#pragma unroll
        for (int ks = 0; ks < 4; ks++) {
          bf16x8 b = *(const bf16x8*)(sS + (n2 * 16 + fr) * 136 + ks * 32 + fq * 8);
          tmp = __builtin_amdgcn_mfma_f32_16x16x32_bf16(q0[ks], b, tmp, 0, 0, 0);
        }
#pragma unroll
        for (int j = 0; j < 4; j++) o[n2][j] += wj[j] * tmp[j];
      }
    }
  }
#pragma unroll
  for (int j = 0; j < 4; j++) {
    float s = 0.f;
#pragma unroll
    for (int n2 = 0; n2 < 8; n2++) s += o[n2][j];
    s += __shfl_xor(s, 1, 64); s += __shfl_xor(s, 2, 64); s += __shfl_xor(s, 4, 64); s += __shfl_xor(s, 8, 64);
    float mean = s * (1.f / 128.f);
    float v = 0.f;
#pragma unroll
    for (int n2 = 0; n2 < 8; n2++) { float dd = o[n2][j] - mean; v += dd * dd; }
    v += __shfl_xor(v, 1, 64); v += __shfl_xor(v, 2, 64); v += __shfl_xor(v, 4, 64); v += __shfl_xor(v, 8, 64);
    float rstd = rsqrtf(v * (1.f / 128.f) + 1e-5f);
    size_t rbase = (size_t)(row0 + qrow + fq * 4 + j) * 2048;
#pragma unroll
    for (int n2 = 0; n2 < 8; n2++) {
      int e = n2 * 16 + fr;
      float gv = bf2f(ZA[rbase + 1536 + h * 128 + e]);
      ZA[rbase + 512 + h * 128 + e] = f2bf((o[n2][j] - mean) * rstd * gv);
    }
  }
}

DEV bf16x8 scale8(u32x4 raw, const float (&w)[8]) {
  union { u32x4 u; bf16x8 v; } r;
#pragma unroll
  for (int q = 0; q < 4; q++) {
    float a = __uint_as_float(raw[q] << 16) * w[q * 2], b = __uint_as_float(raw[q] & 0xffff0000u) * w[q * 2 + 1];
    r.u[q] = pack2(a, b);
  }
  return r.v;
}

DEV void retstate_task(const Params& p, int l, int task) {
  const int tid = TID(), lane = tid & 63, wid = tid >> 6, fr = lane & 15, fq = lane >> 4;
  int seq = task >> 3, h = (task >> 1) & 3, dir = task & 1;
  const u16* KT = (const u16*)(WS(p) + OFF_KT) + (size_t)((seq * 4 + h) * 128) * 256;
  const u16* VT = (const u16*)(WS(p) + OFF_VT) + (size_t)((seq * 4 + h) * 128) * 256;
  const float lg = log1pf(-expf(INP(p, 20)[(l * 2 + dir) * 4 + h]));
  f32x4 acc[2][8];
#pragma unroll
  for (int m = 0; m < 2; m++)
#pragma unroll
    for (int n = 0; n < 8; n++) acc[m][n] = f32x4{0.f, 0.f, 0.f, 0.f};
#pragma unroll 1
  for (int ks = 0; ks < 8; ks++) {
    float w[8];
#pragma unroll
    for (int jj = 0; jj < 8; jj++) { int j = ks * 32 + fq * 8 + jj; w[jj] = __expf(lg * (float)(dir == 0 ? 255 - j : j)); }
    bf16x8 a[2];
#pragma unroll
    for (int m = 0; m < 2; m++) a[m] = scale8(*(const u32x4*)(KT + (size_t)(wid * 32 + m * 16 + fr) * 256 + ks * 32 + fq * 8), w);
#pragma unroll
    for (int n = 0; n < 8; n++) {
      bf16x8 b = *(const bf16x8*)(VT + (size_t)(n * 16 + fr) * 256 + ks * 32 + fq * 8);
#pragma unroll
      for (int m = 0; m < 2; m++) acc[m][n] = __builtin_amdgcn_mfma_f32_16x16x32_bf16(a[m], b, acc[m][n], 0, 0, 0);
    }
  }
  float* o = OUTP(p) + 13107200 + ((((size_t)seq * 2 + l) * 2 + dir) * 4 + h) * 16384;
#pragma unroll
  for (int m = 0; m < 2; m++)
#pragma unroll
    for (int n = 0; n < 8; n++)
#pragma unroll
      for (int j = 0; j < 4; j++) o[(size_t)(wid * 32 + m * 16 + fq * 4 + j) * 128 + n * 16 + fr] = acc[m][n][j];
}

template <bool LAT>
DEV void hyena_mfma(const Params& p, int l, int task, char* smem) {
  constexpr int L = LAT ? 1024 : 256;
  constexpr int NV = LAT ? 4 : 16;
  constexpr int RS = L + 8, CS = 2 * L + 16;
  constexpr int MPW = L / 64, NKS = L / 32, NCH = L / 8, Lsel = LAT ? 1 : 0;
  const int tid = TID(), lane = tid & 63, wid = tid >> 6, fr = lane & 15, fq = lane >> 4;
  const int c = LAT ? task : (task >> 1);
  const int sg = LAT ? 0 : (task & 1);
  u16* CP = (u16*)smem; u16* XV = CP + 8 * CS; u16* GS = XV + NV * RS; u16* O1 = GS + NV * RS;
  const u16* HYT = (const u16*)(WS(p) + OFF_HYZ);
  u16* HYOT = (u16*)(WS(p) + OFF_OUT1) + (size_t)MT * 512;
  const float* cw = INP(p, 22) + (size_t)l * 3 * 1536; const float* cb = INP(p, 23) + l * 1536;
  auto sconv = [&](int arr, u16* dstA) {
    const int ch = arr * 512 + c;
    const float w0 = cw[ch], w1 = cw[1536 + ch], w2 = cw[3072 + ch], bb = cb[ch];
#pragma unroll
    for (int i = 0; i < (NV * NCH) / 256; i++) {
      int id = tid + i * 256; int n = id / NCH, t8 = (id % NCH) * 8;
      const u16* src = LAT ? HYT + (size_t)8192 * 1536 + ((size_t)n * 1536 + ch) * 1024 + t8 : HYT + ((size_t)(sg * 16 + n) * 1536 + ch) * 256 + t8;
      u32x4 raw = *(const u32x4*)src;
      float h[10];
      h[0] = t8 > 0 ? bf2f(src[-1]) : 0.f;
      h[9] = t8 + 8 < L ? bf2f(src[8]) : 0.f;
#pragma unroll
      for (int q = 0; q < 4; q++) { h[1 + 2 * q] = __uint_as_float(raw[q] << 16); h[2 + 2 * q] = __uint_as_float(raw[q] & 0xffff0000u); }
      u32x4 o;
#pragma unroll
      for (int q = 0; q < 4; q++) o[q] = pack2(w0 * h[2 * q] + w1 * h[2 * q + 1] + w2 * h[2 * q + 2] + bb, w0 * h[2 * q + 1] + w1 * h[2 * q + 2] + w2 * h[2 * q + 3] + bb);
      *(u32x4*)(dstA + n * RS + t8) = o;
    }
  };
  __syncthreads();
  sconv(0, GS);
  sconv(2, XV);
  const int rr = (-fr) & 7;
  const u16* cpl = CP + rr * CS + (L + 8 * fq - fr - rr);
#pragma unroll 1
  for (int o = 0; o < 2; o++) {
    if (o == 1) sconv(1, GS);
    u16* FL = o == 0 ? O1 : XV;
    const float* Gp = (const float*)(WS(p) + OFF_G) + (Lsel ? 524288 : 0) + (size_t)o * (2 * L) * 512 + c;
    if (tid < 2 * L / 8) {
      float f[8];
#pragma unroll
      for (int j = 0; j < 8; j++) { int u = tid * 8 + j; f[j] = u > 0 ? Gp[(size_t)(2 * L - u) * 512] : 0.f; }
      u32x4 v; v[0] = pack2(f[0], f[1]); v[1] = pack2(f[2], f[3]); v[2] = pack2(f[4], f[5]); v[3] = pack2(f[6], f[7]);
      *(u32x4*)(FL + tid * 8) = v;
    }
    if (tid < 2) *(u32x4*)(FL + 2 * L + tid * 8) = u32x4{0u, 0u, 0u, 0u};
    __syncthreads();
    if (tid < 2 * L / 8) {
      u32x4 a = *(const u32x4*)(FL + tid * 8), b = *(const u32x4*)(FL + tid * 8 + 8);
      unsigned d[8] = {a[0], a[1], a[2], a[3], b[0], b[1], b[2], b[3]};
#pragma unroll
      for (int r = 0; r < 8; r++) {
        u32x4 ov;
#pragma unroll
        for (int q = 0; q < 4; q++) ov[q] = (r & 1) ? ((d[q + (r >> 1)] >> 16) | (d[q + (r >> 1) + 1] << 16)) : d[q + (r >> 1)];
        *(u32x4*)(CP + r * CS + tid * 8) = ov;
      }
    }
    __syncthreads();
    float rn;
    {
      constexpr int NTB = LAT ? 128 : 32;
      const float* SP = (const float*)(WS(p) + WS_END) + ((size_t)l * 160 + (LAT ? 32 : 0)) * 2048 + o * 512 + c;
      float ssum = 0.f;
      for (int tb = lane; tb < NTB; tb += 64) ssum += SP[(size_t)tb * 2048] + SP[(size_t)tb * 2048 + 1024];
#pragma unroll
      for (int off = 32; off > 0; off >>= 1) ssum += __shfl_xor(ssum, off, 64);
      rn = rsqrtf(ssum + 1e-6f);
    }
    const float bias = INP(p, 30)[(l * 2 + o) * 512 + c];
    const u16* Xs = o == 0 ? XV : O1;
    f32x4 acc[MPW];
#pragma unroll
    for (int mi = 0; mi < MPW; mi++) acc[mi] = f32x4{0.f, 0.f, 0.f, 0.f};
    const bf16x8 zero8 = {0, 0, 0, 0, 0, 0, 0, 0};
    {
      bf16x8 b_next = (fr < NV) ? *(const bf16x8*)(Xs + fr * RS + fq * 8) : zero8;
#pragma unroll 1
      for (int ks = 0; ks < NKS; ks++) {
        const bf16x8 b = b_next;
        const u16* ap = cpl - 16 * (wid * MPW) + 32 * ks;
        bf16x8 a_cur = *(const bf16x8*)(ap);
        bf16x8 a_nxt = *(const bf16x8*)(ap - 16);
        if (ks + 1 < NKS) b_next = (fr < NV) ? *(const bf16x8*)(Xs + fr * RS + (ks + 1) * 32 + fq * 8) : zero8;
#pragma unroll
        for (int mi = 0; mi < MPW; mi++) {
          bf16x8 a_n2 = a_nxt;
          if (mi + 2 < MPW) a_n2 = *(const bf16x8*)(ap - 16 * (mi + 2));
          __builtin_amdgcn_sched_barrier(0);
          acc[mi] = __builtin_amdgcn_mfma_f32_16x16x32_bf16(a_cur, b, acc[mi], 0, 0, 0);
          __builtin_amdgcn_sched_barrier(0);
          a_cur = a_nxt; a_nxt = a_n2;
        }
      }
    }
    if (fr < NV) {
      const u16* gate = GS;
      const u16* vin = o == 0 ? XV : O1;
#pragma unroll
      for (int mi = 0; mi < MPW; mi++) {
        const int t0 = (wid * MPW + mi) * 16 + fq * 4;
        u32x2 gq = *(const u32x2*)(gate + fr * RS + t0), vq = *(const u32x2*)(vin + fr * RS + t0);
        float g4[4] = {__uint_as_float(gq[0] << 16), __uint_as_float(gq[0] & 0xffff0000u), __uint_as_float(gq[1] << 16), __uint_as_float(gq[1] & 0xffff0000u)};
        float v4[4] = {__uint_as_float(vq[0] << 16), __uint_as_float(vq[0] & 0xffff0000u), __uint_as_float(vq[1] << 16), __uint_as_float(vq[1] & 0xffff0000u)};
        float r4[4];
#pragma unroll
        for (int j = 0; j < 4; j++) r4[j] = g4[j] * (acc[mi][j] * rn + bias * v4[j]);
        if (o == 0) {
          u32x2 ov; ov[0] = pack2(r4[0], r4[1]); ov[1] = pack2(r4[2], r4[3]);
          *(u32x2*)(O1 + fr * RS + t0) = ov;
        } else {
          u16* dst = LAT ? HYOT + (size_t)8192 * 512 + ((size_t)fr * 512 + c) * 1024 + t0 : HYOT + ((size_t)(sg * 16 + fr) * 512 + c) * 256 + t0;
          u32x2 ov; ov[0] = pack2(r4[0], r4[1]); ov[1] = pack2(r4[2], r4[3]);
          *(u32x2*)dst = ov;
        }
      }
    }
    __syncthreads();
  }
}

DEV void phaseD(const Params& p, int l, char* smem) {
  const int nbt = gridDim.x, bt = BID();
  __shared__ int s_task;
  unsigned* ctr = (unsigned*)(WS(p) + OFF_BAR) + 3600 + l * 8;
  if (nbt >= 128 && bt < 64) {
    s5_task(p, l, bt, smem);
    return;
  }
  const int s5lo = nbt >= 128 ? 64 : 0;
#define PULL(pool, limit, body) for (;;) { __syncthreads(); if (threadIdx.x == 0) s_task = (int)atomicAdd(&ctr[pool], 1u); __syncthreads(); \
                                           const int t = s_task; if (t >= (limit)) break; body; }
  PULL(0, 768, ret_task(p, l, t, smem))
  PULL(1, 512, hyena_mfma<true>(p, l, t, smem))
  PULL(2, 576 - s5lo, s5_task(p, l, s5lo + t, smem))
  PULL(3, 1024, hyena_mfma<false>(p, l, t, smem))
  PULL(4, 256, retstate_task(p, l, t))
#undef PULL
}

DEV void phaseE(const Params& p, char* smem) {
  const u16* HYOT = (const u16*)(WS(p) + OFF_OUT1) + (size_t)MT * 512;
  u16* HYO = (u16*)(WS(p) + OFF_OUT1);
  u16* sm = (u16*)smem;
  const int tx = TID() & 63, ty = TID() >> 6;
  for (int tile = BID(); tile < 192 * 8; tile += gridDim.x) {
    int rt = tile >> 3, c0 = (tile & 7) * 64; int row0 = rt * 64;
    const u16* src = row0 < 8192 ? HYOT + ((size_t)(row0 >> 8) * 512 + c0) * 256 + (row0 & 255)
                                 : HYOT + (size_t)8192 * 512 + ((size_t)((row0 - 8192) >> 10) * 512 + c0) * 1024 + ((row0 - 8192) & 1023);
    const int L = row0 < 8192 ? 256 : 1024;
    __syncthreads();
#pragma unroll
    for (int i = 0; i < 16; i++) { int cc = ty + i * 4; sm[cc * 66 + tx] = src[(size_t)cc * L + tx]; }
    __syncthreads();
#pragma unroll
    for (int i = 0; i < 16; i++) { int tt = ty + i * 4; HYO[(size_t)(row0 + tt) * 512 + c0 + tx] = sm[tx * 66 + tt]; }
  }
}

DEV void phaseF(const Params& p, int l, char* smem) {
  u16* sA = (u16*)smem; u16* T = (u16*)smem;
  const u16* H = (const u16*)(WS(p) + OFF_H);
  const u16* WT = (const u16*)(WS(p) + OFF_WT);
  const u16* ZA = (const u16*)(WS(p) + OFF_ZA); const u16* HYO = (const u16*)(WS(p) + OFF_OUT1);
  u16* MG = (u16*)(WS(p) + OFF_YP);
  for (int tile = BID(); tile < 96 * 16; tile += gridDim.x) {
    int tm = tile >> 4, tn = tile & 15;
    if (gridDim.x == 512) {
      const int r = tile >> 9, bb = tile & 511, x = bb & 7, j = bb >> 3;
      tm = r * 32 + (x >> 1) * 8 + (j >> 3); tn = (x & 1) * 8 + (j & 7);
    }
    int row0 = tm * 128, n0 = tn * 64;
    f32x4 a1[4][2], a2[4][2], tt[4][2];
    const u16* Hrow = H + (size_t)row0 * 1024;
    zero_acc<4, 2>(a1); zero_acc<4, 2>(tt);
#pragma unroll 1
    for (int ps = 0; ps < 7; ps++) {
      const u16* Ap; const u16* Bp; int lda, K;
      switch (ps) {
        case 0: Ap = ZA + (size_t)row0 * 2048; lda = 2048; Bp = WT + WGLU_O + (size_t)n0 * 512; K = 512; break;
        case 1: Ap = ZA + (size_t)row0 * 2048; lda = 2048; Bp = WT + WGLU_O + (size_t)(1024 + n0) * 512; K = 512; break;
        case 3: Ap = ZA + (size_t)row0 * 2048 + 512; lda = 2048; Bp = WT + WRETO_O + (size_t)n0 * 512; K = 512; break;
        case 5: Ap = HYO + (size_t)row0 * 512; lda = 512; Bp = WT + WHYO_O + (size_t)n0 * 512; K = 512; break;
        default: Ap = Hrow; lda = 1024; Bp = WT + WIN_O + (size_t)(4096 + ((ps - 2) >> 1) * 1024 + n0) * 1024; K = 1024; break;
      }
      zero_acc<4, 2>(a2);
      gemm_loop<4, 2>(Ap, lda, Bp, K, K, a2, sA);
      if (ps == 0 || ps == 3 || ps == 5) {
#pragma unroll
        for (int m = 0; m < 4; m++)
#pragma unroll
          for (int n = 0; n < 2; n++) a1[m][n] = a2[m][n];
      } else if (ps == 1) {
#pragma unroll
        for (int m = 0; m < 4; m++)
#pragma unroll
          for (int n = 0; n < 2; n++)
#pragma unroll
            for (int j = 0; j < 4; j++) a1[m][n][j] *= sigm(a2[m][n][j]);
      } else {
#pragma unroll
        for (int m = 0; m < 4; m++)
#pragma unroll
          for (int n = 0; n < 2; n++)
#pragma unroll
            for (int j = 0; j < 4; j++) tt[m][n][j] += a1[m][n][j] * sigm(a2[m][n][j]);
      }
    }
    __syncthreads();
    acc_to_lds<4, 2, 72>(tt, T, 0);
    __syncthreads();
    copy_tile<64, 72>(T, MG + (size_t)row0 * 1024 + n0, 1024);
  }
}

template <int MF, int NF>
DEV void resid_store(const Params& p, const f32x4 (&acc)[MF][NF], int l, int chunk, int row0, int col0, bool from_input) {
  const int tid = TID(), lane = tid & 63, wid = tid >> 6, wr = wid >> 1, wc = wid & 1, fr = lane & 15, fq = lane >> 4;
  float* out = OUTP(p);
#pragma unroll
  for (int m = 0; m < MF; m++) {
    const int rb = row0 + m * 32 + wr * 16 + fq * 4;
    const int j = modidx(rb);
    const float* MOD = (const float*)(WS(p) + OFF_MOD) + (l * 5 + j) * 6144 + chunk * 1024;
    const float* BM = INP(p, 7) + l * 6144 + chunk * 1024;
#pragma unroll
    for (int n = 0; n < NF; n++) {
      int col = col0 + wc * (NF * 16) + n * 16 + fr;
      float g = MOD[col] + BM[col];
#pragma unroll
      for (int jj = 0; jj < 4; jj++) {
        int row = rb + jj;
        float xo = from_input ? xin_row(p, row)[col] : out[(size_t)row * 1024 + col];
        out[(size_t)row * 1024 + col] = xo + g * acc[m][n][jj];
      }
    }
  }
}

DEV void phaseG(const Params& p, int l, char* smem) {
  u16* sA = (u16*)smem;
  const u16* MG = (const u16*)(WS(p) + OFF_YP);
  const u16* W = (const u16*)(WS(p) + OFF_WT) + WOUT_O;
  for (int tile = BID(); tile < 64 * 8; tile += gridDim.x) {
    int tm = tile >> 3, tn = tile & 7;
    f32x4 acc[6][4]; zero_acc<6, 4>(acc);
    gemm_loop<6, 4>(MG + (size_t)tm * 192 * 1024, 1024, W + (size_t)tn * 128 * 1024, 1024, 1024, acc, sA);
    resid_store<6, 4>(p, acc, l, 2, tm * 192, tn * 128, l == 0);
  }
}

DEV void phaseI(const Params& p, int l, char* smem) {
  u16* sA = (u16*)smem; u16* T = (u16*)smem;
  const u16* H = (const u16*)(WS(p) + OFF_H);
  const u16* W = (const u16*)(WS(p) + OFF_WT) + WFIN_O;
  u16* ACT = (u16*)(WS(p) + OFF_ZA);
  for (int tile = BID(); tile < 48 * 44; tile += gridDim.x) {
    int tm = tile / 44, tn = tile % 44;
    if (gridDim.x == 512) {
      const int r = tile >> 9, bb = tile & 511, x = bb & 7, j = bb >> 3;
      int sb = r * 16 + x * 2 + (j >> 5), inner = j & 31;
      if (r == 4) { sb = 64 + (bb >> 5); inner = bb & 31; }
      tm = (sb / 11) * 8 + (inner >> 2); tn = (sb % 11) * 4 + (inner & 3);
    }
    f32x4 acc[8][4]; zero_acc<8, 4>(acc);
    gemm_loop<8, 4>(H + (size_t)tm * 256 * 1024, 1024, W + (size_t)tn * 128 * 1024, 1024, 1024, acc, sA);
    const int tid = TID(), lane = tid & 63, wid = tid >> 6, wr = wid >> 1, wc = wid & 1, fr = lane & 15, fq = lane >> 4;
#pragma unroll
    for (int hh = 0; hh < 2; hh++) {
      __syncthreads();
#pragma unroll
      for (int m = 0; m < 4; m++)
#pragma unroll
        for (int n = 0; n < 2; n++)
#pragma unroll
          for (int j = 0; j < 4; j++)
            T[(m * 32 + wr * 16 + fq * 4 + j) * 72 + wc * 32 + n * 16 + fr] = f2bf(silu_(acc[hh * 4 + m][2 * n][j]) * acc[hh * 4 + m][2 * n + 1][j]);
      __syncthreads();
      copy_tile<64, 72>(T, ACT + (size_t)(tm * 256 + hh * 128) * 2816 + tn * 64, 2816);
    }
  }
}

DEV void phaseJ(const Params& p, int l, char* smem) {
  u16* sA = (u16*)smem;
  const u16* ACT = (const u16*)(WS(p) + OFF_ZA);
  const u16* W = (const u16*)(WS(p) + OFF_WT) + WFOUT_O;
  for (int tile = BID(); tile < 64 * 8; tile += gridDim.x) {
    int tm = tile >> 3, tn = tile & 7;
    f32x4 acc[6][4]; zero_acc<6, 4>(acc);
    gemm_loop<6, 4>(ACT + (size_t)tm * 192 * 2816, 2816, W + (size_t)tn * 128 * 2816, 2816, 2816, acc, sA);
    resid_store<6, 4>(p, acc, l, 5, tm * 192, tn * 128, false);
  }
}


#define XB_TMO      128
#define XB_XCNT(j)  (256  + 64 * (j))
#define XB_XSUB(j)  (1280 + 64 * (j))
#define XB_XGEN(j)  (2304 + 64 * (j))
#define XB_TOP      3328
#define XB_TOPGEN   3392
#define XB_SPIN_CAP (1u << 22)
#define LAS __attribute__((address_space(3)))
DEV unsigned xb_ld(unsigned* p) { return __hip_atomic_load(p, __ATOMIC_RELAXED, __HIP_MEMORY_SCOPE_AGENT); }
DEV unsigned xb_add(unsigned* p, unsigned v) { return __hip_atomic_fetch_add(p, v, __ATOMIC_RELAXED, __HIP_MEMORY_SCOPE_AGENT); }
DEV unsigned xb_xcc_id() { return (unsigned)__builtin_amdgcn_s_getreg((3 << 11) | 20) & 0xFu; }
#define XB_SPIN(cond, bar) do { unsigned _sp = 0; while (cond) { __builtin_amdgcn_s_sleep(1); \
    if ((++_sp & 255u) == 0u) { if (xb_ld(&(bar)[XB_TMO])) break; if (_sp > XB_SPIN_CAP) { atomicAdd(&(bar)[XB_TMO], 1u); break; } } } } while (0)
struct XcdBarrier { unsigned* bar; unsigned x; volatile LAS unsigned* st; };
DEV XcdBarrier xcd_barrier_post(unsigned* bar, volatile LAS unsigned* st) {
  XcdBarrier b; b.bar = bar; b.x = xb_xcc_id(); b.st = st;
  if (threadIdx.x == 0) (void)xb_add(&bar[XB_XCNT(b.x)], 1u);
  return b;
}
DEV void xcd_barrier_complete(unsigned* bar, unsigned x, unsigned& nloc, unsigned& nx) {
  const unsigned G = gridDim.x * gridDim.y * gridDim.z;
  unsigned sum, cnt, mine, sp = 0u;
  for (;;) {
    sum = 0u; cnt = 0u; mine = 0u;
#pragma unroll
    for (unsigned j = 0; j < 16; ++j) { const unsigned c = xb_ld(&bar[XB_XCNT(j)]); sum += c; cnt += (c > 0u) ? 1u : 0u; mine = (j == x) ? c : mine; }
    if (sum == G) break;
    __builtin_amdgcn_s_sleep(1);
    if ((++sp & 255u) == 0u) { if (xb_ld(&bar[XB_TMO])) break; if (sp > XB_SPIN_CAP) { atomicAdd(&bar[XB_TMO], 1u); break; } }
  }
  nloc = mine > 0u ? mine : 1u; nx = cnt > 0u ? cnt : 1u;
}
DEV void xcd_barrier(const XcdBarrier& b) {
  asm volatile("s_waitcnt vmcnt(0)" ::: "memory");
  __syncthreads();
  if (threadIdx.x == 0) {
    unsigned* bar = b.bar;
    __builtin_amdgcn_s_waitcnt(0);
    unsigned nloc = b.st[0], nx = b.st[1];
    if (nloc == 0u) { xcd_barrier_complete(bar, b.x, nloc, nx); b.st[0] = nloc; b.st[1] = nx; }
    const unsigned old = xb_add(&bar[XB_XSUB(b.x)], 1u);
    const unsigned gen = old / nloc;
    if (old + 1u == (gen + 1u) * nloc) {
      __builtin_amdgcn_fence(__ATOMIC_RELEASE, "agent");
      asm volatile("s_waitcnt vmcnt(0)" ::: "memory");
      const unsigned og = xb_add(&bar[XB_TOP], 1u);
      const unsigned tg = og / nx;
      if (og + 1u == (tg + 1u) * nx) xb_add(&bar[XB_TOPGEN], 1u);
      else XB_SPIN(xb_ld(&bar[XB_TOPGEN]) == tg, bar);
      __builtin_amdgcn_fence(__ATOMIC_ACQUIRE, "agent");
      xb_add(&bar[XB_XGEN(b.x)], 1u);
      asm volatile("s_waitcnt vmcnt(0)" ::: "memory");
    } else {
      XB_SPIN(xb_ld(&bar[XB_XGEN(b.x)]) == gen, bar);
      __builtin_amdgcn_fence(__ATOMIC_ACQUIRE, "agent");
      asm volatile("s_waitcnt vmcnt(0)" ::: "memory");
    }
  }
  __syncthreads();
}

constexpr int SMEM_BYTES = 57792;

DEV void run_phase(const Params& p, int ph, int l, char* smem) {
  switch (ph) {
    case 0: phaseA(p, smem); break;
    case 1: norm_phase(p, l, 0); if (l == 1) layer_prep(p, 1, smem); break;
    case 2: phaseC(p, l, smem); break;
    case 3: phaseD(p, l, smem); break;
    case 4: phaseE(p, smem); break;
    case 5: phaseF(p, l, smem); break;
    case 6: phaseG(p, l, smem); break;
    case 7: norm_phase(p, l, 1); break;
    case 8: phaseI(p, l, smem); break;
    case 9: phaseJ(p, l, smem); break;
    case 10: norm_phase(p, 0, 2); break;
  }
}

#if MULTI
__global__ void __launch_bounds__(256, 2) kphase(Params p, int ph, int l) {
  __shared__ __attribute__((aligned(16))) char smem[SMEM_BYTES];
  run_phase(p, ph, l, smem);
}
#else
__global__ void __launch_bounds__(256, 2) mega(Params p) {
  __shared__ __attribute__((aligned(16))) char smem[SMEM_BYTES];
  __shared__ uint4 xb_words;
  cg::grid_group grid = cg::this_grid();
  if (threadIdx.x == 0) xb_words = make_uint4(0u, 0u, 0u, 0u);
  __syncthreads();
  XcdBarrier xb = xcd_barrier_post((unsigned*)(p.ws + OFF_BAR), (volatile LAS unsigned*)&xb_words);
  run_phase(p, 0, 0, smem);
  grid.sync();
  for (int l = 0; l < 2; l++) {
    for (int ph = 1; ph <= 9; ph++) {
      run_phase(p, ph, l, smem);
      xcd_barrier(xb);
    }
  }
  run_phase(p, 10, 0, smem);
}
#endif

extern "C" void kernel_launch(void* const* d_in, const int* in_sizes, int n_in, void* d_out, int out_size, void* d_ws, size_t ws_size, hipStream_t stream) {
  Params p{};
  for (int i = 0; i < 36; i++) p.in[i] = (const float*)d_in[i];
  p.out = (float*)d_out;
  p.ws = (char*)d_ws;
  hipMemsetAsync((char*)d_ws + OFF_MOD, 0, ZERO_BYTES, stream);
  static int grid_blocks = 0;
#if MULTI
  if (!grid_blocks) {
    int dev = 0, cus = 0, per_cu = 0;
    hipGetDevice(&dev);
    hipDeviceGetAttribute(&cus, hipDeviceAttributeMultiprocessorCount, dev);
    hipOccupancyMaxActiveBlocksPerMultiprocessor(&per_cu, kphase, 256, 0);
    if (per_cu > 2) per_cu = 2;
    if (per_cu < 1) per_cu = 1;
    grid_blocks = cus * per_cu;
  }
  kphase<<<grid_blocks, 256, 0, stream>>>(p, 0, 0);
  for (int l = 0; l < 2; l++)
    for (int ph = 1; ph <= 9; ph++) kphase<<<grid_blocks, 256, 0, stream>>>(p, ph, l);
  kphase<<<grid_blocks, 256, 0, stream>>>(p, 10, 0);
#else
  if (!grid_blocks) {
    int dev = 0, cus = 0, per_cu = 0;
    hipGetDevice(&dev);
    hipDeviceGetAttribute(&cus, hipDeviceAttributeMultiprocessorCount, dev);
    hipOccupancyMaxActiveBlocksPerMultiprocessor(&per_cu, mega, 256, 0);
    if (per_cu > 2) per_cu = 2;
    if (per_cu < 1) per_cu = 1;
    grid_blocks = cus * per_cu;
  }
  void* args[] = {&p};
  hipError_t e = hipLaunchCooperativeKernel((void*)mega, dim3(grid_blocks), dim3(256), args, 0, stream);
  if (e != hipSuccess) fprintf(stderr, "cooperative launch failed: %s (grid %d)\n", hipGetErrorString(e), grid_blocks);
#endif
}
```

```cpp
#include <hip/hip_runtime.h>
#include <hip/hip_cooperative_groups.h>
#include <cstdio>
namespace cg = cooperative_groups;

#ifndef MULTI
#define MULTI 0
#endif

typedef unsigned short u16;
using bf16x8 = __attribute__((ext_vector_type(8))) short;
using f32x4 = __attribute__((ext_vector_type(4))) float;
using u32x4 = __attribute__((ext_vector_type(4))) unsigned;
using u32x2 = __attribute__((ext_vector_type(2))) unsigned;
#define DEV __device__ __forceinline__

constexpr int MT = 12288;
constexpr size_t OFF_WT = 0;
constexpr int WIN_O = 0, WGLU_O = 7340032, WRETO_O = 8388608, WHYO_O = 8912896, WOUT_O = 9437184, WFIN_O = 10485760, WFOUT_O = 16252928;
constexpr size_t OFF_G = 38273024;
constexpr size_t OFF_H = 48758784;
constexpr size_t OFF_ZA = 73924608;
constexpr size_t OFF_HYZ = 124256256;
constexpr size_t OFF_VT = 162004992;
constexpr size_t OFF_KT = 174587904;
constexpr size_t OFF_QR = 182976512;
constexpr size_t OFF_YP = 187170816;
constexpr size_t OFF_OUT1 = 212336640;
constexpr size_t OFF_MOD = 237502464;
constexpr size_t OFF_SUMSQ = OFF_MOD + 245760;
constexpr size_t OFF_BAR = OFF_SUMSQ + 16384;
constexpr size_t ZERO_BYTES = 245760 + 16384 + 16384;
constexpr size_t OFF_LAMBAR = OFF_BAR + 16384;
constexpr size_t OFF_BBAR = OFF_LAMBAR + 65536;
constexpr size_t OFF_CM = OFF_BBAR + 524288;
constexpr size_t OFF_ROPE = OFF_CM + 524288;
constexpr size_t OFF_S0T = OFF_ROPE + 524288;
constexpr size_t WS_END = OFF_S0T + 2097152;

struct Params {
  const float* in[36];
  float* out;
  char* ws;
};


DEV int TID() { int t = threadIdx.x; asm volatile("" : "+v"(t)); return t; }
DEV int BID() { int t = blockIdx.x; asm volatile("" : "+s"(t)); return t; }
#define GAS __attribute__((address_space(1)))
DEV char* WS(const Params& p) { unsigned long long w = (unsigned long long)p.ws; asm volatile("" : "+s"(w)); return (char*)(GAS char*)w; }
DEV float* OUTP(const Params& p) { unsigned long long w = (unsigned long long)p.out; asm volatile("" : "+s"(w)); return (float*)(GAS float*)w; }
DEV const float* INP(const Params& p, int i) { unsigned long long w = (unsigned long long)p.in[i]; asm volatile("" : "+s"(w)); return (const float*)(GAS const float*)w; }

DEV u16 f2bf(float f) { unsigned u = __float_as_uint(f); u += 0x7fffu + ((u >> 16) & 1u); return (u16)(u >> 16); }
DEV float bf2f(u16 h) { return __uint_as_float(((unsigned)h) << 16); }
DEV float sigm(float x) { return 1.f / (1.f + __expf(-x)); }
DEV float silu_(float x) { return x / (1.f + __expf(-x)); }
DEV float gelu_(float x) { float u = 0.7978845608028654f * (x + 0.044715f * x * x * x); return 0.5f * x * (1.f + tanhf(u)); }
DEV unsigned pack2(float a, float b) { return (unsigned)f2bf(a) | ((unsigned)f2bf(b) << 16); }

DEV const float* xin_row(const Params& p, int row) { return row < 8192 ? INP(p, 0) + (size_t)row * 1024 : INP(p, 1) + (size_t)(row - 8192) * 1024; }
DEV int modidx(int row) { return row < 8192 ? 0 : 1 + ((row - 8192) >> 10); }

template <int MF, int NF>
DEV void gemm_loop(const u16* __restrict__ A, int lda, const u16* __restrict__ B, int ldb, int K, f32x4 (&acc)[MF][NF], u16* sA) {
  const int tid = TID(), lane = tid & 63, wid = tid >> 6, wr = wid >> 1, wc = wid & 1, fr = lane & 15, fq = lane >> 4;
  u16* sB = sA + MF * 32 * 72;
  u32x4 ra[MF], rb[NF];
  const int crow = tid >> 3, ccol = (tid & 7) * 8;
  const u16* Ap = A + (size_t)crow * lda + ccol;
  const u16* Bp = B + (size_t)crow * ldb + ccol;
#pragma unroll
  for (int i = 0; i < MF; i++) ra[i] = *(const u32x4*)(Ap + (size_t)(i * 32) * lda);
#pragma unroll
  for (int i = 0; i < NF; i++) rb[i] = *(const u32x4*)(Bp + (size_t)(i * 32) * ldb);
  for (int k0 = 0; k0 < K; k0 += 64) {
    __syncthreads();
#pragma unroll
    for (int i = 0; i < MF; i++) *(u32x4*)(sA + (crow + i * 32) * 72 + ccol) = ra[i];
#pragma unroll
    for (int i = 0; i < NF; i++) *(u32x4*)(sB + (crow + i * 32) * 72 + ccol) = rb[i];
    __syncthreads();
    if (k0 + 64 < K) {
#pragma unroll
      for (int i = 0; i < MF; i++) ra[i] = *(const u32x4*)(Ap + (size_t)(i * 32) * lda + k0 + 64);
#pragma unroll
      for (int i = 0; i < NF; i++) rb[i] = *(const u32x4*)(Bp + (size_t)(i * 32) * ldb + k0 + 64);
    }
    {
      const u16* sAf = sA + (wr * 16 + fr) * 72 + fq * 8;
      const u16* sBf = sB + (wc * (NF * 16) + fr) * 72 + fq * 8;
      bf16x8 bvA[NF], bvB[NF];
#pragma unroll
      for (int n = 0; n < NF; n++) bvA[n] = *(const bf16x8*)(sBf + n * 16 * 72);
      bf16x8 a_cur = *(const bf16x8*)(sAf);
      bf16x8 a_nxt = *(const bf16x8*)(sAf + 32 * 72);
      __builtin_amdgcn_s_setprio(1);
#pragma unroll
      for (int st = 0; st < 2 * MF; st++) {
        const int ks = st / MF, m = st % MF;
        bf16x8 a_n2 = a_nxt;
        if (st + 2 < 2 * MF) { const int s2 = st + 2; a_n2 = *(const bf16x8*)(sAf + (s2 % MF) * 32 * 72 + (s2 / MF) * 32); }
        if (st == (MF > 3 ? MF - 3 : 0)) {
#pragma unroll
          for (int n = 0; n < NF; n++) bvB[n] = *(const bf16x8*)(sBf + n * 16 * 72 + 32);
        }
        __builtin_amdgcn_sched_barrier(0);
#pragma unroll
        for (int n = 0; n < NF; n++) acc[m][n] = __builtin_amdgcn_mfma_f32_16x16x32_bf16(a_cur, ks == 0 ? bvA[n] : bvB[n], acc[m][n], 0, 0, 0);
        __builtin_amdgcn_sched_barrier(0);
        a_cur = a_nxt; a_nxt = a_n2;
      }
      __builtin_amdgcn_s_setprio(0);
    }
  }
}

template <int MF, int NF>
DEV void zero_acc(f32x4 (&acc)[MF][NF]) {
#pragma unroll
  for (int m = 0; m < MF; m++)
#pragma unroll
    for (int n = 0; n < NF; n++) acc[m][n] = f32x4{0.f, 0.f, 0.f, 0.f};
}

DEV float epi_op(float v, int op) { return op == 1 ? v * 0.08838834764831845f : (op == 2 ? silu_(v) : v); }
template <int MF, int NF, int TS>
DEV void acc_to_lds(const f32x4 (&acc)[MF][NF], u16* T, int m0, int op = 0) {
  const int tid = TID(), lane = tid & 63, wid = tid >> 6, wr = wid >> 1, wc = wid & 1, fr = lane & 15, fq = lane >> 4;
#pragma unroll
  for (int m = 0; m < 4; m++)
#pragma unroll
    for (int n = 0; n < NF; n++)
#pragma unroll
      for (int j = 0; j < 4; j++) T[(m * 32 + wr * 16 + fq * 4 + j) * TS + wc * (NF * 16) + n * 16 + fr] = f2bf(epi_op(acc[m0 + m][n][j], op));
}
template <int MF>
DEV void acc_to_lds_T(const f32x4 (&acc)[MF][4], u16* T, int m0, int op = 0) {
  const int tid = TID(), lane = tid & 63, wid = tid >> 6, wr = wid >> 1, wc = wid & 1, fr = lane & 15, fq = lane >> 4;
#pragma unroll
  for (int m = 0; m < 4; m++)
#pragma unroll
    for (int n = 0; n < 4; n++) {
      u32x2 v; v.x = pack2(epi_op(acc[m0 + m][n][0], op), epi_op(acc[m0 + m][n][1], op)); v.y = pack2(epi_op(acc[m0 + m][n][2], op), epi_op(acc[m0 + m][n][3], op));
      *(u32x2*)(T + (wc * 64 + n * 16 + fr) * 136 + m * 32 + wr * 16 + fq * 4) = v;
    }
}
template <int COLS, int TS>
DEV void copy_tile(const u16* T, u16* dst, int ld) {
  constexpr int CPR = COLS / 8;
  constexpr int NIT = 128 * CPR / 256;
#pragma unroll
  for (int i = 0; i < NIT; i++) {
    int id = TID() + i * 256; int r = id / CPR, ch = id % CPR;
    *(u32x4*)(dst + (size_t)r * ld + ch * 8) = *(const u32x4*)(T + r * TS + ch * 8);
  }
}

DEV void transpose_tile(const float* __restrict__ src, int K, int N, u16* __restrict__ dst, int tile, float* sm, int perm = 0) {
  int nk = K >> 6; int tk = tile % nk, tn = tile / nk; int k0 = tk * 64, n0 = tn * 64;
  int tx = TID() & 63, ty = TID() >> 6;
  __syncthreads();
#pragma unroll
  for (int i = 0; i < 16; i++) { int k = ty + i * 4; sm[k * 65 + tx] = src[(size_t)(k0 + k) * N + n0 + tx]; }
  __syncthreads();
#pragma unroll
  for (int i = 0; i < 16; i++) {
    int n = n0 + ty + i * 4;
    if (perm) { int half = N >> 1; int j = n < half ? n : n - half; n = (j >> 4) * 32 + (n < half ? 0 : 16) + (j & 15); }
    dst[(size_t)n * K + k0 + tx] = f2bf(sm[tx * 65 + (ty + i * 4)]);
  }
}

DEV void wt_task(const Params& p, int l, int t, float* sm) {
  u16* WT = (u16*)(WS(p) + OFF_WT);
  const float* src; int K, N, off, tt, perm = 0;
  if (t < 1792) { src = INP(p, 10) + (size_t)l * 1024 * 7168; K = 1024; N = 7168; off = WIN_O; tt = t; }
  else if (t < 2048) { src = INP(p, 19) + (size_t)l * 512 * 2048; K = 512; N = 2048; off = WGLU_O; tt = t - 1792; }
  else if (t < 2176) { src = INP(p, 21) + (size_t)l * 512 * 1024; K = 512; N = 1024; off = WRETO_O; tt = t - 2048; }
  else if (t < 2304) { src = INP(p, 31) + (size_t)l * 512 * 1024; K = 512; N = 1024; off = WHYO_O; tt = t - 2176; }
  else if (t < 2560) { src = INP(p, 32) + (size_t)l * 1024 * 1024; K = 1024; N = 1024; off = WOUT_O; tt = t - 2304; }
  else if (t < 3968) { src = INP(p, 33) + (size_t)l * 1024 * 5632; K = 1024; N = 5632; off = WFIN_O; tt = t - 2560; perm = 1; }
  else { src = INP(p, 34) + (size_t)l * 2816 * 1024; K = 2816; N = 1024; off = WFOUT_O; tt = t - 3968; }
  transpose_tile(src, K, N, WT + off, tt, sm, perm);
}

DEV void mod_task(const Params& p, int task, float* sm) {
  int cb = task % 96; int l = task / 96;
  int tid = TID(), lane = tid & 63, kq = tid >> 6;
  __syncthreads();
  for (int i = tid; i < 5120; i += 256) {
    int j = i >> 10, k = i & 1023;
    float c = (j == 0) ? INP(p, 5)[k] : INP(p, 4)[(j - 1) * 1024 + k];
    sm[i] = silu_(c);
  }
  __syncthreads();
  int col = cb * 64 + lane;
  const float* w = INP(p, 6) + (size_t)l * 1024 * 6144 + col;
  float a0 = 0, a1 = 0, a2 = 0, a3 = 0, a4 = 0;
#pragma unroll 32
  for (int kk = 0; kk < 256; kk++) {
    int k = kk * 4 + kq;
    float wv = w[(size_t)k * 6144];
    a0 += sm[k] * wv; a1 += sm[1024 + k] * wv; a2 += sm[2048 + k] * wv; a3 += sm[3072 + k] * wv; a4 += sm[4096 + k] * wv;
  }
  float* red = sm + 5120;
  red[(kq * 5 + 0) * 64 + lane] = a0; red[(kq * 5 + 1) * 64 + lane] = a1; red[(kq * 5 + 2) * 64 + lane] = a2;
  red[(kq * 5 + 3) * 64 + lane] = a3; red[(kq * 5 + 4) * 64 + lane] = a4;
  __syncthreads();
  float* MOD = (float*)(WS(p) + OFF_MOD);
  for (int i = tid; i < 320; i += 256) {
    int j = i >> 6, cc = i & 63;
    float v = ((red[(0 * 5 + j) * 64 + cc] + red[(1 * 5 + j) * 64 + cc]) + red[(2 * 5 + j) * 64 + cc]) + red[(3 * 5 + j) * 64 + cc];
    MOD[(l * 5 + j) * 6144 + cb * 64 + cc] = v;
  }
}

DEV void filt_task(const Params& p, int l, int task, float* sm) {
  int Lsel = task >= 32; int tb = Lsel ? task - 32 : task; int L = Lsel ? 1024 : 256; int t0 = tb * 8;
  int tid = TID();
  float* z = sm; float* h1 = sm + 264; float* h2 = sm + 264 + 512;
  const float* w1 = INP(p, 24) + l * 33 * 64; const float* b1 = INP(p, 25) + l * 64;
  const float* w2 = INP(p, 26) + l * 64 * 64; const float* b2 = INP(p, 27) + l * 64;
  const float* fr0 = INP(p, 28) + l * 128; const float* fr1 = fr0 + 64;
  const float* w3 = INP(p, 29) + (size_t)l * 64 * 2048;
  __syncthreads();
  for (int i = tid; i < 264; i += 256) {
    int tt = i / 33, e = i % 33; float t = (float)(t0 + tt); float v;
    if (e == 0) v = t / (float)L;
    else {
      int b = (e - 1) & 15; float band = 1e-4f + (float)b * ((15.f - 1e-4f) / 15.f);
      float ang = (6.283185307179586f / (float)L) * t * band;
      v = (e <= 16) ? cosf(ang) : -sinf(ang);
    }
    z[i] = v;
  }
  __syncthreads();
  for (int i = tid; i < 512; i += 256) {
    int tt = i >> 6, j = i & 63; float s = b1[j];
    for (int e = 0; e < 33; e++) s += z[tt * 33 + e] * w1[e * 64 + j];
    h1[i] = sinf(fr0[j] * s);
  }
  __syncthreads();
  for (int i = tid; i < 512; i += 256) {
    int tt = i >> 6, j = i & 63; float s = b2[j];
    for (int e = 0; e < 64; e++) s += h1[tt * 64 + e] * w2[e * 64 + j];
    h2[i] = sinf(fr1[j] * s);
  }
  __syncthreads();
  float* FB = (float*)(WS(p) + OFF_G) + (Lsel ? 524288 : 0);
  float* SUMSQ = (float*)(WS(p) + WS_END);
  for (int m = 0; m < 8; m++) {
    int col = tid + m * 256;
    float acc[8];
#pragma unroll
    for (int tt = 0; tt < 8; tt++) acc[tt] = 0.f;
    for (int j = 0; j < 64; j++) {
      float w = w3[j * 2048 + col];
#pragma unroll
      for (int tt = 0; tt < 8; tt++) acc[tt] += h2[tt * 64 + j] * w;
    }
    int dir = col >> 10, o = (col >> 9) & 1, c = col & 511;
    float rate = 3.0701134573253944f + (float)c * ((15.350567286626972f - 3.0701134573253944f) / 511.f);
    float ss = 0.f;
    float* Fo = FB + (size_t)o * (2 * L) * 512 + c;
#pragma unroll
    for (int tt = 0; tt < 8; tt++) {
      int t = t0 + tt;
      float val = acc[tt] * expf(-((float)t / (float)L) * rate);
      if (dir == 0) { Fo[(size_t)(L + t) * 512] = val; ss += val * val; }
      else if (t > 0) { Fo[(size_t)(L - t) * 512] = val; ss += val * val; }
      else { Fo[0] = 0.f; }
    }
    SUMSQ[((size_t)l * 160 + task) * 2048 + col] = ss;
  }
}

DEV void s5prep_task(const Params& p, int task) {
  int idx = task * 256 + TID();
  int pp = idx & 63; int lrg = idx >> 6;
  float lre = INP(p, 11)[idx], lim = INP(p, 12)[idx];
  float dt = expf(INP(p, 13)[lrg]);
  float mag = expf(lre * dt);
  float lbr = mag * cosf(lim * dt), lbi = mag * sinf(lim * dt);
  float nr = lbr - 1.f, ni = lbi; float den = lre * lre + lim * lim;
  float cr = (nr * lre + ni * lim) / den, ci = (ni * lre - nr * lim) / den;
  u16* BBAR = (u16*)(WS(p) + OFF_BBAR); u16* CM = (u16*)(WS(p) + OFF_CM); float* LB = (float*)(WS(p) + OFF_LAMBAR);
  LB[idx * 2] = lbr; LB[idx * 2 + 1] = lbi;
  for (int c = 0; c < 16; c++) {
    float br = INP(p, 14)[(size_t)idx * 16 + c], bi = INP(p, 15)[(size_t)idx * 16 + c];
    BBAR[(size_t)lrg * 2048 + pp * 16 + c] = f2bf(cr * br - ci * bi);
    BBAR[(size_t)lrg * 2048 + (64 + pp) * 16 + c] = f2bf(cr * bi + ci * br);
    CM[(size_t)lrg * 2048 + c * 128 + pp] = f2bf(INP(p, 16)[(size_t)lrg * 1024 + c * 64 + pp]);
    CM[(size_t)lrg * 2048 + c * 128 + 64 + pp] = f2bf(-INP(p, 17)[(size_t)lrg * 1024 + c * 64 + pp]);
  }
}

DEV void rope_task(const Params& p, int task) {
  int idx = task * 256 + TID(); int t = idx >> 6, d = idx & 63; int f = d & 31;
  float inv = powf(10000.f, -(float)f / 32.f);
  float pos = (d < 32) ? (float)(t >> 6) : (float)(t & 63);
  float ang = pos * inv;
  float* R = (float*)(WS(p) + OFF_ROPE);
  R[idx * 2] = cosf(ang); R[idx * 2 + 1] = sinf(ang);
}

DEV int pull_task(unsigned* ctr, int* s_task) {
  __syncthreads();
  if (threadIdx.x == 0) *s_task = (int)atomicAdd(ctr, 1u);
  __syncthreads();
  return *s_task;
}
DEV void layer_prep(const Params& p, int l, char* smem) {
  __shared__ int s_lp;
  unsigned* ctr = (unsigned*)(WS(p) + OFF_BAR) + 3700 + l;
  for (;;) {
    const int t = pull_task(ctr, &s_lp);
    if (t >= 160 + 4672) break;
    if (t < 160) filt_task(p, l, t, (float*)smem);
    else wt_task(p, l, t - 160, (float*)smem);
  }
}
DEV void phaseA(const Params& p, char* smem) {
  __shared__ int s_pa;
  unsigned* ctr = (unsigned*)(WS(p) + OFF_BAR) + 3710;
  for (;;) {
    const int t = pull_task(ctr, &s_pa);
    if (t >= 192 + 256 + 256 + 32) break;
    if (t < 192) mod_task(p, t, (float*)smem);
    else if (t < 448) { int tt = t - 192; int mi = tt >> 2; transpose_tile(INP(p, 3) + (size_t)mi * 16384, 128, 128, (u16*)(WS(p) + OFF_S0T) + (size_t)mi * 16384, tt & 3, (float*)smem); }
    else if (t < 704) rope_task(p, t - 448);
    else s5prep_task(p, t - 704);
  }
  layer_prep(p, 0, smem);
}

DEV void norm_phase(const Params& p, int l, int which) {
  const int lane = TID() & 63;
  const int wave = (BID() * blockDim.x + TID()) >> 6, nw = (gridDim.x * blockDim.x) >> 6;
  u16* H = (u16*)(WS(p) + OFF_H);
  const float* MOD = (const float*)(WS(p) + OFF_MOD);
  for (int row = wave; row < MT; row += nw) {
    const float* x = (l == 0 && which == 0) ? xin_row(p, row) : OUTP(p) + (size_t)row * 1024;
    float4 v[4]; float ss = 0.f;
#pragma unroll
    for (int i = 0; i < 4; i++) { v[i] = *(const float4*)(x + i * 256 + lane * 4); ss += v[i].x * v[i].x + v[i].y * v[i].y + v[i].z * v[i].z + v[i].w * v[i].w; }
#pragma unroll
    for (int o = 32; o > 0; o >>= 1) ss += __shfl_xor(ss, o, 64);
    float rinv = rsqrtf(ss * (1.f / 1024.f) + 1e-6f);
    if (which == 2) {
      const float* nf = INP(p, 35);
#pragma unroll
      for (int i = 0; i < 4; i++) {
        float4 g = *(const float4*)(nf + i * 256 + lane * 4);
        float4 o; o.x = v[i].x * rinv * g.x; o.y = v[i].y * rinv * g.y; o.z = v[i].z * rinv * g.z; o.w = v[i].w * rinv * g.w;
        *(float4*)(OUTP(p) + (size_t)row * 1024 + i * 256 + lane * 4) = o;
      }
    } else {
      int j = modidx(row);
      const float* nwt = (which == 0 ? INP(p, 8) : INP(p, 9)) + l * 1024;
      const float* msh = MOD + (l * 5 + j) * 6144 + (which ? 3 : 0) * 1024;
      const float* msc = msh + 1024;
      const float* bsh = INP(p, 7) + l * 6144 + (which ? 3 : 0) * 1024;
      const float* bsc = bsh + 1024;
#pragma unroll
      for (int i = 0; i < 4; i++) {
        int k = i * 256 + lane * 4;
        float4 g = *(const float4*)(nwt + k);
        float4 sh = *(const float4*)(msh + k), sc = *(const float4*)(msc + k);
        float4 bh = *(const float4*)(bsh + k), bc = *(const float4*)(bsc + k);
        float o0 = v[i].x * rinv * g.x * (1.f + sc.x + bc.x) + sh.x + bh.x;
        float o1 = v[i].y * rinv * g.y * (1.f + sc.y + bc.y) + sh.y + bh.y;
        float o2 = v[i].z * rinv * g.z * (1.f + sc.z + bc.z) + sh.z + bh.z;
        float o3 = v[i].w * rinv * g.w * (1.f + sc.w + bc.w) + sh.w + bh.w;
        u32x2 pk; pk.x = pack2(o0, o1); pk.y = pack2(o2, o3);
        *(u32x2*)(H + (size_t)row * 1024 + k) = pk;
      }
    }
  }
}

DEV void phaseC(const Params& p, int l, char* smem) {
  u16* sA = (u16*)smem; u16* T = (u16*)smem;
  const u16* H = (const u16*)(WS(p) + OFF_H);
  const u16* WIN = (const u16*)(WS(p) + OFF_WT) + WIN_O;
  u16* ZA = (u16*)(WS(p) + OFF_ZA); u16* HYT = (u16*)(WS(p) + OFF_HYZ); u16* VT = (u16*)(WS(p) + OFF_VT);
  u16* KT = (u16*)(WS(p) + OFF_KT); u16* QR = (u16*)(WS(p) + OFF_QR);
  const float* ROPE = (const float*)(WS(p) + OFF_ROPE);
  const int tid = TID();
  for (int tile = BID(); tile < 48 * 32; tile += gridDim.x) {
    int tm = tile >> 5, tn = tile & 31;
    if (gridDim.x == 512) {
      const int r = tile >> 9, bb = tile & 511, x = bb & 7, j = bb >> 3;
      tm = r * 16 + (x >> 2) * 8 + (j >> 3); tn = (x & 3) * 8 + (j & 7);
    }
    f32x4 acc[8][4]; zero_acc<8, 4>(acc);
    gemm_loop<8, 4>(H + (size_t)tm * 256 * 1024, 1024, WIN + (size_t)tn * 128 * 1024, 1024, 1024, acc, sA);
    int kind = tn >> 2, hd = tn & 3;
    const int op = kind == 2 ? 1 : (kind == 4 ? 2 : 0);
#pragma unroll
    for (int hh = 0; hh < 2; hh++) {
      int row0 = tm * 256 + hh * 128; bool lat = row0 >= 8192;
      int seq, t0, L;
      if (!lat) { seq = row0 >> 8; t0 = row0 & 255; L = 256; } else { seq = (row0 - 8192) >> 10; t0 = (row0 - 8192) & 1023; L = 1024; }
      __syncthreads();
      if (kind == 3 || kind >= 5) {
        acc_to_lds_T<8>(acc, T, hh * 4, 0);
        __syncthreads();
        u16* dst;
        if (kind == 3) dst = lat ? VT + (size_t)8192 * 512 + (size_t)((seq * 4 + hd) * 128) * 1024 + t0 : VT + (size_t)((seq * 4 + hd) * 128) * 256 + t0;
        else dst = lat ? HYT + (size_t)8192 * 1536 + ((size_t)seq * 1536 + (tn - 20) * 128) * 1024 + t0 : HYT + ((size_t)seq * 1536 + (tn - 20) * 128) * 256 + t0;
        copy_tile<128, 136>(T, dst, L);
      } else {
        acc_to_lds<8, 4, 136>(acc, T, hh * 4, op);
        __syncthreads();
        bool roped = lat && (kind == 1 || kind == 2);
        if (!(lat && kind == 2)) {
          u16* dst;
          if (kind == 0) dst = ZA + (size_t)row0 * 2048 + hd * 128;
          else if (kind == 1) dst = ZA + (size_t)row0 * 2048 + 512 + hd * 128;
          else if (kind == 2) dst = ZA + (size_t)row0 * 2048 + 1024 + hd * 128;
          else dst = ZA + (size_t)row0 * 2048 + 1536 + hd * 128;
          copy_tile<128, 136>(T, dst, 2048);
        }
        if (roped) {
          u16* dst; int ld;
          if (kind == 1) { dst = QR + (size_t)(row0 - 8192) * 512 + hd * 128; ld = 512; }
          else { dst = ZA + (size_t)row0 * 2048 + 1024 + hd * 128; ld = 2048; }
#pragma unroll 1
          for (int i = 0; i < 4; i++) {
            int id = tid + i * 256; int r = id >> 3, ch = id & 7;
            u32x4 a = *(const u32x4*)(T + r * 136 + ch * 8);
            u32x4 b = *(const u32x4*)(T + r * 136 + 64 + ch * 8);
            const float4* cs = (const float4*)(ROPE + ((size_t)(t0 + r) * 64 + ch * 8) * 2);
            u32x4 o1, o2;
#pragma unroll
            for (int q = 0; q < 4; q++) {
              float4 c4 = cs[q];
              float x1a = __uint_as_float(a[q] << 16), x1b = __uint_as_float(a[q] & 0xffff0000u);
              float x2a = __uint_as_float(b[q] << 16), x2b = __uint_as_float(b[q] & 0xffff0000u);
              o1[q] = pack2(x1a * c4.x - x2a * c4.y, x1b * c4.z - x2b * c4.w);
              o2[q] = pack2(x1a * c4.y + x2a * c4.x, x1b * c4.w + x2b * c4.z);
            }
            *(u32x4*)(dst + (size_t)r * ld + ch * 8) = o1;
            *(u32x4*)(dst + (size_t)r * ld + 64 + ch * 8) = o2;
          }
        }
        if (kind == 2 && !lat) {
          __syncthreads();
          acc_to_lds_T<8>(acc, T, hh * 4, op);
          __syncthreads();
          copy_tile<128, 136>(T, KT + (size_t)((seq * 4 + hd) * 128) * 256 + t0, 256);
        }
      }
    }
  }
}

DEV void s5_task(const Params& p, int l, int task, char* smem) {
  const int tid = TID(), lane = tid & 63, wid = tid >> 6, fr = lane & 15, fq = lane >> 4;
  int seq, gp;
  if (task < 64) { seq = 32 + (task >> 4); gp = task & 15; } else { int t2 = task - 64; seq = t2 >> 4; gp = t2 & 15; }
  const bool lat = seq >= 32;
  const int L = lat ? 1024 : 256;
  const int row0 = lat ? 8192 + (seq - 32) * 1024 : seq * 256;
  const int grp = gp * 2 + (wid >> 1), dir = wid & 1;
  const int lrg = (l * 2 + dir) * 32 + grp;
  float* BUT = (float*)(smem + wid * 14592);
  u16* HB = (u16*)(smem + wid * 14592 + 10240);

  u16* ZA = (u16*)(WS(p) + OFF_ZA);
  float* YP = (float*)(WS(p) + OFF_YP);
  const u16* BBAR = (const u16*)(WS(p) + OFF_BBAR) + (size_t)lrg * 2048;
  const u16* CM = (const u16*)(WS(p) + OFF_CM) + (size_t)lrg * 2048;
  const float* LB = (const float*)(WS(p) + OFF_LAMBAR) + ((size_t)lrg * 64 + lane) * 2;
  const float lr = LB[0], li = LB[1];
  bf16x8 bfrag[8], cfrag[4];
  const bf16x8 zero8 = {0, 0, 0, 0, 0, 0, 0, 0};
#pragma unroll
  for (int nt = 0; nt < 8; nt++) bfrag[nt] = (fq < 2) ? *(const bf16x8*)(BBAR + (nt * 16 + fr) * 16 + fq * 8) : zero8;
#pragma unroll
  for (int ks = 0; ks < 4; ks++) cfrag[ks] = *(const bf16x8*)(CM + fr * 128 + ks * 32 + fq * 8);
  float hr = 0.f, hi = 0.f;
  if (lat) {
    const float* s0 = INP(p, 2) + ((((size_t)(seq - 32) * 2 + l) * 2 + dir) * 32 + grp) * 128 + lane * 2;
    hr = s0[0]; hi = s0[1];
  }
  const float dcoef = INP(p, 18)[l * 512 + grp * 16 + fr];
  const int nch = L >> 4;
  __syncthreads();
  const int half = nch >> 1;
  bf16x8 ua_next = (fq < 2) ? *(const bf16x8*)(ZA + (size_t)(row0 + (dir ? nch - 1 : 0) * 16 + fr) * 2048 + grp * 16 + fq * 8) : zero8;
  const int tbase = dir ? 15 : 0, tstep = dir ? -1 : 1;
  for (int i = 0; i < nch; i++) {
    const int ci = dir ? nch - 1 - i : i; const int t0 = ci * 16;
    if (i == half) { asm volatile("s_waitcnt vmcnt(0)" ::: "memory"); __syncthreads(); }
    const bf16x8 ua = ua_next;
    if (i + 1 < nch) {
      const int cn = dir ? nch - 2 - i : i + 1;
      ua_next = (fq < 2) ? *(const bf16x8*)(ZA + (size_t)(row0 + cn * 16 + fr) * 2048 + grp * 16 + fq * 8) : zero8;
    }
    float oth[4] = {0.f, 0.f, 0.f, 0.f}, uu[4] = {0.f, 0.f, 0.f, 0.f};
    if (i >= half) {
#pragma unroll
      for (int j = 0; j < 4; j++) {
        size_t row = (size_t)(row0 + t0 + fq * 4 + j);
        oth[j] = YP[row * 512 + grp * 16 + fr];
        uu[j] = bf2f(ZA[row * 2048 + grp * 16 + fr]);
      }
    }
#pragma unroll
    for (int nt = 0; nt < 8; nt++) {
      f32x4 r = __builtin_amdgcn_mfma_f32_16x16x32_bf16(ua, bfrag[nt], f32x4{0.f, 0.f, 0.f, 0.f}, 0, 0, 0);
      *(f32x4*)(BUT + (nt * 16 + fr) * 20 + fq * 4) = r;
    }
    asm volatile("s_waitcnt lgkmcnt(0)" ::: "memory");
    f32x4 re4[4], im4[4];
#pragma unroll
    for (int q = 0; q < 4; q++) { re4[q] = *(const f32x4*)(BUT + lane * 20 + q * 4); im4[q] = *(const f32x4*)(BUT + (64 + lane) * 20 + q * 4); }
    if (dir == 0) {
#pragma unroll
      for (int t = 0; t < 16; t++) {
        float nr = lr * hr - li * hi + re4[t >> 2][t & 3]; float ni = lr * hi + li * hr + im4[t >> 2][t & 3];
        hr = nr; hi = ni;
        HB[t * 136 + lane] = f2bf(hr); HB[t * 136 + 64 + lane] = f2bf(hi);
      }
    } else {
#pragma unroll
      for (int tt = 0; tt < 16; tt++) {
        const int t = 15 - tt;
        float nr = lr * hr - li * hi + re4[t >> 2][t & 3]; float ni = lr * hi + li * hr + im4[t >> 2][t & 3];
        hr = nr; hi = ni;
        HB[t * 136 + lane] = f2bf(hr); HB[t * 136 + 64 + lane] = f2bf(hi);
      }
    }
    asm volatile("s_waitcnt lgkmcnt(0)" ::: "memory");
    f32x4 y = {0.f, 0.f, 0.f, 0.f};
#pragma unroll
    for (int ks = 0; ks < 4; ks++) {
      bf16x8 a = *(const bf16x8*)(HB + fr * 136 + ks * 32 + fq * 8);
      y = __builtin_amdgcn_mfma_f32_16x16x32_bf16(a, cfrag[ks], y, 0, 0, 0);
    }
    asm volatile("s_waitcnt lgkmcnt(0)" ::: "memory");
    if (i < half) {
#pragma unroll
      for (int j = 0; j < 4; j++) YP[(size_t)(row0 + t0 + fq * 4 + j) * 512 + grp * 16 + fr] = y[j];
    } else {
#pragma unroll
      for (int j = 0; j < 4; j++) {
        size_t row = (size_t)(row0 + t0 + fq * 4 + j);
        float v = y[j] + oth[j] + dcoef * uu[j];
        ZA[row * 2048 + grp * 16 + fr] = f2bf(gelu_(v));
      }
    }
  }
  if (!lat) {
    float* o = OUTP(p) + 12582912 + ((((size_t)seq * 2 + l) * 2 + dir) * 32 + grp) * 128 + lane * 2;
    o[0] = hr; o[1] = hi;
  }
}

DEV void ret_task(const Params& p, int l, int task, char* smem) {
  const int tid = TID(), lane = tid & 63, wid = tid >> 6, fr = lane & 15, fq = lane >> 4;
  int seq, h, qt; bool lat;
  if (task < 256) { lat = true; seq = task >> 6; h = (task >> 4) & 3; qt = task & 15; }
  else { int t2 = task - 256; lat = false; seq = t2 >> 4; h = (t2 >> 2) & 3; qt = t2 & 3; }
  const int L = lat ? 1024 : 256;
  const int row0 = lat ? 8192 + seq * 1024 : seq * 256;
  u16* sK = (u16*)smem; u16* sV = sK + 64 * 136; u16* sP = sV + 128 * 72 + wid * 16 * 72;
  u16* ZA = (u16*)(WS(p) + OFF_ZA);
  const u16* QR = (const u16*)(WS(p) + OFF_QR);
  const u16* VT = (const u16*)(WS(p) + OFF_VT);
  const float lgf = log1pf(-expf(INP(p, 20)[(l * 2 + 0) * 4 + h])), lgb = log1pf(-expf(INP(p, 20)[(l * 2 + 1) * 4 + h]));
  const int qrow = qt * 64 + wid * 16;
  const u16* qsrc = lat ? QR + (size_t)(row0 - 8192 + qrow + fr) * 512 + h * 128 : ZA + (size_t)(row0 + qrow + fr) * 2048 + 512 + h * 128;
  bf16x8 qa[4];
#pragma unroll
  for (int ks = 0; ks < 4; ks++) qa[ks] = *(const bf16x8*)(qsrc + ks * 32 + fq * 8);
  f32x4 o[8];
#pragma unroll
  for (int n = 0; n < 8; n++) o[n] = f32x4{0.f, 0.f, 0.f, 0.f};
  const u16* Kbase = ZA + (size_t)row0 * 2048 + 1024 + h * 128;
  const u16* Vbase = lat ? VT + (size_t)8192 * 512 + (size_t)((seq * 4 + h) * 128) * 1024 : VT + (size_t)((seq * 4 + h) * 128) * 256;
  const int nkt = L >> 6;
  u32x4 kreg[4], vreg[4];
  const int kr = tid >> 4, kc = (tid & 15) * 8;
  const int ve = tid >> 3, vc = (tid & 7) * 8;
#pragma unroll
  for (int i = 0; i < 4; i++) {
    kreg[i] = *(const u32x4*)(Kbase + (size_t)(kr + 16 * i) * 2048 + kc);
    vreg[i] = *(const u32x4*)(Vbase + (size_t)(ve + 32 * i) * L + vc);
  }
  for (int jt = 0; jt < nkt; jt++) {
    __syncthreads();
#pragma unroll
    for (int i = 0; i < 4; i++) {
      *(u32x4*)(sK + (kr + 16 * i) * 136 + kc) = kreg[i];
      *(u32x4*)(sV + (ve + 32 * i) * 72 + vc) = vreg[i];
    }
    __syncthreads();
    if (jt + 1 < nkt) {
#pragma unroll
      for (int i = 0; i < 4; i++) {
        kreg[i] = *(const u32x4*)(Kbase + (size_t)((jt + 1) * 64 + kr + 16 * i) * 2048 + kc);
        vreg[i] = *(const u32x4*)(Vbase + (size_t)(ve + 32 * i) * L + (jt + 1) * 64 + vc);
      }
    }
    f32x4 s[4];
#pragma unroll
    for (int nt = 0; nt < 4; nt++) s[nt] = f32x4{0.f, 0.f, 0.f, 0.f};
    {
      const u16* kp = sK + fr * 136 + fq * 8;
      bf16x8 b_cur = *(const bf16x8*)(kp);
      bf16x8 b_nxt = *(const bf16x8*)(kp + 32);
#pragma unroll
      for (int i = 0; i < 16; i++) {
        bf16x8 b_n2 = b_nxt;
        if (i + 2 < 16) b_n2 = *(const bf16x8*)(kp + ((i + 2) >> 2) * 16 * 136 + ((i + 2) & 3) * 32);
        __builtin_amdgcn_sched_barrier(0);
        s[i >> 2] = __builtin_amdgcn_mfma_f32_16x16x32_bf16(qa[i & 3], b_cur, s[i >> 2], 0, 0, 0);
        __builtin_amdgcn_sched_barrier(0);
        b_cur = b_nxt; b_nxt = b_n2;
      }
    }
#pragma unroll
    for (int nt = 0; nt < 4; nt++)
#pragma unroll
      for (int j = 0; j < 4; j++) {
        int d = (qrow + fq * 4 + j) - (jt * 64 + nt * 16 + fr);
        float w = d >= 0 ? __expf(lgf * (float)d) : __expf(lgb * (float)(-d));
        sP[(fq * 4 + j) * 72 + nt * 16 + fr] = f2bf(s[nt][j] * w);
      }
    asm volatile("s_waitcnt lgkmcnt(0)" ::: "memory");
    {
      bf16x8 pa[2];
      pa[0] = *(const bf16x8*)(sP + fr * 72 + fq * 8);
      pa[1] = *(const bf16x8*)(sP + fr * 72 + 32 + fq * 8);
      const u16* vp = sV + fr * 72 + fq * 8;
      bf16x8 b_cur = *(const bf16x8*)(vp);
      bf16x8 b_nxt = *(const bf16x8*)(vp + 16 * 72);
#pragma unroll
      for (int i = 0; i < 16; i++) {
        bf16x8 b_n2 = b_nxt;
        if (i + 2 < 16) b_n2 = *(const bf16x8*)(vp + ((i + 2) & 7) * 16 * 72 + ((i + 2) >> 3) * 32);
        __builtin_amdgcn_sched_barrier(0);
        o[i & 7] = __builtin_amdgcn_mfma_f32_16x16x32_bf16(pa[i >> 3], b_cur, o[i & 7], 0, 0, 0);
        __builtin_amdgcn_sched_barrier(0);
        b_cur = b_nxt; b_nxt = b_n2;
      }
    }
    asm volatile("s_waitcnt lgkmcnt(0)" ::: "memory");
  }
  if (lat) {
    const u16* q0src = ZA + (size_t)(row0 + qrow + fr) * 2048 + 512 + h * 128;
    bf16x8 q0[4];
#pragma unroll
    for (int ks = 0; ks < 4; ks++) q0[ks] = *(const bf16x8*)(q0src + ks * 32 + fq * 8);
#pragma unroll 1
    for (int dir = 0; dir < 2; dir++) {
      const u16* S0 = (const u16*)(WS(p) + OFF_S0T) + (size_t)((((seq * 2 + l) * 2 + dir) * 4 + h)) * 16384;
      u16* sS = sK;
      __syncthreads();
#pragma unroll
      for (int i = 0; i < 8; i++) {
        int id = tid + i * 256; int e = id >> 4, ch = id & 15;
        *(u32x4*)(sS + e * 136 + ch * 8) = *(const u32x4*)(S0 + (size_t)e * 128 + ch * 8);
      }
      __syncthreads();
      float wj[4];
#pragma unroll
      for (int j = 0; j < 4; j++) { int gi = qrow + fq * 4 + j; wj[j] = dir == 0 ? __expf(lgf * (float)(gi + 1)) : __expf(lgb * (float)(L - 1 - gi)); }
#pragma unroll
      for (int n2 = 0; n2 < 8; n2++) {
        f32x4 tmp = {0.f, 0.f, 0.f, 0.f};
#pragma unroll
        for (int ks = 0; ks < 4; ks++) {
          bf16x8 b = *(const bf16x8*)(sS + (n2 * 16 + fr) * 136 + ks * 32 + fq * 8);
          tmp = __builtin_amdgcn_mfma_f32_16x16x32_bf16(q0[ks], b, tmp, 0, 0, 0);
        }
#pragma unroll
        for (int j = 0; j < 4; j++) o[n2][j] += wj[j] * tmp[j];
      }
    }
  }
#pragma unroll
  for (int j = 0; j < 4; j++) {
    float s = 0.f;
#pragma unroll
    for (int n2 = 0; n2 < 8; n2++) s += o[n2][j];
    s += __shfl_xor(s, 1, 64); s += __shfl_xor(s, 2, 64); s += __shfl_xor(s, 4, 64); s += __shfl_xor(s, 8, 64);
    float mean = s * (1.f / 128.f);
    float v = 0.f;
#pragma unroll
    for (int n2 = 0; n2 < 8; n2++) { float dd = o[n2][j] - mean; v += dd * dd; }
    v += __shfl_xor(v, 1, 64); v += __shfl_xor(v, 2, 64); v += __shfl_xor(v, 4, 64); v += __shfl_xor(v, 8, 64);
    float rstd = rsqrtf(v * (1.f / 128.f) + 1e-5f);
    size_t rbase = (size_t)(row0 + qrow + fq * 4 + j) * 2048;
#pragma unroll
    for (int n2 = 0; n2 < 8; n2++) {
      int e = n2 * 16 + fr;
      float gv = bf2f(ZA[rbase + 1536 + h * 128 + e]);
      ZA[rbase + 512 + h * 128 + e] = f2bf((o[n2][j] - mean) * rstd * gv);
    }
  }
}

DEV bf16x8 scale8(u32x4 raw, const float (&w)[8]) {
  union { u32x4 u; bf16x8 v; } r;
#pragma unroll
  for (int q = 0; q < 4; q++) {
    float a = __uint_as_float(raw[q] << 16) * w[q * 2], b = __uint_as_float(raw[q] & 0xffff0000u) * w[q * 2 + 1];
    r.u[q] = pack2(a, b);
  }
  return r.v;
}

DEV void retstate_task(const Params& p, int l, int task) {
  const int tid = TID(), lane = tid & 63, wid = tid >> 6, fr = lane & 15, fq = lane >> 4;
  int seq = task >> 3, h = (task >> 1) & 3, dir = task & 1;
  const u16* KT = (const u16*)(WS(p) + OFF_KT) + (size_t)((seq * 4 + h) * 128) * 256;
  const u16* VT = (const u16*)(WS(p) + OFF_VT) + (size_t)((seq * 4 + h) * 128) * 256;
  const float lg = log1pf(-expf(INP(p, 20)[(l * 2 + dir) * 4 + h]));
  f32x4 acc[2][8];
#pragma unroll
  for (int m = 0; m < 2; m++)
#pragma unroll
    for (int n = 0; n < 8; n++) acc[m][n] = f32x4{0.f, 0.f, 0.f, 0.f};
#pragma unroll 1
  for (int ks = 0; ks < 8; ks++) {
    float w[8];
#pragma unroll
    for (int jj = 0; jj < 8; jj++) { int j = ks * 32 + fq * 8 + jj; w[jj] = __expf(lg * (float)(dir == 0 ? 255 - j : j)); }
    bf16x8 a[2];
#pragma unroll
    for (int m = 0; m < 2; m++) a[m] = scale8(*(const u32x4*)(KT + (size_t)(wid * 32 + m * 16 + fr) * 256 + ks * 32 + fq * 8), w);
#pragma unroll
    for (int n = 0; n < 8; n++) {
      bf16x8 b = *(const bf16x8*)(VT + (size_t)(n * 16 + fr) * 256 + ks * 32 + fq * 8);
#pragma unroll
      for (int m = 0; m < 2; m++) acc[m][n] = __builtin_amdgcn_mfma_f32_16x16x32_bf16(a[m], b, acc[m][n], 0, 0, 0);
    }
  }
  float* o = OUTP(p) + 13107200 + ((((size_t)seq * 2 + l) * 2 + dir) * 4 + h) * 16384;
#pragma unroll
  for (int m = 0; m < 2; m++)
#pragma unroll
    for (int n = 0; n < 8; n++)
#pragma unroll
      for (int j = 0; j < 4; j++) o[(size_t)(wid * 32 + m * 16 + fq * 4 + j) * 128 + n * 16 + fr] = acc[m][n][j];
}

template <bool LAT>
DEV void hyena_mfma(const Params& p, int l, int task, char* smem) {
  constexpr int L = LAT ? 1024 : 256;
  constexpr int NV = LAT ? 4 : 16;
  constexpr int RS = L + 8, CS = 2 * L + 16;
  constexpr int MPW = L / 64, NKS = L / 32, NCH = L / 8, Lsel = LAT ? 1 : 0;
  const int tid = TID(), lane = tid & 63, wid = tid >> 6, fr = lane & 15, fq = lane >> 4;
  const int c = LAT ? task : (task >> 1);
  const int sg = LAT ? 0 : (task & 1);
  u16* CP = (u16*)smem; u16* XV = CP + 8 * CS; u16* GS = XV + NV * RS; u16* O1 = GS + NV * RS;
  const u16* HYT = (const u16*)(WS(p) + OFF_HYZ);
  u16* HYOT = (u16*)(WS(p) + OFF_OUT1) + (size_t)MT * 512;
  const float* cw = INP(p, 22) + (size_t)l * 3 * 1536; const float* cb = INP(p, 23) + l * 1536;
  auto sconv = [&](int arr, u16* dstA) {
    const int ch = arr * 512 + c;
    const float w0 = cw[ch], w1 = cw[1536 + ch], w2 = cw[3072 + ch], bb = cb[ch];
#pragma unroll
    for (int i = 0; i < (NV * NCH) / 256; i++) {
      int id = tid + i * 256; int n = id / NCH, t8 = (id % NCH) * 8;
      const u16* src = LAT ? HYT + (size_t)8192 * 1536 + ((size_t)n * 1536 + ch) * 1024 + t8 : HYT + ((size_t)(sg * 16 + n) * 1536 + ch) * 256 + t8;
      u32x4 raw = *(const u32x4*)src;
      float h[10];
      h[0] = t8 > 0 ? bf2f(src[-1]) : 0.f;
      h[9] = t8 + 8 < L ? bf2f(src[8]) : 0.f;
#pragma unroll
      for (int q = 0; q < 4; q++) { h[1 + 2 * q] = __uint_as_float(raw[q] << 16); h[2 + 2 * q] = __uint_as_float(raw[q] & 0xffff0000u); }
      u32x4 o;
#pragma unroll
      for (int q = 0; q < 4; q++) o[q] = pack2(w0 * h[2 * q] + w1 * h[2 * q + 1] + w2 * h[2 * q + 2] + bb, w0 * h[2 * q + 1] + w1 * h[2 * q + 2] + w2 * h[2 * q + 3] + bb);
      *(u32x4*)(dstA + n * RS + t8) = o;
    }
  };
  __syncthreads();
  sconv(0, GS);
  sconv(2, XV);
  const int rr = (-fr) & 7;
  const u16* cpl = CP + rr * CS + (L + 8 * fq - fr - rr);
#pragma unroll 1
  for (int o = 0; o < 2; o++) {
    if (o == 1) sconv(1, GS);
    u16* FL = o == 0 ? O1 : XV;
    const float* Gp = (const float*)(WS(p) + OFF_G) + (Lsel ? 524288 : 0) + (size_t)o * (2 * L) * 512 + c;
    if (tid < 2 * L / 8) {
      float f[8];
#pragma unroll
      for (int j = 0; j < 8; j++) { int u = tid * 8 + j; f[j] = u > 0 ? Gp[(size_t)(2 * L - u) * 512] : 0.f; }
      u32x4 v; v[0] = pack2(f[0], f[1]); v[1] = pack2(f[2], f[3]); v[2] = pack2(f[4], f[5]); v[3] = pack2(f[6], f[7]);
      *(u32x4*)(FL + tid * 8) = v;
    }
    if (tid < 2) *(u32x4*)(FL + 2 * L + tid * 8) = u32x4{0u, 0u, 0u, 0u};
    __syncthreads();
    if (tid < 2 * L / 8) {
      u32x4 a = *(const u32x4*)(FL + tid * 8), b = *(const u32x4*)(FL + tid * 8 + 8);
      unsigned d[8] = {a[0], a[1], a[2], a[3], b[0], b[1], b[2], b[3]};
#pragma unroll
      for (int r = 0; r < 8; r++) {
        u32x4 ov;
#pragma unroll
        for (int q = 0; q < 4; q++) ov[q] = (r & 1) ? ((d[q + (r >> 1)] >> 16) | (d[q + (r >> 1) + 1] << 16)) : d[q + (r >> 1)];
        *(u32x4*)(CP + r * CS + tid * 8) = ov;
      }
    }
    __syncthreads();
    float rn;
    {
      constexpr int NTB = LAT ? 128 : 32;
      const float* SP = (const float*)(WS(p) + WS_END) + ((size_t)l * 160 + (LAT ? 32 : 0)) * 2048 + o * 512 + c;
      float ssum = 0.f;
      for (int tb = lane; tb < NTB; tb += 64) ssum += SP[(size_t)tb * 2048] + SP[(size_t)tb * 2048 + 1024];
#pragma unroll
      for (int off = 32; off > 0; off >>= 1) ssum += __shfl_xor(ssum, off, 64);
      rn = rsqrtf(ssum + 1e-6f);
    }
    const float bias = INP(p, 30)[(l * 2 + o) * 512 + c];
    const u16* Xs = o == 0 ? XV : O1;
    f32x4 acc[MPW];
#pragma unroll
    for (int mi = 0; mi < MPW; mi++) acc[mi] = f32x4{0.f, 0.f, 0.f, 0.f};
    const bf16x8 zero8 = {0, 0, 0, 0, 0, 0, 0, 0};
    {
      bf16x8 b_next = (fr < NV) ? *(const bf16x8*)(Xs + fr * RS + fq * 8) : zero8;
#pragma unroll 1
      for (int ks = 0; ks < NKS; ks++) {
        const bf16x8 b = b_next;
        const u16* ap = cpl - 16 * (wid * MPW) + 32 * ks;
        bf16x8 a_cur = *(const bf16x8*)(ap);
        bf16x8 a_nxt = *(const bf16x8*)(ap - 16);
        if (ks + 1 < NKS) b_next = (fr < NV) ? *(const bf16x8*)(Xs + fr * RS + (ks + 1) * 32 + fq * 8) : zero8;
#pragma unroll
        for (int mi = 0; mi < MPW; mi++) {
          bf16x8 a_n2 = a_nxt;
          if (mi + 2 < MPW) a_n2 = *(const bf16x8*)(ap - 16 * (mi + 2));
          __builtin_amdgcn_sched_barrier(0);
          acc[mi] = __builtin_amdgcn_mfma_f32_16x16x32_bf16(a_cur, b, acc[mi], 0, 0, 0);
          __builtin_amdgcn_sched_barrier(0);
          a_cur = a_nxt; a_nxt = a_n2;
        }
      }
    }
    if (fr < NV) {
      const u16* gate = GS;
      const u16* vin = o == 0 ? XV : O1;
#pragma unroll
      for (int mi = 0; mi < MPW; mi++) {
        const int t0 = (wid * MPW + mi) * 16 + fq * 4;
        u32x2 gq = *(const u32x2*)(gate + fr * RS + t0), vq = *(const u32x2*)(vin + fr * RS + t0);
        float g4[4] = {__uint_as_float(gq[0] << 16), __uint_as_float(gq[0] & 0xffff0000u), __uint_as_float(gq[1] << 16), __uint_as_float(gq[1] & 0xffff0000u)};
        float v4[4] = {__uint_as_float(vq[0] << 16), __uint_as_float(vq[0] & 0xffff0000u), __uint_as_float(vq[1] << 16), __uint_as_float(vq[1] & 0xffff0000u)};
        float r4[4];
#pragma unroll
        for (int j = 0; j < 4; j++) r4[j] = g4[j] * (acc[mi][j] * rn + bias * v4[j]);
        if (o == 0) {
          u32x2 ov; ov[0] = pack2(r4[0], r4[1]); ov[1] = pack2(r4[2], r4[3]);
          *(u32x2*)(O1 + fr * RS + t0) = ov;
        } else {
          u16* dst = LAT ? HYOT + (size_t)8192 * 512 + ((size_t)fr * 512 + c) * 1024 + t0 : HYOT + ((size_t)(sg * 16 + fr) * 512 + c) * 256 + t0;
          u32x2 ov; ov[0] = pack2(r4[0], r4[1]); ov[1] = pack2(r4[2], r4[3]);
          *(u32x2*)dst = ov;
        }
      }
    }
    __syncthreads();
  }
}

DEV void phaseD(const Params& p, int l, char* smem) {
  const int nbt = gridDim.x, bt = BID();
  __shared__ int s_task;
  unsigned* ctr = (unsigned*)(WS(p) + OFF_BAR) + 3600 + l * 8;
  if (nbt >= 128 && bt < 64) {
    s5_task(p, l, bt, smem);
    return;
  }
  const int s5lo = nbt >= 128 ? 64 : 0;
#define PULL(pool, limit, body) for (;;) { __syncthreads(); if (threadIdx.x == 0) s_task = (int)atomicAdd(&ctr[pool], 1u); __syncthreads(); \
                                           const int t = s_task; if (t >= (limit)) break; body; }
  PULL(0, 768, ret_task(p, l, t, smem))
  PULL(1, 512, hyena_mfma<true>(p, l, t, smem))
  PULL(2, 576 - s5lo, s5_task(p, l, s5lo + t, smem))
  PULL(3, 1024, hyena_mfma<false>(p, l, t, smem))
  PULL(4, 256, retstate_task(p, l, t))
#undef PULL
}

DEV void phaseE(const Params& p, char* smem) {
  const u16* HYOT = (const u16*)(WS(p) + OFF_OUT1) + (size_t)MT * 512;
  u16* HYO = (u16*)(WS(p) + OFF_OUT1);
  u16* sm = (u16*)smem;
  const int tx = TID() & 63, ty = TID() >> 6;
  for (int tile = BID(); tile < 192 * 8; tile += gridDim.x) {
    int rt = tile >> 3, c0 = (tile & 7) * 64; int row0 = rt * 64;
    const u16* src = row0 < 8192 ? HYOT + ((size_t)(row0 >> 8) * 512 + c0) * 256 + (row0 & 255)
                                 : HYOT + (size_t)8192 * 512 + ((size_t)((row0 - 8192) >> 10) * 512 + c0) * 1024 + ((row0 - 8192) & 1023);
    const int L = row0 < 8192 ? 256 : 1024;
    __syncthreads();
#pragma unroll
    for (int i = 0; i < 16; i++) { int cc = ty + i * 4; sm[cc * 66 + tx] = src[(size_t)cc * L + tx]; }
    __syncthreads();
#pragma unroll
    for (int i = 0; i < 16; i++) { int tt = ty + i * 4; HYO[(size_t)(row0 + tt) * 512 + c0 + tx] = sm[tx * 66 + tt]; }
  }
}

DEV void phaseF(const Params& p, int l, char* smem) {
  u16* sA = (u16*)smem; u16* T = (u16*)smem;
  const u16* H = (const u16*)(WS(p) + OFF_H);
  const u16* WT = (const u16*)(WS(p) + OFF_WT);
  const u16* ZA = (const u16*)(WS(p) + OFF_ZA); const u16* HYO = (const u16*)(WS(p) + OFF_OUT1);
  u16* MG = (u16*)(WS(p) + OFF_YP);
  for (int tile = BID(); tile < 96 * 16; tile += gridDim.x) {
    int tm = tile >> 4, tn = tile & 15;
    if (gridDim.x == 512) {
      const int r = tile >> 9, bb = tile & 511, x = bb & 7, j = bb >> 3;
      tm = r * 32 + (x >> 1) * 8 + (j >> 3); tn = (x & 1) * 8 + (j & 7);
    }
    int row0 = tm * 128, n0 = tn * 64;
    f32x4 a1[4][2], a2[4][2], tt[4][2];
    const u16* Hrow = H + (size_t)row0 * 1024;
    zero_acc<4, 2>(a1); zero_acc<4, 2>(tt);
#pragma unroll 1
    for (int ps = 0; ps < 7; ps++) {
      const u16* Ap; const u16* Bp; int lda, K;
      switch (ps) {
        case 0: Ap = ZA + (size_t)row0 * 2048; lda = 2048; Bp = WT + WGLU_O + (size_t)n0 * 512; K = 512; break;
        case 1: Ap = ZA + (size_t)row0 * 2048; lda = 2048; Bp = WT + WGLU_O + (size_t)(1024 + n0) * 512; K = 512; break;
        case 3: Ap = ZA + (size_t)row0 * 2048 + 512; lda = 2048; Bp = WT + WRETO_O + (size_t)n0 * 512; K = 512; break;
        case 5: Ap = HYO + (size_t)row0 * 512; lda = 512; Bp = WT + WHYO_O + (size_t)n0 * 512; K = 512; break;
        default: Ap = Hrow; lda = 1024; Bp = WT + WIN_O + (size_t)(4096 + ((ps - 2) >> 1) * 1024 + n0) * 1024; K = 1024; break;
      }
      zero_acc<4, 2>(a2);
      gemm_loop<4, 2>(Ap, lda, Bp, K, K, a2, sA);
      if (ps == 0 || ps == 3 || ps == 5) {
#pragma unroll
        for (int m = 0; m < 4; m++)
#pragma unroll
          for (int n = 0; n < 2; n++) a1[m][n] = a2[m][n];
      } else if (ps == 1) {
#pragma unroll
        for (int m = 0; m < 4; m++)
#pragma unroll
          for (int n = 0; n < 2; n++)
#pragma unroll
            for (int j = 0; j < 4; j++) a1[m][n][j] *= sigm(a2[m][n][j]);
      } else {
#pragma unroll
        for (int m = 0; m < 4; m++)
#pragma unroll
          for (int n = 0; n < 2; n++)
#pragma unroll
            for (int j = 0; j < 4; j++) tt[m][n][j] += a1[m][n][j] * sigm(a2[m][n][j]);
      }
    }
    __syncthreads();
    acc_to_lds<4, 2, 72>(tt, T, 0);
    __syncthreads();
    copy_tile<64, 72>(T, MG + (size_t)row0 * 1024 + n0, 1024);
  }
}

template <int MF, int NF>
DEV void resid_store(const Params& p, const f32x4 (&acc)[MF][NF], int l, int chunk, int row0, int col0, bool from_input) {
  const int tid = TID(), lane = tid & 63, wid = tid >> 6, wr = wid >> 1, wc = wid & 1, fr = lane & 15, fq = lane >> 4;
  float* out = OUTP(p);
#pragma unroll
  for (int m = 0; m < MF; m++) {
    const int rb = row0 + m * 32 + wr * 16 + fq * 4;
    const int j = modidx(rb);
    const float* MOD = (const float*)(WS(p) + OFF_MOD) + (l * 5 + j) * 6144 + chunk * 1024;
    const float* BM = INP(p, 7) + l * 6144 + chunk * 1024;
#pragma unroll
    for (int n = 0; n < NF; n++) {
      int col = col0 + wc * (NF * 16) + n * 16 + fr;
      float g = MOD[col] + BM[col];
#pragma unroll
      for (int jj = 0; jj < 4; jj++) {
        int row = rb + jj;
        float xo = from_input ? xin_row(p, row)[col] : out[(size_t)row * 1024 + col];
        out[(size_t)row * 1024 + col] = xo + g * acc[m][n][jj];
      }
    }
  }
}

DEV void phaseG(const Params& p, int l, char* smem) {
  u16* sA = (u16*)smem;
  const u16* MG = (const u16*)(WS(p) + OFF_YP);
  const u16* W = (const u16*)(WS(p) + OFF_WT) + WOUT_O;
  for (int tile = BID(); tile < 64 * 8; tile += gridDim.x) {
    int tm = tile >> 3, tn = tile & 7;
    f32x4 acc[6][4]; zero_acc<6, 4>(acc);
    gemm_loop<6, 4>(MG + (size_t)tm * 192 * 1024, 1024, W + (size_t)tn * 128 * 1024, 1024, 1024, acc, sA);
    resid_store<6, 4>(p, acc, l, 2, tm * 192, tn * 128, l == 0);
  }
}

DEV void phaseI(const Params& p, int l, char* smem) {
  u16* sA = (u16*)smem; u16* T = (u16*)smem;
  const u16* H = (const u16*)(WS(p) + OFF_H);
  const u16* W = (const u16*)(WS(p) + OFF_WT) + WFIN_O;
  u16* ACT = (u16*)(WS(p) + OFF_ZA);
  for (int tile = BID(); tile < 48 * 44; tile += gridDim.x) {
    int tm = tile / 44, tn = tile % 44;
    if (gridDim.x == 512) {
      const int r = tile >> 9, bb = tile & 511, x = bb & 7, j = bb >> 3;
      int sb = r * 16 + x * 2 + (j >> 5), inner = j & 31;
      if (r == 4) { sb = 64 + (bb >> 5); inner = bb & 31; }
      tm = (sb / 11) * 8 + (inner >> 2); tn = (sb % 11) * 4 + (inner & 3);
    }
    f32x4 acc[8][4]; zero_acc<8, 4>(acc);
    gemm_loop<8, 4>(H + (size_t)tm * 256 * 1024, 1024, W + (size_t)tn * 128 * 1024, 1024, 1024, acc, sA);
    const int tid = TID(), lane = tid & 63, wid = tid >> 6, wr = wid >> 1, wc = wid & 1, fr = lane & 15, fq = lane >> 4;
#pragma unroll
    for (int hh = 0; hh < 2; hh++) {
      __syncthreads();
#pragma unroll
      for (int m = 0; m < 4; m++)
#pragma unroll
        for (int n = 0; n < 2; n++)
#pragma unroll
          for (int j = 0; j < 4; j++)
            T[(m * 32 + wr * 16 + fq * 4 + j) * 72 + wc * 32 + n * 16 + fr] = f2bf(silu_(acc[hh * 4 + m][2 * n][j]) * acc[hh * 4 + m][2 * n + 1][j]);
      __syncthreads();
      copy_tile<64, 72>(T, ACT + (size_t)(tm * 256 + hh * 128) * 2816 + tn * 64, 2816);
    }
  }
}

DEV void phaseJ(const Params& p, int l, char* smem) {
  u16* sA = (u16*)smem;
  const u16* ACT = (const u16*)(WS(p) + OFF_ZA);
  const u16* W = (const u16*)(WS(p) + OFF_WT) + WFOUT_O;
  for (int tile = BID(); tile < 64 * 8; tile += gridDim.x) {
    int tm = tile >> 3, tn = tile & 7;
    f32x4 acc[6][4]; zero_acc<6, 4>(acc);
    gemm_loop<6, 4>(ACT + (size_t)tm * 192 * 2816, 2816, W + (size_t)tn * 128 * 2816, 2816, 2816, acc, sA);
    resid_store<6, 4>(p, acc, l, 5, tm * 192, tn * 128, false);
  }
}


#define XB_TMO      128
#define XB_XCNT(j)  (256  + 64 * (j))
#define XB_XSUB(j)  (1280 + 64 * (j))
#define XB_XGEN(j)  (2304 + 64 * (j))
#define XB_TOP      3328
#define XB_TOPGEN   3392
#define XB_SPIN_CAP (1u << 22)
#define LAS __attribute__((address_space(3)))
DEV unsigned xb_ld(unsigned* p) { return __hip_atomic_load(p, __ATOMIC_RELAXED, __HIP_MEMORY_SCOPE_AGENT); }
DEV unsigned xb_add(unsigned* p, unsigned v) { return __hip_atomic_fetch_add(p, v, __ATOMIC_RELAXED, __HIP_MEMORY_SCOPE_AGENT); }
DEV unsigned xb_xcc_id() { return (unsigned)__builtin_amdgcn_s_getreg((3 << 11) | 20) & 0xFu; }
#define XB_SPIN(cond, bar) do { unsigned _sp = 0; while (cond) { __builtin_amdgcn_s_sleep(1); \
    if ((++_sp & 255u) == 0u) { if (xb_ld(&(bar)[XB_TMO])) break; if (_sp > XB_SPIN_CAP) { atomicAdd(&(bar)[XB_TMO], 1u); break; } } } } while (0)
struct XcdBarrier { unsigned* bar; unsigned x; volatile LAS unsigned* st; };
DEV XcdBarrier xcd_barrier_post(unsigned* bar, volatile LAS unsigned* st) {
  XcdBarrier b; b.bar = bar; b.x = xb_xcc_id(); b.st = st;
  if (threadIdx.x == 0) (void)xb_add(&bar[XB_XCNT(b.x)], 1u);
  return b;
}
DEV void xcd_barrier_complete(unsigned* bar, unsigned x, unsigned& nloc, unsigned& nx) {
  const unsigned G = gridDim.x * gridDim.y * gridDim.z;
  unsigned sum, cnt, mine, sp = 0u;
  for (;;) {
    sum = 0u; cnt = 0u; mine = 0u;
#pragma unroll
    for (unsigned j = 0; j < 16; ++j) { const unsigned c = xb_ld(&bar[XB_XCNT(j)]); sum += c; cnt += (c > 0u) ? 1u : 0u; mine = (j == x) ? c : mine; }
    if (sum == G) break;
    __builtin_amdgcn_s_sleep(1);
    if ((++sp & 255u) == 0u) { if (xb_ld(&bar[XB_TMO])) break; if (sp > XB_SPIN_CAP) { atomicAdd(&bar[XB_TMO], 1u); break; } }
  }
  nloc = mine > 0u ? mine : 1u; nx = cnt > 0u ? cnt : 1u;
}
DEV void xcd_barrier(const XcdBarrier& b) {
  asm volatile("s_waitcnt vmcnt(0)" ::: "memory");
  __syncthreads();
  if (threadIdx.x == 0) {
    unsigned* bar = b.bar;
    __builtin_amdgcn_s_waitcnt(0);
    unsigned nloc = b.st[0], nx = b.st[1];
    if (nloc == 0u) { xcd_barrier_complete(bar, b.x, nloc, nx); b.st[0] = nloc; b.st[1] = nx; }
    const unsigned old = xb_add(&bar[XB_XSUB(b.x)], 1u);
    const unsigned gen = old / nloc;
    if (old + 1u == (gen + 1u) * nloc) {
      __builtin_amdgcn_fence(__ATOMIC_RELEASE, "agent");
      asm volatile("s_waitcnt vmcnt(0)" ::: "memory");
      const unsigned og = xb_add(&bar[XB_TOP], 1u);
      const unsigned tg = og / nx;
      if (og + 1u == (tg + 1u) * nx) xb_add(&bar[XB_TOPGEN], 1u);
      else XB_SPIN(xb_ld(&bar[XB_TOPGEN]) == tg, bar);
      __builtin_amdgcn_fence(__ATOMIC_ACQUIRE, "agent");
      xb_add(&bar[XB_XGEN(b.x)], 1u);
      asm volatile("s_waitcnt vmcnt(0)" ::: "memory");
    } else {
      XB_SPIN(xb_ld(&bar[XB_XGEN(b.x)]) == gen, bar);
      __builtin_amdgcn_fence(__ATOMIC_ACQUIRE, "agent");
      asm volatile("s_waitcnt vmcnt(0)" ::: "memory");
    }
  }
  __syncthreads();
}

constexpr int SMEM_BYTES = 58368;

DEV void run_phase(const Params& p, int ph, int l, char* smem) {
  switch (ph) {
    case 0: phaseA(p, smem); break;
    case 1: norm_phase(p, l, 0); if (l == 1) layer_prep(p, 1, smem); break;
    case 2: phaseC(p, l, smem); break;
    case 3: phaseD(p, l, smem); break;
    case 4: phaseE(p, smem); break;
    case 5: phaseF(p, l, smem); break;
    case 6: phaseG(p, l, smem); break;
    case 7: norm_phase(p, l, 1); break;
    case 8: phaseI(p, l, smem); break;
    case 9: phaseJ(p, l, smem); break;
    case 10: norm_phase(p, 0, 2); break;
  }
}

#if MULTI
__global__ void __launch_bounds__(256, 2) kphase(Params p, int ph, int l) {
  __shared__ __attribute__((aligned(16))) char smem[SMEM_BYTES];
  run_phase(p, ph, l, smem);
}
#else
__global__ void __launch_bounds__(256, 2) mega(Params p) {
  __shared__ __attribute__((aligned(16))) char smem[SMEM_BYTES];
  __shared__ uint4 xb_words;
  cg::grid_group grid = cg::this_grid();
  if (threadIdx.x == 0) xb_words = make_uint4(0u, 0u, 0u, 0u);
  __syncthreads();
  XcdBarrier xb = xcd_barrier_post((unsigned*)(p.ws + OFF_BAR), (volatile LAS unsigned*)&xb_words);
  run_phase(p, 0, 0, smem);
  grid.sync();
  for (int l = 0; l < 2; l++) {
    for (int ph = 1; ph <= 9; ph++) {
      run_phase(p, ph, l, smem);
      xcd_barrier(xb);
    }
  }
  run_phase(p, 10, 0, smem);
}
#endif

extern "C" void kernel_launch(void* const* d_in, const int* in_sizes, int n_in, void* d_out, int out_size, void* d_ws, size_t ws_size, hipStream_t stream) {
  Params p{};
  for (int i = 0; i < 36; i++) p.in[i] = (const float*)d_in[i];
  p.out = (float*)d_out;
  p.ws = (char*)d_ws;
  hipMemsetAsync((char*)d_ws + OFF_MOD, 0, ZERO_BYTES, stream);
  static int grid_blocks = 0;
#if MULTI
  if (!grid_blocks) {
    int dev = 0, cus = 0, per_cu = 0;
    hipGetDevice(&dev);
    hipDeviceGetAttribute(&cus, hipDeviceAttributeMultiprocessorCount, dev);
    hipOccupancyMaxActiveBlocksPerMultiprocessor(&per_cu, kphase, 256, 0);
    if (per_cu > 2) per_cu = 2;
    if (per_cu < 1) per_cu = 1;
    grid_blocks = cus * per_cu;
  }
  kphase<<<grid_blocks, 256, 0, stream>>>(p, 0, 0);
  for (int l = 0; l < 2; l++)
    for (int ph = 1; ph <= 9; ph++) kphase<<<grid_blocks, 256, 0, stream>>>(p, ph, l);
  kphase<<<grid_blocks, 256, 0, stream>>>(p, 10, 0);
#else
  if (!grid_blocks) {
    int dev = 0, cus = 0, per_cu = 0;
    hipGetDevice(&dev);
    hipDeviceGetAttribute(&cus, hipDeviceAttributeMultiprocessorCount, dev);
    hipOccupancyMaxActiveBlocksPerMultiprocessor(&per_cu, mega, 256, 0);
    if (per_cu > 2) per_cu = 2;
    if (per_cu < 1) per_cu = 1;
    grid_blocks = cus * per_cu;
  }
  void* args[] = {&p};
  hipError_t e = hipLaunchCooperativeKernel((void*)mega, dim3(grid_blocks), dim3(256), args, 0, stream);
  if (e != hipSuccess) fprintf(stderr, "cooperative launch failed: %s (grid %d)\n", hipGetErrorString(e), grid_blocks);
#endif
}
```

```cpp
#include <hip/hip_runtime.h>
#include <hip/hip_cooperative_groups.h>
#include <cstdio>
namespace cg = cooperative_groups;

#ifndef MULTI
#define MULTI 0
#endif

typedef unsigned short u16;
using bf16x8 = __attribute__((ext_vector_type(8))) short;
using f32x4 = __attribute__((ext_vector_type(4))) float;
using u32x4 = __attribute__((ext_vector_type(4))) unsigned;
using u32x2 = __attribute__((ext_vector_type(2))) unsigned;
#define DEV __device__ __forceinline__

constexpr int MT = 12288;
constexpr size_t OFF_WT = 0;
constexpr int WIN_O = 0, WGLU_O = 7340032, WRETO_O = 8388608, WHYO_O = 8912896, WOUT_O = 9437184, WFIN_O = 10485760, WFOUT_O = 16252928;
constexpr size_t OFF_G = 38273024;
constexpr size_t OFF_H = 48758784;
constexpr size_t OFF_ZA = 73924608;
constexpr size_t OFF_HYZ = 124256256;
constexpr size_t OFF_VT = 162004992;
constexpr size_t OFF_KT = 174587904;
constexpr size_t OFF_QR = 182976512;
constexpr size_t OFF_YP = 187170816;
constexpr size_t OFF_OUT1 = 212336640;
constexpr size_t OFF_MOD = 237502464;
constexpr size_t OFF_SUMSQ = OFF_MOD + 245760;
constexpr size_t OFF_BAR = OFF_SUMSQ + 16384;
constexpr size_t ZERO_BYTES = 245760 + 16384 + 16384;
constexpr size_t OFF_LAMBAR = OFF_BAR + 16384;
constexpr size_t OFF_BBAR = OFF_LAMBAR + 65536;
constexpr size_t OFF_CM = OFF_BBAR + 524288;
constexpr size_t OFF_ROPE = OFF_CM + 524288;
constexpr size_t OFF_S0T = OFF_ROPE + 524288;
constexpr size_t WS_END = OFF_S0T + 2097152;

struct Params {
  const float* in[36];
  float* out;
  char* ws;
};


DEV int TID() { int t = threadIdx.x; asm volatile("" : "+v"(t)); return t; }
DEV int BID() { int t = blockIdx.x; asm volatile("" : "+s"(t)); return t; }
#define GAS __attribute__((address_space(1)))
DEV char* WS(const Params& p) { unsigned long long w = (unsigned long long)p.ws; asm volatile("" : "+s"(w)); return (char*)(GAS char*)w; }
DEV float* OUTP(const Params& p) { unsigned long long w = (unsigned long long)p.out; asm volatile("" : "+s"(w)); return (float*)(GAS float*)w; }
DEV const float* INP(const Params& p, int i) { unsigned long long w = (unsigned long long)p.in[i]; asm volatile("" : "+s"(w)); return (const float*)(GAS const float*)w; }

DEV u16 f2bf(float f) { unsigned u = __float_as_uint(f); u += 0x7fffu + ((u >> 16) & 1u); return (u16)(u >> 16); }
DEV float bf2f(u16 h) { return __uint_as_float(((unsigned)h) << 16); }
DEV float sigm(float x) { return 1.f / (1.f + __expf(-x)); }
DEV float silu_(float x) { return x / (1.f + __expf(-x)); }
DEV float gelu_(float x) { float u = 0.7978845608028654f * (x + 0.044715f * x * x * x); return 0.5f * x * (1.f + tanhf(u)); }
DEV unsigned pack2(float a, float b) { return (unsigned)f2bf(a) | ((unsigned)f2bf(b) << 16); }

DEV const float* xin_row(const Params& p, int row) { return row < 8192 ? INP(p, 0) + (size_t)row * 1024 : INP(p, 1) + (size_t)(row - 8192) * 1024; }
DEV int modidx(int row) { return row < 8192 ? 0 : 1 + ((row - 8192) >> 10); }

template <int MF, int NF>
DEV void gemm_loop(const u16* __restrict__ A, int lda, const u16* __restrict__ B, int ldb, int K, f32x4 (&acc)[MF][NF], u16* sA) {
  const int tid = TID(), lane = tid & 63, wid = tid >> 6, wr = wid >> 1, wc = wid & 1, fr = lane & 15, fq = lane >> 4;
  u16* sB = sA + MF * 32 * 72;
  u32x4 ra[MF], rb[NF];
  const int crow = tid >> 3, ccol = (tid & 7) * 8;
  const u16* Ap = A + (size_t)crow * lda + ccol;
  const u16* Bp = B + (size_t)crow * ldb + ccol;
#pragma unroll
  for (int i = 0; i < MF; i++) ra[i] = *(const u32x4*)(Ap + (size_t)(i * 32) * lda);
#pragma unroll
  for (int i = 0; i < NF; i++) rb[i] = *(const u32x4*)(Bp + (size_t)(i * 32) * ldb);
  for (int k0 = 0; k0 < K; k0 += 64) {
    __syncthreads();
#pragma unroll
    for (int i = 0; i < MF; i++) *(u32x4*)(sA + (crow + i * 32) * 72 + ccol) = ra[i];
#pragma unroll
    for (int i = 0; i < NF; i++) *(u32x4*)(sB + (crow + i * 32) * 72 + ccol) = rb[i];
    __syncthreads();
    if (k0 + 64 < K) {
#pragma unroll
      for (int i = 0; i < MF; i++) ra[i] = *(const u32x4*)(Ap + (size_t)(i * 32) * lda + k0 + 64);
#pragma unroll
      for (int i = 0; i < NF; i++) rb[i] = *(const u32x4*)(Bp + (size_t)(i * 32) * ldb + k0 + 64);
    }
    {
      const u16* sAf = sA + (wr * 16 + fr) * 72 + fq * 8;
      const u16* sBf = sB + (wc * (NF * 16) + fr) * 72 + fq * 8;
      bf16x8 bvA[NF], bvB[NF];
#pragma unroll
      for (int n = 0; n < NF; n++) bvA[n] = *(const bf16x8*)(sBf + n * 16 * 72);
      bf16x8 a_cur = *(const bf16x8*)(sAf);
      bf16x8 a_nxt = *(const bf16x8*)(sAf + 32 * 72);
      __builtin_amdgcn_s_setprio(1);
#pragma unroll
      for (int st = 0; st < 2 * MF; st++) {
        const int ks = st / MF, m = st % MF;
        bf16x8 a_n2 = a_nxt;
        if (st + 2 < 2 * MF) { const int s2 = st + 2; a_n2 = *(const bf16x8*)(sAf + (s2 % MF) * 32 * 72 + (s2 / MF) * 32); }
        if (st == (MF > 3 ? MF - 3 : 0)) {
#pragma unroll
          for (int n = 0; n < NF; n++) bvB[n] = *(const bf16x8*)(sBf + n * 16 * 72 + 32);
        }
        __builtin_amdgcn_sched_barrier(0);
#pragma unroll
        for (int n = 0; n < NF; n++) acc[m][n] = __builtin_amdgcn_mfma_f32_16x16x32_bf16(a_cur, ks == 0 ? bvA[n] : bvB[n], acc[m][n], 0, 0, 0);
        __builtin_amdgcn_sched_barrier(0);
        a_cur = a_nxt; a_nxt = a_n2;
      }
      __builtin_amdgcn_s_setprio(0);
    }
  }
}

template <int MF, int NF>
DEV void zero_acc(f32x4 (&acc)[MF][NF]) {
#pragma unroll
  for (int m = 0; m < MF; m++)
#pragma unroll
    for (int n = 0; n < NF; n++) acc[m][n] = f32x4{0.f, 0.f, 0.f, 0.f};
}

DEV float epi_op(float v, int op) { return op == 1 ? v * 0.08838834764831845f : (op == 2 ? silu_(v) : v); }
template <int MF, int NF, int TS>
DEV void acc_to_lds(const f32x4 (&acc)[MF][NF], u16* T, int m0, int op = 0) {
  const int tid = TID(), lane = tid & 63, wid = tid >> 6, wr = wid >> 1, wc = wid & 1, fr = lane & 15, fq = lane >> 4;
#pragma unroll
  for (int m = 0; m < 4; m++)
#pragma unroll
    for (int n = 0; n < NF; n++)
#pragma unroll
      for (int j = 0; j < 4; j++) T[(m * 32 + wr * 16 + fq * 4 + j) * TS + wc * (NF * 16) + n * 16 + fr] = f2bf(epi_op(acc[m0 + m][n][j], op));
}
template <int MF>
DEV void acc_to_lds_T(const f32x4 (&acc)[MF][4], u16* T, int m0, int op = 0) {
  const int tid = TID(), lane = tid & 63, wid = tid >> 6, wr = wid >> 1, wc = wid & 1, fr = lane & 15, fq = lane >> 4;
#pragma unroll
  for (int m = 0; m < 4; m++)
#pragma unroll
    for (int n = 0; n < 4; n++) {
      u32x2 v; v.x = pack2(epi_op(acc[m0 + m][n][0], op), epi_op(acc[m0 + m][n][1], op)); v.y = pack2(epi_op(acc[m0 + m][n][2], op), epi_op(acc[m0 + m][n][3], op));
      *(u32x2*)(T + (wc * 64 + n * 16 + fr) * 136 + m * 32 + wr * 16 + fq * 4) = v;
    }
}
template <int COLS, int TS>
DEV void copy_tile(const u16* T, u16* dst, int ld) {
  constexpr int CPR = COLS / 8;
  constexpr int NIT = 128 * CPR / 256;
#pragma unroll
  for (int i = 0; i < NIT; i++) {
    int id = TID() + i * 256; int r = id / CPR, ch = id % CPR;
    *(u32x4*)(dst + (size_t)r * ld + ch * 8) = *(const u32x4*)(T + r * TS + ch * 8);
  }
}

DEV void transpose_tile(const float* __restrict__ src, int K, int N, u16* __restrict__ dst, int tile, float* sm, int perm = 0) {
  int nk = K >> 6; int tk = tile % nk, tn = tile / nk; int k0 = tk * 64, n0 = tn * 64;
  int tx = TID() & 63, ty = TID() >> 6;
  __syncthreads();
#pragma unroll
  for (int i = 0; i < 16; i++) { int k = ty + i * 4; sm[k * 65 + tx] = src[(size_t)(k0 + k) * N + n0 + tx]; }
  __syncthreads();
#pragma unroll
  for (int i = 0; i < 16; i++) {
    int n = n0 + ty + i * 4;
    if (perm) { int half = N >> 1; int j = n < half ? n : n - half; n = (j >> 4) * 32 + (n < half ? 0 : 16) + (j & 15); }
    dst[(size_t)n * K + k0 + tx] = f2bf(sm[tx * 65 + (ty + i * 4)]);
  }
}

DEV void wt_task(const Params& p, int l, int t, float* sm) {
  u16* WT = (u16*)(WS(p) + OFF_WT);
  const float* src; int K, N, off, tt, perm = 0;
  if (t < 1792) { src = INP(p, 10) + (size_t)l * 1024 * 7168; K = 1024; N = 7168; off = WIN_O; tt = t; }
  else if (t < 2048) { src = INP(p, 19) + (size_t)l * 512 * 2048; K = 512; N = 2048; off = WGLU_O; tt = t - 1792; }
  else if (t < 2176) { src = INP(p, 21) + (size_t)l * 512 * 1024; K = 512; N = 1024; off = WRETO_O; tt = t - 2048; }
  else if (t < 2304) { src = INP(p, 31) + (size_t)l * 512 * 1024; K = 512; N = 1024; off = WHYO_O; tt = t - 2176; }
  else if (t < 2560) { src = INP(p, 32) + (size_t)l * 1024 * 1024; K = 1024; N = 1024; off = WOUT_O; tt = t - 2304; }
  else if (t < 3968) { src = INP(p, 33) + (size_t)l * 1024 * 5632; K = 1024; N = 5632; off = WFIN_O; tt = t - 2560; perm = 1; }
  else { src = INP(p, 34) + (size_t)l * 2816 * 1024; K = 2816; N = 1024; off = WFOUT_O; tt = t - 3968; }
  transpose_tile(src, K, N, WT + off, tt, sm, perm);
}

DEV void mod_task(const Params& p, int task, float* sm) {
  int cb = task % 96; int l = task / 96;
  int tid = TID(), lane = tid & 63, kq = tid >> 6;
  __syncthreads();
  for (int i = tid; i < 5120; i += 256) {
    int j = i >> 10, k = i & 1023;
    float c = (j == 0) ? INP(p, 5)[k] : INP(p, 4)[(j - 1) * 1024 + k];
    sm[i] = silu_(c);
  }
  __syncthreads();
  int col = cb * 64 + lane;
  const float* w = INP(p, 6) + (size_t)l * 1024 * 6144 + col;
  float a0 = 0, a1 = 0, a2 = 0, a3 = 0, a4 = 0;
#pragma unroll 32
  for (int kk = 0; kk < 256; kk++) {
    int k = kk * 4 + kq;
    float wv = w[(size_t)k * 6144];
    a0 += sm[k] * wv; a1 += sm[1024 + k] * wv; a2 += sm[2048 + k] * wv; a3 += sm[3072 + k] * wv; a4 += sm[4096 + k] * wv;
  }
  float* red = sm + 5120;
  red[(kq * 5 + 0) * 64 + lane] = a0; red[(kq * 5 + 1) * 64 + lane] = a1; red[(kq * 5 + 2) * 64 + lane] = a2;
  red[(kq * 5 + 3) * 64 + lane] = a3; red[(kq * 5 + 4) * 64 + lane] = a4;
  __syncthreads();
  float* MOD = (float*)(WS(p) + OFF_MOD);
  for (int i = tid; i < 320; i += 256) {
    int j = i >> 6, cc = i & 63;
    float v = ((red[(0 * 5 + j) * 64 + cc] + red[(1 * 5 + j) * 64 + cc]) + red[(2 * 5 + j) * 64 + cc]) + red[(3 * 5 + j) * 64 + cc];
    MOD[(l * 5 + j) * 6144 + cb * 64 + cc] = v;
  }
}

DEV void filt_task(const Params& p, int l, int task, float* sm) {
  int Lsel = task >= 32; int tb = Lsel ? task - 32 : task; int L = Lsel ? 1024 : 256; int t0 = tb * 8;
  int tid = TID();
  float* z = sm; float* h1 = sm + 264; float* h2 = sm + 264 + 512;
  const float* w1 = INP(p, 24) + l * 33 * 64; const float* b1 = INP(p, 25) + l * 64;
  const float* w2 = INP(p, 26) + l * 64 * 64; const float* b2 = INP(p, 27) + l * 64;
  const float* fr0 = INP(p, 28) + l * 128; const float* fr1 = fr0 + 64;
  const float* w3 = INP(p, 29) + (size_t)l * 64 * 2048;
  __syncthreads();
  for (int i = tid; i < 264; i += 256) {
    int tt = i / 33, e = i % 33; float t = (float)(t0 + tt); float v;
    if (e == 0) v = t / (float)L;
    else {
      int b = (e - 1) & 15; float band = 1e-4f + (float)b * ((15.f - 1e-4f) / 15.f);
      float ang = (6.283185307179586f / (float)L) * t * band;
      v = (e <= 16) ? cosf(ang) : -sinf(ang);
    }
    z[i] = v;
  }
  __syncthreads();
  for (int i = tid; i < 512; i += 256) {
    int tt = i >> 6, j = i & 63; float s = b1[j];
    for (int e = 0; e < 33; e++) s += z[tt * 33 + e] * w1[e * 64 + j];
    h1[i] = sinf(fr0[j] * s);
  }
  __syncthreads();
  for (int i = tid; i < 512; i += 256) {
    int tt = i >> 6, j = i & 63; float s = b2[j];
    for (int e = 0; e < 64; e++) s += h1[tt * 64 + e] * w2[e * 64 + j];
    h2[i] = sinf(fr1[j] * s);
  }
  __syncthreads();
  float* FB = (float*)(WS(p) + OFF_G) + (Lsel ? 524288 : 0);
  float* SUMSQ = (float*)(WS(p) + WS_END);
  for (int m = 0; m < 8; m++) {
    int col = tid + m * 256;
    float acc[8];
#pragma unroll
    for (int tt = 0; tt < 8; tt++) acc[tt] = 0.f;
    for (int j = 0; j < 64; j++) {
      float w = w3[j * 2048 + col];
#pragma unroll
      for (int tt = 0; tt < 8; tt++) acc[tt] += h2[tt * 64 + j] * w;
    }
    int dir = col >> 10, o = (col >> 9) & 1, c = col & 511;
    float rate = 3.0701134573253944f + (float)c * ((15.350567286626972f - 3.0701134573253944f) / 511.f);
    float ss = 0.f;
    float* Fo = FB + (size_t)o * (2 * L) * 512 + c;
#pragma unroll
    for (int tt = 0; tt < 8; tt++) {
      int t = t0 + tt;
      float val = acc[tt] * expf(-((float)t / (float)L) * rate);
      if (dir == 0) { Fo[(size_t)(L + t) * 512] = val; ss += val * val; }
      else if (t > 0) { Fo[(size_t)(L - t) * 512] = val; ss += val * val; }
      else { Fo[0] = 0.f; }
    }
    SUMSQ[((size_t)l * 160 + task) * 2048 + col] = ss;
  }
}

DEV void s5prep_task(const Params& p, int task) {
  int idx = task * 256 + TID();
  int pp = idx & 63; int lrg = idx >> 6;
  float lre = INP(p, 11)[idx], lim = INP(p, 12)[idx];
  float dt = expf(INP(p, 13)[lrg]);
  float mag = expf(lre * dt);
  float lbr = mag * cosf(lim * dt), lbi = mag * sinf(lim * dt);
  float nr = lbr - 1.f, ni = lbi; float den = lre * lre + lim * lim;
  float cr = (nr * lre + ni * lim) / den, ci = (ni * lre - nr * lim) / den;
  u16* BBAR = (u16*)(WS(p) + OFF_BBAR); u16* CM = (u16*)(WS(p) + OFF_CM); float* LB = (float*)(WS(p) + OFF_LAMBAR);
  LB[idx * 2] = lbr; LB[idx * 2 + 1] = lbi;
  for (int c = 0; c < 16; c++) {
    float br = INP(p, 14)[(size_t)idx * 16 + c], bi = INP(p, 15)[(size_t)idx * 16 + c];
    BBAR[(size_t)lrg * 2048 + pp * 16 + c] = f2bf(cr * br - ci * bi);
    BBAR[(size_t)lrg * 2048 + (64 + pp) * 16 + c] = f2bf(cr * bi + ci * br);
    CM[(size_t)lrg * 2048 + c * 128 + pp] = f2bf(INP(p, 16)[(size_t)lrg * 1024 + c * 64 + pp]);
    CM[(size_t)lrg * 2048 + c * 128 + 64 + pp] = f2bf(-INP(p, 17)[(size_t)lrg * 1024 + c * 64 + pp]);
  }
}

DEV void rope_task(const Params& p, int task) {
  int idx = task * 256 + TID(); int t = idx >> 6, d = idx & 63; int f = d & 31;
  float inv = powf(10000.f, -(float)f / 32.f);
  float pos = (d < 32) ? (float)(t >> 6) : (float)(t & 63);
  float ang = pos * inv;
  float* R = (float*)(WS(p) + OFF_ROPE);
  R[idx * 2] = cosf(ang); R[idx * 2 + 1] = sinf(ang);
}

DEV int pull_task(unsigned* ctr, int* s_task) {
  __syncthreads();
  if (threadIdx.x == 0) *s_task = (int)atomicAdd(ctr, 1u);
  __syncthreads();
  return *s_task;
}
DEV void layer_prep(const Params& p, int l, char* smem) {
  __shared__ int s_lp;
  unsigned* ctr = (unsigned*)(WS(p) + OFF_BAR) + 3700 + l;
  for (;;) {
    const int t = pull_task(ctr, &s_lp);
    if (t >= 160 + 4672) break;
    if (t < 160) filt_task(p, l, t, (float*)smem);
    else wt_task(p, l, t - 160, (float*)smem);
  }
}
DEV void phaseA(const Params& p, char* smem) {
  __shared__ int s_pa;
  unsigned* ctr = (unsigned*)(WS(p) + OFF_BAR) + 3710;
  for (;;) {
    const int t = pull_task(ctr, &s_pa);
    if (t >= 192 + 256 + 256 + 32) break;
    if (t < 192) mod_task(p, t, (float*)smem);
    else if (t < 448) { int tt = t - 192; int mi = tt >> 2; transpose_tile(INP(p, 3) + (size_t)mi * 16384, 128, 128, (u16*)(WS(p) + OFF_S0T) + (size_t)mi * 16384, tt & 3, (float*)smem); }
    else if (t < 704) rope_task(p, t - 448);
    else s5prep_task(p, t - 704);
  }
  layer_prep(p, 0, smem);
}

DEV void norm_phase(const Params& p, int l, int which) {
  const int lane = TID() & 63;
  const int wave = (BID() * blockDim.x + TID()) >> 6, nw = (gridDim.x * blockDim.x) >> 6;
  u16* H = (u16*)(WS(p) + OFF_H);
  const float* MOD = (const float*)(WS(p) + OFF_MOD);
  for (int row = wave; row < MT; row += nw) {
    const float* x = (l == 0 && which == 0) ? xin_row(p, row) : OUTP(p) + (size_t)row * 1024;
    float4 v[4]; float ss = 0.f;
#pragma unroll
    for (int i = 0; i < 4; i++) { v[i] = *(const float4*)(x + i * 256 + lane * 4); ss += v[i].x * v[i].x + v[i].y * v[i].y + v[i].z * v[i].z + v[i].w * v[i].w; }
#pragma unroll
    for (int o = 32; o > 0; o >>= 1) ss += __shfl_xor(ss, o, 64);
    float rinv = rsqrtf(ss * (1.f / 1024.f) + 1e-6f);
    if (which == 2) {
      const float* nf = INP(p, 35);
#pragma unroll
      for (int i = 0; i < 4; i++) {
        float4 g = *(const float4*)(nf + i * 256 + lane * 4);
        float4 o; o.x = v[i].x * rinv * g.x; o.y = v[i].y * rinv * g.y; o.z = v[i].z * rinv * g.z; o.w = v[i].w * rinv * g.w;
        *(float4*)(OUTP(p) + (size_t)row * 1024 + i * 256 + lane * 4) = o;
      }
    } else {
      int j = modidx(row);
      const float* nwt = (which == 0 ? INP(p, 8) : INP(p, 9)) + l * 1024;
      const float* msh = MOD + (l * 5 + j) * 6144 + (which ? 3 : 0) * 1024;
      const float* msc = msh + 1024;
      const float* bsh = INP(p, 7) + l * 6144 + (which ? 3 : 0) * 1024;
      const float* bsc = bsh + 1024;
#pragma unroll
      for (int i = 0; i < 4; i++) {
        int k = i * 256 + lane * 4;
        float4 g = *(const float4*)(nwt + k);
        float4 sh = *(const float4*)(msh + k), sc = *(const float4*)(msc + k);
        float4 bh = *(const float4*)(bsh + k), bc = *(const float4*)(bsc + k);
        float o0 = v[i].x * rinv * g.x * (1.f + sc.x + bc.x) + sh.x + bh.x;
        float o1 = v[i].y * rinv * g.y * (1.f + sc.y + bc.y) + sh.y + bh.y;
        float o2 = v[i].z * rinv * g.z * (1.f + sc.z + bc.z) + sh.z + bh.z;
        float o3 = v[i].w * rinv * g.w * (1.f + sc.w + bc.w) + sh.w + bh.w;
        u32x2 pk; pk.x = pack2(o0, o1); pk.y = pack2(o2, o3);
        *(u32x2*)(H + (size_t)row * 1024 + k) = pk;
      }
    }
  }
}

DEV void phaseC(const Params& p, int l, char* smem) {
  u16* sA = (u16*)smem; u16* T = (u16*)smem;
  const u16* H = (const u16*)(WS(p) + OFF_H);
  const u16* WIN = (const u16*)(WS(p) + OFF_WT) + WIN_O;
  u16* ZA = (u16*)(WS(p) + OFF_ZA); u16* HYT = (u16*)(WS(p) + OFF_HYZ); u16* VT = (u16*)(WS(p) + OFF_VT);
  u16* KT = (u16*)(WS(p) + OFF_KT); u16* QR = (u16*)(WS(p) + OFF_QR);
  const float* ROPE = (const float*)(WS(p) + OFF_ROPE);
  const int tid = TID();
  for (int tile = BID(); tile < 48 * 32; tile += gridDim.x) {
    int tm = tile >> 5, tn = tile & 31;
    if (gridDim.x == 512) {
      const int r = tile >> 9, bb = tile & 511, x = bb & 7, j = bb >> 3;
      tm = r * 16 + (x >> 2) * 8 + (j >> 3); tn = (x & 3) * 8 + (j & 7);
    }
    f32x4 acc[8][4]; zero_acc<8, 4>(acc);
    gemm_loop<8, 4>(H + (size_t)tm * 256 * 1024, 1024, WIN + (size_t)tn * 128 * 1024, 1024, 1024, acc, sA);
    int kind = tn >> 2, hd = tn & 3;
    const int op = kind == 2 ? 1 : (kind == 4 ? 2 : 0);
#pragma unroll
    for (int hh = 0; hh < 2; hh++) {
      int row0 = tm * 256 + hh * 128; bool lat = row0 >= 8192;
      int seq, t0, L;
      if (!lat) { seq = row0 >> 8; t0 = row0 & 255; L = 256; } else { seq = (row0 - 8192) >> 10; t0 = (row0 - 8192) & 1023; L = 1024; }
      __syncthreads();
      if (kind == 3 || kind >= 5) {
        acc_to_lds_T<8>(acc, T, hh * 4, 0);
        __syncthreads();
        u16* dst;
        if (kind == 3) dst = lat ? VT + (size_t)8192 * 512 + (size_t)((seq * 4 + hd) * 128) * 1024 + t0 : VT + (size_t)((seq * 4 + hd) * 128) * 256 + t0;
        else dst = lat ? HYT + (size_t)8192 * 1536 + ((size_t)seq * 1536 + (tn - 20) * 128) * 1024 + t0 : HYT + ((size_t)seq * 1536 + (tn - 20) * 128) * 256 + t0;
        copy_tile<128, 136>(T, dst, L);
      } else {
        acc_to_lds<8, 4, 136>(acc, T, hh * 4, op);
        __syncthreads();
        bool roped = lat && (kind == 1 || kind == 2);
        if (!(lat && kind == 2)) {
          u16* dst;
          if (kind == 0) dst = ZA + (size_t)row0 * 2048 + hd * 128;
          else if (kind == 1) dst = ZA + (size_t)row0 * 2048 + 512 + hd * 128;
          else if (kind == 2) dst = ZA + (size_t)row0 * 2048 + 1024 + hd * 128;
          else dst = ZA + (size_t)row0 * 2048 + 1536 + hd * 128;
          copy_tile<128, 136>(T, dst, 2048);
        }
        if (roped) {
          u16* dst; int ld;
          if (kind == 1) { dst = QR + (size_t)(row0 - 8192) * 512 + hd * 128; ld = 512; }
          else { dst = ZA + (size_t)row0 * 2048 + 1024 + hd * 128; ld = 2048; }
#pragma unroll 1
          for (int i = 0; i < 4; i++) {
            int id = tid + i * 256; int r = id >> 3, ch = id & 7;
            u32x4 a = *(const u32x4*)(T + r * 136 + ch * 8);
            u32x4 b = *(const u32x4*)(T + r * 136 + 64 + ch * 8);
            const float4* cs = (const float4*)(ROPE + ((size_t)(t0 + r) * 64 + ch * 8) * 2);
            u32x4 o1, o2;
#pragma unroll
            for (int q = 0; q < 4; q++) {
              float4 c4 = cs[q];
              float x1a = __uint_as_float(a[q] << 16), x1b = __uint_as_float(a[q] & 0xffff0000u);
              float x2a = __uint_as_float(b[q] << 16), x2b = __uint_as_float(b[q] & 0xffff0000u);
              o1[q] = pack2(x1a * c4.x - x2a * c4.y, x1b * c4.z - x2b * c4.w);
              o2[q] = pack2(x1a * c4.y + x2a * c4.x, x1b * c4.w + x2b * c4.z);
            }
            *(u32x4*)(dst + (size_t)r * ld + ch * 8) = o1;
            *(u32x4*)(dst + (size_t)r * ld + 64 + ch * 8) = o2;
          }
        }
        if (kind == 2 && !lat) {
          __syncthreads();
          acc_to_lds_T<8>(acc, T, hh * 4, op);
          __syncthreads();
          copy_tile<128, 136>(T, KT + (size_t)((seq * 4 + hd) * 128) * 256 + t0, 256);
        }
      }
    }
  }
}

DEV void s5_task(const Params& p, int l, int task, char* smem) {
  const int tid = TID(), lane = tid & 63, wid = tid >> 6, fr = lane & 15, fq = lane >> 4;
  int seq, gp;
  if (task < 64) { seq = 32 + (task >> 4); gp = task & 15; } else { int t2 = task - 64; seq = t2 >> 4; gp = t2 & 15; }
  const bool lat = seq >= 32;
  const int L = lat ? 1024 : 256;
  const int row0 = lat ? 8192 + (seq - 32) * 1024 : seq * 256;
  const int grp = gp * 2 + (wid >> 1), dir = wid & 1;
  const int lrg = (l * 2 + dir) * 32 + grp;
  float* BU = (float*)(smem + wid * 12544);
  u16* HB = (u16*)(smem + wid * 12544 + 8192);
  u16* ZA = (u16*)(WS(p) + OFF_ZA);
  float* YP = (float*)(WS(p) + OFF_YP);
  const u16* BBAR = (const u16*)(WS(p) + OFF_BBAR) + (size_t)lrg * 2048;
  const u16* CM = (const u16*)(WS(p) + OFF_CM) + (size_t)lrg * 2048;
  const float* LB = (const float*)(WS(p) + OFF_LAMBAR) + ((size_t)lrg * 64 + lane) * 2;
  const float lr = LB[0], li = LB[1];
  bf16x8 bfrag[8], cfrag[4];
  const bf16x8 zero8 = {0, 0, 0, 0, 0, 0, 0, 0};
#pragma unroll
  for (int nt = 0; nt < 8; nt++) bfrag[nt] = (fq < 2) ? *(const bf16x8*)(BBAR + (nt * 16 + fr) * 16 + fq * 8) : zero8;
#pragma unroll
  for (int ks = 0; ks < 4; ks++) cfrag[ks] = *(const bf16x8*)(CM + fr * 128 + ks * 32 + fq * 8);
  float hr = 0.f, hi = 0.f;
  if (lat) {
    const float* s0 = INP(p, 2) + ((((size_t)(seq - 32) * 2 + l) * 2 + dir) * 32 + grp) * 128 + lane * 2;
    hr = s0[0]; hi = s0[1];
  }
  const float dcoef = INP(p, 18)[l * 512 + grp * 16 + fr];
  const int nch = L >> 4;
  __syncthreads();
  const int half = nch >> 1;
  bf16x8 ua_next = (fq < 2) ? *(const bf16x8*)(ZA + (size_t)(row0 + (dir ? nch - 1 : 0) * 16 + fr) * 2048 + grp * 16 + fq * 8) : zero8;
  const int tbase = dir ? 15 : 0, tstep = dir ? -1 : 1;
  for (int i = 0; i < nch; i++) {
    const int ci = dir ? nch - 1 - i : i; const int t0 = ci * 16;
    if (i == half) { asm volatile("s_waitcnt vmcnt(0)" ::: "memory"); __syncthreads(); }
    const bf16x8 ua = ua_next;
    if (i + 1 < nch) {
      const int cn = dir ? nch - 2 - i : i + 1;
      ua_next = (fq < 2) ? *(const bf16x8*)(ZA + (size_t)(row0 + cn * 16 + fr) * 2048 + grp * 16 + fq * 8) : zero8;
    }
    float oth[4] = {0.f, 0.f, 0.f, 0.f}, uu[4] = {0.f, 0.f, 0.f, 0.f};
    if (i >= half) {
#pragma unroll
      for (int j = 0; j < 4; j++) {
        size_t row = (size_t)(row0 + t0 + fq * 4 + j);
        oth[j] = YP[row * 512 + grp * 16 + fr];
        uu[j] = bf2f(ZA[row * 2048 + grp * 16 + fr]);
      }
    }
#pragma unroll
    for (int nt = 0; nt < 8; nt++) {
      f32x4 r = __builtin_amdgcn_mfma_f32_16x16x32_bf16(ua, bfrag[nt], f32x4{0.f, 0.f, 0.f, 0.f}, 0, 0, 0);
#pragma unroll
      for (int j = 0; j < 4; j++) BU[(fq * 4 + j) * 128 + nt * 16 + fr] = r[j];
    }
    asm volatile("s_waitcnt lgkmcnt(0)" ::: "memory");
#pragma unroll
    for (int tt = 0; tt < 16; tt++) {
      const int t = tbase + tstep * tt;
      float re = BU[t * 128 + lane], im = BU[t * 128 + 64 + lane];
      float nr = lr * hr - li * hi + re; float ni = lr * hi + li * hr + im;
      hr = nr; hi = ni;
      HB[t * 136 + lane] = f2bf(hr); HB[t * 136 + 64 + lane] = f2bf(hi);
    }
    asm volatile("s_waitcnt lgkmcnt(0)" ::: "memory");
    f32x4 y = {0.f, 0.f, 0.f, 0.f};
#pragma unroll
    for (int ks = 0; ks < 4; ks++) {
      bf16x8 a = *(const bf16x8*)(HB + fr * 136 + ks * 32 + fq * 8);
      y = __builtin_amdgcn_mfma_f32_16x16x32_bf16(a, cfrag[ks], y, 0, 0, 0);
    }
    asm volatile("s_waitcnt lgkmcnt(0)" ::: "memory");
    if (i < half) {
#pragma unroll
      for (int j = 0; j < 4; j++) YP[(size_t)(row0 + t0 + fq * 4 + j) * 512 + grp * 16 + fr] = y[j];
    } else {
#pragma unroll
      for (int j = 0; j < 4; j++) {
        size_t row = (size_t)(row0 + t0 + fq * 4 + j);
        float v = y[j] + oth[j] + dcoef * uu[j];
        ZA[row * 2048 + grp * 16 + fr] = f2bf(gelu_(v));
      }
    }
  }
  if (!lat) {
    float* o = OUTP(p) + 12582912 + ((((size_t)seq * 2 + l) * 2 + dir) * 32 + grp) * 128 + lane * 2;
    o[0] = hr; o[1] = hi;
  }
}

DEV void ret_task(const Params& p, int l, int task, char* smem) {
  const int tid = TID(), lane = tid & 63, wid = tid >> 6, fr = lane & 15, fq = lane >> 4;
  int seq, h, qt; bool lat;
  if (task < 256) { lat = true; seq = task >> 6; h = (task >> 4) & 3; qt = task & 15; }
  else { int t2 = task - 256; lat = false; seq = t2 >> 4; h = (t2 >> 2) & 3; qt = t2 & 3; }
  const int L = lat ? 1024 : 256;
  const int row0 = lat ? 8192 + seq * 1024 : seq * 256;
  u16* sK = (u16*)smem; u16* sV = sK + 64 * 136; u16* sP = sV + 128 * 72 + wid * 16 * 72;
  u16* ZA = (u16*)(WS(p) + OFF_ZA);
  const u16* QR = (const u16*)(WS(p) + OFF_QR);
  const u16* VT = (const u16*)(WS(p) + OFF_VT);
  const float lgf = log1pf(-expf(INP(p, 20)[(l * 2 + 0) * 4 + h])), lgb = log1pf(-expf(INP(p, 20)[(l * 2 + 1) * 4 + h]));
  const int qrow = qt * 64 + wid * 16;
  const u16* qsrc = lat ? QR + (size_t)(row0 - 8192 + qrow + fr) * 512 + h * 128 : ZA + (size_t)(row0 + qrow + fr) * 2048 + 512 + h * 128;
  bf16x8 qa[4];
#pragma unroll
  for (int ks = 0; ks < 4; ks++) qa[ks] = *(const bf16x8*)(qsrc + ks * 32 + fq * 8);
  f32x4 o[8];
#pragma unroll
  for (int n = 0; n < 8; n++) o[n] = f32x4{0.f, 0.f, 0.f, 0.f};
  const u16* Kbase = ZA + (size_t)row0 * 2048 + 1024 + h * 128;
  const u16* Vbase = lat ? VT + (size_t)8192 * 512 + (size_t)((seq * 4 + h) * 128) * 1024 : VT + (size_t)((seq * 4 + h) * 128) * 256;
  const int nkt = L >> 6;
  u32x4 kreg[4], vreg[4];
  const int kr = tid >> 4, kc = (tid & 15) * 8;
  const int ve = tid >> 3, vc = (tid & 7) * 8;
#pragma unroll
  for (int i = 0; i < 4; i++) {
    kreg[i] = *(const u32x4*)(Kbase + (size_t)(kr + 16 * i) * 2048 + kc);
    vreg[i] = *(const u32x4*)(Vbase + (size_t)(ve + 32 * i) * L + vc);
  }
  for (int jt = 0; jt < nkt; jt++) {
    __syncthreads();
#pragma unroll
    for (int i = 0; i < 4; i++) {
      *(u32x4*)(sK + (kr + 16 * i) * 136 + kc) = kreg[i];
      *(u32x4*)(sV + (ve + 32 * i) * 72 + vc) = vreg[i];
    }
    __syncthreads();
    if (jt + 1 < nkt) {
#pragma unroll
      for (int i = 0; i < 4; i++) {
        kreg[i] = *(const u32x4*)(Kbase + (size_t)((jt + 1) * 64 + kr + 16 * i) * 2048 + kc);
        vreg[i] = *(const u32x4*)(Vbase + (size_t)(ve + 32 * i) * L + (jt + 1) * 64 + vc);
      }
    }
    f32x4 s[4];
#pragma unroll
    for (int nt = 0; nt < 4; nt++) s[nt] = f32x4{0.f, 0.f, 0.f, 0.f};
    {
      const u16* kp = sK + fr * 136 + fq * 8;
      bf16x8 b_cur = *(const bf16x8*)(kp);
      bf16x8 b_nxt = *(const bf16x8*)(kp + 32);
#pragma unroll
      for (int i = 0; i < 16; i++) {
        bf16x8 b_n2 = b_nxt;
        if (i + 2 < 16) b_n2 = *(const bf16x8*)(kp + ((i + 2) >> 2) * 16 * 136 + ((i + 2) & 3) * 32);
        __builtin_amdgcn_sched_barrier(0);
        s[i >> 2] = __builtin_amdgcn_mfma_f32_16x16x32_bf16(qa[i & 3], b_cur, s[i >> 2], 0, 0, 0);
        __builtin_amdgcn_sched_barrier(0);
        b_cur = b_nxt; b_nxt = b_n2;
      }
    }
#pragma unroll
    for (int nt = 0; nt < 4; nt++)
#pragma unroll
      for (int j = 0; j < 4; j++) {
        int d = (qrow + fq * 4 + j) - (jt * 64 + nt * 16 + fr);
        float w = d >= 0 ? __expf(lgf * (float)d) : __expf(lgb * (float)(-d));
        sP[(fq * 4 + j) * 72 + nt * 16 + fr] = f2bf(s[nt][j] * w);
      }
    asm volatile("s_waitcnt lgkmcnt(0)" ::: "memory");
    {
      bf16x8 pa[2];
      pa[0] = *(const bf16x8*)(sP + fr * 72 + fq * 8);
      pa[1] = *(const bf16x8*)(sP + fr * 72 + 32 + fq * 8);
      const u16* vp = sV + fr * 72 + fq * 8;
      bf16x8 b_cur = *(const bf16x8*)(vp);
      bf16x8 b_nxt = *(const bf16x8*)(vp + 16 * 72);
#pragma unroll
      for (int i = 0; i < 16; i++) {
        bf16x8 b_n2 = b_nxt;
        if (i + 2 < 16) b_n2 = *(const bf16x8*)(vp + ((i + 2) & 7) * 16 * 72 + ((i + 2) >> 3) * 32);
        __builtin_amdgcn_sched_barrier(0);
        o[i & 7] = __builtin_amdgcn_mfma_f32_16x16x32_bf16(pa[i >> 3], b_cur, o[i & 7], 0, 0, 0);
        __builtin_amdgcn_sched_barrier(0);
        b_cur = b_nxt; b_nxt = b_n2;
      }
    }
    asm volatile("s_waitcnt lgkmcnt(0)" ::: "memory");
  }
  if (lat) {
    const u16* q0src = ZA + (size_t)(row0 + qrow + fr) * 2048 + 512 + h * 128;
    bf16x8 q0[4];
#pragma unroll
    for (int ks = 0; ks < 4; ks++) q0[ks] = *(const bf16x8*)(q0src + ks * 32 + fq * 8);
#pragma unroll 1
    for (int dir = 0; dir < 2; dir++) {
      const u16* S0 = (const u16*)(WS(p) + OFF_S0T) + (size_t)((((seq * 2 + l) * 2 + dir) * 4 + h)) * 16384;
      u16* sS = sK;
      __syncthreads();
#pragma unroll
      for (int i = 0; i < 8; i++) {
        int id = tid + i * 256; int e = id >> 4, ch = id & 15;
        *(u32x4*)(sS + e * 136 + ch * 8) = *(const u32x4*)(S0 + (size_t)e * 128 + ch * 8);
      }
      __syncthreads();
      float wj[4];
#pragma unroll
      for (int j = 0; j < 4; j++) { int gi = qrow + fq * 4 + j; wj[j] = dir == 0 ? __expf(lgf * (float)(gi + 1)) : __expf(lgb * (float)(L - 1 - gi)); }
#pragma unroll
      for (int n2 = 0; n2 < 8; n2++) {
        f32x4 tmp = {0.f, 0.f, 0.f, 0.f};
#pragma unroll
        for (int ks = 0; ks < 4; ks++) {
          bf16x8 b = *(const bf16x8*)(sS + (n2 * 16 + fr) * 136 + ks * 32 + fq * 8);
          tmp = __builtin_amdgcn_mfma_f32_16x16x32_bf16(q0[ks], b, tmp, 0, 0, 0);
        }
#pragma unroll
        for (int j = 0; j < 4; j++) o[n2][j] += wj[j] * tmp[j];
      }
    }
  }
#pragma unroll
  for (int j = 0; j < 4; j++) {
    float s = 0.f;
#pragma unroll
    for (int n2 = 0; n2 < 8; n2++) s += o[n2][j];
    s += __shfl_xor(s, 1, 64); s += __shfl_xor(s, 2, 64); s += __shfl_xor(s, 4, 64); s += __shfl_xor(s, 8, 64);
    float mean = s * (1.f / 128.f);
    float v = 0.f;
#pragma unroll
    for (int n2 = 0; n2 < 8; n2++) { float dd = o[n2][j] - mean; v += dd * dd; }
    v += __shfl_xor(v, 1, 64); v += __shfl_xor(v, 2, 64); v += __shfl_xor(v, 4, 64); v += __shfl_xor(v, 8, 64);
    float rstd = rsqrtf(v * (1.f / 128.f) + 1e-5f);
    size_t rbase = (size_t)(row0 + qrow + fq * 4 + j) * 2048;
#pragma unroll
    for (int n2 = 0; n2 < 8; n2++) {
      int e = n2 * 16 + fr;
      float gv = bf2f(ZA[rbase + 1536 + h * 128 + e]);
      ZA[rbase + 512 + h * 128 + e] = f2bf((o[n2][j] - mean) * rstd * gv);
    }
  }
}

DEV bf16x8 scale8(u32x4 raw, const float (&w)[8]) {
  union { u32x4 u; bf16x8 v; } r;
#pragma unroll
  for (int q = 0; q < 4; q++) {
    float a = __uint_as_float(raw[q] << 16) * w[q * 2], b = __uint_as_float(raw[q] & 0xffff0000u) * w[q * 2 + 1];
    r.u[q] = pack2(a, b);
  }
  return r.v;
}

DEV void retstate_task(const Params& p, int l, int task) {
  const int tid = TID(), lane = tid & 63, wid = tid >> 6, fr = lane & 15, fq = lane >> 4;
  int seq = task >> 3, h = (task >> 1) & 3, dir = task & 1;
  const u16* KT = (const u16*)(WS(p) + OFF_KT) + (size_t)((seq * 4 + h) * 128) * 256;
  const u16* VT = (const u16*)(WS(p) + OFF_VT) + (size_t)((seq * 4 + h) * 128) * 256;
  const float lg = log1pf(-expf(INP(p, 20)[(l * 2 + dir) * 4 + h]));
  f32x4 acc[2][8];
#pragma unroll
  for (int m = 0; m < 2; m++)
#pragma unroll
    for (int n = 0; n < 8; n++) acc[m][n] = f32x4{0.f, 0.f, 0.f, 0.f};
#pragma unroll 1
  for (int ks = 0; ks < 8; ks++) {
    float w[8];
#pragma unroll
    for (int jj = 0; jj < 8; jj++) { int j = ks * 32 + fq * 8 + jj; w[jj] = __expf(lg * (float)(dir == 0 ? 255 - j : j)); }
    bf16x8 a[2];
#pragma unroll
    for (int m = 0; m < 2; m++) a[m] = scale8(*(const u32x4*)(KT + (size_t)(wid * 32 + m * 16 + fr) * 256 + ks * 32 + fq * 8), w);
#pragma unroll
    for (int n = 0; n < 8; n++) {
      bf16x8 b = *(const bf16x8*)(VT + (size_t)(n * 16 + fr) * 256 + ks * 32 + fq * 8);
#pragma unroll
      for (int m = 0; m < 2; m++) acc[m][n] = __builtin_amdgcn_mfma_f32_16x16x32_bf16(a[m], b, acc[m][n], 0, 0, 0);
    }
  }
  float* o = OUTP(p) + 13107200 + ((((size_t)seq * 2 + l) * 2 + dir) * 4 + h) * 16384;
#pragma unroll
  for (int m = 0; m < 2; m++)
#pragma unroll
    for (int n = 0; n < 8; n++)
#pragma unroll
      for (int j = 0; j < 4; j++) o[(size_t)(wid * 32 + m * 16 + fq * 4 + j) * 128 + n * 16 + fr] = acc[m][n][j];
}

template <bool LAT>
DEV void hyena_mfma(const Params& p, int l, int task, char* smem) {
  constexpr int L = LAT ? 1024 : 256;
  constexpr int NV = LAT ? 4 : 16;
  constexpr int RS = L + 8, CS = 2 * L + 16;
  constexpr int MPW = L / 64, NKS = L / 32, NCH = L / 8, Lsel = LAT ? 1 : 0;
  const int tid = TID(), lane = tid & 63, wid = tid >> 6, fr = lane & 15, fq = lane >> 4;
  const int c = LAT ? task : (task >> 1);
  const int sg = LAT ? 0 : (task & 1);
  u16* CP = (u16*)smem; u16* XV = CP + 8 * CS; u16* GS = XV + NV * RS; u16* O1 = GS + NV * RS;
  const u16* HYT = (const u16*)(WS(p) + OFF_HYZ);
  u16* HYOT = (u16*)(WS(p) + OFF_OUT1) + (size_t)MT * 512;
  const float* cw = INP(p, 22) + (size_t)l * 3 * 1536; const float* cb = INP(p, 23) + l * 1536;
  auto sconv = [&](int arr, u16* dstA) {
    const int ch = arr * 512 + c;
    const float w0 = cw[ch], w1 = cw[1536 + ch], w2 = cw[3072 + ch], bb = cb[ch];
#pragma unroll
    for (int i = 0; i < (NV * NCH) / 256; i++) {
      int id = tid + i * 256; int n = id / NCH, t8 = (id % NCH) * 8;
      const u16* src = LAT ? HYT + (size_t)8192 * 1536 + ((size_t)n * 1536 + ch) * 1024 + t8 : HYT + ((size_t)(sg * 16 + n) * 1536 + ch) * 256 + t8;
      u32x4 raw = *(const u32x4*)src;
      float h[10];
      h[0] = t8 > 0 ? bf2f(src[-1]) : 0.f;
      h[9] = t8 + 8 < L ? bf2f(src[8]) : 0.f;
#pragma unroll
      for (int q = 0; q < 4; q++) { h[1 + 2 * q] = __uint_as_float(raw[q] << 16); h[2 + 2 * q] = __uint_as_float(raw[q] & 0xffff0000u); }
      u32x4 o;
#pragma unroll
      for (int q = 0; q < 4; q++) o[q] = pack2(w0 * h[2 * q] + w1 * h[2 * q + 1] + w2 * h[2 * q + 2] + bb, w0 * h[2 * q + 1] + w1 * h[2 * q + 2] + w2 * h[2 * q + 3] + bb);
      *(u32x4*)(dstA + n * RS + t8) = o;
    }
  };
  __syncthreads();
  sconv(0, GS);
  sconv(2, XV);
  const int rr = (-fr) & 7;
  const u16* cpl = CP + rr * CS + (L + 8 * fq - fr - rr);
#pragma unroll 1
  for (int o = 0; o < 2; o++) {
    if (o == 1) sconv(1, GS);
    u16* FL = o == 0 ? O1 : XV;
    const float* Gp = (const float*)(WS(p) + OFF_G) + (Lsel ? 524288 : 0) + (size_t)o * (2 * L) * 512 + c;
    if (tid < 2 * L / 8) {
      float f[8];
#pragma unroll
      for (int j = 0; j < 8; j++) { int u = tid * 8 + j; f[j] = u > 0 ? Gp[(size_t)(2 * L - u) * 512] : 0.f; }
      u32x4 v; v[0] = pack2(f[0], f[1]); v[1] = pack2(f[2], f[3]); v[2] = pack2(f[4], f[5]); v[3] = pack2(f[6], f[7]);
      *(u32x4*)(FL + tid * 8) = v;
    }
    if (tid < 2) *(u32x4*)(FL + 2 * L + tid * 8) = u32x4{0u, 0u, 0u, 0u};
    __syncthreads();
    if (tid < 2 * L / 8) {
      u32x4 a = *(const u32x4*)(FL + tid * 8), b = *(const u32x4*)(FL + tid * 8 + 8);
      unsigned d[8] = {a[0], a[1], a[2], a[3], b[0], b[1], b[2], b[3]};
#pragma unroll
      for (int r = 0; r < 8; r++) {
        u32x4 ov;
#pragma unroll
        for (int q = 0; q < 4; q++) ov[q] = (r & 1) ? ((d[q + (r >> 1)] >> 16) | (d[q + (r >> 1) + 1] << 16)) : d[q + (r >> 1)];
        *(u32x4*)(CP + r * CS + tid * 8) = ov;
      }
    }
    __syncthreads();
    float rn;
    {
      constexpr int NTB = LAT ? 128 : 32;
      const float* SP = (const float*)(WS(p) + WS_END) + ((size_t)l * 160 + (LAT ? 32 : 0)) * 2048 + o * 512 + c;
      float ssum = 0.f;
      for (int tb = lane; tb < NTB; tb += 64) ssum += SP[(size_t)tb * 2048] + SP[(size_t)tb * 2048 + 1024];
#pragma unroll
      for (int off = 32; off > 0; off >>= 1) ssum += __shfl_xor(ssum, off, 64);
      rn = rsqrtf(ssum + 1e-6f);
    }
    const float bias = INP(p, 30)[(l * 2 + o) * 512 + c];
    const u16* Xs = o == 0 ? XV : O1;
    f32x4 acc[MPW];
#pragma unroll
    for (int mi = 0; mi < MPW; mi++) acc[mi] = f32x4{0.f, 0.f, 0.f, 0.f};
    const bf16x8 zero8 = {0, 0, 0, 0, 0, 0, 0, 0};
    {
      bf16x8 b_next = (fr < NV) ? *(const bf16x8*)(Xs + fr * RS + fq * 8) : zero8;
#pragma unroll 1
      for (int ks = 0; ks < NKS; ks++) {
        const bf16x8 b = b_next;
        const u16* ap = cpl - 16 * (wid * MPW) + 32 * ks;
        bf16x8 a_cur = *(const bf16x8*)(ap);
        bf16x8 a_nxt = *(const bf16x8*)(ap - 16);
        if (ks + 1 < NKS) b_next = (fr < NV) ? *(const bf16x8*)(Xs + fr * RS + (ks + 1) * 32 + fq * 8) : zero8;
#pragma unroll
        for (int mi = 0; mi < MPW; mi++) {
          bf16x8 a_n2 = a_nxt;
          if (mi + 2 < MPW) a_n2 = *(const bf16x8*)(ap - 16 * (mi + 2));
          __builtin_amdgcn_sched_barrier(0);
          acc[mi] = __builtin_amdgcn_mfma_f32_16x16x32_bf16(a_cur, b, acc[mi], 0, 0, 0);
          __builtin_amdgcn_sched_barrier(0);
          a_cur = a_nxt; a_nxt = a_n2;
        }
      }
    }
    if (fr < NV) {
      const u16* gate = GS;
      const u16* vin = o == 0 ? XV : O1;
#pragma unroll
      for (int mi = 0; mi < MPW; mi++) {
        const int t0 = (wid * MPW + mi) * 16 + fq * 4;
        u32x2 gq = *(const u32x2*)(gate + fr * RS + t0), vq = *(const u32x2*)(vin + fr * RS + t0);
        float g4[4] = {__uint_as_float(gq[0] << 16), __uint_as_float(gq[0] & 0xffff0000u), __uint_as_float(gq[1] << 16), __uint_as_float(gq[1] & 0xffff0000u)};
        float v4[4] = {__uint_as_float(vq[0] << 16), __uint_as_float(vq[0] & 0xffff0000u), __uint_as_float(vq[1] << 16), __uint_as_float(vq[1] & 0xffff0000u)};
        float r4[4];
#pragma unroll
        for (int j = 0; j < 4; j++) r4[j] = g4[j] * (acc[mi][j] * rn + bias * v4[j]);
        if (o == 0) {
          u32x2 ov; ov[0] = pack2(r4[0], r4[1]); ov[1] = pack2(r4[2], r4[3]);
          *(u32x2*)(O1 + fr * RS + t0) = ov;
        } else {
          u16* dst = LAT ? HYOT + (size_t)8192 * 512 + ((size_t)fr * 512 + c) * 1024 + t0 : HYOT + ((size_t)(sg * 16 + fr) * 512 + c) * 256 + t0;
          u32x2 ov; ov[0] = pack2(r4[0], r4[1]); ov[1] = pack2(r4[2], r4[3]);
          *(u32x2*)dst = ov;
        }
      }
    }
    __syncthreads();
  }
}

DEV void phaseD(const Params& p, int l, char* smem) {
  const int nbt = gridDim.x, bt = BID();
  __shared__ int s_task;
  unsigned* ctr = (unsigned*)(WS(p) + OFF_BAR) + 3600 + l * 8;
  if (nbt >= 128 && bt < 64) {
    s5_task(p, l, bt, smem);
    return;
  }
  const int s5lo = nbt >= 128 ? 64 : 0;
#define PULL(pool, limit, body) for (;;) { __syncthreads(); if (threadIdx.x == 0) s_task = (int)atomicAdd(&ctr[pool], 1u); __syncthreads(); \
                                           const int t = s_task; if (t >= (limit)) break; body; }
  PULL(0, 768, ret_task(p, l, t, smem))
  PULL(2, 576 - s5lo, s5_task(p, l, s5lo + t, smem))
  PULL(1, 512, hyena_mfma<true>(p, l, t, smem))
  PULL(3, 1024, hyena_mfma<false>(p, l, t, smem))
  PULL(4, 256, retstate_task(p, l, t))
#undef PULL
}

DEV void phaseE(const Params& p, char* smem) {
  const u16* HYOT = (const u16*)(WS(p) + OFF_OUT1) + (size_t)MT * 512;
  u16* HYO = (u16*)(WS(p) + OFF_OUT1);
  u16* sm = (u16*)smem;
  const int tx = TID() & 63, ty = TID() >> 6;
  for (int tile = BID(); tile < 192 * 8; tile += gridDim.x) {
    int rt = tile >> 3, c0 = (tile & 7) * 64; int row0 = rt * 64;
    const u16* src = row0 < 8192 ? HYOT + ((size_t)(row0 >> 8) * 512 + c0) * 256 + (row0 & 255)
                                 : HYOT + (size_t)8192 * 512 + ((size_t)((row0 - 8192) >> 10) * 512 + c0) * 1024 + ((row0 - 8192) & 1023);
    const int L = row0 < 8192 ? 256 : 1024;
    __syncthreads();
#pragma unroll
    for (int i = 0; i < 16; i++) { int cc = ty + i * 4; sm[cc * 66 + tx] = src[(size_t)cc * L + tx]; }
    __syncthreads();
#pragma unroll
    for (int i = 0; i < 16; i++) { int tt = ty + i * 4; HYO[(size_t)(row0 + tt) * 512 + c0 + tx] = sm[tx * 66 + tt]; }
  }
}

DEV void phaseF(const Params& p, int l, char* smem) {
  u16* sA = (u16*)smem; u16* T = (u16*)smem;
  const u16* H = (const u16*)(WS(p) + OFF_H);
  const u16* WT = (const u16*)(WS(p) + OFF_WT);
  const u16* ZA = (const u16*)(WS(p) + OFF_ZA); const u16* HYO = (const u16*)(WS(p) + OFF_OUT1);
  u16* MG = (u16*)(WS(p) + OFF_YP);
  for (int tile = BID(); tile < 96 * 16; tile += gridDim.x) {
    int tm = tile >> 4, tn = tile & 15;
    if (gridDim.x == 512) {
      const int r = tile >> 9, bb = tile & 511, x = bb & 7, j = bb >> 3;
      tm = r * 32 + (x >> 1) * 8 + (j >> 3); tn = (x & 1) * 8 + (j & 7);
    }
    int row0 = tm * 128, n0 = tn * 64;
    f32x4 a1[4][2], a2[4][2], tt[4][2];
    const u16* Hrow = H + (size_t)row0 * 1024;
    zero_acc<4, 2>(a1); zero_acc<4, 2>(tt);
#pragma unroll 1
    for (int ps = 0; ps < 7; ps++) {
      const u16* Ap; const u16* Bp; int lda, K;
      switch (ps) {
        case 0: Ap = ZA + (size_t)row0 * 2048; lda = 2048; Bp = WT + WGLU_O + (size_t)n0 * 512; K = 512; break;
        case 1: Ap = ZA + (size_t)row0 * 2048; lda = 2048; Bp = WT + WGLU_O + (size_t)(1024 + n0) * 512; K = 512; break;
        case 3: Ap = ZA + (size_t)row0 * 2048 + 512; lda = 2048; Bp = WT + WRETO_O + (size_t)n0 * 512; K = 512; break;
        case 5: Ap = HYO + (size_t)row0 * 512; lda = 512; Bp = WT + WHYO_O + (size_t)n0 * 512; K = 512; break;
        default: Ap = Hrow; lda = 1024; Bp = WT + WIN_O + (size_t)(4096 + ((ps - 2) >> 1) * 1024 + n0) * 1024; K = 1024; break;
      }
      zero_acc<4, 2>(a2);
      gemm_loop<4, 2>(Ap, lda, Bp, K, K, a2, sA);
      if (ps == 0 || ps == 3 || ps == 5) {
#pragma unroll
        for (int m = 0; m < 4; m++)
#pragma unroll
          for (int n = 0; n < 2; n++) a1[m][n] = a2[m][n];
      } else if (ps == 1) {
#pragma unroll
        for (int m = 0; m < 4; m++)
#pragma unroll
          for (int n = 0; n < 2; n++)
#pragma unroll
            for (int j = 0; j < 4; j++) a1[m][n][j] *= sigm(a2[m][n][j]);
      } else {
#pragma unroll
        for (int m = 0; m < 4; m++)
#pragma unroll
          for (int n = 0; n < 2; n++)
#pragma unroll
            for (int j = 0; j < 4; j++) tt[m][n][j] += a1[m][n][j] * sigm(a2[m][n][j]);
      }
    }
    __syncthreads();
    acc_to_lds<4, 2, 72>(tt, T, 0);
    __syncthreads();
    copy_tile<64, 72>(T, MG + (size_t)row0 * 1024 + n0, 1024);
  }
}

template <int MF, int NF>
DEV void resid_store(const Params& p, const f32x4 (&acc)[MF][NF], int l, int chunk, int row0, int col0, bool from_input) {
  const int tid = TID(), lane = tid & 63, wid = tid >> 6, wr = wid >> 1, wc = wid & 1, fr = lane & 15, fq = lane >> 4;
  float* out = OUTP(p);
#pragma unroll
  for (int m = 0; m < MF; m++) {
    const int rb = row0 + m * 32 + wr * 16 + fq * 4;
    const int j = modidx(rb);
    const float* MOD = (const float*)(WS(p) + OFF_MOD) + (l * 5 + j) * 6144 + chunk * 1024;
    const float* BM = INP(p, 7) + l * 6144 + chunk * 1024;
#pragma unroll
    for (int n = 0; n < NF; n++) {
      int col = col0 + wc * (NF * 16) + n * 16 + fr;
      float g = MOD[col] + BM[col];
#pragma unroll
      for (int jj = 0; jj < 4; jj++) {
        int row = rb + jj;
        float xo = from_input ? xin_row(p, row)[col] : out[(size_t)row * 1024 + col];
        out[(size_t)row * 1024 + col] = xo + g * acc[m][n][jj];
      }
    }
  }
}

DEV void phaseG(const Params& p, int l, char* smem) {
  u16* sA = (u16*)smem;
  const u16* MG = (const u16*)(WS(p) + OFF_YP);
  const u16* W = (const u16*)(WS(p) + OFF_WT) + WOUT_O;
  for (int tile = BID(); tile < 64 * 8; tile += gridDim.x) {
    int tm = tile >> 3, tn = tile & 7;
    f32x4 acc[6][4]; zero_acc<6, 4>(acc);
    gemm_loop<6, 4>(MG + (size_t)tm * 192 * 1024, 1024, W + (size_t)tn * 128 * 1024, 1024, 1024, acc, sA);
    resid_store<6, 4>(p, acc, l, 2, tm * 192, tn * 128, l == 0);
  }
}

DEV void phaseI(const Params& p, int l, char* smem) {
  u16* sA = (u16*)smem; u16* T = (u16*)smem;
  const u16* H = (const u16*)(WS(p) + OFF_H);
  const u16* W = (const u16*)(WS(p) + OFF_WT) + WFIN_O;
  u16* ACT = (u16*)(WS(p) + OFF_ZA);
  for (int tile = BID(); tile < 48 * 44; tile += gridDim.x) {
    int tm = tile / 44, tn = tile % 44;
    if (gridDim.x == 512) {
      const int r = tile >> 9, bb = tile & 511, x = bb & 7, j = bb >> 3;
      int sb = r * 16 + x * 2 + (j >> 5), inner = j & 31;
      if (r == 4) { sb = 64 + (bb >> 5); inner = bb & 31; }
      tm = (sb / 11) * 8 + (inner >> 2); tn = (sb % 11) * 4 + (inner & 3);
    }
    f32x4 acc[8][4]; zero_acc<8, 4>(acc);
    gemm_loop<8, 4>(H + (size_t)tm * 256 * 1024, 1024, W + (size_t)tn * 128 * 1024, 1024, 1024, acc, sA);
    const int tid = TID(), lane = tid & 63, wid = tid >> 6, wr = wid >> 1, wc = wid & 1, fr = lane & 15, fq = lane >> 4;
#pragma unroll
    for (int hh = 0; hh < 2; hh++) {
      __syncthreads();
#pragma unroll
      for (int m = 0; m < 4; m++)
#pragma unroll
        for (int n = 0; n < 2; n++)
#pragma unroll
          for (int j = 0; j < 4; j++)
            T[(m * 32 + wr * 16 + fq * 4 + j) * 72 + wc * 32 + n * 16 + fr] = f2bf(silu_(acc[hh * 4 + m][2 * n][j]) * acc[hh * 4 + m][2 * n + 1][j]);
      __syncthreads();
      copy_tile<64, 72>(T, ACT + (size_t)(tm * 256 + hh * 128) * 2816 + tn * 64, 2816);
    }
  }
}

DEV void phaseJ(const Params& p, int l, char* smem) {
  u16* sA = (u16*)smem;
  const u16* ACT = (const u16*)(WS(p) + OFF_ZA);
  const u16* W = (const u16*)(WS(p) + OFF_WT) + WFOUT_O;
  for (int tile = BID(); tile < 64 * 8; tile += gridDim.x) {
    int tm = tile >> 3, tn = tile & 7;
    f32x4 acc[6][4]; zero_acc<6, 4>(acc);
    gemm_loop<6, 4>(ACT + (size_t)tm * 192 * 2816, 2816, W + (size_t)tn * 128 * 2816, 2816, 2816, acc, sA);
    resid_store<6, 4>(p, acc, l, 5, tm * 192, tn * 128, false);
  }
}


#define XB_TMO      128
#define XB_XCNT(j)  (256  + 64 * (j))
#define XB_XSUB(j)  (1280 + 64 * (j))
#define XB_XGEN(j)  (2304 + 64 * (j))
#define XB_TOP      3328
#define XB_TOPGEN   3392
#define XB_SPIN_CAP (1u << 22)
#define LAS __attribute__((address_space(3)))
DEV unsigned xb_ld(unsigned* p) { return __hip_atomic_load(p, __ATOMIC_RELAXED, __HIP_MEMORY_SCOPE_AGENT); }
DEV unsigned xb_add(unsigned* p, unsigned v) { return __hip_atomic_fetch_add(p, v, __ATOMIC_RELAXED, __HIP_MEMORY_SCOPE_AGENT); }
DEV unsigned xb_xcc_id() { return (unsigned)__builtin_amdgcn_s_getreg((3 << 11) | 20) & 0xFu; }
#define XB_SPIN(cond, bar) do { unsigned _sp = 0; while (cond) { __builtin_amdgcn_s_sleep(1); \
    if ((++_sp & 255u) == 0u) { if (xb_ld(&(bar)[XB_TMO])) break; if (_sp > XB_SPIN_CAP) { atomicAdd(&(bar)[XB_TMO], 1u); break; } } } } while (0)
struct XcdBarrier { unsigned* bar; unsigned x; volatile LAS unsigned* st; };
DEV XcdBarrier xcd_barrier_post(unsigned* bar, volatile LAS unsigned* st) {
  XcdBarrier b; b.bar = bar; b.x = xb_xcc_id(); b.st = st;
  if (threadIdx.x == 0) (void)xb_add(&bar[XB_XCNT(b.x)], 1u);
  return b;
}
DEV void xcd_barrier_complete(unsigned* bar, unsigned x, unsigned& nloc, unsigned& nx) {
  const unsigned G = gridDim.x * gridDim.y * gridDim.z;
  unsigned sum, cnt, mine, sp = 0u;
  for (;;) {
    sum = 0u; cnt = 0u; mine = 0u;
#pragma unroll
    for (unsigned j = 0; j < 16; ++j) { const unsigned c = xb_ld(&bar[XB_XCNT(j)]); sum += c; cnt += (c > 0u) ? 1u : 0u; mine = (j == x) ? c : mine; }
    if (sum == G) break;
    __builtin_amdgcn_s_sleep(1);
    if ((++sp & 255u) == 0u) { if (xb_ld(&bar[XB_TMO])) break; if (sp > XB_SPIN_CAP) { atomicAdd(&bar[XB_TMO], 1u); break; } }
  }
  nloc = mine > 0u ? mine : 1u; nx = cnt > 0u ? cnt : 1u;
}
DEV void xcd_barrier(const XcdBarrier& b) {
  asm volatile("s_waitcnt vmcnt(0)" ::: "memory");
  __syncthreads();
  if (threadIdx.x == 0) {
    unsigned* bar = b.bar;
    __builtin_amdgcn_s_waitcnt(0);
    unsigned nloc = b.st[0], nx = b.st[1];
    if (nloc == 0u) { xcd_barrier_complete(bar, b.x, nloc, nx); b.st[0] = nloc; b.st[1] = nx; }
    const unsigned old = xb_add(&bar[XB_XSUB(b.x)], 1u);
    const unsigned gen = old / nloc;
    if (old + 1u == (gen + 1u) * nloc) {
      __builtin_amdgcn_fence(__ATOMIC_RELEASE, "agent");
      asm volatile("s_waitcnt vmcnt(0)" ::: "memory");
      const unsigned og = xb_add(&bar[XB_TOP], 1u);
      const unsigned tg = og / nx;
      if (og + 1u == (tg + 1u) * nx) xb_add(&bar[XB_TOPGEN], 1u);
      else XB_SPIN(xb_ld(&bar[XB_TOPGEN]) == tg, bar);
      __builtin_amdgcn_fence(__ATOMIC_ACQUIRE, "agent");
      xb_add(&bar[XB_XGEN(b.x)], 1u);
      asm volatile("s_waitcnt vmcnt(0)" ::: "memory");
    } else {
      XB_SPIN(xb_ld(&bar[XB_XGEN(b.x)]) == gen, bar);
      __builtin_amdgcn_fence(__ATOMIC_ACQUIRE, "agent");
      asm volatile("s_waitcnt vmcnt(0)" ::: "memory");
    }
  }
  __syncthreads();
}

constexpr int SMEM_BYTES = 57792;

DEV void run_phase(const Params& p, int ph, int l, char* smem) {
  switch (ph) {
    case 0: phaseA(p, smem); break;
    case 1: norm_phase(p, l, 0); if (l == 1) layer_prep(p, 1, smem); break;
    case 2: phaseC(p, l, smem); break;
    case 3: phaseD(p, l, smem); break;
    case 4: phaseE(p, smem); break;
    case 5: phaseF(p, l, smem); break;
    case 6: phaseG(p, l, smem); break;
    case 7: norm_phase(p, l, 1); break;
    case 8: phaseI(p, l, smem); break;
    case 9: phaseJ(p, l, smem); break;
    case 10: norm_phase(p, 0, 2); break;
  }
}

#if MULTI
__global__ void __launch_bounds__(256, 2) kphase(Params p, int ph, int l) {
  __shared__ __attribute__((aligned(16))) char smem[SMEM_BYTES];
  run_phase(p, ph, l, smem);
}
#else
__global__ void __launch_bounds__(256, 2) mega(Params p) {
  __shared__ __attribute__((aligned(16))) char smem[SMEM_BYTES];
  __shared__ uint4 xb_words;
  cg::grid_group grid = cg::this_grid();
  if (threadIdx.x == 0) xb_words = make_uint4(0u, 0u, 0u, 0u);
  __syncthreads();
  XcdBarrier xb = xcd_barrier_post((unsigned*)(p.ws + OFF_BAR), (volatile LAS unsigned*)&xb_words);
  run_phase(p, 0, 0, smem);
  grid.sync();
  for (int l = 0; l < 2; l++) {
    for (int ph = 1; ph <= 9; ph++) {
      run_phase(p, ph, l, smem);
      xcd_barrier(xb);
    }
  }
  run_phase(p, 10, 0, smem);
}
#endif

extern "C" void kernel_launch(void* const* d_in, const int* in_sizes, int n_in, void* d_out, int out_size, void* d_ws, size_t ws_size, hipStream_t stream) {
  Params p{};
  for (int i = 0; i < 36; i++) p.in[i] = (const float*)d_in[i];
  p.out = (float*)d_out;
  p.ws = (char*)d_ws;
  hipMemsetAsync((char*)d_ws + OFF_MOD, 0, ZERO_BYTES, stream);
  static int grid_blocks = 0;
#if MULTI
  if (!grid_blocks) {
    int dev = 0, cus = 0, per_cu = 0;
    hipGetDevice(&dev);
    hipDeviceGetAttribute(&cus, hipDeviceAttributeMultiprocessorCount, dev);
    hipOccupancyMaxActiveBlocksPerMultiprocessor(&per_cu, kphase, 256, 0);
    if (per_cu > 2) per_cu = 2;
    if (per_cu < 1) per_cu = 1;
    grid_blocks = cus * per_cu;
  }
  kphase<<<grid_blocks, 256, 0, stream>>>(p, 0, 0);
  for (int l = 0; l < 2; l++)
    for (int ph = 1; ph <= 9; ph++) kphase<<<grid_blocks, 256, 0, stream>>>(p, ph, l);
  kphase<<<grid_blocks, 256, 0, stream>>>(p, 10, 0);
#else
  if (!grid_blocks) {
    int dev = 0, cus = 0, per_cu = 0;
    hipGetDevice(&dev);
    hipDeviceGetAttribute(&cus, hipDeviceAttributeMultiprocessorCount, dev);
    hipOccupancyMaxActiveBlocksPerMultiprocessor(&per_cu, mega, 256, 0);
    if (per_cu > 2) per_cu = 2;
    if (per_cu < 1) per_cu = 1;
    grid_blocks = cus * per_cu;
  }
  void* args[] = {&p};
  hipError_t e = hipLaunchCooperativeKernel((void*)mega, dim3(grid_blocks), dim3(256), args, 0, stream);
  if (e != hipSuccess) fprintf(stderr, "cooperative launch failed: %s (grid %d)\n", hipGetErrorString(e), grid_blocks);
#endif
}
```
